# Optimizing an MI355X kernel written in HIP

```python
import math
import jax
import jax.numpy as jnp
from jax import lax
import numpy as np

D_MODEL = 1024
BATCH = 2
SEQ = 8192
DEPTH = 2

GRID_W = 64
CTX_LEN = 256
EPS = 1e-6
ADA_CHUNKS = 6

MLA_HEADS = 4
MLA_NOPE = 64
MLA_ROPE = 32
MLA_QK = MLA_NOPE + MLA_ROPE
MLA_V = 64
MLA_Q_LORA = 192
MLA_KV_LORA = 128
ROPE_THETA = 10000.0
Q_BLOCK = 128

GDN_HEADS = 4
GDN_DK = 128
GDN_DV = 128
GDN_CONV = 3
GDN_CHUNK = 64

POOL_WINDOWS = (2, 4, 8, 16)
POOL_GROUP = 64
POOL_WIDTH = POOL_GROUP * len(POOL_WINDOWS)

D_MIX = MLA_HEADS * MLA_V + GDN_HEADS * GDN_DV + POOL_WIDTH

N_EXPERTS = 16
EC_CAPACITY_FACTOR = 2
D_EXPERT = 512

IN_SPLITS = (MLA_Q_LORA, MLA_KV_LORA, MLA_ROPE,
             GDN_HEADS * GDN_DK, GDN_HEADS * GDN_DK, GDN_HEADS * GDN_DV, GDN_HEADS * GDN_DV,
             2 * GDN_HEADS, 2 * GDN_HEADS, POOL_WIDTH)
IN_COLS = sum(IN_SPLITS)

kernel_name = "hybrid_mla_gdn_pool_ecmoe_dit"


def rms_norm(x, g):
    xf = x.astype(jnp.float32)
    y = xf * lax.rsqrt(jnp.mean(xf * xf, axis=-1, keepdims=True) + EPS)
    return (y * g.astype(jnp.float32)).astype(x.dtype)


def l2_norm(x):
    xf = x.astype(jnp.float32)
    return (xf * lax.rsqrt(jnp.sum(xf * xf, axis=-1, keepdims=True) + EPS)).astype(x.dtype)


def modulate(x, g, shift, scale):
    return rms_norm(x, g) * (1.0 + scale) + shift


def split_cols(p):
    offsets = [int(o) for o in np.cumsum(IN_SPLITS)[:-1]]
    return jnp.split(p, offsets, axis=-1)


def axial_rope_tables(n_tokens):
    rows = n_tokens // GRID_W
    row = jnp.repeat(jnp.arange(rows, dtype=jnp.float32), GRID_W)
    col = jnp.tile(jnp.arange(GRID_W, dtype=jnp.float32), rows)
    n_freq = MLA_ROPE // 4
    inv_freq = ROPE_THETA ** (-jnp.arange(n_freq, dtype=jnp.float32) / n_freq)
    ang_r = row[:, None] * inv_freq
    ang_c = col[:, None] * inv_freq
    return tuple(t[None, :, None, :] for t in (jnp.cos(ang_r), jnp.sin(ang_r), jnp.cos(ang_c), jnp.sin(ang_c)))


def rotate_half(x, cos, sin):
    x1, x2 = jnp.split(x, 2, axis=-1)
    return jnp.concatenate([x1 * cos - x2 * sin, x2 * cos + x1 * sin], axis=-1)


def with_rope(x, rope_tabs):
    if rope_tabs is None:
        return x
    cr, sr, cc, sc = rope_tabs
    xr, xcol = jnp.split(x[..., MLA_NOPE:].astype(jnp.float32), 2, axis=-1)
    rot = jnp.concatenate([rotate_half(xr, cr, sr), rotate_half(xcol, cc, sc)], axis=-1)
    return jnp.concatenate([x[..., :MLA_NOPE], rot.astype(x.dtype)], axis=-1)


def mla_queries(p_q, q_a_norm, w_uq, q_norm, rope_tabs):
    B, T, _ = p_q.shape
    q = (rms_norm(p_q, q_a_norm) @ w_uq).reshape(B, T, MLA_HEADS, MLA_QK)
    return with_rope(rms_norm(q, q_norm), rope_tabs)


def mla_keys_values(p_kv, p_kr, kv_a_norm, w_ukv, k_norm, rope_tabs):
    B, T, _ = p_kv.shape
    kv = (rms_norm(p_kv, kv_a_norm) @ w_ukv).reshape(B, T, MLA_HEADS, MLA_NOPE + MLA_V)
    k_nope, v = kv[..., :MLA_NOPE], kv[..., MLA_NOPE:]
    k_rope = jnp.broadcast_to(p_kr[:, :, None, :], (B, T, MLA_HEADS, MLA_ROPE))
    k = rms_norm(jnp.concatenate([k_nope, k_rope], axis=-1), k_norm)
    return with_rope(k, rope_tabs), v


def softmax_attend(q, k, v):
    s = jnp.einsum('bqhd,bkhd->bhqk', q, k, preferred_element_type=jnp.float32) * (MLA_QK ** -0.5)
    p = jax.nn.softmax(s, axis=-1).astype(v.dtype)
    return jnp.einsum('bhqk,bkhd->bqhd', p, v)


def blocked_attend(q, k, v):
    B, T, H, d = q.shape
    nb = T // Q_BLOCK
    qb = jnp.moveaxis(q.reshape(B, nb, Q_BLOCK, H, d), 1, 0)
    out = lax.map(lambda qi: softmax_attend(qi, k, v), qb)
    return jnp.moveaxis(out, 0, 1).reshape(B, T, H, v.shape[-1])


def short_conv(u, w):
    pad = GDN_CONV // 2
    return lax.conv_general_dilated(u, w[:, None, :].astype(u.dtype), window_strides=(1,),
                                    padding=((pad, pad),), dimension_numbers=('NWC', 'WIO', 'NWC'),
                                    feature_group_count=u.shape[-1])


def gdn_inputs(pq, pk, pv, pa, pb, conv_w, a_log, dt_bias):
    B, T, _ = pq.shape
    qkv = jax.nn.silu(short_conv(jnp.concatenate([pq, pk, pv], axis=-1), conv_w))
    q, k, v = jnp.split(qkv, [GDN_HEADS * GDN_DK, 2 * GDN_HEADS * GDN_DK], axis=-1)
    q = l2_norm(q.reshape(B, T, GDN_HEADS, GDN_DK)) * (GDN_DK ** -0.5)
    k = l2_norm(k.reshape(B, T, GDN_HEADS, GDN_DK))
    v = v.reshape(B, T, GDN_HEADS, GDN_DV)
    pa = pa.reshape(B, T, 2, GDN_HEADS).astype(jnp.float32)
    pb = pb.reshape(B, T, 2, GDN_HEADS).astype(jnp.float32)
    g = -jnp.exp(a_log.astype(jnp.float32)) * jax.nn.softplus(pa + dt_bias.astype(jnp.float32))
    beta = jax.nn.sigmoid(pb)
    return q, k, v, g, beta


def gated_delta_chunked(q, k, v, g, beta, s0):
    B, T, H, _ = q.shape
    dv = v.shape[-1]
    C = GDN_CHUNK
    n = T // C
    f32 = jnp.float32

    def chunks(a):
        a = a.astype(f32).reshape((B, n, C, H) + a.shape[3:])
        return jnp.moveaxis(a, (1, 3), (0, 2))

    qc, kc, vc, bc = chunks(q), chunks(k), chunks(v), chunks(beta)
    gc = jnp.cumsum(chunks(g), axis=-1)
    idx = jnp.arange(C)
    incl = idx[:, None] >= idx[None, :]
    strict = idx[:, None] > idx[None, :]
    decay = jnp.exp(jnp.where(incl, gc[..., :, None] - gc[..., None, :], -jnp.inf))
    kb = kc * bc[..., None]
    a_low = jnp.where(strict, jnp.einsum('nbhcd,nbhsd->nbhcs', kb, kc) * decay, 0.0)
    tmat = a_low + jnp.eye(C, dtype=f32)
    w = lax.linalg.triangular_solve(tmat, kb * jnp.exp(gc)[..., None], left_side=True, lower=True, unit_diagonal=True)
    u = lax.linalg.triangular_solve(tmat, vc * bc[..., None], left_side=True, lower=True, unit_diagonal=True)
    qk = jnp.einsum('nbhcd,nbhsd->nbhcs', qc, kc) * decay
    qg = qc * jnp.exp(gc)[..., None]
    g_last = gc[..., -1]
    kd = kc * jnp.exp(g_last[..., None] - gc)[..., None]

    def step(s, inp):
        w_i, u_i, qk_i, qg_i, kd_i, gl_i = inp
        v_new = u_i - jnp.einsum('bhcd,bhde->bhce', w_i, s)
        o = jnp.einsum('bhcd,bhde->bhce', qg_i, s) + jnp.einsum('bhcs,bhse->bhce', qk_i, v_new)
        s = s * jnp.exp(gl_i)[..., None, None] + jnp.einsum('bhcd,bhce->bhde', kd_i, v_new)
        return s, o

    s_final, o = lax.scan(step, s0.astype(f32), (w, u, qk, qg, kd, g_last))
    o = jnp.moveaxis(o, (0, 2), (1, 3)).reshape(B, T, H, dv)
    return o.astype(v.dtype), s_final


def gdn_bidirectional(c_in, l_in):
    qc, kc, vc, gc, bc = c_in
    ql, kl, vl, gl, bl = l_in
    s0 = jnp.zeros((qc.shape[0], GDN_HEADS, GDN_DK, GDN_DV), jnp.float32)
    rev = lambda a: jnp.flip(a, axis=1)
    o_cf, s_cf = gated_delta_chunked(qc, kc, vc, gc[:, :, 0], bc[:, :, 0], s0)
    o_lf, _ = gated_delta_chunked(ql, kl, vl, gl[:, :, 0], bl[:, :, 0], s_cf)
    o_cb, s_cb = gated_delta_chunked(rev(qc), rev(kc), rev(vc), rev(gc[:, :, 1]), rev(bc[:, :, 1]), s0)
    o_lb, _ = gated_delta_chunked(rev(ql), rev(kl), rev(vl), rev(gl[:, :, 1]), rev(bl[:, :, 1]), s_cb)
    return o_cf + rev(o_cb), o_lf + rev(o_lb)


def gdn_output(o, z, norm_g):
    B, T = z.shape[:2]
    zh = z.reshape(B, T, GDN_HEADS, GDN_DV)
    return (rms_norm(o, norm_g) * jax.nn.silu(zh)).reshape(B, T, GDN_HEADS * GDN_DV)


def pool_mixer(u, pool_w, pool_scale):
    B, T, _ = u.shape
    uf = u.astype(jnp.float32)
    csum = jnp.concatenate([jnp.zeros((B, 1, POOL_WIDTH), jnp.float32), jnp.cumsum(uf, axis=1)], axis=1)
    t = jnp.arange(T)
    diffs = []
    for gi, win in enumerate(POOL_WINDOWS):
        lo = jnp.clip(t - win // 2, 0, T)
        hi = jnp.clip(t - win // 2 + win, 0, T)
        sl = slice(gi * POOL_GROUP, (gi + 1) * POOL_GROUP)
        mean = (csum[:, hi, sl] - csum[:, lo, sl]) / (hi - lo).astype(jnp.float32)[None, :, None]
        diffs.append(mean - uf[..., sl])
    d = jnp.stack(diffs, axis=2).astype(u.dtype)
    y = jnp.einsum('btgc,gcd->btgd', d, pool_w).reshape(B, T, POOL_WIDTH)
    return y * pool_scale


def expert_choice_ffn(h, w_router, w_gate, w_up, w_down):
    B, T, D = h.shape
    cap = EC_CAPACITY_FACTOR * T // N_EXPERTS
    aff = jax.nn.softmax(jnp.einsum('btd,de->bte', h, w_router, preferred_element_type=jnp.float32), axis=-1)
    gate, idx = lax.top_k(jnp.swapaxes(aff, 1, 2), cap)
    xs = jax.vmap(lambda hb, ib: hb[ib])(h, idx)
    hid = jax.nn.silu(jnp.einsum('becd,edf->becf', xs, w_gate)) * jnp.einsum('becd,edf->becf', xs, w_up)
    y = jnp.einsum('becf,efd->becd', hid, w_down) * gate.astype(h.dtype)[..., None]
    return jax.vmap(lambda yb, ib: jnp.zeros((T, D), h.dtype).at[ib.reshape(-1)].add(yb.reshape(-1, D)))(y, idx)


def mixer_sublayer(h_c, h_l, rope_tabs, need_ctx, w_in, q_a_norm, w_uq, kv_a_norm, w_ukv, q_norm, k_norm,
                   conv_w, a_log, dt_bias, gdn_norm_g, pool_w, pool_scale, w_out):
    B, T, _ = h_l.shape
    pc = split_cols(h_c @ w_in)
    pl = split_cols(h_l @ w_in)
    k_c, v_c = mla_keys_values(pc[1], pc[2], kv_a_norm, w_ukv, k_norm, None)
    k_l, v_l = mla_keys_values(pl[1], pl[2], kv_a_norm, w_ukv, k_norm, rope_tabs)
    q_l = mla_queries(pl[0], q_a_norm, w_uq, q_norm, rope_tabs)
    att_l = blocked_attend(q_l, jnp.concatenate([k_c, k_l], axis=1),
                           jnp.concatenate([v_c, v_l], axis=1)).reshape(B, T, MLA_HEADS * MLA_V)
    c_in = gdn_inputs(pc[3], pc[4], pc[5], pc[7], pc[8], conv_w, a_log, dt_bias)
    l_in = gdn_inputs(pl[3], pl[4], pl[5], pl[7], pl[8], conv_w, a_log, dt_bias)
    o_c, o_l = gdn_bidirectional(c_in, l_in)
    gdn_l = gdn_output(o_l, pl[6], gdn_norm_g)
    pool_l = pool_mixer(pl[9], pool_w, pool_scale)
    y_l = jnp.concatenate([att_l, gdn_l, pool_l], axis=-1) @ w_out
    if not need_ctx:
        return None, y_l
    q_c = mla_queries(pc[0], q_a_norm, w_uq, q_norm, None)
    att_c = softmax_attend(q_c, k_c, v_c).reshape(B, -1, MLA_HEADS * MLA_V)
    gdn_c = gdn_output(o_c, pc[6], gdn_norm_g)
    pool_c = pool_mixer(pc[9], pool_w, pool_scale)
    y_c = jnp.concatenate([att_c, gdn_c, pool_c], axis=-1) @ w_out
    return y_c, y_l


def setup_inputs(seed: int = 0) -> dict:
    key = jax.random.key(seed)
    keys = jax.random.split(key, 32)
    f32 = jnp.float32
    L, D = DEPTH, D_MODEL

    def nrm(i, shape, scale):
        return jax.random.normal(keys[i], shape, f32) * scale

    dt = jnp.exp(jax.random.uniform(keys[17], (L, 2, GDN_HEADS), f32, math.log(1e-3), math.log(1e-1)))
    return {
        'x': nrm(0, (BATCH, SEQ, D), 1.0),
        'c': nrm(1, (BATCH, D), 1.0),
        'ctx': nrm(2, (BATCH, CTX_LEN, D), 1.0),
        'c_ctx': nrm(3, (D,), 1.0),
        'ada_w': nrm(4, (L, D, ADA_CHUNKS * D), 0.5 * D ** -0.5),
        'ada_b': nrm(5, (L, ADA_CHUNKS * D), 0.02),
        'norm1_g': 1.0 + nrm(6, (L, D), 0.05),
        'norm2_g': 1.0 + nrm(7, (L, D), 0.05),
        'w_in': nrm(8, (L, D, IN_COLS), D ** -0.5),
        'mla_q_a_norm': 1.0 + nrm(9, (L, MLA_Q_LORA), 0.05),
        'mla_w_uq': nrm(10, (L, MLA_Q_LORA, MLA_HEADS * MLA_QK), MLA_Q_LORA ** -0.5),
        'mla_kv_a_norm': 1.0 + nrm(11, (L, MLA_KV_LORA), 0.05),
        'mla_w_ukv': nrm(12, (L, MLA_KV_LORA, MLA_HEADS * (MLA_NOPE + MLA_V)), MLA_KV_LORA ** -0.5),
        'mla_q_norm': 1.0 + nrm(13, (L, MLA_QK), 0.05),
        'mla_k_norm': 1.0 + nrm(14, (L, MLA_QK), 0.05),
        'gdn_conv_w': nrm(15, (L, GDN_CONV, 2 * GDN_HEADS * GDN_DK + GDN_HEADS * GDN_DV), GDN_CONV ** -0.5),
        'gdn_a_log': jnp.log(jax.random.uniform(keys[16], (L, 2, GDN_HEADS), f32, 1.0, 16.0)),
        'gdn_dt_bias': dt + jnp.log(-jnp.expm1(-dt)),
        'gdn_norm_g': 1.0 + nrm(18, (L, GDN_DV), 0.05),
        'pool_w': nrm(19, (L, len(POOL_WINDOWS), POOL_GROUP, POOL_GROUP), POOL_GROUP ** -0.5),
        'pool_scale': 1.0 + nrm(20, (L, POOL_WIDTH), 0.1),
        'w_out': nrm(21, (L, D_MIX, D), D_MIX ** -0.5),
        'moe_router': nrm(22, (L, D, N_EXPERTS), D ** -0.5),
        'moe_w_gate': nrm(23, (L, N_EXPERTS, D, D_EXPERT), D ** -0.5),
        'moe_w_up': nrm(24, (L, N_EXPERTS, D, D_EXPERT), D ** -0.5),
        'moe_w_down': nrm(25, (L, N_EXPERTS, D_EXPERT, D), D_EXPERT ** -0.5),
    }


def reference(x, c, ctx, c_ctx, ada_w, ada_b, norm1_g, norm2_g, w_in, mla_q_a_norm, mla_w_uq, mla_kv_a_norm,
              mla_w_ukv, mla_q_norm, mla_k_norm, gdn_conv_w, gdn_a_log, gdn_dt_bias, gdn_norm_g, pool_w,
              pool_scale, w_out, moe_router, moe_w_gate, moe_w_up, moe_w_down):
    rope_tabs = axial_rope_tables(x.shape[1])
    xc = ctx
    for l in range(DEPTH):
        need_ctx = l < DEPTH - 1
        m = jnp.split(jax.nn.silu(c) @ ada_w[l] + ada_b[l], ADA_CHUNKS, axis=-1)
        mc = jnp.split(jax.nn.silu(c_ctx) @ ada_w[l] + ada_b[l], ADA_CHUNKS, axis=-1)
        sh1, sc1, g1, sh2, sc2, g2 = [t[:, None, :] for t in m]
        csh1, csc1, cg1, csh2, csc2, cg2 = mc
        h_l = modulate(x, norm1_g[l], sh1, sc1)
        h_c = modulate(xc, norm1_g[l], csh1, csc1)
        y_c, y_l = mixer_sublayer(h_c, h_l, rope_tabs, need_ctx, w_in[l], mla_q_a_norm[l], mla_w_uq[l],
                                  mla_kv_a_norm[l], mla_w_ukv[l], mla_q_norm[l], mla_k_norm[l], gdn_conv_w[l],
                                  gdn_a_log[l], gdn_dt_bias[l], gdn_norm_g[l], pool_w[l], pool_scale[l], w_out[l])
        x = x + g1 * y_l
        x = x + g2 * expert_choice_ffn(modulate(x, norm2_g[l], sh2, sc2), moe_router[l], moe_w_gate[l],
                                       moe_w_up[l], moe_w_down[l])
        if need_ctx:
            xc = xc + cg1 * y_c
            xc = xc + cg2 * expert_choice_ffn(modulate(xc, norm2_g[l], csh2, csc2), moe_router[l],
                                              moe_w_gate[l], moe_w_up[l], moe_w_down[l])
    return x
```

```cpp
#include <hip/hip_runtime.h>
#include <hip/hip_bf16.h>
#include <hip/hip_cooperative_groups.h>
#include <cstdint>
#include <cstdio>
namespace cg = cooperative_groups;
#define REP_SCAN 1
#define REP_ATTN 1
#define REP_PRE 1
#define REP_MLA 1
#define REP_PMW 1
#define REP_TOPK 1
#define REP_GATHER 1
#define REP_INPROJ 1
#define REP_MOEGU 1
#define REP_MOD 1
#define REP_FIN 1
#define REP_INIT 1

constexpr int D = 1024, NB = 2, T = 8192, TC = 256;
constexpr int ML = NB * T;
constexpr int MC = NB * TC;
constexpr int MR = ML + MC;
constexpr int NIN = 2672, NINP = 2816;
constexpr int NE = 16, DEXP = 512, CAPL = 1024, CAPC = 32;
constexpr int NPAIR = NB * NE * CAPL + NB * NE * CAPC;
constexpr int TK = TC + T;
constexpr float EPS = 1e-6f;
constexpr int NT = 512;
constexpr int PC_Q = 0, PC_KV = 192, PC_KR = 320, PC_GQ = 352, PC_GK = 864, PC_GV = 1376, PC_Z = 1888, PC_A = 2400, PC_B = 2408, PC_POOL = 2416;
constexpr int PC_OF = 352, PC_OB = 864;

typedef unsigned short bf16_t;
__device__ __forceinline__ float bf2f(bf16_t b) { return __uint_as_float(((unsigned)b) << 16); }
__device__ __forceinline__ bf16_t f2bf(float f) { unsigned u = __float_as_uint(f); u += 0x7FFFu + ((u >> 16) & 1u); return (bf16_t)(u >> 16); }
__device__ __forceinline__ float silu_f(float x) { return x * __builtin_amdgcn_rcpf(1.0f + __expf(-x)); }
__device__ __forceinline__ float sigmoid_f(float x) { return 1.0f / (1.0f + expf(-x)); }
__device__ __forceinline__ float softplus_f(float x) {
  if (x > 20.f) return x;
  const float y = __expf(x);
  return y < 0.0625f ? y * (1.f - y * (0.5f - y * (0.333333343f - 0.25f * y))) : __logf(1.f + y);
}

constexpr size_t al256(size_t x) { return (x + 255) / 256 * 256; }
constexpr size_t OFF_BAR = 0;
constexpr size_t OFF_MOD = 16384;
constexpr size_t OFF_XC = al256(OFF_MOD + 2 * 3 * 6144 * 4);
constexpr size_t OFF_AFFT = al256(OFF_XC + (size_t)MC * D * 4);
constexpr size_t OFF_IDX = al256(OFF_AFFT + (size_t)NE * MR * 4);
constexpr size_t OFF_GATE = al256(OFF_IDX + (size_t)NPAIR * 4);
constexpr size_t OFF_SLOT = al256(OFF_GATE + (size_t)NPAIR * 4);
constexpr size_t OFF_GB = al256(OFF_SLOT + (size_t)MR * 16 * 4);
constexpr size_t OFF_H = al256(OFF_GB + (size_t)MR * 16 * 4);
constexpr size_t OFF_P = al256(OFF_H + (size_t)MR * D * 2);
constexpr size_t OFF_RB = al256(OFF_P + (size_t)MR * NINP * 2);
constexpr size_t RB_BYTES = (size_t)1056 * 100352;
constexpr size_t OFF_QKV = al256(OFF_RB + RB_BYTES);
constexpr size_t QK_ELEMS = (size_t)NB * 4 * TK * 128, V_ELEMS = (size_t)NB * 4 * TK * 64;
constexpr size_t OFF_WINT = al256(OFF_QKV + (2 * QK_ELEMS + V_ELEMS) * 2);
constexpr size_t OFF_WOUTT = al256(OFF_WINT + (size_t)2 * NINP * D * 2);
constexpr size_t OFF_WUP = al256(OFF_WOUTT + (size_t)2 * D * D * 2);
constexpr size_t OFF_MOEGU = al256(OFF_WUP + (size_t)2 * 1024 * 256 * 2);
constexpr size_t OFF_MOED = OFF_MOEGU + (size_t)NE * D * D * 2;
constexpr size_t OFF_END = al256(OFF_MOED + (size_t)NE * D * DEXP * 2);
constexpr size_t OFF_UPRAW = OFF_MOEGU;
constexpr size_t OFF_OPART = OFF_MOEGU;
constexpr size_t OFF_MLPART = OFF_OPART + (size_t)4 * ML * 256 * 2;
static_assert(OFF_MLPART + (size_t)4 * ML * 4 * 2 * 4 <= OFF_END, "partials must fit in the MoE weight region");
constexpr size_t OFF_HID = OFF_RB + (size_t)64 * 1024 * 1024;
constexpr size_t OFF_Y = OFF_P;
constexpr size_t OFF_YO = OFF_P;
constexpr size_t OFF_XS = OFF_P;


struct Params {
  const float* x; const float* c; const float* ctx; const float* c_ctx; const float* ada_w; const float* ada_b;
  const float* norm1_g; const float* norm2_g; const float* w_in; const float* q_a_norm; const float* w_uq; const float* kv_a_norm;
  const float* w_ukv; const float* q_norm; const float* k_norm; const float* conv_w; const float* a_log; const float* dt_bias;
  const float* gdn_norm_g; const float* pool_w; const float* pool_scale; const float* w_out; const float* router;
  const float* w_gate; const float* w_up; const float* w_down;
  float* out; char* ws;
};

__device__ __forceinline__ const float* xrow_src(const Params& p, int r, int l) { return l == 0 ? (r < ML ? p.x + (size_t)r * D : p.ctx + (size_t)(r - ML) * D) : (r < ML ? p.out + (size_t)r * D : (const float*)(p.ws + OFF_XC) + (size_t)(r - ML) * D); }
__device__ __forceinline__ float* xrow(const Params& p, int r) { return r < ML ? p.out + (size_t)r * D : (float*)(p.ws + OFF_XC) + (size_t)(r - ML) * D; }
__device__ __forceinline__ void rowinfo(int r, int& mj, int& t, int& tlen, int& r0) {
  if (r < ML) { mj = r >> 13; t = r & (T - 1); tlen = T; r0 = r - t; } else { int rc = r - ML; mj = 2; t = rc & (TC - 1); tlen = TC; r0 = r - t; }
}
__device__ __forceinline__ const float* modvec(const Params& p, int l, int mj, int chunk) { return (const float*)(p.ws + OFF_MOD) + ((size_t)(l * 3 + mj) * 6 + chunk) * D; }
__device__ __forceinline__ int pair_base(int s, int e) { return s < 2 ? (s * NE + e) * CAPL : NB * NE * CAPL + ((s - 2) * NE + e) * CAPC; }
__device__ __forceinline__ float wave_sum(float v) { for (int o = 32; o > 0; o >>= 1) v += __shfl_xor(v, o); return v; }

__device__ __forceinline__ int ltid() { int t = threadIdx.x; asm volatile("" : "+v"(t)); return t; }
__device__ __forceinline__ int lbid() { int t = blockIdx.x; asm volatile("" : "+s"(t)); return t; }
#define XB_TMO      128
#define XB_XCNT(j)  (256  + 64 * (j))
#define XB_XSUB(j)  (1280 + 64 * (j))
#define XB_XGEN(j)  (2304 + 64 * (j))
#define XB_TOP      3328
#define XB_TOPGEN   3392
#define XCD_BAR_WORDS 3456
#define XB_SPIN_CAP (1u << 22)
#define LAS __attribute__((address_space(3)))
__device__ __forceinline__ unsigned xb_ld(unsigned* p)              { return __hip_atomic_load(p, __ATOMIC_RELAXED, __HIP_MEMORY_SCOPE_AGENT); }
__device__ __forceinline__ unsigned xb_add(unsigned* p, unsigned v) { return __hip_atomic_fetch_add(p, v, __ATOMIC_RELAXED, __HIP_MEMORY_SCOPE_AGENT); }
__device__ __forceinline__ unsigned xb_xcc_id() { return (unsigned)__builtin_amdgcn_s_getreg((3 << 11) | 20) & 0xFu; }
#define XB_SPIN(cond, bar) do { unsigned _sp = 0; while (cond) { __builtin_amdgcn_s_sleep(1); \
    if ((++_sp & 255u) == 0u) { if (xb_ld(&(bar)[XB_TMO])) break; if (_sp > XB_SPIN_CAP) { atomicAdd(&(bar)[XB_TMO], 1u); break; } } } } while (0)
struct XcdBarrier { unsigned* bar; unsigned x; volatile LAS unsigned* st; };
__device__ __forceinline__ XcdBarrier xcd_barrier_post(unsigned* bar, volatile LAS unsigned* st) {
  XcdBarrier b; b.bar = bar; b.x = xb_xcc_id(); b.st = st;
  if (threadIdx.x == 0) (void)xb_add(&bar[XB_XCNT(b.x)], 1u);
  return b;
}
__device__ __forceinline__ void xcd_barrier_complete(unsigned* bar, unsigned x, unsigned& nloc, unsigned& nx) {
  const unsigned G = gridDim.x * gridDim.y * gridDim.z;
  unsigned sum, cnt, mine, sp = 0u;
  for (;;) {
    sum = 0u; cnt = 0u; mine = 0u;
#pragma unroll
    for (unsigned j = 0; j < 16; ++j) { const unsigned c = xb_ld(&bar[XB_XCNT(j)]); sum += c; cnt += (c > 0u) ? 1u : 0u; mine = (j == x) ? c : mine; }
    if (sum == G) break;
    __builtin_amdgcn_s_sleep(1);
    if ((++sp & 255u) == 0u) { if (xb_ld(&bar[XB_TMO])) break; if (sp > XB_SPIN_CAP) { atomicAdd(&bar[XB_TMO], 1u); break; } }
  }
  nloc = mine > 0u ? mine : 1u; nx = cnt > 0u ? cnt : 1u;
}
__device__ __forceinline__ void xcd_barrier(const XcdBarrier& b) {
  asm volatile("s_waitcnt vmcnt(0)" ::: "memory");
  __syncthreads();
  if (threadIdx.x == 0) {
    unsigned* bar = b.bar;
    __builtin_amdgcn_s_waitcnt(0);
    unsigned nloc = b.st[0], nx = b.st[1];
    if (nloc == 0u) { xcd_barrier_complete(bar, b.x, nloc, nx); b.st[0] = nloc; b.st[1] = nx; }
    const unsigned old = xb_add(&bar[XB_XSUB(b.x)], 1u);
    const unsigned gen = old / nloc;
    if (old + 1u == (gen + 1u) * nloc) {
      __builtin_amdgcn_fence(__ATOMIC_RELEASE, "agent");
      asm volatile("s_waitcnt vmcnt(0)" ::: "memory");
      const unsigned og = xb_add(&bar[XB_TOP], 1u);
      const unsigned tg = og / nx;
      if (og + 1u == (tg + 1u) * nx) xb_add(&bar[XB_TOPGEN], 1u);
      else XB_SPIN(xb_ld(&bar[XB_TOPGEN]) == tg, bar);
      __builtin_amdgcn_fence(__ATOMIC_ACQUIRE, "agent");
      xb_add(&bar[XB_XGEN(b.x)], 1u);
      asm volatile("s_waitcnt vmcnt(0)" ::: "memory");
    } else {
      XB_SPIN(xb_ld(&bar[XB_XGEN(b.x)]) == gen, bar);
      __builtin_amdgcn_fence(__ATOMIC_ACQUIRE, "agent");
      asm volatile("s_waitcnt vmcnt(0)" ::: "memory");
    }
  }
  __syncthreads();
}


namespace pg8 {
#define PG8_LAS __attribute__((address_space(3)))
typedef short bf16x8 __attribute__((ext_vector_type(8)));
typedef float f32x4 __attribute__((ext_vector_type(4)));
typedef unsigned u32x4 __attribute__((ext_vector_type(4)));
constexpr int BM = 256, BK = 64, HALF = 128, HTB = HALF * BK * 2, STAGE_BYTES = 8 * HTB, NXCD = 8, WGM = 8;
__host__ __device__ __forceinline__ int lds_byte(int r, int c) { const int st = (r >> 4) * 2 + (c >> 5), rr = r & 15, cc = c & 31, ob = rr * 64 + cc * 2; return st * 1024 + (ob ^ (((ob >> 9) & 1) << 5)); }
__host__ __device__ __forceinline__ void stage_rc(int b, int& R, int& C) { const int st = b / 1024, sb = b % 1024, swz = sb ^ (((sb >> 9) & 1) << 5); R = (st >> 1) * 16 + swz / 64; C = (st & 1) * 32 + (swz % 64) / 2; }
__host__ __device__ __forceinline__ int perm32(int rho) { const int n = rho >> 4, i = rho & 15; return 8 * (i >> 2) + 4 * n + (i & 3); }
struct Unit { int pm, pn; };
__device__ __forceinline__ unsigned cvt_pk_bf16(float lo, float hi) { unsigned r; asm volatile("v_cvt_pk_bf16_f32 %0, %1, %2" : "=v"(r) : "v"(lo), "v"(hi)); return r; }
struct GridOrder {
  int nM, nN, nwg, G, c;
  __device__ __forceinline__ void init(int nM_, int nN_, int G_, int c_) { nM = nM_; nN = nN_; nwg = nM * nN; G = G_; c = c_; }
  __device__ __forceinline__ bool next(int i, Unit& u) const {
    const long L = (long)i * G + c; if (L >= nwg) return false;
    int wgid = (int)L; { const int q = nwg / NXCD, r = nwg % NXCD, xcd = wgid % NXCD, off = wgid / NXCD; wgid = (xcd < r ? xcd * (q + 1) : r * (q + 1) + (xcd - r) * q) + off; }
    const int nig = WGM * nN, gid = wgid / nig, fm = gid * WGM, gsz = (nM - fm) < WGM ? (nM - fm) : WGM;
    u.pm = fm + ((wgid % nig) % gsz); u.pn = (wgid % nig) / gsz; return true;
  }
};
template <class Epi, class Sched, bool GATHER = false>
__device__ __forceinline__ void gemm_phase(PG8_LAS unsigned char* lds, const Sched& S, const Epi& E) {
  const int tid = ltid(), wid = __builtin_amdgcn_readfirstlane(tid >> 6), lane = tid & 63, wr = wid >> 2, wc = wid & 3, fr = lane & 15, fq = lane >> 4;
  const int K = S.K, nt = K / BK;
  unsigned voffA[2], voffB[2]; int RA[2], CA[2];
#pragma unroll
  for (int i = 0; i < 2; ++i) { int R, C; stage_rc(tid * 16 + i * 8192, R, C); const int Rb = Epi::PERM ? ((R & ~31) + perm32(R & 31)) : R;
    voffA[i] = (unsigned)(R * S.lda + C) * 2u; voffB[i] = (unsigned)(Rb * S.ldb + C) * 2u; RA[i] = R; CA[i] = C; }
  const size_t kstep = (size_t)(BK * 2);
  const size_t hstepA = GATHER ? 0 : (size_t)HALF * S.lda * 2, hstepB = (size_t)HALF * S.ldb * 2;
  unsigned vc[2][2], vn[2][2];
#define PG8_GOFF(dst, unit) do { if (GATHER) { _Pragma("unroll") for (int _h = 0; _h < 2; ++_h) _Pragma("unroll") for (int _i = 0; _i < 2; ++_i) \
    dst[_h][_i] = (unsigned)(S.gidx[(unit).pm * 256 + _h * HALF + RA[_i]] * S.lda + CA[_i]) * 2u; } } while (0)
#define PG8_STAGE_A(bufoff, gbase, half, usenext) do { if (GATHER) { unsigned _v[2] = {(usenext) ? vn[half][0] : vc[half][0], (usenext) ? vn[half][1] : vc[half][1]}; PG8_STAGE(bufoff, gbase, _v); } \
    else PG8_STAGE(bufoff, gbase, voffA); } while (0)
  const unsigned ldsw = (unsigned)wid * 1024u;
  const int aoff = lds_byte(wr * 64 + fr, fq * 8), boff = lds_byte(wc * 32 + fr, fq * 8);
#define PG8_SA(b, h) (((b) * 2 + (h)) * HTB)
#define PG8_SB(b, h) ((4 + (b) * 2 + (h)) * HTB)
#define PG8_STAGE(bufoff, gbase, voff) do { _Pragma("unroll") for (int _i = 0; _i < 2; ++_i) \
    __builtin_amdgcn_global_load_lds((const unsigned*)((const char*)(gbase) + (voff)[_i]), (PG8_LAS unsigned*)(lds + (bufoff) + ldsw + _i * 8192), 16, 0, 0); } while (0)
#define PG8_LDA(dst, b, h) do { _Pragma("unroll") for (int m = 0; m < 4; ++m) _Pragma("unroll") for (int k = 0; k < 2; ++k) dst[m][k] = *(const PG8_LAS bf16x8*)(lds + PG8_SA(b, h) + aoff + m * 2048 + k * 1024); } while (0)
#define PG8_LDB(dst, b, h) do { _Pragma("unroll") for (int n = 0; n < 2; ++n) _Pragma("unroll") for (int k = 0; k < 2; ++k) dst[n][k] = *(const PG8_LAS bf16x8*)(lds + PG8_SB(b, h) + boff + n * 2048 + k * 1024); } while (0)
#define PG8_MMA(ai, bj, At, Bt) do { __builtin_amdgcn_s_setprio(1); _Pragma("unroll") for (int m = 0; m < 4; ++m) _Pragma("unroll") for (int n = 0; n < 2; ++n) _Pragma("unroll") for (int k = 0; k < 2; ++k) \
    acc[ai][bj][m][n] = __builtin_amdgcn_mfma_f32_16x16x32_bf16(Bt[n][k], At[m][k], acc[ai][bj][m][n], 0, 0, 0); __builtin_amdgcn_s_setprio(0); } while (0)
#define PG8_WAIT_V(n) asm volatile("s_waitcnt vmcnt(" #n ")" ::: "memory")
#define PG8_WAIT_L(n) asm volatile("s_waitcnt lgkmcnt(" #n ")" ::: "memory")
#define PG8_BAR __builtin_amdgcn_s_barrier()
#define PG8_SCHED __builtin_amdgcn_sched_barrier(0)
  Unit cur, nxt; int ui = 0;
  if (!S.next(0, cur)) return;
  f32x4 acc[2][2][4][2];
#pragma unroll
  for (int a = 0; a < 2; ++a)
#pragma unroll
    for (int b = 0; b < 2; ++b)
#pragma unroll
      for (int m = 0; m < 4; ++m)
#pragma unroll
        for (int n = 0; n < 2; ++n) acc[a][b][m][n] = (f32x4){0.f, 0.f, 0.f, 0.f};
  bf16x8 At[4][2], B0[2][2], B1[2][2];
  const char* cA = S.a_ptr(cur); const char* cB = S.b_ptr(cur);
  PG8_GOFF(vc, cur);
  PG8_STAGE(PG8_SB(0, 0), cB, voffB); PG8_STAGE_A(PG8_SA(0, 0), cA, 0, false); PG8_STAGE(PG8_SB(0, 1), cB + hstepB, voffB); PG8_STAGE_A(PG8_SA(0, 1), cA + hstepA, 1, false);
  if (wr == 1) PG8_BAR;
  PG8_WAIT_V(4); PG8_BAR;
  PG8_STAGE(PG8_SB(1, 0), cB + kstep, voffB); PG8_STAGE_A(PG8_SA(1, 0), cA + kstep, 0, false); PG8_STAGE(PG8_SB(1, 1), cB + hstepB + kstep, voffB);
  PG8_WAIT_V(6); PG8_BAR;
  for (;;) {
    const bool has_next = S.next(ui + 1, nxt);
    const char* nA = has_next ? S.a_ptr(nxt) : cA; const char* nB = has_next ? S.b_ptr(nxt) : cB;
    if (has_next) PG8_GOFF(vn, nxt); else { _Pragma("unroll") for (int _h = 0; _h < 2; ++_h) _Pragma("unroll") for (int _i = 0; _i < 2; ++_i) vn[_h][_i] = vc[_h][_i]; }
    for (int t = 0; t < nt; t += 2) {
      const bool last = (t == nt - 2);
      const char* a1 = cA + (size_t)(t + 1) * kstep;
      const char* a2 = last ? nA : cA + (size_t)(t + 2) * kstep; const char* b2 = last ? nB : cB + (size_t)(t + 2) * kstep;
      const char* a3 = a2 + kstep; const char* b3 = b2 + kstep;
      PG8_LDB(B0, 0, 0); PG8_SCHED; PG8_LDA(At, 0, 0); PG8_STAGE_A(PG8_SA(1, 1), a1 + hstepA, 1, false);
      PG8_WAIT_L(8); PG8_BAR; PG8_WAIT_L(0); PG8_MMA(0, 0, At, B0); PG8_BAR; PG8_SCHED;
      PG8_LDB(B1, 0, 1); PG8_STAGE(PG8_SB(0, 0), b2, voffB);
      PG8_BAR; PG8_WAIT_L(0); PG8_MMA(0, 1, At, B1); PG8_BAR;
      PG8_LDA(At, 0, 1); PG8_STAGE_A(PG8_SA(0, 0), a2, 0, last);
      PG8_BAR; PG8_WAIT_L(0); PG8_MMA(1, 0, At, B0); PG8_BAR; PG8_SCHED;
      PG8_STAGE(PG8_SB(0, 1), b2 + hstepB, voffB);
      PG8_WAIT_V(6); PG8_BAR; PG8_MMA(1, 1, At, B1); PG8_BAR;
      PG8_LDB(B0, 1, 0); PG8_SCHED; PG8_LDA(At, 1, 0); PG8_STAGE_A(PG8_SA(0, 1), a2 + hstepA, 1, last);
      PG8_WAIT_L(8); PG8_BAR; PG8_WAIT_L(0); PG8_MMA(0, 0, At, B0); PG8_BAR; PG8_SCHED;
      PG8_LDB(B1, 1, 1); PG8_STAGE(PG8_SB(1, 0), b3, voffB);
      PG8_BAR; PG8_WAIT_L(0); PG8_MMA(0, 1, At, B1); PG8_BAR;
      PG8_LDA(At, 1, 1); PG8_STAGE_A(PG8_SA(1, 0), a3, 0, last);
      PG8_BAR; PG8_WAIT_L(0); PG8_MMA(1, 0, At, B0); PG8_BAR; PG8_SCHED;
      PG8_STAGE(PG8_SB(1, 1), b3 + hstepB, voffB);
      PG8_WAIT_V(6); PG8_BAR; PG8_MMA(1, 1, At, B1); PG8_BAR;
    }
    E(acc, cur, wr, wc, fr, fq);
    if (!has_next) break;
#pragma unroll
    for (int a = 0; a < 2; ++a)
#pragma unroll
      for (int b = 0; b < 2; ++b)
#pragma unroll
        for (int m = 0; m < 4; ++m)
#pragma unroll
          for (int n = 0; n < 2; ++n) acc[a][b][m][n] = (f32x4){0.f, 0.f, 0.f, 0.f};
    cur = nxt; cA = nA; cB = nB; ++ui;
    _Pragma("unroll") for (int _h = 0; _h < 2; ++_h) _Pragma("unroll") for (int _i = 0; _i < 2; ++_i) vc[_h][_i] = vn[_h][_i];
  }
  PG8_WAIT_V(0);
  if (wr == 0) PG8_BAR;
  PG8_BAR;
#undef PG8_SA
#undef PG8_SB
#undef PG8_STAGE
#undef PG8_STAGE_A
#undef PG8_GOFF
#undef PG8_LDA
#undef PG8_LDB
#undef PG8_MMA
#undef PG8_WAIT_V
#undef PG8_WAIT_L
#undef PG8_BAR
#undef PG8_SCHED
}
}

struct DenseSched : pg8::GridOrder {
  const char* A; const char* Bt; int lda, ldb, K; const int* gidx;
  __device__ __forceinline__ const char* a_ptr(const pg8::Unit& u) const { return A + (size_t)u.pm * 256 * lda * 2; }
  __device__ __forceinline__ const char* b_ptr(const pg8::Unit& u) const { return Bt + (size_t)u.pn * 256 * ldb * 2; }
};
struct EpiStoreBf16 {
  static constexpr bool PERM = true, AFTER_DRAIN = false;
  bf16_t* O; int ldc;
  __device__ __forceinline__ void operator()(const pg8::f32x4 (&acc)[2][2][4][2], const pg8::Unit& u, int wr, int wc, int fr, int fq) const {
    const int row0 = u.pm * 256 + wr * 64 + fr, col0 = u.pn * 256 + wc * 32 + 8 * fq;
#pragma unroll
    for (int ai = 0; ai < 2; ++ai)
#pragma unroll
      for (int m = 0; m < 4; ++m) { bf16_t* rowp = O + (size_t)(row0 + ai * 128 + m * 16) * ldc + col0;
#pragma unroll
        for (int bj = 0; bj < 2; ++bj) { const pg8::f32x4 v0 = acc[ai][bj][m][0], v1 = acc[ai][bj][m][1];
          pg8::u32x4 w; w.x = pg8::cvt_pk_bf16(v0[0], v0[1]); w.y = pg8::cvt_pk_bf16(v0[2], v0[3]); w.z = pg8::cvt_pk_bf16(v1[0], v1[1]); w.w = pg8::cvt_pk_bf16(v1[2], v1[3]);
          *(pg8::u32x4*)(rowp + bj * 128) = w; } }
  }
};
struct EpiResidual {
  static constexpr bool PERM = false, AFTER_DRAIN = false;
  float* xl; float* xc; const float* mod;
  int chunk;
  __device__ __forceinline__ void operator()(const pg8::f32x4 (&acc)[2][2][4][2], const pg8::Unit& u, int wr, int wc, int fr, int fq) const {
    const int mj = u.pm < 32 ? 0 : (u.pm < 64 ? 1 : 2);
    float* base = u.pm < 64 ? xl + (size_t)u.pm * 256 * D : xc + (size_t)(u.pm - 64) * 256 * D;
    const float* gv = mod + ((size_t)mj * 6 + chunk) * D;
    const int row0 = wr * 64 + fr, col0 = u.pn * 256 + wc * 32 + 4 * fq;
#pragma unroll
    for (int bj = 0; bj < 2; ++bj)
#pragma unroll
      for (int n = 0; n < 2; ++n) {
        const pg8::f32x4 g = *(const pg8::f32x4*)(gv + col0 + bj * 128 + n * 16);
#pragma unroll
        for (int ai = 0; ai < 2; ++ai)
#pragma unroll
          for (int m = 0; m < 4; ++m) { pg8::f32x4* q = (pg8::f32x4*)(base + (size_t)(row0 + ai * 128 + m * 16) * D + col0 + bj * 128 + n * 16); *q = *q + g * acc[ai][bj][m][n]; }
      }
  }
};
struct MoeSched : pg8::GridOrder {
  const char* A; const char* Bt; int lda, ldb, K; size_t bstride;
  const int* gidx; bool gather;
  __device__ __forceinline__ const char* a_ptr(const pg8::Unit& u) const { return gather ? A : A + (size_t)u.pm * 256 * lda * 2; }
  __device__ __forceinline__ const char* b_ptr(const pg8::Unit& u) const { return Bt + (size_t)((u.pm >> 2) & 15) * bstride + (size_t)u.pn * 256 * ldb * 2; }
};
struct EpiSwiGLU {
  static constexpr bool PERM = true, AFTER_DRAIN = false;
  bf16_t* O;
  __device__ __forceinline__ void operator()(const pg8::f32x4 (&acc)[2][2][4][2], const pg8::Unit& u, int wr, int wc, int fr, int fq) const {
    const int row0 = u.pm * 256 + wr * 64 + fr, col0 = u.pn * 128 + wc * 16 + 4 * fq;
#pragma unroll
    for (int ai = 0; ai < 2; ++ai)
#pragma unroll
      for (int m = 0; m < 4; ++m) { bf16_t* rowp = O + (size_t)(row0 + ai * 128 + m * 16) * DEXP + col0;
#pragma unroll
        for (int bj = 0; bj < 2; ++bj) { const pg8::f32x4 v0 = acc[ai][bj][m][0], v1 = acc[ai][bj][m][1];
          const float h0 = silu_f(v0[0]) * v0[1], h1 = silu_f(v0[2]) * v0[3], h2 = silu_f(v1[0]) * v1[1], h3 = silu_f(v1[2]) * v1[3];
          uint2 w; w.x = pg8::cvt_pk_bf16(h0, h1); w.y = pg8::cvt_pk_bf16(h2, h3);
          *(uint2*)(rowp + bj * 64) = w; } }
  }
};
struct EpiGateBf16 {
  static constexpr bool PERM = true, AFTER_DRAIN = false;
  bf16_t* O; const float* gate;
  __device__ __forceinline__ void operator()(const pg8::f32x4 (&acc)[2][2][4][2], const pg8::Unit& u, int wr, int wc, int fr, int fq) const {
    const int row0 = u.pm * 256 + wr * 64 + fr, col0 = u.pn * 256 + wc * 32 + 8 * fq;
#pragma unroll
    for (int ai = 0; ai < 2; ++ai)
#pragma unroll
      for (int m = 0; m < 4; ++m) { const int row = row0 + ai * 128 + m * 16; const float g = gate[row]; bf16_t* rowp = O + (size_t)row * D + col0;
#pragma unroll
        for (int bj = 0; bj < 2; ++bj) { const pg8::f32x4 v0 = acc[ai][bj][m][0] * g, v1 = acc[ai][bj][m][1] * g;
          pg8::u32x4 w; w.x = pg8::cvt_pk_bf16(v0[0], v0[1]); w.y = pg8::cvt_pk_bf16(v0[2], v0[3]); w.z = pg8::cvt_pk_bf16(v1[0], v1[1]); w.w = pg8::cvt_pk_bf16(v1[2], v1[3]);
          *(pg8::u32x4*)(rowp + bj * 128) = w; } }
  }
};

namespace fa {
using bf16x8 = __attribute__((ext_vector_type(8))) short;
using s16x4  = __attribute__((ext_vector_type(4))) short;
using f32x16 = __attribute__((ext_vector_type(16))) float;
using u32x4  = __attribute__((ext_vector_type(4))) unsigned;
constexpr int NW = 8, QBLK = 32, KVBLK = 64, LDQK = 128, LDV = 64;
constexpr float SCALE = 0.10206207261596575f;
constexpr float THR = 8.f;
constexpr size_t SHM_V = KVBLK * 64 * 2, SHM_K = KVBLK * 128 * 2, SHM_ATTN = 2 * SHM_V + 2 * SHM_K + NW * 64 * 4;
#define FA_KSWZ(row, colB) ((row) * 256 + ((colB) ^ (((row) & 7) << 4)))
#define FA_SBAR() __builtin_amdgcn_sched_barrier(0)
__device__ __forceinline__ int crow(int r, int hi) { return (r & 3) + 8 * (r >> 2) + 4 * hi; }
__device__ __forceinline__ unsigned cvtpk(float lo, float hi) { unsigned r; asm volatile("v_cvt_pk_bf16_f32 %0, %1, %2" : "=v"(r) : "v"(lo), "v"(hi)); return r; }
__device__ __forceinline__ void partialSM(f32x16& p0, f32x16& p1, float& m_reg, float& mn, float& alpha) {
  constexpr float C = SCALE * 1.4426950408889634f;
  float pmax = p0[0];
#pragma unroll
  for (int r = 1; r < 16; ++r) pmax = fmaxf(pmax, p0[r]);
#pragma unroll
  for (int r = 0; r < 16; ++r) pmax = fmaxf(pmax, p1[r]);
  { auto rr = __builtin_amdgcn_permlane32_swap(__float_as_uint(pmax), __float_as_uint(pmax), false, false);
    pmax = fmaxf(__uint_as_float(rr[0]), __uint_as_float(rr[1])); }
  if (__builtin_expect(__all(pmax - m_reg <= THR / SCALE), 1)) { mn = m_reg; alpha = 1.f; }
  else { mn = fmaxf(m_reg, pmax); alpha = __builtin_amdgcn_exp2f((m_reg - mn) * C); m_reg = mn; }
  float mnC = -mn * C;
  p0 = p0 * C + mnC; p1 = p1 * C + mnC;
#pragma unroll
  for (int r = 0; r < 16; ++r) p0[r] = __builtin_amdgcn_exp2f(p0[r]);
}
__device__ __forceinline__ void finishSM(f32x16& p0, f32x16& p1, float alpha, float& l_reg, bf16x8& pa0, bf16x8& pa1, bf16x8& pa2, bf16x8& pa3) {
#pragma unroll
  for (int r = 0; r < 16; ++r) p1[r] = __builtin_amdgcn_exp2f(p1[r]);
  float ps;
  { const f32x16 t = p0 + p1; const auto t8 = t.lo + t.hi; const auto t4 = t8.lo + t8.hi; const auto t2 = t4.lo + t4.hi; ps = t2.x + t2.y; }
  { auto rr = __builtin_amdgcn_permlane32_swap(__float_as_uint(ps), __float_as_uint(ps), false, false);
    ps = __uint_as_float(rr[0]) + __uint_as_float(rr[1]); }
  l_reg = l_reg * alpha + ps;
#define FA_PK4(P, BASE, OUT) do { unsigned a0 = cvtpk(P[BASE + 0], P[BASE + 1]), a1 = cvtpk(P[BASE + 2], P[BASE + 3]);   \
    unsigned b0 = cvtpk(P[BASE + 4], P[BASE + 5]), b1 = cvtpk(P[BASE + 6], P[BASE + 7]);                              \
    auto r0 = __builtin_amdgcn_permlane32_swap(a0, b0, false, false); auto r1 = __builtin_amdgcn_permlane32_swap(a1, b1, false, false); \
    u32x4 w = {r0[0], r1[0], r0[1], r1[1]}; OUT = *reinterpret_cast<bf16x8*>(&w); } while (0)
  FA_PK4(p0, 0, pa0); FA_PK4(p0, 8, pa1); FA_PK4(p1, 0, pa2); FA_PK4(p1, 8, pa3);
#undef FA_PK4
}
__device__ __forceinline__ void qkt(f32x16& p0, f32x16& p1, const char* Ks, const bf16x8* qr, int r32, int hi) {
  p0 = f32x16{}; p1 = f32x16{};
#pragma unroll
  for (int d0 = 0; d0 < 6; ++d0) { int cb = (d0 * 16 + hi * 8) * 2;
    bf16x8 b0 = *reinterpret_cast<const bf16x8*>(Ks + FA_KSWZ(r32, cb));
    bf16x8 b1 = *reinterpret_cast<const bf16x8*>(Ks + FA_KSWZ(32 + r32, cb));
    p0 = __builtin_amdgcn_mfma_f32_32x32x16_bf16(b0, qr[d0], p0, 0, 0, 0);
    p1 = __builtin_amdgcn_mfma_f32_32x32x16_bf16(b1, qr[d0], p1, 0, 0, 0); }
}
__device__ __forceinline__ int v_st(int k, int c) { const int kk = (k & ~0xC) | ((k & 4) << 1) | ((k & 8) >> 1); return ((kk >> 3) * 2 + (c >> 5)) * 512 + ((kk & 7) * 32 + (c & 31)) * 2; }
__device__ __forceinline__ int v_rd_base(int lane) { return ((lane & 3) << 3) | (((lane >> 2) & 3) << 6) | (((lane >> 4) & 1) << 5) | (((lane >> 5) & 1) << 8); }
constexpr int v_rd_off(int d0, int ks, int half) { return d0 * 512 + ks * 2048 + half * 1024; }
template <int OFF> __device__ __forceinline__ s16x4 tr_read(int vb) {
  s16x4 r; asm volatile("ds_read_b64_tr_b16 %0, %1 offset:%2" : "=&v"(r) : "v"(vb), "i"(OFF) : "memory"); return r;
}
template <int D0> __device__ __forceinline__ void pv_one(f32x16& od, int vb, bf16x8 pa0, bf16x8 pa1, bf16x8 pa2, bf16x8 pa3) {
  const s16x4 l0 = tr_read<v_rd_off(D0, 0, 0)>(vb), h0 = tr_read<v_rd_off(D0, 0, 1)>(vb), l1 = tr_read<v_rd_off(D0, 1, 0)>(vb), h1 = tr_read<v_rd_off(D0, 1, 1)>(vb);
  const s16x4 l2 = tr_read<v_rd_off(D0, 2, 0)>(vb), h2 = tr_read<v_rd_off(D0, 2, 1)>(vb), l3 = tr_read<v_rd_off(D0, 3, 0)>(vb), h3 = tr_read<v_rd_off(D0, 3, 1)>(vb);
  asm volatile("s_waitcnt lgkmcnt(0)" ::: "memory"); FA_SBAR();
#define FA_PK(L, H) (bf16x8){L[0], L[1], L[2], L[3], H[0], H[1], H[2], H[3]}
  od = __builtin_amdgcn_mfma_f32_32x32x16_bf16(pa0, FA_PK(l0, h0), od, 0, 0, 0);
  od = __builtin_amdgcn_mfma_f32_32x32x16_bf16(pa1, FA_PK(l1, h1), od, 0, 0, 0);
  od = __builtin_amdgcn_mfma_f32_32x32x16_bf16(pa2, FA_PK(l2, h2), od, 0, 0, 0);
  od = __builtin_amdgcn_mfma_f32_32x32x16_bf16(pa3, FA_PK(l3, h3), od, 0, 0, 0);
#undef FA_PK
}
__device__ __forceinline__ void attn_body(const bf16_t* __restrict__ Qb, const bf16_t* __restrict__ Kh, const bf16_t* __restrict__ Vh, bf16_t* __restrict__ Ob, int ldo, int seq, char* lds, float* mlp = nullptr, int mlstride = 0) {
  const int tid = ltid(), wid = tid >> 6, lane = tid & 63, r32 = lane & 31, hi = lane >> 5;
  char* V_lds = lds; char* K_lds = lds + 2 * SHM_V;
  float* ws = (float*)(lds + 2 * SHM_V + 2 * SHM_K) + wid * 64; float* li_l = ws; float* al_l = ws + 32;
  float m_reg = -1e30f, l_reg = 0; f32x16 o[2] = {}; bf16x8 qr[6];
  const bf16_t* Qw = Qb + (long)(wid * QBLK + r32) * LDQK + hi * 8;
#pragma unroll
  for (int d0 = 0; d0 < 6; ++d0) qr[d0] = *reinterpret_cast<const bf16x8*>(Qw + d0 * 16);
  const int sr = tid >> 4, sc = (tid & 15) * 8;
  const int vr = tid >> 3, vc = (tid & 7) * 8, vst0 = v_st(vr, vc);
  const int vb0 = (int)(uintptr_t)V_lds + v_rd_base(lane);
  struct { bf16x8 vs0, ks0, ks1; } sr_[2];
#define FA_SLOAD(i, k0) do { sr_[i].vs0 = *reinterpret_cast<const bf16x8*>(&Vh[(long)((k0) + vr) * LDV + vc]); \
    sr_[i].ks0 = *reinterpret_cast<const bf16x8*>(&Kh[(long)((k0) + sr) * LDQK + sc]); sr_[i].ks1 = *reinterpret_cast<const bf16x8*>(&Kh[(long)((k0) + 32 + sr) * LDQK + sc]); } while (0)
#define FA_SWRITE(b, i) do { *(bf16x8*)(V_lds + (b) * SHM_V + vst0) = sr_[i].vs0; int kc = sc * 2;               \
    *(bf16x8*)(K_lds + (b) * SHM_K + FA_KSWZ(sr, kc)) = sr_[i].ks0;                       \
    *(bf16x8*)(K_lds + (b) * SHM_K + FA_KSWZ(32 + sr, kc)) = sr_[i].ks1; } while (0)
#define FA_SWAIT() asm volatile("s_waitcnt vmcnt(3)" ::: "memory")
#define FA_RESC(a) do { if (__any((a) < 1.f)) { if (hi == 0) al_l[r32] = (a); asm volatile("s_waitcnt lgkmcnt(0)" ::: "memory"); \
    _Pragma("unroll") for (int d = 0; d < 2; ++d) _Pragma("unroll") for (int r = 0; r < 16; ++r) o[d][r] *= al_l[crow(r, hi)]; } } while (0)
  f32x16 pA0, pA1, pB0, pB1; float mnA, mnB, alA, alB; bf16x8 pa0, pa1, pa2, pa3; const int NTL = seq / KVBLK;
  constexpr int SE = 0, SO = 1;
  __syncthreads();
  FA_SLOAD(SE, 0); asm volatile("s_waitcnt vmcnt(0)" ::: "memory"); FA_SWRITE(0, SE); __syncthreads();
  qkt(pA0, pA1, K_lds, qr, r32, hi); partialSM(pA0, pA1, m_reg, mnA, alA);
  FA_SLOAD(SO, KVBLK); if (2 < NTL) FA_SLOAD(SE, 2 * KVBLK);
  FA_SWAIT(); FA_SWRITE(1, SO); __syncthreads();
  for (int j = 1; j + 1 < NTL; j += 2) {
    FA_SBAR(); qkt(pB0, pB1, K_lds + SHM_K, qr, r32, hi);
    finishSM(pA0, pA1, alA, l_reg, pa0, pa1, pa2, pa3); FA_SBAR();
    FA_SLOAD(SO, (j + 2) * KVBLK); FA_SBAR();
    pv_one<0>(o[0], vb0, pa0, pa1, pa2, pa3); pv_one<1>(o[1], vb0, pa0, pa1, pa2, pa3); partialSM(pB0, pB1, m_reg, mnB, alB);
    __syncthreads(); FA_SWAIT(); FA_SWRITE(0, SE);
    FA_RESC(alB); __syncthreads();
    FA_SBAR(); qkt(pA0, pA1, K_lds, qr, r32, hi);
    finishSM(pB0, pB1, alB, l_reg, pa0, pa1, pa2, pa3); FA_SBAR();
    if (j + 3 < NTL) FA_SLOAD(SE, (j + 3) * KVBLK); FA_SBAR();
    pv_one<0>(o[0], vb0 + (int)SHM_V, pa0, pa1, pa2, pa3); pv_one<1>(o[1], vb0 + (int)SHM_V, pa0, pa1, pa2, pa3); partialSM(pA0, pA1, m_reg, mnA, alA);
    __syncthreads(); FA_SWAIT(); FA_SWRITE(1, SO);
    FA_RESC(alA); __syncthreads();
  }
  FA_SBAR(); qkt(pB0, pB1, K_lds + SHM_K, qr, r32, hi);
  finishSM(pA0, pA1, alA, l_reg, pa0, pa1, pa2, pa3); FA_SBAR();
  pv_one<0>(o[0], vb0, pa0, pa1, pa2, pa3); pv_one<1>(o[1], vb0, pa0, pa1, pa2, pa3); partialSM(pB0, pB1, m_reg, mnB, alB);
  __syncthreads(); FA_RESC(alB);
  finishSM(pB0, pB1, alB, l_reg, pa0, pa1, pa2, pa3); FA_SBAR();
  pv_one<0>(o[0], vb0 + (int)SHM_V, pa0, pa1, pa2, pa3); pv_one<1>(o[1], vb0 + (int)SHM_V, pa0, pa1, pa2, pa3);
  if (hi == 0) { li_l[r32] = l_reg; if (mlp) { float* q2 = mlp + (size_t)(wid * QBLK + r32) * mlstride; q2[0] = m_reg; q2[1] = l_reg; } }
  asm volatile("s_waitcnt lgkmcnt(0)" ::: "memory");
  float rli[16];
#pragma unroll
  for (int r = 0; r < 16; ++r) rli[r] = __builtin_amdgcn_rcpf(li_l[crow(r, hi)]);
  bf16_t* Ow = Ob + (long)(wid * QBLK) * ldo;
#pragma unroll
  for (int r = 0; r < 16; ++r) { int orow = crow(r, hi);
#pragma unroll
    for (int d0 = 0; d0 < 2; ++d0) Ow[(long)orow * ldo + d0 * 32 + r32] = f2bf(o[d0][r] * rli[r]); }
#undef FA_SLOAD
#undef FA_SWRITE
#undef FA_SWAIT
#undef FA_RESC
}
}

namespace gd {
using bf16x8 = __attribute__((ext_vector_type(8))) short;
using f32x4 = __attribute__((ext_vector_type(4))) float;
constexpr int NCH = 132;
constexpr size_t R_QF = 0, R_KF = 16384, R_KTF = 32768, R_VC = 49152, R_DIR = 65536, DIR_BYTES = 17408, D_TINV = 0, D_QKM = 8192, D_VEC = 16384;
constexpr size_t CHREC = R_DIR + 2 * DIR_BYTES;
__device__ __forceinline__ unsigned pk(float lo, float hi) { unsigned r; asm volatile("v_cvt_pk_bf16_f32 %0, %1, %2" : "=v"(r) : "v"(lo), "v"(hi)); return r; }
__device__ __forceinline__ bf16x8 pack8(const f32x4 a, const f32x4 b) { typedef unsigned u4 __attribute__((ext_vector_type(4))); u4 w = {pk(a[0], a[1]), pk(a[2], a[3]), pk(b[0], b[1]), pk(b[2], b[3])}; return *reinterpret_cast<bf16x8*>(&w); }
__device__ __forceinline__ int chunk_row0(int b, int c) { return c < 4 ? ML + b * TC + 64 * c : b * T + 64 * (c - 4); }
constexpr int L_Q = 0, L_K = 16384, L_V = 32768, L_KK = 49152  , L_QK = 65792, L_G = 82432  ,
              L_A = 0  , L_X0 = 32768  , L_X1 = 83968, L_AT = 100352;
__device__ __forceinline__ int swz(int row, int colB) { return row * 256 + (colB ^ ((row & 7) << 4)); }
__device__ __forceinline__ void tr_pair(int a0, int a1, uint2& lo, uint2& hi) {
  asm volatile("ds_read_b64_tr_b16 %0, %2\n\tds_read_b64_tr_b16 %1, %3\n\ts_waitcnt lgkmcnt(0)" : "=&v"(lo), "=&v"(hi) : "v"(a0), "v"(a1) : "memory");
}
__device__ __forceinline__ uint2 tr_one(int a0) {
  uint2 r; asm volatile("ds_read_b64_tr_b16 %0, %1\n\ts_waitcnt lgkmcnt(0)" : "=&v"(r) : "v"(a0) : "memory"); return r;
}

__device__ __forceinline__ void inv_offdiag(const float* A, float* X, int bi, int bj, int lane) {
  const int rc = lane & 15, g = lane >> 4;
  f32x4 t = {0.f, 0.f, 0.f, 0.f};
  for (int k = bj; k < bi; ++k) {
#pragma unroll
    for (int s4 = 0; s4 < 4; ++s4)
      t = __builtin_amdgcn_mfma_f32_16x16x4f32(A[(bi * 16 + rc) * 64 + k * 16 + s4 * 4 + g], X[(k * 16 + s4 * 4 + g) * 64 + bj * 16 + rc], t, 0, 0, 0);
  }
  f32x4 o = {0.f, 0.f, 0.f, 0.f};
#pragma unroll
  for (int r = 0; r < 4; ++r)
    o = __builtin_amdgcn_mfma_f32_16x16x4f32(X[(bi * 16 + rc) * 64 + bi * 16 + g * 4 + r], t[r], o, 0, 0, 0);
#pragma unroll
  for (int r = 0; r < 4; ++r) X[(bi * 16 + g * 4 + r) * 64 + bj * 16 + rc] = -o[r];
}
__device__ __forceinline__ void lds_barrier() { asm volatile("s_waitcnt lgkmcnt(0)" ::: "memory"); __builtin_amdgcn_s_barrier(); asm volatile("" ::: "memory"); }
constexpr int L_CW = 133120;
__device__ __forceinline__ void precompute_load(const Params& p, int b, int h, int c, int tid, uint4 (&xin)[3][4]) {
  const bf16_t* P = (const bf16_t*)(p.ws + OFF_P);
  const int row0 = chunk_row0(b, c), tlen = c < 4 ? TC : T, t0 = c < 4 ? 64 * c : 64 * (c - 4);
  const int ch8 = tid & 15, tokA = 2 * (tid >> 4);
#pragma unroll
  for (int which = 0; which < 3; ++which) {
    const int ch0 = which * 512 + h * 128 + ch8 * 8;
#pragma unroll
    for (int jj = 0; jj < 4; ++jj) { const int tt = t0 + tokA - 1 + jj;
      xin[which][jj] = (tt >= 0 && tt < tlen) ? *(const uint4*)(P + (size_t)(row0 + tokA - 1 + jj) * NINP + PC_GQ + ch0) : make_uint4(0u, 0u, 0u, 0u); }
  }
}
__device__ __forceinline__ void precompute_item(const Params& p, int l, int b, int h, int c, char* lds, int tid, const uint4 (&xin)[3][4]) {
  const int lane = tid & 63, wv = tid >> 6;
  const bf16_t* P = (const bf16_t*)(p.ws + OFF_P);
  char* rec = p.ws + OFF_RB + (size_t)((b * 4 + h) * NCH + c) * CHREC;
  const int row0 = chunk_row0(b, c);
  const int ldsb = (int)(uintptr_t)lds;
  lds_barrier();
  {
    const int ch8 = tid & 15, tg = tid >> 4, tokA = 2 * tg;
    const float* cwl = (const float*)(lds + L_CW);
#pragma unroll
    for (int which = 0; which < 3; ++which) {
      float xf[4][8];
#pragma unroll
      for (int jj = 0; jj < 4; ++jj) { const unsigned w4[4] = {xin[which][jj].x, xin[which][jj].y, xin[which][jj].z, xin[which][jj].w};
#pragma unroll
        for (int i = 0; i < 4; ++i) { xf[jj][2 * i] = __uint_as_float(w4[i] << 16); xf[jj][2 * i + 1] = __uint_as_float(w4[i] & 0xffff0000u); } }
      float wf[3][8];
#pragma unroll
      for (int j = 0; j < 3; ++j) { const float4 w0 = *(const float4*)(cwl + j * 1536 + which * 512 + h * 128 + ch8 * 8), w1 = *(const float4*)(cwl + j * 1536 + which * 512 + h * 128 + ch8 * 8 + 4);
        wf[j][0] = w0.x; wf[j][1] = w0.y; wf[j][2] = w0.z; wf[j][3] = w0.w; wf[j][4] = w1.x; wf[j][5] = w1.y; wf[j][6] = w1.z; wf[j][7] = w1.w; }
#pragma unroll
      for (int a = 0; a < 2; ++a) {
        float o[8], ss = 0.f;
#pragma unroll
        for (int i = 0; i < 8; ++i) { o[i] = silu_f(wf[0][i] * xf[a][i] + wf[1][i] * xf[a + 1][i] + wf[2][i] * xf[a + 2][i]); ss += o[i] * o[i]; }
        if (which < 2) {
          ss += __shfl_xor(ss, 1); ss += __shfl_xor(ss, 2); ss += __shfl_xor(ss, 4); ss += __shfl_xor(ss, 8);
          const float sc = rsqrtf(ss + EPS) * (which == 0 ? 0.08838834764831845f : 1.f);
#pragma unroll
          for (int i = 0; i < 8; ++i) o[i] *= sc;
        }
        uint4 w; w.x = pk(o[0], o[1]); w.y = pk(o[2], o[3]); w.z = pk(o[4], o[5]); w.w = pk(o[6], o[7]);
        *(uint4*)(lds + (which == 0 ? L_Q : (which == 1 ? L_K : L_V)) + swz(tokA + a, ch8 * 16)) = w;
      }
    }
    if (tid < 128) {
      const int d = tid >> 6, tk = tid & 63;
      const float pa = bf2f(P[(size_t)(row0 + tk) * NINP + PC_A + d * 4 + h]), pb = bf2f(P[(size_t)(row0 + tk) * NINP + PC_B + d * 4 + h]);
      float* gs = (float*)(lds + L_G);
      gs[d * 64 + tk] = -expf(p.a_log[l * 8 + d * 4 + h]) * softplus_f(pa + p.dt_bias[l * 8 + d * 4 + h]);
      gs[128 + d * 64 + tk] = sigmoid_f(pb);
    }
  }
  lds_barrier();
  if (wv == 0) {
    float* gs = (float*)(lds + L_G);
    float a0 = gs[lane], a1 = gs[64 + 63 - lane];
#pragma unroll
    for (int o = 1; o < 64; o <<= 1) { const float n0 = __shfl_up(a0, o), n1 = __shfl_up(a1, o); if (lane >= o) { a0 += n0; a1 += n1; } }
    gs[256 + lane] = a0; gs[256 + 64 + 63 - lane] = a1;
  }
  {
    const int cc = lane & 15, g = lane >> 4;
#pragma unroll
    for (int tt = 0; tt < 2; ++tt) {
      const int tile = wv * 2 + tt, mi = tile >> 2, nj = tile & 3;
      f32x4 akk = {0.f, 0.f, 0.f, 0.f}, aqk = {0.f, 0.f, 0.f, 0.f};
#pragma unroll
      for (int s4 = 0; s4 < 4; ++s4) {
        const bf16x8 ak = *(const bf16x8*)(lds + L_K + swz(mi * 16 + cc, s4 * 64 + g * 16));
        const bf16x8 aq = *(const bf16x8*)(lds + L_Q + swz(mi * 16 + cc, s4 * 64 + g * 16));
        const bf16x8 bk = *(const bf16x8*)(lds + L_K + swz(nj * 16 + cc, s4 * 64 + g * 16));
        akk = __builtin_amdgcn_mfma_f32_16x16x32_bf16(ak, bk, akk, 0, 0, 0);
        aqk = __builtin_amdgcn_mfma_f32_16x16x32_bf16(aq, bk, aqk, 0, 0, 0);
      }
      float* KK = (float*)(lds + L_KK); float* QK = (float*)(lds + L_QK);
#pragma unroll
      for (int r = 0; r < 4; ++r) { KK[(mi * 16 + g * 4 + r) * 65 + nj * 16 + cc] = akk[r]; QK[(mi * 16 + g * 4 + r) * 65 + nj * 16 + cc] = aqk[r]; }
    }
#pragma unroll
    for (int it = 0; it < 2; ++it) {
      const int item = tid + it * NT, fl = item & 63, frag = item >> 6, mt = frag >> 3, kbj = frag & 7, r = fl & 31, hl = fl >> 5;
      const int row = mt * 32 + r, cb = (kbj * 16 + hl * 4) * 2;
      uint4 wq, wk;
      { const uint2 lo = *(const uint2*)(lds + L_Q + swz(row, cb)), hi = *(const uint2*)(lds + L_Q + swz(row, cb + 16)); wq = make_uint4(lo.x, lo.y, hi.x, hi.y); }
      { const uint2 lo = *(const uint2*)(lds + L_K + swz(row, cb)), hi = *(const uint2*)(lds + L_K + swz(row, cb + 16)); wk = make_uint4(lo.x, lo.y, hi.x, hi.y); }
      *(uint4*)(rec + R_QF + (size_t)item * 16) = wq; *(uint4*)(rec + R_KF + (size_t)item * 16) = wk;
    }
#pragma unroll
    for (int it = 0; it < 2; ++it) {
      const int item = tid + it * NT, fl = item & 63, frag = item >> 6, mt = frag >> 2, kbj = frag & 3, i16 = fl & 15, gq = fl >> 4;
      const int tok0 = kbj * 16 + (gq >> 1) * 4 + (i16 >> 2), cb = (mt * 32 + (gq & 1) * 16 + (i16 & 3) * 4) * 2;
      uint2 lo, hi; tr_pair(ldsb + L_K + swz(tok0, cb), ldsb + L_K + swz(tok0 + 8, cb), lo, hi);
      *(uint4*)(rec + R_KTF + (size_t)item * 16) = make_uint4(lo.x, lo.y, hi.x, hi.y);
    }
#pragma unroll
    for (int it = 0; it < 4; ++it) {
      const int item = tid + it * NT, fl = item & 63, q = (item >> 6) & 3, mt = (item >> 8) & 1, sl = item >> 9, i16 = fl & 15, gq = fl >> 4;
      const int tok0 = mt * 32 + q * 8 + (gq >> 1) * 4 + (i16 >> 2), cb = (sl * 32 + (gq & 1) * 16 + (i16 & 3) * 4) * 2;
      const uint2 v = tr_one(ldsb + L_V + swz(tok0, cb));
      *(uint2*)(rec + R_VC + (size_t)item * 8) = v;
    }
  }
  lds_barrier();
  {
    const float* gs = (const float*)(lds + L_G); const float* KK = (const float*)(lds + L_KK);
    float* A = (float*)(lds + L_A);
#pragma unroll 4
    for (int it = 0; it < 16; ++it) {
      const int e = tid + it * NT, d = e >> 12, ip = (e >> 6) & 63, jp = e & 63, ti = d ? 63 - ip : ip, tj = d ? 63 - jp : jp;
      A[e] = ip > jp ? gs[128 + d * 64 + ti] * KK[ti * 65 + tj] * __expf(gs[256 + d * 64 + ti] - gs[256 + d * 64 + tj]) : 0.f;
    }
  }
  lds_barrier();
  if (wv < 2) {
    const float* A = (const float*)(lds + L_A) + wv * 4096; float* X = (float*)(lds + (wv ? L_X1 : L_X0));
    const int qb = lane >> 4, c16 = lane & 15;
    float x[16];
    f32x4 an[4];
#pragma unroll
    for (int q4 = 0; q4 < 4; ++q4) an[q4] = *(const f32x4*)(A + (qb * 16) * 64 + qb * 16 + q4 * 4);
#pragma unroll
    for (int r = 0; r < 16; ++r) {
      f32x4 ac[4];
#pragma unroll
      for (int q4 = 0; q4 < 4; ++q4) ac[q4] = an[q4];
      if (r < 15) {
#pragma unroll
        for (int q4 = 0; q4 < 4; ++q4) an[q4] = *(const f32x4*)(A + (qb * 16 + r + 1) * 64 + qb * 16 + q4 * 4); }
      asm volatile("" ::: "memory");
      float sacc = (r == c16) ? 1.f : 0.f;
#pragma unroll
      for (int q = 0; q < 16; ++q) if (q < r) sacc -= ac[q >> 2][q & 3] * x[q];
      x[r] = sacc;
      X[(qb * 16 + r) * 64 + qb * 16 + c16] = sacc;
    }
  } else {
    const float* gs = (const float*)(lds + L_G); const float* QK = (const float*)(lds + L_QK);
    const int t2 = tid - 128;
    for (int e = t2; e < 2 * 6 * 256; e += 384) {
      const int d = e / 1536, r6 = (e % 1536) >> 8, w = e & 255; const int bi = r6 < 3 ? 0 : (r6 < 5 ? 1 : 2), bj = r6 < 3 ? r6 + 1 : (r6 < 5 ? r6 - 1 : 3);
      ((float*)(lds + (d ? L_X1 : L_X0)))[(bi * 16 + (w >> 4)) * 64 + bj * 16 + (w & 15)] = 0.f; }
    for (int item = t2; item < 1024; item += 384) {
      const int d = item >> 9, fl = item & 63, frag = (item >> 6) & 7, mt = frag >> 2, kbj = frag & 3, r = fl & 31, hl = fl >> 5;
      const int i = mt * 32 + r; const float gci = gs[256 + d * 64 + i];
      float v[8];
#pragma unroll
      for (int j = 0; j < 8; ++j) { const int jj = kbj * 16 + 8 * (j >> 2) + 4 * hl + (j & 3); const bool ok = d ? (i <= jj) : (i >= jj);
        v[j] = ok ? QK[i * 65 + jj] * __expf(gci - gs[256 + d * 64 + jj]) : 0.f; }
      *(uint4*)(rec + R_DIR + d * DIR_BYTES + D_QKM + (size_t)(item & 511) * 16) = make_uint4(pk(v[0], v[1]), pk(v[2], v[3]), pk(v[4], v[5]), pk(v[6], v[7]));
    }
    if (t2 < 128) {
      const int d = t2 >> 6, tk = t2 & 63; float* vec = (float*)(rec + R_DIR + d * DIR_BYTES + D_VEC);
      const float gc = gs[256 + d * 64 + tk], gl = gs[256 + d * 64 + (d ? 0 : 63)];
      vec[tk] = gs[128 + d * 64 + tk]; vec[64 + tk] = __expf(gc); vec[128 + tk] = __expf(gl - gc);
      if (tk == 0) vec[192] = __expf(gl);
    }
  }
  lds_barrier();
  if (wv < 6) inv_offdiag((const float*)(lds + L_A) + (wv & 1) * 4096, (float*)(lds + ((wv & 1) ? L_X1 : L_X0)), (wv >> 1) + 1, wv >> 1, lane);
  lds_barrier();
  if (wv < 4) inv_offdiag((const float*)(lds + L_A) + (wv & 1) * 4096, (float*)(lds + ((wv & 1) ? L_X1 : L_X0)), (wv >> 1) + 2, wv >> 1, lane);
  lds_barrier();
  if (wv < 2) inv_offdiag((const float*)(lds + L_A) + wv * 4096, (float*)(lds + (wv ? L_X1 : L_X0)), 3, 0, lane);
  lds_barrier();
  {
#pragma unroll
    for (int it = 0; it < 2; ++it) {
      const int item = tid + it * NT, d = item >> 9, fl = item & 63, frag = (item >> 6) & 7, mt = frag >> 2, kbj = frag & 3, r = fl & 31, hl = fl >> 5;
      const int i = mt * 32 + r, ri = d ? 63 - i : i; const float* X = (const float*)(lds + (d ? L_X1 : L_X0)) + ri * 64; const float* bet = (const float*)(lds + L_G) + 128 + d * 64;
      float v[8];
#pragma unroll
      for (int j = 0; j < 8; ++j) { const int jj = kbj * 16 + 8 * (j >> 2) + 4 * hl + (j & 3); v[j] = X[d ? 63 - jj : jj] * bet[jj]; }
      *(uint4*)(rec + R_DIR + d * DIR_BYTES + D_TINV + (size_t)(item & 511) * 16) = make_uint4(pk(v[0], v[1]), pk(v[2], v[3]), pk(v[4], v[5]), pk(v[6], v[7]));
    }
  }
}

constexpr int SBUF_ = 74752;
template <int LW>
__device__ __forceinline__ void scan_loader(const char* recs, int dir, int half, char* smem, int lane) {
  typedef unsigned v4u __attribute__((ext_vector_type(4))); typedef __attribute__((address_space(1))) const v4u g_u4; typedef __attribute__((address_space(3))) v4u l_u4;
#define GD_CHUNK(step) (dir == 0 ? (step) : ((step) < 4 ? 3 - (step) : NCH + 3 - (step)))
#define GD_SOFF(i_) ((i_) < 48 ? (size_t)(i_) * 1024 : ((i_) < 56 ? R_VC + (size_t)half * 8192 + ((i_) - 48) * 1024 : R_DIR + (size_t)dir * DIR_BYTES + ((i_) - 56) * 1024))
#define GD_LOAD(R, step) do { const char* _b = recs + (size_t)GD_CHUNK(step) * CHREC + lane * 16; \
    _Pragma("unroll") for (int _j = 0; _j < 19; ++_j) { const int _i = LW + 4 * _j; if (_i < 73) R[_j] = *(g_u4*)(_b + GD_SOFF(_i)); } } while (0)
#define GD_WRITE(R, buf) do { char* _d = smem + (buf) * SBUF_ + lane * 16; \
    _Pragma("unroll") for (int _j = 0; _j < 19; ++_j) { const int _i = LW + 4 * _j; if (_i < 73) *(l_u4*)(_d + _i * 1024) = R[_j]; } } while (0)
  v4u RA[19], RB[19];
  GD_LOAD(RA, 0); GD_LOAD(RB, 1); GD_WRITE(RA, 0); GD_LOAD(RA, 2);
  lds_barrier();
  for (int step = 0; step < NCH; step += 2) {
    if (step + 1 < NCH) GD_WRITE(RB, 1);
    if (step + 3 < NCH) GD_LOAD(RB, step + 3);
    lds_barrier();
    if (step + 2 < NCH) GD_WRITE(RA, 0);
    if (step + 4 < NCH) GD_LOAD(RA, step + 4);
    lds_barrier();
  }
#undef GD_CHUNK
#undef GD_SOFF
#undef GD_LOAD
#undef GD_WRITE
}
constexpr int SB_QF = 0, SB_KF = 16384, SB_KTF = 32768, SB_VC = 49152, SB_TINV = 57344, SB_QKM = 65536, SB_VEC = 73728, SBUF = 74752;
using f32x16 = __attribute__((ext_vector_type(16))) float;
__device__ __forceinline__ unsigned pkb(float lo, float hi) {
  typedef __bf16 bf2 __attribute__((ext_vector_type(2))); typedef float f2 __attribute__((ext_vector_type(2)));
  bf2 r = __builtin_convertvector((f2){lo, hi}, bf2); return *reinterpret_cast<unsigned*>(&r);
}
template <int J> __device__ __forceinline__ bf16x8 pack16(const f32x16& v) {
  typedef unsigned u4 __attribute__((ext_vector_type(4)));
  u4 w = {pk(v[8 * J], v[8 * J + 1]), pk(v[8 * J + 2], v[8 * J + 3]), pk(v[8 * J + 4], v[8 * J + 5]), pk(v[8 * J + 6], v[8 * J + 7])};
  return *reinterpret_cast<bf16x8*>(&w);
}
typedef __attribute__((address_space(1))) char gchar; typedef __attribute__((address_space(1))) bf16_t gbf16;
#define GD_STO(o, I, MT) do { const unsigned _w = pk(o[I], o[(I) + 1]); gchar* _rb = Pst + (size_t)((MT) * 32 + 8 * ((I) >> 2) + ((I) & 3)) * (NINP * 2); asm volatile("" : "+s"(_rb)); \
    *(gbf16*)(_rb + voff) = (bf16_t)_w; *(gbf16*)(_rb + voff1) = (bf16_t)(_w >> 16); } while (0)
__device__ __forceinline__ void scan_unit_lds(const Params& p, int unit_, char* smem, int tid) {
  const int wv = __builtin_amdgcn_readfirstlane(tid >> 6), lane = tid & 63, unit = __builtin_amdgcn_readfirstlane(unit_);
  const int chain = unit >> 1, half = unit & 1, dir = chain & 1, h = (chain >> 1) & 3, b = chain >> 3;
  const char* recs = p.ws + OFF_RB + (size_t)((b * 4 + h) * NCH) * CHREC;
#define GD_CHUNK(step) (dir == 0 ? (step) : ((step) < 4 ? 3 - (step) : NCH + 3 - (step)))
  if (wv >= 4) {
    if (wv == 4) scan_loader<0>(recs, dir, half, smem, lane); else if (wv == 5) scan_loader<1>(recs, dir, half, smem, lane);
    else if (wv == 6) scan_loader<2>(recs, dir, half, smem, lane); else scan_loader<3>(recs, dir, half, smem, lane);
    return;
  }
  if (wv >= 2) {
    for (int i = 0; i <= NCH; ++i) lds_barrier();
    return;
  }
  lds_barrier();
  const int c32 = lane & 31, hl = lane >> 5;
  const unsigned voff_ = (unsigned)(c32 * 2 + hl * 4 * NINP * 2);
  gchar* Pc = (gchar*)(p.ws + OFF_P + (size_t)((dir ? PC_OB : PC_OF) + h * 128 + (half * 2 + wv) * 32) * 2);
  gchar* Pprev = (gchar*)(p.ws + OFF_P + (size_t)(PC_GV + h * 128 + (half * 2 + wv) * 32) * 2 + (size_t)chunk_row0(b, GD_CHUNK(0)) * (NINP * 2));
  f32x16 S[4], ks0, ks1, oq0, oq1, vn0, vn1;
  bf16x8 f0[8], f1[8], Sb[8], Rb[4], Vb[4], VFb[4];
  typedef unsigned u4 __attribute__((ext_vector_type(4)));
#pragma unroll
  for (int t = 0; t < 4; ++t)
#pragma unroll
    for (int i = 0; i < 16; ++i) S[t][i] = 0.f;
#pragma unroll
  for (int i = 0; i < 16; ++i) { oq0[i] = 0.f; oq1[i] = 0.f; }
#pragma unroll
  for (int k = 0; k < 8; ++k) { Sb[k] = (bf16x8){0, 0, 0, 0, 0, 0, 0, 0}; f0[k] = ((const bf16x8*)(smem + SB_KF))[k * 64 + lane]; }
#define GD_SB() __builtin_amdgcn_sched_barrier(0)
#define GD_MF(a, b, c) c = __builtin_amdgcn_mfma_f32_32x32x16_bf16(a, b, c, 0, 0, 0)
#define GD_ZERO(a) do { _Pragma("unroll") for (int _i = 0; _i < 16; ++_i) a[_i] = 0.f; } while (0)
#define GD_LO(w) __uint_as_float((w) << 16)
#define GD_HI(w) __uint_as_float((w) & 0xffff0000u)
#define GD_RLOAD(vA, vB, eA, eB, MT, HQ) do { vA = VC[((MT) * 4 + 2 * (HQ)) * 64 + lane]; vB = VC[((MT) * 4 + 2 * (HQ) + 1) * 64 + lane]; \
    eA = *(const f32x4*)(vec + 64 + (MT) * 32 + (HQ) * 16); eB = *(const f32x4*)(vec + 64 + (MT) * 32 + (HQ) * 16 + 8); } while (0)
#define GD_RC2(ks, v, e, I0, wa, wb) do { wa = pk(GD_LO(v.x) - e[0] * ks[(I0)], GD_HI(v.x) - e[1] * ks[(I0) + 1]); wb = pk(GD_LO(v.y) - e[2] * ks[(I0) + 2], GD_HI(v.y) - e[3] * ks[(I0) + 3]); } while (0)
#define GD_VF2(vn, e, I0, wa, wb) do { wa = pk(vn[(I0)] * e[0], vn[(I0) + 1] * e[1]); wb = pk(vn[(I0) + 2] * e[2], vn[(I0) + 3] * e[3]); } while (0)
#define GD_W4(dst) do { const u4 _w = {w0, w1, w2, w3}; dst = *reinterpret_cast<const bf16x8*>(&_w); } while (0)
#define GD_FLOAD(eA, eB, MT, HQ) do { eA = *(const f32x4*)(vec + 128 + (MT) * 32 + (HQ) * 16); eB = *(const f32x4*)(vec + 128 + (MT) * 32 + (HQ) * 16 + 8); } while (0)
#define GD_ELOAD(eA, eB, MT, HQ) do { eA = *(const f32x4*)(vec + 64 + (MT) * 32 + (HQ) * 16); eB = *(const f32x4*)(vec + 64 + (MT) * 32 + (HQ) * 16 + 8); } while (0)
#define GD_OINIT(oq, eA, eB, HQ) do { _Pragma("unroll") for (int _r = 0; _r < 4; ++_r) { oq[8 * (HQ) + _r] *= eA[_r]; oq[8 * (HQ) + 4 + _r] *= eB[_r]; } } while (0)
#define GD_SCALE(St, I0) do { float _e = egl; asm volatile("" : "+v"(_e)); _Pragma("unroll") for (int _r = 0; _r < 4; ++_r) St[(I0) + _r] *= _e; } while (0)
  uint2 vXA, vXB, vYA, vYB; f32x4 eXA, eXB, eYA, eYB, gXA, gXB, gYA, gYB; float egl; unsigned w0, w1, w2, w3;
  for (int step = 0; step < NCH; ++step) {
    const char* buf = smem + (step & 1) * SBUF; const char* nbuf = smem + ((step + 1) & 1) * SBUF;
    const bf16x8* QF = (const bf16x8*)(buf + SB_QF); const bf16x8* KF = (const bf16x8*)(buf + SB_KF); const bf16x8* KTF = (const bf16x8*)(buf + SB_KTF);
    const bf16x8* KFn = (const bf16x8*)(nbuf + SB_KF);
    const uint2* VC = (const uint2*)(buf + SB_VC + wv * 4096);
    const bf16x8* TF = (const bf16x8*)(buf + SB_TINV); const bf16x8* QKF = (const bf16x8*)(buf + SB_QKM); const float* vec = (const float*)(buf + SB_VEC) + 4 * hl;
    gchar* Pst = Pprev;
    unsigned voff = voff_; asm volatile("" : "+v"(voff)); unsigned voff1 = voff_ + NINP * 2; asm volatile("" : "+v"(voff1));
    GD_ZERO(ks0);
    GD_SB();
#pragma unroll
    for (int k = 0; k < 8; ++k) {
      GD_MF(f0[k], Sb[k], ks0);
      f1[k] = KF[(8 + k) * 64 + lane];
      if (k < 4) { GD_STO(oq0, 4 * k, 0); GD_STO(oq0, 4 * k + 2, 0); } else { GD_STO(oq1, 4 * (k - 4), 1); GD_STO(oq1, 4 * (k - 4) + 2, 1); }
      if (k == 6) GD_RLOAD(vXA, vXB, eXA, eXB, 0, 0);
      if (k == 7) { GD_RLOAD(vYA, vYB, eYA, eYB, 0, 1); GD_ZERO(ks1); }
      GD_SB();
    }
#pragma unroll
    for (int k = 0; k < 8; ++k) {
      GD_MF(f1[k], Sb[k], ks1);
      f0[k] = QF[k * 64 + lane];
      if (k == 1) GD_RC2(ks0, vXA, eXA, 0, w0, w1);
      if (k == 2) { GD_RC2(ks0, vXB, eXB, 4, w2, w3); GD_W4(Rb[0]); }
      if (k == 3) GD_RC2(ks0, vYA, eYA, 8, w0, w1);
      if (k == 4) { GD_RC2(ks0, vYB, eYB, 12, w2, w3); GD_W4(Rb[1]); }
      if (k == 5) GD_RLOAD(vXA, vXB, eXA, eXB, 1, 0);
      if (k == 6) GD_RLOAD(vYA, vYB, eYA, eYB, 1, 1);
      if (k == 7) { GD_ZERO(oq0); }
      GD_SB();
    }
#pragma unroll
    for (int k = 0; k < 8; ++k) {
      GD_MF(f0[k], Sb[k], oq0);
      f1[k] = QF[(8 + k) * 64 + lane];
      if (k == 1) GD_RC2(ks1, vXA, eXA, 0, w0, w1);
      if (k == 2) { GD_RC2(ks1, vXB, eXB, 4, w2, w3); GD_W4(Rb[2]); }
      if (k == 3) GD_RC2(ks1, vYA, eYA, 8, w0, w1);
      if (k == 4) { GD_RC2(ks1, vYB, eYB, 12, w2, w3); GD_W4(Rb[3]); }
      if (k == 6) egl = vec[192 - 4 * hl];
      if (k == 7) { GD_ZERO(oq1); }
      GD_SB();
    }
#pragma unroll
    for (int k = 0; k < 8; ++k) {
      GD_MF(f1[k], Sb[k], oq1);
      f0[k] = TF[k * 64 + lane];
      GD_SCALE(S[k >> 2], 4 * (k & 3)); GD_SCALE(S[2 + (k >> 2)], 4 * (k & 3));
      if (k == 6) { GD_FLOAD(gXA, gXB, 0, 0); GD_FLOAD(gYA, gYB, 0, 1); }
      if (k == 7) { GD_ZERO(vn0); GD_ZERO(vn1); }
      GD_SB();
    }
#pragma unroll
    for (int k = 0; k < 8; ++k) {
      if (k < 4) GD_MF(f0[k], Rb[k], vn0); else GD_MF(f0[k], Rb[k - 4], vn1);
      f1[k] = KTF[k * 64 + lane];
      if (k == 5) GD_VF2(vn0, gXA, 0, w0, w1);
      if (k == 6) { GD_VF2(vn0, gXB, 4, w2, w3); GD_W4(VFb[0]); }
      if (k == 7) { GD_VF2(vn0, gYA, 8, w0, w1); GD_FLOAD(gXA, gXB, 1, 0); }
      GD_SB();
    }
#pragma unroll
    for (int k = 0; k < 8; ++k) {
      if (k == 0) GD_MF(f1[0], VFb[0], S[0]); if (k == 1) GD_MF(f1[4], VFb[0], S[1]); if (k == 2) GD_MF(f1[1], VFb[1], S[0]); if (k == 3) GD_MF(f1[5], VFb[1], S[1]);
      if (k == 4) GD_MF(f1[2], VFb[2], S[0]); if (k == 5) GD_MF(f1[6], VFb[2], S[1]); if (k == 6) GD_MF(f1[3], VFb[3], S[0]); if (k == 7) GD_MF(f1[7], VFb[3], S[1]);
      f0[k] = KTF[(8 + k) * 64 + lane];
      if (k == 0) { GD_VF2(vn0, gYB, 12, w2, w3); GD_W4(VFb[1]); }
      if (k == 1) { GD_VF2(vn1, gXA, 0, w0, w1); GD_FLOAD(gYA, gYB, 1, 1); }
      if (k == 2) { GD_VF2(vn1, gXB, 4, w2, w3); GD_W4(VFb[2]); }
      if (k == 3) GD_VF2(vn1, gYA, 8, w0, w1);
      if (k == 4) { GD_VF2(vn1, gYB, 12, w2, w3); GD_W4(VFb[3]); }
      if (k == 5) Vb[0] = pack16<0>(vn0);
      if (k == 6) { Vb[1] = pack16<1>(vn0); GD_ELOAD(eXA, eXB, 0, 0); }
      if (k == 7) { Vb[2] = pack16<0>(vn1); GD_ELOAD(eYA, eYB, 0, 1); }
      GD_SB();
    }
#pragma unroll
    for (int k = 0; k < 8; ++k) {
      if (k < 4) GD_MF(f0[k], VFb[k], S[2]); else GD_MF(f0[k], VFb[k - 4], S[3]);
      if (k < 4) { f1[2 * k] = QKF[(2 * k) * 64 + lane]; f1[2 * k + 1] = QKF[(2 * k + 1) * 64 + lane]; }
      if (k == 0) GD_OINIT(oq0, eXA, eXB, 0);
      if (k == 1) { GD_OINIT(oq0, eYA, eYB, 1); GD_ELOAD(eXA, eXB, 1, 0); }
      if (k == 2) { GD_ELOAD(eYA, eYB, 1, 1); Vb[3] = pack16<1>(vn1); Sb[0] = pack16<0>(S[0]); }
      if (k == 3) GD_OINIT(oq1, eXA, eXB, 0);
      if (k == 4) GD_OINIT(oq1, eYA, eYB, 1);
      if (k == 5) Sb[1] = pack16<1>(S[0]);
      if (k == 6) Sb[2] = pack16<0>(S[1]);
      if (k == 7) Sb[3] = pack16<1>(S[1]);
      GD_SB();
    }
    Pprev = Pc + (size_t)chunk_row0(b, GD_CHUNK(step)) * (NINP * 2);
    lds_barrier();
    GD_SB();
#pragma unroll
    for (int k = 0; k < 8; ++k) {
      if (k < 4) GD_MF(f1[k], Vb[k], oq0); else GD_MF(f1[k], Vb[k - 4], oq1);
      f0[k] = KFn[k * 64 + lane];
      if (k == 0) Sb[4] = pack16<0>(S[2]);
      if (k == 1) Sb[5] = pack16<1>(S[2]);
      if (k == 2) Sb[6] = pack16<0>(S[3]);
      if (k == 3) Sb[7] = pack16<1>(S[3]);
      GD_SB();
    }
  }
  {
    gchar* Pst = Pprev; const unsigned voff = voff_, voff1 = voff_ + NINP * 2;
#pragma unroll
    for (int k = 0; k < 8; ++k) { if (k < 4) { GD_STO(oq0, 4 * k, 0); GD_STO(oq0, 4 * k + 2, 0); } else { GD_STO(oq1, 4 * (k - 4), 1); GD_STO(oq1, 4 * (k - 4) + 2, 1); } }
  }
#undef GD_SB
#undef GD_MF
#undef GD_ZERO
#undef GD_LO
#undef GD_HI
#undef GD_RLOAD
#undef GD_RC2
#undef GD_VF2
#undef GD_W4
#undef GD_FLOAD
#undef GD_ELOAD
#undef GD_OINIT
#undef GD_SCALE
#undef GD_CHUNK
}
#undef GD_STO
}

__device__ __forceinline__ void ph_init_ada(const Params& p) {
  const int TIDX = ltid(); const int BIDX = lbid();
  const size_t n = (size_t)MR * D, gt = (size_t)BIDX * NT + TIDX, gs = (size_t)gridDim.x * NT;
  for (size_t i = gt; i < n; i += gs) {
    int r = (int)(i / D), cc = (int)(i % D);
    xrow(p, r)[cc] = r < ML ? p.x[i] : p.ctx[(size_t)(r - ML) * D + cc];
  }
}
__device__ __forceinline__ void ph_modulate(const Params& p, int l, int which, int nrows) {
  const int TIDX = ltid(); const int BIDX = lbid();
  const int lane = TIDX & 63, wv = TIDX >> 6;
  for (int r = BIDX * 8 + wv; r < nrows; r += gridDim.x * 8) {
    int mj, t, tlen, r0; rowinfo(r, mj, t, tlen, r0);
    const float* xr = xrow_src(p, r, l);
    const float* g = (which ? p.norm2_g : p.norm1_g) + l * D;
    const float* sh = modvec(p, l, mj, which ? 3 : 0); const float* sc = modvec(p, l, mj, which ? 4 : 1);
    float v[16], ss = 0;
#pragma unroll
    for (int i = 0; i < 16; ++i) { v[i] = xr[lane + i * 64]; ss += v[i] * v[i]; }
    ss = wave_sum(ss);
    const float rstd = rsqrtf(ss / D + EPS);
    bf16_t* h = (bf16_t*)(p.ws + OFF_H) + (size_t)r * D;
#pragma unroll
    for (int i = 0; i < 16; ++i) { int cc = lane + i * 64; v[i] = v[i] * rstd * g[cc] * (1.f + sc[cc]) + sh[cc]; h[cc] = f2bf(v[i]); }
    if (which) {
      const float* wr = p.router + (size_t)l * D * NE;
      float lo[16];
#pragma unroll
      for (int e = 0; e < 16; ++e) lo[e] = 0.f;
#pragma unroll
      for (int i = 0; i < 16; ++i) { int cc = lane + i * 64;
#pragma unroll
        for (int e = 0; e < 16; ++e) lo[e] += v[i] * wr[cc * NE + e]; }
      float mx = -1e30f;
#pragma unroll
      for (int e = 0; e < 16; ++e) { lo[e] = wave_sum(lo[e]); mx = fmaxf(mx, lo[e]); }
      float sum = 0;
#pragma unroll
      for (int e = 0; e < 16; ++e) { lo[e] = expf(lo[e] - mx); sum += lo[e]; }
      float* afft = (float*)(p.ws + OFF_AFFT);
      if (lane == 0) {
#pragma unroll
        for (int e = 0; e < 16; ++e) afft[(size_t)e * MR + r] = lo[e] / sum;
      }
    }
  }
}

__device__ __forceinline__ constexpr int ngemm_lds_floats() { return 16 * 65 + 16 * 129; }
template <typename LoadA, typename LoadB, typename Epi>
__device__ __forceinline__ void ngemm_tile(float* lds, int M, int N, int K, int tm, int tn, LoadA lda_, LoadB ldb_, Epi epi) {
  float (*sA)[65] = (float (*)[65])lds; float (*sB)[129] = (float (*)[129])(lds + 16 * 65);
  const int tid = ltid(), tx = tid & 31, ty = tid >> 5;
  float acc[4][4];
#pragma unroll
  for (int i = 0; i < 4; ++i)
#pragma unroll
    for (int j = 0; j < 4; ++j) acc[i][j] = 0.f;
  for (int k0 = 0; k0 < K; k0 += 16) {
#pragma unroll
    for (int i = 0; i < 2; ++i) { int e = tid + i * 512; int rr = e >> 4, kk = e & 15; int gr = tm * 64 + rr; sA[kk][rr] = gr < M ? lda_(gr, k0 + kk) : 0.f; }
#pragma unroll
    for (int i = 0; i < 4; ++i) { int e = tid + i * 512; int kk = e >> 7, cc = e & 127; int gc = tn * 128 + cc; sB[kk][cc] = gc < N ? ldb_(k0 + kk, gc) : 0.f; }
    __syncthreads();
#pragma unroll
    for (int kk = 0; kk < 16; ++kk) {
      float a[4], b[4];
#pragma unroll
      for (int i = 0; i < 4; ++i) { a[i] = sA[kk][ty * 4 + i]; b[i] = sB[kk][tx * 4 + i]; }
#pragma unroll
      for (int i = 0; i < 4; ++i)
#pragma unroll
        for (int j = 0; j < 4; ++j) acc[i][j] += a[i] * b[j];
    }
    __syncthreads();
  }
#pragma unroll
  for (int i = 0; i < 4; ++i)
#pragma unroll
    for (int j = 0; j < 4; ++j) { int rr = tm * 64 + ty * 4 + i, cc = tn * 128 + tx * 4 + j; if (rr < M && cc < N) epi(rr, cc, acc[i][j]); }
}

__device__ __forceinline__ void ph_inproj(const Params& p, int l, float* lds) {
  const int TIDX = ltid(); const int BIDX = lbid();
  const bf16_t* H = (const bf16_t*)(p.ws + OFF_H); const float* W = p.w_in + (size_t)l * D * NIN; bf16_t* P = (bf16_t*)(p.ws + OFF_P);
  const int ntn = (NIN + 127) / 128, ntm = MR / 64;
  for (int vb = BIDX; vb < ntn * ntm; vb += gridDim.x)
    ngemm_tile(lds, MR, NIN, D, vb / ntn, vb % ntn,
               [&](int r, int k) { return bf2f(H[(size_t)r * D + k]); },
               [&](int k, int n) { return W[(size_t)k * NIN + n]; },
               [&](int r, int n, float v) { P[(size_t)r * NINP + n] = f2bf(v); });
}

__device__ __forceinline__ void ph_mla(const Params& p, int l, float* lds) {
  const int TIDX = ltid(); const int BIDX = lbid();
  float* pq = lds; float* pkv = pq + 192; float* pkr = pkv + 128; float* qraw = pkr + 32; float* kvraw = qraw + 384; float* qn = kvraw + 512; float* kn = qn + 384; float* red = kn + 384;
  const int tid = TIDX;
  for (int r = BIDX; r < MR; r += gridDim.x) {
    int mj, t, tlen, r0; rowinfo(r, mj, t, tlen, r0);
    const bf16_t* P = (const bf16_t*)(p.ws + OFF_P) + (size_t)r * NINP;
    __syncthreads();
    if (tid < 192) pq[tid] = bf2f(P[PC_Q + tid]);
    if (tid < 128) pkv[tid] = bf2f(P[PC_KV + tid]);
    if (tid < 32) pkr[tid] = bf2f(P[PC_KR + tid]);
    __syncthreads();
    if (tid < 64) { float s = 0; for (int k = tid; k < 192; k += 64) s += pq[k] * pq[k]; s = wave_sum(s); if (tid == 0) red[0] = rsqrtf(s / 192.f + EPS); }
    else if (tid < 128) { float s = 0; for (int k = tid - 64; k < 128; k += 64) s += pkv[k] * pkv[k]; s = wave_sum(s); if (tid == 64) red[1] = rsqrtf(s / 128.f + EPS); }
    __syncthreads();
    const float rq = red[0], rkv = red[1];
    const float* wuq = p.w_uq + (size_t)l * 192 * 384; const float* qan = p.q_a_norm + l * 192;
    const float* wukv = p.w_ukv + (size_t)l * 128 * 512; const float* kvan = p.kv_a_norm + l * 128;
    if (tid < 384) { float a = 0; for (int k = 0; k < 192; ++k) a += pq[k] * rq * qan[k] * wuq[k * 384 + tid]; qraw[tid] = a; }
    { float a = 0; for (int k = 0; k < 128; ++k) a += pkv[k] * rkv * kvan[k] * wukv[k * 512 + tid]; kvraw[tid] = a; }
    __syncthreads();
    const float* qnw = p.q_norm + l * 96; const float* knw = p.k_norm + l * 96;
    if (tid < 384) {
      int h = tid / 96, d = tid % 96;
      float sq = 0, sk = 0;
      for (int dd = 0; dd < 96; ++dd) { float a = qraw[h * 96 + dd]; sq += a * a; float b = dd < 64 ? kvraw[h * 128 + dd] : pkr[dd - 64]; sk += b * b; }
      float kval = d < 64 ? kvraw[h * 128 + d] : pkr[d - 64];
      qn[tid] = qraw[tid] * rsqrtf(sq / 96.f + EPS) * qnw[d];
      kn[tid] = kval * rsqrtf(sk / 96.f + EPS) * knw[d];
    }
    __syncthreads();
    const bool lat = r < ML; const int b = lat ? (r >> 13) : ((r - ML) >> 8); const int pos = lat ? TC + t : t;
    bf16_t* Q = (bf16_t*)(p.ws + OFF_QKV); bf16_t* Kb = Q + QK_ELEMS; bf16_t* Vb = Kb + QK_ELEMS;
    {
      int h = tid >> 7, d = tid & 127;
      float qv = 0, kv = 0;
      if (d < 96) {
        qv = qn[h * 96 + d]; kv = kn[h * 96 + d];
        if (lat && d >= 64) {
          int part = (d - 64) >> 4, w = (d - 64) & 15, i = w & 7; bool first = w < 8;
          float posv = part == 0 ? (float)(t >> 6) : (float)(t & 63);
          float invf = powf(10000.f, -(float)i / 8.f);
          float ang = posv * invf, cs = cosf(ang), sn = sinf(ang);
          int i1 = h * 96 + 64 + part * 16 + i, i2 = i1 + 8;
          qv = first ? qn[i1] * cs - qn[i2] * sn : qn[i2] * cs + qn[i1] * sn;
          kv = first ? kn[i1] * cs - kn[i2] * sn : kn[i2] * cs + kn[i1] * sn;
        }
      }
      size_t o = ((size_t)(b * 4 + h) * TK + pos) * 128 + d;
      Q[o] = f2bf(qv); Kb[o] = f2bf(kv);
      if (d < 64) Vb[((size_t)(b * 4 + h) * TK + pos) * 64 + d] = f2bf(kvraw[h * 128 + 64 + d]);
    }
  }
}

__device__ __forceinline__ void ph_gdnprep(const Params& p, int l, float* lds) {
  const int TIDX = ltid(); const int BIDX = lbid();
  float* cv = lds; float* rs = lds + 1536;
  const int tid = TIDX;
  const bf16_t* P = (const bf16_t*)(p.ws + OFF_P);
  const float* cw = p.conv_w + (size_t)l * 3 * 1536;
  for (int r = BIDX; r < MR; r += gridDim.x) {
    int mj, t, tlen, r0; rowinfo(r, mj, t, tlen, r0);
    __syncthreads();
    for (int c = tid; c < 1536; c += NT) {
      float a = 0;
      for (int j = 0; j < 3; ++j) { int tt = t + j - 1; if (tt >= 0 && tt < tlen) a += cw[j * 1536 + c] * bf2f(P[(size_t)(r0 + tt) * NINP + PC_GQ + c]); }
      cv[c] = silu_f(a);
    }
    __syncthreads();
    if (tid < 8) { float s = 0; for (int d = 0; d < 128; ++d) { float v = cv[tid * 128 + d]; s += v * v; } rs[tid] = rsqrtf(s + EPS) * (tid < 4 ? 0.08838834764831845f : 1.f); }
    __syncthreads();
    float* G = (float*)(p.ws + OFF_RB) + (size_t)r * 1536;
    for (int c = tid; c < 1536; c += NT) G[c] = c < 1024 ? cv[c] * rs[c >> 7] : cv[c];
    if (tid < 8) {
      float* gb = (float*)(p.ws + OFF_GB) + (size_t)r * 16;
      float pa = bf2f(P[(size_t)r * NINP + PC_A + tid]), pb = bf2f(P[(size_t)r * NINP + PC_B + tid]);
      gb[tid] = -expf(p.a_log[l * 8 + tid]) * softplus_f(pa + p.dt_bias[l * 8 + tid]);
      gb[8 + tid] = sigmoid_f(pb);
    }
  }
}
__device__ __forceinline__ void ph_scan(const Params& p, float* lds) {
  const int TIDX = ltid(); const int BIDX = lbid();
  if (BIDX >= 16) return;
  float* sk = lds; float* sq = lds + 128; float* red = lds + 256; float* red2 = lds + 256 + 512;
  const int tid = TIDX, e = tid & 127, part = tid >> 7;
  const int chain = BIDX, dir = chain & 1, h = (chain >> 1) & 3, b = chain >> 3;
  const float* G = (const float*)(p.ws + OFF_RB); const float* GB = (const float*)(p.ws + OFF_GB);
  bf16_t* P = (bf16_t*)(p.ws + OFF_P);
  float S[32];
#pragma unroll
  for (int d = 0; d < 32; ++d) S[d] = 0.f;
  __syncthreads();
  for (int step = 0; step < TC + T; ++step) {
    int row;
    if (step < TC) row = ML + b * TC + (dir ? TC - 1 - step : step);
    else { int i = step - TC; row = b * T + (dir ? T - 1 - i : i); }
    const float* q = G + (size_t)row * 1536 + h * 128; const float* k = q + 512; const float v = q[1024 + e];
    if (tid < 128) sk[tid] = k[tid]; else if (tid < 256) sq[tid - 128] = q[tid - 128];
    const float g = GB[(size_t)row * 16 + dir * 4 + h], beta = GB[(size_t)row * 16 + 8 + dir * 4 + h];
    const float eg = expf(g);
    __syncthreads();
    float ks = 0;
#pragma unroll
    for (int d = 0; d < 32; ++d) ks += sk[part * 32 + d] * S[d];
    red[part * 128 + e] = ks;
    __syncthreads();
    ks = red[e] + red[128 + e] + red[256 + e] + red[384 + e];
    const float vn = beta * (v - eg * ks);
    float o = 0;
#pragma unroll
    for (int d = 0; d < 32; ++d) { S[d] = eg * S[d] + sk[part * 32 + d] * vn; o += sq[part * 32 + d] * S[d]; }
    red2[part * 128 + e] = o;
    __syncthreads();
    if (part == 0) P[(size_t)row * NINP + (dir ? PC_OB : PC_OF) + h * 128 + e] = f2bf(red2[e] + red2[128 + e] + red2[256 + e] + red2[384 + e]);
  }
  __syncthreads();
}
__device__ __forceinline__ void ph_attn(const Params& p, bool need_ctx, float* lds) {
  const int TIDX = ltid(); const int BIDX = lbid();
  float (*sK)[96] = (float (*)[96])lds; float (*sV)[64] = (float (*)[64])(lds + 32 * 96);
  const int tid = TIDX;
  const int nlat = NB * 4 * (T / NT), nitem = nlat + (need_ctx ? NB * 4 : 0);
  const bf16_t* Q = (const bf16_t*)(p.ws + OFF_QKV); const bf16_t* Kb = Q + QK_ELEMS; const bf16_t* Vb = Kb + QK_ELEMS;
  for (int it = gridDim.x - 1 - BIDX; it < nitem; it += gridDim.x) {
    const bool ctxq = it >= nlat;
    int b, h, qt;
    if (!ctxq) { qt = it % (T / NT); h = (it / (T / NT)) & 3; b = it / (4 * (T / NT)); } else { int j = it - nlat; qt = 0; h = j & 3; b = j >> 2; }
    const bool active = !ctxq || tid < TC;
    const int qpos = ctxq ? (active ? tid : 0) : TC + qt * NT + tid;
    const int nk = ctxq ? TC : TK;
    const size_t bh = (size_t)(b * 4 + h) * TK;
    float q[96], o[64];
#pragma unroll
    for (int d = 0; d < 96; ++d) q[d] = bf2f(Q[(bh + qpos) * 128 + d]);
#pragma unroll
    for (int d = 0; d < 64; ++d) o[d] = 0.f;
    float m = -1e30f, lsum = 0.f;
    const float scale = 0.10206207261596575f;
    for (int k0 = 0; k0 < nk; k0 += 32) {
      __syncthreads();
      for (int e = tid; e < 32 * 96; e += NT) { int j = e / 96, d = e % 96; sK[j][d] = bf2f(Kb[(bh + k0 + j) * 128 + d]); }
      for (int e = tid; e < 32 * 64; e += NT) { int j = e >> 6, d = e & 63; sV[j][d] = bf2f(Vb[(bh + k0 + j) * 64 + d]); }
      __syncthreads();
      for (int j = 0; j < 32; ++j) {
        float s = 0;
#pragma unroll
        for (int d = 0; d < 96; ++d) s += q[d] * sK[j][d];
        s *= scale;
        if (s > m) { float a = __expf(m - s); lsum *= a;
#pragma unroll
          for (int d = 0; d < 64; ++d) o[d] *= a;
          m = s; }
        float pe = __expf(s - m); lsum += pe;
#pragma unroll
        for (int d = 0; d < 64; ++d) o[d] += pe * sV[j][d];
      }
    }
    if (active) {
      const int row = ctxq ? ML + b * TC + qpos : b * T + (qpos - TC);
      bf16_t* cat = (bf16_t*)(p.ws + OFF_H) + (size_t)row * D + h * 64;
      float inv = 1.f / lsum;
#pragma unroll
      for (int d = 0; d < 64; ++d) cat[d] = f2bf(o[d] * inv);
    }
  }
}
__device__ __forceinline__ void ph_gdnfin_pool(const Params& p, int l, int nrows, float* lds) {
  const int TIDX = ltid(); const int BIDX = lbid();
  float* ov = lds; float* rs = lds + 512; float* dv = lds + 520;
  const int tid = TIDX;
  const bf16_t* P = (const bf16_t*)(p.ws + OFF_P);
  for (int r = BIDX; r < nrows; r += gridDim.x) {
    int mj, t, tlen, r0; rowinfo(r, mj, t, tlen, r0);
    bf16_t* cat = (bf16_t*)(p.ws + OFF_H) + (size_t)r * D;
    __syncthreads();
    ov[tid] = bf2f(P[(size_t)r * NINP + PC_OF + tid]) + bf2f(P[(size_t)r * NINP + PC_OB + tid]);
    if (tid < 256) {
      int c = tid, gi = c >> 6, win = 2 << gi;
      int lo = t - win / 2, hi = lo + win; lo = lo < 0 ? 0 : lo; hi = hi > tlen ? tlen : hi;
      float s = 0; for (int tt = lo; tt < hi; ++tt) s += bf2f(P[(size_t)(r0 + tt) * NINP + PC_POOL + c]);
      dv[c] = s / (float)(hi - lo) - bf2f(P[(size_t)r * NINP + PC_POOL + c]);
    }
    __syncthreads();
    if (tid < 4) { float s = 0; for (int d = 0; d < 128; ++d) { float v = ov[tid * 128 + d]; s += v * v; } rs[tid] = rsqrtf(s / 128.f + EPS); }
    __syncthreads();
    const float* gn = p.gdn_norm_g + l * 128;
    { int c = tid; float z = bf2f(P[(size_t)r * NINP + PC_Z + c]); cat[256 + c] = f2bf(ov[c] * rs[c >> 7] * gn[c & 127] * silu_f(z)); }
    if (tid < 256) {
      int j = tid, gi = j >> 6, dd = j & 63;
      const float* pw = p.pool_w + ((size_t)l * 4 + gi) * 64 * 64;
      float a = 0; for (int c = 0; c < 64; ++c) a += dv[gi * 64 + c] * pw[c * 64 + dd];
      cat[768 + j] = f2bf(a * p.pool_scale[l * 256 + j]);
    }
  }
}
__device__ __forceinline__ void ph_outproj(const Params& p, int l, int nrows, float* lds) {
  const int TIDX = ltid(); const int BIDX = lbid();
  const bf16_t* A = (const bf16_t*)(p.ws + OFF_H); const float* W = p.w_out + (size_t)l * D * D;
  const int ntn = D / 128, ntm = nrows / 64;
  for (int vb = BIDX; vb < ntn * ntm; vb += gridDim.x)
    ngemm_tile(lds, nrows, D, D, vb / ntn, vb % ntn,
               [&](int r, int k) { return bf2f(A[(size_t)r * D + k]); },
               [&](int k, int n) { return W[(size_t)k * D + n]; },
               [&](int r, int n, float v) { int mj = r < ML ? (r >> 13) : 2; xrow(p, r)[n] += modvec(p, l, mj, 2)[n] * v; });
}
__device__ __forceinline__ void ph_topk(const Params& p, int nseq) {
  const int TIDX = ltid(); const int BIDX = lbid();
  const size_t total = (size_t)nseq * NE * T;
  for (size_t i = (size_t)BIDX * NT + TIDX; i < total; i += (size_t)gridDim.x * NT) {
    const int t = (int)(i % T), e = (int)((i / T) % NE), s = (int)(i / ((size_t)T * NE));
    const int tlen = s < 2 ? T : TC, cap = s < 2 ? CAPL : CAPC, r0 = s < 2 ? s * T : ML + (s - 2) * TC;
    if (t >= tlen) continue;
    const float* a = (const float*)(p.ws + OFF_AFFT) + (size_t)e * MR + r0;
    const float me = a[t];
    int rank = 0;
    for (int u = 0; u < tlen; ++u) { float o = a[u]; rank += (o > me || (o == me && u < t)) ? 1 : 0; }
    int* slot = (int*)(p.ws + OFF_SLOT);
    if (rank < cap) { int pi = pair_base(s, e) + rank; ((int*)(p.ws + OFF_IDX))[pi] = r0 + t; ((float*)(p.ws + OFF_GATE))[pi] = me; slot[(size_t)(r0 + t) * 16 + e] = rank; }
    else slot[(size_t)(r0 + t) * 16 + e] = -1;
  }
}
__device__ __forceinline__ void ph_moe_gu(const Params& p, int l, int grp0, int grp1, float* lds) {
  const int TIDX = ltid(); const int BIDX = lbid();
  const bf16_t* H = (const bf16_t*)(p.ws + OFF_H);
  float* tmp = (float*)(p.ws + OFF_P);
  const int ntn = DEXP / 128, ntm = CAPL / 64, per = ntn * ntm;
  for (int vb = BIDX; vb < (grp1 - grp0) * per; vb += gridDim.x) {
    const int grp = grp0 + vb / per, tt = vb % per, tm = tt / ntn, tn = tt % ntn;
    const int s = grp >> 4, e = grp & 15; const int cap = s < 2 ? CAPL : CAPC;
    if (tm * 64 >= cap) continue;
    const int pb = pair_base(s, e);
    const int* idx = (const int*)(p.ws + OFF_IDX) + pb;
    const float* Wg = p.w_gate + ((size_t)l * NE + e) * D * DEXP; const float* Wu = p.w_up + ((size_t)l * NE + e) * D * DEXP;
    bf16_t* hid = (bf16_t*)(p.ws + OFF_HID) + (size_t)pb * DEXP;
    ngemm_tile(lds, cap, DEXP, D, tm, tn,
               [&](int r, int k) { return bf2f(H[(size_t)idx[r] * D + k]); },
               [&](int k, int n) { return Wg[(size_t)k * DEXP + n]; },
               [&](int r, int n, float v) { tmp[(size_t)(pb + r) * DEXP + n] = v; });
    ngemm_tile(lds, cap, DEXP, D, tm, tn,
               [&](int r, int k) { return bf2f(H[(size_t)idx[r] * D + k]); },
               [&](int k, int n) { return Wu[(size_t)k * DEXP + n]; },
               [&](int r, int n, float v) { float g = tmp[(size_t)(pb + r) * DEXP + n]; hid[(size_t)r * DEXP + n] = f2bf(silu_f(g) * v); });
  }
}
__device__ __forceinline__ void ph_moe_down(const Params& p, int l, int grp0, int grp1, float* lds) {
  const int TIDX = ltid(); const int BIDX = lbid();
  const int ntn = D / 128, ntm = CAPL / 64, per = ntn * ntm;
  for (int vb = BIDX; vb < (grp1 - grp0) * per; vb += gridDim.x) {
    const int grp = grp0 + vb / per, tt = vb % per, tm = tt / ntn, tn = tt % ntn;
    const int s = grp >> 4, e = grp & 15; const int cap = s < 2 ? CAPL : CAPC;
    if (tm * 64 >= cap) continue;
    const int pb = pair_base(s, e);
    const bf16_t* hid = (const bf16_t*)(p.ws + OFF_HID) + (size_t)pb * DEXP;
    const float* Wd = p.w_down + ((size_t)l * NE + e) * DEXP * D;
    const float* gate = (const float*)(p.ws + OFF_GATE) + pb;
    bf16_t* Y = (bf16_t*)(p.ws + OFF_Y) + (size_t)pb * D;
    ngemm_tile(lds, cap, D, DEXP, tm, tn,
               [&](int r, int k) { return bf2f(hid[(size_t)r * DEXP + k]); },
               [&](int k, int n) { return Wd[(size_t)k * D + n]; },
               [&](int r, int n, float v) { Y[(size_t)r * D + n] = f2bf(v * gate[r]); });
  }
}
__device__ __forceinline__ void ph_combine(const Params& p, int l, int nrows) {
  const int TIDX = ltid(); const int BIDX = lbid();
  const bf16_t* Y = (const bf16_t*)(p.ws + OFF_Y);
  for (int r = BIDX; r < nrows; r += gridDim.x) {
    int mj, t, tlen, r0; rowinfo(r, mj, t, tlen, r0);
    const int s = r < ML ? (r >> 13) : 2 + ((r - ML) >> 8);
    const int* slot = (const int*)(p.ws + OFF_SLOT) + (size_t)r * 16;
    const float* g2 = modvec(p, l, mj, 5);
    float* xr = xrow(p, r);
    for (int c = TIDX; c < D; c += NT) {
      float a = 0;
      for (int e = 0; e < 16; ++e) { int sl = slot[e]; if (sl >= 0) a += bf2f(Y[(size_t)(pair_base(s, e) + sl) * D + c]); }
      xr[c] += g2[c] * a;
    }
  }
}


__device__ __forceinline__ void transpose_cvt_tile(float* lds, const float* W, int ldw, int N, bf16_t* Wt, int K, int rmul, int roff, int tk, int tn, int tid, const float* kscale = nullptr) {
  __syncthreads();
#pragma unroll
  for (int i = 0; i < 8; ++i) { int e = tid + i * NT; int kk = e >> 6, nn = e & 63; int n = tn * 64 + nn; lds[kk * 65 + nn] = n < N ? W[(size_t)(tk * 64 + kk) * ldw + n] * (kscale ? kscale[tk * 64 + kk] : 1.f) : 0.f; }
  __syncthreads();
#pragma unroll
  for (int i = 0; i < 8; ++i) { int e = tid + i * NT; int nn = e >> 6, kk = e & 63; int n = tn * 64 + nn; if (n < N) Wt[(size_t)(n * rmul + roff) * K + tk * 64 + kk] = f2bf(lds[kk * 65 + nn]); }
}
__device__ __forceinline__ void transpose_cvt_4tiles(float* lds, const float* W, int ldw, int N, bf16_t* Wt, int K, int rmul, int roff, int t4, int ntiles, int tid, const float* kscale) {
  const int ntn = (N + 63) / 64;
  float v[4][8];
#pragma unroll
  for (int q = 0; q < 4; ++q) { const int t = t4 + q, tk = t / ntn, tn = t % ntn;
#pragma unroll
    for (int i = 0; i < 8; ++i) { const int el = tid + i * NT, kk = el >> 6, nn = el & 63, n = tn * 64 + nn;
      v[q][i] = (t < ntiles && n < N) ? W[(size_t)(tk * 64 + kk) * ldw + n] * (kscale ? kscale[tk * 64 + kk] : 1.f) : 0.f; } }
  __syncthreads();
#pragma unroll
  for (int q = 0; q < 4; ++q)
#pragma unroll
    for (int i = 0; i < 8; ++i) { const int el = tid + i * NT, kk = el >> 6, nn = el & 63; lds[q * 4160 + kk * 65 + nn] = v[q][i]; }
  __syncthreads();
#pragma unroll
  for (int q = 0; q < 4; ++q) { const int t = t4 + q, tk = t / ntn, tn = t % ntn;
#pragma unroll
    for (int i = 0; i < 4; ++i) { const int el = tid + i * NT, nn = el >> 5, k2 = (el & 31) * 2, n = tn * 64 + nn;
      if (t < ntiles && n < N) *(unsigned*)(Wt + (size_t)(n * rmul + roff) * K + tk * 64 + k2) = gd::pk(lds[q * 4160 + k2 * 65 + nn], lds[q * 4160 + (k2 + 1) * 65 + nn]); } }
}
__device__ __forceinline__ void ph_prep_weights(const Params& p, float* lds) {
  const int TIDX = ltid(); const int BIDX = lbid();
  bf16_t* winT = (bf16_t*)(p.ws + OFF_WINT); bf16_t* woutT = (bf16_t*)(p.ws + OFF_WOUTT);
  const int g_in = 2 * 168, g_out = 2 * 64, g_q = 2 * 5, g_kv = 2 * 4;
  for (int vb = BIDX; vb < g_in + g_out + g_q + g_kv; vb += gridDim.x) {
    if (vb < g_in) { const int l = vb / 168, r = vb % 168; transpose_cvt_4tiles(lds, p.w_in + (size_t)l * D * NIN, NIN, NIN, winT + (size_t)l * NINP * D, D, 1, 0, r * 4, 16 * 42, TIDX, nullptr); }
    else if (vb < g_in + g_out) { const int v = vb - g_in, l = v / 64, r = v % 64; transpose_cvt_4tiles(lds, p.w_out + (size_t)l * D * D, D, D, woutT + (size_t)l * D * D, D, 1, 0, r * 4, 256, TIDX, nullptr); }
    else if (vb < g_in + g_out + g_q) { const int v = vb - g_in - g_out, l = v / 5, r = v % 5;
      transpose_cvt_4tiles(lds, p.w_uq + (size_t)l * 192 * 384, 384, 384, (bf16_t*)(p.ws + OFF_WUP) + (size_t)l * 1024 * 256, 256, 1, 0, r * 4, 18, TIDX, p.q_a_norm + l * 192); }
    else { const int v = vb - g_in - g_out - g_q, l = v / 4, r = v % 4;
      transpose_cvt_4tiles(lds, p.w_ukv + (size_t)l * 128 * 512, 512, 512, (bf16_t*)(p.ws + OFF_WUP) + (size_t)l * 1024 * 256 + 512 * 256, 256, 1, 0, r * 4, 16, TIDX, p.kv_a_norm + l * 128); }
  }
  for (int q = 0; q < 16; ++q) {
    const int i = (q * (int)gridDim.x + BIDX) * NT + TIDX; if (i >= 2 * 1024 * 256) break;
    const int k = i & 255, n = (i >> 8) & 1023;
    if ((n < 384 && k >= 192) || (n >= 384 && n < 512) || (n >= 512 && k >= 128)) ((bf16_t*)(p.ws + OFF_WUP))[i] = 0;
  }
  for (size_t i = (size_t)BIDX * NT + TIDX; i < (size_t)2 * (NINP - NIN) * D; i += (size_t)gridDim.x * NT) {
    const int l = (int)(i / ((size_t)(NINP - NIN) * D)); const size_t r = i % ((size_t)(NINP - NIN) * D);
    winT[(size_t)l * NINP * D + (size_t)NIN * D + r] = 0;
  }
}
__device__ __forceinline__ void ph_inproj_fast(const Params& p, int l, char* smem) {
  DenseSched S; S.init(MR / 256, NINP / 256, (int)gridDim.x, lbid());
  S.A = p.ws + OFF_H; S.Bt = p.ws + OFF_WINT + (size_t)l * NINP * D * 2; S.lda = D; S.ldb = D; S.K = D;
  EpiStoreBf16 E; E.O = (bf16_t*)(p.ws + OFF_P); E.ldc = NINP;
  pg8::gemm_phase(( PG8_LAS unsigned char*)smem, S, E);
}

__device__ __forceinline__ void ph_outproj_fast(const Params& p, int l, char* smem) {
  DenseSched S; S.init(ML / 256, D / 256, (int)gridDim.x, lbid());
  S.A = p.ws + OFF_H; S.Bt = p.ws + OFF_WOUTT + (size_t)l * D * D * 2; S.lda = D; S.ldb = D; S.K = D;
  EpiStoreBf16 E; E.O = (bf16_t*)(p.ws + OFF_YO); E.ldc = D;
  pg8::gemm_phase((PG8_LAS unsigned char*)smem, S, E);
}

__device__ __forceinline__ void ph_prep_moe_weights(const Params& p, int l, float* lds, int b0, int nb) {
  const int TIDX = ltid(); const int BIDX = lbid() - b0;
  if (BIDX < 0) return;
  bf16_t* gu = (bf16_t*)(p.ws + OFF_MOEGU); bf16_t* dn = (bf16_t*)(p.ws + OFF_MOED);
  unsigned* ctr = (unsigned*)(p.ws + OFF_BAR) + 16 + l; volatile int* bc = (volatile int*)(lds + 4 * 4160);
  __syncthreads();
  if (TIDX == 0) bc[0] = (int)__hip_atomic_fetch_add(ctr, 1u, __ATOMIC_RELAXED, __HIP_MEMORY_SCOPE_AGENT);
  __syncthreads();
  int vb = __builtin_amdgcn_readfirstlane(bc[0]);
  for (int it = 1; ; ++it) {
    if (vb >= NE * 3 * 32) break;
    const int e = vb / 96, r = vb % 96, which = r >> 5, t4 = (r & 31) * 4;
    const float* W; int ldw, K, rmul, roff; bf16_t* Wt;
    if (which < 2) { W = (which ? p.w_up : p.w_gate) + ((size_t)l * NE + e) * D * DEXP; ldw = DEXP; K = D; rmul = 2; roff = which; Wt = gu + (size_t)e * D * D; }
    else { W = p.w_down + ((size_t)l * NE + e) * DEXP * D; ldw = D; K = DEXP; rmul = 1; roff = 0; Wt = dn + (size_t)e * D * DEXP; }
    const int ntn = ldw / 64;
    float v[4][8];
#pragma unroll
    for (int q = 0; q < 4; ++q) { const int t = t4 + q, tk = t / ntn, tn = t % ntn;
#pragma unroll
      for (int i = 0; i < 8; ++i) { const int el = TIDX + i * NT, kk = el >> 6, nn = el & 63; v[q][i] = W[(size_t)(tk * 64 + kk) * ldw + tn * 64 + nn]; } }
    if (TIDX == 0) bc[it & 1] = (int)__hip_atomic_fetch_add(ctr, 1u, __ATOMIC_RELAXED, __HIP_MEMORY_SCOPE_AGENT);
    __syncthreads();
#pragma unroll
    for (int q = 0; q < 4; ++q)
#pragma unroll
      for (int i = 0; i < 8; ++i) { const int el = TIDX + i * NT, kk = el >> 6, nn = el & 63; lds[q * 4160 + kk * 65 + nn] = v[q][i]; }
    __syncthreads();
#pragma unroll
    for (int q = 0; q < 4; ++q) { const int t = t4 + q, tk = t / ntn, tn = t % ntn;
#pragma unroll
      for (int i = 0; i < 4; ++i) { const int el = TIDX + i * NT, nn = el >> 5, k2 = (el & 31) * 2;
        const unsigned w = gd::pk(lds[q * 4160 + k2 * 65 + nn], lds[q * 4160 + (k2 + 1) * 65 + nn]);
        *(unsigned*)(Wt + (size_t)((tn * 64 + nn) * rmul + roff) * K + tk * 64 + k2) = w; } }
    vb = __builtin_amdgcn_readfirstlane(bc[it & 1]);
  }
}
__device__ __forceinline__ void ph_gather(const Params& p) {
  const int TIDX = ltid(); const int BIDX = lbid();
  const int lane = TIDX & 63, wv = TIDX >> 6;
  const int* idx = (const int*)(p.ws + OFF_IDX);
  const uint4* H = (const uint4*)(p.ws + OFF_H); uint4* xs = (uint4*)(p.ws + OFF_XS);
  for (int r = BIDX * 8 + wv; r < NB * NE * CAPL; r += gridDim.x * 8) {
    const int src = idx[r];
    const uint4 a = H[(size_t)src * 128 + lane], b = H[(size_t)src * 128 + 64 + lane];
    xs[(size_t)r * 128 + lane] = a; xs[(size_t)r * 128 + 64 + lane] = b;
  }
}
__device__ __forceinline__ void ph_moe_gu_fast(const Params& p, char* smem) {
  MoeSched S; S.init(NB * NE * CAPL / 256, 2 * DEXP / 256, (int)gridDim.x, lbid());
  S.A = p.ws + OFF_H; S.Bt = p.ws + OFF_MOEGU; S.lda = D; S.ldb = D; S.K = D; S.bstride = (size_t)D * D * 2; S.gidx = (const int*)(p.ws + OFF_IDX); S.gather = true;
  EpiSwiGLU E; E.O = (bf16_t*)(p.ws + OFF_HID);
  pg8::gemm_phase<EpiSwiGLU, MoeSched, true>((PG8_LAS unsigned char*)smem, S, E);
}
__device__ __forceinline__ void ph_moe_down_fast(const Params& p, char* smem) {
  MoeSched S; S.init(NB * NE * CAPL / 256, D / 256, (int)gridDim.x, lbid());
  S.A = p.ws + OFF_HID; S.Bt = p.ws + OFF_MOED; S.lda = DEXP; S.ldb = DEXP; S.K = DEXP; S.bstride = (size_t)D * DEXP * 2; S.gidx = nullptr; S.gather = false;
  EpiGateBf16 E; E.O = (bf16_t*)(p.ws + OFF_Y); E.gate = (const float*)(p.ws + OFF_GATE);
  pg8::gemm_phase((PG8_LAS unsigned char*)smem, S, E);
}

__device__ __forceinline__ void attn_ctx_item(const Params& p, int j, char* smem) {
  const bf16_t* Q = (const bf16_t*)(p.ws + OFF_QKV); const bf16_t* Kb = Q + QK_ELEMS; const bf16_t* Vb = Kb + QK_ELEMS;
  const int h = j & 3, b = j >> 2; const size_t bh = (size_t)(b * 4 + h) * TK;
  fa::attn_body(Q + bh * 128, Kb + bh * 128, Vb + bh * 64, (bf16_t*)(p.ws + OFF_H) + (size_t)(ML + b * TC) * D + h * 64, D, TC, smem);
}
__device__ __forceinline__ void attn_seg(const Params& p, int x, int qt, int off, int len, char* smem) {
  const bf16_t* Q = (const bf16_t*)(p.ws + OFF_QKV); const bf16_t* Kb = Q + QK_ELEMS; const bf16_t* Vb = Kb + QK_ELEMS;
  const int h = x & 3, b = x >> 2, part = off == 0 ? 0 : 1, kv0 = off * 128;
  const size_t bh = (size_t)(b * 4 + h) * TK; const int row0 = b * T + qt * 256;
  bf16_t* op = (bf16_t*)(p.ws + OFF_OPART) + ((size_t)part * ML + row0) * 256 + h * 64;
  float* ml = (float*)(p.ws + OFF_MLPART) + (((size_t)part * ML + row0) * 4 + h) * 2;
  fa::attn_body(Q + (bh + TC + qt * 256) * 128, Kb + (bh + kv0) * 128, Vb + (bh + kv0) * 64, op, 256, len * 128, smem, ml, 8);
  if (off == 0 && len == TK / 128) {
    const int t = ltid();
    if (t < 256) *(float2*)((float*)(p.ws + OFF_MLPART) + (((size_t)ML + row0 + t) * 4 + h) * 2) = make_float2(-1e30f, 0.f);
  }
}
__device__ __forceinline__ void ph_attn_fast(const Params& p, bool need_ctx, char* smem) {
  const int BIDX = lbid();
  const int nns = (int)gridDim.x - 32;
  if (BIDX >= 32) {
    const int x = BIDX & 7, j = (BIDX - 32) >> 3, nj = nns >> 3;
    constexpr int PPQ = TK / 128, NPAIRS = 32 * PPQ;
    const int hi = (NPAIRS * (j + 1)) / nj;
    for (int cur = (NPAIRS * j) / nj; cur < hi; ) {
      const int qt = cur / PPQ, off = cur - qt * PPQ, len = min(PPQ - off, hi - cur);
      attn_seg(p, x, qt, off, len, smem);
      cur += len;
    }
    if (need_ctx && j == nj - 1) attn_ctx_item(p, x, smem);
  }
}

__device__ __forceinline__ void ph_gdn_precompute(const Params& p, int l, char* smem) {
  const int TIDX = ltid(); const int BIDX = lbid();
  __syncthreads();
  { const float* cw = p.conv_w + (size_t)l * 3 * 1536; float* cwl = (float*)(smem + gd::L_CW);
    for (int i = TIDX; i < 3 * 1536 / 4; i += NT) ((float4*)cwl)[i] = ((const float4*)cw)[i]; }
  const int nit = NB * 4 * gd::NCH;
  for (int it = BIDX; it < nit; it += gridDim.x) {
    const int c = it % gd::NCH, bh = it / gd::NCH;
    uint4 cur[3][4];
    gd::precompute_load(p, bh >> 2, bh & 3, c, TIDX, cur);
    gd::precompute_item(p, l, bh >> 2, bh & 3, c, smem, TIDX, cur);
  }
  __syncthreads();
}
__device__ __forceinline__ void ph_scan_fast(const Params& p, char* smem) {
  const int TIDX = ltid(); const int BIDX = lbid();
  if (BIDX < 32) gd::scan_unit_lds(p, (((BIDX & 7) + 8 * (BIDX >> 4)) << 1) | ((BIDX >> 3) & 1), smem, TIDX);
}

struct MlaSched : pg8::GridOrder {
  const char* P; const char* W; int lda, ldb, K; const int* gidx;
  __device__ __forceinline__ const char* a_ptr(const pg8::Unit& u) const { return P + (size_t)u.pm * 256 * NINP * 2 + (u.pn < 2 ? PC_Q : PC_KV) * 2; }
  __device__ __forceinline__ const char* b_ptr(const pg8::Unit& u) const { return W + (size_t)u.pn * 256 * 256 * 2; }
};
__device__ __forceinline__ void ph_mla_gemm(const Params& p, int l, char* smem) {
  if (lbid() < 32) return;
  MlaSched S; S.init(MR / 256, 4, (int)gridDim.x - 32, lbid() - 32);
  S.P = p.ws + OFF_P; S.W = p.ws + OFF_WUP + (size_t)l * 1024 * 256 * 2; S.lda = NINP; S.ldb = 256; S.K = 256; S.gidx = nullptr;
  EpiStoreBf16 E; E.O = (bf16_t*)(p.ws + OFF_UPRAW); E.ldc = 1024;
  pg8::gemm_phase((PG8_LAS unsigned char*)smem, S, E);
}
__device__ __forceinline__ void ph_mla_finish(const Params& p, int l) {
  const int TIDX = ltid(); const int BIDX = lbid();
  const int lane = TIDX & 63, wv = TIDX >> 6, cc = lane & 15, h = lane >> 4;
  const bf16_t* P = (const bf16_t*)(p.ws + OFF_P); const bf16_t* RAW = (const bf16_t*)(p.ws + OFF_UPRAW);
  bf16_t* Qo = (bf16_t*)(p.ws + OFF_QKV); bf16_t* Ko = Qo + QK_ELEMS; bf16_t* Vo = Ko + QK_ELEMS;
  const float invf = __builtin_amdgcn_exp2f(-(float)(cc & 7) * 1.6609640474436813f);
  const float sgn = (cc < 8) ? -1.f : 1.f;
  float qw[6], kw[6];
#pragma unroll
  for (int nt = 0; nt < 6; ++nt) { qw[nt] = p.q_norm[l * 96 + nt * 16 + cc]; kw[nt] = p.k_norm[l * 96 + nt * 16 + cc]; }
  for (int r2 = (BIDX + gridDim.x * wv) * 2; r2 < MR; r2 += gridDim.x * 8 * 2)
#pragma unroll
  for (int rr = 0; rr < 2; ++rr) { const int r = r2 + rr;
    const bool lat = r < ML; const int b = lat ? (r >> 13) : ((r - ML) >> 8), t = lat ? (r & (T - 1)) : ((r - ML) & (TC - 1)), pos = lat ? TC + t : t;
    const bf16_t* Pr = P + (size_t)r * NINP; const bf16_t* Rr = RAW + (size_t)r * 1024;
    float qa[6], ka[8], pq[3], pkv[2], pkr[2];
#pragma unroll
    for (int nt = 0; nt < 6; ++nt) qa[nt] = bf2f(Rr[h * 96 + nt * 16 + cc]);
#pragma unroll
    for (int nt = 0; nt < 8; ++nt) ka[nt] = bf2f(Rr[512 + h * 128 + nt * 16 + cc]);
#pragma unroll
    for (int i = 0; i < 3; ++i) pq[i] = bf2f(Pr[PC_Q + i * 64 + lane]);
#pragma unroll
    for (int i = 0; i < 2; ++i) { pkv[i] = bf2f(Pr[PC_KV + i * 64 + lane]); pkr[i] = bf2f(Pr[PC_KR + i * 16 + cc]); }
    const float rq = rsqrtf(wave_sum(pq[0] * pq[0] + pq[1] * pq[1] + pq[2] * pq[2]) / 192.f + EPS);
    const float rkv = rsqrtf(wave_sum(pkv[0] * pkv[0] + pkv[1] * pkv[1]) / 128.f + EPS);
    const float a0 = (float)(t >> 6) * invf, a1 = (float)(t & 63) * invf;
    const float cs[2] = {__cosf(a0), __cosf(a1)}, sn[2] = {__sinf(a0), __sinf(a1)};
    { float ss = 0.f;
#pragma unroll
      for (int nt = 0; nt < 6; ++nt) ss += qa[nt] * qa[nt];
      ss += __shfl_xor(ss, 1); ss += __shfl_xor(ss, 2); ss += __shfl_xor(ss, 4); ss += __shfl_xor(ss, 8);
      const float sc = rq * rsqrtf(rq * rq * ss / 96.f + EPS);
      const size_t ob = ((size_t)(b * 4 + h) * TK + pos) * 128;
#pragma unroll
      for (int nt = 0; nt < 6; ++nt) { float v = qa[nt] * sc * qw[nt];
        if (nt >= 4) { const float o = __shfl_xor(v, 8); if (lat) v = v * cs[nt - 4] + sgn * o * sn[nt - 4]; }
        Qo[ob + nt * 16 + cc] = f2bf(v); } }
    { float ss = 0.f, skr = pkr[0] * pkr[0] + pkr[1] * pkr[1];
#pragma unroll
      for (int nt = 0; nt < 4; ++nt) ss += ka[nt] * ka[nt];
      ss += __shfl_xor(ss, 1); ss += __shfl_xor(ss, 2); ss += __shfl_xor(ss, 4); ss += __shfl_xor(ss, 8);
      skr += __shfl_xor(skr, 1); skr += __shfl_xor(skr, 2); skr += __shfl_xor(skr, 4); skr += __shfl_xor(skr, 8);
      const float sck = rsqrtf((rkv * rkv * ss + skr) / 96.f + EPS);
      const size_t ob = ((size_t)(b * 4 + h) * TK + pos);
#pragma unroll
      for (int nt = 0; nt < 4; ++nt) Ko[ob * 128 + nt * 16 + cc] = f2bf(ka[nt] * rkv * sck * kw[nt]);
#pragma unroll
      for (int q = 0; q < 2; ++q) { float v = pkr[q] * kw[4 + q]; const float o = __shfl_xor(v, 8); if (lat) v = v * cs[q] + sgn * o * sn[q];
        Ko[ob * 128 + 64 + q * 16 + cc] = f2bf(v * sck); }
#pragma unroll
      for (int nt = 0; nt < 4; ++nt) Vo[ob * 64 + nt * 16 + cc] = f2bf(ka[4 + nt] * rkv); }
  }
}
constexpr int POOL_ROWB = 144, POOL_TILEB = 64 * POOL_ROWB;
template <int H>
__device__ __forceinline__ void pool_unit(const Params& p, int l, int tile, int gi, char* Dw, const char* WTl, int lane) {
  typedef unsigned u2 __attribute__((ext_vector_type(2)));
  using bf16x8 = fa::bf16x8; using f32x16 = fa::f32x16;
  const int r_first = tile * 64;
  int r0, tlen;
  if (r_first < ML) { r0 = r_first & ~(T - 1); tlen = T; } else { r0 = ML + ((r_first - ML) & ~(TC - 1)); tlen = TC; }
  const int cq = lane & 15, tb = lane >> 4, tbase = r_first - r0 + tb * 16;
  const bf16_t* Pg = (const bf16_t*)(p.ws + OFF_P) + (size_t)r0 * NINP + PC_POOL + gi * 64 + cq * 4;
  constexpr int NR = 15 + 2 * H;
  u2 xs[NR];
#pragma unroll
  for (int j = 0; j < NR; ++j) { const int tt = tbase - H + j; xs[j] = (tt >= 0 && tt < tlen) ? *(const u2*)(Pg + (size_t)tt * NINP) : (u2){0u, 0u}; }
#define PL_LO(w) __uint_as_float((w) << 16)
#define PL_HI(w) __uint_as_float((w) & 0xffff0000u)
  float s0 = 0.f, s1 = 0.f, s2 = 0.f, s3 = 0.f;
#pragma unroll
  for (int j = 0; j < 2 * H; ++j) { s0 += PL_LO(xs[j].x); s1 += PL_HI(xs[j].x); s2 += PL_LO(xs[j].y); s3 += PL_HI(xs[j].y); }
  char* drow = Dw + (tb * 16) * POOL_ROWB + cq * 8;
#pragma unroll
  for (int i = 0; i < 16; ++i) {
    const int t = tbase + i; const int lo = t - H < 0 ? 0 : t - H, hi = t + H > tlen ? tlen : t + H;
    const float inv = 1.f / (float)(hi - lo);
    const u2 c = xs[i + H];
    u2 w; w.x = gd::pk(s0 * inv - PL_LO(c.x), s1 * inv - PL_HI(c.x)); w.y = gd::pk(s2 * inv - PL_LO(c.y), s3 * inv - PL_HI(c.y));
    *(u2*)(drow + i * POOL_ROWB) = w;
    if (i < 15) { const u2 a = xs[i + 2 * H], b = xs[i];
      s0 += PL_LO(a.x) - PL_LO(b.x); s1 += PL_HI(a.x) - PL_HI(b.x); s2 += PL_LO(a.y) - PL_LO(b.y); s3 += PL_HI(a.y) - PL_HI(b.y); }
  }
#undef PL_LO
#undef PL_HI
  asm volatile("s_waitcnt lgkmcnt(0)" ::: "memory");
  const int r32 = lane & 31, hl = lane >> 5;
  f32x16 acc[2][2];
#pragma unroll
  for (int a = 0; a < 2; ++a)
#pragma unroll
    for (int b = 0; b < 2; ++b)
#pragma unroll
      for (int i = 0; i < 16; ++i) acc[a][b][i] = 0.f;
#pragma unroll
  for (int ks = 0; ks < 4; ++ks) {
    const bf16x8 a0 = *(const bf16x8*)(WTl + r32 * POOL_ROWB + ks * 32 + hl * 16), a1 = *(const bf16x8*)(WTl + (32 + r32) * POOL_ROWB + ks * 32 + hl * 16);
    const bf16x8 b0 = *(const bf16x8*)(Dw + r32 * POOL_ROWB + ks * 32 + hl * 16), b1 = *(const bf16x8*)(Dw + (32 + r32) * POOL_ROWB + ks * 32 + hl * 16);
    acc[0][0] = __builtin_amdgcn_mfma_f32_32x32x16_bf16(a0, b0, acc[0][0], 0, 0, 0); acc[0][1] = __builtin_amdgcn_mfma_f32_32x32x16_bf16(a0, b1, acc[0][1], 0, 0, 0);
    acc[1][0] = __builtin_amdgcn_mfma_f32_32x32x16_bf16(a1, b0, acc[1][0], 0, 0, 0); acc[1][1] = __builtin_amdgcn_mfma_f32_32x32x16_bf16(a1, b1, acc[1][1], 0, 0, 0);
  }
  const float* psc = p.pool_scale + l * 256 + gi * 64 + 4 * hl;
  bf16_t* cat = (bf16_t*)(p.ws + OFF_H) + (size_t)(r_first + r32) * D + 768 + gi * 64 + 4 * hl;
#pragma unroll
  for (int mt = 0; mt < 2; ++mt)
#pragma unroll
    for (int q = 0; q < 4; ++q) {
      const float4 s4 = *(const float4*)(psc + mt * 32 + q * 8);
#pragma unroll
      for (int nt = 0; nt < 2; ++nt) {
        u2 w; w.x = gd::pk(acc[mt][nt][4 * q] * s4.x, acc[mt][nt][4 * q + 1] * s4.y); w.y = gd::pk(acc[mt][nt][4 * q + 2] * s4.z, acc[mt][nt][4 * q + 3] * s4.w);
        *(u2*)(cat + (size_t)(nt * 32) * D + mt * 32 + q * 8) = w;
      }
    }
  asm volatile("s_waitcnt lgkmcnt(0)" ::: "memory");
}
__device__ __forceinline__ void ph_pool_mfma(const Params& p, int l, int nrows, char* smem) {
  const int TIDX = ltid(); const int BIDX = lbid();
  const int lane = TIDX & 63, wv = TIDX >> 6;
  const int gi = BIDX & 3;
  __syncthreads();
  {
    const float4* W = (const float4*)(p.pool_w + ((size_t)l * 4 + gi) * 4096);
    for (int i = TIDX; i < 1024; i += NT) { const float4 w = W[i]; const int c = i >> 4, o4 = (i & 15) * 4;
      bf16_t* dst = (bf16_t*)(smem + o4 * POOL_ROWB) + c;
      dst[0] = f2bf(w.x); dst[POOL_ROWB / 2] = f2bf(w.y); dst[POOL_ROWB] = f2bf(w.z); dst[3 * POOL_ROWB / 2] = f2bf(w.w); }
  }
  __syncthreads();
  char* Dw = smem + POOL_TILEB + wv * POOL_TILEB;
  const int ntiles = nrows >> 6;
  for (int tile = wv * ((int)gridDim.x >> 2) + (BIDX >> 2); tile < ntiles; tile += 8 * ((int)gridDim.x >> 2)) {
    if (gi == 0) pool_unit<1>(p, l, tile, 0, Dw, smem, lane); else if (gi == 1) pool_unit<2>(p, l, tile, 1, Dw, smem, lane);
    else if (gi == 2) pool_unit<4>(p, l, tile, 2, Dw, smem, lane); else pool_unit<8>(p, l, tile, 3, Dw, smem, lane);
  }
}
template <int MODE>
__device__ __forceinline__ void ph_gdnfin_pool_fast(const Params& p, int l, int nrows, float* lds, int b0, int nb) {
  const int TIDX = ltid(); const int BIDX = lbid() - b0;
  if (BIDX < 0) return;
  const int lane = TIDX & 63, wv = TIDX >> 6;
  float* Wl = lds; float* dsc = lds + 16384 + wv * 256;
  if (MODE == 1) {
    __syncthreads();
    for (int i = TIDX; i < 4096; i += NT) ((float4*)Wl)[i] = ((const float4*)(p.pool_w + (size_t)l * 16384))[i];
    __syncthreads();
  }
  const bf16_t* P = (const bf16_t*)(p.ws + OFF_P);
  const float* gn = p.gdn_norm_g + l * 128; const float* psc = p.pool_scale + l * 256;
  for (int r = BIDX + nb * wv; r < nrows; r += nb * 8) {
    int mj, t, tlen, r0; rowinfo(r, mj, t, tlen, r0);
    bf16_t* cat = (bf16_t*)(p.ws + OFF_H) + (size_t)r * D;
    const bf16_t* Pr = P + (size_t)r * NINP;
    if (MODE == 2 && r < ML) {
      const int hh = lane >> 4;
      float mp[2], lp[2], mx = -1e30f;
#pragma unroll
      for (int q = 0; q < 2; ++q) { const float2 ml = *(const float2*)((const float*)(p.ws + OFF_MLPART) + (((size_t)q * ML + r) * 4 + hh) * 2); mp[q] = ml.x; lp[q] = ml.y; mx = fmaxf(mx, ml.x); }
      float acc4[4] = {0.f, 0.f, 0.f, 0.f}, wsum = 0.f;
#pragma unroll
      for (int q = 0; q < 2; ++q) { const float w = lp[q] * __expf((mp[q] - mx) * fa::SCALE); wsum += w;
        const uint2 o = *(const uint2*)((const bf16_t*)(p.ws + OFF_OPART) + ((size_t)q * ML + r) * 256 + lane * 4);
        acc4[0] += w * __uint_as_float(o.x << 16); acc4[1] += w * __uint_as_float(o.x & 0xffff0000u); acc4[2] += w * __uint_as_float(o.y << 16); acc4[3] += w * __uint_as_float(o.y & 0xffff0000u); }
      const float inv = 1.f / wsum;
      uint2 w2; w2.x = gd::pk(acc4[0] * inv, acc4[1] * inv); w2.y = gd::pk(acc4[2] * inv, acc4[3] * inv);
      *(uint2*)(cat + lane * 4) = w2;
    }
    if (MODE == 2) {
      const uint4 a = *(const uint4*)(Pr + PC_OF + lane * 8), bq = *(const uint4*)(Pr + PC_OB + lane * 8), z = *(const uint4*)(Pr + PC_Z + lane * 8);
      const unsigned aw[4] = {a.x, a.y, a.z, a.w}, bw[4] = {bq.x, bq.y, bq.z, bq.w}, zw[4] = {z.x, z.y, z.z, z.w};
      float o[8], ss = 0.f;
#pragma unroll
      for (int i = 0; i < 4; ++i) { o[2 * i] = __uint_as_float(aw[i] << 16) + __uint_as_float(bw[i] << 16); o[2 * i + 1] = __uint_as_float(aw[i] & 0xffff0000u) + __uint_as_float(bw[i] & 0xffff0000u); }
#pragma unroll
      for (int i = 0; i < 8; ++i) ss += o[i] * o[i];
      ss += __shfl_xor(ss, 1); ss += __shfl_xor(ss, 2); ss += __shfl_xor(ss, 4); ss += __shfl_xor(ss, 8);
      const float rs = rsqrtf(ss / 128.f + EPS);
      float y[8];
#pragma unroll
      for (int i = 0; i < 4; ++i) { const float z0 = __uint_as_float(zw[i] << 16), z1 = __uint_as_float(zw[i] & 0xffff0000u);
        y[2 * i] = o[2 * i] * rs * gn[(lane & 15) * 8 + 2 * i] * silu_f(z0); y[2 * i + 1] = o[2 * i + 1] * rs * gn[(lane & 15) * 8 + 2 * i + 1] * silu_f(z1); }
      uint4 w; w.x = gd::pk(y[0], y[1]); w.y = gd::pk(y[2], y[3]); w.z = gd::pk(y[4], y[5]); w.w = gd::pk(y[6], y[7]);
      *(uint4*)(cat + 256 + lane * 8) = w;
    }
    if (MODE == 1) {
      const int gi = lane >> 4, win = 2 << gi;
      int lo = t - win / 2, hi = lo + win; lo = lo < 0 ? 0 : lo; hi = hi > tlen ? tlen : hi;
      float sm[4] = {0.f, 0.f, 0.f, 0.f};
      uint2 uw[16];
#pragma unroll
      for (int q = 0; q < 16; ++q) { const int tt = t - 8 + q; const bool ok = tt >= lo && tt < hi; uw[q] = ok ? *(const uint2*)(P + (size_t)(r0 + tt) * NINP + PC_POOL + lane * 4) : make_uint2(0u, 0u); }
#pragma unroll
      for (int q = 0; q < 16; ++q) { sm[0] += __uint_as_float(uw[q].x << 16); sm[1] += __uint_as_float(uw[q].x & 0xffff0000u); sm[2] += __uint_as_float(uw[q].y << 16); sm[3] += __uint_as_float(uw[q].y & 0xffff0000u); }
      const uint2 u = *(const uint2*)(Pr + PC_POOL + lane * 4); const float inv = 1.f / (float)(hi - lo);
      dsc[lane * 4 + 0] = sm[0] * inv - __uint_as_float(u.x << 16); dsc[lane * 4 + 1] = sm[1] * inv - __uint_as_float(u.x & 0xffff0000u);
      dsc[lane * 4 + 2] = sm[2] * inv - __uint_as_float(u.y << 16); dsc[lane * 4 + 3] = sm[3] * inv - __uint_as_float(u.y & 0xffff0000u);
      float4 acc = {0.f, 0.f, 0.f, 0.f};
      const float* wg = Wl + gi * 4096 + (lane & 15) * 4; const float* dg = dsc + gi * 64;
#pragma unroll 8
      for (int c = 0; c < 64; ++c) { const float dv = dg[c]; const float4 w4 = *(const float4*)(wg + c * 64); acc.x += dv * w4.x; acc.y += dv * w4.y; acc.z += dv * w4.z; acc.w += dv * w4.w; }
      const float4 s4 = *(const float4*)(psc + lane * 4);
      uint2 w; w.x = gd::pk(acc.x * s4.x, acc.y * s4.y); w.y = gd::pk(acc.z * s4.z, acc.w * s4.w);
      *(uint2*)(cat + 768 + lane * 4) = w;
    }
  }
}
__device__ __forceinline__ void ph_ada_fast(const Params& p, float* lds) {
  const int TIDX = ltid(); const int BIDX = lbid();
  const int cg = TIDX & 15, ksl = TIDX >> 4;
  for (int u = BIDX; u < 2 * 96; u += gridDim.x) {
    const int l = u / 96, n0 = (u % 96) * 64 + cg * 4;
    const float* w = p.ada_w + (size_t)l * D * 6144 + n0;
    float4 a0 = {0.f, 0.f, 0.f, 0.f}, a1 = a0, a2 = a0;
#pragma unroll 16
    for (int kk = 0; kk < 32; ++kk) { const int k = ksl * 32 + kk; const float4 w4 = *(const float4*)(w + (size_t)k * 6144);
      const float s0 = silu_f(p.c[k]), s1 = silu_f(p.c[D + k]), s2 = silu_f(p.c_ctx[k]);
      a0.x += s0 * w4.x; a0.y += s0 * w4.y; a0.z += s0 * w4.z; a0.w += s0 * w4.w;
      a1.x += s1 * w4.x; a1.y += s1 * w4.y; a1.z += s1 * w4.z; a1.w += s1 * w4.w;
      a2.x += s2 * w4.x; a2.y += s2 * w4.y; a2.z += s2 * w4.z; a2.w += s2 * w4.w; }
    __syncthreads();
    float4* red = (float4*)lds;
    red[(ksl * 3 + 0) * 16 + cg] = a0; red[(ksl * 3 + 1) * 16 + cg] = a1; red[(ksl * 3 + 2) * 16 + cg] = a2;
    __syncthreads();
    if (TIDX < 192) { const int j = TIDX / 64, c = TIDX % 64; const float* rf = lds;
      float a = p.ada_b[l * 6144 + (u % 96) * 64 + c];
      for (int q = 0; q < 32; ++q) a += rf[((q * 3 + j) * 16 + (c >> 2)) * 4 + (c & 3)];
      ((float*)(p.ws + OFF_MOD))[(size_t)(l * 3 + j) * 6144 + (u % 96) * 64 + c] = a; }
  }
}

__device__ __forceinline__ void ph_topk_fast(const Params& p, int nseq, char* smem) {
  const int TIDX = ltid(); const int BIDX = lbid();
  unsigned* keys = (unsigned*)smem;
  unsigned* hist = keys + 8192;
  unsigned* ctl = hist + 256;
  unsigned* scn = ctl + 8;
  for (int prob = BIDX; prob < nseq * NE; prob += gridDim.x) {
    const int s = prob >> 4, e = prob & 15;
    const int tlen = s < 2 ? T : TC, cap = s < 2 ? CAPL : CAPC, r0 = s < 2 ? s * T : ML + (s - 2) * TC;
    const float* a = (const float*)(p.ws + OFF_AFFT) + (size_t)e * MR + r0;
    __syncthreads();
    for (int i = TIDX; i < tlen; i += NT) keys[i] = __float_as_uint(a[i]);
    if (TIDX == 0) { ctl[0] = 0u; ctl[1] = (unsigned)cap; }
    __syncthreads();
    for (int pass = 0; pass < 4; ++pass) {
      const int shift = 24 - 8 * pass;
      if (TIDX < 256) hist[TIDX] = 0u;
      __syncthreads();
      const unsigned prefix = ctl[0], want = ctl[1];
      const unsigned himask = pass == 0 ? 0u : (0xffffffffu << (shift + 8));
      { unsigned cur = 0u, cnt = 0u;
        for (int i = TIDX; i < tlen; i += NT) { const unsigned k = keys[i];
          if ((k & himask) == prefix) { const unsigned dgt = (k >> shift) & 255u; if (dgt == cur) ++cnt; else { if (cnt) atomicAdd(&hist[cur], cnt); cur = dgt; cnt = 1u; } } }
        if (cnt) atomicAdd(&hist[cur], cnt); }
      __syncthreads();
      if (TIDX < 256) {
        const unsigned mine = hist[TIDX];
        unsigned inc = mine;
#pragma unroll
        for (int o = 1; o < 64; o <<= 1) { const unsigned n = __shfl_down(inc, o); if ((TIDX & 63) + o < 64) inc += n; }
        if ((TIDX & 63) == 0) scn[TIDX >> 6] = inc;
        __builtin_amdgcn_s_waitcnt(0);
      }
      __syncthreads();
      if (TIDX < 256) {
        const unsigned mine = hist[TIDX];
        unsigned inc = mine;
#pragma unroll
        for (int o = 1; o < 64; o <<= 1) { const unsigned n = __shfl_down(inc, o); if ((TIDX & 63) + o < 64) inc += n; }
        unsigned above = inc - mine;
        for (int w = (TIDX >> 6) + 1; w < 4; ++w) above += scn[w];
        if (above < want && above + mine >= want) { ctl[2] = prefix | ((unsigned)TIDX << shift); ctl[3] = want - above; }
      }
      __syncthreads();
      if (TIDX == 0) { ctl[0] = ctl[2]; ctl[1] = ctl[3]; }
      __syncthreads();
    }
    const unsigned thr = ctl[0], weq = ctl[1];
    const int per = tlen / NT > 0 ? tlen / NT : 1, nthr = tlen / per, t0 = TIDX * per;
    unsigned cnt = 0u;
    if (TIDX < nthr) for (int i = 0; i < per; ++i) { const unsigned k = keys[t0 + i]; cnt += (k > thr ? 0x10000u : 0u) + (k == thr ? 1u : 0u); }
    unsigned inc = cnt;
#pragma unroll
    for (int o = 1; o < 64; o <<= 1) { const unsigned n = __shfl_up(inc, o); if ((TIDX & 63) >= o) inc += n; }
    if ((TIDX & 63) == 63) scn[TIDX >> 6] = inc;
    __syncthreads();
    unsigned base = 0u;
    for (int w = 0; w < (TIDX >> 6); ++w) base += scn[w];
    unsigned run = base + inc - cnt;
    int* idx = (int*)(p.ws + OFF_IDX); float* gate = (float*)(p.ws + OFF_GATE); int* slot = (int*)(p.ws + OFF_SLOT);
    const int pb = pair_base(s, e);
    if (TIDX < nthr) for (int i = 0; i < per; ++i) {
      const unsigned k = keys[t0 + i]; const unsigned ngt = run >> 16, neq = run & 0xffffu;
      const unsigned eqtaken = neq < weq ? neq : weq;
      int sl = -1;
      if (k > thr) sl = (int)(ngt + eqtaken);
      else if (k == thr && neq < weq) sl = (int)(ngt + neq);
      if (sl >= 0) { idx[pb + sl] = r0 + t0 + i; gate[pb + sl] = __uint_as_float(k); }
      slot[(size_t)(r0 + t0 + i) * 16 + e] = sl;
      run += (k > thr ? 0x10000u : 0u) + (k == thr ? 1u : 0u);
    }
  }
}
__device__ __forceinline__ void ph_combine_fast(const Params& p, int l, int nrows, int next_l) {
  const int TIDX = ltid(); const int BIDX = lbid();
  const int lane = TIDX & 63, wv = TIDX >> 6;
  const bf16_t* Y = (const bf16_t*)(p.ws + OFF_Y);
  for (int r4 = (BIDX + gridDim.x * wv) * 4; r4 < nrows; r4 += gridDim.x * 8 * 4) {
    int mj, t, tlen, r0; rowinfo(r4, mj, t, tlen, r0);
    const int s = r4 < ML ? (r4 >> 13) : 2 + ((r4 - ML) >> 8);
    const int slot4 = ((const int*)(p.ws + OFF_SLOT))[(size_t)r4 * 16 + lane];
    const unsigned long long vm = __ballot(slot4 >= 0);
    const int pairl = pair_base(s, lane & 15) + slot4;
    float4 xv[4][4]; uint4 ya[4][2][2]; int nsel[4];
    float* xr[4];
#pragma unroll
    for (int rr = 0; rr < 4; ++rr) { xr[rr] = xrow(p, r4 + rr);
#pragma unroll
      for (int hf = 0; hf < 2; ++hf) { const uint4 xb4 = *(const uint4*)((const bf16_t*)xr[rr] + hf * 512 + lane * 8);
        xv[rr][hf * 2 + 0] = make_float4(__uint_as_float(xb4.x << 16), __uint_as_float(xb4.x & 0xffff0000u), __uint_as_float(xb4.y << 16), __uint_as_float(xb4.y & 0xffff0000u));
        xv[rr][hf * 2 + 1] = make_float4(__uint_as_float(xb4.z << 16), __uint_as_float(xb4.z & 0xffff0000u), __uint_as_float(xb4.w << 16), __uint_as_float(xb4.w & 0xffff0000u)); } }
#pragma unroll
    for (int rr = 0; rr < 4; ++rr) {
      unsigned m16 = (unsigned)(vm >> (rr * 16)) & 0xffffu; nsel[rr] = __builtin_popcount(m16);
#pragma unroll
      for (int k = 0; k < 2; ++k) {
        if (m16) { const int e = __builtin_ctz(m16); m16 &= m16 - 1; const int pr = __builtin_amdgcn_readlane(pairl, rr * 16 + e);
          const bf16_t* yr = Y + (size_t)pr * D; ya[rr][k][0] = *(const uint4*)(yr + lane * 8); ya[rr][k][1] = *(const uint4*)(yr + 512 + lane * 8); }
        else { ya[rr][k][0] = make_uint4(0u, 0u, 0u, 0u); ya[rr][k][1] = make_uint4(0u, 0u, 0u, 0u); }
      }
    }
    const float* g2 = modvec(p, l, mj, 5);
    float4 gq[4];
#pragma unroll
    for (int hf = 0; hf < 2; ++hf)
#pragma unroll
      for (int q = 0; q < 2; ++q) gq[hf * 2 + q] = *(const float4*)(g2 + hf * 512 + lane * 8 + q * 4);
    asm volatile("s_waitcnt vmcnt(0)" ::: "memory");
#pragma unroll
    for (int rr = 0; rr < 4; ++rr) {
      float acc[16];
#pragma unroll
      for (int i = 0; i < 16; ++i) acc[i] = 0.f;
#pragma unroll
      for (int k = 0; k < 2; ++k)
#pragma unroll
        for (int hf = 0; hf < 2; ++hf) { const unsigned w[4] = {ya[rr][k][hf].x, ya[rr][k][hf].y, ya[rr][k][hf].z, ya[rr][k][hf].w};
#pragma unroll
          for (int i = 0; i < 4; ++i) { acc[hf * 8 + 2 * i] += __uint_as_float(w[i] << 16); acc[hf * 8 + 2 * i + 1] += __uint_as_float(w[i] & 0xffff0000u); } }
      if (nsel[rr] > 2) {
        unsigned m16 = (unsigned)(vm >> (rr * 16)) & 0xffffu; m16 &= m16 - 1; m16 &= m16 - 1;
        while (m16) { const int e = __builtin_ctz(m16); m16 &= m16 - 1; const int pr = __builtin_amdgcn_readlane(pairl, rr * 16 + e);
          const bf16_t* yr = Y + (size_t)pr * D; const uint4 a = *(const uint4*)(yr + lane * 8), bq = *(const uint4*)(yr + 512 + lane * 8);
          const unsigned w[8] = {a.x, a.y, a.z, a.w, bq.x, bq.y, bq.z, bq.w};
#pragma unroll
          for (int i = 0; i < 8; ++i) { acc[2 * i] += __uint_as_float(w[i] << 16); acc[2 * i + 1] += __uint_as_float(w[i] & 0xffff0000u); } }
      }
      float x[16], ss = 0.f;
#pragma unroll
      for (int hf = 0; hf < 2; ++hf)
#pragma unroll
        for (int q = 0; q < 2; ++q) { const int c = hf * 512 + lane * 8 + q * 4; float4 xq = xv[rr][hf * 2 + q]; const float4 gv = gq[hf * 2 + q];
          xq.x += gv.x * acc[hf * 8 + q * 4 + 0]; xq.y += gv.y * acc[hf * 8 + q * 4 + 1]; xq.z += gv.z * acc[hf * 8 + q * 4 + 2]; xq.w += gv.w * acc[hf * 8 + q * 4 + 3];
          if (next_l >= 0) { uint2 xb2; xb2.x = gd::pk(xq.x, xq.y); xb2.y = gd::pk(xq.z, xq.w); *(uint2*)((bf16_t*)xr[rr] + c) = xb2; }
          else *(float4*)(xr[rr] + c) = xq;
          x[hf * 8 + q * 4 + 0] = xq.x; x[hf * 8 + q * 4 + 1] = xq.y; x[hf * 8 + q * 4 + 2] = xq.z; x[hf * 8 + q * 4 + 3] = xq.w;
          ss += xq.x * xq.x + xq.y * xq.y + xq.z * xq.z + xq.w * xq.w; }
      if (next_l >= 0) {
        ss = wave_sum(ss);
        const float rstd = rsqrtf(ss / D + EPS);
        const float* g = p.norm1_g + next_l * D; const float* sh = modvec(p, next_l, mj, 0); const float* sc = modvec(p, next_l, mj, 1);
        bf16_t* h = (bf16_t*)(p.ws + OFF_H) + (size_t)(r4 + rr) * D;
#pragma unroll
        for (int hf = 0; hf < 2; ++hf) { const int c = hf * 512 + lane * 8; float y[8];
#pragma unroll
          for (int i = 0; i < 8; ++i) y[i] = x[hf * 8 + i] * rstd * g[c + i] * (1.f + sc[c + i]) + sh[c + i];
          uint4 w; w.x = gd::pk(y[0], y[1]); w.y = gd::pk(y[2], y[3]); w.z = gd::pk(y[4], y[5]); w.w = gd::pk(y[6], y[7]);
          *(uint4*)(h + c) = w; }
      }
    }
  }
}
template <class RowPtr>
__device__ __forceinline__ gd::f32x4 coop_tile_32x64(RowPtr arow, const bf16_t* Bt, int ldb, int K, float* lds, int wv, int lane) {
  using gd::bf16x8; using gd::f32x4;
  const int cc = lane & 15, g = lane >> 4;
  const bf16_t* a0 = arow(cc) + g * 8; const bf16_t* a1 = arow(16 + cc) + g * 8;
  f32x4 acc[2][4];
#pragma unroll
  for (int m = 0; m < 2; ++m)
#pragma unroll
    for (int n = 0; n < 4; ++n) acc[m][n] = (f32x4){0.f, 0.f, 0.f, 0.f};
  for (int ks = wv; ks < K / 32; ks += 8) {
    const bf16x8 A0 = *(const bf16x8*)(a0 + ks * 32), A1 = *(const bf16x8*)(a1 + ks * 32);
#pragma unroll
    for (int n = 0; n < 4; ++n) { const bf16x8 B = *(const bf16x8*)(Bt + (size_t)(n * 16 + cc) * ldb + ks * 32 + g * 8);
      acc[0][n] = __builtin_amdgcn_mfma_f32_16x16x32_bf16(A0, B, acc[0][n], 0, 0, 0); acc[1][n] = __builtin_amdgcn_mfma_f32_16x16x32_bf16(A1, B, acc[1][n], 0, 0, 0); }
  }
  gd::lds_barrier();
#pragma unroll
  for (int m = 0; m < 2; ++m)
#pragma unroll
    for (int n = 0; n < 4; ++n) *(f32x4*)(lds + ((wv * 8 + m * 4 + n) * 64 + lane) * 4) = acc[m][n];
  gd::lds_barrier();
  f32x4 r = {0.f, 0.f, 0.f, 0.f};
#pragma unroll
  for (int w = 0; w < 8; ++w) r += *(const f32x4*)(lds + ((w * 8 + wv) * 64 + lane) * 4);
  return r;
}
__device__ __forceinline__ void ph_ctx_moe_gu(const Params& p, float* lds) {
  const int TIDX = ltid(); const int BIDX = lbid();
  const int lane = TIDX & 63, wv = TIDX >> 6, cc = lane & 15, g = lane >> 4;
  const bf16_t* H = (const bf16_t*)(p.ws + OFF_H); const bf16_t* GU = (const bf16_t*)(p.ws + OFF_MOEGU); bf16_t* hid = (bf16_t*)(p.ws + OFF_HID);
  const int* idx = (const int*)(p.ws + OFF_IDX);
  for (int it = BIDX; it < 32 * 16; it += gridDim.x) {
    const int grp = 32 + (it >> 4), ns = it & 15, s = grp >> 4, e = grp & 15, pb = pair_base(s, e);
    const gd::f32x4 v4 = coop_tile_32x64([&](int r) { return H + (size_t)idx[pb + r] * D; }, GU + (size_t)e * D * D + (size_t)(ns * 64) * D, D, D, lds, wv, lane);
    const int m = wv >> 2, n = wv & 3;
#pragma unroll
    for (int r = 0; r < 4; ++r) { const float v = v4[r], o = __shfl_xor(v, 1);
      if ((cc & 1) == 0) hid[(size_t)(pb + m * 16 + g * 4 + r) * DEXP + ((ns * 64 + n * 16 + cc) >> 1)] = f2bf(silu_f(v) * o); }
  }
}
__device__ __forceinline__ void ph_ctx_moe_down(const Params& p, float* lds) {
  const int TIDX = ltid(); const int BIDX = lbid();
  const int lane = TIDX & 63, wv = TIDX >> 6, cc = lane & 15, g = lane >> 4;
  const bf16_t* hid = (const bf16_t*)(p.ws + OFF_HID); const bf16_t* DN = (const bf16_t*)(p.ws + OFF_MOED); bf16_t* Y = (bf16_t*)(p.ws + OFF_Y);
  const float* gate = (const float*)(p.ws + OFF_GATE);
  for (int it = BIDX; it < 32 * 16; it += gridDim.x) {
    const int grp = 32 + (it >> 4), ns = it & 15, s = grp >> 4, e = grp & 15, pb = pair_base(s, e);
    const gd::f32x4 v4 = coop_tile_32x64([&](int r) { return hid + (size_t)(pb + r) * DEXP; }, DN + (size_t)e * D * DEXP + (size_t)(ns * 64) * DEXP, DEXP, DEXP, lds, wv, lane);
    const int m = wv >> 2, n = wv & 3;
#pragma unroll
    for (int r = 0; r < 4; ++r) { const int row = pb + m * 16 + g * 4 + r; Y[(size_t)row * D + ns * 64 + n * 16 + cc] = f2bf(v4[r] * gate[row]); }
  }
}
__device__ __forceinline__ void ph_ctx_outproj(const Params& p, int l, float* lds) {
  const int TIDX = ltid(); const int BIDX = lbid();
  const int lane = TIDX & 63, wv = TIDX >> 6, cc = lane & 15, g = lane >> 4;
  const bf16_t* A = (const bf16_t*)(p.ws + OFF_H) + (size_t)ML * D; const bf16_t* W = (const bf16_t*)(p.ws + OFF_WOUTT) + (size_t)l * D * D;
  bf16_t* yo = (bf16_t*)(p.ws + OFF_YO) + (size_t)ML * D;
  for (int it = BIDX; it < 16 * 16; it += gridDim.x) {
    const int mt = it >> 4, ns = it & 15;
    const gd::f32x4 v4 = coop_tile_32x64([&](int r) { return A + (size_t)(mt * 32 + r) * D; }, W + (size_t)(ns * 64) * D, D, D, lds, wv, lane);
    const int m = wv >> 2, n = wv & 3;
#pragma unroll
    for (int r = 0; r < 4; ++r) yo[(size_t)(mt * 32 + m * 16 + g * 4 + r) * D + ns * 64 + n * 16 + cc] = f2bf(v4[r]);
  }
}
__device__ __forceinline__ void ph_modulate2_fast(const Params& p, int l, int nrows, float* lds) {
  const int TIDX = ltid(); const int BIDX = lbid();
  const int lane = TIDX & 63, wv = TIDX >> 6;
  __syncthreads();
  { const float* wr = p.router + (size_t)l * D * NE;
    for (int i = TIDX; i < D * 4; i += NT) { const int c = i >> 2, q = i & 3, pr = (c & ~255) + (c & 3) * 64 + ((c >> 2) & 63);
      *(float4*)(lds + pr * 20 + q * 4) = *(const float4*)(wr + c * 16 + q * 4); } }
  __syncthreads();
  const float* g = p.norm2_g + l * D;
  for (int r4 = (BIDX + gridDim.x * wv) * 4; r4 < nrows; r4 += gridDim.x * 8 * 4) {
    int mj, t, tlen, r0; rowinfo(r4, mj, t, tlen, r0);
    const float* sh = modvec(p, l, mj, 3); const float* sc = modvec(p, l, mj, 4);
    float4 xv[4][4], gv[4], sv[4], hv[4];
#pragma unroll
    for (int rr = 0; rr < 4; ++rr) xv[rr][0] = xv[rr][1] = xv[rr][2] = xv[rr][3] = make_float4(0.f, 0.f, 0.f, 0.f);
    if (l == 0) {
#pragma unroll
      for (int rr = 0; rr < 4; ++rr) { const float* xr = xrow_src(p, r4 + rr, 0);
#pragma unroll
        for (int i = 0; i < 4; ++i) xv[rr][i] = *(const float4*)(xr + i * 256 + lane * 4); }
    } else {
#pragma unroll
      for (int rr = 0; rr < 4; ++rr) { const bf16_t* xr = (const bf16_t*)xrow_src(p, r4 + rr, 1);
#pragma unroll
        for (int i = 0; i < 4; ++i) { const uint2 v = *(const uint2*)(xr + i * 256 + lane * 4);
          xv[rr][i] = make_float4(__uint_as_float(v.x << 16), __uint_as_float(v.x & 0xffff0000u), __uint_as_float(v.y << 16), __uint_as_float(v.y & 0xffff0000u)); } }
    }
    {
      const float* g1 = modvec(p, l, mj, 2); const bf16_t* yo = (const bf16_t*)(p.ws + OFF_YO);
#pragma unroll
      for (int i = 0; i < 4; ++i) { const int c = i * 256 + lane * 4; const float4 gg = *(const float4*)(g1 + c);
#pragma unroll
        for (int rr = 0; rr < 4; ++rr) { const uint2 yv = *(const uint2*)(yo + (size_t)(r4 + rr) * D + c);
          xv[rr][i].x += gg.x * __uint_as_float(yv.x << 16); xv[rr][i].y += gg.y * __uint_as_float(yv.x & 0xffff0000u);
          xv[rr][i].z += gg.z * __uint_as_float(yv.y << 16); xv[rr][i].w += gg.w * __uint_as_float(yv.y & 0xffff0000u);
          uint2 xb2; xb2.x = gd::pk(xv[rr][i].x, xv[rr][i].y); xb2.y = gd::pk(xv[rr][i].z, xv[rr][i].w);
          *(uint2*)((bf16_t*)xrow(p, r4 + rr) + c) = xb2; } }
    }
#pragma unroll
    for (int i = 0; i < 4; ++i) { const int c = i * 256 + lane * 4; gv[i] = *(const float4*)(g + c); sv[i] = *(const float4*)(sc + c); hv[i] = *(const float4*)(sh + c); }
#pragma unroll
    for (int rr = 0; rr < 4; ++rr) {
      const int r = r4 + rr;
      float ss = 0.f;
#pragma unroll
      for (int i = 0; i < 4; ++i) ss += xv[rr][i].x * xv[rr][i].x + xv[rr][i].y * xv[rr][i].y + xv[rr][i].z * xv[rr][i].z + xv[rr][i].w * xv[rr][i].w;
      ss = wave_sum(ss);
      const float rstd = rsqrtf(ss / D + EPS);
      bf16_t* h = (bf16_t*)(p.ws + OFF_H) + (size_t)r * D;
      float lo[16];
#pragma unroll
      for (int e = 0; e < 16; ++e) lo[e] = 0.f;
#pragma unroll
      for (int i = 0; i < 4; ++i) {
        const int c = i * 256 + lane * 4;
        float y[4];
        y[0] = xv[rr][i].x * rstd * gv[i].x * (1.f + sv[i].x) + hv[i].x; y[1] = xv[rr][i].y * rstd * gv[i].y * (1.f + sv[i].y) + hv[i].y;
        y[2] = xv[rr][i].z * rstd * gv[i].z * (1.f + sv[i].z) + hv[i].z; y[3] = xv[rr][i].w * rstd * gv[i].w * (1.f + sv[i].w) + hv[i].w;
        uint2 w; w.x = gd::pk(y[0], y[1]); w.y = gd::pk(y[2], y[3]);
        *(uint2*)(h + c) = w;
#pragma unroll
        for (int q = 0; q < 4; ++q) {
          const float* wrow = lds + (i * 256 + q * 64 + lane) * 20;
#pragma unroll
          for (int e4 = 0; e4 < 4; ++e4) { const float4 w4 = *(const float4*)(wrow + e4 * 4);
            lo[e4 * 4 + 0] += y[q] * w4.x; lo[e4 * 4 + 1] += y[q] * w4.y; lo[e4 * 4 + 2] += y[q] * w4.z; lo[e4 * 4 + 3] += y[q] * w4.w; }
        }
      }
#pragma unroll
      for (int k = 0; k < 4; ++k) {
        const int half = 8 >> k, mask = 32 >> k; const bool upper = (lane & mask) != 0;
#pragma unroll
        for (int i = 0; i < half; ++i) { const float send = upper ? lo[i] : lo[i + half]; const float recv = __shfl_xor(send, mask); lo[i] = (upper ? lo[i + half] : lo[i]) + recv; }
      }
      float v = lo[0]; v += __shfl_xor(v, 1); v += __shfl_xor(v, 2);
      float mx = v;
      mx = fmaxf(mx, __shfl_xor(mx, 4)); mx = fmaxf(mx, __shfl_xor(mx, 8)); mx = fmaxf(mx, __shfl_xor(mx, 16)); mx = fmaxf(mx, __shfl_xor(mx, 32));
      const float ex = expf(v - mx);
      float sm = ex; sm += __shfl_xor(sm, 4); sm += __shfl_xor(sm, 8); sm += __shfl_xor(sm, 16); sm += __shfl_xor(sm, 32);
      if ((lane & 3) == 0) { const int e = ((lane >> 5) & 1) * 8 + ((lane >> 4) & 1) * 4 + ((lane >> 3) & 1) * 2 + ((lane >> 2) & 1);
        ((float*)(p.ws + OFF_AFFT))[(size_t)e * MR + r] = ex / sm; }
    }
  }
}

__device__ __forceinline__ void ph_modulate1_fast(const Params& p) {
  const int TIDX = ltid(); const int BIDX = lbid();
  const int lane = TIDX & 63, wv = TIDX >> 6;
  const float* g = p.norm1_g;
  for (int r2 = (BIDX + gridDim.x * wv) * 2; r2 < MR; r2 += gridDim.x * 8 * 2) {
    int mj, t, tlen, r0; rowinfo(r2, mj, t, tlen, r0);
    const float* sh = modvec(p, 0, mj, 0); const float* sc = modvec(p, 0, mj, 1);
    float4 xv[2][4];
#pragma unroll
    for (int rr = 0; rr < 2; ++rr) { const float* xr = xrow_src(p, r2 + rr, 0);
#pragma unroll
      for (int i = 0; i < 4; ++i) xv[rr][i] = *(const float4*)(xr + i * 256 + lane * 4); }
    float4 gv[4], sv[4], hv[4];
#pragma unroll
    for (int i = 0; i < 4; ++i) { const int c = i * 256 + lane * 4; gv[i] = *(const float4*)(g + c); sv[i] = *(const float4*)(sc + c); hv[i] = *(const float4*)(sh + c); }
#pragma unroll
    for (int rr = 0; rr < 2; ++rr) {
      float ss = 0.f;
#pragma unroll
      for (int i = 0; i < 4; ++i) ss += xv[rr][i].x * xv[rr][i].x + xv[rr][i].y * xv[rr][i].y + xv[rr][i].z * xv[rr][i].z + xv[rr][i].w * xv[rr][i].w;
      ss = wave_sum(ss);
      const float rstd = rsqrtf(ss / D + EPS);
      bf16_t* h = (bf16_t*)(p.ws + OFF_H) + (size_t)(r2 + rr) * D;
#pragma unroll
      for (int i = 0; i < 4; ++i) { const int c = i * 256 + lane * 4;
        uint2 w; w.x = gd::pk(xv[rr][i].x * rstd * gv[i].x * (1.f + sv[i].x) + hv[i].x, xv[rr][i].y * rstd * gv[i].y * (1.f + sv[i].y) + hv[i].y);
        w.y = gd::pk(xv[rr][i].z * rstd * gv[i].z * (1.f + sv[i].z) + hv[i].z, xv[rr][i].w * rstd * gv[i].w * (1.f + sv[i].w) + hv[i].w);
        *(uint2*)(h + c) = w; }
    }
  }
}

constexpr size_t LDS_BYTES = 163840;
__global__ void __launch_bounds__(NT, 2) mega(Params p) {
  extern __shared__ __attribute__((aligned(16))) char smem[];
  float* lds = (float*)smem;
  volatile LAS unsigned* xbst = (volatile LAS unsigned*)(smem + LDS_BYTES - 16);
  if (threadIdx.x == 0) { xbst[0] = 0u; xbst[1] = 0u; xbst[2] = 0u; xbst[3] = 0u; }
  __syncthreads();
  XcdBarrier xb = xcd_barrier_post((unsigned*)(p.ws + OFF_BAR), xbst);
  cg::grid_group grid = cg::this_grid();

  if (p.ws == nullptr) grid.sync();
  for (int l = 0; l < 2; ++l) {
    const bool need_ctx = l == 0;
    const int nrows = need_ctx ? MR : ML, nseq = need_ctx ? 4 : 2;
    if (l == 0) { ph_ada_fast(p, lds); ph_prep_weights(p, lds); xcd_barrier(xb); ph_modulate1_fast(p); xcd_barrier(xb); }
    for (int _r = 0; _r < REP_INPROJ; ++_r) ph_inproj_fast(p, l, smem);
    xcd_barrier(xb);
    for (int _r = 0; _r < REP_PRE; ++_r) ph_gdn_precompute(p, l, smem);
    ph_mla_gemm(p, l, smem);
    xcd_barrier(xb);
    for (int _r = 0; _r < REP_MLA; ++_r) ph_mla_finish(p, l);
    xcd_barrier(xb);
    for (int _r = 0; _r < REP_SCAN; ++_r) ph_scan_fast(p, smem);
    for (int _r = 0; _r < REP_ATTN; ++_r) ph_attn_fast(p, need_ctx, smem);
    ph_pool_mfma(p, l, nrows, smem);
    xcd_barrier(xb);
    ph_gdnfin_pool_fast<2>(p, l, nrows, lds, 0, (int)gridDim.x);
    xcd_barrier(xb);
    ph_outproj_fast(p, l, smem);
    if (need_ctx) ph_ctx_outproj(p, l, lds);
    xcd_barrier(xb);
    for (int _r = 0; _r < REP_MOD; ++_r) ph_modulate2_fast(p, l, nrows, lds);
    xcd_barrier(xb);
    for (int _r = 0; _r < REP_TOPK; ++_r) ph_topk_fast(p, nseq, smem);
    ph_prep_moe_weights(p, l, lds, 0, (int)gridDim.x);
    xcd_barrier(xb);
    for (int _r = 0; _r < REP_MOEGU; ++_r) ph_moe_gu_fast(p, smem);
    if (need_ctx) ph_ctx_moe_gu(p, lds);
    xcd_barrier(xb);
    ph_moe_down_fast(p, smem);
    if (need_ctx) ph_ctx_moe_down(p, lds);
    xcd_barrier(xb);
    ph_combine_fast(p, l, nrows, l == 0 ? 1 : -1);
    xcd_barrier(xb);
  }
}

extern "C" void kernel_launch(void* const* d_in, const int* in_sizes, int n_in, void* d_out, int out_size, void* d_ws, size_t ws_size, hipStream_t stream) {
  static int grid_blocks = 0;
  if (ws_size < OFF_END) { fprintf(stderr, "kernel_launch: workspace too small: %zu < %zu\n", ws_size, (size_t)OFF_END); return; }
  if (!grid_blocks) {
    if (hipFuncSetAttribute((const void*)mega, hipFuncAttributeMaxDynamicSharedMemorySize, (int)LDS_BYTES) != hipSuccess) { fprintf(stderr, "kernel_launch: hipFuncSetAttribute failed\n"); return; }
    int dev = 0, cus = 0, per_cu = 0;
    hipGetDevice(&dev);
    hipDeviceGetAttribute(&cus, hipDeviceAttributeMultiprocessorCount, dev);
    hipOccupancyMaxActiveBlocksPerMultiprocessor(&per_cu, mega, NT, LDS_BYTES);
    if (per_cu < 1) { fprintf(stderr, "kernel_launch: occupancy query returned %d\n", per_cu); return; }
    grid_blocks = cus;
  }
  Params p{};
  const float** f = (const float**)&p;
  for (int i = 0; i < 26; ++i) f[i] = (const float*)d_in[i];
  p.out = (float*)d_out; p.ws = (char*)d_ws;
  hipMemsetAsync((char*)d_ws + OFF_BAR, 0, 16384, stream);
  void* args[] = {&p};
  hipError_t e = hipLaunchCooperativeKernel((const void*)mega, dim3(grid_blocks), dim3(NT), args, LDS_BYTES, stream);
  if (e != hipSuccess) fprintf(stderr, "cooperative launch failed: %s (grid %d)\n", hipGetErrorString(e), grid_blocks);
}
```

```cpp
#include <hip/hip_runtime.h>
#include <hip/hip_bf16.h>
#include <hip/hip_cooperative_groups.h>
#include <cstdint>
#include <cstdio>
namespace cg = cooperative_groups;
#define REP_SCAN 1
#define REP_ATTN 1
#define REP_PRE 1
#define REP_MLA 1
#define REP_PMW 1
#define REP_TOPK 1
#define REP_GATHER 1
#define REP_INPROJ 1
#define REP_MOEGU 1
#define REP_MOD 1
#define REP_FIN 1
#define REP_INIT 1

constexpr int D = 1024, NB = 2, T = 8192, TC = 256;
constexpr int ML = NB * T;
constexpr int MC = NB * TC;
constexpr int MR = ML + MC;
constexpr int NIN = 2672, NINP = 2816;
constexpr int NE = 16, DEXP = 512, CAPL = 1024, CAPC = 32;
constexpr int NPAIR = NB * NE * CAPL + NB * NE * CAPC;
constexpr int TK = TC + T;
constexpr float EPS = 1e-6f;
constexpr int NT = 512;
constexpr int PC_Q = 0, PC_KV = 192, PC_KR = 320, PC_GQ = 352, PC_GK = 864, PC_GV = 1376, PC_Z = 1888, PC_A = 2400, PC_B = 2408, PC_POOL = 2416;
constexpr int PC_OF = 352, PC_OB = 864;

typedef unsigned short bf16_t;
__device__ __forceinline__ float bf2f(bf16_t b) { return __uint_as_float(((unsigned)b) << 16); }
__device__ __forceinline__ bf16_t f2bf(float f) { unsigned u = __float_as_uint(f); u += 0x7FFFu + ((u >> 16) & 1u); return (bf16_t)(u >> 16); }
__device__ __forceinline__ float silu_f(float x) { return x * __builtin_amdgcn_rcpf(1.0f + __expf(-x)); }
__device__ __forceinline__ float sigmoid_f(float x) { return 1.0f / (1.0f + expf(-x)); }
__device__ __forceinline__ float softplus_f(float x) {
  if (x > 20.f) return x;
  const float y = __expf(x);
  return y < 0.0625f ? y * (1.f - y * (0.5f - y * (0.333333343f - 0.25f * y))) : __logf(1.f + y);
}

typedef float f4v_t __attribute__((ext_vector_type(4))); typedef unsigned u2v_t __attribute__((ext_vector_type(2))); typedef unsigned u4v_t __attribute__((ext_vector_type(4)));
__device__ __forceinline__ float4 ld_nt_f4(const float* q) { const f4v_t v = __builtin_nontemporal_load((const f4v_t*)q); return make_float4(v[0], v[1], v[2], v[3]); }
__device__ __forceinline__ uint2 ld_nt_u2(const void* q) { const u2v_t v = __builtin_nontemporal_load((const u2v_t*)q); return make_uint2(v[0], v[1]); }
__device__ __forceinline__ uint4 ld_nt_u4(const void* q) { const u4v_t v = __builtin_nontemporal_load((const u4v_t*)q); return make_uint4(v[0], v[1], v[2], v[3]); }
__device__ __forceinline__ void st_nt_f4(float* q, const float4 v) { const f4v_t w = {v.x, v.y, v.z, v.w}; __builtin_nontemporal_store(w, (f4v_t*)q); }
constexpr size_t al256(size_t x) { return (x + 255) / 256 * 256; }
constexpr size_t OFF_BAR = 0;
constexpr size_t OFF_MOD = 16384;
constexpr size_t OFF_XC = al256(OFF_MOD + 2 * 3 * 6144 * 4);
constexpr size_t OFF_AFFT = al256(OFF_XC + (size_t)MC * D * 4);
constexpr size_t OFF_IDX = al256(OFF_AFFT + (size_t)NE * MR * 4);
constexpr size_t OFF_GATE = al256(OFF_IDX + (size_t)NPAIR * 4);
constexpr size_t OFF_SLOT = al256(OFF_GATE + (size_t)NPAIR * 4);
constexpr size_t OFF_GB = al256(OFF_SLOT + (size_t)MR * 16 * 4);
constexpr size_t OFF_H = al256(OFF_GB + (size_t)MR * 16 * 4);
constexpr size_t OFF_P = al256(OFF_H + (size_t)MR * D * 2);
constexpr size_t OFF_RB = al256(OFF_P + (size_t)MR * NINP * 2);
constexpr size_t RB_BYTES = (size_t)1056 * 100352;
constexpr size_t OFF_QKV = al256(OFF_RB + RB_BYTES);
constexpr size_t QK_ELEMS = (size_t)NB * 4 * TK * 128, V_ELEMS = (size_t)NB * 4 * TK * 64;
constexpr size_t OFF_WINT = al256(OFF_QKV + (2 * QK_ELEMS + V_ELEMS) * 2);
constexpr size_t OFF_WOUTT = al256(OFF_WINT + (size_t)2 * NINP * D * 2);
constexpr size_t OFF_WUP = al256(OFF_WOUTT + (size_t)2 * D * D * 2);
constexpr size_t OFF_MOEGU = al256(OFF_WUP + (size_t)2 * 1024 * 256 * 2);
constexpr size_t OFF_MOED = OFF_MOEGU + (size_t)NE * D * D * 2;
constexpr size_t OFF_END = al256(OFF_MOED + (size_t)NE * D * DEXP * 2);
constexpr size_t OFF_UPRAW = OFF_MOEGU;
constexpr size_t OFF_OPART = OFF_MOEGU;
constexpr size_t OFF_MLPART = OFF_OPART + (size_t)4 * ML * 256 * 2;
static_assert(OFF_MLPART + (size_t)4 * ML * 4 * 2 * 4 <= OFF_END, "partials must fit in the MoE weight region");
constexpr size_t OFF_HID = OFF_RB + (size_t)64 * 1024 * 1024;
constexpr size_t OFF_Y = OFF_P;
constexpr size_t OFF_YO = OFF_P;
constexpr size_t OFF_XS = OFF_P;


struct Params {
  const float* x; const float* c; const float* ctx; const float* c_ctx; const float* ada_w; const float* ada_b;
  const float* norm1_g; const float* norm2_g; const float* w_in; const float* q_a_norm; const float* w_uq; const float* kv_a_norm;
  const float* w_ukv; const float* q_norm; const float* k_norm; const float* conv_w; const float* a_log; const float* dt_bias;
  const float* gdn_norm_g; const float* pool_w; const float* pool_scale; const float* w_out; const float* router;
  const float* w_gate; const float* w_up; const float* w_down;
  float* out; char* ws;
};

__device__ __forceinline__ const float* xrow_src(const Params& p, int r, int l) { return l == 0 ? (r < ML ? p.x + (size_t)r * D : p.ctx + (size_t)(r - ML) * D) : (r < ML ? p.out + (size_t)r * D : (const float*)(p.ws + OFF_XC) + (size_t)(r - ML) * D); }
__device__ __forceinline__ float* xrow(const Params& p, int r) { return r < ML ? p.out + (size_t)r * D : (float*)(p.ws + OFF_XC) + (size_t)(r - ML) * D; }
__device__ __forceinline__ void rowinfo(int r, int& mj, int& t, int& tlen, int& r0) {
  if (r < ML) { mj = r >> 13; t = r & (T - 1); tlen = T; r0 = r - t; } else { int rc = r - ML; mj = 2; t = rc & (TC - 1); tlen = TC; r0 = r - t; }
}
__device__ __forceinline__ const float* modvec(const Params& p, int l, int mj, int chunk) { return (const float*)(p.ws + OFF_MOD) + ((size_t)(l * 3 + mj) * 6 + chunk) * D; }
__device__ __forceinline__ int pair_base(int s, int e) { return s < 2 ? (s * NE + e) * CAPL : NB * NE * CAPL + ((s - 2) * NE + e) * CAPC; }
__device__ __forceinline__ float wave_sum(float v) { for (int o = 32; o > 0; o >>= 1) v += __shfl_xor(v, o); return v; }

__device__ __forceinline__ int ltid() { int t = threadIdx.x; asm volatile("" : "+v"(t)); return t; }
__device__ __forceinline__ int lbid() { int t = blockIdx.x; asm volatile("" : "+s"(t)); return t; }
#define XB_TMO      128
#define XB_XCNT(j)  (256  + 64 * (j))
#define XB_XSUB(j)  (1280 + 64 * (j))
#define XB_XGEN(j)  (2304 + 64 * (j))
#define XB_TOP      3328
#define XB_TOPGEN   3392
#define XCD_BAR_WORDS 3456
#define XB_SPIN_CAP (1u << 22)
#define LAS __attribute__((address_space(3)))
__device__ __forceinline__ unsigned xb_ld(unsigned* p)              { return __hip_atomic_load(p, __ATOMIC_RELAXED, __HIP_MEMORY_SCOPE_AGENT); }
__device__ __forceinline__ unsigned xb_add(unsigned* p, unsigned v) { return __hip_atomic_fetch_add(p, v, __ATOMIC_RELAXED, __HIP_MEMORY_SCOPE_AGENT); }
__device__ __forceinline__ unsigned xb_xcc_id() { return (unsigned)__builtin_amdgcn_s_getreg((3 << 11) | 20) & 0xFu; }
#define XB_SPIN(cond, bar) do { unsigned _sp = 0; while (cond) { __builtin_amdgcn_s_sleep(1); \
    if ((++_sp & 255u) == 0u) { if (xb_ld(&(bar)[XB_TMO])) break; if (_sp > XB_SPIN_CAP) { atomicAdd(&(bar)[XB_TMO], 1u); break; } } } } while (0)
struct XcdBarrier { unsigned* bar; unsigned x; volatile LAS unsigned* st; };
__device__ __forceinline__ XcdBarrier xcd_barrier_post(unsigned* bar, volatile LAS unsigned* st) {
  XcdBarrier b; b.bar = bar; b.x = xb_xcc_id(); b.st = st;
  if (threadIdx.x == 0) (void)xb_add(&bar[XB_XCNT(b.x)], 1u);
  return b;
}
__device__ __forceinline__ void xcd_barrier_complete(unsigned* bar, unsigned x, unsigned& nloc, unsigned& nx) {
  const unsigned G = gridDim.x * gridDim.y * gridDim.z;
  unsigned sum, cnt, mine, sp = 0u;
  for (;;) {
    sum = 0u; cnt = 0u; mine = 0u;
#pragma unroll
    for (unsigned j = 0; j < 16; ++j) { const unsigned c = xb_ld(&bar[XB_XCNT(j)]); sum += c; cnt += (c > 0u) ? 1u : 0u; mine = (j == x) ? c : mine; }
    if (sum == G) break;
    __builtin_amdgcn_s_sleep(1);
    if ((++sp & 255u) == 0u) { if (xb_ld(&bar[XB_TMO])) break; if (sp > XB_SPIN_CAP) { atomicAdd(&bar[XB_TMO], 1u); break; } }
  }
  nloc = mine > 0u ? mine : 1u; nx = cnt > 0u ? cnt : 1u;
}
__device__ __forceinline__ void xcd_barrier(const XcdBarrier& b) {
  asm volatile("s_waitcnt vmcnt(0)" ::: "memory");
  __syncthreads();
  if (threadIdx.x == 0) {
    unsigned* bar = b.bar;
    __builtin_amdgcn_s_waitcnt(0);
    unsigned nloc = b.st[0], nx = b.st[1];
    if (nloc == 0u) { xcd_barrier_complete(bar, b.x, nloc, nx); b.st[0] = nloc; b.st[1] = nx; }
    const unsigned old = xb_add(&bar[XB_XSUB(b.x)], 1u);
    const unsigned gen = old / nloc;
    if (old + 1u == (gen + 1u) * nloc) {
      __builtin_amdgcn_fence(__ATOMIC_RELEASE, "agent");
      asm volatile("s_waitcnt vmcnt(0)" ::: "memory");
      const unsigned og = xb_add(&bar[XB_TOP], 1u);
      const unsigned tg = og / nx;
      if (og + 1u == (tg + 1u) * nx) xb_add(&bar[XB_TOPGEN], 1u);
      else XB_SPIN(xb_ld(&bar[XB_TOPGEN]) == tg, bar);
      __builtin_amdgcn_fence(__ATOMIC_ACQUIRE, "agent");
      xb_add(&bar[XB_XGEN(b.x)], 1u);
      asm volatile("s_waitcnt vmcnt(0)" ::: "memory");
    } else {
      XB_SPIN(xb_ld(&bar[XB_XGEN(b.x)]) == gen, bar);
      __builtin_amdgcn_fence(__ATOMIC_ACQUIRE, "agent");
      asm volatile("s_waitcnt vmcnt(0)" ::: "memory");
    }
  }
  __syncthreads();
}


namespace pg8 {
#define PG8_LAS __attribute__((address_space(3)))
typedef short bf16x8 __attribute__((ext_vector_type(8)));
typedef float f32x4 __attribute__((ext_vector_type(4)));
typedef unsigned u32x4 __attribute__((ext_vector_type(4)));
constexpr int BM = 256, BK = 64, HALF = 128, HTB = HALF * BK * 2, STAGE_BYTES = 8 * HTB, NXCD = 8, WGM = 8;
__host__ __device__ __forceinline__ int lds_byte(int r, int c) { const int st = (r >> 4) * 2 + (c >> 5), rr = r & 15, cc = c & 31, ob = rr * 64 + cc * 2; return st * 1024 + (ob ^ (((ob >> 9) & 1) << 5)); }
__host__ __device__ __forceinline__ void stage_rc(int b, int& R, int& C) { const int st = b / 1024, sb = b % 1024, swz = sb ^ (((sb >> 9) & 1) << 5); R = (st >> 1) * 16 + swz / 64; C = (st & 1) * 32 + (swz % 64) / 2; }
__host__ __device__ __forceinline__ int perm32(int rho) { const int n = rho >> 4, i = rho & 15; return 8 * (i >> 2) + 4 * n + (i & 3); }
struct Unit { int pm, pn; };
__device__ __forceinline__ unsigned cvt_pk_bf16(float lo, float hi) { unsigned r; asm volatile("v_cvt_pk_bf16_f32 %0, %1, %2" : "=v"(r) : "v"(lo), "v"(hi)); return r; }
struct GridOrder {
  int nM, nN, nwg, G, c;
  __device__ __forceinline__ void init(int nM_, int nN_, int G_, int c_) { nM = nM_; nN = nN_; nwg = nM * nN; G = G_; c = c_; }
  __device__ __forceinline__ bool next(int i, Unit& u) const {
    const long L = (long)i * G + c; if (L >= nwg) return false;
    int wgid = (int)L; { const int q = nwg / NXCD, r = nwg % NXCD, xcd = wgid % NXCD, off = wgid / NXCD; wgid = (xcd < r ? xcd * (q + 1) : r * (q + 1) + (xcd - r) * q) + off; }
    const int nig = WGM * nN, gid = wgid / nig, fm = gid * WGM, gsz = (nM - fm) < WGM ? (nM - fm) : WGM;
    u.pm = fm + ((wgid % nig) % gsz); u.pn = (wgid % nig) / gsz; return true;
  }
};
template <class Epi, class Sched, bool GATHER = false>
__device__ __forceinline__ void gemm_phase(PG8_LAS unsigned char* lds, const Sched& S, const Epi& E) {
  const int tid = ltid(), wid = __builtin_amdgcn_readfirstlane(tid >> 6), lane = tid & 63, wr = wid >> 2, wc = wid & 3, fr = lane & 15, fq = lane >> 4;
  const int K = S.K, nt = K / BK;
  unsigned voffA[2], voffB[2]; int RA[2], CA[2];
#pragma unroll
  for (int i = 0; i < 2; ++i) { int R, C; stage_rc(tid * 16 + i * 8192, R, C); const int Rb = Epi::PERM ? ((R & ~31) + perm32(R & 31)) : R;
    voffA[i] = (unsigned)(R * S.lda + C) * 2u; voffB[i] = (unsigned)(Rb * S.ldb + C) * 2u; RA[i] = R; CA[i] = C; }
  const size_t kstep = (size_t)(BK * 2);
  const size_t hstepA = GATHER ? 0 : (size_t)HALF * S.lda * 2, hstepB = (size_t)HALF * S.ldb * 2;
  unsigned vc[2][2], vn[2][2];
#define PG8_GOFF(dst, unit) do { if (GATHER) { _Pragma("unroll") for (int _h = 0; _h < 2; ++_h) _Pragma("unroll") for (int _i = 0; _i < 2; ++_i) \
    dst[_h][_i] = (unsigned)(S.gidx[(unit).pm * 256 + _h * HALF + RA[_i]] * S.lda + CA[_i]) * 2u; } } while (0)
#define PG8_STAGE_A(bufoff, gbase, half, usenext) do { if (GATHER) { unsigned _v[2] = {(usenext) ? vn[half][0] : vc[half][0], (usenext) ? vn[half][1] : vc[half][1]}; PG8_STAGE(bufoff, gbase, _v); } \
    else PG8_STAGE(bufoff, gbase, voffA); } while (0)
  const unsigned ldsw = (unsigned)wid * 1024u;
  const int aoff = lds_byte(wr * 64 + fr, fq * 8), boff = lds_byte(wc * 32 + fr, fq * 8);
#define PG8_SA(b, h) (((b) * 2 + (h)) * HTB)
#define PG8_SB(b, h) ((4 + (b) * 2 + (h)) * HTB)
#define PG8_STAGE(bufoff, gbase, voff) do { _Pragma("unroll") for (int _i = 0; _i < 2; ++_i) \
    __builtin_amdgcn_global_load_lds((const unsigned*)((const char*)(gbase) + (voff)[_i]), (PG8_LAS unsigned*)(lds + (bufoff) + ldsw + _i * 8192), 16, 0, 0); } while (0)
#define PG8_LDA(dst, b, h) do { _Pragma("unroll") for (int m = 0; m < 4; ++m) _Pragma("unroll") for (int k = 0; k < 2; ++k) dst[m][k] = *(const PG8_LAS bf16x8*)(lds + PG8_SA(b, h) + aoff + m * 2048 + k * 1024); } while (0)
#define PG8_LDB(dst, b, h) do { _Pragma("unroll") for (int n = 0; n < 2; ++n) _Pragma("unroll") for (int k = 0; k < 2; ++k) dst[n][k] = *(const PG8_LAS bf16x8*)(lds + PG8_SB(b, h) + boff + n * 2048 + k * 1024); } while (0)
#define PG8_MMA(ai, bj, At, Bt) do { __builtin_amdgcn_s_setprio(1); _Pragma("unroll") for (int m = 0; m < 4; ++m) _Pragma("unroll") for (int n = 0; n < 2; ++n) _Pragma("unroll") for (int k = 0; k < 2; ++k) \
    acc[ai][bj][m][n] = __builtin_amdgcn_mfma_f32_16x16x32_bf16(Bt[n][k], At[m][k], acc[ai][bj][m][n], 0, 0, 0); __builtin_amdgcn_s_setprio(0); } while (0)
#define PG8_WAIT_V(n) asm volatile("s_waitcnt vmcnt(" #n ")" ::: "memory")
#define PG8_WAIT_L(n) asm volatile("s_waitcnt lgkmcnt(" #n ")" ::: "memory")
#define PG8_BAR __builtin_amdgcn_s_barrier()
#define PG8_SCHED __builtin_amdgcn_sched_barrier(0)
  Unit cur, nxt; int ui = 0;
  if (!S.next(0, cur)) return;
  f32x4 acc[2][2][4][2];
#pragma unroll
  for (int a = 0; a < 2; ++a)
#pragma unroll
    for (int b = 0; b < 2; ++b)
#pragma unroll
      for (int m = 0; m < 4; ++m)
#pragma unroll
        for (int n = 0; n < 2; ++n) acc[a][b][m][n] = (f32x4){0.f, 0.f, 0.f, 0.f};
  bf16x8 At[4][2], B0[2][2], B1[2][2];
  const char* cA = S.a_ptr(cur); const char* cB = S.b_ptr(cur);
  PG8_GOFF(vc, cur);
  PG8_STAGE(PG8_SB(0, 0), cB, voffB); PG8_STAGE_A(PG8_SA(0, 0), cA, 0, false); PG8_STAGE(PG8_SB(0, 1), cB + hstepB, voffB); PG8_STAGE_A(PG8_SA(0, 1), cA + hstepA, 1, false);
  if (wr == 1) PG8_BAR;
  PG8_WAIT_V(4); PG8_BAR;
  PG8_STAGE(PG8_SB(1, 0), cB + kstep, voffB); PG8_STAGE_A(PG8_SA(1, 0), cA + kstep, 0, false); PG8_STAGE(PG8_SB(1, 1), cB + hstepB + kstep, voffB);
  PG8_WAIT_V(6); PG8_BAR;
  for (;;) {
    const bool has_next = S.next(ui + 1, nxt);
    const char* nA = has_next ? S.a_ptr(nxt) : cA; const char* nB = has_next ? S.b_ptr(nxt) : cB;
    if (has_next) PG8_GOFF(vn, nxt); else { _Pragma("unroll") for (int _h = 0; _h < 2; ++_h) _Pragma("unroll") for (int _i = 0; _i < 2; ++_i) vn[_h][_i] = vc[_h][_i]; }
    for (int t = 0; t < nt; t += 2) {
      const bool last = (t == nt - 2);
      const char* a1 = cA + (size_t)(t + 1) * kstep;
      const char* a2 = last ? nA : cA + (size_t)(t + 2) * kstep; const char* b2 = last ? nB : cB + (size_t)(t + 2) * kstep;
      const char* a3 = a2 + kstep; const char* b3 = b2 + kstep;
      PG8_LDB(B0, 0, 0); PG8_SCHED; PG8_LDA(At, 0, 0); PG8_STAGE_A(PG8_SA(1, 1), a1 + hstepA, 1, false);
      PG8_WAIT_L(8); PG8_BAR; PG8_WAIT_L(0); PG8_MMA(0, 0, At, B0); PG8_BAR; PG8_SCHED;
      PG8_LDB(B1, 0, 1); PG8_STAGE(PG8_SB(0, 0), b2, voffB);
      PG8_BAR; PG8_WAIT_L(0); PG8_MMA(0, 1, At, B1); PG8_BAR;
      PG8_LDA(At, 0, 1); PG8_STAGE_A(PG8_SA(0, 0), a2, 0, last);
      PG8_BAR; PG8_WAIT_L(0); PG8_MMA(1, 0, At, B0); PG8_BAR; PG8_SCHED;
      PG8_STAGE(PG8_SB(0, 1), b2 + hstepB, voffB);
      PG8_WAIT_V(6); PG8_BAR; PG8_MMA(1, 1, At, B1); PG8_BAR;
      PG8_LDB(B0, 1, 0); PG8_SCHED; PG8_LDA(At, 1, 0); PG8_STAGE_A(PG8_SA(0, 1), a2 + hstepA, 1, last);
      PG8_WAIT_L(8); PG8_BAR; PG8_WAIT_L(0); PG8_MMA(0, 0, At, B0); PG8_BAR; PG8_SCHED;
      PG8_LDB(B1, 1, 1); PG8_STAGE(PG8_SB(1, 0), b3, voffB);
      PG8_BAR; PG8_WAIT_L(0); PG8_MMA(0, 1, At, B1); PG8_BAR;
      PG8_LDA(At, 1, 1); PG8_STAGE_A(PG8_SA(1, 0), a3, 0, last);
      PG8_BAR; PG8_WAIT_L(0); PG8_MMA(1, 0, At, B0); PG8_BAR; PG8_SCHED;
      PG8_STAGE(PG8_SB(1, 1), b3 + hstepB, voffB);
      PG8_WAIT_V(6); PG8_BAR; PG8_MMA(1, 1, At, B1); PG8_BAR;
    }
    E(acc, cur, wr, wc, fr, fq);
    if (!has_next) break;
#pragma unroll
    for (int a = 0; a < 2; ++a)
#pragma unroll
      for (int b = 0; b < 2; ++b)
#pragma unroll
        for (int m = 0; m < 4; ++m)
#pragma unroll
          for (int n = 0; n < 2; ++n) acc[a][b][m][n] = (f32x4){0.f, 0.f, 0.f, 0.f};
    cur = nxt; cA = nA; cB = nB; ++ui;
    _Pragma("unroll") for (int _h = 0; _h < 2; ++_h) _Pragma("unroll") for (int _i = 0; _i < 2; ++_i) vc[_h][_i] = vn[_h][_i];
  }
  PG8_WAIT_V(0);
  if (wr == 0) PG8_BAR;
  PG8_BAR;
#undef PG8_SA
#undef PG8_SB
#undef PG8_STAGE
#undef PG8_STAGE_A
#undef PG8_GOFF
#undef PG8_LDA
#undef PG8_LDB
#undef PG8_MMA
#undef PG8_WAIT_V
#undef PG8_WAIT_L
#undef PG8_BAR
#undef PG8_SCHED
}
}

struct DenseSched : pg8::GridOrder {
  const char* A; const char* Bt; int lda, ldb, K; const int* gidx;
  __device__ __forceinline__ const char* a_ptr(const pg8::Unit& u) const { return A + (size_t)u.pm * 256 * lda * 2; }
  __device__ __forceinline__ const char* b_ptr(const pg8::Unit& u) const { return Bt + (size_t)u.pn * 256 * ldb * 2; }
};
struct EpiStoreBf16 {
  static constexpr bool PERM = true, AFTER_DRAIN = false;
  bf16_t* O; int ldc;
  __device__ __forceinline__ void operator()(const pg8::f32x4 (&acc)[2][2][4][2], const pg8::Unit& u, int wr, int wc, int fr, int fq) const {
    const int row0 = u.pm * 256 + wr * 64 + fr, col0 = u.pn * 256 + wc * 32 + 8 * fq;
#pragma unroll
    for (int ai = 0; ai < 2; ++ai)
#pragma unroll
      for (int m = 0; m < 4; ++m) { bf16_t* rowp = O + (size_t)(row0 + ai * 128 + m * 16) * ldc + col0;
#pragma unroll
        for (int bj = 0; bj < 2; ++bj) { const pg8::f32x4 v0 = acc[ai][bj][m][0], v1 = acc[ai][bj][m][1];
          pg8::u32x4 w; w.x = pg8::cvt_pk_bf16(v0[0], v0[1]); w.y = pg8::cvt_pk_bf16(v0[2], v0[3]); w.z = pg8::cvt_pk_bf16(v1[0], v1[1]); w.w = pg8::cvt_pk_bf16(v1[2], v1[3]);
          *(pg8::u32x4*)(rowp + bj * 128) = w; } }
  }
};
struct EpiResidual {
  static constexpr bool PERM = false, AFTER_DRAIN = false;
  float* xl; float* xc; const float* mod;
  int chunk;
  __device__ __forceinline__ void operator()(const pg8::f32x4 (&acc)[2][2][4][2], const pg8::Unit& u, int wr, int wc, int fr, int fq) const {
    const int mj = u.pm < 32 ? 0 : (u.pm < 64 ? 1 : 2);
    float* base = u.pm < 64 ? xl + (size_t)u.pm * 256 * D : xc + (size_t)(u.pm - 64) * 256 * D;
    const float* gv = mod + ((size_t)mj * 6 + chunk) * D;
    const int row0 = wr * 64 + fr, col0 = u.pn * 256 + wc * 32 + 4 * fq;
#pragma unroll
    for (int bj = 0; bj < 2; ++bj)
#pragma unroll
      for (int n = 0; n < 2; ++n) {
        const pg8::f32x4 g = *(const pg8::f32x4*)(gv + col0 + bj * 128 + n * 16);
#pragma unroll
        for (int ai = 0; ai < 2; ++ai)
#pragma unroll
          for (int m = 0; m < 4; ++m) { pg8::f32x4* q = (pg8::f32x4*)(base + (size_t)(row0 + ai * 128 + m * 16) * D + col0 + bj * 128 + n * 16); *q = *q + g * acc[ai][bj][m][n]; }
      }
  }
};
struct MoeSched : pg8::GridOrder {
  const char* A; const char* Bt; int lda, ldb, K; size_t bstride;
  const int* gidx; bool gather;
  __device__ __forceinline__ const char* a_ptr(const pg8::Unit& u) const { return gather ? A : A + (size_t)u.pm * 256 * lda * 2; }
  __device__ __forceinline__ const char* b_ptr(const pg8::Unit& u) const { return Bt + (size_t)((u.pm >> 2) & 15) * bstride + (size_t)u.pn * 256 * ldb * 2; }
};
struct EpiSwiGLU {
  static constexpr bool PERM = true, AFTER_DRAIN = false;
  bf16_t* O;
  __device__ __forceinline__ void operator()(const pg8::f32x4 (&acc)[2][2][4][2], const pg8::Unit& u, int wr, int wc, int fr, int fq) const {
    const int row0 = u.pm * 256 + wr * 64 + fr, col0 = u.pn * 128 + wc * 16 + 4 * fq;
#pragma unroll
    for (int ai = 0; ai < 2; ++ai)
#pragma unroll
      for (int m = 0; m < 4; ++m) { bf16_t* rowp = O + (size_t)(row0 + ai * 128 + m * 16) * DEXP + col0;
#pragma unroll
        for (int bj = 0; bj < 2; ++bj) { const pg8::f32x4 v0 = acc[ai][bj][m][0], v1 = acc[ai][bj][m][1];
          const float h0 = silu_f(v0[0]) * v0[1], h1 = silu_f(v0[2]) * v0[3], h2 = silu_f(v1[0]) * v1[1], h3 = silu_f(v1[2]) * v1[3];
          uint2 w; w.x = pg8::cvt_pk_bf16(h0, h1); w.y = pg8::cvt_pk_bf16(h2, h3);
          *(uint2*)(rowp + bj * 64) = w; } }
  }
};
struct EpiGateBf16 {
  static constexpr bool PERM = true, AFTER_DRAIN = false;
  bf16_t* O; const float* gate;
  __device__ __forceinline__ void operator()(const pg8::f32x4 (&acc)[2][2][4][2], const pg8::Unit& u, int wr, int wc, int fr, int fq) const {
    const int row0 = u.pm * 256 + wr * 64 + fr, col0 = u.pn * 256 + wc * 32 + 8 * fq;
#pragma unroll
    for (int ai = 0; ai < 2; ++ai)
#pragma unroll
      for (int m = 0; m < 4; ++m) { const int row = row0 + ai * 128 + m * 16; const float g = gate[row]; bf16_t* rowp = O + (size_t)row * D + col0;
#pragma unroll
        for (int bj = 0; bj < 2; ++bj) { const pg8::f32x4 v0 = acc[ai][bj][m][0] * g, v1 = acc[ai][bj][m][1] * g;
          pg8::u32x4 w; w.x = pg8::cvt_pk_bf16(v0[0], v0[1]); w.y = pg8::cvt_pk_bf16(v0[2], v0[3]); w.z = pg8::cvt_pk_bf16(v1[0], v1[1]); w.w = pg8::cvt_pk_bf16(v1[2], v1[3]);
          *(pg8::u32x4*)(rowp + bj * 128) = w; } }
  }
};

namespace fa {
using bf16x8 = __attribute__((ext_vector_type(8))) short;
using s16x4  = __attribute__((ext_vector_type(4))) short;
using f32x16 = __attribute__((ext_vector_type(16))) float;
using u32x4  = __attribute__((ext_vector_type(4))) unsigned;
constexpr int NW = 8, QBLK = 32, KVBLK = 64, LDQK = 128, LDV = 64;
constexpr float SCALE = 0.10206207261596575f;
constexpr float THR = 8.f;
constexpr size_t SHM_V = KVBLK * 64 * 2, SHM_K = KVBLK * 128 * 2, SHM_ATTN = 2 * SHM_V + 2 * SHM_K + NW * 64 * 4;
#define FA_KSWZ(row, colB) ((row) * 256 + ((colB) ^ (((row) & 7) << 4)))
#define FA_SBAR() __builtin_amdgcn_sched_barrier(0)
__device__ __forceinline__ int crow(int r, int hi) { return (r & 3) + 8 * (r >> 2) + 4 * hi; }
__device__ __forceinline__ unsigned cvtpk(float lo, float hi) { unsigned r; asm volatile("v_cvt_pk_bf16_f32 %0, %1, %2" : "=v"(r) : "v"(lo), "v"(hi)); return r; }
__device__ __forceinline__ void partialSM(f32x16& p0, f32x16& p1, float& m_reg, float& mn, float& alpha) {
  constexpr float C = SCALE * 1.4426950408889634f;
  float pmax = p0[0];
#pragma unroll
  for (int r = 1; r < 16; ++r) pmax = fmaxf(pmax, p0[r]);
#pragma unroll
  for (int r = 0; r < 16; ++r) pmax = fmaxf(pmax, p1[r]);
  { auto rr = __builtin_amdgcn_permlane32_swap(__float_as_uint(pmax), __float_as_uint(pmax), false, false);
    pmax = fmaxf(__uint_as_float(rr[0]), __uint_as_float(rr[1])); }
  if (__builtin_expect(__all(pmax - m_reg <= THR / SCALE), 1)) { mn = m_reg; alpha = 1.f; }
  else { mn = fmaxf(m_reg, pmax); alpha = __builtin_amdgcn_exp2f((m_reg - mn) * C); m_reg = mn; }
  float mnC = -mn * C;
  p0 = p0 * C + mnC; p1 = p1 * C + mnC;
#pragma unroll
  for (int r = 0; r < 16; ++r) p0[r] = __builtin_amdgcn_exp2f(p0[r]);
}
__device__ __forceinline__ void finishSM(f32x16& p0, f32x16& p1, float alpha, float& l_reg, bf16x8& pa0, bf16x8& pa1, bf16x8& pa2, bf16x8& pa3) {
#pragma unroll
  for (int r = 0; r < 16; ++r) p1[r] = __builtin_amdgcn_exp2f(p1[r]);
  float ps;
  { const f32x16 t = p0 + p1; const auto t8 = t.lo + t.hi; const auto t4 = t8.lo + t8.hi; const auto t2 = t4.lo + t4.hi; ps = t2.x + t2.y; }
  { auto rr = __builtin_amdgcn_permlane32_swap(__float_as_uint(ps), __float_as_uint(ps), false, false);
    ps = __uint_as_float(rr[0]) + __uint_as_float(rr[1]); }
  l_reg = l_reg * alpha + ps;
#define FA_PK4(P, BASE, OUT) do { unsigned a0 = cvtpk(P[BASE + 0], P[BASE + 1]), a1 = cvtpk(P[BASE + 2], P[BASE + 3]);   \
    unsigned b0 = cvtpk(P[BASE + 4], P[BASE + 5]), b1 = cvtpk(P[BASE + 6], P[BASE + 7]);                              \
    auto r0 = __builtin_amdgcn_permlane32_swap(a0, b0, false, false); auto r1 = __builtin_amdgcn_permlane32_swap(a1, b1, false, false); \
    u32x4 w = {r0[0], r1[0], r0[1], r1[1]}; OUT = *reinterpret_cast<bf16x8*>(&w); } while (0)
  FA_PK4(p0, 0, pa0); FA_PK4(p0, 8, pa1); FA_PK4(p1, 0, pa2); FA_PK4(p1, 8, pa3);
#undef FA_PK4
}
__device__ __forceinline__ void qkt(f32x16& p0, f32x16& p1, const char* Ks, const bf16x8* qr, int r32, int hi) {
  p0 = f32x16{}; p1 = f32x16{};
#pragma unroll
  for (int d0 = 0; d0 < 6; ++d0) { int cb = (d0 * 16 + hi * 8) * 2;
    bf16x8 b0 = *reinterpret_cast<const bf16x8*>(Ks + FA_KSWZ(r32, cb));
    bf16x8 b1 = *reinterpret_cast<const bf16x8*>(Ks + FA_KSWZ(32 + r32, cb));
    p0 = __builtin_amdgcn_mfma_f32_32x32x16_bf16(b0, qr[d0], p0, 0, 0, 0);
    p1 = __builtin_amdgcn_mfma_f32_32x32x16_bf16(b1, qr[d0], p1, 0, 0, 0); }
}
__device__ __forceinline__ int v_st(int k, int c) { const int kk = (k & ~0xC) | ((k & 4) << 1) | ((k & 8) >> 1); return ((kk >> 3) * 2 + (c >> 5)) * 512 + ((kk & 7) * 32 + (c & 31)) * 2; }
__device__ __forceinline__ int v_rd_base(int lane) { return ((lane & 3) << 3) | (((lane >> 2) & 3) << 6) | (((lane >> 4) & 1) << 5) | (((lane >> 5) & 1) << 8); }
constexpr int v_rd_off(int d0, int ks, int half) { return d0 * 512 + ks * 2048 + half * 1024; }
template <int OFF> __device__ __forceinline__ s16x4 tr_read(int vb) {
  s16x4 r; asm volatile("ds_read_b64_tr_b16 %0, %1 offset:%2" : "=&v"(r) : "v"(vb), "i"(OFF) : "memory"); return r;
}
template <int D0> __device__ __forceinline__ void pv_one(f32x16& od, int vb, bf16x8 pa0, bf16x8 pa1, bf16x8 pa2, bf16x8 pa3) {
  const s16x4 l0 = tr_read<v_rd_off(D0, 0, 0)>(vb), h0 = tr_read<v_rd_off(D0, 0, 1)>(vb), l1 = tr_read<v_rd_off(D0, 1, 0)>(vb), h1 = tr_read<v_rd_off(D0, 1, 1)>(vb);
  const s16x4 l2 = tr_read<v_rd_off(D0, 2, 0)>(vb), h2 = tr_read<v_rd_off(D0, 2, 1)>(vb), l3 = tr_read<v_rd_off(D0, 3, 0)>(vb), h3 = tr_read<v_rd_off(D0, 3, 1)>(vb);
  asm volatile("s_waitcnt lgkmcnt(0)" ::: "memory"); FA_SBAR();
#define FA_PK(L, H) (bf16x8){L[0], L[1], L[2], L[3], H[0], H[1], H[2], H[3]}
  od = __builtin_amdgcn_mfma_f32_32x32x16_bf16(pa0, FA_PK(l0, h0), od, 0, 0, 0);
  od = __builtin_amdgcn_mfma_f32_32x32x16_bf16(pa1, FA_PK(l1, h1), od, 0, 0, 0);
  od = __builtin_amdgcn_mfma_f32_32x32x16_bf16(pa2, FA_PK(l2, h2), od, 0, 0, 0);
  od = __builtin_amdgcn_mfma_f32_32x32x16_bf16(pa3, FA_PK(l3, h3), od, 0, 0, 0);
#undef FA_PK
}
__device__ __forceinline__ void attn_body(const bf16_t* __restrict__ Qb, const bf16_t* __restrict__ Kh, const bf16_t* __restrict__ Vh, bf16_t* __restrict__ Ob, int ldo, int seq, char* lds, float* mlp = nullptr, int mlstride = 0) {
  const int tid = ltid(), wid = tid >> 6, lane = tid & 63, r32 = lane & 31, hi = lane >> 5;
  char* V_lds = lds; char* K_lds = lds + 2 * SHM_V;
  float* ws = (float*)(lds + 2 * SHM_V + 2 * SHM_K) + wid * 64; float* li_l = ws; float* al_l = ws + 32;
  float m_reg = -1e30f, l_reg = 0; f32x16 o[2] = {}; bf16x8 qr[6];
  const bf16_t* Qw = Qb + (long)(wid * QBLK + r32) * LDQK + hi * 8;
#pragma unroll
  for (int d0 = 0; d0 < 6; ++d0) qr[d0] = *reinterpret_cast<const bf16x8*>(Qw + d0 * 16);
  const int sr = tid >> 4, sc = (tid & 15) * 8;
  const int vr = tid >> 3, vc = (tid & 7) * 8, vst0 = v_st(vr, vc);
  const int vb0 = (int)(uintptr_t)V_lds + v_rd_base(lane);
  struct { bf16x8 vs0, ks0, ks1; } sr_[2];
#define FA_SLOAD(i, k0) do { sr_[i].vs0 = *reinterpret_cast<const bf16x8*>(&Vh[(long)((k0) + vr) * LDV + vc]); \
    sr_[i].ks0 = *reinterpret_cast<const bf16x8*>(&Kh[(long)((k0) + sr) * LDQK + sc]); sr_[i].ks1 = *reinterpret_cast<const bf16x8*>(&Kh[(long)((k0) + 32 + sr) * LDQK + sc]); } while (0)
#define FA_SWRITE(b, i) do { *(bf16x8*)(V_lds + (b) * SHM_V + vst0) = sr_[i].vs0; int kc = sc * 2;               \
    *(bf16x8*)(K_lds + (b) * SHM_K + FA_KSWZ(sr, kc)) = sr_[i].ks0;                       \
    *(bf16x8*)(K_lds + (b) * SHM_K + FA_KSWZ(32 + sr, kc)) = sr_[i].ks1; } while (0)
#define FA_SWAIT() asm volatile("s_waitcnt vmcnt(3)" ::: "memory")
#define FA_RESC(a) do { if (__any((a) < 1.f)) { if (hi == 0) al_l[r32] = (a); asm volatile("s_waitcnt lgkmcnt(0)" ::: "memory"); \
    _Pragma("unroll") for (int d = 0; d < 2; ++d) _Pragma("unroll") for (int r = 0; r < 16; ++r) o[d][r] *= al_l[crow(r, hi)]; } } while (0)
  f32x16 pA0, pA1, pB0, pB1; float mnA, mnB, alA, alB; bf16x8 pa0, pa1, pa2, pa3; const int NTL = seq / KVBLK;
  constexpr int SE = 0, SO = 1;
  __syncthreads();
  FA_SLOAD(SE, 0); asm volatile("s_waitcnt vmcnt(0)" ::: "memory"); FA_SWRITE(0, SE); __syncthreads();
  qkt(pA0, pA1, K_lds, qr, r32, hi); partialSM(pA0, pA1, m_reg, mnA, alA);
  FA_SLOAD(SO, KVBLK); if (2 < NTL) FA_SLOAD(SE, 2 * KVBLK);
  FA_SWAIT(); FA_SWRITE(1, SO); __syncthreads();
  for (int j = 1; j + 1 < NTL; j += 2) {
    FA_SBAR(); qkt(pB0, pB1, K_lds + SHM_K, qr, r32, hi);
    finishSM(pA0, pA1, alA, l_reg, pa0, pa1, pa2, pa3); FA_SBAR();
    FA_SLOAD(SO, (j + 2) * KVBLK); FA_SBAR();
    pv_one<0>(o[0], vb0, pa0, pa1, pa2, pa3); pv_one<1>(o[1], vb0, pa0, pa1, pa2, pa3); partialSM(pB0, pB1, m_reg, mnB, alB);
    __syncthreads(); FA_SWAIT(); FA_SWRITE(0, SE);
    FA_RESC(alB); __syncthreads();
    FA_SBAR(); qkt(pA0, pA1, K_lds, qr, r32, hi);
    finishSM(pB0, pB1, alB, l_reg, pa0, pa1, pa2, pa3); FA_SBAR();
    if (j + 3 < NTL) FA_SLOAD(SE, (j + 3) * KVBLK); FA_SBAR();
    pv_one<0>(o[0], vb0 + (int)SHM_V, pa0, pa1, pa2, pa3); pv_one<1>(o[1], vb0 + (int)SHM_V, pa0, pa1, pa2, pa3); partialSM(pA0, pA1, m_reg, mnA, alA);
    __syncthreads(); FA_SWAIT(); FA_SWRITE(1, SO);
    FA_RESC(alA); __syncthreads();
  }
  FA_SBAR(); qkt(pB0, pB1, K_lds + SHM_K, qr, r32, hi);
  finishSM(pA0, pA1, alA, l_reg, pa0, pa1, pa2, pa3); FA_SBAR();
  pv_one<0>(o[0], vb0, pa0, pa1, pa2, pa3); pv_one<1>(o[1], vb0, pa0, pa1, pa2, pa3); partialSM(pB0, pB1, m_reg, mnB, alB);
  __syncthreads(); FA_RESC(alB);
  finishSM(pB0, pB1, alB, l_reg, pa0, pa1, pa2, pa3); FA_SBAR();
  pv_one<0>(o[0], vb0 + (int)SHM_V, pa0, pa1, pa2, pa3); pv_one<1>(o[1], vb0 + (int)SHM_V, pa0, pa1, pa2, pa3);
  if (hi == 0) { li_l[r32] = l_reg; if (mlp) { float* q2 = mlp + (size_t)(wid * QBLK + r32) * mlstride; q2[0] = m_reg; q2[1] = l_reg; } }
  asm volatile("s_waitcnt lgkmcnt(0)" ::: "memory");
  float rli[16];
#pragma unroll
  for (int r = 0; r < 16; ++r) rli[r] = __builtin_amdgcn_rcpf(li_l[crow(r, hi)]);
  bf16_t* Ow = Ob + (long)(wid * QBLK) * ldo;
#pragma unroll
  for (int r = 0; r < 16; ++r) { int orow = crow(r, hi);
#pragma unroll
    for (int d0 = 0; d0 < 2; ++d0) Ow[(long)orow * ldo + d0 * 32 + r32] = f2bf(o[d0][r] * rli[r]); }
#undef FA_SLOAD
#undef FA_SWRITE
#undef FA_SWAIT
#undef FA_RESC
}
}

namespace gd {
using bf16x8 = __attribute__((ext_vector_type(8))) short;
using f32x4 = __attribute__((ext_vector_type(4))) float;
constexpr int NCH = 132;
constexpr size_t R_QF = 0, R_KF = 16384, R_KTF = 32768, R_VC = 49152, R_DIR = 65536, DIR_BYTES = 17408, D_TINV = 0, D_QKM = 8192, D_VEC = 16384;
constexpr size_t CHREC = R_DIR + 2 * DIR_BYTES;
__device__ __forceinline__ unsigned pk(float lo, float hi) { unsigned r; asm volatile("v_cvt_pk_bf16_f32 %0, %1, %2" : "=v"(r) : "v"(lo), "v"(hi)); return r; }
__device__ __forceinline__ bf16x8 pack8(const f32x4 a, const f32x4 b) { typedef unsigned u4 __attribute__((ext_vector_type(4))); u4 w = {pk(a[0], a[1]), pk(a[2], a[3]), pk(b[0], b[1]), pk(b[2], b[3])}; return *reinterpret_cast<bf16x8*>(&w); }
__device__ __forceinline__ int chunk_row0(int b, int c) { return c < 4 ? ML + b * TC + 64 * c : b * T + 64 * (c - 4); }
constexpr int L_Q = 0, L_K = 16384, L_V = 32768, L_KK = 49152  , L_QK = 65792, L_G = 82432  ,
              L_A = 0  , L_X0 = 32768  , L_X1 = 83968, L_AT = 100352;
__device__ __forceinline__ int swz(int row, int colB) { return row * 256 + (colB ^ ((row & 7) << 4)); }
__device__ __forceinline__ void tr_pair(int a0, int a1, uint2& lo, uint2& hi) {
  asm volatile("ds_read_b64_tr_b16 %0, %2\n\tds_read_b64_tr_b16 %1, %3\n\ts_waitcnt lgkmcnt(0)" : "=&v"(lo), "=&v"(hi) : "v"(a0), "v"(a1) : "memory");
}
__device__ __forceinline__ uint2 tr_one(int a0) {
  uint2 r; asm volatile("ds_read_b64_tr_b16 %0, %1\n\ts_waitcnt lgkmcnt(0)" : "=&v"(r) : "v"(a0) : "memory"); return r;
}

__device__ __forceinline__ void inv_offdiag(const float* A, float* X, int bi, int bj, int lane) {
  const int rc = lane & 15, g = lane >> 4;
  f32x4 t = {0.f, 0.f, 0.f, 0.f};
  for (int k = bj; k < bi; ++k) {
#pragma unroll
    for (int s4 = 0; s4 < 4; ++s4)
      t = __builtin_amdgcn_mfma_f32_16x16x4f32(A[(bi * 16 + rc) * 64 + k * 16 + s4 * 4 + g], X[(k * 16 + s4 * 4 + g) * 64 + bj * 16 + rc], t, 0, 0, 0);
  }
  f32x4 o = {0.f, 0.f, 0.f, 0.f};
#pragma unroll
  for (int r = 0; r < 4; ++r)
    o = __builtin_amdgcn_mfma_f32_16x16x4f32(X[(bi * 16 + rc) * 64 + bi * 16 + g * 4 + r], t[r], o, 0, 0, 0);
#pragma unroll
  for (int r = 0; r < 4; ++r) X[(bi * 16 + g * 4 + r) * 64 + bj * 16 + rc] = -o[r];
}
__device__ __forceinline__ void lds_barrier() { asm volatile("s_waitcnt lgkmcnt(0)" ::: "memory"); __builtin_amdgcn_s_barrier(); asm volatile("" ::: "memory"); }
constexpr int L_CW = 133120;
__device__ __forceinline__ void precompute_load(const Params& p, int b, int h, int c, int tid, uint4 (&xin)[3][4]) {
  const bf16_t* P = (const bf16_t*)(p.ws + OFF_P);
  const int row0 = chunk_row0(b, c), tlen = c < 4 ? TC : T, t0 = c < 4 ? 64 * c : 64 * (c - 4);
  const int ch8 = tid & 15, tokA = 2 * (tid >> 4);
#pragma unroll
  for (int which = 0; which < 3; ++which) {
    const int ch0 = which * 512 + h * 128 + ch8 * 8;
#pragma unroll
    for (int jj = 0; jj < 4; ++jj) { const int tt = t0 + tokA - 1 + jj;
      xin[which][jj] = (tt >= 0 && tt < tlen) ? *(const uint4*)(P + (size_t)(row0 + tokA - 1 + jj) * NINP + PC_GQ + ch0) : make_uint4(0u, 0u, 0u, 0u); }
  }
}
__device__ __forceinline__ void precompute_item(const Params& p, int l, int b, int h, int c, char* lds, int tid, const uint4 (&xin)[3][4]) {
  const int lane = tid & 63, wv = tid >> 6;
  const bf16_t* P = (const bf16_t*)(p.ws + OFF_P);
  char* rec = p.ws + OFF_RB + (size_t)((b * 4 + h) * NCH + c) * CHREC;
  const int row0 = chunk_row0(b, c);
  const int ldsb = (int)(uintptr_t)lds;
  lds_barrier();
  {
    const int ch8 = tid & 15, tg = tid >> 4, tokA = 2 * tg;
    const float* cwl = (const float*)(lds + L_CW);
#pragma unroll
    for (int which = 0; which < 3; ++which) {
      float xf[4][8];
#pragma unroll
      for (int jj = 0; jj < 4; ++jj) { const unsigned w4[4] = {xin[which][jj].x, xin[which][jj].y, xin[which][jj].z, xin[which][jj].w};
#pragma unroll
        for (int i = 0; i < 4; ++i) { xf[jj][2 * i] = __uint_as_float(w4[i] << 16); xf[jj][2 * i + 1] = __uint_as_float(w4[i] & 0xffff0000u); } }
      float wf[3][8];
#pragma unroll
      for (int j = 0; j < 3; ++j) { const float4 w0 = *(const float4*)(cwl + j * 1536 + which * 512 + h * 128 + ch8 * 8), w1 = *(const float4*)(cwl + j * 1536 + which * 512 + h * 128 + ch8 * 8 + 4);
        wf[j][0] = w0.x; wf[j][1] = w0.y; wf[j][2] = w0.z; wf[j][3] = w0.w; wf[j][4] = w1.x; wf[j][5] = w1.y; wf[j][6] = w1.z; wf[j][7] = w1.w; }
#pragma unroll
      for (int a = 0; a < 2; ++a) {
        float o[8], ss = 0.f;
#pragma unroll
        for (int i = 0; i < 8; ++i) { o[i] = silu_f(wf[0][i] * xf[a][i] + wf[1][i] * xf[a + 1][i] + wf[2][i] * xf[a + 2][i]); ss += o[i] * o[i]; }
        if (which < 2) {
          ss += __shfl_xor(ss, 1); ss += __shfl_xor(ss, 2); ss += __shfl_xor(ss, 4); ss += __shfl_xor(ss, 8);
          const float sc = rsqrtf(ss + EPS) * (which == 0 ? 0.08838834764831845f : 1.f);
#pragma unroll
          for (int i = 0; i < 8; ++i) o[i] *= sc;
        }
        uint4 w; w.x = pk(o[0], o[1]); w.y = pk(o[2], o[3]); w.z = pk(o[4], o[5]); w.w = pk(o[6], o[7]);
        *(uint4*)(lds + (which == 0 ? L_Q : (which == 1 ? L_K : L_V)) + swz(tokA + a, ch8 * 16)) = w;
      }
    }
    if (tid < 128) {
      const int d = tid >> 6, tk = tid & 63;
      const float pa = bf2f(P[(size_t)(row0 + tk) * NINP + PC_A + d * 4 + h]), pb = bf2f(P[(size_t)(row0 + tk) * NINP + PC_B + d * 4 + h]);
      float* gs = (float*)(lds + L_G);
      gs[d * 64 + tk] = -expf(p.a_log[l * 8 + d * 4 + h]) * softplus_f(pa + p.dt_bias[l * 8 + d * 4 + h]);
      gs[128 + d * 64 + tk] = sigmoid_f(pb);
    }
  }
  lds_barrier();
  if (wv == 0) {
    float* gs = (float*)(lds + L_G);
    float a0 = gs[lane], a1 = gs[64 + 63 - lane];
#pragma unroll
    for (int o = 1; o < 64; o <<= 1) { const float n0 = __shfl_up(a0, o), n1 = __shfl_up(a1, o); if (lane >= o) { a0 += n0; a1 += n1; } }
    gs[256 + lane] = a0; gs[256 + 64 + 63 - lane] = a1;
  }
  {
    const int cc = lane & 15, g = lane >> 4;
#pragma unroll
    for (int tt = 0; tt < 2; ++tt) {
      const int tile = wv * 2 + tt, mi = tile >> 2, nj = tile & 3;
      f32x4 akk = {0.f, 0.f, 0.f, 0.f}, aqk = {0.f, 0.f, 0.f, 0.f};
#pragma unroll
      for (int s4 = 0; s4 < 4; ++s4) {
        const bf16x8 ak = *(const bf16x8*)(lds + L_K + swz(mi * 16 + cc, s4 * 64 + g * 16));
        const bf16x8 aq = *(const bf16x8*)(lds + L_Q + swz(mi * 16 + cc, s4 * 64 + g * 16));
        const bf16x8 bk = *(const bf16x8*)(lds + L_K + swz(nj * 16 + cc, s4 * 64 + g * 16));
        akk = __builtin_amdgcn_mfma_f32_16x16x32_bf16(ak, bk, akk, 0, 0, 0);
        aqk = __builtin_amdgcn_mfma_f32_16x16x32_bf16(aq, bk, aqk, 0, 0, 0);
      }
      float* KK = (float*)(lds + L_KK); float* QK = (float*)(lds + L_QK);
#pragma unroll
      for (int r = 0; r < 4; ++r) { KK[(mi * 16 + g * 4 + r) * 65 + nj * 16 + cc] = akk[r]; QK[(mi * 16 + g * 4 + r) * 65 + nj * 16 + cc] = aqk[r]; }
    }
#pragma unroll
    for (int it = 0; it < 2; ++it) {
      const int item = tid + it * NT, fl = item & 63, frag = item >> 6, mt = frag >> 3, kbj = frag & 7, r = fl & 31, hl = fl >> 5;
      const int row = mt * 32 + r, cb = (kbj * 16 + hl * 4) * 2;
      uint4 wq, wk;
      { const uint2 lo = *(const uint2*)(lds + L_Q + swz(row, cb)), hi = *(const uint2*)(lds + L_Q + swz(row, cb + 16)); wq = make_uint4(lo.x, lo.y, hi.x, hi.y); }
      { const uint2 lo = *(const uint2*)(lds + L_K + swz(row, cb)), hi = *(const uint2*)(lds + L_K + swz(row, cb + 16)); wk = make_uint4(lo.x, lo.y, hi.x, hi.y); }
      *(uint4*)(rec + R_QF + (size_t)item * 16) = wq; *(uint4*)(rec + R_KF + (size_t)item * 16) = wk;
    }
#pragma unroll
    for (int it = 0; it < 2; ++it) {
      const int item = tid + it * NT, fl = item & 63, frag = item >> 6, mt = frag >> 2, kbj = frag & 3, i16 = fl & 15, gq = fl >> 4;
      const int tok0 = kbj * 16 + (gq >> 1) * 4 + (i16 >> 2), cb = (mt * 32 + (gq & 1) * 16 + (i16 & 3) * 4) * 2;
      uint2 lo, hi; tr_pair(ldsb + L_K + swz(tok0, cb), ldsb + L_K + swz(tok0 + 8, cb), lo, hi);
      *(uint4*)(rec + R_KTF + (size_t)item * 16) = make_uint4(lo.x, lo.y, hi.x, hi.y);
    }
#pragma unroll
    for (int it = 0; it < 4; ++it) {
      const int item = tid + it * NT, fl = item & 63, q = (item >> 6) & 3, mt = (item >> 8) & 1, sl = item >> 9, i16 = fl & 15, gq = fl >> 4;
      const int tok0 = mt * 32 + q * 8 + (gq >> 1) * 4 + (i16 >> 2), cb = (sl * 32 + (gq & 1) * 16 + (i16 & 3) * 4) * 2;
      const uint2 v = tr_one(ldsb + L_V + swz(tok0, cb));
      *(uint2*)(rec + R_VC + (size_t)item * 8) = v;
    }
  }
  lds_barrier();
  {
    const float* gs = (const float*)(lds + L_G); const float* KK = (const float*)(lds + L_KK);
    float* A = (float*)(lds + L_A);
#pragma unroll 4
    for (int it = 0; it < 16; ++it) {
      const int e = tid + it * NT, d = e >> 12, ip = (e >> 6) & 63, jp = e & 63, ti = d ? 63 - ip : ip, tj = d ? 63 - jp : jp;
      A[e] = ip > jp ? gs[128 + d * 64 + ti] * KK[ti * 65 + tj] * __expf(gs[256 + d * 64 + ti] - gs[256 + d * 64 + tj]) : 0.f;
    }
  }
  lds_barrier();
  if (wv < 2) {
    const float* A = (const float*)(lds + L_A) + wv * 4096; float* X = (float*)(lds + (wv ? L_X1 : L_X0));
    const int qb = lane >> 4, c16 = lane & 15;
    float x[16];
    f32x4 an[4];
#pragma unroll
    for (int q4 = 0; q4 < 4; ++q4) an[q4] = *(const f32x4*)(A + (qb * 16) * 64 + qb * 16 + q4 * 4);
#pragma unroll
    for (int r = 0; r < 16; ++r) {
      f32x4 ac[4];
#pragma unroll
      for (int q4 = 0; q4 < 4; ++q4) ac[q4] = an[q4];
      if (r < 15) {
#pragma unroll
        for (int q4 = 0; q4 < 4; ++q4) an[q4] = *(const f32x4*)(A + (qb * 16 + r + 1) * 64 + qb * 16 + q4 * 4); }
      asm volatile("" ::: "memory");
      float sacc = (r == c16) ? 1.f : 0.f;
#pragma unroll
      for (int q = 0; q < 16; ++q) if (q < r) sacc -= ac[q >> 2][q & 3] * x[q];
      x[r] = sacc;
      X[(qb * 16 + r) * 64 + qb * 16 + c16] = sacc;
    }
  } else {
    const float* gs = (const float*)(lds + L_G); const float* QK = (const float*)(lds + L_QK);
    const int t2 = tid - 128;
    for (int e = t2; e < 2 * 6 * 256; e += 384) {
      const int d = e / 1536, r6 = (e % 1536) >> 8, w = e & 255; const int bi = r6 < 3 ? 0 : (r6 < 5 ? 1 : 2), bj = r6 < 3 ? r6 + 1 : (r6 < 5 ? r6 - 1 : 3);
      ((float*)(lds + (d ? L_X1 : L_X0)))[(bi * 16 + (w >> 4)) * 64 + bj * 16 + (w & 15)] = 0.f; }
    for (int item = t2; item < 1024; item += 384) {
      const int d = item >> 9, fl = item & 63, frag = (item >> 6) & 7, mt = frag >> 2, kbj = frag & 3, r = fl & 31, hl = fl >> 5;
      const int i = mt * 32 + r; const float gci = gs[256 + d * 64 + i];
      float v[8];
#pragma unroll
      for (int j = 0; j < 8; ++j) { const int jj = kbj * 16 + 8 * (j >> 2) + 4 * hl + (j & 3); const bool ok = d ? (i <= jj) : (i >= jj);
        v[j] = ok ? QK[i * 65 + jj] * __expf(gci - gs[256 + d * 64 + jj]) : 0.f; }
      *(uint4*)(rec + R_DIR + d * DIR_BYTES + D_QKM + (size_t)(item & 511) * 16) = make_uint4(pk(v[0], v[1]), pk(v[2], v[3]), pk(v[4], v[5]), pk(v[6], v[7]));
    }
    if (t2 < 128) {
      const int d = t2 >> 6, tk = t2 & 63; float* vec = (float*)(rec + R_DIR + d * DIR_BYTES + D_VEC);
      const float gc = gs[256 + d * 64 + tk], gl = gs[256 + d * 64 + (d ? 0 : 63)];
      vec[tk] = gs[128 + d * 64 + tk]; vec[64 + tk] = __expf(gc); vec[128 + tk] = __expf(gl - gc);
      if (tk == 0) vec[192] = __expf(gl);
    }
  }
  lds_barrier();
  if (wv < 6) inv_offdiag((const float*)(lds + L_A) + (wv & 1) * 4096, (float*)(lds + ((wv & 1) ? L_X1 : L_X0)), (wv >> 1) + 1, wv >> 1, lane);
  lds_barrier();
  if (wv < 4) inv_offdiag((const float*)(lds + L_A) + (wv & 1) * 4096, (float*)(lds + ((wv & 1) ? L_X1 : L_X0)), (wv >> 1) + 2, wv >> 1, lane);
  lds_barrier();
  if (wv < 2) inv_offdiag((const float*)(lds + L_A) + wv * 4096, (float*)(lds + (wv ? L_X1 : L_X0)), 3, 0, lane);
  lds_barrier();
  {
#pragma unroll
    for (int it = 0; it < 2; ++it) {
      const int item = tid + it * NT, d = item >> 9, fl = item & 63, frag = (item >> 6) & 7, mt = frag >> 2, kbj = frag & 3, r = fl & 31, hl = fl >> 5;
      const int i = mt * 32 + r, ri = d ? 63 - i : i; const float* X = (const float*)(lds + (d ? L_X1 : L_X0)) + ri * 64; const float* bet = (const float*)(lds + L_G) + 128 + d * 64;
      float v[8];
#pragma unroll
      for (int j = 0; j < 8; ++j) { const int jj = kbj * 16 + 8 * (j >> 2) + 4 * hl + (j & 3); v[j] = X[d ? 63 - jj : jj] * bet[jj]; }
      *(uint4*)(rec + R_DIR + d * DIR_BYTES + D_TINV + (size_t)(item & 511) * 16) = make_uint4(pk(v[0], v[1]), pk(v[2], v[3]), pk(v[4], v[5]), pk(v[6], v[7]));
    }
  }
}

constexpr int SBUF_ = 74752;
template <int LW>
__device__ __forceinline__ void scan_loader(const char* recs, int dir, int half, char* smem, int lane) {
  typedef unsigned v4u __attribute__((ext_vector_type(4))); typedef __attribute__((address_space(1))) const v4u g_u4; typedef __attribute__((address_space(3))) v4u l_u4;
#define GD_CHUNK(step) (dir == 0 ? (step) : ((step) < 4 ? 3 - (step) : NCH + 3 - (step)))
#define GD_SOFF(i_) ((i_) < 48 ? (size_t)(i_) * 1024 : ((i_) < 56 ? R_VC + (size_t)half * 8192 + ((i_) - 48) * 1024 : R_DIR + (size_t)dir * DIR_BYTES + ((i_) - 56) * 1024))
#define GD_LOAD(R, step) do { const char* _b = recs + (size_t)GD_CHUNK(step) * CHREC + lane * 16; \
    _Pragma("unroll") for (int _j = 0; _j < 19; ++_j) { const int _i = LW + 4 * _j; if (_i < 73) R[_j] = *(g_u4*)(_b + GD_SOFF(_i)); } } while (0)
#define GD_WRITE(R, buf) do { char* _d = smem + (buf) * SBUF_ + lane * 16; \
    _Pragma("unroll") for (int _j = 0; _j < 19; ++_j) { const int _i = LW + 4 * _j; if (_i < 73) *(l_u4*)(_d + _i * 1024) = R[_j]; } } while (0)
  v4u RA[19], RB[19];
  GD_LOAD(RA, 0); GD_LOAD(RB, 1); GD_WRITE(RA, 0); GD_LOAD(RA, 2);
  lds_barrier();
  for (int step = 0; step < NCH; step += 2) {
    if (step + 1 < NCH) GD_WRITE(RB, 1);
    if (step + 3 < NCH) GD_LOAD(RB, step + 3);
    lds_barrier();
    if (step + 2 < NCH) GD_WRITE(RA, 0);
    if (step + 4 < NCH) GD_LOAD(RA, step + 4);
    lds_barrier();
  }
#undef GD_CHUNK
#undef GD_SOFF
#undef GD_LOAD
#undef GD_WRITE
}
constexpr int SB_QF = 0, SB_KF = 16384, SB_KTF = 32768, SB_VC = 49152, SB_TINV = 57344, SB_QKM = 65536, SB_VEC = 73728, SBUF = 74752;
using f32x16 = __attribute__((ext_vector_type(16))) float;
__device__ __forceinline__ unsigned pkb(float lo, float hi) {
  typedef __bf16 bf2 __attribute__((ext_vector_type(2))); typedef float f2 __attribute__((ext_vector_type(2)));
  bf2 r = __builtin_convertvector((f2){lo, hi}, bf2); return *reinterpret_cast<unsigned*>(&r);
}
template <int J> __device__ __forceinline__ bf16x8 pack16(const f32x16& v) {
  typedef unsigned u4 __attribute__((ext_vector_type(4)));
  u4 w = {pk(v[8 * J], v[8 * J + 1]), pk(v[8 * J + 2], v[8 * J + 3]), pk(v[8 * J + 4], v[8 * J + 5]), pk(v[8 * J + 6], v[8 * J + 7])};
  return *reinterpret_cast<bf16x8*>(&w);
}
typedef __attribute__((address_space(1))) char gchar; typedef __attribute__((address_space(1))) bf16_t gbf16;
#define GD_STO(o, I, MT) do { const unsigned _w = pk(o[I], o[(I) + 1]); gchar* _rb = Pst + (size_t)((MT) * 32 + 8 * ((I) >> 2) + ((I) & 3)) * (NINP * 2); asm volatile("" : "+s"(_rb)); \
    *(gbf16*)(_rb + voff) = (bf16_t)_w; *(gbf16*)(_rb + voff1) = (bf16_t)(_w >> 16); } while (0)
__device__ __forceinline__ void scan_unit_lds(const Params& p, int unit_, char* smem, int tid) {
  const int wv = __builtin_amdgcn_readfirstlane(tid >> 6), lane = tid & 63, unit = __builtin_amdgcn_readfirstlane(unit_);
  const int chain = unit >> 1, half = unit & 1, dir = chain & 1, h = (chain >> 1) & 3, b = chain >> 3;
  const char* recs = p.ws + OFF_RB + (size_t)((b * 4 + h) * NCH) * CHREC;
#define GD_CHUNK(step) (dir == 0 ? (step) : ((step) < 4 ? 3 - (step) : NCH + 3 - (step)))
  if (wv >= 4) {
    if (wv == 4) scan_loader<0>(recs, dir, half, smem, lane); else if (wv == 5) scan_loader<1>(recs, dir, half, smem, lane);
    else if (wv == 6) scan_loader<2>(recs, dir, half, smem, lane); else scan_loader<3>(recs, dir, half, smem, lane);
    return;
  }
  if (wv >= 2) {
    for (int i = 0; i <= NCH; ++i) lds_barrier();
    return;
  }
  lds_barrier();
  const int c32 = lane & 31, hl = lane >> 5;
  const unsigned voff_ = (unsigned)(c32 * 2 + hl * 4 * NINP * 2);
  gchar* Pc = (gchar*)(p.ws + OFF_P + (size_t)((dir ? PC_OB : PC_OF) + h * 128 + (half * 2 + wv) * 32) * 2);
  gchar* Pprev = (gchar*)(p.ws + OFF_P + (size_t)(PC_GV + h * 128 + (half * 2 + wv) * 32) * 2 + (size_t)chunk_row0(b, GD_CHUNK(0)) * (NINP * 2));
  f32x16 S[4], ks0, ks1, oq0, oq1, vn0, vn1;
  bf16x8 f0[8], f1[8], Sb[8], Rb[4], Vb[4], VFb[4];
  typedef unsigned u4 __attribute__((ext_vector_type(4)));
#pragma unroll
  for (int t = 0; t < 4; ++t)
#pragma unroll
    for (int i = 0; i < 16; ++i) S[t][i] = 0.f;
#pragma unroll
  for (int i = 0; i < 16; ++i) { oq0[i] = 0.f; oq1[i] = 0.f; }
#pragma unroll
  for (int k = 0; k < 8; ++k) { Sb[k] = (bf16x8){0, 0, 0, 0, 0, 0, 0, 0}; f0[k] = ((const bf16x8*)(smem + SB_KF))[k * 64 + lane]; }
#define GD_SB() __builtin_amdgcn_sched_barrier(0)
#define GD_MF(a, b, c) c = __builtin_amdgcn_mfma_f32_32x32x16_bf16(a, b, c, 0, 0, 0)
#define GD_ZERO(a) do { _Pragma("unroll") for (int _i = 0; _i < 16; ++_i) a[_i] = 0.f; } while (0)
#define GD_LO(w) __uint_as_float((w) << 16)
#define GD_HI(w) __uint_as_float((w) & 0xffff0000u)
#define GD_RLOAD(vA, vB, eA, eB, MT, HQ) do { vA = VC[((MT) * 4 + 2 * (HQ)) * 64 + lane]; vB = VC[((MT) * 4 + 2 * (HQ) + 1) * 64 + lane]; \
    eA = *(const f32x4*)(vec + 64 + (MT) * 32 + (HQ) * 16); eB = *(const f32x4*)(vec + 64 + (MT) * 32 + (HQ) * 16 + 8); } while (0)
#define GD_RC2(ks, v, e, I0, wa, wb) do { wa = pk(GD_LO(v.x) - e[0] * ks[(I0)], GD_HI(v.x) - e[1] * ks[(I0) + 1]); wb = pk(GD_LO(v.y) - e[2] * ks[(I0) + 2], GD_HI(v.y) - e[3] * ks[(I0) + 3]); } while (0)
#define GD_VF2(vn, e, I0, wa, wb) do { wa = pk(vn[(I0)] * e[0], vn[(I0) + 1] * e[1]); wb = pk(vn[(I0) + 2] * e[2], vn[(I0) + 3] * e[3]); } while (0)
#define GD_W4(dst) do { const u4 _w = {w0, w1, w2, w3}; dst = *reinterpret_cast<const bf16x8*>(&_w); } while (0)
#define GD_FLOAD(eA, eB, MT, HQ) do { eA = *(const f32x4*)(vec + 128 + (MT) * 32 + (HQ) * 16); eB = *(const f32x4*)(vec + 128 + (MT) * 32 + (HQ) * 16 + 8); } while (0)
#define GD_ELOAD(eA, eB, MT, HQ) do { eA = *(const f32x4*)(vec + 64 + (MT) * 32 + (HQ) * 16); eB = *(const f32x4*)(vec + 64 + (MT) * 32 + (HQ) * 16 + 8); } while (0)
#define GD_OINIT(oq, eA, eB, HQ) do { _Pragma("unroll") for (int _r = 0; _r < 4; ++_r) { oq[8 * (HQ) + _r] *= eA[_r]; oq[8 * (HQ) + 4 + _r] *= eB[_r]; } } while (0)
#define GD_SCALE(St, I0) do { float _e = egl; asm volatile("" : "+v"(_e)); _Pragma("unroll") for (int _r = 0; _r < 4; ++_r) St[(I0) + _r] *= _e; } while (0)
  uint2 vXA, vXB, vYA, vYB; f32x4 eXA, eXB, eYA, eYB, gXA, gXB, gYA, gYB; float egl; unsigned w0, w1, w2, w3;
  for (int step = 0; step < NCH; ++step) {
    const char* buf = smem + (step & 1) * SBUF; const char* nbuf = smem + ((step + 1) & 1) * SBUF;
    const bf16x8* QF = (const bf16x8*)(buf + SB_QF); const bf16x8* KF = (const bf16x8*)(buf + SB_KF); const bf16x8* KTF = (const bf16x8*)(buf + SB_KTF);
    const bf16x8* KFn = (const bf16x8*)(nbuf + SB_KF);
    const uint2* VC = (const uint2*)(buf + SB_VC + wv * 4096);
    const bf16x8* TF = (const bf16x8*)(buf + SB_TINV); const bf16x8* QKF = (const bf16x8*)(buf + SB_QKM); const float* vec = (const float*)(buf + SB_VEC) + 4 * hl;
    gchar* Pst = Pprev;
    unsigned voff = voff_; asm volatile("" : "+v"(voff)); unsigned voff1 = voff_ + NINP * 2; asm volatile("" : "+v"(voff1));
    GD_ZERO(ks0);
    GD_SB();
#pragma unroll
    for (int k = 0; k < 8; ++k) {
      GD_MF(f0[k], Sb[k], ks0);
      f1[k] = KF[(8 + k) * 64 + lane];
      if (k < 4) { GD_STO(oq0, 4 * k, 0); GD_STO(oq0, 4 * k + 2, 0); } else { GD_STO(oq1, 4 * (k - 4), 1); GD_STO(oq1, 4 * (k - 4) + 2, 1); }
      if (k == 6) GD_RLOAD(vXA, vXB, eXA, eXB, 0, 0);
      if (k == 7) { GD_RLOAD(vYA, vYB, eYA, eYB, 0, 1); GD_ZERO(ks1); }
      GD_SB();
    }
#pragma unroll
    for (int k = 0; k < 8; ++k) {
      GD_MF(f1[k], Sb[k], ks1);
      f0[k] = QF[k * 64 + lane];
      if (k == 1) GD_RC2(ks0, vXA, eXA, 0, w0, w1);
      if (k == 2) { GD_RC2(ks0, vXB, eXB, 4, w2, w3); GD_W4(Rb[0]); }
      if (k == 3) GD_RC2(ks0, vYA, eYA, 8, w0, w1);
      if (k == 4) { GD_RC2(ks0, vYB, eYB, 12, w2, w3); GD_W4(Rb[1]); }
      if (k == 5) GD_RLOAD(vXA, vXB, eXA, eXB, 1, 0);
      if (k == 6) GD_RLOAD(vYA, vYB, eYA, eYB, 1, 1);
      if (k == 7) { GD_ZERO(oq0); }
      GD_SB();
    }
#pragma unroll
    for (int k = 0; k < 8; ++k) {
      GD_MF(f0[k], Sb[k], oq0);
      f1[k] = QF[(8 + k) * 64 + lane];
      if (k == 1) GD_RC2(ks1, vXA, eXA, 0, w0, w1);
      if (k == 2) { GD_RC2(ks1, vXB, eXB, 4, w2, w3); GD_W4(Rb[2]); }
      if (k == 3) GD_RC2(ks1, vYA, eYA, 8, w0, w1);
      if (k == 4) { GD_RC2(ks1, vYB, eYB, 12, w2, w3); GD_W4(Rb[3]); }
      if (k == 6) egl = vec[192 - 4 * hl];
      if (k == 7) { GD_ZERO(oq1); }
      GD_SB();
    }
#pragma unroll
    for (int k = 0; k < 8; ++k) {
      GD_MF(f1[k], Sb[k], oq1);
      f0[k] = TF[k * 64 + lane];
      GD_SCALE(S[k >> 2], 4 * (k & 3)); GD_SCALE(S[2 + (k >> 2)], 4 * (k & 3));
      if (k == 6) { GD_FLOAD(gXA, gXB, 0, 0); GD_FLOAD(gYA, gYB, 0, 1); }
      if (k == 7) { GD_ZERO(vn0); GD_ZERO(vn1); }
      GD_SB();
    }
#pragma unroll
    for (int k = 0; k < 8; ++k) {
      if (k < 4) GD_MF(f0[k], Rb[k], vn0); else GD_MF(f0[k], Rb[k - 4], vn1);
      f1[k] = KTF[k * 64 + lane];
      if (k == 5) GD_VF2(vn0, gXA, 0, w0, w1);
      if (k == 6) { GD_VF2(vn0, gXB, 4, w2, w3); GD_W4(VFb[0]); }
      if (k == 7) { GD_VF2(vn0, gYA, 8, w0, w1); GD_FLOAD(gXA, gXB, 1, 0); }
      GD_SB();
    }
#pragma unroll
    for (int k = 0; k < 8; ++k) {
      if (k == 0) GD_MF(f1[0], VFb[0], S[0]); if (k == 1) GD_MF(f1[4], VFb[0], S[1]); if (k == 2) GD_MF(f1[1], VFb[1], S[0]); if (k == 3) GD_MF(f1[5], VFb[1], S[1]);
      if (k == 4) GD_MF(f1[2], VFb[2], S[0]); if (k == 5) GD_MF(f1[6], VFb[2], S[1]); if (k == 6) GD_MF(f1[3], VFb[3], S[0]); if (k == 7) GD_MF(f1[7], VFb[3], S[1]);
      f0[k] = KTF[(8 + k) * 64 + lane];
      if (k == 0) { GD_VF2(vn0, gYB, 12, w2, w3); GD_W4(VFb[1]); }
      if (k == 1) { GD_VF2(vn1, gXA, 0, w0, w1); GD_FLOAD(gYA, gYB, 1, 1); }
      if (k == 2) { GD_VF2(vn1, gXB, 4, w2, w3); GD_W4(VFb[2]); }
      if (k == 3) GD_VF2(vn1, gYA, 8, w0, w1);
      if (k == 4) { GD_VF2(vn1, gYB, 12, w2, w3); GD_W4(VFb[3]); }
      if (k == 5) Vb[0] = pack16<0>(vn0);
      if (k == 6) { Vb[1] = pack16<1>(vn0); GD_ELOAD(eXA, eXB, 0, 0); }
      if (k == 7) { Vb[2] = pack16<0>(vn1); GD_ELOAD(eYA, eYB, 0, 1); }
      GD_SB();
    }
#pragma unroll
    for (int k = 0; k < 8; ++k) {
      if (k < 4) GD_MF(f0[k], VFb[k], S[2]); else GD_MF(f0[k], VFb[k - 4], S[3]);
      if (k < 4) { f1[2 * k] = QKF[(2 * k) * 64 + lane]; f1[2 * k + 1] = QKF[(2 * k + 1) * 64 + lane]; }
      if (k == 0) GD_OINIT(oq0, eXA, eXB, 0);
      if (k == 1) { GD_OINIT(oq0, eYA, eYB, 1); GD_ELOAD(eXA, eXB, 1, 0); }
      if (k == 2) { GD_ELOAD(eYA, eYB, 1, 1); Vb[3] = pack16<1>(vn1); Sb[0] = pack16<0>(S[0]); }
      if (k == 3) GD_OINIT(oq1, eXA, eXB, 0);
      if (k == 4) GD_OINIT(oq1, eYA, eYB, 1);
      if (k == 5) Sb[1] = pack16<1>(S[0]);
      if (k == 6) Sb[2] = pack16<0>(S[1]);
      if (k == 7) Sb[3] = pack16<1>(S[1]);
      GD_SB();
    }
    Pprev = Pc + (size_t)chunk_row0(b, GD_CHUNK(step)) * (NINP * 2);
    lds_barrier();
    GD_SB();
#pragma unroll
    for (int k = 0; k < 8; ++k) {
      if (k < 4) GD_MF(f1[k], Vb[k], oq0); else GD_MF(f1[k], Vb[k - 4], oq1);
      f0[k] = KFn[k * 64 + lane];
      if (k == 0) Sb[4] = pack16<0>(S[2]);
      if (k == 1) Sb[5] = pack16<1>(S[2]);
      if (k == 2) Sb[6] = pack16<0>(S[3]);
      if (k == 3) Sb[7] = pack16<1>(S[3]);
      GD_SB();
    }
  }
  {
    gchar* Pst = Pprev; const unsigned voff = voff_, voff1 = voff_ + NINP * 2;
#pragma unroll
    for (int k = 0; k < 8; ++k) { if (k < 4) { GD_STO(oq0, 4 * k, 0); GD_STO(oq0, 4 * k + 2, 0); } else { GD_STO(oq1, 4 * (k - 4), 1); GD_STO(oq1, 4 * (k - 4) + 2, 1); } }
  }
#undef GD_SB
#undef GD_MF
#undef GD_ZERO
#undef GD_LO
#undef GD_HI
#undef GD_RLOAD
#undef GD_RC2
#undef GD_VF2
#undef GD_W4
#undef GD_FLOAD
#undef GD_ELOAD
#undef GD_OINIT
#undef GD_SCALE
#undef GD_CHUNK
}
#undef GD_STO
}

__device__ __forceinline__ void ph_init_ada(const Params& p) {
  const int TIDX = ltid(); const int BIDX = lbid();
  const size_t n = (size_t)MR * D, gt = (size_t)BIDX * NT + TIDX, gs = (size_t)gridDim.x * NT;
  for (size_t i = gt; i < n; i += gs) {
    int r = (int)(i / D), cc = (int)(i % D);
    xrow(p, r)[cc] = r < ML ? p.x[i] : p.ctx[(size_t)(r - ML) * D + cc];
  }
}
__device__ __forceinline__ void ph_modulate(const Params& p, int l, int which, int nrows) {
  const int TIDX = ltid(); const int BIDX = lbid();
  const int lane = TIDX & 63, wv = TIDX >> 6;
  for (int r = BIDX * 8 + wv; r < nrows; r += gridDim.x * 8) {
    int mj, t, tlen, r0; rowinfo(r, mj, t, tlen, r0);
    const float* xr = xrow_src(p, r, l);
    const float* g = (which ? p.norm2_g : p.norm1_g) + l * D;
    const float* sh = modvec(p, l, mj, which ? 3 : 0); const float* sc = modvec(p, l, mj, which ? 4 : 1);
    float v[16], ss = 0;
#pragma unroll
    for (int i = 0; i < 16; ++i) { v[i] = xr[lane + i * 64]; ss += v[i] * v[i]; }
    ss = wave_sum(ss);
    const float rstd = rsqrtf(ss / D + EPS);
    bf16_t* h = (bf16_t*)(p.ws + OFF_H) + (size_t)r * D;
#pragma unroll
    for (int i = 0; i < 16; ++i) { int cc = lane + i * 64; v[i] = v[i] * rstd * g[cc] * (1.f + sc[cc]) + sh[cc]; h[cc] = f2bf(v[i]); }
    if (which) {
      const float* wr = p.router + (size_t)l * D * NE;
      float lo[16];
#pragma unroll
      for (int e = 0; e < 16; ++e) lo[e] = 0.f;
#pragma unroll
      for (int i = 0; i < 16; ++i) { int cc = lane + i * 64;
#pragma unroll
        for (int e = 0; e < 16; ++e) lo[e] += v[i] * wr[cc * NE + e]; }
      float mx = -1e30f;
#pragma unroll
      for (int e = 0; e < 16; ++e) { lo[e] = wave_sum(lo[e]); mx = fmaxf(mx, lo[e]); }
      float sum = 0;
#pragma unroll
      for (int e = 0; e < 16; ++e) { lo[e] = expf(lo[e] - mx); sum += lo[e]; }
      float* afft = (float*)(p.ws + OFF_AFFT);
      if (lane == 0) {
#pragma unroll
        for (int e = 0; e < 16; ++e) afft[(size_t)e * MR + r] = lo[e] / sum;
      }
    }
  }
}

__device__ __forceinline__ constexpr int ngemm_lds_floats() { return 16 * 65 + 16 * 129; }
template <typename LoadA, typename LoadB, typename Epi>
__device__ __forceinline__ void ngemm_tile(float* lds, int M, int N, int K, int tm, int tn, LoadA lda_, LoadB ldb_, Epi epi) {
  float (*sA)[65] = (float (*)[65])lds; float (*sB)[129] = (float (*)[129])(lds + 16 * 65);
  const int tid = ltid(), tx = tid & 31, ty = tid >> 5;
  float acc[4][4];
#pragma unroll
  for (int i = 0; i < 4; ++i)
#pragma unroll
    for (int j = 0; j < 4; ++j) acc[i][j] = 0.f;
  for (int k0 = 0; k0 < K; k0 += 16) {
#pragma unroll
    for (int i = 0; i < 2; ++i) { int e = tid + i * 512; int rr = e >> 4, kk = e & 15; int gr = tm * 64 + rr; sA[kk][rr] = gr < M ? lda_(gr, k0 + kk) : 0.f; }
#pragma unroll
    for (int i = 0; i < 4; ++i) { int e = tid + i * 512; int kk = e >> 7, cc = e & 127; int gc = tn * 128 + cc; sB[kk][cc] = gc < N ? ldb_(k0 + kk, gc) : 0.f; }
    __syncthreads();
#pragma unroll
    for (int kk = 0; kk < 16; ++kk) {
      float a[4], b[4];
#pragma unroll
      for (int i = 0; i < 4; ++i) { a[i] = sA[kk][ty * 4 + i]; b[i] = sB[kk][tx * 4 + i]; }
#pragma unroll
      for (int i = 0; i < 4; ++i)
#pragma unroll
        for (int j = 0; j < 4; ++j) acc[i][j] += a[i] * b[j];
    }
    __syncthreads();
  }
#pragma unroll
  for (int i = 0; i < 4; ++i)
#pragma unroll
    for (int j = 0; j < 4; ++j) { int rr = tm * 64 + ty * 4 + i, cc = tn * 128 + tx * 4 + j; if (rr < M && cc < N) epi(rr, cc, acc[i][j]); }
}

__device__ __forceinline__ void ph_inproj(const Params& p, int l, float* lds) {
  const int TIDX = ltid(); const int BIDX = lbid();
  const bf16_t* H = (const bf16_t*)(p.ws + OFF_H); const float* W = p.w_in + (size_t)l * D * NIN; bf16_t* P = (bf16_t*)(p.ws + OFF_P);
  const int ntn = (NIN + 127) / 128, ntm = MR / 64;
  for (int vb = BIDX; vb < ntn * ntm; vb += gridDim.x)
    ngemm_tile(lds, MR, NIN, D, vb / ntn, vb % ntn,
               [&](int r, int k) { return bf2f(H[(size_t)r * D + k]); },
               [&](int k, int n) { return W[(size_t)k * NIN + n]; },
               [&](int r, int n, float v) { P[(size_t)r * NINP + n] = f2bf(v); });
}

__device__ __forceinline__ void ph_mla(const Params& p, int l, float* lds) {
  const int TIDX = ltid(); const int BIDX = lbid();
  float* pq = lds; float* pkv = pq + 192; float* pkr = pkv + 128; float* qraw = pkr + 32; float* kvraw = qraw + 384; float* qn = kvraw + 512; float* kn = qn + 384; float* red = kn + 384;
  const int tid = TIDX;
  for (int r = BIDX; r < MR; r += gridDim.x) {
    int mj, t, tlen, r0; rowinfo(r, mj, t, tlen, r0);
    const bf16_t* P = (const bf16_t*)(p.ws + OFF_P) + (size_t)r * NINP;
    __syncthreads();
    if (tid < 192) pq[tid] = bf2f(P[PC_Q + tid]);
    if (tid < 128) pkv[tid] = bf2f(P[PC_KV + tid]);
    if (tid < 32) pkr[tid] = bf2f(P[PC_KR + tid]);
    __syncthreads();
    if (tid < 64) { float s = 0; for (int k = tid; k < 192; k += 64) s += pq[k] * pq[k]; s = wave_sum(s); if (tid == 0) red[0] = rsqrtf(s / 192.f + EPS); }
    else if (tid < 128) { float s = 0; for (int k = tid - 64; k < 128; k += 64) s += pkv[k] * pkv[k]; s = wave_sum(s); if (tid == 64) red[1] = rsqrtf(s / 128.f + EPS); }
    __syncthreads();
    const float rq = red[0], rkv = red[1];
    const float* wuq = p.w_uq + (size_t)l * 192 * 384; const float* qan = p.q_a_norm + l * 192;
    const float* wukv = p.w_ukv + (size_t)l * 128 * 512; const float* kvan = p.kv_a_norm + l * 128;
    if (tid < 384) { float a = 0; for (int k = 0; k < 192; ++k) a += pq[k] * rq * qan[k] * wuq[k * 384 + tid]; qraw[tid] = a; }
    { float a = 0; for (int k = 0; k < 128; ++k) a += pkv[k] * rkv * kvan[k] * wukv[k * 512 + tid]; kvraw[tid] = a; }
    __syncthreads();
    const float* qnw = p.q_norm + l * 96; const float* knw = p.k_norm + l * 96;
    if (tid < 384) {
      int h = tid / 96, d = tid % 96;
      float sq = 0, sk = 0;
      for (int dd = 0; dd < 96; ++dd) { float a = qraw[h * 96 + dd]; sq += a * a; float b = dd < 64 ? kvraw[h * 128 + dd] : pkr[dd - 64]; sk += b * b; }
      float kval = d < 64 ? kvraw[h * 128 + d] : pkr[d - 64];
      qn[tid] = qraw[tid] * rsqrtf(sq / 96.f + EPS) * qnw[d];
      kn[tid] = kval * rsqrtf(sk / 96.f + EPS) * knw[d];
    }
    __syncthreads();
    const bool lat = r < ML; const int b = lat ? (r >> 13) : ((r - ML) >> 8); const int pos = lat ? TC + t : t;
    bf16_t* Q = (bf16_t*)(p.ws + OFF_QKV); bf16_t* Kb = Q + QK_ELEMS; bf16_t* Vb = Kb + QK_ELEMS;
    {
      int h = tid >> 7, d = tid & 127;
      float qv = 0, kv = 0;
      if (d < 96) {
        qv = qn[h * 96 + d]; kv = kn[h * 96 + d];
        if (lat && d >= 64) {
          int part = (d - 64) >> 4, w = (d - 64) & 15, i = w & 7; bool first = w < 8;
          float posv = part == 0 ? (float)(t >> 6) : (float)(t & 63);
          float invf = powf(10000.f, -(float)i / 8.f);
          float ang = posv * invf, cs = cosf(ang), sn = sinf(ang);
          int i1 = h * 96 + 64 + part * 16 + i, i2 = i1 + 8;
          qv = first ? qn[i1] * cs - qn[i2] * sn : qn[i2] * cs + qn[i1] * sn;
          kv = first ? kn[i1] * cs - kn[i2] * sn : kn[i2] * cs + kn[i1] * sn;
        }
      }
      size_t o = ((size_t)(b * 4 + h) * TK + pos) * 128 + d;
      Q[o] = f2bf(qv); Kb[o] = f2bf(kv);
      if (d < 64) Vb[((size_t)(b * 4 + h) * TK + pos) * 64 + d] = f2bf(kvraw[h * 128 + 64 + d]);
    }
  }
}

__device__ __forceinline__ void ph_gdnprep(const Params& p, int l, float* lds) {
  const int TIDX = ltid(); const int BIDX = lbid();
  float* cv = lds; float* rs = lds + 1536;
  const int tid = TIDX;
  const bf16_t* P = (const bf16_t*)(p.ws + OFF_P);
  const float* cw = p.conv_w + (size_t)l * 3 * 1536;
  for (int r = BIDX; r < MR; r += gridDim.x) {
    int mj, t, tlen, r0; rowinfo(r, mj, t, tlen, r0);
    __syncthreads();
    for (int c = tid; c < 1536; c += NT) {
      float a = 0;
      for (int j = 0; j < 3; ++j) { int tt = t + j - 1; if (tt >= 0 && tt < tlen) a += cw[j * 1536 + c] * bf2f(P[(size_t)(r0 + tt) * NINP + PC_GQ + c]); }
      cv[c] = silu_f(a);
    }
    __syncthreads();
    if (tid < 8) { float s = 0; for (int d = 0; d < 128; ++d) { float v = cv[tid * 128 + d]; s += v * v; } rs[tid] = rsqrtf(s + EPS) * (tid < 4 ? 0.08838834764831845f : 1.f); }
    __syncthreads();
    float* G = (float*)(p.ws + OFF_RB) + (size_t)r * 1536;
    for (int c = tid; c < 1536; c += NT) G[c] = c < 1024 ? cv[c] * rs[c >> 7] : cv[c];
    if (tid < 8) {
      float* gb = (float*)(p.ws + OFF_GB) + (size_t)r * 16;
      float pa = bf2f(P[(size_t)r * NINP + PC_A + tid]), pb = bf2f(P[(size_t)r * NINP + PC_B + tid]);
      gb[tid] = -expf(p.a_log[l * 8 + tid]) * softplus_f(pa + p.dt_bias[l * 8 + tid]);
      gb[8 + tid] = sigmoid_f(pb);
    }
  }
}
__device__ __forceinline__ void ph_scan(const Params& p, float* lds) {
  const int TIDX = ltid(); const int BIDX = lbid();
  if (BIDX >= 16) return;
  float* sk = lds; float* sq = lds + 128; float* red = lds + 256; float* red2 = lds + 256 + 512;
  const int tid = TIDX, e = tid & 127, part = tid >> 7;
  const int chain = BIDX, dir = chain & 1, h = (chain >> 1) & 3, b = chain >> 3;
  const float* G = (const float*)(p.ws + OFF_RB); const float* GB = (const float*)(p.ws + OFF_GB);
  bf16_t* P = (bf16_t*)(p.ws + OFF_P);
  float S[32];
#pragma unroll
  for (int d = 0; d < 32; ++d) S[d] = 0.f;
  __syncthreads();
  for (int step = 0; step < TC + T; ++step) {
    int row;
    if (step < TC) row = ML + b * TC + (dir ? TC - 1 - step : step);
    else { int i = step - TC; row = b * T + (dir ? T - 1 - i : i); }
    const float* q = G + (size_t)row * 1536 + h * 128; const float* k = q + 512; const float v = q[1024 + e];
    if (tid < 128) sk[tid] = k[tid]; else if (tid < 256) sq[tid - 128] = q[tid - 128];
    const float g = GB[(size_t)row * 16 + dir * 4 + h], beta = GB[(size_t)row * 16 + 8 + dir * 4 + h];
    const float eg = expf(g);
    __syncthreads();
    float ks = 0;
#pragma unroll
    for (int d = 0; d < 32; ++d) ks += sk[part * 32 + d] * S[d];
    red[part * 128 + e] = ks;
    __syncthreads();
    ks = red[e] + red[128 + e] + red[256 + e] + red[384 + e];
    const float vn = beta * (v - eg * ks);
    float o = 0;
#pragma unroll
    for (int d = 0; d < 32; ++d) { S[d] = eg * S[d] + sk[part * 32 + d] * vn; o += sq[part * 32 + d] * S[d]; }
    red2[part * 128 + e] = o;
    __syncthreads();
    if (part == 0) P[(size_t)row * NINP + (dir ? PC_OB : PC_OF) + h * 128 + e] = f2bf(red2[e] + red2[128 + e] + red2[256 + e] + red2[384 + e]);
  }
  __syncthreads();
}
__device__ __forceinline__ void ph_attn(const Params& p, bool need_ctx, float* lds) {
  const int TIDX = ltid(); const int BIDX = lbid();
  float (*sK)[96] = (float (*)[96])lds; float (*sV)[64] = (float (*)[64])(lds + 32 * 96);
  const int tid = TIDX;
  const int nlat = NB * 4 * (T / NT), nitem = nlat + (need_ctx ? NB * 4 : 0);
  const bf16_t* Q = (const bf16_t*)(p.ws + OFF_QKV); const bf16_t* Kb = Q + QK_ELEMS; const bf16_t* Vb = Kb + QK_ELEMS;
  for (int it = gridDim.x - 1 - BIDX; it < nitem; it += gridDim.x) {
    const bool ctxq = it >= nlat;
    int b, h, qt;
    if (!ctxq) { qt = it % (T / NT); h = (it / (T / NT)) & 3; b = it / (4 * (T / NT)); } else { int j = it - nlat; qt = 0; h = j & 3; b = j >> 2; }
    const bool active = !ctxq || tid < TC;
    const int qpos = ctxq ? (active ? tid : 0) : TC + qt * NT + tid;
    const int nk = ctxq ? TC : TK;
    const size_t bh = (size_t)(b * 4 + h) * TK;
    float q[96], o[64];
#pragma unroll
    for (int d = 0; d < 96; ++d) q[d] = bf2f(Q[(bh + qpos) * 128 + d]);
#pragma unroll
    for (int d = 0; d < 64; ++d) o[d] = 0.f;
    float m = -1e30f, lsum = 0.f;
    const float scale = 0.10206207261596575f;
    for (int k0 = 0; k0 < nk; k0 += 32) {
      __syncthreads();
      for (int e = tid; e < 32 * 96; e += NT) { int j = e / 96, d = e % 96; sK[j][d] = bf2f(Kb[(bh + k0 + j) * 128 + d]); }
      for (int e = tid; e < 32 * 64; e += NT) { int j = e >> 6, d = e & 63; sV[j][d] = bf2f(Vb[(bh + k0 + j) * 64 + d]); }
      __syncthreads();
      for (int j = 0; j < 32; ++j) {
        float s = 0;
#pragma unroll
        for (int d = 0; d < 96; ++d) s += q[d] * sK[j][d];
        s *= scale;
        if (s > m) { float a = __expf(m - s); lsum *= a;
#pragma unroll
          for (int d = 0; d < 64; ++d) o[d] *= a;
          m = s; }
        float pe = __expf(s - m); lsum += pe;
#pragma unroll
        for (int d = 0; d < 64; ++d) o[d] += pe * sV[j][d];
      }
    }
    if (active) {
      const int row = ctxq ? ML + b * TC + qpos : b * T + (qpos - TC);
      bf16_t* cat = (bf16_t*)(p.ws + OFF_H) + (size_t)row * D + h * 64;
      float inv = 1.f / lsum;
#pragma unroll
      for (int d = 0; d < 64; ++d) cat[d] = f2bf(o[d] * inv);
    }
  }
}
__device__ __forceinline__ void ph_gdnfin_pool(const Params& p, int l, int nrows, float* lds) {
  const int TIDX = ltid(); const int BIDX = lbid();
  float* ov = lds; float* rs = lds + 512; float* dv = lds + 520;
  const int tid = TIDX;
  const bf16_t* P = (const bf16_t*)(p.ws + OFF_P);
  for (int r = BIDX; r < nrows; r += gridDim.x) {
    int mj, t, tlen, r0; rowinfo(r, mj, t, tlen, r0);
    bf16_t* cat = (bf16_t*)(p.ws + OFF_H) + (size_t)r * D;
    __syncthreads();
    ov[tid] = bf2f(P[(size_t)r * NINP + PC_OF + tid]) + bf2f(P[(size_t)r * NINP + PC_OB + tid]);
    if (tid < 256) {
      int c = tid, gi = c >> 6, win = 2 << gi;
      int lo = t - win / 2, hi = lo + win; lo = lo < 0 ? 0 : lo; hi = hi > tlen ? tlen : hi;
      float s = 0; for (int tt = lo; tt < hi; ++tt) s += bf2f(P[(size_t)(r0 + tt) * NINP + PC_POOL + c]);
      dv[c] = s / (float)(hi - lo) - bf2f(P[(size_t)r * NINP + PC_POOL + c]);
    }
    __syncthreads();
    if (tid < 4) { float s = 0; for (int d = 0; d < 128; ++d) { float v = ov[tid * 128 + d]; s += v * v; } rs[tid] = rsqrtf(s / 128.f + EPS); }
    __syncthreads();
    const float* gn = p.gdn_norm_g + l * 128;
    { int c = tid; float z = bf2f(P[(size_t)r * NINP + PC_Z + c]); cat[256 + c] = f2bf(ov[c] * rs[c >> 7] * gn[c & 127] * silu_f(z)); }
    if (tid < 256) {
      int j = tid, gi = j >> 6, dd = j & 63;
      const float* pw = p.pool_w + ((size_t)l * 4 + gi) * 64 * 64;
      float a = 0; for (int c = 0; c < 64; ++c) a += dv[gi * 64 + c] * pw[c * 64 + dd];
      cat[768 + j] = f2bf(a * p.pool_scale[l * 256 + j]);
    }
  }
}
__device__ __forceinline__ void ph_outproj(const Params& p, int l, int nrows, float* lds) {
  const int TIDX = ltid(); const int BIDX = lbid();
  const bf16_t* A = (const bf16_t*)(p.ws + OFF_H); const float* W = p.w_out + (size_t)l * D * D;
  const int ntn = D / 128, ntm = nrows / 64;
  for (int vb = BIDX; vb < ntn * ntm; vb += gridDim.x)
    ngemm_tile(lds, nrows, D, D, vb / ntn, vb % ntn,
               [&](int r, int k) { return bf2f(A[(size_t)r * D + k]); },
               [&](int k, int n) { return W[(size_t)k * D + n]; },
               [&](int r, int n, float v) { int mj = r < ML ? (r >> 13) : 2; xrow(p, r)[n] += modvec(p, l, mj, 2)[n] * v; });
}
__device__ __forceinline__ void ph_topk(const Params& p, int nseq) {
  const int TIDX = ltid(); const int BIDX = lbid();
  const size_t total = (size_t)nseq * NE * T;
  for (size_t i = (size_t)BIDX * NT + TIDX; i < total; i += (size_t)gridDim.x * NT) {
    const int t = (int)(i % T), e = (int)((i / T) % NE), s = (int)(i / ((size_t)T * NE));
    const int tlen = s < 2 ? T : TC, cap = s < 2 ? CAPL : CAPC, r0 = s < 2 ? s * T : ML + (s - 2) * TC;
    if (t >= tlen) continue;
    const float* a = (const float*)(p.ws + OFF_AFFT) + (size_t)e * MR + r0;
    const float me = a[t];
    int rank = 0;
    for (int u = 0; u < tlen; ++u) { float o = a[u]; rank += (o > me || (o == me && u < t)) ? 1 : 0; }
    int* slot = (int*)(p.ws + OFF_SLOT);
    if (rank < cap) { int pi = pair_base(s, e) + rank; ((int*)(p.ws + OFF_IDX))[pi] = r0 + t; ((float*)(p.ws + OFF_GATE))[pi] = me; slot[(size_t)(r0 + t) * 16 + e] = rank; }
    else slot[(size_t)(r0 + t) * 16 + e] = -1;
  }
}
__device__ __forceinline__ void ph_moe_gu(const Params& p, int l, int grp0, int grp1, float* lds) {
  const int TIDX = ltid(); const int BIDX = lbid();
  const bf16_t* H = (const bf16_t*)(p.ws + OFF_H);
  float* tmp = (float*)(p.ws + OFF_P);
  const int ntn = DEXP / 128, ntm = CAPL / 64, per = ntn * ntm;
  for (int vb = BIDX; vb < (grp1 - grp0) * per; vb += gridDim.x) {
    const int grp = grp0 + vb / per, tt = vb % per, tm = tt / ntn, tn = tt % ntn;
    const int s = grp >> 4, e = grp & 15; const int cap = s < 2 ? CAPL : CAPC;
    if (tm * 64 >= cap) continue;
    const int pb = pair_base(s, e);
    const int* idx = (const int*)(p.ws + OFF_IDX) + pb;
    const float* Wg = p.w_gate + ((size_t)l * NE + e) * D * DEXP; const float* Wu = p.w_up + ((size_t)l * NE + e) * D * DEXP;
    bf16_t* hid = (bf16_t*)(p.ws + OFF_HID) + (size_t)pb * DEXP;
    ngemm_tile(lds, cap, DEXP, D, tm, tn,
               [&](int r, int k) { return bf2f(H[(size_t)idx[r] * D + k]); },
               [&](int k, int n) { return Wg[(size_t)k * DEXP + n]; },
               [&](int r, int n, float v) { tmp[(size_t)(pb + r) * DEXP + n] = v; });
    ngemm_tile(lds, cap, DEXP, D, tm, tn,
               [&](int r, int k) { return bf2f(H[(size_t)idx[r] * D + k]); },
               [&](int k, int n) { return Wu[(size_t)k * DEXP + n]; },
               [&](int r, int n, float v) { float g = tmp[(size_t)(pb + r) * DEXP + n]; hid[(size_t)r * DEXP + n] = f2bf(silu_f(g) * v); });
  }
}
__device__ __forceinline__ void ph_moe_down(const Params& p, int l, int grp0, int grp1, float* lds) {
  const int TIDX = ltid(); const int BIDX = lbid();
  const int ntn = D / 128, ntm = CAPL / 64, per = ntn * ntm;
  for (int vb = BIDX; vb < (grp1 - grp0) * per; vb += gridDim.x) {
    const int grp = grp0 + vb / per, tt = vb % per, tm = tt / ntn, tn = tt % ntn;
    const int s = grp >> 4, e = grp & 15; const int cap = s < 2 ? CAPL : CAPC;
    if (tm * 64 >= cap) continue;
    const int pb = pair_base(s, e);
    const bf16_t* hid = (const bf16_t*)(p.ws + OFF_HID) + (size_t)pb * DEXP;
    const float* Wd = p.w_down + ((size_t)l * NE + e) * DEXP * D;
    const float* gate = (const float*)(p.ws + OFF_GATE) + pb;
    bf16_t* Y = (bf16_t*)(p.ws + OFF_Y) + (size_t)pb * D;
    ngemm_tile(lds, cap, D, DEXP, tm, tn,
               [&](int r, int k) { return bf2f(hid[(size_t)r * DEXP + k]); },
               [&](int k, int n) { return Wd[(size_t)k * D + n]; },
               [&](int r, int n, float v) { Y[(size_t)r * D + n] = f2bf(v * gate[r]); });
  }
}
__device__ __forceinline__ void ph_combine(const Params& p, int l, int nrows) {
  const int TIDX = ltid(); const int BIDX = lbid();
  const bf16_t* Y = (const bf16_t*)(p.ws + OFF_Y);
  for (int r = BIDX; r < nrows; r += gridDim.x) {
    int mj, t, tlen, r0; rowinfo(r, mj, t, tlen, r0);
    const int s = r < ML ? (r >> 13) : 2 + ((r - ML) >> 8);
    const int* slot = (const int*)(p.ws + OFF_SLOT) + (size_t)r * 16;
    const float* g2 = modvec(p, l, mj, 5);
    float* xr = xrow(p, r);
    for (int c = TIDX; c < D; c += NT) {
      float a = 0;
      for (int e = 0; e < 16; ++e) { int sl = slot[e]; if (sl >= 0) a += bf2f(Y[(size_t)(pair_base(s, e) + sl) * D + c]); }
      xr[c] += g2[c] * a;
    }
  }
}


__device__ __forceinline__ void transpose_cvt_tile(float* lds, const float* W, int ldw, int N, bf16_t* Wt, int K, int rmul, int roff, int tk, int tn, int tid, const float* kscale = nullptr) {
  __syncthreads();
#pragma unroll
  for (int i = 0; i < 8; ++i) { int e = tid + i * NT; int kk = e >> 6, nn = e & 63; int n = tn * 64 + nn; lds[kk * 65 + nn] = n < N ? W[(size_t)(tk * 64 + kk) * ldw + n] * (kscale ? kscale[tk * 64 + kk] : 1.f) : 0.f; }
  __syncthreads();
#pragma unroll
  for (int i = 0; i < 8; ++i) { int e = tid + i * NT; int nn = e >> 6, kk = e & 63; int n = tn * 64 + nn; if (n < N) Wt[(size_t)(n * rmul + roff) * K + tk * 64 + kk] = f2bf(lds[kk * 65 + nn]); }
}
__device__ __forceinline__ void transpose_cvt_4tiles(float* lds, const float* W, int ldw, int N, bf16_t* Wt, int K, int rmul, int roff, int t4, int ntiles, int tid, const float* kscale) {
  const int ntn = (N + 63) / 64;
  float v[4][8];
#pragma unroll
  for (int q = 0; q < 4; ++q) { const int t = t4 + q, tk = t / ntn, tn = t % ntn;
#pragma unroll
    for (int i = 0; i < 8; ++i) { const int el = tid + i * NT, kk = el >> 6, nn = el & 63, n = tn * 64 + nn;
      v[q][i] = (t < ntiles && n < N) ? W[(size_t)(tk * 64 + kk) * ldw + n] * (kscale ? kscale[tk * 64 + kk] : 1.f) : 0.f; } }
  __syncthreads();
#pragma unroll
  for (int q = 0; q < 4; ++q)
#pragma unroll
    for (int i = 0; i < 8; ++i) { const int el = tid + i * NT, kk = el >> 6, nn = el & 63; lds[q * 4160 + kk * 65 + nn] = v[q][i]; }
  __syncthreads();
#pragma unroll
  for (int q = 0; q < 4; ++q) { const int t = t4 + q, tk = t / ntn, tn = t % ntn;
#pragma unroll
    for (int i = 0; i < 4; ++i) { const int el = tid + i * NT, nn = el >> 5, k2 = (el & 31) * 2, n = tn * 64 + nn;
      if (t < ntiles && n < N) *(unsigned*)(Wt + (size_t)(n * rmul + roff) * K + tk * 64 + k2) = gd::pk(lds[q * 4160 + k2 * 65 + nn], lds[q * 4160 + (k2 + 1) * 65 + nn]); } }
}
__device__ __forceinline__ void ph_prep_weights(const Params& p, float* lds) {
  const int TIDX = ltid(); const int BIDX = lbid();
  bf16_t* winT = (bf16_t*)(p.ws + OFF_WINT); bf16_t* woutT = (bf16_t*)(p.ws + OFF_WOUTT);
  const int g_in = 2 * 168, g_out = 2 * 64, g_q = 2 * 5, g_kv = 2 * 4;
  for (int vb = BIDX; vb < g_in + g_out + g_q + g_kv; vb += gridDim.x) {
    if (vb < g_in) { const int l = vb / 168, r = vb % 168; transpose_cvt_4tiles(lds, p.w_in + (size_t)l * D * NIN, NIN, NIN, winT + (size_t)l * NINP * D, D, 1, 0, r * 4, 16 * 42, TIDX, nullptr); }
    else if (vb < g_in + g_out) { const int v = vb - g_in, l = v / 64, r = v % 64; transpose_cvt_4tiles(lds, p.w_out + (size_t)l * D * D, D, D, woutT + (size_t)l * D * D, D, 1, 0, r * 4, 256, TIDX, nullptr); }
    else if (vb < g_in + g_out + g_q) { const int v = vb - g_in - g_out, l = v / 5, r = v % 5;
      transpose_cvt_4tiles(lds, p.w_uq + (size_t)l * 192 * 384, 384, 384, (bf16_t*)(p.ws + OFF_WUP) + (size_t)l * 1024 * 256, 256, 1, 0, r * 4, 18, TIDX, p.q_a_norm + l * 192); }
    else { const int v = vb - g_in - g_out - g_q, l = v / 4, r = v % 4;
      transpose_cvt_4tiles(lds, p.w_ukv + (size_t)l * 128 * 512, 512, 512, (bf16_t*)(p.ws + OFF_WUP) + (size_t)l * 1024 * 256 + 512 * 256, 256, 1, 0, r * 4, 16, TIDX, p.kv_a_norm + l * 128); }
  }
  for (int q = 0; q < 16; ++q) {
    const int i = (q * (int)gridDim.x + BIDX) * NT + TIDX; if (i >= 2 * 1024 * 256) break;
    const int k = i & 255, n = (i >> 8) & 1023;
    if ((n < 384 && k >= 192) || (n >= 384 && n < 512) || (n >= 512 && k >= 128)) ((bf16_t*)(p.ws + OFF_WUP))[i] = 0;
  }
  for (size_t i = (size_t)BIDX * NT + TIDX; i < (size_t)2 * (NINP - NIN) * D; i += (size_t)gridDim.x * NT) {
    const int l = (int)(i / ((size_t)(NINP - NIN) * D)); const size_t r = i % ((size_t)(NINP - NIN) * D);
    winT[(size_t)l * NINP * D + (size_t)NIN * D + r] = 0;
  }
}
__device__ __forceinline__ void ph_inproj_fast(const Params& p, int l, char* smem) {
  DenseSched S; S.init(MR / 256, NINP / 256, (int)gridDim.x, lbid());
  S.A = p.ws + OFF_H; S.Bt = p.ws + OFF_WINT + (size_t)l * NINP * D * 2; S.lda = D; S.ldb = D; S.K = D;
  EpiStoreBf16 E; E.O = (bf16_t*)(p.ws + OFF_P); E.ldc = NINP;
  pg8::gemm_phase(( PG8_LAS unsigned char*)smem, S, E);
}

__device__ __forceinline__ void ph_outproj_fast(const Params& p, int l, char* smem) {
  DenseSched S; S.init(ML / 256, D / 256, (int)gridDim.x, lbid());
  S.A = p.ws + OFF_H; S.Bt = p.ws + OFF_WOUTT + (size_t)l * D * D * 2; S.lda = D; S.ldb = D; S.K = D;
  EpiStoreBf16 E; E.O = (bf16_t*)(p.ws + OFF_YO); E.ldc = D;
  pg8::gemm_phase((PG8_LAS unsigned char*)smem, S, E);
}

__device__ __forceinline__ void ph_prep_moe_weights(const Params& p, int l, float* lds, int b0, int nb) {
  const int TIDX = ltid(); const int BIDX = lbid() - b0;
  if (BIDX < 0) return;
  bf16_t* gu = (bf16_t*)(p.ws + OFF_MOEGU); bf16_t* dn = (bf16_t*)(p.ws + OFF_MOED);
  unsigned* ctr = (unsigned*)(p.ws + OFF_BAR) + 16 + l; volatile int* bc = (volatile int*)(lds + 4 * 4160);
  __syncthreads();
  if (TIDX == 0) bc[0] = (int)__hip_atomic_fetch_add(ctr, 1u, __ATOMIC_RELAXED, __HIP_MEMORY_SCOPE_AGENT);
  __syncthreads();
  int vb = __builtin_amdgcn_readfirstlane(bc[0]);
  for (int it = 1; ; ++it) {
    if (vb >= NE * 3 * 32) break;
    const int e = vb / 96, r = vb % 96, which = r >> 5, t4 = (r & 31) * 4;
    const float* W; int ldw, K, rmul, roff; bf16_t* Wt;
    if (which < 2) { W = (which ? p.w_up : p.w_gate) + ((size_t)l * NE + e) * D * DEXP; ldw = DEXP; K = D; rmul = 2; roff = which; Wt = gu + (size_t)e * D * D; }
    else { W = p.w_down + ((size_t)l * NE + e) * DEXP * D; ldw = D; K = DEXP; rmul = 1; roff = 0; Wt = dn + (size_t)e * D * DEXP; }
    const int ntn = ldw / 64;
    float v[4][8];
#pragma unroll
    for (int q = 0; q < 4; ++q) { const int t = t4 + q, tk = t / ntn, tn = t % ntn;
#pragma unroll
      for (int i = 0; i < 8; ++i) { const int el = TIDX + i * NT, kk = el >> 6, nn = el & 63; v[q][i] = __builtin_nontemporal_load(&W[(size_t)(tk * 64 + kk) * ldw + tn * 64 + nn]); } }
    if (TIDX == 0) bc[it & 1] = (int)__hip_atomic_fetch_add(ctr, 1u, __ATOMIC_RELAXED, __HIP_MEMORY_SCOPE_AGENT);
    __syncthreads();
#pragma unroll
    for (int q = 0; q < 4; ++q)
#pragma unroll
      for (int i = 0; i < 8; ++i) { const int el = TIDX + i * NT, kk = el >> 6, nn = el & 63; lds[q * 4160 + kk * 65 + nn] = v[q][i]; }
    __syncthreads();
#pragma unroll
    for (int q = 0; q < 4; ++q) { const int t = t4 + q, tk = t / ntn, tn = t % ntn;
#pragma unroll
      for (int i = 0; i < 4; ++i) { const int el = TIDX + i * NT, nn = el >> 5, k2 = (el & 31) * 2;
        const unsigned w = gd::pk(lds[q * 4160 + k2 * 65 + nn], lds[q * 4160 + (k2 + 1) * 65 + nn]);
        *(unsigned*)(Wt + (size_t)((tn * 64 + nn) * rmul + roff) * K + tk * 64 + k2) = w; } }
    vb = __builtin_amdgcn_readfirstlane(bc[it & 1]);
  }
}
__device__ __forceinline__ void ph_gather(const Params& p) {
  const int TIDX = ltid(); const int BIDX = lbid();
  const int lane = TIDX & 63, wv = TIDX >> 6;
  const int* idx = (const int*)(p.ws + OFF_IDX);
  const uint4* H = (const uint4*)(p.ws + OFF_H); uint4* xs = (uint4*)(p.ws + OFF_XS);
  for (int r = BIDX * 8 + wv; r < NB * NE * CAPL; r += gridDim.x * 8) {
    const int src = idx[r];
    const uint4 a = H[(size_t)src * 128 + lane], b = H[(size_t)src * 128 + 64 + lane];
    xs[(size_t)r * 128 + lane] = a; xs[(size_t)r * 128 + 64 + lane] = b;
  }
}
__device__ __forceinline__ void ph_moe_gu_fast(const Params& p, char* smem) {
  MoeSched S; S.init(NB * NE * CAPL / 256, 2 * DEXP / 256, (int)gridDim.x, lbid());
  S.A = p.ws + OFF_H; S.Bt = p.ws + OFF_MOEGU; S.lda = D; S.ldb = D; S.K = D; S.bstride = (size_t)D * D * 2; S.gidx = (const int*)(p.ws + OFF_IDX); S.gather = true;
  EpiSwiGLU E; E.O = (bf16_t*)(p.ws + OFF_HID);
  pg8::gemm_phase<EpiSwiGLU, MoeSched, true>((PG8_LAS unsigned char*)smem, S, E);
}
__device__ __forceinline__ void ph_moe_down_fast(const Params& p, char* smem) {
  MoeSched S; S.init(NB * NE * CAPL / 256, D / 256, (int)gridDim.x, lbid());
  S.A = p.ws + OFF_HID; S.Bt = p.ws + OFF_MOED; S.lda = DEXP; S.ldb = DEXP; S.K = DEXP; S.bstride = (size_t)D * DEXP * 2; S.gidx = nullptr; S.gather = false;
  EpiGateBf16 E; E.O = (bf16_t*)(p.ws + OFF_Y); E.gate = (const float*)(p.ws + OFF_GATE);
  pg8::gemm_phase((PG8_LAS unsigned char*)smem, S, E);
}

__device__ __forceinline__ void attn_ctx_item(const Params& p, int j, char* smem) {
  const bf16_t* Q = (const bf16_t*)(p.ws + OFF_QKV); const bf16_t* Kb = Q + QK_ELEMS; const bf16_t* Vb = Kb + QK_ELEMS;
  const int h = j & 3, b = j >> 2; const size_t bh = (size_t)(b * 4 + h) * TK;
  fa::attn_body(Q + bh * 128, Kb + bh * 128, Vb + bh * 64, (bf16_t*)(p.ws + OFF_H) + (size_t)(ML + b * TC) * D + h * 64, D, TC, smem);
}
__device__ __forceinline__ void attn_seg(const Params& p, int x, int qt, int off, int len, char* smem) {
  const bf16_t* Q = (const bf16_t*)(p.ws + OFF_QKV); const bf16_t* Kb = Q + QK_ELEMS; const bf16_t* Vb = Kb + QK_ELEMS;
  const int h = x & 3, b = x >> 2, part = off == 0 ? 0 : 1, kv0 = off * 128;
  const size_t bh = (size_t)(b * 4 + h) * TK; const int row0 = b * T + qt * 256;
  bf16_t* op = (bf16_t*)(p.ws + OFF_OPART) + ((size_t)part * ML + row0) * 256 + h * 64;
  float* ml = (float*)(p.ws + OFF_MLPART) + (((size_t)part * ML + row0) * 4 + h) * 2;
  fa::attn_body(Q + (bh + TC + qt * 256) * 128, Kb + (bh + kv0) * 128, Vb + (bh + kv0) * 64, op, 256, len * 128, smem, ml, 8);
  if (off == 0 && len == TK / 128) {
    const int t = ltid();
    if (t < 256) *(float2*)((float*)(p.ws + OFF_MLPART) + (((size_t)ML + row0 + t) * 4 + h) * 2) = make_float2(-1e30f, 0.f);
  }
}
__device__ __forceinline__ void ph_attn_fast(const Params& p, bool need_ctx, char* smem) {
  const int BIDX = lbid();
  const int nns = (int)gridDim.x - 32;
  if (BIDX >= 32) {
    const int x = BIDX & 7, j = (BIDX - 32) >> 3, nj = nns >> 3;
    constexpr int PPQ = TK / 128, NPAIRS = 32 * PPQ;
    const int hi = (NPAIRS * (j + 1)) / nj;
    for (int cur = (NPAIRS * j) / nj; cur < hi; ) {
      const int qt = cur / PPQ, off = cur - qt * PPQ, len = min(PPQ - off, hi - cur);
      attn_seg(p, x, qt, off, len, smem);
      cur += len;
    }
    if (need_ctx && j == nj - 1) attn_ctx_item(p, x, smem);
  }
}

__device__ __forceinline__ void ph_gdn_precompute(const Params& p, int l, char* smem) {
  const int TIDX = ltid(); const int BIDX = lbid();
  __syncthreads();
  { const float* cw = p.conv_w + (size_t)l * 3 * 1536; float* cwl = (float*)(smem + gd::L_CW);
    for (int i = TIDX; i < 3 * 1536 / 4; i += NT) ((float4*)cwl)[i] = ((const float4*)cw)[i]; }
  const int nit = NB * 4 * gd::NCH;
  for (int it = BIDX; it < nit; it += gridDim.x) {
    const int c = it % gd::NCH, bh = it / gd::NCH;
    uint4 cur[3][4];
    gd::precompute_load(p, bh >> 2, bh & 3, c, TIDX, cur);
    gd::precompute_item(p, l, bh >> 2, bh & 3, c, smem, TIDX, cur);
  }
  __syncthreads();
}
__device__ __forceinline__ void ph_scan_fast(const Params& p, char* smem) {
  const int TIDX = ltid(); const int BIDX = lbid();
  if (BIDX < 32) gd::scan_unit_lds(p, (((BIDX & 7) + 8 * (BIDX >> 4)) << 1) | ((BIDX >> 3) & 1), smem, TIDX);
}

struct MlaSched : pg8::GridOrder {
  const char* P; const char* W; int lda, ldb, K; const int* gidx;
  __device__ __forceinline__ const char* a_ptr(const pg8::Unit& u) const { return P + (size_t)u.pm * 256 * NINP * 2 + (u.pn < 2 ? PC_Q : PC_KV) * 2; }
  __device__ __forceinline__ const char* b_ptr(const pg8::Unit& u) const { return W + (size_t)u.pn * 256 * 256 * 2; }
};
__device__ __forceinline__ void ph_mla_gemm(const Params& p, int l, char* smem) {
  if (lbid() < 32) return;
  MlaSched S; S.init(MR / 256, 4, (int)gridDim.x - 32, lbid() - 32);
  S.P = p.ws + OFF_P; S.W = p.ws + OFF_WUP + (size_t)l * 1024 * 256 * 2; S.lda = NINP; S.ldb = 256; S.K = 256; S.gidx = nullptr;
  EpiStoreBf16 E; E.O = (bf16_t*)(p.ws + OFF_UPRAW); E.ldc = 1024;
  pg8::gemm_phase((PG8_LAS unsigned char*)smem, S, E);
}
__device__ __forceinline__ void ph_mla_finish(const Params& p, int l) {
  const int TIDX = ltid(); const int BIDX = lbid();
  const int lane = TIDX & 63, wv = TIDX >> 6, cc = lane & 15, h = lane >> 4;
  const bf16_t* P = (const bf16_t*)(p.ws + OFF_P); const bf16_t* RAW = (const bf16_t*)(p.ws + OFF_UPRAW);
  bf16_t* Qo = (bf16_t*)(p.ws + OFF_QKV); bf16_t* Ko = Qo + QK_ELEMS; bf16_t* Vo = Ko + QK_ELEMS;
  const float invf = __builtin_amdgcn_exp2f(-(float)(cc & 7) * 1.6609640474436813f);
  const float sgn = (cc < 8) ? -1.f : 1.f;
  float qw[6], kw[6];
#pragma unroll
  for (int nt = 0; nt < 6; ++nt) { qw[nt] = p.q_norm[l * 96 + nt * 16 + cc]; kw[nt] = p.k_norm[l * 96 + nt * 16 + cc]; }
  for (int r2 = (BIDX + gridDim.x * wv) * 2; r2 < MR; r2 += gridDim.x * 8 * 2)
#pragma unroll
  for (int rr = 0; rr < 2; ++rr) { const int r = r2 + rr;
    const bool lat = r < ML; const int b = lat ? (r >> 13) : ((r - ML) >> 8), t = lat ? (r & (T - 1)) : ((r - ML) & (TC - 1)), pos = lat ? TC + t : t;
    const bf16_t* Pr = P + (size_t)r * NINP; const bf16_t* Rr = RAW + (size_t)r * 1024;
    float qa[6], ka[8], pq[3], pkv[2], pkr[2];
#pragma unroll
    for (int nt = 0; nt < 6; ++nt) qa[nt] = bf2f(Rr[h * 96 + nt * 16 + cc]);
#pragma unroll
    for (int nt = 0; nt < 8; ++nt) ka[nt] = bf2f(Rr[512 + h * 128 + nt * 16 + cc]);
#pragma unroll
    for (int i = 0; i < 3; ++i) pq[i] = bf2f(Pr[PC_Q + i * 64 + lane]);
#pragma unroll
    for (int i = 0; i < 2; ++i) { pkv[i] = bf2f(Pr[PC_KV + i * 64 + lane]); pkr[i] = bf2f(Pr[PC_KR + i * 16 + cc]); }
    const float rq = rsqrtf(wave_sum(pq[0] * pq[0] + pq[1] * pq[1] + pq[2] * pq[2]) / 192.f + EPS);
    const float rkv = rsqrtf(wave_sum(pkv[0] * pkv[0] + pkv[1] * pkv[1]) / 128.f + EPS);
    const float a0 = (float)(t >> 6) * invf, a1 = (float)(t & 63) * invf;
    const float cs[2] = {__cosf(a0), __cosf(a1)}, sn[2] = {__sinf(a0), __sinf(a1)};
    { float ss = 0.f;
#pragma unroll
      for (int nt = 0; nt < 6; ++nt) ss += qa[nt] * qa[nt];
      ss += __shfl_xor(ss, 1); ss += __shfl_xor(ss, 2); ss += __shfl_xor(ss, 4); ss += __shfl_xor(ss, 8);
      const float sc = rq * rsqrtf(rq * rq * ss / 96.f + EPS);
      const size_t ob = ((size_t)(b * 4 + h) * TK + pos) * 128;
#pragma unroll
      for (int nt = 0; nt < 6; ++nt) { float v = qa[nt] * sc * qw[nt];
        if (nt >= 4) { const float o = __shfl_xor(v, 8); if (lat) v = v * cs[nt - 4] + sgn * o * sn[nt - 4]; }
        Qo[ob + nt * 16 + cc] = f2bf(v); } }
    { float ss = 0.f, skr = pkr[0] * pkr[0] + pkr[1] * pkr[1];
#pragma unroll
      for (int nt = 0; nt < 4; ++nt) ss += ka[nt] * ka[nt];
      ss += __shfl_xor(ss, 1); ss += __shfl_xor(ss, 2); ss += __shfl_xor(ss, 4); ss += __shfl_xor(ss, 8);
      skr += __shfl_xor(skr, 1); skr += __shfl_xor(skr, 2); skr += __shfl_xor(skr, 4); skr += __shfl_xor(skr, 8);
      const float sck = rsqrtf((rkv * rkv * ss + skr) / 96.f + EPS);
      const size_t ob = ((size_t)(b * 4 + h) * TK + pos);
#pragma unroll
      for (int nt = 0; nt < 4; ++nt) Ko[ob * 128 + nt * 16 + cc] = f2bf(ka[nt] * rkv * sck * kw[nt]);
#pragma unroll
      for (int q = 0; q < 2; ++q) { float v = pkr[q] * kw[4 + q]; const float o = __shfl_xor(v, 8); if (lat) v = v * cs[q] + sgn * o * sn[q];
        Ko[ob * 128 + 64 + q * 16 + cc] = f2bf(v * sck); }
#pragma unroll
      for (int nt = 0; nt < 4; ++nt) Vo[ob * 64 + nt * 16 + cc] = f2bf(ka[4 + nt] * rkv); }
  }
}
constexpr int POOL_ROWB = 144, POOL_TILEB = 64 * POOL_ROWB;
template <int H>
__device__ __forceinline__ void pool_unit(const Params& p, int l, int tile, int gi, char* Dw, const char* WTl, int lane) {
  typedef unsigned u2 __attribute__((ext_vector_type(2)));
  using bf16x8 = fa::bf16x8; using f32x16 = fa::f32x16;
  const int r_first = tile * 64;
  int r0, tlen;
  if (r_first < ML) { r0 = r_first & ~(T - 1); tlen = T; } else { r0 = ML + ((r_first - ML) & ~(TC - 1)); tlen = TC; }
  const int cq = lane & 15, tb = lane >> 4, tbase = r_first - r0 + tb * 16;
  const bf16_t* Pg = (const bf16_t*)(p.ws + OFF_P) + (size_t)r0 * NINP + PC_POOL + gi * 64 + cq * 4;
  constexpr int NR = 15 + 2 * H;
  u2 xs[NR];
#pragma unroll
  for (int j = 0; j < NR; ++j) { const int tt = tbase - H + j; xs[j] = (tt >= 0 && tt < tlen) ? *(const u2*)(Pg + (size_t)tt * NINP) : (u2){0u, 0u}; }
#define PL_LO(w) __uint_as_float((w) << 16)
#define PL_HI(w) __uint_as_float((w) & 0xffff0000u)
  float s0 = 0.f, s1 = 0.f, s2 = 0.f, s3 = 0.f;
#pragma unroll
  for (int j = 0; j < 2 * H; ++j) { s0 += PL_LO(xs[j].x); s1 += PL_HI(xs[j].x); s2 += PL_LO(xs[j].y); s3 += PL_HI(xs[j].y); }
  char* drow = Dw + (tb * 16) * POOL_ROWB + cq * 8;
#pragma unroll
  for (int i = 0; i < 16; ++i) {
    const int t = tbase + i; const int lo = t - H < 0 ? 0 : t - H, hi = t + H > tlen ? tlen : t + H;
    const float inv = 1.f / (float)(hi - lo);
    const u2 c = xs[i + H];
    u2 w; w.x = gd::pk(s0 * inv - PL_LO(c.x), s1 * inv - PL_HI(c.x)); w.y = gd::pk(s2 * inv - PL_LO(c.y), s3 * inv - PL_HI(c.y));
    *(u2*)(drow + i * POOL_ROWB) = w;
    if (i < 15) { const u2 a = xs[i + 2 * H], b = xs[i];
      s0 += PL_LO(a.x) - PL_LO(b.x); s1 += PL_HI(a.x) - PL_HI(b.x); s2 += PL_LO(a.y) - PL_LO(b.y); s3 += PL_HI(a.y) - PL_HI(b.y); }
  }
#undef PL_LO
#undef PL_HI
  asm volatile("s_waitcnt lgkmcnt(0)" ::: "memory");
  const int r32 = lane & 31, hl = lane >> 5;
  f32x16 acc[2][2];
#pragma unroll
  for (int a = 0; a < 2; ++a)
#pragma unroll
    for (int b = 0; b < 2; ++b)
#pragma unroll
      for (int i = 0; i < 16; ++i) acc[a][b][i] = 0.f;
#pragma unroll
  for (int ks = 0; ks < 4; ++ks) {
    const bf16x8 a0 = *(const bf16x8*)(WTl + r32 * POOL_ROWB + ks * 32 + hl * 16), a1 = *(const bf16x8*)(WTl + (32 + r32) * POOL_ROWB + ks * 32 + hl * 16);
    const bf16x8 b0 = *(const bf16x8*)(Dw + r32 * POOL_ROWB + ks * 32 + hl * 16), b1 = *(const bf16x8*)(Dw + (32 + r32) * POOL_ROWB + ks * 32 + hl * 16);
    acc[0][0] = __builtin_amdgcn_mfma_f32_32x32x16_bf16(a0, b0, acc[0][0], 0, 0, 0); acc[0][1] = __builtin_amdgcn_mfma_f32_32x32x16_bf16(a0, b1, acc[0][1], 0, 0, 0);
    acc[1][0] = __builtin_amdgcn_mfma_f32_32x32x16_bf16(a1, b0, acc[1][0], 0, 0, 0); acc[1][1] = __builtin_amdgcn_mfma_f32_32x32x16_bf16(a1, b1, acc[1][1], 0, 0, 0);
  }
  const float* psc = p.pool_scale + l * 256 + gi * 64 + 4 * hl;
  bf16_t* cat = (bf16_t*)(p.ws + OFF_H) + (size_t)(r_first + r32) * D + 768 + gi * 64 + 4 * hl;
#pragma unroll
  for (int mt = 0; mt < 2; ++mt)
#pragma unroll
    for (int q = 0; q < 4; ++q) {
      const float4 s4 = *(const float4*)(psc + mt * 32 + q * 8);
#pragma unroll
      for (int nt = 0; nt < 2; ++nt) {
        u2 w; w.x = gd::pk(acc[mt][nt][4 * q] * s4.x, acc[mt][nt][4 * q + 1] * s4.y); w.y = gd::pk(acc[mt][nt][4 * q + 2] * s4.z, acc[mt][nt][4 * q + 3] * s4.w);
        *(u2*)(cat + (size_t)(nt * 32) * D + mt * 32 + q * 8) = w;
      }
    }
  asm volatile("s_waitcnt lgkmcnt(0)" ::: "memory");
}
__device__ __forceinline__ void ph_pool_mfma(const Params& p, int l, int nrows, char* smem) {
  const int TIDX = ltid(); const int BIDX = lbid();
  const int lane = TIDX & 63, wv = TIDX >> 6;
  const int gi = BIDX & 3;
  __syncthreads();
  {
    const float4* W = (const float4*)(p.pool_w + ((size_t)l * 4 + gi) * 4096);
    for (int i = TIDX; i < 1024; i += NT) { const float4 w = W[i]; const int c = i >> 4, o4 = (i & 15) * 4;
      bf16_t* dst = (bf16_t*)(smem + o4 * POOL_ROWB) + c;
      dst[0] = f2bf(w.x); dst[POOL_ROWB / 2] = f2bf(w.y); dst[POOL_ROWB] = f2bf(w.z); dst[3 * POOL_ROWB / 2] = f2bf(w.w); }
  }
  __syncthreads();
  char* Dw = smem + POOL_TILEB + wv * POOL_TILEB;
  const int ntiles = nrows >> 6;
  for (int tile = wv * ((int)gridDim.x >> 2) + (BIDX >> 2); tile < ntiles; tile += 8 * ((int)gridDim.x >> 2)) {
    if (gi == 0) pool_unit<1>(p, l, tile, 0, Dw, smem, lane); else if (gi == 1) pool_unit<2>(p, l, tile, 1, Dw, smem, lane);
    else if (gi == 2) pool_unit<4>(p, l, tile, 2, Dw, smem, lane); else pool_unit<8>(p, l, tile, 3, Dw, smem, lane);
  }
}
template <int MODE>
__device__ __forceinline__ void ph_gdnfin_pool_fast(const Params& p, int l, int nrows, float* lds, int b0, int nb) {
  const int TIDX = ltid(); const int BIDX = lbid() - b0;
  if (BIDX < 0) return;
  const int lane = TIDX & 63, wv = TIDX >> 6;
  float* Wl = lds; float* dsc = lds + 16384 + wv * 256;
  if (MODE == 1) {
    __syncthreads();
    for (int i = TIDX; i < 4096; i += NT) ((float4*)Wl)[i] = ((const float4*)(p.pool_w + (size_t)l * 16384))[i];
    __syncthreads();
  }
  const bf16_t* P = (const bf16_t*)(p.ws + OFF_P);
  const float* gn = p.gdn_norm_g + l * 128; const float* psc = p.pool_scale + l * 256;
  for (int r = BIDX + nb * wv; r < nrows; r += nb * 8) {
    int mj, t, tlen, r0; rowinfo(r, mj, t, tlen, r0);
    bf16_t* cat = (bf16_t*)(p.ws + OFF_H) + (size_t)r * D;
    const bf16_t* Pr = P + (size_t)r * NINP;
    if (MODE == 2 && r < ML) {
      const int hh = lane >> 4;
      float mp[2], lp[2], mx = -1e30f;
#pragma unroll
      for (int q = 0; q < 2; ++q) { const float2 ml = *(const float2*)((const float*)(p.ws + OFF_MLPART) + (((size_t)q * ML + r) * 4 + hh) * 2); mp[q] = ml.x; lp[q] = ml.y; mx = fmaxf(mx, ml.x); }
      float acc4[4] = {0.f, 0.f, 0.f, 0.f}, wsum = 0.f;
#pragma unroll
      for (int q = 0; q < 2; ++q) { const float w = lp[q] * __expf((mp[q] - mx) * fa::SCALE); wsum += w;
        const uint2 o = *(const uint2*)((const bf16_t*)(p.ws + OFF_OPART) + ((size_t)q * ML + r) * 256 + lane * 4);
        acc4[0] += w * __uint_as_float(o.x << 16); acc4[1] += w * __uint_as_float(o.x & 0xffff0000u); acc4[2] += w * __uint_as_float(o.y << 16); acc4[3] += w * __uint_as_float(o.y & 0xffff0000u); }
      const float inv = 1.f / wsum;
      uint2 w2; w2.x = gd::pk(acc4[0] * inv, acc4[1] * inv); w2.y = gd::pk(acc4[2] * inv, acc4[3] * inv);
      *(uint2*)(cat + lane * 4) = w2;
    }
    if (MODE == 2) {
      const uint4 a = *(const uint4*)(Pr + PC_OF + lane * 8), bq = *(const uint4*)(Pr + PC_OB + lane * 8), z = *(const uint4*)(Pr + PC_Z + lane * 8);
      const unsigned aw[4] = {a.x, a.y, a.z, a.w}, bw[4] = {bq.x, bq.y, bq.z, bq.w}, zw[4] = {z.x, z.y, z.z, z.w};
      float o[8], ss = 0.f;
#pragma unroll
      for (int i = 0; i < 4; ++i) { o[2 * i] = __uint_as_float(aw[i] << 16) + __uint_as_float(bw[i] << 16); o[2 * i + 1] = __uint_as_float(aw[i] & 0xffff0000u) + __uint_as_float(bw[i] & 0xffff0000u); }
#pragma unroll
      for (int i = 0; i < 8; ++i) ss += o[i] * o[i];
      ss += __shfl_xor(ss, 1); ss += __shfl_xor(ss, 2); ss += __shfl_xor(ss, 4); ss += __shfl_xor(ss, 8);
      const float rs = rsqrtf(ss / 128.f + EPS);
      float y[8];
#pragma unroll
      for (int i = 0; i < 4; ++i) { const float z0 = __uint_as_float(zw[i] << 16), z1 = __uint_as_float(zw[i] & 0xffff0000u);
        y[2 * i] = o[2 * i] * rs * gn[(lane & 15) * 8 + 2 * i] * silu_f(z0); y[2 * i + 1] = o[2 * i + 1] * rs * gn[(lane & 15) * 8 + 2 * i + 1] * silu_f(z1); }
      uint4 w; w.x = gd::pk(y[0], y[1]); w.y = gd::pk(y[2], y[3]); w.z = gd::pk(y[4], y[5]); w.w = gd::pk(y[6], y[7]);
      *(uint4*)(cat + 256 + lane * 8) = w;
    }
    if (MODE == 1) {
      const int gi = lane >> 4, win = 2 << gi;
      int lo = t - win / 2, hi = lo + win; lo = lo < 0 ? 0 : lo; hi = hi > tlen ? tlen : hi;
      float sm[4] = {0.f, 0.f, 0.f, 0.f};
      uint2 uw[16];
#pragma unroll
      for (int q = 0; q < 16; ++q) { const int tt = t - 8 + q; const bool ok = tt >= lo && tt < hi; uw[q] = ok ? *(const uint2*)(P + (size_t)(r0 + tt) * NINP + PC_POOL + lane * 4) : make_uint2(0u, 0u); }
#pragma unroll
      for (int q = 0; q < 16; ++q) { sm[0] += __uint_as_float(uw[q].x << 16); sm[1] += __uint_as_float(uw[q].x & 0xffff0000u); sm[2] += __uint_as_float(uw[q].y << 16); sm[3] += __uint_as_float(uw[q].y & 0xffff0000u); }
      const uint2 u = *(const uint2*)(Pr + PC_POOL + lane * 4); const float inv = 1.f / (float)(hi - lo);
      dsc[lane * 4 + 0] = sm[0] * inv - __uint_as_float(u.x << 16); dsc[lane * 4 + 1] = sm[1] * inv - __uint_as_float(u.x & 0xffff0000u);
      dsc[lane * 4 + 2] = sm[2] * inv - __uint_as_float(u.y << 16); dsc[lane * 4 + 3] = sm[3] * inv - __uint_as_float(u.y & 0xffff0000u);
      float4 acc = {0.f, 0.f, 0.f, 0.f};
      const float* wg = Wl + gi * 4096 + (lane & 15) * 4; const float* dg = dsc + gi * 64;
#pragma unroll 8
      for (int c = 0; c < 64; ++c) { const float dv = dg[c]; const float4 w4 = *(const float4*)(wg + c * 64); acc.x += dv * w4.x; acc.y += dv * w4.y; acc.z += dv * w4.z; acc.w += dv * w4.w; }
      const float4 s4 = *(const float4*)(psc + lane * 4);
      uint2 w; w.x = gd::pk(acc.x * s4.x, acc.y * s4.y); w.y = gd::pk(acc.z * s4.z, acc.w * s4.w);
      *(uint2*)(cat + 768 + lane * 4) = w;
    }
  }
}
__device__ __forceinline__ void ph_ada_fast(const Params& p, float* lds) {
  const int TIDX = ltid(); const int BIDX = lbid();
  const int cg = TIDX & 15, ksl = TIDX >> 4;
  for (int u = BIDX; u < 2 * 96; u += gridDim.x) {
    const int l = u / 96, n0 = (u % 96) * 64 + cg * 4;
    const float* w = p.ada_w + (size_t)l * D * 6144 + n0;
    float4 a0 = {0.f, 0.f, 0.f, 0.f}, a1 = a0, a2 = a0;
#pragma unroll 16
    for (int kk = 0; kk < 32; ++kk) { const int k = ksl * 32 + kk; typedef float f4v __attribute__((ext_vector_type(4))); const f4v w4 = __builtin_nontemporal_load((const f4v*)(w + (size_t)k * 6144));
      const float s0 = silu_f(p.c[k]), s1 = silu_f(p.c[D + k]), s2 = silu_f(p.c_ctx[k]);
      a0.x += s0 * w4.x; a0.y += s0 * w4.y; a0.z += s0 * w4.z; a0.w += s0 * w4.w;
      a1.x += s1 * w4.x; a1.y += s1 * w4.y; a1.z += s1 * w4.z; a1.w += s1 * w4.w;
      a2.x += s2 * w4.x; a2.y += s2 * w4.y; a2.z += s2 * w4.z; a2.w += s2 * w4.w; }
    __syncthreads();
    float4* red = (float4*)lds;
    red[(ksl * 3 + 0) * 16 + cg] = a0; red[(ksl * 3 + 1) * 16 + cg] = a1; red[(ksl * 3 + 2) * 16 + cg] = a2;
    __syncthreads();
    if (TIDX < 192) { const int j = TIDX / 64, c = TIDX % 64; const float* rf = lds;
      float a = p.ada_b[l * 6144 + (u % 96) * 64 + c];
      for (int q = 0; q < 32; ++q) a += rf[((q * 3 + j) * 16 + (c >> 2)) * 4 + (c & 3)];
      ((float*)(p.ws + OFF_MOD))[(size_t)(l * 3 + j) * 6144 + (u % 96) * 64 + c] = a; }
  }
}

__device__ __forceinline__ void ph_topk_fast(const Params& p, int nseq, char* smem) {
  const int TIDX = ltid(); const int BIDX = lbid();
  unsigned* keys = (unsigned*)smem;
  unsigned* hist = keys + 8192;
  unsigned* ctl = hist + 256;
  unsigned* scn = ctl + 8;
  for (int prob = BIDX; prob < nseq * NE; prob += gridDim.x) {
    const int s = prob >> 4, e = prob & 15;
    const int tlen = s < 2 ? T : TC, cap = s < 2 ? CAPL : CAPC, r0 = s < 2 ? s * T : ML + (s - 2) * TC;
    const float* a = (const float*)(p.ws + OFF_AFFT) + (size_t)e * MR + r0;
    __syncthreads();
    for (int i = TIDX; i < tlen; i += NT) keys[i] = __float_as_uint(a[i]);
    if (TIDX == 0) { ctl[0] = 0u; ctl[1] = (unsigned)cap; }
    __syncthreads();
    for (int pass = 0; pass < 4; ++pass) {
      const int shift = 24 - 8 * pass;
      if (TIDX < 256) hist[TIDX] = 0u;
      __syncthreads();
      const unsigned prefix = ctl[0], want = ctl[1];
      const unsigned himask = pass == 0 ? 0u : (0xffffffffu << (shift + 8));
      { unsigned cur = 0u, cnt = 0u;
        for (int i = TIDX; i < tlen; i += NT) { const unsigned k = keys[i];
          if ((k & himask) == prefix) { const unsigned dgt = (k >> shift) & 255u; if (dgt == cur) ++cnt; else { if (cnt) atomicAdd(&hist[cur], cnt); cur = dgt; cnt = 1u; } } }
        if (cnt) atomicAdd(&hist[cur], cnt); }
      __syncthreads();
      if (TIDX < 256) {
        const unsigned mine = hist[TIDX];
        unsigned inc = mine;
#pragma unroll
        for (int o = 1; o < 64; o <<= 1) { const unsigned n = __shfl_down(inc, o); if ((TIDX & 63) + o < 64) inc += n; }
        if ((TIDX & 63) == 0) scn[TIDX >> 6] = inc;
        __builtin_amdgcn_s_waitcnt(0);
      }
      __syncthreads();
      if (TIDX < 256) {
        const unsigned mine = hist[TIDX];
        unsigned inc = mine;
#pragma unroll
        for (int o = 1; o < 64; o <<= 1) { const unsigned n = __shfl_down(inc, o); if ((TIDX & 63) + o < 64) inc += n; }
        unsigned above = inc - mine;
        for (int w = (TIDX >> 6) + 1; w < 4; ++w) above += scn[w];
        if (above < want && above + mine >= want) { ctl[2] = prefix | ((unsigned)TIDX << shift); ctl[3] = want - above; }
      }
      __syncthreads();
      if (TIDX == 0) { ctl[0] = ctl[2]; ctl[1] = ctl[3]; }
      __syncthreads();
    }
    const unsigned thr = ctl[0], weq = ctl[1];
    const int per = tlen / NT > 0 ? tlen / NT : 1, nthr = tlen / per, t0 = TIDX * per;
    unsigned cnt = 0u;
    if (TIDX < nthr) for (int i = 0; i < per; ++i) { const unsigned k = keys[t0 + i]; cnt += (k > thr ? 0x10000u : 0u) + (k == thr ? 1u : 0u); }
    unsigned inc = cnt;
#pragma unroll
    for (int o = 1; o < 64; o <<= 1) { const unsigned n = __shfl_up(inc, o); if ((TIDX & 63) >= o) inc += n; }
    if ((TIDX & 63) == 63) scn[TIDX >> 6] = inc;
    __syncthreads();
    unsigned base = 0u;
    for (int w = 0; w < (TIDX >> 6); ++w) base += scn[w];
    unsigned run = base + inc - cnt;
    int* idx = (int*)(p.ws + OFF_IDX); float* gate = (float*)(p.ws + OFF_GATE); int* slot = (int*)(p.ws + OFF_SLOT);
    const int pb = pair_base(s, e);
    if (TIDX < nthr) for (int i = 0; i < per; ++i) {
      const unsigned k = keys[t0 + i]; const unsigned ngt = run >> 16, neq = run & 0xffffu;
      const unsigned eqtaken = neq < weq ? neq : weq;
      int sl = -1;
      if (k > thr) sl = (int)(ngt + eqtaken);
      else if (k == thr && neq < weq) sl = (int)(ngt + neq);
      if (sl >= 0) { idx[pb + sl] = r0 + t0 + i; gate[pb + sl] = __uint_as_float(k); }
      slot[(size_t)(r0 + t0 + i) * 16 + e] = sl;
      run += (k > thr ? 0x10000u : 0u) + (k == thr ? 1u : 0u);
    }
  }
}
__device__ __forceinline__ void ph_combine_fast(const Params& p, int l, int nrows, int next_l) {
  const int TIDX = ltid(); const int BIDX = lbid();
  const int lane = TIDX & 63, wv = TIDX >> 6;
  const bf16_t* Y = (const bf16_t*)(p.ws + OFF_Y);
  for (int r4 = (BIDX + gridDim.x * wv) * 4; r4 < nrows; r4 += gridDim.x * 8 * 4) {
    int mj, t, tlen, r0; rowinfo(r4, mj, t, tlen, r0);
    const int s = r4 < ML ? (r4 >> 13) : 2 + ((r4 - ML) >> 8);
    const int slot4 = ((const int*)(p.ws + OFF_SLOT))[(size_t)r4 * 16 + lane];
    const unsigned long long vm = __ballot(slot4 >= 0);
    const int pairl = pair_base(s, lane & 15) + slot4;
    float4 xv[4][4]; uint4 ya[4][2][2]; int nsel[4];
    float* xr[4];
#pragma unroll
    for (int rr = 0; rr < 4; ++rr) { xr[rr] = xrow(p, r4 + rr);
#pragma unroll
      for (int hf = 0; hf < 2; ++hf) { const uint4 xb4 = ld_nt_u4((const bf16_t*)xr[rr] + hf * 512 + lane * 8);
        xv[rr][hf * 2 + 0] = make_float4(__uint_as_float(xb4.x << 16), __uint_as_float(xb4.x & 0xffff0000u), __uint_as_float(xb4.y << 16), __uint_as_float(xb4.y & 0xffff0000u));
        xv[rr][hf * 2 + 1] = make_float4(__uint_as_float(xb4.z << 16), __uint_as_float(xb4.z & 0xffff0000u), __uint_as_float(xb4.w << 16), __uint_as_float(xb4.w & 0xffff0000u)); } }
#pragma unroll
    for (int rr = 0; rr < 4; ++rr) {
      unsigned m16 = (unsigned)(vm >> (rr * 16)) & 0xffffu; nsel[rr] = __builtin_popcount(m16);
#pragma unroll
      for (int k = 0; k < 2; ++k) {
        if (m16) { const int e = __builtin_ctz(m16); m16 &= m16 - 1; const int pr = __builtin_amdgcn_readlane(pairl, rr * 16 + e);
          const bf16_t* yr = Y + (size_t)pr * D; ya[rr][k][0] = ld_nt_u4(yr + lane * 8); ya[rr][k][1] = ld_nt_u4(yr + 512 + lane * 8); }
        else { ya[rr][k][0] = make_uint4(0u, 0u, 0u, 0u); ya[rr][k][1] = make_uint4(0u, 0u, 0u, 0u); }
      }
    }
    const float* g2 = modvec(p, l, mj, 5);
    float4 gq[4];
#pragma unroll
    for (int hf = 0; hf < 2; ++hf)
#pragma unroll
      for (int q = 0; q < 2; ++q) gq[hf * 2 + q] = *(const float4*)(g2 + hf * 512 + lane * 8 + q * 4);
    asm volatile("s_waitcnt vmcnt(0)" ::: "memory");
#pragma unroll
    for (int rr = 0; rr < 4; ++rr) {
      float acc[16];
#pragma unroll
      for (int i = 0; i < 16; ++i) acc[i] = 0.f;
#pragma unroll
      for (int k = 0; k < 2; ++k)
#pragma unroll
        for (int hf = 0; hf < 2; ++hf) { const unsigned w[4] = {ya[rr][k][hf].x, ya[rr][k][hf].y, ya[rr][k][hf].z, ya[rr][k][hf].w};
#pragma unroll
          for (int i = 0; i < 4; ++i) { acc[hf * 8 + 2 * i] += __uint_as_float(w[i] << 16); acc[hf * 8 + 2 * i + 1] += __uint_as_float(w[i] & 0xffff0000u); } }
      if (nsel[rr] > 2) {
        unsigned m16 = (unsigned)(vm >> (rr * 16)) & 0xffffu; m16 &= m16 - 1; m16 &= m16 - 1;
        while (m16) { const int e = __builtin_ctz(m16); m16 &= m16 - 1; const int pr = __builtin_amdgcn_readlane(pairl, rr * 16 + e);
          const bf16_t* yr = Y + (size_t)pr * D; const uint4 a = *(const uint4*)(yr + lane * 8), bq = *(const uint4*)(yr + 512 + lane * 8);
          const unsigned w[8] = {a.x, a.y, a.z, a.w, bq.x, bq.y, bq.z, bq.w};
#pragma unroll
          for (int i = 0; i < 8; ++i) { acc[2 * i] += __uint_as_float(w[i] << 16); acc[2 * i + 1] += __uint_as_float(w[i] & 0xffff0000u); } }
      }
      float x[16], ss = 0.f;
#pragma unroll
      for (int hf = 0; hf < 2; ++hf)
#pragma unroll
        for (int q = 0; q < 2; ++q) { const int c = hf * 512 + lane * 8 + q * 4; float4 xq = xv[rr][hf * 2 + q]; const float4 gv = gq[hf * 2 + q];
          xq.x += gv.x * acc[hf * 8 + q * 4 + 0]; xq.y += gv.y * acc[hf * 8 + q * 4 + 1]; xq.z += gv.z * acc[hf * 8 + q * 4 + 2]; xq.w += gv.w * acc[hf * 8 + q * 4 + 3];
          if (next_l >= 0) { uint2 xb2; xb2.x = gd::pk(xq.x, xq.y); xb2.y = gd::pk(xq.z, xq.w); *(uint2*)((bf16_t*)xr[rr] + c) = xb2; }
          else st_nt_f4(xr[rr] + c, xq);
          x[hf * 8 + q * 4 + 0] = xq.x; x[hf * 8 + q * 4 + 1] = xq.y; x[hf * 8 + q * 4 + 2] = xq.z; x[hf * 8 + q * 4 + 3] = xq.w;
          ss += xq.x * xq.x + xq.y * xq.y + xq.z * xq.z + xq.w * xq.w; }
      if (next_l >= 0) {
        ss = wave_sum(ss);
        const float rstd = rsqrtf(ss / D + EPS);
        const float* g = p.norm1_g + next_l * D; const float* sh = modvec(p, next_l, mj, 0); const float* sc = modvec(p, next_l, mj, 1);
        bf16_t* h = (bf16_t*)(p.ws + OFF_H) + (size_t)(r4 + rr) * D;
#pragma unroll
        for (int hf = 0; hf < 2; ++hf) { const int c = hf * 512 + lane * 8; float y[8];
#pragma unroll
          for (int i = 0; i < 8; ++i) y[i] = x[hf * 8 + i] * rstd * g[c + i] * (1.f + sc[c + i]) + sh[c + i];
          uint4 w; w.x = gd::pk(y[0], y[1]); w.y = gd::pk(y[2], y[3]); w.z = gd::pk(y[4], y[5]); w.w = gd::pk(y[6], y[7]);
          *(uint4*)(h + c) = w; }
      }
    }
  }
}
template <class RowPtr>
__device__ __forceinline__ gd::f32x4 coop_tile_32x64(RowPtr arow, const bf16_t* Bt, int ldb, int K, float* lds, int wv, int lane) {
  using gd::bf16x8; using gd::f32x4;
  const int cc = lane & 15, g = lane >> 4;
  const bf16_t* a0 = arow(cc) + g * 8; const bf16_t* a1 = arow(16 + cc) + g * 8;
  f32x4 acc[2][4];
#pragma unroll
  for (int m = 0; m < 2; ++m)
#pragma unroll
    for (int n = 0; n < 4; ++n) acc[m][n] = (f32x4){0.f, 0.f, 0.f, 0.f};
  for (int ks = wv; ks < K / 32; ks += 8) {
    const bf16x8 A0 = *(const bf16x8*)(a0 + ks * 32), A1 = *(const bf16x8*)(a1 + ks * 32);
#pragma unroll
    for (int n = 0; n < 4; ++n) { const bf16x8 B = *(const bf16x8*)(Bt + (size_t)(n * 16 + cc) * ldb + ks * 32 + g * 8);
      acc[0][n] = __builtin_amdgcn_mfma_f32_16x16x32_bf16(A0, B, acc[0][n], 0, 0, 0); acc[1][n] = __builtin_amdgcn_mfma_f32_16x16x32_bf16(A1, B, acc[1][n], 0, 0, 0); }
  }
  gd::lds_barrier();
#pragma unroll
  for (int m = 0; m < 2; ++m)
#pragma unroll
    for (int n = 0; n < 4; ++n) *(f32x4*)(lds + ((wv * 8 + m * 4 + n) * 64 + lane) * 4) = acc[m][n];
  gd::lds_barrier();
  f32x4 r = {0.f, 0.f, 0.f, 0.f};
#pragma unroll
  for (int w = 0; w < 8; ++w) r += *(const f32x4*)(lds + ((w * 8 + wv) * 64 + lane) * 4);
  return r;
}
__device__ __forceinline__ void ph_ctx_moe_gu(const Params& p, float* lds) {
  const int TIDX = ltid(); const int BIDX = lbid();
  const int lane = TIDX & 63, wv = TIDX >> 6, cc = lane & 15, g = lane >> 4;
  const bf16_t* H = (const bf16_t*)(p.ws + OFF_H); const bf16_t* GU = (const bf16_t*)(p.ws + OFF_MOEGU); bf16_t* hid = (bf16_t*)(p.ws + OFF_HID);
  const int* idx = (const int*)(p.ws + OFF_IDX);
  for (int it = BIDX; it < 32 * 16; it += gridDim.x) {
    const int grp = 32 + (it >> 4), ns = it & 15, s = grp >> 4, e = grp & 15, pb = pair_base(s, e);
    const gd::f32x4 v4 = coop_tile_32x64([&](int r) { return H + (size_t)idx[pb + r] * D; }, GU + (size_t)e * D * D + (size_t)(ns * 64) * D, D, D, lds, wv, lane);
    const int m = wv >> 2, n = wv & 3;
#pragma unroll
    for (int r = 0; r < 4; ++r) { const float v = v4[r], o = __shfl_xor(v, 1);
      if ((cc & 1) == 0) hid[(size_t)(pb + m * 16 + g * 4 + r) * DEXP + ((ns * 64 + n * 16 + cc) >> 1)] = f2bf(silu_f(v) * o); }
  }
}
__device__ __forceinline__ void ph_ctx_moe_down(const Params& p, float* lds) {
  const int TIDX = ltid(); const int BIDX = lbid();
  const int lane = TIDX & 63, wv = TIDX >> 6, cc = lane & 15, g = lane >> 4;
  const bf16_t* hid = (const bf16_t*)(p.ws + OFF_HID); const bf16_t* DN = (const bf16_t*)(p.ws + OFF_MOED); bf16_t* Y = (bf16_t*)(p.ws + OFF_Y);
  const float* gate = (const float*)(p.ws + OFF_GATE);
  for (int it = BIDX; it < 32 * 16; it += gridDim.x) {
    const int grp = 32 + (it >> 4), ns = it & 15, s = grp >> 4, e = grp & 15, pb = pair_base(s, e);
    const gd::f32x4 v4 = coop_tile_32x64([&](int r) { return hid + (size_t)(pb + r) * DEXP; }, DN + (size_t)e * D * DEXP + (size_t)(ns * 64) * DEXP, DEXP, DEXP, lds, wv, lane);
    const int m = wv >> 2, n = wv & 3;
#pragma unroll
    for (int r = 0; r < 4; ++r) { const int row = pb + m * 16 + g * 4 + r; Y[(size_t)row * D + ns * 64 + n * 16 + cc] = f2bf(v4[r] * gate[row]); }
  }
}
__device__ __forceinline__ void ph_ctx_outproj(const Params& p, int l, float* lds) {
  const int TIDX = ltid(); const int BIDX = lbid();
  const int lane = TIDX & 63, wv = TIDX >> 6, cc = lane & 15, g = lane >> 4;
  const bf16_t* A = (const bf16_t*)(p.ws + OFF_H) + (size_t)ML * D; const bf16_t* W = (const bf16_t*)(p.ws + OFF_WOUTT) + (size_t)l * D * D;
  bf16_t* yo = (bf16_t*)(p.ws + OFF_YO) + (size_t)ML * D;
  for (int it = BIDX; it < 16 * 16; it += gridDim.x) {
    const int mt = it >> 4, ns = it & 15;
    const gd::f32x4 v4 = coop_tile_32x64([&](int r) { return A + (size_t)(mt * 32 + r) * D; }, W + (size_t)(ns * 64) * D, D, D, lds, wv, lane);
    const int m = wv >> 2, n = wv & 3;
#pragma unroll
    for (int r = 0; r < 4; ++r) yo[(size_t)(mt * 32 + m * 16 + g * 4 + r) * D + ns * 64 + n * 16 + cc] = f2bf(v4[r]);
  }
}
__device__ __forceinline__ void ph_modulate2_fast(const Params& p, int l, int nrows, float* lds) {
  const int TIDX = ltid(); const int BIDX = lbid();
  const int lane = TIDX & 63, wv = TIDX >> 6;
  __syncthreads();
  { const float* wr = p.router + (size_t)l * D * NE;
    for (int i = TIDX; i < D * 4; i += NT) { const int c = i >> 2, q = i & 3, pr = (c & ~255) + (c & 3) * 64 + ((c >> 2) & 63);
      *(float4*)(lds + pr * 20 + q * 4) = *(const float4*)(wr + c * 16 + q * 4); } }
  __syncthreads();
  const float* g = p.norm2_g + l * D;
  for (int r4 = (BIDX + gridDim.x * wv) * 4; r4 < nrows; r4 += gridDim.x * 8 * 4) {
    int mj, t, tlen, r0; rowinfo(r4, mj, t, tlen, r0);
    const float* sh = modvec(p, l, mj, 3); const float* sc = modvec(p, l, mj, 4);
    float4 xv[4][4], gv[4], sv[4], hv[4];
#pragma unroll
    for (int rr = 0; rr < 4; ++rr) xv[rr][0] = xv[rr][1] = xv[rr][2] = xv[rr][3] = make_float4(0.f, 0.f, 0.f, 0.f);
    if (l == 0) {
#pragma unroll
      for (int rr = 0; rr < 4; ++rr) { const float* xr = xrow_src(p, r4 + rr, 0);
#pragma unroll
        for (int i = 0; i < 4; ++i) xv[rr][i] = ld_nt_f4(xr + i * 256 + lane * 4); }
    } else {
#pragma unroll
      for (int rr = 0; rr < 4; ++rr) { const bf16_t* xr = (const bf16_t*)xrow_src(p, r4 + rr, 1);
#pragma unroll
        for (int i = 0; i < 4; ++i) { const uint2 v = ld_nt_u2(xr + i * 256 + lane * 4);
          xv[rr][i] = make_float4(__uint_as_float(v.x << 16), __uint_as_float(v.x & 0xffff0000u), __uint_as_float(v.y << 16), __uint_as_float(v.y & 0xffff0000u)); } }
    }
    {
      const float* g1 = modvec(p, l, mj, 2); const bf16_t* yo = (const bf16_t*)(p.ws + OFF_YO);
#pragma unroll
      for (int i = 0; i < 4; ++i) { const int c = i * 256 + lane * 4; const float4 gg = *(const float4*)(g1 + c);
#pragma unroll
        for (int rr = 0; rr < 4; ++rr) { const uint2 yv = ld_nt_u2(yo + (size_t)(r4 + rr) * D + c);
          xv[rr][i].x += gg.x * __uint_as_float(yv.x << 16); xv[rr][i].y += gg.y * __uint_as_float(yv.x & 0xffff0000u);
          xv[rr][i].z += gg.z * __uint_as_float(yv.y << 16); xv[rr][i].w += gg.w * __uint_as_float(yv.y & 0xffff0000u);
          uint2 xb2; xb2.x = gd::pk(xv[rr][i].x, xv[rr][i].y); xb2.y = gd::pk(xv[rr][i].z, xv[rr][i].w);
          *(uint2*)((bf16_t*)xrow(p, r4 + rr) + c) = xb2; } }
    }
#pragma unroll
    for (int i = 0; i < 4; ++i) { const int c = i * 256 + lane * 4; gv[i] = *(const float4*)(g + c); sv[i] = *(const float4*)(sc + c); hv[i] = *(const float4*)(sh + c); }
#pragma unroll
    for (int rr = 0; rr < 4; ++rr) {
      const int r = r4 + rr;
      float ss = 0.f;
#pragma unroll
      for (int i = 0; i < 4; ++i) ss += xv[rr][i].x * xv[rr][i].x + xv[rr][i].y * xv[rr][i].y + xv[rr][i].z * xv[rr][i].z + xv[rr][i].w * xv[rr][i].w;
      ss = wave_sum(ss);
      const float rstd = rsqrtf(ss / D + EPS);
      bf16_t* h = (bf16_t*)(p.ws + OFF_H) + (size_t)r * D;
      float lo[16];
#pragma unroll
      for (int e = 0; e < 16; ++e) lo[e] = 0.f;
#pragma unroll
      for (int i = 0; i < 4; ++i) {
        const int c = i * 256 + lane * 4;
        float y[4];
        y[0] = xv[rr][i].x * rstd * gv[i].x * (1.f + sv[i].x) + hv[i].x; y[1] = xv[rr][i].y * rstd * gv[i].y * (1.f + sv[i].y) + hv[i].y;
        y[2] = xv[rr][i].z * rstd * gv[i].z * (1.f + sv[i].z) + hv[i].z; y[3] = xv[rr][i].w * rstd * gv[i].w * (1.f + sv[i].w) + hv[i].w;
        uint2 w; w.x = gd::pk(y[0], y[1]); w.y = gd::pk(y[2], y[3]);
        *(uint2*)(h + c) = w;
#pragma unroll
        for (int q = 0; q < 4; ++q) {
          const float* wrow = lds + (i * 256 + q * 64 + lane) * 20;
#pragma unroll
          for (int e4 = 0; e4 < 4; ++e4) { const float4 w4 = *(const float4*)(wrow + e4 * 4);
            lo[e4 * 4 + 0] += y[q] * w4.x; lo[e4 * 4 + 1] += y[q] * w4.y; lo[e4 * 4 + 2] += y[q] * w4.z; lo[e4 * 4 + 3] += y[q] * w4.w; }
        }
      }
#pragma unroll
      for (int k = 0; k < 4; ++k) {
        const int half = 8 >> k, mask = 32 >> k; const bool upper = (lane & mask) != 0;
#pragma unroll
        for (int i = 0; i < half; ++i) { const float send = upper ? lo[i] : lo[i + half]; const float recv = __shfl_xor(send, mask); lo[i] = (upper ? lo[i + half] : lo[i]) + recv; }
      }
      float v = lo[0]; v += __shfl_xor(v, 1); v += __shfl_xor(v, 2);
      float mx = v;
      mx = fmaxf(mx, __shfl_xor(mx, 4)); mx = fmaxf(mx, __shfl_xor(mx, 8)); mx = fmaxf(mx, __shfl_xor(mx, 16)); mx = fmaxf(mx, __shfl_xor(mx, 32));
      const float ex = expf(v - mx);
      float sm = ex; sm += __shfl_xor(sm, 4); sm += __shfl_xor(sm, 8); sm += __shfl_xor(sm, 16); sm += __shfl_xor(sm, 32);
      if ((lane & 3) == 0) { const int e = ((lane >> 5) & 1) * 8 + ((lane >> 4) & 1) * 4 + ((lane >> 3) & 1) * 2 + ((lane >> 2) & 1);
        ((float*)(p.ws + OFF_AFFT))[(size_t)e * MR + r] = ex / sm; }
    }
  }
}

__device__ __forceinline__ void ph_modulate1_fast(const Params& p) {
  const int TIDX = ltid(); const int BIDX = lbid();
  const int lane = TIDX & 63, wv = TIDX >> 6;
  const float* g = p.norm1_g;
  for (int r2 = (BIDX + gridDim.x * wv) * 2; r2 < MR; r2 += gridDim.x * 8 * 2) {
    int mj, t, tlen, r0; rowinfo(r2, mj, t, tlen, r0);
    const float* sh = modvec(p, 0, mj, 0); const float* sc = modvec(p, 0, mj, 1);
    float4 xv[2][4];
#pragma unroll
    for (int rr = 0; rr < 2; ++rr) { const float* xr = xrow_src(p, r2 + rr, 0);
#pragma unroll
      for (int i = 0; i < 4; ++i) xv[rr][i] = ld_nt_f4(xr + i * 256 + lane * 4); }
    float4 gv[4], sv[4], hv[4];
#pragma unroll
    for (int i = 0; i < 4; ++i) { const int c = i * 256 + lane * 4; gv[i] = *(const float4*)(g + c); sv[i] = *(const float4*)(sc + c); hv[i] = *(const float4*)(sh + c); }
#pragma unroll
    for (int rr = 0; rr < 2; ++rr) {
      float ss = 0.f;
#pragma unroll
      for (int i = 0; i < 4; ++i) ss += xv[rr][i].x * xv[rr][i].x + xv[rr][i].y * xv[rr][i].y + xv[rr][i].z * xv[rr][i].z + xv[rr][i].w * xv[rr][i].w;
      ss = wave_sum(ss);
      const float rstd = rsqrtf(ss / D + EPS);
      bf16_t* h = (bf16_t*)(p.ws + OFF_H) + (size_t)(r2 + rr) * D;
#pragma unroll
      for (int i = 0; i < 4; ++i) { const int c = i * 256 + lane * 4;
        uint2 w; w.x = gd::pk(xv[rr][i].x * rstd * gv[i].x * (1.f + sv[i].x) + hv[i].x, xv[rr][i].y * rstd * gv[i].y * (1.f + sv[i].y) + hv[i].y);
        w.y = gd::pk(xv[rr][i].z * rstd * gv[i].z * (1.f + sv[i].z) + hv[i].z, xv[rr][i].w * rstd * gv[i].w * (1.f + sv[i].w) + hv[i].w);
        *(uint2*)(h + c) = w; }
    }
  }
}

constexpr size_t LDS_BYTES = 163840;
__global__ void __launch_bounds__(NT, 2) mega(Params p) {
  extern __shared__ __attribute__((aligned(16))) char smem[];
  float* lds = (float*)smem;
  volatile LAS unsigned* xbst = (volatile LAS unsigned*)(smem + LDS_BYTES - 16);
  if (threadIdx.x == 0) { xbst[0] = 0u; xbst[1] = 0u; xbst[2] = 0u; xbst[3] = 0u; }
  __syncthreads();
  XcdBarrier xb = xcd_barrier_post((unsigned*)(p.ws + OFF_BAR), xbst);
  cg::grid_group grid = cg::this_grid();

  if (p.ws == nullptr) grid.sync();
  for (int l = 0; l < 2; ++l) {
    const bool need_ctx = l == 0;
    const int nrows = need_ctx ? MR : ML, nseq = need_ctx ? 4 : 2;
    if (l == 0) { ph_ada_fast(p, lds); ph_prep_weights(p, lds); xcd_barrier(xb); ph_modulate1_fast(p); xcd_barrier(xb); }
    for (int _r = 0; _r < REP_INPROJ; ++_r) ph_inproj_fast(p, l, smem);
    xcd_barrier(xb);
    for (int _r = 0; _r < REP_PRE; ++_r) ph_gdn_precompute(p, l, smem);
    ph_mla_gemm(p, l, smem);
    xcd_barrier(xb);
    for (int _r = 0; _r < REP_MLA; ++_r) ph_mla_finish(p, l);
    xcd_barrier(xb);
    for (int _r = 0; _r < REP_SCAN; ++_r) ph_scan_fast(p, smem);
    for (int _r = 0; _r < REP_ATTN; ++_r) ph_attn_fast(p, need_ctx, smem);
    ph_pool_mfma(p, l, nrows, smem);
    xcd_barrier(xb);
    ph_gdnfin_pool_fast<2>(p, l, nrows, lds, 0, (int)gridDim.x);
    xcd_barrier(xb);
    ph_outproj_fast(p, l, smem);
    if (need_ctx) ph_ctx_outproj(p, l, lds);
    xcd_barrier(xb);
    for (int _r = 0; _r < REP_MOD; ++_r) ph_modulate2_fast(p, l, nrows, lds);
    xcd_barrier(xb);
    for (int _r = 0; _r < REP_TOPK; ++_r) ph_topk_fast(p, nseq, smem);
    ph_prep_moe_weights(p, l, lds, 0, (int)gridDim.x);
    xcd_barrier(xb);
    for (int _r = 0; _r < REP_MOEGU; ++_r) ph_moe_gu_fast(p, smem);
    if (need_ctx) ph_ctx_moe_gu(p, lds);
    xcd_barrier(xb);
    ph_moe_down_fast(p, smem);
    if (need_ctx) ph_ctx_moe_down(p, lds);
    xcd_barrier(xb);
    ph_combine_fast(p, l, nrows, l == 0 ? 1 : -1);
    xcd_barrier(xb);
  }
}

extern "C" void kernel_launch(void* const* d_in, const int* in_sizes, int n_in, void* d_out, int out_size, void* d_ws, size_t ws_size, hipStream_t stream) {
  static int grid_blocks = 0;
  if (ws_size < OFF_END) { fprintf(stderr, "kernel_launch: workspace too small: %zu < %zu\n", ws_size, (size_t)OFF_END); return; }
  if (!grid_blocks) {
    if (hipFuncSetAttribute((const void*)mega, hipFuncAttributeMaxDynamicSharedMemorySize, (int)LDS_BYTES) != hipSuccess) { fprintf(stderr, "kernel_launch: hipFuncSetAttribute failed\n"); return; }
    int dev = 0, cus = 0, per_cu = 0;
    hipGetDevice(&dev);
    hipDeviceGetAttribute(&cus, hipDeviceAttributeMultiprocessorCount, dev);
    hipOccupancyMaxActiveBlocksPerMultiprocessor(&per_cu, mega, NT, LDS_BYTES);
    if (per_cu < 1) { fprintf(stderr, "kernel_launch: occupancy query returned %d\n", per_cu); return; }
    grid_blocks = cus;
  }
  Params p{};
  const float** f = (const float**)&p;
  for (int i = 0; i < 26; ++i) f[i] = (const float*)d_in[i];
  p.out = (float*)d_out; p.ws = (char*)d_ws;
  hipMemsetAsync((char*)d_ws + OFF_BAR, 0, 16384, stream);
  void* args[] = {&p};
  hipError_t e = hipLaunchCooperativeKernel((const void*)mega, dim3(grid_blocks), dim3(NT), args, LDS_BYTES, stream);
  if (e != hipSuccess) fprintf(stderr, "cooperative launch failed: %s (grid %d)\n", hipGetErrorString(e), grid_blocks);
}
```

```cpp
#include <hip/hip_runtime.h>
#include <hip/hip_bf16.h>
#include <hip/hip_cooperative_groups.h>
#include <cstdint>
#include <cstdio>
namespace cg = cooperative_groups;
#define REP_SCAN 1
#define REP_ATTN 1
#define REP_PRE 1
#define REP_MLA 1
#define REP_PMW 1
#define REP_TOPK 1
#define REP_GATHER 1
#define REP_INPROJ 1
#define REP_MOEGU 1
#define REP_MOD 1
#define REP_FIN 1
#define REP_INIT 1

constexpr int D = 1024, NB = 2, T = 8192, TC = 256;
constexpr int ML = NB * T;
constexpr int MC = NB * TC;
constexpr int MR = ML + MC;
constexpr int NIN = 2672, NINP = 2816;
constexpr int NE = 16, DEXP = 512, CAPL = 1024, CAPC = 32;
constexpr int NPAIR = NB * NE * CAPL + NB * NE * CAPC;
constexpr int TK = TC + T;
constexpr float EPS = 1e-6f;
constexpr int NT = 512;
constexpr int PC_Q = 0, PC_KV = 192, PC_KR = 320, PC_GQ = 352, PC_GK = 864, PC_GV = 1376, PC_Z = 1888, PC_A = 2400, PC_B = 2408, PC_POOL = 2416;
constexpr int PC_OF = 352, PC_OB = 864;

typedef unsigned short bf16_t;
__device__ __forceinline__ float bf2f(bf16_t b) { return __uint_as_float(((unsigned)b) << 16); }
__device__ __forceinline__ bf16_t f2bf(float f) { unsigned u = __float_as_uint(f); u += 0x7FFFu + ((u >> 16) & 1u); return (bf16_t)(u >> 16); }
__device__ __forceinline__ float silu_f(float x) { return x * __builtin_amdgcn_rcpf(1.0f + __expf(-x)); }
__device__ __forceinline__ float sigmoid_f(float x) { return 1.0f / (1.0f + expf(-x)); }
__device__ __forceinline__ float softplus_f(float x) {
  if (x > 20.f) return x;
  const float y = __expf(x);
  return y < 0.0625f ? y * (1.f - y * (0.5f - y * (0.333333343f - 0.25f * y))) : __logf(1.f + y);
}

typedef float f4v_t __attribute__((ext_vector_type(4))); typedef unsigned u2v_t __attribute__((ext_vector_type(2))); typedef unsigned u4v_t __attribute__((ext_vector_type(4)));
__device__ __forceinline__ float4 ld_nt_f4(const float* q) { const f4v_t v = __builtin_nontemporal_load((const f4v_t*)q); return make_float4(v[0], v[1], v[2], v[3]); }
__device__ __forceinline__ uint2 ld_nt_u2(const void* q) { const u2v_t v = __builtin_nontemporal_load((const u2v_t*)q); return make_uint2(v[0], v[1]); }
__device__ __forceinline__ uint4 ld_nt_u4(const void* q) { const u4v_t v = __builtin_nontemporal_load((const u4v_t*)q); return make_uint4(v[0], v[1], v[2], v[3]); }
__device__ __forceinline__ void st_nt_f4(float* q, const float4 v) { const f4v_t w = {v.x, v.y, v.z, v.w}; __builtin_nontemporal_store(w, (f4v_t*)q); }
constexpr size_t al256(size_t x) { return (x + 255) / 256 * 256; }
constexpr size_t OFF_BAR = 0;
constexpr size_t OFF_MOD = 16384;
constexpr size_t OFF_XC = al256(OFF_MOD + 2 * 3 * 6144 * 4);
constexpr size_t OFF_AFFT = al256(OFF_XC + (size_t)MC * D * 4);
constexpr size_t OFF_IDX = al256(OFF_AFFT + (size_t)NE * MR * 4);
constexpr size_t OFF_GATE = al256(OFF_IDX + (size_t)NPAIR * 4);
constexpr size_t OFF_SLOT = al256(OFF_GATE + (size_t)NPAIR * 4);
constexpr size_t OFF_GB = al256(OFF_SLOT + (size_t)MR * 16 * 4);
constexpr size_t OFF_H = al256(OFF_GB + (size_t)MR * 16 * 4);
constexpr size_t OFF_P = al256(OFF_H + (size_t)MR * D * 2);
constexpr size_t OFF_RB = al256(OFF_P + (size_t)MR * NINP * 2);
constexpr size_t RB_BYTES = (size_t)1056 * 100352;
constexpr size_t OFF_QKV = al256(OFF_RB + RB_BYTES);
constexpr size_t QK_ELEMS = (size_t)NB * 4 * TK * 128, V_ELEMS = (size_t)NB * 4 * TK * 64;
constexpr size_t OFF_WINT = al256(OFF_QKV + (2 * QK_ELEMS + V_ELEMS) * 2);
constexpr size_t OFF_WOUTT = al256(OFF_WINT + (size_t)2 * NINP * D * 2);
constexpr size_t OFF_WUP = al256(OFF_WOUTT + (size_t)2 * D * D * 2);
constexpr size_t OFF_MOEGU = al256(OFF_WUP + (size_t)2 * 1024 * 256 * 2);
constexpr size_t OFF_MOED = OFF_MOEGU + (size_t)NE * D * D * 2;
constexpr size_t OFF_END = al256(OFF_MOED + (size_t)NE * D * DEXP * 2);
constexpr size_t OFF_UPRAW = OFF_MOEGU;
constexpr size_t OFF_OPART = OFF_MOEGU;
constexpr size_t OFF_MLPART = OFF_OPART + (size_t)4 * ML * 256 * 2;
static_assert(OFF_MLPART + (size_t)4 * ML * 4 * 2 * 4 <= OFF_END, "partials must fit in the MoE weight region");
constexpr size_t OFF_HID = OFF_RB + (size_t)64 * 1024 * 1024;
constexpr size_t OFF_Y = OFF_P;
constexpr size_t OFF_YO = OFF_P;
constexpr size_t OFF_XS = OFF_P;


struct Params {
  const float* x; const float* c; const float* ctx; const float* c_ctx; const float* ada_w; const float* ada_b;
  const float* norm1_g; const float* norm2_g; const float* w_in; const float* q_a_norm; const float* w_uq; const float* kv_a_norm;
  const float* w_ukv; const float* q_norm; const float* k_norm; const float* conv_w; const float* a_log; const float* dt_bias;
  const float* gdn_norm_g; const float* pool_w; const float* pool_scale; const float* w_out; const float* router;
  const float* w_gate; const float* w_up; const float* w_down;
  float* out; char* ws;
};

__device__ __forceinline__ const float* xrow_src(const Params& p, int r, int l) { return l == 0 ? (r < ML ? p.x + (size_t)r * D : p.ctx + (size_t)(r - ML) * D) : (r < ML ? p.out + (size_t)r * D : (const float*)(p.ws + OFF_XC) + (size_t)(r - ML) * D); }
__device__ __forceinline__ float* xrow(const Params& p, int r) { return r < ML ? p.out + (size_t)r * D : (float*)(p.ws + OFF_XC) + (size_t)(r - ML) * D; }
__device__ __forceinline__ void rowinfo(int r, int& mj, int& t, int& tlen, int& r0) {
  if (r < ML) { mj = r >> 13; t = r & (T - 1); tlen = T; r0 = r - t; } else { int rc = r - ML; mj = 2; t = rc & (TC - 1); tlen = TC; r0 = r - t; }
}
__device__ __forceinline__ const float* modvec(const Params& p, int l, int mj, int chunk) { return (const float*)(p.ws + OFF_MOD) + ((size_t)(l * 3 + mj) * 6 + chunk) * D; }
__device__ __forceinline__ int pair_base(int s, int e) { return s < 2 ? (s * NE + e) * CAPL : NB * NE * CAPL + ((s - 2) * NE + e) * CAPC; }
__device__ __forceinline__ float wave_sum(float v) { for (int o = 32; o > 0; o >>= 1) v += __shfl_xor(v, o); return v; }

__device__ __forceinline__ int ltid() { int t = threadIdx.x; asm volatile("" : "+v"(t)); return t; }
__device__ __forceinline__ int lbid() { int t = blockIdx.x; asm volatile("" : "+s"(t)); return t; }
#define XB_TMO      128
#define XB_XCNT(j)  (256  + 64 * (j))
#define XB_XSUB(j)  (1280 + 64 * (j))
#define XB_XGEN(j)  (2304 + 64 * (j))
#define XB_TOP      3328
#define XB_TOPGEN   3392
#define XCD_BAR_WORDS 3456
#define XB_SPIN_CAP (1u << 22)
#define LAS __attribute__((address_space(3)))
__device__ __forceinline__ unsigned xb_ld(unsigned* p)              { return __hip_atomic_load(p, __ATOMIC_RELAXED, __HIP_MEMORY_SCOPE_AGENT); }
__device__ __forceinline__ unsigned xb_add(unsigned* p, unsigned v) { return __hip_atomic_fetch_add(p, v, __ATOMIC_RELAXED, __HIP_MEMORY_SCOPE_AGENT); }
__device__ __forceinline__ unsigned xb_xcc_id() { return (unsigned)__builtin_amdgcn_s_getreg((3 << 11) | 20) & 0xFu; }
#define XB_SPIN(cond, bar) do { unsigned _sp = 0; while (cond) { __builtin_amdgcn_s_sleep(1); \
    if ((++_sp & 255u) == 0u) { if (xb_ld(&(bar)[XB_TMO])) break; if (_sp > XB_SPIN_CAP) { atomicAdd(&(bar)[XB_TMO], 1u); break; } } } } while (0)
struct XcdBarrier { unsigned* bar; unsigned x; volatile LAS unsigned* st; };
__device__ __forceinline__ XcdBarrier xcd_barrier_post(unsigned* bar, volatile LAS unsigned* st) {
  XcdBarrier b; b.bar = bar; b.x = xb_xcc_id(); b.st = st;
  if (threadIdx.x == 0) (void)xb_add(&bar[XB_XCNT(b.x)], 1u);
  return b;
}
__device__ __forceinline__ void xcd_barrier_complete(unsigned* bar, unsigned x, unsigned& nloc, unsigned& nx) {
  const unsigned G = gridDim.x * gridDim.y * gridDim.z;
  unsigned sum, cnt, mine, sp = 0u;
  for (;;) {
    sum = 0u; cnt = 0u; mine = 0u;
#pragma unroll
    for (unsigned j = 0; j < 16; ++j) { const unsigned c = xb_ld(&bar[XB_XCNT(j)]); sum += c; cnt += (c > 0u) ? 1u : 0u; mine = (j == x) ? c : mine; }
    if (sum == G) break;
    __builtin_amdgcn_s_sleep(1);
    if ((++sp & 255u) == 0u) { if (xb_ld(&bar[XB_TMO])) break; if (sp > XB_SPIN_CAP) { atomicAdd(&bar[XB_TMO], 1u); break; } }
  }
  nloc = mine > 0u ? mine : 1u; nx = cnt > 0u ? cnt : 1u;
}
__device__ __forceinline__ void xcd_barrier(const XcdBarrier& b) {
  asm volatile("s_waitcnt vmcnt(0)" ::: "memory");
  __syncthreads();
  if (threadIdx.x == 0) {
    unsigned* bar = b.bar;
    __builtin_amdgcn_s_waitcnt(0);
    unsigned nloc = b.st[0], nx = b.st[1];
    if (nloc == 0u) { xcd_barrier_complete(bar, b.x, nloc, nx); b.st[0] = nloc; b.st[1] = nx; }
    const unsigned old = xb_add(&bar[XB_XSUB(b.x)], 1u);
    const unsigned gen = old / nloc;
    if (old + 1u == (gen + 1u) * nloc) {
      __builtin_amdgcn_fence(__ATOMIC_RELEASE, "agent");
      asm volatile("s_waitcnt vmcnt(0)" ::: "memory");
      const unsigned og = xb_add(&bar[XB_TOP], 1u);
      const unsigned tg = og / nx;
      if (og + 1u == (tg + 1u) * nx) xb_add(&bar[XB_TOPGEN], 1u);
      else XB_SPIN(xb_ld(&bar[XB_TOPGEN]) == tg, bar);
      __builtin_amdgcn_fence(__ATOMIC_ACQUIRE, "agent");
      xb_add(&bar[XB_XGEN(b.x)], 1u);
      asm volatile("s_waitcnt vmcnt(0)" ::: "memory");
    } else {
      XB_SPIN(xb_ld(&bar[XB_XGEN(b.x)]) == gen, bar);
      __builtin_amdgcn_fence(__ATOMIC_ACQUIRE, "agent");
      asm volatile("s_waitcnt vmcnt(0)" ::: "memory");
    }
  }
  __syncthreads();
}


namespace pg8 {
#define PG8_LAS __attribute__((address_space(3)))
typedef short bf16x8 __attribute__((ext_vector_type(8)));
typedef float f32x4 __attribute__((ext_vector_type(4)));
typedef unsigned u32x4 __attribute__((ext_vector_type(4)));
constexpr int BM = 256, BK = 64, HALF = 128, HTB = HALF * BK * 2, STAGE_BYTES = 8 * HTB, NXCD = 8, WGM = 8;
__host__ __device__ __forceinline__ int lds_byte(int r, int c) { const int st = (r >> 4) * 2 + (c >> 5), rr = r & 15, cc = c & 31, ob = rr * 64 + cc * 2; return st * 1024 + (ob ^ (((ob >> 9) & 1) << 5)); }
__host__ __device__ __forceinline__ void stage_rc(int b, int& R, int& C) { const int st = b / 1024, sb = b % 1024, swz = sb ^ (((sb >> 9) & 1) << 5); R = (st >> 1) * 16 + swz / 64; C = (st & 1) * 32 + (swz % 64) / 2; }
__host__ __device__ __forceinline__ int perm32(int rho) { const int n = rho >> 4, i = rho & 15; return 8 * (i >> 2) + 4 * n + (i & 3); }
struct Unit { int pm, pn; };
__device__ __forceinline__ unsigned cvt_pk_bf16(float lo, float hi) { unsigned r; asm volatile("v_cvt_pk_bf16_f32 %0, %1, %2" : "=v"(r) : "v"(lo), "v"(hi)); return r; }
struct GridOrder {
  int nM, nN, nwg, G, c;
  __device__ __forceinline__ void init(int nM_, int nN_, int G_, int c_) { nM = nM_; nN = nN_; nwg = nM * nN; G = G_; c = c_; }
  __device__ __forceinline__ bool next(int i, Unit& u) const {
    const long L = (long)i * G + c; if (L >= nwg) return false;
    int wgid = (int)L; { const int q = nwg / NXCD, r = nwg % NXCD, xcd = wgid % NXCD, off = wgid / NXCD; wgid = (xcd < r ? xcd * (q + 1) : r * (q + 1) + (xcd - r) * q) + off; }
    const int nig = WGM * nN, gid = wgid / nig, fm = gid * WGM, gsz = (nM - fm) < WGM ? (nM - fm) : WGM;
    u.pm = fm + ((wgid % nig) % gsz); u.pn = (wgid % nig) / gsz; return true;
  }
};
template <class Epi, class Sched, bool GATHER = false>
__device__ __forceinline__ void gemm_phase(PG8_LAS unsigned char* lds, const Sched& S, const Epi& E) {
  const int tid = ltid(), wid = __builtin_amdgcn_readfirstlane(tid >> 6), lane = tid & 63, wr = wid >> 2, wc = wid & 3, fr = lane & 15, fq = lane >> 4;
  const int K = S.K, nt = K / BK;
  unsigned voffA[2], voffB[2]; int RA[2], CA[2];
#pragma unroll
  for (int i = 0; i < 2; ++i) { int R, C; stage_rc(tid * 16 + i * 8192, R, C); const int Rb = Epi::PERM ? ((R & ~31) + perm32(R & 31)) : R;
    voffA[i] = (unsigned)(R * S.lda + C) * 2u; voffB[i] = (unsigned)(Rb * S.ldb + C) * 2u; RA[i] = R; CA[i] = C; }
  const size_t kstep = (size_t)(BK * 2);
  const size_t hstepA = GATHER ? 0 : (size_t)HALF * S.lda * 2, hstepB = (size_t)HALF * S.ldb * 2;
  unsigned vc[2][2], vn[2][2];
#define PG8_GOFF(dst, unit) do { if (GATHER) { _Pragma("unroll") for (int _h = 0; _h < 2; ++_h) _Pragma("unroll") for (int _i = 0; _i < 2; ++_i) \
    dst[_h][_i] = (unsigned)(S.gidx[(unit).pm * 256 + _h * HALF + RA[_i]] * S.lda + CA[_i]) * 2u; } } while (0)
#define PG8_STAGE_A(bufoff, gbase, half, usenext) do { if (GATHER) { unsigned _v[2] = {(usenext) ? vn[half][0] : vc[half][0], (usenext) ? vn[half][1] : vc[half][1]}; PG8_STAGE(bufoff, gbase, _v); } \
    else PG8_STAGE(bufoff, gbase, voffA); } while (0)
  const unsigned ldsw = (unsigned)wid * 1024u;
  const int aoff = lds_byte(wr * 64 + fr, fq * 8), boff = lds_byte(wc * 32 + fr, fq * 8);
#define PG8_SA(b, h) (((b) * 2 + (h)) * HTB)
#define PG8_SB(b, h) ((4 + (b) * 2 + (h)) * HTB)
#define PG8_STAGE(bufoff, gbase, voff) do { _Pragma("unroll") for (int _i = 0; _i < 2; ++_i) \
    __builtin_amdgcn_global_load_lds((const unsigned*)((const char*)(gbase) + (voff)[_i]), (PG8_LAS unsigned*)(lds + (bufoff) + ldsw + _i * 8192), 16, 0, 0); } while (0)
#define PG8_LDA(dst, b, h) do { _Pragma("unroll") for (int m = 0; m < 4; ++m) _Pragma("unroll") for (int k = 0; k < 2; ++k) dst[m][k] = *(const PG8_LAS bf16x8*)(lds + PG8_SA(b, h) + aoff + m * 2048 + k * 1024); } while (0)
#define PG8_LDB(dst, b, h) do { _Pragma("unroll") for (int n = 0; n < 2; ++n) _Pragma("unroll") for (int k = 0; k < 2; ++k) dst[n][k] = *(const PG8_LAS bf16x8*)(lds + PG8_SB(b, h) + boff + n * 2048 + k * 1024); } while (0)
#define PG8_MMA(ai, bj, At, Bt) do { __builtin_amdgcn_s_setprio(1); _Pragma("unroll") for (int m = 0; m < 4; ++m) _Pragma("unroll") for (int n = 0; n < 2; ++n) _Pragma("unroll") for (int k = 0; k < 2; ++k) \
    acc[ai][bj][m][n] = __builtin_amdgcn_mfma_f32_16x16x32_bf16(Bt[n][k], At[m][k], acc[ai][bj][m][n], 0, 0, 0); __builtin_amdgcn_s_setprio(0); } while (0)
#define PG8_WAIT_V(n) asm volatile("s_waitcnt vmcnt(" #n ")" ::: "memory")
#define PG8_WAIT_L(n) asm volatile("s_waitcnt lgkmcnt(" #n ")" ::: "memory")
#define PG8_BAR __builtin_amdgcn_s_barrier()
#define PG8_SCHED __builtin_amdgcn_sched_barrier(0)
  Unit cur, nxt; int ui = 0;
  if (!S.next(0, cur)) return;
  f32x4 acc[2][2][4][2];
#pragma unroll
  for (int a = 0; a < 2; ++a)
#pragma unroll
    for (int b = 0; b < 2; ++b)
#pragma unroll
      for (int m = 0; m < 4; ++m)
#pragma unroll
        for (int n = 0; n < 2; ++n) acc[a][b][m][n] = (f32x4){0.f, 0.f, 0.f, 0.f};
  bf16x8 At[4][2], B0[2][2], B1[2][2];
  const char* cA = S.a_ptr(cur); const char* cB = S.b_ptr(cur);
  PG8_GOFF(vc, cur);
  PG8_STAGE(PG8_SB(0, 0), cB, voffB); PG8_STAGE_A(PG8_SA(0, 0), cA, 0, false); PG8_STAGE(PG8_SB(0, 1), cB + hstepB, voffB); PG8_STAGE_A(PG8_SA(0, 1), cA + hstepA, 1, false);
  if (wr == 1) PG8_BAR;
  PG8_WAIT_V(4); PG8_BAR;
  PG8_STAGE(PG8_SB(1, 0), cB + kstep, voffB); PG8_STAGE_A(PG8_SA(1, 0), cA + kstep, 0, false); PG8_STAGE(PG8_SB(1, 1), cB + hstepB + kstep, voffB);
  PG8_WAIT_V(6); PG8_BAR;
  for (;;) {
    const bool has_next = S.next(ui + 1, nxt);
    const char* nA = has_next ? S.a_ptr(nxt) : cA; const char* nB = has_next ? S.b_ptr(nxt) : cB;
    if (has_next) PG8_GOFF(vn, nxt); else { _Pragma("unroll") for (int _h = 0; _h < 2; ++_h) _Pragma("unroll") for (int _i = 0; _i < 2; ++_i) vn[_h][_i] = vc[_h][_i]; }
    for (int t = 0; t < nt; t += 2) {
      const bool last = (t == nt - 2);
      const char* a1 = cA + (size_t)(t + 1) * kstep;
      const char* a2 = last ? nA : cA + (size_t)(t + 2) * kstep; const char* b2 = last ? nB : cB + (size_t)(t + 2) * kstep;
      const char* a3 = a2 + kstep; const char* b3 = b2 + kstep;
      PG8_LDB(B0, 0, 0); PG8_SCHED; PG8_LDA(At, 0, 0); PG8_STAGE_A(PG8_SA(1, 1), a1 + hstepA, 1, false);
      PG8_WAIT_L(8); PG8_BAR; PG8_WAIT_L(0); PG8_MMA(0, 0, At, B0); PG8_BAR; PG8_SCHED;
      PG8_LDB(B1, 0, 1); PG8_STAGE(PG8_SB(0, 0), b2, voffB);
      PG8_BAR; PG8_WAIT_L(0); PG8_MMA(0, 1, At, B1); PG8_BAR;
      PG8_LDA(At, 0, 1); PG8_STAGE_A(PG8_SA(0, 0), a2, 0, last);
      PG8_BAR; PG8_WAIT_L(0); PG8_MMA(1, 0, At, B0); PG8_BAR; PG8_SCHED;
      PG8_STAGE(PG8_SB(0, 1), b2 + hstepB, voffB);
      PG8_WAIT_V(6); PG8_BAR; PG8_MMA(1, 1, At, B1); PG8_BAR;
      PG8_LDB(B0, 1, 0); PG8_SCHED; PG8_LDA(At, 1, 0); PG8_STAGE_A(PG8_SA(0, 1), a2 + hstepA, 1, last);
      PG8_WAIT_L(8); PG8_BAR; PG8_WAIT_L(0); PG8_MMA(0, 0, At, B0); PG8_BAR; PG8_SCHED;
      PG8_LDB(B1, 1, 1); PG8_STAGE(PG8_SB(1, 0), b3, voffB);
      PG8_BAR; PG8_WAIT_L(0); PG8_MMA(0, 1, At, B1); PG8_BAR;
      PG8_LDA(At, 1, 1); PG8_STAGE_A(PG8_SA(1, 0), a3, 0, last);
      PG8_BAR; PG8_WAIT_L(0); PG8_MMA(1, 0, At, B0); PG8_BAR; PG8_SCHED;
      PG8_STAGE(PG8_SB(1, 1), b3 + hstepB, voffB);
      PG8_WAIT_V(6); PG8_BAR; PG8_MMA(1, 1, At, B1); PG8_BAR;
    }
    E(acc, cur, wr, wc, fr, fq);
    if (!has_next) break;
#pragma unroll
    for (int a = 0; a < 2; ++a)
#pragma unroll
      for (int b = 0; b < 2; ++b)
#pragma unroll
        for (int m = 0; m < 4; ++m)
#pragma unroll
          for (int n = 0; n < 2; ++n) acc[a][b][m][n] = (f32x4){0.f, 0.f, 0.f, 0.f};
    cur = nxt; cA = nA; cB = nB; ++ui;
    _Pragma("unroll") for (int _h = 0; _h < 2; ++_h) _Pragma("unroll") for (int _i = 0; _i < 2; ++_i) vc[_h][_i] = vn[_h][_i];
  }
  PG8_WAIT_V(0);
  if (wr == 0) PG8_BAR;
  PG8_BAR;
#undef PG8_SA
#undef PG8_SB
#undef PG8_STAGE
#undef PG8_STAGE_A
#undef PG8_GOFF
#undef PG8_LDA
#undef PG8_LDB
#undef PG8_MMA
#undef PG8_WAIT_V
#undef PG8_WAIT_L
#undef PG8_BAR
#undef PG8_SCHED
}
}

struct DenseSched : pg8::GridOrder {
  const char* A; const char* Bt; int lda, ldb, K; const int* gidx;
  __device__ __forceinline__ const char* a_ptr(const pg8::Unit& u) const { return A + (size_t)u.pm * 256 * lda * 2; }
  __device__ __forceinline__ const char* b_ptr(const pg8::Unit& u) const { return Bt + (size_t)u.pn * 256 * ldb * 2; }
};
struct EpiStoreBf16 {
  static constexpr bool PERM = true, AFTER_DRAIN = false;
  bf16_t* O; int ldc;
  __device__ __forceinline__ void operator()(const pg8::f32x4 (&acc)[2][2][4][2], const pg8::Unit& u, int wr, int wc, int fr, int fq) const {
    const int row0 = u.pm * 256 + wr * 64 + fr, col0 = u.pn * 256 + wc * 32 + 8 * fq;
#pragma unroll
    for (int ai = 0; ai < 2; ++ai)
#pragma unroll
      for (int m = 0; m < 4; ++m) { bf16_t* rowp = O + (size_t)(row0 + ai * 128 + m * 16) * ldc + col0;
#pragma unroll
        for (int bj = 0; bj < 2; ++bj) { const pg8::f32x4 v0 = acc[ai][bj][m][0], v1 = acc[ai][bj][m][1];
          pg8::u32x4 w; w.x = pg8::cvt_pk_bf16(v0[0], v0[1]); w.y = pg8::cvt_pk_bf16(v0[2], v0[3]); w.z = pg8::cvt_pk_bf16(v1[0], v1[1]); w.w = pg8::cvt_pk_bf16(v1[2], v1[3]);
          *(pg8::u32x4*)(rowp + bj * 128) = w; } }
  }
};
struct EpiResidual {
  static constexpr bool PERM = false, AFTER_DRAIN = false;
  float* xl; float* xc; const float* mod;
  int chunk;
  __device__ __forceinline__ void operator()(const pg8::f32x4 (&acc)[2][2][4][2], const pg8::Unit& u, int wr, int wc, int fr, int fq) const {
    const int mj = u.pm < 32 ? 0 : (u.pm < 64 ? 1 : 2);
    float* base = u.pm < 64 ? xl + (size_t)u.pm * 256 * D : xc + (size_t)(u.pm - 64) * 256 * D;
    const float* gv = mod + ((size_t)mj * 6 + chunk) * D;
    const int row0 = wr * 64 + fr, col0 = u.pn * 256 + wc * 32 + 4 * fq;
#pragma unroll
    for (int bj = 0; bj < 2; ++bj)
#pragma unroll
      for (int n = 0; n < 2; ++n) {
        const pg8::f32x4 g = *(const pg8::f32x4*)(gv + col0 + bj * 128 + n * 16);
#pragma unroll
        for (int ai = 0; ai < 2; ++ai)
#pragma unroll
          for (int m = 0; m < 4; ++m) { pg8::f32x4* q = (pg8::f32x4*)(base + (size_t)(row0 + ai * 128 + m * 16) * D + col0 + bj * 128 + n * 16); *q = *q + g * acc[ai][bj][m][n]; }
      }
  }
};
struct MoeSched : pg8::GridOrder {
  const char* A; const char* Bt; int lda, ldb, K; size_t bstride;
  const int* gidx; bool gather;
  __device__ __forceinline__ const char* a_ptr(const pg8::Unit& u) const { return gather ? A : A + (size_t)u.pm * 256 * lda * 2; }
  __device__ __forceinline__ const char* b_ptr(const pg8::Unit& u) const { return Bt + (size_t)((u.pm >> 2) & 15) * bstride + (size_t)u.pn * 256 * ldb * 2; }
};
struct EpiSwiGLU {
  static constexpr bool PERM = true, AFTER_DRAIN = false;
  bf16_t* O;
  __device__ __forceinline__ void operator()(const pg8::f32x4 (&acc)[2][2][4][2], const pg8::Unit& u, int wr, int wc, int fr, int fq) const {
    const int row0 = u.pm * 256 + wr * 64 + fr, col0 = u.pn * 128 + wc * 16 + 4 * fq;
#pragma unroll
    for (int ai = 0; ai < 2; ++ai)
#pragma unroll
      for (int m = 0; m < 4; ++m) { bf16_t* rowp = O + (size_t)(row0 + ai * 128 + m * 16) * DEXP + col0;
#pragma unroll
        for (int bj = 0; bj < 2; ++bj) { const pg8::f32x4 v0 = acc[ai][bj][m][0], v1 = acc[ai][bj][m][1];
          const float h0 = silu_f(v0[0]) * v0[1], h1 = silu_f(v0[2]) * v0[3], h2 = silu_f(v1[0]) * v1[1], h3 = silu_f(v1[2]) * v1[3];
          uint2 w; w.x = pg8::cvt_pk_bf16(h0, h1); w.y = pg8::cvt_pk_bf16(h2, h3);
          *(uint2*)(rowp + bj * 64) = w; } }
  }
};
struct EpiGateBf16 {
  static constexpr bool PERM = true, AFTER_DRAIN = false;
  bf16_t* O; const float* gate;
  __device__ __forceinline__ void operator()(const pg8::f32x4 (&acc)[2][2][4][2], const pg8::Unit& u, int wr, int wc, int fr, int fq) const {
    const int row0 = u.pm * 256 + wr * 64 + fr, col0 = u.pn * 256 + wc * 32 + 8 * fq;
#pragma unroll
    for (int ai = 0; ai < 2; ++ai)
#pragma unroll
      for (int m = 0; m < 4; ++m) { const int row = row0 + ai * 128 + m * 16; const float g = gate[row]; bf16_t* rowp = O + (size_t)row * D + col0;
#pragma unroll
        for (int bj = 0; bj < 2; ++bj) { const pg8::f32x4 v0 = acc[ai][bj][m][0] * g, v1 = acc[ai][bj][m][1] * g;
          pg8::u32x4 w; w.x = pg8::cvt_pk_bf16(v0[0], v0[1]); w.y = pg8::cvt_pk_bf16(v0[2], v0[3]); w.z = pg8::cvt_pk_bf16(v1[0], v1[1]); w.w = pg8::cvt_pk_bf16(v1[2], v1[3]);
          *(pg8::u32x4*)(rowp + bj * 128) = w; } }
  }
};

namespace fa {
using bf16x8 = __attribute__((ext_vector_type(8))) short;
using s16x4  = __attribute__((ext_vector_type(4))) short;
using f32x16 = __attribute__((ext_vector_type(16))) float;
using u32x4  = __attribute__((ext_vector_type(4))) unsigned;
constexpr int NW = 8, QBLK = 32, KVBLK = 64, LDQK = 128, LDV = 64;
constexpr float SCALE = 0.10206207261596575f;
constexpr float THR = 8.f;
constexpr size_t SHM_V = KVBLK * 64 * 2, SHM_K = KVBLK * 128 * 2, SHM_ATTN = 2 * SHM_V + 2 * SHM_K + NW * 64 * 4;
#define FA_KSWZ(row, colB) ((row) * 256 + ((colB) ^ (((row) & 7) << 4)))
#define FA_SBAR() __builtin_amdgcn_sched_barrier(0)
__device__ __forceinline__ int crow(int r, int hi) { return (r & 3) + 8 * (r >> 2) + 4 * hi; }
__device__ __forceinline__ unsigned cvtpk(float lo, float hi) { unsigned r; asm volatile("v_cvt_pk_bf16_f32 %0, %1, %2" : "=v"(r) : "v"(lo), "v"(hi)); return r; }
__device__ __forceinline__ void partialSM(f32x16& p0, f32x16& p1, float& m_reg, float& mn, float& alpha) {
  constexpr float C = SCALE * 1.4426950408889634f;
  float pmax = p0[0];
#pragma unroll
  for (int r = 1; r < 16; ++r) pmax = fmaxf(pmax, p0[r]);
#pragma unroll
  for (int r = 0; r < 16; ++r) pmax = fmaxf(pmax, p1[r]);
  { auto rr = __builtin_amdgcn_permlane32_swap(__float_as_uint(pmax), __float_as_uint(pmax), false, false);
    pmax = fmaxf(__uint_as_float(rr[0]), __uint_as_float(rr[1])); }
  if (__builtin_expect(__all(pmax - m_reg <= THR / SCALE), 1)) { mn = m_reg; alpha = 1.f; }
  else { mn = fmaxf(m_reg, pmax); alpha = __builtin_amdgcn_exp2f((m_reg - mn) * C); m_reg = mn; }
  float mnC = -mn * C;
  p0 = p0 * C + mnC; p1 = p1 * C + mnC;
#pragma unroll
  for (int r = 0; r < 16; ++r) p0[r] = __builtin_amdgcn_exp2f(p0[r]);
}
__device__ __forceinline__ void finishSM(f32x16& p0, f32x16& p1, float alpha, float& l_reg, bf16x8& pa0, bf16x8& pa1, bf16x8& pa2, bf16x8& pa3) {
#pragma unroll
  for (int r = 0; r < 16; ++r) p1[r] = __builtin_amdgcn_exp2f(p1[r]);
  float ps;
  { const f32x16 t = p0 + p1; const auto t8 = t.lo + t.hi; const auto t4 = t8.lo + t8.hi; const auto t2 = t4.lo + t4.hi; ps = t2.x + t2.y; }
  { auto rr = __builtin_amdgcn_permlane32_swap(__float_as_uint(ps), __float_as_uint(ps), false, false);
    ps = __uint_as_float(rr[0]) + __uint_as_float(rr[1]); }
  l_reg = l_reg * alpha + ps;
#define FA_PK4(P, BASE, OUT) do { unsigned a0 = cvtpk(P[BASE + 0], P[BASE + 1]), a1 = cvtpk(P[BASE + 2], P[BASE + 3]);   \
    unsigned b0 = cvtpk(P[BASE + 4], P[BASE + 5]), b1 = cvtpk(P[BASE + 6], P[BASE + 7]);                              \
    auto r0 = __builtin_amdgcn_permlane32_swap(a0, b0, false, false); auto r1 = __builtin_amdgcn_permlane32_swap(a1, b1, false, false); \
    u32x4 w = {r0[0], r1[0], r0[1], r1[1]}; OUT = *reinterpret_cast<bf16x8*>(&w); } while (0)
  FA_PK4(p0, 0, pa0); FA_PK4(p0, 8, pa1); FA_PK4(p1, 0, pa2); FA_PK4(p1, 8, pa3);
#undef FA_PK4
}
__device__ __forceinline__ void qkt(f32x16& p0, f32x16& p1, const char* Ks, const bf16x8* qr, int r32, int hi) {
  p0 = f32x16{}; p1 = f32x16{};
#pragma unroll
  for (int d0 = 0; d0 < 6; ++d0) { int cb = (d0 * 16 + hi * 8) * 2;
    bf16x8 b0 = *reinterpret_cast<const bf16x8*>(Ks + FA_KSWZ(r32, cb));
    bf16x8 b1 = *reinterpret_cast<const bf16x8*>(Ks + FA_KSWZ(32 + r32, cb));
    p0 = __builtin_amdgcn_mfma_f32_32x32x16_bf16(b0, qr[d0], p0, 0, 0, 0);
    p1 = __builtin_amdgcn_mfma_f32_32x32x16_bf16(b1, qr[d0], p1, 0, 0, 0); }
}
__device__ __forceinline__ int v_st(int k, int c) { const int kk = (k & ~0xC) | ((k & 4) << 1) | ((k & 8) >> 1); return ((kk >> 3) * 2 + (c >> 5)) * 512 + ((kk & 7) * 32 + (c & 31)) * 2; }
__device__ __forceinline__ int v_rd_base(int lane) { return ((lane & 3) << 3) | (((lane >> 2) & 3) << 6) | (((lane >> 4) & 1) << 5) | (((lane >> 5) & 1) << 8); }
constexpr int v_rd_off(int d0, int ks, int half) { return d0 * 512 + ks * 2048 + half * 1024; }
template <int OFF> __device__ __forceinline__ s16x4 tr_read(int vb) {
  s16x4 r; asm volatile("ds_read_b64_tr_b16 %0, %1 offset:%2" : "=&v"(r) : "v"(vb), "i"(OFF) : "memory"); return r;
}
template <int D0> __device__ __forceinline__ void pv_one(f32x16& od, int vb, bf16x8 pa0, bf16x8 pa1, bf16x8 pa2, bf16x8 pa3) {
  const s16x4 l0 = tr_read<v_rd_off(D0, 0, 0)>(vb), h0 = tr_read<v_rd_off(D0, 0, 1)>(vb), l1 = tr_read<v_rd_off(D0, 1, 0)>(vb), h1 = tr_read<v_rd_off(D0, 1, 1)>(vb);
  const s16x4 l2 = tr_read<v_rd_off(D0, 2, 0)>(vb), h2 = tr_read<v_rd_off(D0, 2, 1)>(vb), l3 = tr_read<v_rd_off(D0, 3, 0)>(vb), h3 = tr_read<v_rd_off(D0, 3, 1)>(vb);
  asm volatile("s_waitcnt lgkmcnt(0)" ::: "memory"); FA_SBAR();
#define FA_PK(L, H) (bf16x8){L[0], L[1], L[2], L[3], H[0], H[1], H[2], H[3]}
  od = __builtin_amdgcn_mfma_f32_32x32x16_bf16(pa0, FA_PK(l0, h0), od, 0, 0, 0);
  od = __builtin_amdgcn_mfma_f32_32x32x16_bf16(pa1, FA_PK(l1, h1), od, 0, 0, 0);
  od = __builtin_amdgcn_mfma_f32_32x32x16_bf16(pa2, FA_PK(l2, h2), od, 0, 0, 0);
  od = __builtin_amdgcn_mfma_f32_32x32x16_bf16(pa3, FA_PK(l3, h3), od, 0, 0, 0);
#undef FA_PK
}
__device__ __forceinline__ void attn_body(const bf16_t* __restrict__ Qb, const bf16_t* __restrict__ Kh, const bf16_t* __restrict__ Vh, bf16_t* __restrict__ Ob, int ldo, int seq, char* lds, float* mlp = nullptr, int mlstride = 0) {
  const int tid = ltid(), wid = tid >> 6, lane = tid & 63, r32 = lane & 31, hi = lane >> 5;
  char* V_lds = lds; char* K_lds = lds + 2 * SHM_V;
  float* ws = (float*)(lds + 2 * SHM_V + 2 * SHM_K) + wid * 64; float* li_l = ws; float* al_l = ws + 32;
  float m_reg = -1e30f, l_reg = 0; f32x16 o[2] = {}; bf16x8 qr[6];
  const bf16_t* Qw = Qb + (long)(wid * QBLK + r32) * LDQK + hi * 8;
#pragma unroll
  for (int d0 = 0; d0 < 6; ++d0) qr[d0] = *reinterpret_cast<const bf16x8*>(Qw + d0 * 16);
  const int sr = tid >> 4, sc = (tid & 15) * 8;
  const int vr = tid >> 3, vc = (tid & 7) * 8, vst0 = v_st(vr, vc);
  const int vb0 = (int)(uintptr_t)V_lds + v_rd_base(lane);
  struct { bf16x8 vs0, ks0, ks1; } sr_[2];
#define FA_SLOAD(i, k0) do { sr_[i].vs0 = *reinterpret_cast<const bf16x8*>(&Vh[(long)((k0) + vr) * LDV + vc]); \
    sr_[i].ks0 = *reinterpret_cast<const bf16x8*>(&Kh[(long)((k0) + sr) * LDQK + sc]); sr_[i].ks1 = *reinterpret_cast<const bf16x8*>(&Kh[(long)((k0) + 32 + sr) * LDQK + sc]); } while (0)
#define FA_SWRITE(b, i) do { *(bf16x8*)(V_lds + (b) * SHM_V + vst0) = sr_[i].vs0; int kc = sc * 2;               \
    *(bf16x8*)(K_lds + (b) * SHM_K + FA_KSWZ(sr, kc)) = sr_[i].ks0;                       \
    *(bf16x8*)(K_lds + (b) * SHM_K + FA_KSWZ(32 + sr, kc)) = sr_[i].ks1; } while (0)
#define FA_SWAIT() asm volatile("s_waitcnt vmcnt(3)" ::: "memory")
#define FA_RESC(a) do { if (__any((a) < 1.f)) { if (hi == 0) al_l[r32] = (a); asm volatile("s_waitcnt lgkmcnt(0)" ::: "memory"); \
    _Pragma("unroll") for (int d = 0; d < 2; ++d) _Pragma("unroll") for (int r = 0; r < 16; ++r) o[d][r] *= al_l[crow(r, hi)]; } } while (0)
  f32x16 pA0, pA1, pB0, pB1; float mnA, mnB, alA, alB; bf16x8 pa0, pa1, pa2, pa3; const int NTL = seq / KVBLK;
  constexpr int SE = 0, SO = 1;
  __syncthreads();
  FA_SLOAD(SE, 0); asm volatile("s_waitcnt vmcnt(0)" ::: "memory"); FA_SWRITE(0, SE); __syncthreads();
  qkt(pA0, pA1, K_lds, qr, r32, hi); partialSM(pA0, pA1, m_reg, mnA, alA);
  FA_SLOAD(SO, KVBLK); if (2 < NTL) FA_SLOAD(SE, 2 * KVBLK);
  FA_SWAIT(); FA_SWRITE(1, SO); __syncthreads();
  for (int j = 1; j + 1 < NTL; j += 2) {
    FA_SBAR(); qkt(pB0, pB1, K_lds + SHM_K, qr, r32, hi);
    finishSM(pA0, pA1, alA, l_reg, pa0, pa1, pa2, pa3); FA_SBAR();
    FA_SLOAD(SO, (j + 2) * KVBLK); FA_SBAR();
    pv_one<0>(o[0], vb0, pa0, pa1, pa2, pa3); pv_one<1>(o[1], vb0, pa0, pa1, pa2, pa3); partialSM(pB0, pB1, m_reg, mnB, alB);
    __syncthreads(); FA_SWAIT(); FA_SWRITE(0, SE);
    FA_RESC(alB); __syncthreads();
    FA_SBAR(); qkt(pA0, pA1, K_lds, qr, r32, hi);
    finishSM(pB0, pB1, alB, l_reg, pa0, pa1, pa2, pa3); FA_SBAR();
    if (j + 3 < NTL) FA_SLOAD(SE, (j + 3) * KVBLK); FA_SBAR();
    pv_one<0>(o[0], vb0 + (int)SHM_V, pa0, pa1, pa2, pa3); pv_one<1>(o[1], vb0 + (int)SHM_V, pa0, pa1, pa2, pa3); partialSM(pA0, pA1, m_reg, mnA, alA);
    __syncthreads(); FA_SWAIT(); FA_SWRITE(1, SO);
    FA_RESC(alA); __syncthreads();
  }
  FA_SBAR(); qkt(pB0, pB1, K_lds + SHM_K, qr, r32, hi);
  finishSM(pA0, pA1, alA, l_reg, pa0, pa1, pa2, pa3); FA_SBAR();
  pv_one<0>(o[0], vb0, pa0, pa1, pa2, pa3); pv_one<1>(o[1], vb0, pa0, pa1, pa2, pa3); partialSM(pB0, pB1, m_reg, mnB, alB);
  __syncthreads(); FA_RESC(alB);
  finishSM(pB0, pB1, alB, l_reg, pa0, pa1, pa2, pa3); FA_SBAR();
  pv_one<0>(o[0], vb0 + (int)SHM_V, pa0, pa1, pa2, pa3); pv_one<1>(o[1], vb0 + (int)SHM_V, pa0, pa1, pa2, pa3);
  if (hi == 0) { li_l[r32] = l_reg; if (mlp) { float* q2 = mlp + (size_t)(wid * QBLK + r32) * mlstride; q2[0] = m_reg; q2[1] = l_reg; } }
  asm volatile("s_waitcnt lgkmcnt(0)" ::: "memory");
  float rli[16];
#pragma unroll
  for (int r = 0; r < 16; ++r) rli[r] = __builtin_amdgcn_rcpf(li_l[crow(r, hi)]);
  bf16_t* Ow = Ob + (long)(wid * QBLK) * ldo;
#pragma unroll
  for (int r = 0; r < 16; ++r) { int orow = crow(r, hi);
#pragma unroll
    for (int d0 = 0; d0 < 2; ++d0) Ow[(long)orow * ldo + d0 * 32 + r32] = f2bf(o[d0][r] * rli[r]); }
#undef FA_SLOAD
#undef FA_SWRITE
#undef FA_SWAIT
#undef FA_RESC
}
}

namespace gd {
using bf16x8 = __attribute__((ext_vector_type(8))) short;
using f32x4 = __attribute__((ext_vector_type(4))) float;
constexpr int NCH = 132;
constexpr size_t R_QF = 0, R_KF = 16384, R_KTF = 32768, R_VC = 49152, R_DIR = 65536, DIR_BYTES = 17408, D_TINV = 0, D_QKM = 8192, D_VEC = 16384;
constexpr size_t CHREC = R_DIR + 2 * DIR_BYTES;
__device__ __forceinline__ unsigned pk(float lo, float hi) { unsigned r; asm volatile("v_cvt_pk_bf16_f32 %0, %1, %2" : "=v"(r) : "v"(lo), "v"(hi)); return r; }
__device__ __forceinline__ bf16x8 pack8(const f32x4 a, const f32x4 b) { typedef unsigned u4 __attribute__((ext_vector_type(4))); u4 w = {pk(a[0], a[1]), pk(a[2], a[3]), pk(b[0], b[1]), pk(b[2], b[3])}; return *reinterpret_cast<bf16x8*>(&w); }
__device__ __forceinline__ int chunk_row0(int b, int c) { return c < 4 ? ML + b * TC + 64 * c : b * T + 64 * (c - 4); }
constexpr int L_Q = 0, L_K = 16384, L_V = 32768, L_KK = 49152  , L_QK = 65792, L_G = 82432  ,
              L_A = 0  , L_X0 = 32768  , L_X1 = 83968, L_AT = 100352;
__device__ __forceinline__ int swz(int row, int colB) { return row * 256 + (colB ^ ((row & 7) << 4)); }
__device__ __forceinline__ void tr_pair(int a0, int a1, uint2& lo, uint2& hi) {
  asm volatile("ds_read_b64_tr_b16 %0, %2\n\tds_read_b64_tr_b16 %1, %3\n\ts_waitcnt lgkmcnt(0)" : "=&v"(lo), "=&v"(hi) : "v"(a0), "v"(a1) : "memory");
}
__device__ __forceinline__ uint2 tr_one(int a0) {
  uint2 r; asm volatile("ds_read_b64_tr_b16 %0, %1\n\ts_waitcnt lgkmcnt(0)" : "=&v"(r) : "v"(a0) : "memory"); return r;
}

__device__ __forceinline__ void inv_offdiag(const float* A, float* X, int bi, int bj, int lane) {
  const int rc = lane & 15, g = lane >> 4;
  f32x4 t = {0.f, 0.f, 0.f, 0.f};
  for (int k = bj; k < bi; ++k) {
#pragma unroll
    for (int s4 = 0; s4 < 4; ++s4)
      t = __builtin_amdgcn_mfma_f32_16x16x4f32(A[(bi * 16 + rc) * 64 + k * 16 + s4 * 4 + g], X[(k * 16 + s4 * 4 + g) * 64 + bj * 16 + rc], t, 0, 0, 0);
  }
  f32x4 o = {0.f, 0.f, 0.f, 0.f};
#pragma unroll
  for (int r = 0; r < 4; ++r)
    o = __builtin_amdgcn_mfma_f32_16x16x4f32(X[(bi * 16 + rc) * 64 + bi * 16 + g * 4 + r], t[r], o, 0, 0, 0);
#pragma unroll
  for (int r = 0; r < 4; ++r) X[(bi * 16 + g * 4 + r) * 64 + bj * 16 + rc] = -o[r];
}
__device__ __forceinline__ void lds_barrier() { asm volatile("s_waitcnt lgkmcnt(0)" ::: "memory"); __builtin_amdgcn_s_barrier(); asm volatile("" ::: "memory"); }
constexpr int L_CW = 133120;
__device__ __forceinline__ void precompute_load(const Params& p, int b, int h, int c, int tid, uint4 (&xin)[3][4]) {
  const bf16_t* P = (const bf16_t*)(p.ws + OFF_P);
  const int row0 = chunk_row0(b, c), tlen = c < 4 ? TC : T, t0 = c < 4 ? 64 * c : 64 * (c - 4);
  const int ch8 = tid & 15, tokA = 2 * (tid >> 4);
#pragma unroll
  for (int which = 0; which < 3; ++which) {
    const int ch0 = which * 512 + h * 128 + ch8 * 8;
#pragma unroll
    for (int jj = 0; jj < 4; ++jj) { const int tt = t0 + tokA - 1 + jj;
      xin[which][jj] = (tt >= 0 && tt < tlen) ? *(const uint4*)(P + (size_t)(row0 + tokA - 1 + jj) * NINP + PC_GQ + ch0) : make_uint4(0u, 0u, 0u, 0u); }
  }
}
__device__ __forceinline__ void precompute_item(const Params& p, int l, int b, int h, int c, char* lds, int tid, const uint4 (&xin)[3][4]) {
  const int lane = tid & 63, wv = tid >> 6;
  const bf16_t* P = (const bf16_t*)(p.ws + OFF_P);
  char* rec = p.ws + OFF_RB + (size_t)((b * 4 + h) * NCH + c) * CHREC;
  const int row0 = chunk_row0(b, c);
  const int ldsb = (int)(uintptr_t)lds;
  lds_barrier();
  {
    const int ch8 = tid & 15, tg = tid >> 4, tokA = 2 * tg;
    const float* cwl = (const float*)(lds + L_CW);
#pragma unroll
    for (int which = 0; which < 3; ++which) {
      float xf[4][8];
#pragma unroll
      for (int jj = 0; jj < 4; ++jj) { const unsigned w4[4] = {xin[which][jj].x, xin[which][jj].y, xin[which][jj].z, xin[which][jj].w};
#pragma unroll
        for (int i = 0; i < 4; ++i) { xf[jj][2 * i] = __uint_as_float(w4[i] << 16); xf[jj][2 * i + 1] = __uint_as_float(w4[i] & 0xffff0000u); } }
      float wf[3][8];
#pragma unroll
      for (int j = 0; j < 3; ++j) { const float4 w0 = *(const float4*)(cwl + j * 1536 + which * 512 + h * 128 + ch8 * 8), w1 = *(const float4*)(cwl + j * 1536 + which * 512 + h * 128 + ch8 * 8 + 4);
        wf[j][0] = w0.x; wf[j][1] = w0.y; wf[j][2] = w0.z; wf[j][3] = w0.w; wf[j][4] = w1.x; wf[j][5] = w1.y; wf[j][6] = w1.z; wf[j][7] = w1.w; }
#pragma unroll
      for (int a = 0; a < 2; ++a) {
        float o[8], ss = 0.f;
#pragma unroll
        for (int i = 0; i < 8; ++i) { o[i] = silu_f(wf[0][i] * xf[a][i] + wf[1][i] * xf[a + 1][i] + wf[2][i] * xf[a + 2][i]); ss += o[i] * o[i]; }
        if (which < 2) {
          ss += __shfl_xor(ss, 1); ss += __shfl_xor(ss, 2); ss += __shfl_xor(ss, 4); ss += __shfl_xor(ss, 8);
          const float sc = rsqrtf(ss + EPS) * (which == 0 ? 0.08838834764831845f : 1.f);
#pragma unroll
          for (int i = 0; i < 8; ++i) o[i] *= sc;
        }
        uint4 w; w.x = pk(o[0], o[1]); w.y = pk(o[2], o[3]); w.z = pk(o[4], o[5]); w.w = pk(o[6], o[7]);
        *(uint4*)(lds + (which == 0 ? L_Q : (which == 1 ? L_K : L_V)) + swz(tokA + a, ch8 * 16)) = w;
      }
    }
    if (tid < 128) {
      const int d = tid >> 6, tk = tid & 63;
      const float pa = bf2f(P[(size_t)(row0 + tk) * NINP + PC_A + d * 4 + h]), pb = bf2f(P[(size_t)(row0 + tk) * NINP + PC_B + d * 4 + h]);
      float* gs = (float*)(lds + L_G);
      gs[d * 64 + tk] = -expf(p.a_log[l * 8 + d * 4 + h]) * softplus_f(pa + p.dt_bias[l * 8 + d * 4 + h]);
      gs[128 + d * 64 + tk] = sigmoid_f(pb);
    }
  }
  lds_barrier();
  if (wv == 0) {
    float* gs = (float*)(lds + L_G);
    float a0 = gs[lane], a1 = gs[64 + 63 - lane];
#pragma unroll
    for (int o = 1; o < 64; o <<= 1) { const float n0 = __shfl_up(a0, o), n1 = __shfl_up(a1, o); if (lane >= o) { a0 += n0; a1 += n1; } }
    gs[256 + lane] = a0; gs[256 + 64 + 63 - lane] = a1;
  }
  {
    const int cc = lane & 15, g = lane >> 4;
#pragma unroll
    for (int tt = 0; tt < 2; ++tt) {
      const int tile = wv * 2 + tt, mi = tile >> 2, nj = tile & 3;
      f32x4 akk = {0.f, 0.f, 0.f, 0.f}, aqk = {0.f, 0.f, 0.f, 0.f};
#pragma unroll
      for (int s4 = 0; s4 < 4; ++s4) {
        const bf16x8 ak = *(const bf16x8*)(lds + L_K + swz(mi * 16 + cc, s4 * 64 + g * 16));
        const bf16x8 aq = *(const bf16x8*)(lds + L_Q + swz(mi * 16 + cc, s4 * 64 + g * 16));
        const bf16x8 bk = *(const bf16x8*)(lds + L_K + swz(nj * 16 + cc, s4 * 64 + g * 16));
        akk = __builtin_amdgcn_mfma_f32_16x16x32_bf16(ak, bk, akk, 0, 0, 0);
        aqk = __builtin_amdgcn_mfma_f32_16x16x32_bf16(aq, bk, aqk, 0, 0, 0);
      }
      float* KK = (float*)(lds + L_KK); float* QK = (float*)(lds + L_QK);
#pragma unroll
      for (int r = 0; r < 4; ++r) { KK[(mi * 16 + g * 4 + r) * 65 + nj * 16 + cc] = akk[r]; QK[(mi * 16 + g * 4 + r) * 65 + nj * 16 + cc] = aqk[r]; }
    }
#pragma unroll
    for (int it = 0; it < 2; ++it) {
      const int item = tid + it * NT, fl = item & 63, frag = item >> 6, mt = frag >> 3, kbj = frag & 7, r = fl & 31, hl = fl >> 5;
      const int row = mt * 32 + r, cb = (kbj * 16 + hl * 4) * 2;
      uint4 wq, wk;
      { const uint2 lo = *(const uint2*)(lds + L_Q + swz(row, cb)), hi = *(const uint2*)(lds + L_Q + swz(row, cb + 16)); wq = make_uint4(lo.x, lo.y, hi.x, hi.y); }
      { const uint2 lo = *(const uint2*)(lds + L_K + swz(row, cb)), hi = *(const uint2*)(lds + L_K + swz(row, cb + 16)); wk = make_uint4(lo.x, lo.y, hi.x, hi.y); }
      *(uint4*)(rec + R_QF + (size_t)item * 16) = wq; *(uint4*)(rec + R_KF + (size_t)item * 16) = wk;
    }
#pragma unroll
    for (int it = 0; it < 2; ++it) {
      const int item = tid + it * NT, fl = item & 63, frag = item >> 6, mt = frag >> 2, kbj = frag & 3, i16 = fl & 15, gq = fl >> 4;
      const int tok0 = kbj * 16 + (gq >> 1) * 4 + (i16 >> 2), cb = (mt * 32 + (gq & 1) * 16 + (i16 & 3) * 4) * 2;
      uint2 lo, hi; tr_pair(ldsb + L_K + swz(tok0, cb), ldsb + L_K + swz(tok0 + 8, cb), lo, hi);
      *(uint4*)(rec + R_KTF + (size_t)item * 16) = make_uint4(lo.x, lo.y, hi.x, hi.y);
    }
#pragma unroll
    for (int it = 0; it < 4; ++it) {
      const int item = tid + it * NT, fl = item & 63, q = (item >> 6) & 3, mt = (item >> 8) & 1, sl = item >> 9, i16 = fl & 15, gq = fl >> 4;
      const int tok0 = mt * 32 + q * 8 + (gq >> 1) * 4 + (i16 >> 2), cb = (sl * 32 + (gq & 1) * 16 + (i16 & 3) * 4) * 2;
      const uint2 v = tr_one(ldsb + L_V + swz(tok0, cb));
      *(uint2*)(rec + R_VC + (size_t)item * 8) = v;
    }
  }
  lds_barrier();
  {
    const float* gs = (const float*)(lds + L_G); const float* KK = (const float*)(lds + L_KK);
    float* A = (float*)(lds + L_A);
#pragma unroll 4
    for (int it = 0; it < 16; ++it) {
      const int e = tid + it * NT, d = e >> 12, ip = (e >> 6) & 63, jp = e & 63, ti = d ? 63 - ip : ip, tj = d ? 63 - jp : jp;
      A[e] = ip > jp ? gs[128 + d * 64 + ti] * KK[ti * 65 + tj] * __expf(gs[256 + d * 64 + ti] - gs[256 + d * 64 + tj]) : 0.f;
    }
  }
  lds_barrier();
  if (wv < 2) {
    const float* A = (const float*)(lds + L_A) + wv * 4096; float* X = (float*)(lds + (wv ? L_X1 : L_X0));
    const int qb = lane >> 4, c16 = lane & 15;
    float x[16];
    f32x4 an[4];
#pragma unroll
    for (int q4 = 0; q4 < 4; ++q4) an[q4] = *(const f32x4*)(A + (qb * 16) * 64 + qb * 16 + q4 * 4);
#pragma unroll
    for (int r = 0; r < 16; ++r) {
      f32x4 ac[4];
#pragma unroll
      for (int q4 = 0; q4 < 4; ++q4) ac[q4] = an[q4];
      if (r < 15) {
#pragma unroll
        for (int q4 = 0; q4 < 4; ++q4) an[q4] = *(const f32x4*)(A + (qb * 16 + r + 1) * 64 + qb * 16 + q4 * 4); }
      asm volatile("" ::: "memory");
      float sacc = (r == c16) ? 1.f : 0.f;
#pragma unroll
      for (int q = 0; q < 16; ++q) if (q < r) sacc -= ac[q >> 2][q & 3] * x[q];
      x[r] = sacc;
      X[(qb * 16 + r) * 64 + qb * 16 + c16] = sacc;
    }
  } else {
    const float* gs = (const float*)(lds + L_G); const float* QK = (const float*)(lds + L_QK);
    const int t2 = tid - 128;
    for (int e = t2; e < 2 * 6 * 256; e += 384) {
      const int d = e / 1536, r6 = (e % 1536) >> 8, w = e & 255; const int bi = r6 < 3 ? 0 : (r6 < 5 ? 1 : 2), bj = r6 < 3 ? r6 + 1 : (r6 < 5 ? r6 - 1 : 3);
      ((float*)(lds + (d ? L_X1 : L_X0)))[(bi * 16 + (w >> 4)) * 64 + bj * 16 + (w & 15)] = 0.f; }
    for (int item = t2; item < 1024; item += 384) {
      const int d = item >> 9, fl = item & 63, frag = (item >> 6) & 7, mt = frag >> 2, kbj = frag & 3, r = fl & 31, hl = fl >> 5;
      const int i = mt * 32 + r; const float gci = gs[256 + d * 64 + i];
      float v[8];
#pragma unroll
      for (int j = 0; j < 8; ++j) { const int jj = kbj * 16 + 8 * (j >> 2) + 4 * hl + (j & 3); const bool ok = d ? (i <= jj) : (i >= jj);
        v[j] = ok ? QK[i * 65 + jj] * __expf(gci - gs[256 + d * 64 + jj]) : 0.f; }
      *(uint4*)(rec + R_DIR + d * DIR_BYTES + D_QKM + (size_t)(item & 511) * 16) = make_uint4(pk(v[0], v[1]), pk(v[2], v[3]), pk(v[4], v[5]), pk(v[6], v[7]));
    }
    if (t2 < 128) {
      const int d = t2 >> 6, tk = t2 & 63; float* vec = (float*)(rec + R_DIR + d * DIR_BYTES + D_VEC);
      const float gc = gs[256 + d * 64 + tk], gl = gs[256 + d * 64 + (d ? 0 : 63)];
      vec[tk] = gs[128 + d * 64 + tk]; vec[64 + tk] = __expf(gc); vec[128 + tk] = __expf(gl - gc);
      if (tk == 0) vec[192] = __expf(gl);
    }
  }
  lds_barrier();
  if (wv < 6) inv_offdiag((const float*)(lds + L_A) + (wv & 1) * 4096, (float*)(lds + ((wv & 1) ? L_X1 : L_X0)), (wv >> 1) + 1, wv >> 1, lane);
  lds_barrier();
  if (wv < 4) inv_offdiag((const float*)(lds + L_A) + (wv & 1) * 4096, (float*)(lds + ((wv & 1) ? L_X1 : L_X0)), (wv >> 1) + 2, wv >> 1, lane);
  lds_barrier();
  if (wv < 2) inv_offdiag((const float*)(lds + L_A) + wv * 4096, (float*)(lds + (wv ? L_X1 : L_X0)), 3, 0, lane);
  lds_barrier();
  {
#pragma unroll
    for (int it = 0; it < 2; ++it) {
      const int item = tid + it * NT, d = item >> 9, fl = item & 63, frag = (item >> 6) & 7, mt = frag >> 2, kbj = frag & 3, r = fl & 31, hl = fl >> 5;
      const int i = mt * 32 + r, ri = d ? 63 - i : i; const float* X = (const float*)(lds + (d ? L_X1 : L_X0)) + ri * 64; const float* bet = (const float*)(lds + L_G) + 128 + d * 64;
      float v[8];
#pragma unroll
      for (int j = 0; j < 8; ++j) { const int jj = kbj * 16 + 8 * (j >> 2) + 4 * hl + (j & 3); v[j] = X[d ? 63 - jj : jj] * bet[jj]; }
      *(uint4*)(rec + R_DIR + d * DIR_BYTES + D_TINV + (size_t)(item & 511) * 16) = make_uint4(pk(v[0], v[1]), pk(v[2], v[3]), pk(v[4], v[5]), pk(v[6], v[7]));
    }
  }
}

constexpr int SBUF_ = 74752;
template <int LW>
__device__ __forceinline__ void scan_loader(const char* recs, int dir, int half, char* smem, int lane) {
  typedef unsigned v4u __attribute__((ext_vector_type(4))); typedef __attribute__((address_space(1))) const v4u g_u4; typedef __attribute__((address_space(3))) v4u l_u4;
#define GD_CHUNK(step) (dir == 0 ? (step) : ((step) < 4 ? 3 - (step) : NCH + 3 - (step)))
#define GD_SOFF(i_) ((i_) < 48 ? (size_t)(i_) * 1024 : ((i_) < 56 ? R_VC + (size_t)half * 8192 + ((i_) - 48) * 1024 : R_DIR + (size_t)dir * DIR_BYTES + ((i_) - 56) * 1024))
#define GD_LOAD(R, step) do { const char* _b = recs + (size_t)GD_CHUNK(step) * CHREC + lane * 16; \
    _Pragma("unroll") for (int _j = 0; _j < 19; ++_j) { const int _i = LW + 4 * _j; if (_i < 73) R[_j] = *(g_u4*)(_b + GD_SOFF(_i)); } } while (0)
#define GD_WRITE(R, buf) do { char* _d = smem + (buf) * SBUF_ + lane * 16; \
    _Pragma("unroll") for (int _j = 0; _j < 19; ++_j) { const int _i = LW + 4 * _j; if (_i < 73) *(l_u4*)(_d + _i * 1024) = R[_j]; } } while (0)
  v4u RA[19], RB[19];
  GD_LOAD(RA, 0); GD_LOAD(RB, 1); GD_WRITE(RA, 0); GD_LOAD(RA, 2);
  lds_barrier();
  for (int step = 0; step < NCH; step += 2) {
    if (step + 1 < NCH) GD_WRITE(RB, 1);
    if (step + 3 < NCH) GD_LOAD(RB, step + 3);
    lds_barrier();
    if (step + 2 < NCH) GD_WRITE(RA, 0);
    if (step + 4 < NCH) GD_LOAD(RA, step + 4);
    lds_barrier();
  }
#undef GD_CHUNK
#undef GD_SOFF
#undef GD_LOAD
#undef GD_WRITE
}
constexpr int SB_QF = 0, SB_KF = 16384, SB_KTF = 32768, SB_VC = 49152, SB_TINV = 57344, SB_QKM = 65536, SB_VEC = 73728, SBUF = 74752;
using f32x16 = __attribute__((ext_vector_type(16))) float;
__device__ __forceinline__ unsigned pkb(float lo, float hi) {
  typedef __bf16 bf2 __attribute__((ext_vector_type(2))); typedef float f2 __attribute__((ext_vector_type(2)));
  bf2 r = __builtin_convertvector((f2){lo, hi}, bf2); return *reinterpret_cast<unsigned*>(&r);
}
template <int J> __device__ __forceinline__ bf16x8 pack16(const f32x16& v) {
  typedef unsigned u4 __attribute__((ext_vector_type(4)));
  u4 w = {pk(v[8 * J], v[8 * J + 1]), pk(v[8 * J + 2], v[8 * J + 3]), pk(v[8 * J + 4], v[8 * J + 5]), pk(v[8 * J + 6], v[8 * J + 7])};
  return *reinterpret_cast<bf16x8*>(&w);
}
typedef __attribute__((address_space(1))) char gchar; typedef __attribute__((address_space(1))) bf16_t gbf16;
#define GD_STO(o, I, MT) do { const unsigned _w = pk(o[I], o[(I) + 1]); gchar* _rb = Pst + (size_t)((MT) * 32 + 8 * ((I) >> 2) + ((I) & 3)) * (NINP * 2); asm volatile("" : "+s"(_rb)); \
    *(gbf16*)(_rb + voff) = (bf16_t)_w; *(gbf16*)(_rb + voff1) = (bf16_t)(_w >> 16); } while (0)
__device__ __forceinline__ void scan_unit_lds(const Params& p, int unit_, char* smem, int tid) {
  const int wv = __builtin_amdgcn_readfirstlane(tid >> 6), lane = tid & 63, unit = __builtin_amdgcn_readfirstlane(unit_);
  const int chain = unit >> 1, half = unit & 1, dir = chain & 1, h = (chain >> 1) & 3, b = chain >> 3;
  const char* recs = p.ws + OFF_RB + (size_t)((b * 4 + h) * NCH) * CHREC;
#define GD_CHUNK(step) (dir == 0 ? (step) : ((step) < 4 ? 3 - (step) : NCH + 3 - (step)))
  if (wv >= 4) {
    if (wv == 4) scan_loader<0>(recs, dir, half, smem, lane); else if (wv == 5) scan_loader<1>(recs, dir, half, smem, lane);
    else if (wv == 6) scan_loader<2>(recs, dir, half, smem, lane); else scan_loader<3>(recs, dir, half, smem, lane);
    return;
  }
  if (wv >= 2) {
    for (int i = 0; i <= NCH; ++i) lds_barrier();
    return;
  }
  lds_barrier();
  const int c32 = lane & 31, hl = lane >> 5;
  const unsigned voff_ = (unsigned)(c32 * 2 + hl * 4 * NINP * 2);
  gchar* Pc = (gchar*)(p.ws + OFF_P + (size_t)((dir ? PC_OB : PC_OF) + h * 128 + (half * 2 + wv) * 32) * 2);
  gchar* Pprev = (gchar*)(p.ws + OFF_P + (size_t)(PC_GV + h * 128 + (half * 2 + wv) * 32) * 2 + (size_t)chunk_row0(b, GD_CHUNK(0)) * (NINP * 2));
  f32x16 S[4], ks0, ks1, oq0, oq1, vn0, vn1;
  bf16x8 f0[8], f1[8], Sb[8], Rb[4], Vb[4], VFb[4];
  typedef unsigned u4 __attribute__((ext_vector_type(4)));
#pragma unroll
  for (int t = 0; t < 4; ++t)
#pragma unroll
    for (int i = 0; i < 16; ++i) S[t][i] = 0.f;
#pragma unroll
  for (int i = 0; i < 16; ++i) { oq0[i] = 0.f; oq1[i] = 0.f; }
#pragma unroll
  for (int k = 0; k < 8; ++k) { Sb[k] = (bf16x8){0, 0, 0, 0, 0, 0, 0, 0}; f0[k] = ((const bf16x8*)(smem + SB_KF))[k * 64 + lane]; }
#define GD_SB() __builtin_amdgcn_sched_barrier(0)
#define GD_MF(a, b, c) c = __builtin_amdgcn_mfma_f32_32x32x16_bf16(a, b, c, 0, 0, 0)
#define GD_ZERO(a) do { _Pragma("unroll") for (int _i = 0; _i < 16; ++_i) a[_i] = 0.f; } while (0)
#define GD_LO(w) __uint_as_float((w) << 16)
#define GD_HI(w) __uint_as_float((w) & 0xffff0000u)
#define GD_RLOAD(vA, vB, eA, eB, MT, HQ) do { vA = VC[((MT) * 4 + 2 * (HQ)) * 64 + lane]; vB = VC[((MT) * 4 + 2 * (HQ) + 1) * 64 + lane]; \
    eA = *(const f32x4*)(vec + 64 + (MT) * 32 + (HQ) * 16); eB = *(const f32x4*)(vec + 64 + (MT) * 32 + (HQ) * 16 + 8); } while (0)
#define GD_RC2(ks, v, e, I0, wa, wb) do { wa = pk(GD_LO(v.x) - e[0] * ks[(I0)], GD_HI(v.x) - e[1] * ks[(I0) + 1]); wb = pk(GD_LO(v.y) - e[2] * ks[(I0) + 2], GD_HI(v.y) - e[3] * ks[(I0) + 3]); } while (0)
#define GD_VF2(vn, e, I0, wa, wb) do { wa = pk(vn[(I0)] * e[0], vn[(I0) + 1] * e[1]); wb = pk(vn[(I0) + 2] * e[2], vn[(I0) + 3] * e[3]); } while (0)
#define GD_W4(dst) do { const u4 _w = {w0, w1, w2, w3}; dst = *reinterpret_cast<const bf16x8*>(&_w); } while (0)
#define GD_FLOAD(eA, eB, MT, HQ) do { eA = *(const f32x4*)(vec + 128 + (MT) * 32 + (HQ) * 16); eB = *(const f32x4*)(vec + 128 + (MT) * 32 + (HQ) * 16 + 8); } while (0)
#define GD_ELOAD(eA, eB, MT, HQ) do { eA = *(const f32x4*)(vec + 64 + (MT) * 32 + (HQ) * 16); eB = *(const f32x4*)(vec + 64 + (MT) * 32 + (HQ) * 16 + 8); } while (0)
#define GD_OINIT(oq, eA, eB, HQ) do { _Pragma("unroll") for (int _r = 0; _r < 4; ++_r) { oq[8 * (HQ) + _r] *= eA[_r]; oq[8 * (HQ) + 4 + _r] *= eB[_r]; } } while (0)
#define GD_SCALE(St, I0) do { float _e = egl; asm volatile("" : "+v"(_e)); _Pragma("unroll") for (int _r = 0; _r < 4; ++_r) St[(I0) + _r] *= _e; } while (0)
  uint2 vXA, vXB, vYA, vYB; f32x4 eXA, eXB, eYA, eYB, gXA, gXB, gYA, gYB; float egl; unsigned w0, w1, w2, w3;
  for (int step = 0; step < NCH; ++step) {
    const char* buf = smem + (step & 1) * SBUF; const char* nbuf = smem + ((step + 1) & 1) * SBUF;
    const bf16x8* QF = (const bf16x8*)(buf + SB_QF); const bf16x8* KF = (const bf16x8*)(buf + SB_KF); const bf16x8* KTF = (const bf16x8*)(buf + SB_KTF);
    const bf16x8* KFn = (const bf16x8*)(nbuf + SB_KF);
    const uint2* VC = (const uint2*)(buf + SB_VC + wv * 4096);
    const bf16x8* TF = (const bf16x8*)(buf + SB_TINV); const bf16x8* QKF = (const bf16x8*)(buf + SB_QKM); const float* vec = (const float*)(buf + SB_VEC) + 4 * hl;
    gchar* Pst = Pprev;
    unsigned voff = voff_; asm volatile("" : "+v"(voff)); unsigned voff1 = voff_ + NINP * 2; asm volatile("" : "+v"(voff1));
    GD_ZERO(ks0);
    GD_SB();
#pragma unroll
    for (int k = 0; k < 8; ++k) {
      GD_MF(f0[k], Sb[k], ks0);
      f1[k] = KF[(8 + k) * 64 + lane];
      if (k < 4) { GD_STO(oq0, 4 * k, 0); GD_STO(oq0, 4 * k + 2, 0); } else { GD_STO(oq1, 4 * (k - 4), 1); GD_STO(oq1, 4 * (k - 4) + 2, 1); }
      if (k == 6) GD_RLOAD(vXA, vXB, eXA, eXB, 0, 0);
      if (k == 7) { GD_RLOAD(vYA, vYB, eYA, eYB, 0, 1); GD_ZERO(ks1); }
      GD_SB();
    }
#pragma unroll
    for (int k = 0; k < 8; ++k) {
      GD_MF(f1[k], Sb[k], ks1);
      f0[k] = QF[k * 64 + lane];
      if (k == 1) GD_RC2(ks0, vXA, eXA, 0, w0, w1);
      if (k == 2) { GD_RC2(ks0, vXB, eXB, 4, w2, w3); GD_W4(Rb[0]); }
      if (k == 3) GD_RC2(ks0, vYA, eYA, 8, w0, w1);
      if (k == 4) { GD_RC2(ks0, vYB, eYB, 12, w2, w3); GD_W4(Rb[1]); }
      if (k == 5) GD_RLOAD(vXA, vXB, eXA, eXB, 1, 0);
      if (k == 6) GD_RLOAD(vYA, vYB, eYA, eYB, 1, 1);
      if (k == 7) { GD_ZERO(oq0); }
      GD_SB();
    }
#pragma unroll
    for (int k = 0; k < 8; ++k) {
      GD_MF(f0[k], Sb[k], oq0);
      f1[k] = QF[(8 + k) * 64 + lane];
      if (k == 1) GD_RC2(ks1, vXA, eXA, 0, w0, w1);
      if (k == 2) { GD_RC2(ks1, vXB, eXB, 4, w2, w3); GD_W4(Rb[2]); }
      if (k == 3) GD_RC2(ks1, vYA, eYA, 8, w0, w1);
      if (k == 4) { GD_RC2(ks1, vYB, eYB, 12, w2, w3); GD_W4(Rb[3]); }
      if (k == 6) egl = vec[192 - 4 * hl];
      if (k == 7) { GD_ZERO(oq1); }
      GD_SB();
    }
#pragma unroll
    for (int k = 0; k < 8; ++k) {
      GD_MF(f1[k], Sb[k], oq1);
      f0[k] = TF[k * 64 + lane];
      GD_SCALE(S[k >> 2], 4 * (k & 3)); GD_SCALE(S[2 + (k >> 2)], 4 * (k & 3));
      if (k == 6) { GD_FLOAD(gXA, gXB, 0, 0); GD_FLOAD(gYA, gYB, 0, 1); }
      if (k == 7) { GD_ZERO(vn0); GD_ZERO(vn1); }
      GD_SB();
    }
#pragma unroll
    for (int k = 0; k < 8; ++k) {
      if (k < 4) GD_MF(f0[k], Rb[k], vn0); else GD_MF(f0[k], Rb[k - 4], vn1);
      f1[k] = KTF[k * 64 + lane];
      if (k == 5) GD_VF2(vn0, gXA, 0, w0, w1);
      if (k == 6) { GD_VF2(vn0, gXB, 4, w2, w3); GD_W4(VFb[0]); }
      if (k == 7) { GD_VF2(vn0, gYA, 8, w0, w1); GD_FLOAD(gXA, gXB, 1, 0); }
      GD_SB();
    }
#pragma unroll
    for (int k = 0; k < 8; ++k) {
      if (k == 0) GD_MF(f1[0], VFb[0], S[0]); if (k == 1) GD_MF(f1[4], VFb[0], S[1]); if (k == 2) GD_MF(f1[1], VFb[1], S[0]); if (k == 3) GD_MF(f1[5], VFb[1], S[1]);
      if (k == 4) GD_MF(f1[2], VFb[2], S[0]); if (k == 5) GD_MF(f1[6], VFb[2], S[1]); if (k == 6) GD_MF(f1[3], VFb[3], S[0]); if (k == 7) GD_MF(f1[7], VFb[3], S[1]);
      f0[k] = KTF[(8 + k) * 64 + lane];
      if (k == 0) { GD_VF2(vn0, gYB, 12, w2, w3); GD_W4(VFb[1]); }
      if (k == 1) { GD_VF2(vn1, gXA, 0, w0, w1); GD_FLOAD(gYA, gYB, 1, 1); }
      if (k == 2) { GD_VF2(vn1, gXB, 4, w2, w3); GD_W4(VFb[2]); }
      if (k == 3) GD_VF2(vn1, gYA, 8, w0, w1);
      if (k == 4) { GD_VF2(vn1, gYB, 12, w2, w3); GD_W4(VFb[3]); }
      if (k == 5) Vb[0] = pack16<0>(vn0);
      if (k == 6) { Vb[1] = pack16<1>(vn0); GD_ELOAD(eXA, eXB, 0, 0); }
      if (k == 7) { Vb[2] = pack16<0>(vn1); GD_ELOAD(eYA, eYB, 0, 1); }
      GD_SB();
    }
#pragma unroll
    for (int k = 0; k < 8; ++k) {
      if (k < 4) GD_MF(f0[k], VFb[k], S[2]); else GD_MF(f0[k], VFb[k - 4], S[3]);
      if (k < 4) { f1[2 * k] = QKF[(2 * k) * 64 + lane]; f1[2 * k + 1] = QKF[(2 * k + 1) * 64 + lane]; }
      if (k == 0) GD_OINIT(oq0, eXA, eXB, 0);
      if (k == 1) { GD_OINIT(oq0, eYA, eYB, 1); GD_ELOAD(eXA, eXB, 1, 0); }
      if (k == 2) { GD_ELOAD(eYA, eYB, 1, 1); Vb[3] = pack16<1>(vn1); Sb[0] = pack16<0>(S[0]); }
      if (k == 3) GD_OINIT(oq1, eXA, eXB, 0);
      if (k == 4) GD_OINIT(oq1, eYA, eYB, 1);
      if (k == 5) Sb[1] = pack16<1>(S[0]);
      if (k == 6) Sb[2] = pack16<0>(S[1]);
      if (k == 7) Sb[3] = pack16<1>(S[1]);
      GD_SB();
    }
    Pprev = Pc + (size_t)chunk_row0(b, GD_CHUNK(step)) * (NINP * 2);
    lds_barrier();
    GD_SB();
#pragma unroll
    for (int k = 0; k < 8; ++k) {
      if (k < 4) GD_MF(f1[k], Vb[k], oq0); else GD_MF(f1[k], Vb[k - 4], oq1);
      f0[k] = KFn[k * 64 + lane];
      if (k == 0) Sb[4] = pack16<0>(S[2]);
      if (k == 1) Sb[5] = pack16<1>(S[2]);
      if (k == 2) Sb[6] = pack16<0>(S[3]);
      if (k == 3) Sb[7] = pack16<1>(S[3]);
      GD_SB();
    }
  }
  {
    gchar* Pst = Pprev; const unsigned voff = voff_, voff1 = voff_ + NINP * 2;
#pragma unroll
    for (int k = 0; k < 8; ++k) { if (k < 4) { GD_STO(oq0, 4 * k, 0); GD_STO(oq0, 4 * k + 2, 0); } else { GD_STO(oq1, 4 * (k - 4), 1); GD_STO(oq1, 4 * (k - 4) + 2, 1); } }
  }
#undef GD_SB
#undef GD_MF
#undef GD_ZERO
#undef GD_LO
#undef GD_HI
#undef GD_RLOAD
#undef GD_RC2
#undef GD_VF2
#undef GD_W4
#undef GD_FLOAD
#undef GD_ELOAD
#undef GD_OINIT
#undef GD_SCALE
#undef GD_CHUNK
}
#undef GD_STO
}

__device__ __forceinline__ void ph_init_ada(const Params& p) {
  const int TIDX = ltid(); const int BIDX = lbid();
  const size_t n = (size_t)MR * D, gt = (size_t)BIDX * NT + TIDX, gs = (size_t)gridDim.x * NT;
  for (size_t i = gt; i < n; i += gs) {
    int r = (int)(i / D), cc = (int)(i % D);
    xrow(p, r)[cc] = r < ML ? p.x[i] : p.ctx[(size_t)(r - ML) * D + cc];
  }
}
__device__ __forceinline__ void ph_modulate(const Params& p, int l, int which, int nrows) {
  const int TIDX = ltid(); const int BIDX = lbid();
  const int lane = TIDX & 63, wv = TIDX >> 6;
  for (int r = BIDX * 8 + wv; r < nrows; r += gridDim.x * 8) {
    int mj, t, tlen, r0; rowinfo(r, mj, t, tlen, r0);
    const float* xr = xrow_src(p, r, l);
    const float* g = (which ? p.norm2_g : p.norm1_g) + l * D;
    const float* sh = modvec(p, l, mj, which ? 3 : 0); const float* sc = modvec(p, l, mj, which ? 4 : 1);
    float v[16], ss = 0;
#pragma unroll
    for (int i = 0; i < 16; ++i) { v[i] = xr[lane + i * 64]; ss += v[i] * v[i]; }
    ss = wave_sum(ss);
    const float rstd = rsqrtf(ss / D + EPS);
    bf16_t* h = (bf16_t*)(p.ws + OFF_H) + (size_t)r * D;
#pragma unroll
    for (int i = 0; i < 16; ++i) { int cc = lane + i * 64; v[i] = v[i] * rstd * g[cc] * (1.f + sc[cc]) + sh[cc]; h[cc] = f2bf(v[i]); }
    if (which) {
      const float* wr = p.router + (size_t)l * D * NE;
      float lo[16];
#pragma unroll
      for (int e = 0; e < 16; ++e) lo[e] = 0.f;
#pragma unroll
      for (int i = 0; i < 16; ++i) { int cc = lane + i * 64;
#pragma unroll
        for (int e = 0; e < 16; ++e) lo[e] += v[i] * wr[cc * NE + e]; }
      float mx = -1e30f;
#pragma unroll
      for (int e = 0; e < 16; ++e) { lo[e] = wave_sum(lo[e]); mx = fmaxf(mx, lo[e]); }
      float sum = 0;
#pragma unroll
      for (int e = 0; e < 16; ++e) { lo[e] = expf(lo[e] - mx); sum += lo[e]; }
      float* afft = (float*)(p.ws + OFF_AFFT);
      if (lane == 0) {
#pragma unroll
        for (int e = 0; e < 16; ++e) afft[(size_t)e * MR + r] = lo[e] / sum;
      }
    }
  }
}

__device__ __forceinline__ constexpr int ngemm_lds_floats() { return 16 * 65 + 16 * 129; }
template <typename LoadA, typename LoadB, typename Epi>
__device__ __forceinline__ void ngemm_tile(float* lds, int M, int N, int K, int tm, int tn, LoadA lda_, LoadB ldb_, Epi epi) {
  float (*sA)[65] = (float (*)[65])lds; float (*sB)[129] = (float (*)[129])(lds + 16 * 65);
  const int tid = ltid(), tx = tid & 31, ty = tid >> 5;
  float acc[4][4];
#pragma unroll
  for (int i = 0; i < 4; ++i)
#pragma unroll
    for (int j = 0; j < 4; ++j) acc[i][j] = 0.f;
  for (int k0 = 0; k0 < K; k0 += 16) {
#pragma unroll
    for (int i = 0; i < 2; ++i) { int e = tid + i * 512; int rr = e >> 4, kk = e & 15; int gr = tm * 64 + rr; sA[kk][rr] = gr < M ? lda_(gr, k0 + kk) : 0.f; }
#pragma unroll
    for (int i = 0; i < 4; ++i) { int e = tid + i * 512; int kk = e >> 7, cc = e & 127; int gc = tn * 128 + cc; sB[kk][cc] = gc < N ? ldb_(k0 + kk, gc) : 0.f; }
    __syncthreads();
#pragma unroll
    for (int kk = 0; kk < 16; ++kk) {
      float a[4], b[4];
#pragma unroll
      for (int i = 0; i < 4; ++i) { a[i] = sA[kk][ty * 4 + i]; b[i] = sB[kk][tx * 4 + i]; }
#pragma unroll
      for (int i = 0; i < 4; ++i)
#pragma unroll
        for (int j = 0; j < 4; ++j) acc[i][j] += a[i] * b[j];
    }
    __syncthreads();
  }
#pragma unroll
  for (int i = 0; i < 4; ++i)
#pragma unroll
    for (int j = 0; j < 4; ++j) { int rr = tm * 64 + ty * 4 + i, cc = tn * 128 + tx * 4 + j; if (rr < M && cc < N) epi(rr, cc, acc[i][j]); }
}

__device__ __forceinline__ void ph_inproj(const Params& p, int l, float* lds) {
  const int TIDX = ltid(); const int BIDX = lbid();
  const bf16_t* H = (const bf16_t*)(p.ws + OFF_H); const float* W = p.w_in + (size_t)l * D * NIN; bf16_t* P = (bf16_t*)(p.ws + OFF_P);
  const int ntn = (NIN + 127) / 128, ntm = MR / 64;
  for (int vb = BIDX; vb < ntn * ntm; vb += gridDim.x)
    ngemm_tile(lds, MR, NIN, D, vb / ntn, vb % ntn,
               [&](int r, int k) { return bf2f(H[(size_t)r * D + k]); },
               [&](int k, int n) { return W[(size_t)k * NIN + n]; },
               [&](int r, int n, float v) { P[(size_t)r * NINP + n] = f2bf(v); });
}

__device__ __forceinline__ void ph_mla(const Params& p, int l, float* lds) {
  const int TIDX = ltid(); const int BIDX = lbid();
  float* pq = lds; float* pkv = pq + 192; float* pkr = pkv + 128; float* qraw = pkr + 32; float* kvraw = qraw + 384; float* qn = kvraw + 512; float* kn = qn + 384; float* red = kn + 384;
  const int tid = TIDX;
  for (int r = BIDX; r < MR; r += gridDim.x) {
    int mj, t, tlen, r0; rowinfo(r, mj, t, tlen, r0);
    const bf16_t* P = (const bf16_t*)(p.ws + OFF_P) + (size_t)r * NINP;
    __syncthreads();
    if (tid < 192) pq[tid] = bf2f(P[PC_Q + tid]);
    if (tid < 128) pkv[tid] = bf2f(P[PC_KV + tid]);
    if (tid < 32) pkr[tid] = bf2f(P[PC_KR + tid]);
    __syncthreads();
    if (tid < 64) { float s = 0; for (int k = tid; k < 192; k += 64) s += pq[k] * pq[k]; s = wave_sum(s); if (tid == 0) red[0] = rsqrtf(s / 192.f + EPS); }
    else if (tid < 128) { float s = 0; for (int k = tid - 64; k < 128; k += 64) s += pkv[k] * pkv[k]; s = wave_sum(s); if (tid == 64) red[1] = rsqrtf(s / 128.f + EPS); }
    __syncthreads();
    const float rq = red[0], rkv = red[1];
    const float* wuq = p.w_uq + (size_t)l * 192 * 384; const float* qan = p.q_a_norm + l * 192;
    const float* wukv = p.w_ukv + (size_t)l * 128 * 512; const float* kvan = p.kv_a_norm + l * 128;
    if (tid < 384) { float a = 0; for (int k = 0; k < 192; ++k) a += pq[k] * rq * qan[k] * wuq[k * 384 + tid]; qraw[tid] = a; }
    { float a = 0; for (int k = 0; k < 128; ++k) a += pkv[k] * rkv * kvan[k] * wukv[k * 512 + tid]; kvraw[tid] = a; }
    __syncthreads();
    const float* qnw = p.q_norm + l * 96; const float* knw = p.k_norm + l * 96;
    if (tid < 384) {
      int h = tid / 96, d = tid % 96;
      float sq = 0, sk = 0;
      for (int dd = 0; dd < 96; ++dd) { float a = qraw[h * 96 + dd]; sq += a * a; float b = dd < 64 ? kvraw[h * 128 + dd] : pkr[dd - 64]; sk += b * b; }
      float kval = d < 64 ? kvraw[h * 128 + d] : pkr[d - 64];
      qn[tid] = qraw[tid] * rsqrtf(sq / 96.f + EPS) * qnw[d];
      kn[tid] = kval * rsqrtf(sk / 96.f + EPS) * knw[d];
    }
    __syncthreads();
    const bool lat = r < ML; const int b = lat ? (r >> 13) : ((r - ML) >> 8); const int pos = lat ? TC + t : t;
    bf16_t* Q = (bf16_t*)(p.ws + OFF_QKV); bf16_t* Kb = Q + QK_ELEMS; bf16_t* Vb = Kb + QK_ELEMS;
    {
      int h = tid >> 7, d = tid & 127;
      float qv = 0, kv = 0;
      if (d < 96) {
        qv = qn[h * 96 + d]; kv = kn[h * 96 + d];
        if (lat && d >= 64) {
          int part = (d - 64) >> 4, w = (d - 64) & 15, i = w & 7; bool first = w < 8;
          float posv = part == 0 ? (float)(t >> 6) : (float)(t & 63);
          float invf = powf(10000.f, -(float)i / 8.f);
          float ang = posv * invf, cs = cosf(ang), sn = sinf(ang);
          int i1 = h * 96 + 64 + part * 16 + i, i2 = i1 + 8;
          qv = first ? qn[i1] * cs - qn[i2] * sn : qn[i2] * cs + qn[i1] * sn;
          kv = first ? kn[i1] * cs - kn[i2] * sn : kn[i2] * cs + kn[i1] * sn;
        }
      }
      size_t o = ((size_t)(b * 4 + h) * TK + pos) * 128 + d;
      Q[o] = f2bf(qv); Kb[o] = f2bf(kv);
      if (d < 64) Vb[((size_t)(b * 4 + h) * TK + pos) * 64 + d] = f2bf(kvraw[h * 128 + 64 + d]);
    }
  }
}

__device__ __forceinline__ void ph_gdnprep(const Params& p, int l, float* lds) {
  const int TIDX = ltid(); const int BIDX = lbid();
  float* cv = lds; float* rs = lds + 1536;
  const int tid = TIDX;
  const bf16_t* P = (const bf16_t*)(p.ws + OFF_P);
  const float* cw = p.conv_w + (size_t)l * 3 * 1536;
  for (int r = BIDX; r < MR; r += gridDim.x) {
    int mj, t, tlen, r0; rowinfo(r, mj, t, tlen, r0);
    __syncthreads();
    for (int c = tid; c < 1536; c += NT) {
      float a = 0;
      for (int j = 0; j < 3; ++j) { int tt = t + j - 1; if (tt >= 0 && tt < tlen) a += cw[j * 1536 + c] * bf2f(P[(size_t)(r0 + tt) * NINP + PC_GQ + c]); }
      cv[c] = silu_f(a);
    }
    __syncthreads();
    if (tid < 8) { float s = 0; for (int d = 0; d < 128; ++d) { float v = cv[tid * 128 + d]; s += v * v; } rs[tid] = rsqrtf(s + EPS) * (tid < 4 ? 0.08838834764831845f : 1.f); }
    __syncthreads();
    float* G = (float*)(p.ws + OFF_RB) + (size_t)r * 1536;
    for (int c = tid; c < 1536; c += NT) G[c] = c < 1024 ? cv[c] * rs[c >> 7] : cv[c];
    if (tid < 8) {
      float* gb = (float*)(p.ws + OFF_GB) + (size_t)r * 16;
      float pa = bf2f(P[(size_t)r * NINP + PC_A + tid]), pb = bf2f(P[(size_t)r * NINP + PC_B + tid]);
      gb[tid] = -expf(p.a_log[l * 8 + tid]) * softplus_f(pa + p.dt_bias[l * 8 + tid]);
      gb[8 + tid] = sigmoid_f(pb);
    }
  }
}
__device__ __forceinline__ void ph_scan(const Params& p, float* lds) {
  const int TIDX = ltid(); const int BIDX = lbid();
  if (BIDX >= 16) return;
  float* sk = lds; float* sq = lds + 128; float* red = lds + 256; float* red2 = lds + 256 + 512;
  const int tid = TIDX, e = tid & 127, part = tid >> 7;
  const int chain = BIDX, dir = chain & 1, h = (chain >> 1) & 3, b = chain >> 3;
  const float* G = (const float*)(p.ws + OFF_RB); const float* GB = (const float*)(p.ws + OFF_GB);
  bf16_t* P = (bf16_t*)(p.ws + OFF_P);
  float S[32];
#pragma unroll
  for (int d = 0; d < 32; ++d) S[d] = 0.f;
  __syncthreads();
  for (int step = 0; step < TC + T; ++step) {
    int row;
    if (step < TC) row = ML + b * TC + (dir ? TC - 1 - step : step);
    else { int i = step - TC; row = b * T + (dir ? T - 1 - i : i); }
    const float* q = G + (size_t)row * 1536 + h * 128; const float* k = q + 512; const float v = q[1024 + e];
    if (tid < 128) sk[tid] = k[tid]; else if (tid < 256) sq[tid - 128] = q[tid - 128];
    const float g = GB[(size_t)row * 16 + dir * 4 + h], beta = GB[(size_t)row * 16 + 8 + dir * 4 + h];
    const float eg = expf(g);
    __syncthreads();
    float ks = 0;
#pragma unroll
    for (int d = 0; d < 32; ++d) ks += sk[part * 32 + d] * S[d];
    red[part * 128 + e] = ks;
    __syncthreads();
    ks = red[e] + red[128 + e] + red[256 + e] + red[384 + e];
    const float vn = beta * (v - eg * ks);
    float o = 0;
#pragma unroll
    for (int d = 0; d < 32; ++d) { S[d] = eg * S[d] + sk[part * 32 + d] * vn; o += sq[part * 32 + d] * S[d]; }
    red2[part * 128 + e] = o;
    __syncthreads();
    if (part == 0) P[(size_t)row * NINP + (dir ? PC_OB : PC_OF) + h * 128 + e] = f2bf(red2[e] + red2[128 + e] + red2[256 + e] + red2[384 + e]);
  }
  __syncthreads();
}
__device__ __forceinline__ void ph_attn(const Params& p, bool need_ctx, float* lds) {
  const int TIDX = ltid(); const int BIDX = lbid();
  float (*sK)[96] = (float (*)[96])lds; float (*sV)[64] = (float (*)[64])(lds + 32 * 96);
  const int tid = TIDX;
  const int nlat = NB * 4 * (T / NT), nitem = nlat + (need_ctx ? NB * 4 : 0);
  const bf16_t* Q = (const bf16_t*)(p.ws + OFF_QKV); const bf16_t* Kb = Q + QK_ELEMS; const bf16_t* Vb = Kb + QK_ELEMS;
  for (int it = gridDim.x - 1 - BIDX; it < nitem; it += gridDim.x) {
    const bool ctxq = it >= nlat;
    int b, h, qt;
    if (!ctxq) { qt = it % (T / NT); h = (it / (T / NT)) & 3; b = it / (4 * (T / NT)); } else { int j = it - nlat; qt = 0; h = j & 3; b = j >> 2; }
    const bool active = !ctxq || tid < TC;
    const int qpos = ctxq ? (active ? tid : 0) : TC + qt * NT + tid;
    const int nk = ctxq ? TC : TK;
    const size_t bh = (size_t)(b * 4 + h) * TK;
    float q[96], o[64];
#pragma unroll
    for (int d = 0; d < 96; ++d) q[d] = bf2f(Q[(bh + qpos) * 128 + d]);
#pragma unroll
    for (int d = 0; d < 64; ++d) o[d] = 0.f;
    float m = -1e30f, lsum = 0.f;
    const float scale = 0.10206207261596575f;
    for (int k0 = 0; k0 < nk; k0 += 32) {
      __syncthreads();
      for (int e = tid; e < 32 * 96; e += NT) { int j = e / 96, d = e % 96; sK[j][d] = bf2f(Kb[(bh + k0 + j) * 128 + d]); }
      for (int e = tid; e < 32 * 64; e += NT) { int j = e >> 6, d = e & 63; sV[j][d] = bf2f(Vb[(bh + k0 + j) * 64 + d]); }
      __syncthreads();
      for (int j = 0; j < 32; ++j) {
        float s = 0;
#pragma unroll
        for (int d = 0; d < 96; ++d) s += q[d] * sK[j][d];
        s *= scale;
        if (s > m) { float a = __expf(m - s); lsum *= a;
#pragma unroll
          for (int d = 0; d < 64; ++d) o[d] *= a;
          m = s; }
        float pe = __expf(s - m); lsum += pe;
#pragma unroll
        for (int d = 0; d < 64; ++d) o[d] += pe * sV[j][d];
      }
    }
    if (active) {
      const int row = ctxq ? ML + b * TC + qpos : b * T + (qpos - TC);
      bf16_t* cat = (bf16_t*)(p.ws + OFF_H) + (size_t)row * D + h * 64;
      float inv = 1.f / lsum;
#pragma unroll
      for (int d = 0; d < 64; ++d) cat[d] = f2bf(o[d] * inv);
    }
  }
}
__device__ __forceinline__ void ph_gdnfin_pool(const Params& p, int l, int nrows, float* lds) {
  const int TIDX = ltid(); const int BIDX = lbid();
  float* ov = lds; float* rs = lds + 512; float* dv = lds + 520;
  const int tid = TIDX;
  const bf16_t* P = (const bf16_t*)(p.ws + OFF_P);
  for (int r = BIDX; r < nrows; r += gridDim.x) {
    int mj, t, tlen, r0; rowinfo(r, mj, t, tlen, r0);
    bf16_t* cat = (bf16_t*)(p.ws + OFF_H) + (size_t)r * D;
    __syncthreads();
    ov[tid] = bf2f(P[(size_t)r * NINP + PC_OF + tid]) + bf2f(P[(size_t)r * NINP + PC_OB + tid]);
    if (tid < 256) {
      int c = tid, gi = c >> 6, win = 2 << gi;
      int lo = t - win / 2, hi = lo + win; lo = lo < 0 ? 0 : lo; hi = hi > tlen ? tlen : hi;
      float s = 0; for (int tt = lo; tt < hi; ++tt) s += bf2f(P[(size_t)(r0 + tt) * NINP + PC_POOL + c]);
      dv[c] = s / (float)(hi - lo) - bf2f(P[(size_t)r * NINP + PC_POOL + c]);
    }
    __syncthreads();
    if (tid < 4) { float s = 0; for (int d = 0; d < 128; ++d) { float v = ov[tid * 128 + d]; s += v * v; } rs[tid] = rsqrtf(s / 128.f + EPS); }
    __syncthreads();
    const float* gn = p.gdn_norm_g + l * 128;
    { int c = tid; float z = bf2f(P[(size_t)r * NINP + PC_Z + c]); cat[256 + c] = f2bf(ov[c] * rs[c >> 7] * gn[c & 127] * silu_f(z)); }
    if (tid < 256) {
      int j = tid, gi = j >> 6, dd = j & 63;
      const float* pw = p.pool_w + ((size_t)l * 4 + gi) * 64 * 64;
      float a = 0; for (int c = 0; c < 64; ++c) a += dv[gi * 64 + c] * pw[c * 64 + dd];
      cat[768 + j] = f2bf(a * p.pool_scale[l * 256 + j]);
    }
  }
}
__device__ __forceinline__ void ph_outproj(const Params& p, int l, int nrows, float* lds) {
  const int TIDX = ltid(); const int BIDX = lbid();
  const bf16_t* A = (const bf16_t*)(p.ws + OFF_H); const float* W = p.w_out + (size_t)l * D * D;
  const int ntn = D / 128, ntm = nrows / 64;
  for (int vb = BIDX; vb < ntn * ntm; vb += gridDim.x)
    ngemm_tile(lds, nrows, D, D, vb / ntn, vb % ntn,
               [&](int r, int k) { return bf2f(A[(size_t)r * D + k]); },
               [&](int k, int n) { return W[(size_t)k * D + n]; },
               [&](int r, int n, float v) { int mj = r < ML ? (r >> 13) : 2; xrow(p, r)[n] += modvec(p, l, mj, 2)[n] * v; });
}
__device__ __forceinline__ void ph_topk(const Params& p, int nseq) {
  const int TIDX = ltid(); const int BIDX = lbid();
  const size_t total = (size_t)nseq * NE * T;
  for (size_t i = (size_t)BIDX * NT + TIDX; i < total; i += (size_t)gridDim.x * NT) {
    const int t = (int)(i % T), e = (int)((i / T) % NE), s = (int)(i / ((size_t)T * NE));
    const int tlen = s < 2 ? T : TC, cap = s < 2 ? CAPL : CAPC, r0 = s < 2 ? s * T : ML + (s - 2) * TC;
    if (t >= tlen) continue;
    const float* a = (const float*)(p.ws + OFF_AFFT) + (size_t)e * MR + r0;
    const float me = a[t];
    int rank = 0;
    for (int u = 0; u < tlen; ++u) { float o = a[u]; rank += (o > me || (o == me && u < t)) ? 1 : 0; }
    int* slot = (int*)(p.ws + OFF_SLOT);
    if (rank < cap) { int pi = pair_base(s, e) + rank; ((int*)(p.ws + OFF_IDX))[pi] = r0 + t; ((float*)(p.ws + OFF_GATE))[pi] = me; slot[(size_t)(r0 + t) * 16 + e] = rank; }
    else slot[(size_t)(r0 + t) * 16 + e] = -1;
  }
}
__device__ __forceinline__ void ph_moe_gu(const Params& p, int l, int grp0, int grp1, float* lds) {
  const int TIDX = ltid(); const int BIDX = lbid();
  const bf16_t* H = (const bf16_t*)(p.ws + OFF_H);
  float* tmp = (float*)(p.ws + OFF_P);
  const int ntn = DEXP / 128, ntm = CAPL / 64, per = ntn * ntm;
  for (int vb = BIDX; vb < (grp1 - grp0) * per; vb += gridDim.x) {
    const int grp = grp0 + vb / per, tt = vb % per, tm = tt / ntn, tn = tt % ntn;
    const int s = grp >> 4, e = grp & 15; const int cap = s < 2 ? CAPL : CAPC;
    if (tm * 64 >= cap) continue;
    const int pb = pair_base(s, e);
    const int* idx = (const int*)(p.ws + OFF_IDX) + pb;
    const float* Wg = p.w_gate + ((size_t)l * NE + e) * D * DEXP; const float* Wu = p.w_up + ((size_t)l * NE + e) * D * DEXP;
    bf16_t* hid = (bf16_t*)(p.ws + OFF_HID) + (size_t)pb * DEXP;
    ngemm_tile(lds, cap, DEXP, D, tm, tn,
               [&](int r, int k) { return bf2f(H[(size_t)idx[r] * D + k]); },
               [&](int k, int n) { return Wg[(size_t)k * DEXP + n]; },
               [&](int r, int n, float v) { tmp[(size_t)(pb + r) * DEXP + n] = v; });
    ngemm_tile(lds, cap, DEXP, D, tm, tn,
               [&](int r, int k) { return bf2f(H[(size_t)idx[r] * D + k]); },
               [&](int k, int n) { return Wu[(size_t)k * DEXP + n]; },
               [&](int r, int n, float v) { float g = tmp[(size_t)(pb + r) * DEXP + n]; hid[(size_t)r * DEXP + n] = f2bf(silu_f(g) * v); });
  }
}
__device__ __forceinline__ void ph_moe_down(const Params& p, int l, int grp0, int grp1, float* lds) {
  const int TIDX = ltid(); const int BIDX = lbid();
  const int ntn = D / 128, ntm = CAPL / 64, per = ntn * ntm;
  for (int vb = BIDX; vb < (grp1 - grp0) * per; vb += gridDim.x) {
    const int grp = grp0 + vb / per, tt = vb % per, tm = tt / ntn, tn = tt % ntn;
    const int s = grp >> 4, e = grp & 15; const int cap = s < 2 ? CAPL : CAPC;
    if (tm * 64 >= cap) continue;
    const int pb = pair_base(s, e);
    const bf16_t* hid = (const bf16_t*)(p.ws + OFF_HID) + (size_t)pb * DEXP;
    const float* Wd = p.w_down + ((size_t)l * NE + e) * DEXP * D;
    const float* gate = (const float*)(p.ws + OFF_GATE) + pb;
    bf16_t* Y = (bf16_t*)(p.ws + OFF_Y) + (size_t)pb * D;
    ngemm_tile(lds, cap, D, DEXP, tm, tn,
               [&](int r, int k) { return bf2f(hid[(size_t)r * DEXP + k]); },
               [&](int k, int n) { return Wd[(size_t)k * D + n]; },
               [&](int r, int n, float v) { Y[(size_t)r * D + n] = f2bf(v * gate[r]); });
  }
}
__device__ __forceinline__ void ph_combine(const Params& p, int l, int nrows) {
  const int TIDX = ltid(); const int BIDX = lbid();
  const bf16_t* Y = (const bf16_t*)(p.ws + OFF_Y);
  for (int r = BIDX; r < nrows; r += gridDim.x) {
    int mj, t, tlen, r0; rowinfo(r, mj, t, tlen, r0);
    const int s = r < ML ? (r >> 13) : 2 + ((r - ML) >> 8);
    const int* slot = (const int*)(p.ws + OFF_SLOT) + (size_t)r * 16;
    const float* g2 = modvec(p, l, mj, 5);
    float* xr = xrow(p, r);
    for (int c = TIDX; c < D; c += NT) {
      float a = 0;
      for (int e = 0; e < 16; ++e) { int sl = slot[e]; if (sl >= 0) a += bf2f(Y[(size_t)(pair_base(s, e) + sl) * D + c]); }
      xr[c] += g2[c] * a;
    }
  }
}


__device__ __forceinline__ void transpose_cvt_tile(float* lds, const float* W, int ldw, int N, bf16_t* Wt, int K, int rmul, int roff, int tk, int tn, int tid, const float* kscale = nullptr) {
  __syncthreads();
#pragma unroll
  for (int i = 0; i < 8; ++i) { int e = tid + i * NT; int kk = e >> 6, nn = e & 63; int n = tn * 64 + nn; lds[kk * 65 + nn] = n < N ? W[(size_t)(tk * 64 + kk) * ldw + n] * (kscale ? kscale[tk * 64 + kk] : 1.f) : 0.f; }
  __syncthreads();
#pragma unroll
  for (int i = 0; i < 8; ++i) { int e = tid + i * NT; int nn = e >> 6, kk = e & 63; int n = tn * 64 + nn; if (n < N) Wt[(size_t)(n * rmul + roff) * K + tk * 64 + kk] = f2bf(lds[kk * 65 + nn]); }
}
__device__ __forceinline__ void transpose_cvt_4tiles(float* lds, const float* W, int ldw, int N, bf16_t* Wt, int K, int rmul, int roff, int t4, int ntiles, int tid, const float* kscale) {
  const int ntn = (N + 63) / 64;
  float v[4][8];
#pragma unroll
  for (int q = 0; q < 4; ++q) { const int t = t4 + q, tk = t / ntn, tn = t % ntn;
#pragma unroll
    for (int i = 0; i < 8; ++i) { const int el = tid + i * NT, kk = el >> 6, nn = el & 63, n = tn * 64 + nn;
      v[q][i] = (t < ntiles && n < N) ? W[(size_t)(tk * 64 + kk) * ldw + n] * (kscale ? kscale[tk * 64 + kk] : 1.f) : 0.f; } }
  __syncthreads();
#pragma unroll
  for (int q = 0; q < 4; ++q)
#pragma unroll
    for (int i = 0; i < 8; ++i) { const int el = tid + i * NT, kk = el >> 6, nn = el & 63; lds[q * 4160 + kk * 65 + nn] = v[q][i]; }
  __syncthreads();
#pragma unroll
  for (int q = 0; q < 4; ++q) { const int t = t4 + q, tk = t / ntn, tn = t % ntn;
#pragma unroll
    for (int i = 0; i < 4; ++i) { const int el = tid + i * NT, nn = el >> 5, k2 = (el & 31) * 2, n = tn * 64 + nn;
      if (t < ntiles && n < N) *(unsigned*)(Wt + (size_t)(n * rmul + roff) * K + tk * 64 + k2) = gd::pk(lds[q * 4160 + k2 * 65 + nn], lds[q * 4160 + (k2 + 1) * 65 + nn]); } }
}
__device__ __forceinline__ void ph_prep_weights(const Params& p, float* lds) {
  const int TIDX = ltid(); const int BIDX = lbid();
  bf16_t* winT = (bf16_t*)(p.ws + OFF_WINT); bf16_t* woutT = (bf16_t*)(p.ws + OFF_WOUTT);
  const int g_in = 2 * 168, g_out = 2 * 64, g_q = 2 * 5, g_kv = 2 * 4;
  for (int vb = BIDX; vb < g_in + g_out + g_q + g_kv; vb += gridDim.x) {
    if (vb < g_in) { const int l = vb / 168, r = vb % 168; transpose_cvt_4tiles(lds, p.w_in + (size_t)l * D * NIN, NIN, NIN, winT + (size_t)l * NINP * D, D, 1, 0, r * 4, 16 * 42, TIDX, nullptr); }
    else if (vb < g_in + g_out) { const int v = vb - g_in, l = v / 64, r = v % 64; transpose_cvt_4tiles(lds, p.w_out + (size_t)l * D * D, D, D, woutT + (size_t)l * D * D, D, 1, 0, r * 4, 256, TIDX, nullptr); }
    else if (vb < g_in + g_out + g_q) { const int v = vb - g_in - g_out, l = v / 5, r = v % 5;
      transpose_cvt_4tiles(lds, p.w_uq + (size_t)l * 192 * 384, 384, 384, (bf16_t*)(p.ws + OFF_WUP) + (size_t)l * 1024 * 256, 256, 1, 0, r * 4, 18, TIDX, p.q_a_norm + l * 192); }
    else { const int v = vb - g_in - g_out - g_q, l = v / 4, r = v % 4;
      transpose_cvt_4tiles(lds, p.w_ukv + (size_t)l * 128 * 512, 512, 512, (bf16_t*)(p.ws + OFF_WUP) + (size_t)l * 1024 * 256 + 512 * 256, 256, 1, 0, r * 4, 16, TIDX, p.kv_a_norm + l * 128); }
  }
  for (int q = 0; q < 16; ++q) {
    const int i = (q * (int)gridDim.x + BIDX) * NT + TIDX; if (i >= 2 * 1024 * 256) break;
    const int k = i & 255, n = (i >> 8) & 1023;
    if ((n < 384 && k >= 192) || (n >= 384 && n < 512) || (n >= 512 && k >= 128)) ((bf16_t*)(p.ws + OFF_WUP))[i] = 0;
  }
  for (size_t i = (size_t)BIDX * NT + TIDX; i < (size_t)2 * (NINP - NIN) * D; i += (size_t)gridDim.x * NT) {
    const int l = (int)(i / ((size_t)(NINP - NIN) * D)); const size_t r = i % ((size_t)(NINP - NIN) * D);
    winT[(size_t)l * NINP * D + (size_t)NIN * D + r] = 0;
  }
}
__device__ __forceinline__ void ph_inproj_fast(const Params& p, int l, char* smem) {
  DenseSched S; S.init(MR / 256, NINP / 256, (int)gridDim.x, lbid());
  S.A = p.ws + OFF_H; S.Bt = p.ws + OFF_WINT + (size_t)l * NINP * D * 2; S.lda = D; S.ldb = D; S.K = D;
  EpiStoreBf16 E; E.O = (bf16_t*)(p.ws + OFF_P); E.ldc = NINP;
  pg8::gemm_phase(( PG8_LAS unsigned char*)smem, S, E);
}

__device__ __forceinline__ void ph_outproj_fast(const Params& p, int l, char* smem) {
  DenseSched S; S.init(ML / 256, D / 256, (int)gridDim.x, lbid());
  S.A = p.ws + OFF_H; S.Bt = p.ws + OFF_WOUTT + (size_t)l * D * D * 2; S.lda = D; S.ldb = D; S.K = D;
  EpiStoreBf16 E; E.O = (bf16_t*)(p.ws + OFF_YO); E.ldc = D;
  pg8::gemm_phase((PG8_LAS unsigned char*)smem, S, E);
}

__device__ __forceinline__ void ph_prep_moe_weights(const Params& p, int l, float* lds, int b0, int nb) {
  const int TIDX = ltid(); const int BIDX = lbid() - b0;
  if (BIDX < 0) return;
  bf16_t* gu = (bf16_t*)(p.ws + OFF_MOEGU); bf16_t* dn = (bf16_t*)(p.ws + OFF_MOED);
  unsigned* ctr = (unsigned*)(p.ws + OFF_BAR) + 16 + l; volatile int* bc = (volatile int*)(lds + 4 * 4160);
  __syncthreads();
  if (TIDX == 0) bc[0] = (int)__hip_atomic_fetch_add(ctr, 1u, __ATOMIC_RELAXED, __HIP_MEMORY_SCOPE_AGENT);
  __syncthreads();
  int vb = __builtin_amdgcn_readfirstlane(bc[0]);
  for (int it = 1; ; ++it) {
    if (vb >= NE * 3 * 32) break;
    const int e = vb / 96, r = vb % 96, which = r >> 5, t4 = (r & 31) * 4;
    const float* W; int ldw, K, rmul, roff; bf16_t* Wt;
    if (which < 2) { W = (which ? p.w_up : p.w_gate) + ((size_t)l * NE + e) * D * DEXP; ldw = DEXP; K = D; rmul = 2; roff = which; Wt = gu + (size_t)e * D * D; }
    else { W = p.w_down + ((size_t)l * NE + e) * DEXP * D; ldw = D; K = DEXP; rmul = 1; roff = 0; Wt = dn + (size_t)e * D * DEXP; }
    const int ntn = ldw / 64;
    float v[4][8];
#pragma unroll
    for (int q = 0; q < 4; ++q) { const int t = t4 + q, tk = t / ntn, tn = t % ntn;
#pragma unroll
      for (int i = 0; i < 8; ++i) { const int el = TIDX + i * NT, kk = el >> 6, nn = el & 63; v[q][i] = __builtin_nontemporal_load(&W[(size_t)(tk * 64 + kk) * ldw + tn * 64 + nn]); } }
    if (TIDX == 0) bc[it & 1] = (int)__hip_atomic_fetch_add(ctr, 1u, __ATOMIC_RELAXED, __HIP_MEMORY_SCOPE_AGENT);
    __syncthreads();
#pragma unroll
    for (int q = 0; q < 4; ++q)
#pragma unroll
      for (int i = 0; i < 8; ++i) { const int el = TIDX + i * NT, kk = el >> 6, nn = el & 63; lds[q * 4160 + kk * 65 + nn] = v[q][i]; }
    __syncthreads();
#pragma unroll
    for (int q = 0; q < 4; ++q) { const int t = t4 + q, tk = t / ntn, tn = t % ntn;
#pragma unroll
      for (int i = 0; i < 4; ++i) { const int el = TIDX + i * NT, nn = el >> 5, k2 = (el & 31) * 2;
        const unsigned w = gd::pk(lds[q * 4160 + k2 * 65 + nn], lds[q * 4160 + (k2 + 1) * 65 + nn]);
        *(unsigned*)(Wt + (size_t)((tn * 64 + nn) * rmul + roff) * K + tk * 64 + k2) = w; } }
    vb = __builtin_amdgcn_readfirstlane(bc[it & 1]);
  }
}
__device__ __forceinline__ void ph_gather(const Params& p) {
  const int TIDX = ltid(); const int BIDX = lbid();
  const int lane = TIDX & 63, wv = TIDX >> 6;
  const int* idx = (const int*)(p.ws + OFF_IDX);
  const uint4* H = (const uint4*)(p.ws + OFF_H); uint4* xs = (uint4*)(p.ws + OFF_XS);
  for (int r = BIDX * 8 + wv; r < NB * NE * CAPL; r += gridDim.x * 8) {
    const int src = idx[r];
    const uint4 a = H[(size_t)src * 128 + lane], b = H[(size_t)src * 128 + 64 + lane];
    xs[(size_t)r * 128 + lane] = a; xs[(size_t)r * 128 + 64 + lane] = b;
  }
}
__device__ __forceinline__ void ph_moe_gu_fast(const Params& p, char* smem) {
  MoeSched S; S.init(NB * NE * CAPL / 256, 2 * DEXP / 256, (int)gridDim.x, lbid());
  S.A = p.ws + OFF_H; S.Bt = p.ws + OFF_MOEGU; S.lda = D; S.ldb = D; S.K = D; S.bstride = (size_t)D * D * 2; S.gidx = (const int*)(p.ws + OFF_IDX); S.gather = true;
  EpiSwiGLU E; E.O = (bf16_t*)(p.ws + OFF_HID);
  pg8::gemm_phase<EpiSwiGLU, MoeSched, true>((PG8_LAS unsigned char*)smem, S, E);
}
__device__ __forceinline__ void ph_moe_down_fast(const Params& p, char* smem) {
  MoeSched S; S.init(NB * NE * CAPL / 256, D / 256, (int)gridDim.x, lbid());
  S.A = p.ws + OFF_HID; S.Bt = p.ws + OFF_MOED; S.lda = DEXP; S.ldb = DEXP; S.K = DEXP; S.bstride = (size_t)D * DEXP * 2; S.gidx = nullptr; S.gather = false;
  EpiGateBf16 E; E.O = (bf16_t*)(p.ws + OFF_Y); E.gate = (const float*)(p.ws + OFF_GATE);
  pg8::gemm_phase((PG8_LAS unsigned char*)smem, S, E);
}

__device__ __forceinline__ void attn_ctx_item(const Params& p, int j, char* smem) {
  const bf16_t* Q = (const bf16_t*)(p.ws + OFF_QKV); const bf16_t* Kb = Q + QK_ELEMS; const bf16_t* Vb = Kb + QK_ELEMS;
  const int h = j & 3, b = j >> 2; const size_t bh = (size_t)(b * 4 + h) * TK;
  fa::attn_body(Q + bh * 128, Kb + bh * 128, Vb + bh * 64, (bf16_t*)(p.ws + OFF_H) + (size_t)(ML + b * TC) * D + h * 64, D, TC, smem);
}
__device__ __forceinline__ void attn_seg(const Params& p, int x, int qt, int off, int len, char* smem) {
  const bf16_t* Q = (const bf16_t*)(p.ws + OFF_QKV); const bf16_t* Kb = Q + QK_ELEMS; const bf16_t* Vb = Kb + QK_ELEMS;
  const int h = x & 3, b = x >> 2, part = off == 0 ? 0 : 1, kv0 = off * 128;
  const size_t bh = (size_t)(b * 4 + h) * TK; const int row0 = b * T + qt * 256;
  bf16_t* op = (bf16_t*)(p.ws + OFF_OPART) + ((size_t)part * ML + row0) * 256 + h * 64;
  float* ml = (float*)(p.ws + OFF_MLPART) + (((size_t)part * ML + row0) * 4 + h) * 2;
  fa::attn_body(Q + (bh + TC + qt * 256) * 128, Kb + (bh + kv0) * 128, Vb + (bh + kv0) * 64, op, 256, len * 128, smem, ml, 8);
  if (off == 0 && len == TK / 128) {
    const int t = ltid();
    if (t < 256) *(float2*)((float*)(p.ws + OFF_MLPART) + (((size_t)ML + row0 + t) * 4 + h) * 2) = make_float2(-1e30f, 0.f);
  }
}
__device__ __forceinline__ void ph_attn_fast(const Params& p, bool need_ctx, char* smem) {
  const int BIDX = lbid();
  const int nns = (int)gridDim.x - 32;
  if (BIDX >= 32) {
    const int x = BIDX & 7, j = (BIDX - 32) >> 3, nj = nns >> 3;
    constexpr int PPQ = TK / 128, NPAIRS = 32 * PPQ;
    const int hi = (NPAIRS * (j + 1)) / nj;
    for (int cur = (NPAIRS * j) / nj; cur < hi; ) {
      const int qt = cur / PPQ, off = cur - qt * PPQ, len = min(PPQ - off, hi - cur);
      attn_seg(p, x, qt, off, len, smem);
      cur += len;
    }
    if (need_ctx && j == nj - 1) attn_ctx_item(p, x, smem);
  }
}

__device__ __forceinline__ void ph_gdn_precompute(const Params& p, int l, char* smem) {
  const int TIDX = ltid(); const int BIDX = lbid();
  __syncthreads();
  { const float* cw = p.conv_w + (size_t)l * 3 * 1536; float* cwl = (float*)(smem + gd::L_CW);
    for (int i = TIDX; i < 3 * 1536 / 4; i += NT) ((float4*)cwl)[i] = ((const float4*)cw)[i]; }
  const int nit = NB * 4 * gd::NCH;
  for (int it = BIDX; it < nit; it += gridDim.x) {
    const int c = it % gd::NCH, bh = it / gd::NCH;
    uint4 cur[3][4];
    gd::precompute_load(p, bh >> 2, bh & 3, c, TIDX, cur);
    gd::precompute_item(p, l, bh >> 2, bh & 3, c, smem, TIDX, cur);
  }
  __syncthreads();
}
__device__ __forceinline__ void ph_scan_fast(const Params& p, char* smem) {
  const int TIDX = ltid(); const int BIDX = lbid();
  if (BIDX < 32) gd::scan_unit_lds(p, (((BIDX & 7) + 8 * (BIDX >> 4)) << 1) | ((BIDX >> 3) & 1), smem, TIDX);
}

struct MlaSched : pg8::GridOrder {
  const char* P; const char* W; int lda, ldb, K; const int* gidx;
  __device__ __forceinline__ const char* a_ptr(const pg8::Unit& u) const { return P + (size_t)u.pm * 256 * NINP * 2 + (u.pn < 2 ? PC_Q : PC_KV) * 2; }
  __device__ __forceinline__ const char* b_ptr(const pg8::Unit& u) const { return W + (size_t)u.pn * 256 * 256 * 2; }
};
__device__ __forceinline__ void ph_mla_gemm(const Params& p, int l, char* smem) {
  if (lbid() < 32) return;
  MlaSched S; S.init(MR / 256, 4, (int)gridDim.x - 32, lbid() - 32);
  S.P = p.ws + OFF_P; S.W = p.ws + OFF_WUP + (size_t)l * 1024 * 256 * 2; S.lda = NINP; S.ldb = 256; S.K = 256; S.gidx = nullptr;
  EpiStoreBf16 E; E.O = (bf16_t*)(p.ws + OFF_UPRAW); E.ldc = 1024;
  pg8::gemm_phase((PG8_LAS unsigned char*)smem, S, E);
}
__device__ __forceinline__ void ph_mla_finish(const Params& p, int l) {
  const int TIDX = ltid(); const int BIDX = lbid();
  const int lane = TIDX & 63, wv = TIDX >> 6, cc = lane & 15, h = lane >> 4;
  const bf16_t* P = (const bf16_t*)(p.ws + OFF_P); const bf16_t* RAW = (const bf16_t*)(p.ws + OFF_UPRAW);
  bf16_t* Qo = (bf16_t*)(p.ws + OFF_QKV); bf16_t* Ko = Qo + QK_ELEMS; bf16_t* Vo = Ko + QK_ELEMS;
  const float invf = __builtin_amdgcn_exp2f(-(float)(cc & 7) * 1.6609640474436813f);
  const float sgn = (cc < 8) ? -1.f : 1.f;
  float qw[6], kw[6];
#pragma unroll
  for (int nt = 0; nt < 6; ++nt) { qw[nt] = p.q_norm[l * 96 + nt * 16 + cc]; kw[nt] = p.k_norm[l * 96 + nt * 16 + cc]; }
  for (int r2 = (BIDX + gridDim.x * wv) * 2; r2 < MR; r2 += gridDim.x * 8 * 2)
#pragma unroll
  for (int rr = 0; rr < 2; ++rr) { const int r = r2 + rr;
    const bool lat = r < ML; const int b = lat ? (r >> 13) : ((r - ML) >> 8), t = lat ? (r & (T - 1)) : ((r - ML) & (TC - 1)), pos = lat ? TC + t : t;
    const bf16_t* Pr = P + (size_t)r * NINP; const bf16_t* Rr = RAW + (size_t)r * 1024;
    float qa[6], ka[8], pq[3], pkv[2], pkr[2];
#pragma unroll
    for (int nt = 0; nt < 6; ++nt) qa[nt] = bf2f(Rr[h * 96 + nt * 16 + cc]);
#pragma unroll
    for (int nt = 0; nt < 8; ++nt) ka[nt] = bf2f(Rr[512 + h * 128 + nt * 16 + cc]);
#pragma unroll
    for (int i = 0; i < 3; ++i) pq[i] = bf2f(Pr[PC_Q + i * 64 + lane]);
#pragma unroll
    for (int i = 0; i < 2; ++i) { pkv[i] = bf2f(Pr[PC_KV + i * 64 + lane]); pkr[i] = bf2f(Pr[PC_KR + i * 16 + cc]); }
    const float rq = rsqrtf(wave_sum(pq[0] * pq[0] + pq[1] * pq[1] + pq[2] * pq[2]) / 192.f + EPS);
    const float rkv = rsqrtf(wave_sum(pkv[0] * pkv[0] + pkv[1] * pkv[1]) / 128.f + EPS);
    const float a0 = (float)(t >> 6) * invf, a1 = (float)(t & 63) * invf;
    const float cs[2] = {__cosf(a0), __cosf(a1)}, sn[2] = {__sinf(a0), __sinf(a1)};
    { float ss = 0.f;
#pragma unroll
      for (int nt = 0; nt < 6; ++nt) ss += qa[nt] * qa[nt];
      ss += __shfl_xor(ss, 1); ss += __shfl_xor(ss, 2); ss += __shfl_xor(ss, 4); ss += __shfl_xor(ss, 8);
      const float sc = rq * rsqrtf(rq * rq * ss / 96.f + EPS);
      const size_t ob = ((size_t)(b * 4 + h) * TK + pos) * 128;
#pragma unroll
      for (int nt = 0; nt < 6; ++nt) { float v = qa[nt] * sc * qw[nt];
        if (nt >= 4) { const float o = __shfl_xor(v, 8); if (lat) v = v * cs[nt - 4] + sgn * o * sn[nt - 4]; }
        Qo[ob + nt * 16 + cc] = f2bf(v); } }
    { float ss = 0.f, skr = pkr[0] * pkr[0] + pkr[1] * pkr[1];
#pragma unroll
      for (int nt = 0; nt < 4; ++nt) ss += ka[nt] * ka[nt];
      ss += __shfl_xor(ss, 1); ss += __shfl_xor(ss, 2); ss += __shfl_xor(ss, 4); ss += __shfl_xor(ss, 8);
      skr += __shfl_xor(skr, 1); skr += __shfl_xor(skr, 2); skr += __shfl_xor(skr, 4); skr += __shfl_xor(skr, 8);
      const float sck = rsqrtf((rkv * rkv * ss + skr) / 96.f + EPS);
      const size_t ob = ((size_t)(b * 4 + h) * TK + pos);
#pragma unroll
      for (int nt = 0; nt < 4; ++nt) Ko[ob * 128 + nt * 16 + cc] = f2bf(ka[nt] * rkv * sck * kw[nt]);
#pragma unroll
      for (int q = 0; q < 2; ++q) { float v = pkr[q] * kw[4 + q]; const float o = __shfl_xor(v, 8); if (lat) v = v * cs[q] + sgn * o * sn[q];
        Ko[ob * 128 + 64 + q * 16 + cc] = f2bf(v * sck); }
#pragma unroll
      for (int nt = 0; nt < 4; ++nt) Vo[ob * 64 + nt * 16 + cc] = f2bf(ka[4 + nt] * rkv); }
  }
}
constexpr int POOL_ROWB = 144, POOL_TILEB = 64 * POOL_ROWB;
template <int H>
__device__ __forceinline__ void pool_unit(const Params& p, int l, int tile, int gi, char* Dw, const char* WTl, int lane) {
  typedef unsigned u2 __attribute__((ext_vector_type(2)));
  using bf16x8 = fa::bf16x8; using f32x16 = fa::f32x16;
  const int r_first = tile * 64;
  int r0, tlen;
  if (r_first < ML) { r0 = r_first & ~(T - 1); tlen = T; } else { r0 = ML + ((r_first - ML) & ~(TC - 1)); tlen = TC; }
  const int cq = lane & 15, tb = lane >> 4, tbase = r_first - r0 + tb * 16;
  const bf16_t* Pg = (const bf16_t*)(p.ws + OFF_P) + (size_t)r0 * NINP + PC_POOL + gi * 64 + cq * 4;
  constexpr int NR = 15 + 2 * H;
  u2 xs[NR];
#pragma unroll
  for (int j = 0; j < NR; ++j) { const int tt = tbase - H + j; xs[j] = (tt >= 0 && tt < tlen) ? *(const u2*)(Pg + (size_t)tt * NINP) : (u2){0u, 0u}; }
#define PL_LO(w) __uint_as_float((w) << 16)
#define PL_HI(w) __uint_as_float((w) & 0xffff0000u)
  float s0 = 0.f, s1 = 0.f, s2 = 0.f, s3 = 0.f;
#pragma unroll
  for (int j = 0; j < 2 * H; ++j) { s0 += PL_LO(xs[j].x); s1 += PL_HI(xs[j].x); s2 += PL_LO(xs[j].y); s3 += PL_HI(xs[j].y); }
  char* drow = Dw + (tb * 16) * POOL_ROWB + cq * 8;
#pragma unroll
  for (int i = 0; i < 16; ++i) {
    const int t = tbase + i; const int lo = t - H < 0 ? 0 : t - H, hi = t + H > tlen ? tlen : t + H;
    const float inv = 1.f / (float)(hi - lo);
    const u2 c = xs[i + H];
    u2 w; w.x = gd::pk(s0 * inv - PL_LO(c.x), s1 * inv - PL_HI(c.x)); w.y = gd::pk(s2 * inv - PL_LO(c.y), s3 * inv - PL_HI(c.y));
    *(u2*)(drow + i * POOL_ROWB) = w;
    if (i < 15) { const u2 a = xs[i + 2 * H], b = xs[i];
      s0 += PL_LO(a.x) - PL_LO(b.x); s1 += PL_HI(a.x) - PL_HI(b.x); s2 += PL_LO(a.y) - PL_LO(b.y); s3 += PL_HI(a.y) - PL_HI(b.y); }
  }
#undef PL_LO
#undef PL_HI
  asm volatile("s_waitcnt lgkmcnt(0)" ::: "memory");
  const int r32 = lane & 31, hl = lane >> 5;
  f32x16 acc[2][2];
#pragma unroll
  for (int a = 0; a < 2; ++a)
#pragma unroll
    for (int b = 0; b < 2; ++b)
#pragma unroll
      for (int i = 0; i < 16; ++i) acc[a][b][i] = 0.f;
#pragma unroll
  for (int ks = 0; ks < 4; ++ks) {
    const bf16x8 a0 = *(const bf16x8*)(WTl + r32 * POOL_ROWB + ks * 32 + hl * 16), a1 = *(const bf16x8*)(WTl + (32 + r32) * POOL_ROWB + ks * 32 + hl * 16);
    const bf16x8 b0 = *(const bf16x8*)(Dw + r32 * POOL_ROWB + ks * 32 + hl * 16), b1 = *(const bf16x8*)(Dw + (32 + r32) * POOL_ROWB + ks * 32 + hl * 16);
    acc[0][0] = __builtin_amdgcn_mfma_f32_32x32x16_bf16(a0, b0, acc[0][0], 0, 0, 0); acc[0][1] = __builtin_amdgcn_mfma_f32_32x32x16_bf16(a0, b1, acc[0][1], 0, 0, 0);
    acc[1][0] = __builtin_amdgcn_mfma_f32_32x32x16_bf16(a1, b0, acc[1][0], 0, 0, 0); acc[1][1] = __builtin_amdgcn_mfma_f32_32x32x16_bf16(a1, b1, acc[1][1], 0, 0, 0);
  }
  const float* psc = p.pool_scale + l * 256 + gi * 64 + 4 * hl;
  bf16_t* cat = (bf16_t*)(p.ws + OFF_H) + (size_t)(r_first + r32) * D + 768 + gi * 64 + 4 * hl;
#pragma unroll
  for (int mt = 0; mt < 2; ++mt)
#pragma unroll
    for (int q = 0; q < 4; ++q) {
      const float4 s4 = *(const float4*)(psc + mt * 32 + q * 8);
#pragma unroll
      for (int nt = 0; nt < 2; ++nt) {
        u2 w; w.x = gd::pk(acc[mt][nt][4 * q] * s4.x, acc[mt][nt][4 * q + 1] * s4.y); w.y = gd::pk(acc[mt][nt][4 * q + 2] * s4.z, acc[mt][nt][4 * q + 3] * s4.w);
        *(u2*)(cat + (size_t)(nt * 32) * D + mt * 32 + q * 8) = w;
      }
    }
  asm volatile("s_waitcnt lgkmcnt(0)" ::: "memory");
}
__device__ __forceinline__ void ph_pool_mfma(const Params& p, int l, int nrows, char* smem) {
  const int TIDX = ltid(); const int BIDX = lbid();
  const int lane = TIDX & 63, wv = TIDX >> 6;
  const int gi = BIDX & 3;
  __syncthreads();
  {
    const float4* W = (const float4*)(p.pool_w + ((size_t)l * 4 + gi) * 4096);
    for (int i = TIDX; i < 1024; i += NT) { const float4 w = W[i]; const int c = i >> 4, o4 = (i & 15) * 4;
      bf16_t* dst = (bf16_t*)(smem + o4 * POOL_ROWB) + c;
      dst[0] = f2bf(w.x); dst[POOL_ROWB / 2] = f2bf(w.y); dst[POOL_ROWB] = f2bf(w.z); dst[3 * POOL_ROWB / 2] = f2bf(w.w); }
  }
  __syncthreads();
  char* Dw = smem + POOL_TILEB + wv * POOL_TILEB;
  const int ntiles = nrows >> 6;
  for (int tile = wv * ((int)gridDim.x >> 2) + (BIDX >> 2); tile < ntiles; tile += 8 * ((int)gridDim.x >> 2)) {
    if (gi == 0) pool_unit<1>(p, l, tile, 0, Dw, smem, lane); else if (gi == 1) pool_unit<2>(p, l, tile, 1, Dw, smem, lane);
    else if (gi == 2) pool_unit<4>(p, l, tile, 2, Dw, smem, lane); else pool_unit<8>(p, l, tile, 3, Dw, smem, lane);
  }
}
template <int MODE>
__device__ __forceinline__ void ph_gdnfin_pool_fast(const Params& p, int l, int nrows, float* lds, int b0, int nb) {
  const int TIDX = ltid(); const int BIDX = lbid() - b0;
  if (BIDX < 0) return;
  const int lane = TIDX & 63, wv = TIDX >> 6;
  float* Wl = lds; float* dsc = lds + 16384 + wv * 256;
  if (MODE == 1) {
    __syncthreads();
    for (int i = TIDX; i < 4096; i += NT) ((float4*)Wl)[i] = ((const float4*)(p.pool_w + (size_t)l * 16384))[i];
    __syncthreads();
  }
  const bf16_t* P = (const bf16_t*)(p.ws + OFF_P);
  const float* gn = p.gdn_norm_g + l * 128; const float* psc = p.pool_scale + l * 256;
  for (int r = BIDX + nb * wv; r < nrows; r += nb * 8) {
    int mj, t, tlen, r0; rowinfo(r, mj, t, tlen, r0);
    bf16_t* cat = (bf16_t*)(p.ws + OFF_H) + (size_t)r * D;
    const bf16_t* Pr = P + (size_t)r * NINP;
    if (MODE == 2 && r < ML) {
      const int hh = lane >> 4;
      float mp[2], lp[2], mx = -1e30f;
#pragma unroll
      for (int q = 0; q < 2; ++q) { const float2 ml = *(const float2*)((const float*)(p.ws + OFF_MLPART) + (((size_t)q * ML + r) * 4 + hh) * 2); mp[q] = ml.x; lp[q] = ml.y; mx = fmaxf(mx, ml.x); }
      float acc4[4] = {0.f, 0.f, 0.f, 0.f}, wsum = 0.f;
#pragma unroll
      for (int q = 0; q < 2; ++q) { const float w = lp[q] * __expf((mp[q] - mx) * fa::SCALE); wsum += w;
        const uint2 o = *(const uint2*)((const bf16_t*)(p.ws + OFF_OPART) + ((size_t)q * ML + r) * 256 + lane * 4);
        acc4[0] += w * __uint_as_float(o.x << 16); acc4[1] += w * __uint_as_float(o.x & 0xffff0000u); acc4[2] += w * __uint_as_float(o.y << 16); acc4[3] += w * __uint_as_float(o.y & 0xffff0000u); }
      const float inv = 1.f / wsum;
      uint2 w2; w2.x = gd::pk(acc4[0] * inv, acc4[1] * inv); w2.y = gd::pk(acc4[2] * inv, acc4[3] * inv);
      *(uint2*)(cat + lane * 4) = w2;
    }
    if (MODE == 2) {
      const uint4 a = *(const uint4*)(Pr + PC_OF + lane * 8), bq = *(const uint4*)(Pr + PC_OB + lane * 8), z = *(const uint4*)(Pr + PC_Z + lane * 8);
      const unsigned aw[4] = {a.x, a.y, a.z, a.w}, bw[4] = {bq.x, bq.y, bq.z, bq.w}, zw[4] = {z.x, z.y, z.z, z.w};
      float o[8], ss = 0.f;
#pragma unroll
      for (int i = 0; i < 4; ++i) { o[2 * i] = __uint_as_float(aw[i] << 16) + __uint_as_float(bw[i] << 16); o[2 * i + 1] = __uint_as_float(aw[i] & 0xffff0000u) + __uint_as_float(bw[i] & 0xffff0000u); }
#pragma unroll
      for (int i = 0; i < 8; ++i) ss += o[i] * o[i];
      ss += __shfl_xor(ss, 1); ss += __shfl_xor(ss, 2); ss += __shfl_xor(ss, 4); ss += __shfl_xor(ss, 8);
      const float rs = rsqrtf(ss / 128.f + EPS);
      float y[8];
#pragma unroll
      for (int i = 0; i < 4; ++i) { const float z0 = __uint_as_float(zw[i] << 16), z1 = __uint_as_float(zw[i] & 0xffff0000u);
        y[2 * i] = o[2 * i] * rs * gn[(lane & 15) * 8 + 2 * i] * silu_f(z0); y[2 * i + 1] = o[2 * i + 1] * rs * gn[(lane & 15) * 8 + 2 * i + 1] * silu_f(z1); }
      uint4 w; w.x = gd::pk(y[0], y[1]); w.y = gd::pk(y[2], y[3]); w.z = gd::pk(y[4], y[5]); w.w = gd::pk(y[6], y[7]);
      *(uint4*)(cat + 256 + lane * 8) = w;
    }
    if (MODE == 1) {
      const int gi = lane >> 4, win = 2 << gi;
      int lo = t - win / 2, hi = lo + win; lo = lo < 0 ? 0 : lo; hi = hi > tlen ? tlen : hi;
      float sm[4] = {0.f, 0.f, 0.f, 0.f};
      uint2 uw[16];
#pragma unroll
      for (int q = 0; q < 16; ++q) { const int tt = t - 8 + q; const bool ok = tt >= lo && tt < hi; uw[q] = ok ? *(const uint2*)(P + (size_t)(r0 + tt) * NINP + PC_POOL + lane * 4) : make_uint2(0u, 0u); }
#pragma unroll
      for (int q = 0; q < 16; ++q) { sm[0] += __uint_as_float(uw[q].x << 16); sm[1] += __uint_as_float(uw[q].x & 0xffff0000u); sm[2] += __uint_as_float(uw[q].y << 16); sm[3] += __uint_as_float(uw[q].y & 0xffff0000u); }
      const uint2 u = *(const uint2*)(Pr + PC_POOL + lane * 4); const float inv = 1.f / (float)(hi - lo);
      dsc[lane * 4 + 0] = sm[0] * inv - __uint_as_float(u.x << 16); dsc[lane * 4 + 1] = sm[1] * inv - __uint_as_float(u.x & 0xffff0000u);
      dsc[lane * 4 + 2] = sm[2] * inv - __uint_as_float(u.y << 16); dsc[lane * 4 + 3] = sm[3] * inv - __uint_as_float(u.y & 0xffff0000u);
      float4 acc = {0.f, 0.f, 0.f, 0.f};
      const float* wg = Wl + gi * 4096 + (lane & 15) * 4; const float* dg = dsc + gi * 64;
#pragma unroll 8
      for (int c = 0; c < 64; ++c) { const float dv = dg[c]; const float4 w4 = *(const float4*)(wg + c * 64); acc.x += dv * w4.x; acc.y += dv * w4.y; acc.z += dv * w4.z; acc.w += dv * w4.w; }
      const float4 s4 = *(const float4*)(psc + lane * 4);
      uint2 w; w.x = gd::pk(acc.x * s4.x, acc.y * s4.y); w.y = gd::pk(acc.z * s4.z, acc.w * s4.w);
      *(uint2*)(cat + 768 + lane * 4) = w;
    }
  }
}
__device__ __forceinline__ void ph_ada_fast(const Params& p, float* lds) {
  const int TIDX = ltid(); const int BIDX = lbid();
  const int cg = TIDX & 15, ksl = TIDX >> 4;
  for (int u = BIDX; u < 2 * 96; u += gridDim.x) {
    const int l = u / 96, n0 = (u % 96) * 64 + cg * 4;
    const float* w = p.ada_w + (size_t)l * D * 6144 + n0;
    float4 a0 = {0.f, 0.f, 0.f, 0.f}, a1 = a0, a2 = a0;
#pragma unroll 16
    for (int kk = 0; kk < 32; ++kk) { const int k = ksl * 32 + kk; typedef float f4v __attribute__((ext_vector_type(4))); const f4v w4 = __builtin_nontemporal_load((const f4v*)(w + (size_t)k * 6144));
      const float s0 = silu_f(p.c[k]), s1 = silu_f(p.c[D + k]), s2 = silu_f(p.c_ctx[k]);
      a0.x += s0 * w4.x; a0.y += s0 * w4.y; a0.z += s0 * w4.z; a0.w += s0 * w4.w;
      a1.x += s1 * w4.x; a1.y += s1 * w4.y; a1.z += s1 * w4.z; a1.w += s1 * w4.w;
      a2.x += s2 * w4.x; a2.y += s2 * w4.y; a2.z += s2 * w4.z; a2.w += s2 * w4.w; }
    __syncthreads();
    float4* red = (float4*)lds;
    red[(ksl * 3 + 0) * 16 + cg] = a0; red[(ksl * 3 + 1) * 16 + cg] = a1; red[(ksl * 3 + 2) * 16 + cg] = a2;
    __syncthreads();
    if (TIDX < 192) { const int j = TIDX / 64, c = TIDX % 64; const float* rf = lds;
      float a = p.ada_b[l * 6144 + (u % 96) * 64 + c];
      for (int q = 0; q < 32; ++q) a += rf[((q * 3 + j) * 16 + (c >> 2)) * 4 + (c & 3)];
      ((float*)(p.ws + OFF_MOD))[(size_t)(l * 3 + j) * 6144 + (u % 96) * 64 + c] = a; }
  }
}

__device__ __forceinline__ void ph_topk_fast(const Params& p, int nseq, char* smem) {
  const int TIDX = ltid(); const int BIDX = lbid();
  unsigned* keys = (unsigned*)smem;
  unsigned* hist = keys + 8192;
  unsigned* ctl = hist + 256;
  unsigned* scn = ctl + 8;
  for (int prob = BIDX; prob < nseq * NE; prob += gridDim.x) {
    const int s = prob >> 4, e = prob & 15;
    const int tlen = s < 2 ? T : TC, cap = s < 2 ? CAPL : CAPC, r0 = s < 2 ? s * T : ML + (s - 2) * TC;
    const float* a = (const float*)(p.ws + OFF_AFFT) + (size_t)e * MR + r0;
    __syncthreads();
    for (int i = TIDX; i < tlen; i += NT) keys[i] = __float_as_uint(a[i]);
    if (TIDX == 0) { ctl[0] = 0u; ctl[1] = (unsigned)cap; }
    __syncthreads();
    for (int pass = 0; pass < 4; ++pass) {
      const int shift = 24 - 8 * pass;
      if (TIDX < 256) hist[TIDX] = 0u;
      __syncthreads();
      const unsigned prefix = ctl[0], want = ctl[1];
      const unsigned himask = pass == 0 ? 0u : (0xffffffffu << (shift + 8));
      { unsigned cur = 0u, cnt = 0u;
        for (int i = TIDX; i < tlen; i += NT) { const unsigned k = keys[i];
          if ((k & himask) == prefix) { const unsigned dgt = (k >> shift) & 255u; if (dgt == cur) ++cnt; else { if (cnt) atomicAdd(&hist[cur], cnt); cur = dgt; cnt = 1u; } } }
        if (cnt) atomicAdd(&hist[cur], cnt); }
      __syncthreads();
      if (TIDX < 256) {
        const unsigned mine = hist[TIDX];
        unsigned inc = mine;
#pragma unroll
        for (int o = 1; o < 64; o <<= 1) { const unsigned n = __shfl_down(inc, o); if ((TIDX & 63) + o < 64) inc += n; }
        if ((TIDX & 63) == 0) scn[TIDX >> 6] = inc;
        __builtin_amdgcn_s_waitcnt(0);
      }
      __syncthreads();
      if (TIDX < 256) {
        const unsigned mine = hist[TIDX];
        unsigned inc = mine;
#pragma unroll
        for (int o = 1; o < 64; o <<= 1) { const unsigned n = __shfl_down(inc, o); if ((TIDX & 63) + o < 64) inc += n; }
        unsigned above = inc - mine;
        for (int w = (TIDX >> 6) + 1; w < 4; ++w) above += scn[w];
        if (above < want && above + mine >= want) { ctl[2] = prefix | ((unsigned)TIDX << shift); ctl[3] = want - above; }
      }
      __syncthreads();
      if (TIDX == 0) { ctl[0] = ctl[2]; ctl[1] = ctl[3]; }
      __syncthreads();
    }
    const unsigned thr = ctl[0], weq = ctl[1];
    const int per = tlen / NT > 0 ? tlen / NT : 1, nthr = tlen / per, t0 = TIDX * per;
    unsigned cnt = 0u;
    if (TIDX < nthr) for (int i = 0; i < per; ++i) { const unsigned k = keys[t0 + i]; cnt += (k > thr ? 0x10000u : 0u) + (k == thr ? 1u : 0u); }
    unsigned inc = cnt;
#pragma unroll
    for (int o = 1; o < 64; o <<= 1) { const unsigned n = __shfl_up(inc, o); if ((TIDX & 63) >= o) inc += n; }
    if ((TIDX & 63) == 63) scn[TIDX >> 6] = inc;
    __syncthreads();
    unsigned base = 0u;
    for (int w = 0; w < (TIDX >> 6); ++w) base += scn[w];
    unsigned run = base + inc - cnt;
    int* idx = (int*)(p.ws + OFF_IDX); float* gate = (float*)(p.ws + OFF_GATE); int* slot = (int*)(p.ws + OFF_SLOT);
    const int pb = pair_base(s, e);
    if (TIDX < nthr) for (int i = 0; i < per; ++i) {
      const unsigned k = keys[t0 + i]; const unsigned ngt = run >> 16, neq = run & 0xffffu;
      const unsigned eqtaken = neq < weq ? neq : weq;
      int sl = -1;
      if (k > thr) sl = (int)(ngt + eqtaken);
      else if (k == thr && neq < weq) sl = (int)(ngt + neq);
      if (sl >= 0) { idx[pb + sl] = r0 + t0 + i; gate[pb + sl] = __uint_as_float(k); }
      slot[(size_t)(r0 + t0 + i) * 16 + e] = sl;
      run += (k > thr ? 0x10000u : 0u) + (k == thr ? 1u : 0u);
    }
  }
}
__device__ __forceinline__ void ph_combine_fast(const Params& p, int l, int nrows, int next_l) {
  const int TIDX = ltid(); const int BIDX = lbid();
  const int lane = TIDX & 63, wv = TIDX >> 6;
  const bf16_t* Y = (const bf16_t*)(p.ws + OFF_Y);
  for (int r4 = (BIDX + gridDim.x * wv) * 4; r4 < nrows; r4 += gridDim.x * 8 * 4) {
    int mj, t, tlen, r0; rowinfo(r4, mj, t, tlen, r0);
    const int s = r4 < ML ? (r4 >> 13) : 2 + ((r4 - ML) >> 8);
    const int slot4 = ((const int*)(p.ws + OFF_SLOT))[(size_t)r4 * 16 + lane];
    const unsigned long long vm = __ballot(slot4 >= 0);
    const int pairl = pair_base(s, lane & 15) + slot4;
    float4 xv[4][4]; uint4 ya[4][2][2]; int nsel[4];
    float* xr[4];
#pragma unroll
    for (int rr = 0; rr < 4; ++rr) { xr[rr] = xrow(p, r4 + rr);
#pragma unroll
      for (int hf = 0; hf < 2; ++hf) { const uint4 xb4 = ld_nt_u4((const bf16_t*)xr[rr] + hf * 512 + lane * 8);
        xv[rr][hf * 2 + 0] = make_float4(__uint_as_float(xb4.x << 16), __uint_as_float(xb4.x & 0xffff0000u), __uint_as_float(xb4.y << 16), __uint_as_float(xb4.y & 0xffff0000u));
        xv[rr][hf * 2 + 1] = make_float4(__uint_as_float(xb4.z << 16), __uint_as_float(xb4.z & 0xffff0000u), __uint_as_float(xb4.w << 16), __uint_as_float(xb4.w & 0xffff0000u)); } }
#pragma unroll
    for (int rr = 0; rr < 4; ++rr) {
      unsigned m16 = (unsigned)(vm >> (rr * 16)) & 0xffffu; nsel[rr] = __builtin_popcount(m16);
#pragma unroll
      for (int k = 0; k < 2; ++k) {
        if (m16) { const int e = __builtin_ctz(m16); m16 &= m16 - 1; const int pr = __builtin_amdgcn_readlane(pairl, rr * 16 + e);
          const bf16_t* yr = Y + (size_t)pr * D; ya[rr][k][0] = ld_nt_u4(yr + lane * 8); ya[rr][k][1] = ld_nt_u4(yr + 512 + lane * 8); }
        else { ya[rr][k][0] = make_uint4(0u, 0u, 0u, 0u); ya[rr][k][1] = make_uint4(0u, 0u, 0u, 0u); }
      }
    }
    const float* g2 = modvec(p, l, mj, 5);
    float4 gq[4];
#pragma unroll
    for (int hf = 0; hf < 2; ++hf)
#pragma unroll
      for (int q = 0; q < 2; ++q) gq[hf * 2 + q] = *(const float4*)(g2 + hf * 512 + lane * 8 + q * 4);
    asm volatile("s_waitcnt vmcnt(0)" ::: "memory");
#pragma unroll
    for (int rr = 0; rr < 4; ++rr) {
      float acc[16];
#pragma unroll
      for (int i = 0; i < 16; ++i) acc[i] = 0.f;
#pragma unroll
      for (int k = 0; k < 2; ++k)
#pragma unroll
        for (int hf = 0; hf < 2; ++hf) { const unsigned w[4] = {ya[rr][k][hf].x, ya[rr][k][hf].y, ya[rr][k][hf].z, ya[rr][k][hf].w};
#pragma unroll
          for (int i = 0; i < 4; ++i) { acc[hf * 8 + 2 * i] += __uint_as_float(w[i] << 16); acc[hf * 8 + 2 * i + 1] += __uint_as_float(w[i] & 0xffff0000u); } }
      if (nsel[rr] > 2) {
        unsigned m16 = (unsigned)(vm >> (rr * 16)) & 0xffffu; m16 &= m16 - 1; m16 &= m16 - 1;
        while (m16) { const int e = __builtin_ctz(m16); m16 &= m16 - 1; const int pr = __builtin_amdgcn_readlane(pairl, rr * 16 + e);
          const bf16_t* yr = Y + (size_t)pr * D; const uint4 a = *(const uint4*)(yr + lane * 8), bq = *(const uint4*)(yr + 512 + lane * 8);
          const unsigned w[8] = {a.x, a.y, a.z, a.w, bq.x, bq.y, bq.z, bq.w};
#pragma unroll
          for (int i = 0; i < 8; ++i) { acc[2 * i] += __uint_as_float(w[i] << 16); acc[2 * i + 1] += __uint_as_float(w[i] & 0xffff0000u); } }
      }
      float x[16], ss = 0.f;
#pragma unroll
      for (int hf = 0; hf < 2; ++hf)
#pragma unroll
        for (int q = 0; q < 2; ++q) { const int c = hf * 512 + lane * 8 + q * 4; float4 xq = xv[rr][hf * 2 + q]; const float4 gv = gq[hf * 2 + q];
          xq.x += gv.x * acc[hf * 8 + q * 4 + 0]; xq.y += gv.y * acc[hf * 8 + q * 4 + 1]; xq.z += gv.z * acc[hf * 8 + q * 4 + 2]; xq.w += gv.w * acc[hf * 8 + q * 4 + 3];
          if (next_l >= 0) { uint2 xb2; xb2.x = gd::pk(xq.x, xq.y); xb2.y = gd::pk(xq.z, xq.w); *(uint2*)((bf16_t*)xr[rr] + c) = xb2; }
          else st_nt_f4(xr[rr] + c, xq);
          x[hf * 8 + q * 4 + 0] = xq.x; x[hf * 8 + q * 4 + 1] = xq.y; x[hf * 8 + q * 4 + 2] = xq.z; x[hf * 8 + q * 4 + 3] = xq.w;
          ss += xq.x * xq.x + xq.y * xq.y + xq.z * xq.z + xq.w * xq.w; }
      if (next_l >= 0) {
        ss = wave_sum(ss);
        const float rstd = rsqrtf(ss / D + EPS);
        const float* g = p.norm1_g + next_l * D; const float* sh = modvec(p, next_l, mj, 0); const float* sc = modvec(p, next_l, mj, 1);
        bf16_t* h = (bf16_t*)(p.ws + OFF_H) + (size_t)(r4 + rr) * D;
#pragma unroll
        for (int hf = 0; hf < 2; ++hf) { const int c = hf * 512 + lane * 8; float y[8];
#pragma unroll
          for (int i = 0; i < 8; ++i) y[i] = x[hf * 8 + i] * rstd * g[c + i] * (1.f + sc[c + i]) + sh[c + i];
          uint4 w; w.x = gd::pk(y[0], y[1]); w.y = gd::pk(y[2], y[3]); w.z = gd::pk(y[4], y[5]); w.w = gd::pk(y[6], y[7]);
          *(uint4*)(h + c) = w; }
      }
    }
  }
}
template <class RowPtr>
__device__ __forceinline__ gd::f32x4 coop_tile_32x64(RowPtr arow, const bf16_t* Bt, int ldb, int K, float* lds, int wv, int lane) {
  using gd::bf16x8; using gd::f32x4;
  const int cc = lane & 15, g = lane >> 4;
  const bf16_t* a0 = arow(cc) + g * 8; const bf16_t* a1 = arow(16 + cc) + g * 8;
  f32x4 acc[2][4];
#pragma unroll
  for (int m = 0; m < 2; ++m)
#pragma unroll
    for (int n = 0; n < 4; ++n) acc[m][n] = (f32x4){0.f, 0.f, 0.f, 0.f};
  for (int ks = wv; ks < K / 32; ks += 8) {
    const bf16x8 A0 = *(const bf16x8*)(a0 + ks * 32), A1 = *(const bf16x8*)(a1 + ks * 32);
#pragma unroll
    for (int n = 0; n < 4; ++n) { const bf16x8 B = *(const bf16x8*)(Bt + (size_t)(n * 16 + cc) * ldb + ks * 32 + g * 8);
      acc[0][n] = __builtin_amdgcn_mfma_f32_16x16x32_bf16(A0, B, acc[0][n], 0, 0, 0); acc[1][n] = __builtin_amdgcn_mfma_f32_16x16x32_bf16(A1, B, acc[1][n], 0, 0, 0); }
  }
  gd::lds_barrier();
#pragma unroll
  for (int m = 0; m < 2; ++m)
#pragma unroll
    for (int n = 0; n < 4; ++n) *(f32x4*)(lds + ((wv * 8 + m * 4 + n) * 64 + lane) * 4) = acc[m][n];
  gd::lds_barrier();
  f32x4 r = {0.f, 0.f, 0.f, 0.f};
#pragma unroll
  for (int w = 0; w < 8; ++w) r += *(const f32x4*)(lds + ((w * 8 + wv) * 64 + lane) * 4);
  return r;
}
__device__ __forceinline__ void ph_ctx_moe_gu(const Params& p, float* lds) {
  const int TIDX = ltid(); const int BIDX = lbid();
  const int lane = TIDX & 63, wv = TIDX >> 6, cc = lane & 15, g = lane >> 4;
  const bf16_t* H = (const bf16_t*)(p.ws + OFF_H); const bf16_t* GU = (const bf16_t*)(p.ws + OFF_MOEGU); bf16_t* hid = (bf16_t*)(p.ws + OFF_HID);
  const int* idx = (const int*)(p.ws + OFF_IDX);
  for (int it = BIDX; it < 32 * 16; it += gridDim.x) {
    const int grp = 32 + (it >> 4), ns = it & 15, s = grp >> 4, e = grp & 15, pb = pair_base(s, e);
    const gd::f32x4 v4 = coop_tile_32x64([&](int r) { return H + (size_t)idx[pb + r] * D; }, GU + (size_t)e * D * D + (size_t)(ns * 64) * D, D, D, lds, wv, lane);
    const int m = wv >> 2, n = wv & 3;
#pragma unroll
    for (int r = 0; r < 4; ++r) { const float v = v4[r], o = __shfl_xor(v, 1);
      if ((cc & 1) == 0) hid[(size_t)(pb + m * 16 + g * 4 + r) * DEXP + ((ns * 64 + n * 16 + cc) >> 1)] = f2bf(silu_f(v) * o); }
  }
}
__device__ __forceinline__ void ph_ctx_moe_down(const Params& p, float* lds) {
  const int TIDX = ltid(); const int BIDX = lbid();
  const int lane = TIDX & 63, wv = TIDX >> 6, cc = lane & 15, g = lane >> 4;
  const bf16_t* hid = (const bf16_t*)(p.ws + OFF_HID); const bf16_t* DN = (const bf16_t*)(p.ws + OFF_MOED); bf16_t* Y = (bf16_t*)(p.ws + OFF_Y);
  const float* gate = (const float*)(p.ws + OFF_GATE);
  for (int it = BIDX; it < 32 * 16; it += gridDim.x) {
    const int grp = 32 + (it >> 4), ns = it & 15, s = grp >> 4, e = grp & 15, pb = pair_base(s, e);
    const gd::f32x4 v4 = coop_tile_32x64([&](int r) { return hid + (size_t)(pb + r) * DEXP; }, DN + (size_t)e * D * DEXP + (size_t)(ns * 64) * DEXP, DEXP, DEXP, lds, wv, lane);
    const int m = wv >> 2, n = wv & 3;
#pragma unroll
    for (int r = 0; r < 4; ++r) { const int row = pb + m * 16 + g * 4 + r; Y[(size_t)row * D + ns * 64 + n * 16 + cc] = f2bf(v4[r] * gate[row]); }
  }
}
__device__ __forceinline__ void ph_ctx_outproj(const Params& p, int l, float* lds) {
  const int TIDX = ltid(); const int BIDX = lbid();
  const int lane = TIDX & 63, wv = TIDX >> 6, cc = lane & 15, g = lane >> 4;
  const bf16_t* A = (const bf16_t*)(p.ws + OFF_H) + (size_t)ML * D; const bf16_t* W = (const bf16_t*)(p.ws + OFF_WOUTT) + (size_t)l * D * D;
  bf16_t* yo = (bf16_t*)(p.ws + OFF_YO) + (size_t)ML * D;
  for (int it = BIDX; it < 16 * 16; it += gridDim.x) {
    const int mt = it >> 4, ns = it & 15;
    const gd::f32x4 v4 = coop_tile_32x64([&](int r) { return A + (size_t)(mt * 32 + r) * D; }, W + (size_t)(ns * 64) * D, D, D, lds, wv, lane);
    const int m = wv >> 2, n = wv & 3;
#pragma unroll
    for (int r = 0; r < 4; ++r) yo[(size_t)(mt * 32 + m * 16 + g * 4 + r) * D + ns * 64 + n * 16 + cc] = f2bf(v4[r]);
  }
}
__device__ __forceinline__ void ph_modulate2_fast(const Params& p, int l, int nrows, float* lds) {
  const int TIDX = ltid(); const int BIDX = lbid();
  const int lane = TIDX & 63, wv = TIDX >> 6;
  __syncthreads();
  { const float* wr = p.router + (size_t)l * D * NE;
    for (int i = TIDX; i < D * 4; i += NT) { const int c = i >> 2, q = i & 3, pr = (c & ~255) + (c & 3) * 64 + ((c >> 2) & 63);
      *(float4*)(lds + pr * 20 + q * 4) = *(const float4*)(wr + c * 16 + q * 4); } }
  __syncthreads();
  const float* g = p.norm2_g + l * D;
  for (int r4 = (BIDX + gridDim.x * wv) * 4; r4 < nrows; r4 += gridDim.x * 8 * 4) {
    int mj, t, tlen, r0; rowinfo(r4, mj, t, tlen, r0);
    const float* sh = modvec(p, l, mj, 3); const float* sc = modvec(p, l, mj, 4);
    float4 xv[4][4], gv[4], sv[4], hv[4];
#pragma unroll
    for (int rr = 0; rr < 4; ++rr) xv[rr][0] = xv[rr][1] = xv[rr][2] = xv[rr][3] = make_float4(0.f, 0.f, 0.f, 0.f);
    if (l == 0) {
#pragma unroll
      for (int rr = 0; rr < 4; ++rr) { const float* xr = xrow_src(p, r4 + rr, 0);
#pragma unroll
        for (int i = 0; i < 4; ++i) xv[rr][i] = ld_nt_f4(xr + i * 256 + lane * 4); }
    } else {
#pragma unroll
      for (int rr = 0; rr < 4; ++rr) { const bf16_t* xr = (const bf16_t*)xrow_src(p, r4 + rr, 1);
#pragma unroll
        for (int i = 0; i < 4; ++i) { const uint2 v = ld_nt_u2(xr + i * 256 + lane * 4);
          xv[rr][i] = make_float4(__uint_as_float(v.x << 16), __uint_as_float(v.x & 0xffff0000u), __uint_as_float(v.y << 16), __uint_as_float(v.y & 0xffff0000u)); } }
    }
    {
      const float* g1 = modvec(p, l, mj, 2); const bf16_t* yo = (const bf16_t*)(p.ws + OFF_YO);
#pragma unroll
      for (int i = 0; i < 4; ++i) { const int c = i * 256 + lane * 4; const float4 gg = *(const float4*)(g1 + c);
#pragma unroll
        for (int rr = 0; rr < 4; ++rr) { const uint2 yv = ld_nt_u2(yo + (size_t)(r4 + rr) * D + c);
          xv[rr][i].x += gg.x * __uint_as_float(yv.x << 16); xv[rr][i].y += gg.y * __uint_as_float(yv.x & 0xffff0000u);
          xv[rr][i].z += gg.z * __uint_as_float(yv.y << 16); xv[rr][i].w += gg.w * __uint_as_float(yv.y & 0xffff0000u);
          uint2 xb2; xb2.x = gd::pk(xv[rr][i].x, xv[rr][i].y); xb2.y = gd::pk(xv[rr][i].z, xv[rr][i].w);
          *(uint2*)((bf16_t*)xrow(p, r4 + rr) + c) = xb2; } }
    }
#pragma unroll
    for (int i = 0; i < 4; ++i) { const int c = i * 256 + lane * 4; gv[i] = *(const float4*)(g + c); sv[i] = *(const float4*)(sc + c); hv[i] = *(const float4*)(sh + c); }
#pragma unroll
    for (int rr = 0; rr < 4; ++rr) {
      const int r = r4 + rr;
      float ss = 0.f;
#pragma unroll
      for (int i = 0; i < 4; ++i) ss += xv[rr][i].x * xv[rr][i].x + xv[rr][i].y * xv[rr][i].y + xv[rr][i].z * xv[rr][i].z + xv[rr][i].w * xv[rr][i].w;
      ss = wave_sum(ss);
      const float rstd = rsqrtf(ss / D + EPS);
      bf16_t* h = (bf16_t*)(p.ws + OFF_H) + (size_t)r * D;
      float lo[16];
#pragma unroll
      for (int e = 0; e < 16; ++e) lo[e] = 0.f;
#pragma unroll
      for (int i = 0; i < 4; ++i) {
        const int c = i * 256 + lane * 4;
        float y[4];
        y[0] = xv[rr][i].x * rstd * gv[i].x * (1.f + sv[i].x) + hv[i].x; y[1] = xv[rr][i].y * rstd * gv[i].y * (1.f + sv[i].y) + hv[i].y;
        y[2] = xv[rr][i].z * rstd * gv[i].z * (1.f + sv[i].z) + hv[i].z; y[3] = xv[rr][i].w * rstd * gv[i].w * (1.f + sv[i].w) + hv[i].w;
        uint2 w; w.x = gd::pk(y[0], y[1]); w.y = gd::pk(y[2], y[3]);
        *(uint2*)(h + c) = w;
#pragma unroll
        for (int q = 0; q < 4; ++q) {
          const float* wrow = lds + (i * 256 + q * 64 + lane) * 20;
#pragma unroll
          for (int e4 = 0; e4 < 4; ++e4) { const float4 w4 = *(const float4*)(wrow + e4 * 4);
            lo[e4 * 4 + 0] += y[q] * w4.x; lo[e4 * 4 + 1] += y[q] * w4.y; lo[e4 * 4 + 2] += y[q] * w4.z; lo[e4 * 4 + 3] += y[q] * w4.w; }
        }
      }
#pragma unroll
      for (int k = 0; k < 4; ++k) {
        const int half = 8 >> k, mask = 32 >> k; const bool upper = (lane & mask) != 0;
#pragma unroll
        for (int i = 0; i < half; ++i) { const float send = upper ? lo[i] : lo[i + half]; const float recv = __shfl_xor(send, mask); lo[i] = (upper ? lo[i + half] : lo[i]) + recv; }
      }
      float v = lo[0]; v += __shfl_xor(v, 1); v += __shfl_xor(v, 2);
      float mx = v;
      mx = fmaxf(mx, __shfl_xor(mx, 4)); mx = fmaxf(mx, __shfl_xor(mx, 8)); mx = fmaxf(mx, __shfl_xor(mx, 16)); mx = fmaxf(mx, __shfl_xor(mx, 32));
      const float ex = expf(v - mx);
      float sm = ex; sm += __shfl_xor(sm, 4); sm += __shfl_xor(sm, 8); sm += __shfl_xor(sm, 16); sm += __shfl_xor(sm, 32);
      if ((lane & 3) == 0) { const int e = ((lane >> 5) & 1) * 8 + ((lane >> 4) & 1) * 4 + ((lane >> 3) & 1) * 2 + ((lane >> 2) & 1);
        ((float*)(p.ws + OFF_AFFT))[(size_t)e * MR + r] = ex / sm; }
    }
  }
}

__device__ __forceinline__ void ph_modulate1_fast(const Params& p) {
  const int TIDX = ltid(); const int BIDX = lbid();
  const int lane = TIDX & 63, wv = TIDX >> 6;
  const float* g = p.norm1_g;
  for (int r2 = (BIDX + gridDim.x * wv) * 2; r2 < MR; r2 += gridDim.x * 8 * 2) {
    int mj, t, tlen, r0; rowinfo(r2, mj, t, tlen, r0);
    const float* sh = modvec(p, 0, mj, 0); const float* sc = modvec(p, 0, mj, 1);
    float4 xv[2][4];
#pragma unroll
    for (int rr = 0; rr < 2; ++rr) { const float* xr = xrow_src(p, r2 + rr, 0);
#pragma unroll
      for (int i = 0; i < 4; ++i) xv[rr][i] = ld_nt_f4(xr + i * 256 + lane * 4); }
    float4 gv[4], sv[4], hv[4];
#pragma unroll
    for (int i = 0; i < 4; ++i) { const int c = i * 256 + lane * 4; gv[i] = *(const float4*)(g + c); sv[i] = *(const float4*)(sc + c); hv[i] = *(const float4*)(sh + c); }
#pragma unroll
    for (int rr = 0; rr < 2; ++rr) {
      float ss = 0.f;
#pragma unroll
      for (int i = 0; i < 4; ++i) ss += xv[rr][i].x * xv[rr][i].x + xv[rr][i].y * xv[rr][i].y + xv[rr][i].z * xv[rr][i].z + xv[rr][i].w * xv[rr][i].w;
      ss = wave_sum(ss);
      const float rstd = rsqrtf(ss / D + EPS);
      bf16_t* h = (bf16_t*)(p.ws + OFF_H) + (size_t)(r2 + rr) * D;
#pragma unroll
      for (int i = 0; i < 4; ++i) { const int c = i * 256 + lane * 4;
        uint2 w; w.x = gd::pk(xv[rr][i].x * rstd * gv[i].x * (1.f + sv[i].x) + hv[i].x, xv[rr][i].y * rstd * gv[i].y * (1.f + sv[i].y) + hv[i].y);
        w.y = gd::pk(xv[rr][i].z * rstd * gv[i].z * (1.f + sv[i].z) + hv[i].z, xv[rr][i].w * rstd * gv[i].w * (1.f + sv[i].w) + hv[i].w);
        *(uint2*)(h + c) = w; }
    }
  }
}

constexpr size_t LDS_BYTES = 163840;
__global__ void __launch_bounds__(NT, 2) mega(Params p) {
  extern __shared__ __attribute__((aligned(16))) char smem[];
  float* lds = (float*)smem;
  volatile LAS unsigned* xbst = (volatile LAS unsigned*)(smem + LDS_BYTES - 16);
  if (threadIdx.x == 0) { xbst[0] = 0u; xbst[1] = 0u; xbst[2] = 0u; xbst[3] = 0u; }
  __syncthreads();
  XcdBarrier xb = xcd_barrier_post((unsigned*)(p.ws + OFF_BAR), xbst);
  cg::grid_group grid = cg::this_grid();

  if (p.ws == nullptr) grid.sync();
  for (int l = 0; l < 2; ++l) {
    const bool need_ctx = l == 0;
    const int nrows = need_ctx ? MR : ML, nseq = need_ctx ? 4 : 2;
    if (l == 0) { ph_ada_fast(p, lds); ph_prep_weights(p, lds); xcd_barrier(xb); ph_modulate1_fast(p); xcd_barrier(xb); }
    for (int _r = 0; _r < REP_INPROJ; ++_r) ph_inproj_fast(p, l, smem);
    xcd_barrier(xb);
    for (int _r = 0; _r < REP_PRE; ++_r) ph_gdn_precompute(p, l, smem);
    ph_mla_gemm(p, l, smem);
    xcd_barrier(xb);
    for (int _r = 0; _r < REP_MLA; ++_r) ph_mla_finish(p, l);
    xcd_barrier(xb);
    for (int _r = 0; _r < REP_SCAN; ++_r) ph_scan_fast(p, smem);
    for (int _r = 0; _r < REP_ATTN; ++_r) ph_attn_fast(p, need_ctx, smem);
    ph_pool_mfma(p, l, nrows, smem);
    xcd_barrier(xb);
    ph_gdnfin_pool_fast<2>(p, l, nrows, lds, 0, (int)gridDim.x);
    xcd_barrier(xb);
    ph_outproj_fast(p, l, smem);
    if (need_ctx) ph_ctx_outproj(p, l, lds);
    xcd_barrier(xb);
    for (int _r = 0; _r < REP_MOD; ++_r) ph_modulate2_fast(p, l, nrows, lds);
    xcd_barrier(xb);
    for (int _r = 0; _r < REP_TOPK; ++_r) ph_topk_fast(p, nseq, smem);
    ph_prep_moe_weights(p, l, lds, 0, (int)gridDim.x);
    xcd_barrier(xb);
    for (int _r = 0; _r < REP_MOEGU; ++_r) ph_moe_gu_fast(p, smem);
    if (need_ctx) ph_ctx_moe_gu(p, lds);
    xcd_barrier(xb);
    ph_moe_down_fast(p, smem);
    if (need_ctx) ph_ctx_moe_down(p, lds);
    xcd_barrier(xb);
    ph_combine_fast(p, l, nrows, l == 0 ? 1 : -1);
    if (l == 0) xcd_barrier(xb);
  }
}

extern "C" void kernel_launch(void* const* d_in, const int* in_sizes, int n_in, void* d_out, int out_size, void* d_ws, size_t ws_size, hipStream_t stream) {
  static int grid_blocks = 0;
  if (ws_size < OFF_END) { fprintf(stderr, "kernel_launch: workspace too small: %zu < %zu\n", ws_size, (size_t)OFF_END); return; }
  if (!grid_blocks) {
    if (hipFuncSetAttribute((const void*)mega, hipFuncAttributeMaxDynamicSharedMemorySize, (int)LDS_BYTES) != hipSuccess) { fprintf(stderr, "kernel_launch: hipFuncSetAttribute failed\n"); return; }
    int dev = 0, cus = 0, per_cu = 0;
    hipGetDevice(&dev);
    hipDeviceGetAttribute(&cus, hipDeviceAttributeMultiprocessorCount, dev);
    hipOccupancyMaxActiveBlocksPerMultiprocessor(&per_cu, mega, NT, LDS_BYTES);
    if (per_cu < 1) { fprintf(stderr, "kernel_launch: occupancy query returned %d\n", per_cu); return; }
    grid_blocks = cus;
  }
  Params p{};
  const float** f = (const float**)&p;
  for (int i = 0; i < 26; ++i) f[i] = (const float*)d_in[i];
  p.out = (float*)d_out; p.ws = (char*)d_ws;
  hipMemsetAsync((char*)d_ws + OFF_BAR, 0, 16384, stream);
  void* args[] = {&p};
  hipError_t e = hipLaunchCooperativeKernel((const void*)mega, dim3(grid_blocks), dim3(NT), args, LDS_BYTES, stream);
  if (e != hipSuccess) fprintf(stderr, "cooperative launch failed: %s (grid %d)\n", hipGetErrorString(e), grid_blocks);
}
```

```cpp
#include <hip/hip_runtime.h>
#include <hip/hip_bf16.h>
#include <hip/hip_cooperative_groups.h>
#include <cstdint>
#include <cstdio>
namespace cg = cooperative_groups;
#define REP_SCAN 1
#define REP_ATTN 1
#define REP_PRE 1
#define REP_MLA 1
#define REP_PMW 1
#define REP_TOPK 1
#define REP_GATHER 1
#define REP_INPROJ 1
#define REP_MOEGU 1
#define REP_MOD 1
#define REP_FIN 1
#define REP_INIT 1

constexpr int D = 1024, NB = 2, T = 8192, TC = 256;
constexpr int ML = NB * T;
constexpr int MC = NB * TC;
constexpr int MR = ML + MC;
constexpr int NIN = 2672, NINP = 2816;
constexpr int NE = 16, DEXP = 512, CAPL = 1024, CAPC = 32;
constexpr int NPAIR = NB * NE * CAPL + NB * NE * CAPC;
constexpr int TK = TC + T;
constexpr float EPS = 1e-6f;
constexpr int NT = 512;
constexpr int PC_Q = 0, PC_KV = 192, PC_KR = 320, PC_GQ = 352, PC_GK = 864, PC_GV = 1376, PC_Z = 1888, PC_A = 2400, PC_B = 2408, PC_POOL = 2416;
constexpr int PC_OF = 352, PC_OB = 864;

typedef unsigned short bf16_t;
__device__ __forceinline__ float bf2f(bf16_t b) { return __uint_as_float(((unsigned)b) << 16); }
__device__ __forceinline__ bf16_t f2bf(float f) { unsigned u = __float_as_uint(f); u += 0x7FFFu + ((u >> 16) & 1u); return (bf16_t)(u >> 16); }
__device__ __forceinline__ float silu_f(float x) { return x * __builtin_amdgcn_rcpf(1.0f + __expf(-x)); }
__device__ __forceinline__ float sigmoid_f(float x) { return 1.0f / (1.0f + expf(-x)); }
__device__ __forceinline__ float softplus_f(float x) {
  if (x > 20.f) return x;
  const float y = __expf(x);
  return y < 0.0625f ? y * (1.f - y * (0.5f - y * (0.333333343f - 0.25f * y))) : __logf(1.f + y);
}

typedef float f4v_t __attribute__((ext_vector_type(4))); typedef unsigned u2v_t __attribute__((ext_vector_type(2))); typedef unsigned u4v_t __attribute__((ext_vector_type(4)));
__device__ __forceinline__ float4 ld_nt_f4(const float* q) { const f4v_t v = __builtin_nontemporal_load((const f4v_t*)q); return make_float4(v[0], v[1], v[2], v[3]); }
__device__ __forceinline__ uint2 ld_nt_u2(const void* q) { const u2v_t v = __builtin_nontemporal_load((const u2v_t*)q); return make_uint2(v[0], v[1]); }
__device__ __forceinline__ uint4 ld_nt_u4(const void* q) { const u4v_t v = __builtin_nontemporal_load((const u4v_t*)q); return make_uint4(v[0], v[1], v[2], v[3]); }
__device__ __forceinline__ void st_nt_f4(float* q, const float4 v) { const f4v_t w = {v.x, v.y, v.z, v.w}; __builtin_nontemporal_store(w, (f4v_t*)q); }
constexpr size_t al256(size_t x) { return (x + 255) / 256 * 256; }
constexpr size_t OFF_BAR = 0;
constexpr size_t OFF_MOD = 16384;
constexpr size_t OFF_XC = al256(OFF_MOD + 2 * 3 * 6144 * 4);
constexpr size_t OFF_AFFT = al256(OFF_XC + (size_t)MC * D * 4);
constexpr size_t OFF_IDX = al256(OFF_AFFT + (size_t)NE * MR * 4);
constexpr size_t OFF_GATE = al256(OFF_IDX + (size_t)NPAIR * 4);
constexpr size_t OFF_SLOT = al256(OFF_GATE + (size_t)NPAIR * 4);
constexpr size_t OFF_GB = al256(OFF_SLOT + (size_t)MR * 16 * 4);
constexpr size_t OFF_H = al256(OFF_GB + (size_t)MR * 16 * 4);
constexpr size_t OFF_P = al256(OFF_H + (size_t)MR * D * 2);
constexpr size_t OFF_RB = al256(OFF_P + (size_t)MR * NINP * 2);
constexpr size_t RB_BYTES = (size_t)1056 * 100352;
constexpr size_t OFF_QKV = al256(OFF_RB + RB_BYTES);
constexpr size_t QK_ELEMS = (size_t)NB * 4 * TK * 128, V_ELEMS = (size_t)NB * 4 * TK * 64;
constexpr size_t OFF_WINT = al256(OFF_QKV + (2 * QK_ELEMS + V_ELEMS) * 2);
constexpr size_t OFF_WOUTT = al256(OFF_WINT + (size_t)2 * NINP * D * 2);
constexpr size_t OFF_WUP = al256(OFF_WOUTT + (size_t)2 * D * D * 2);
constexpr size_t OFF_MOEGU = al256(OFF_WUP + (size_t)2 * 1024 * 256 * 2);
constexpr size_t OFF_MOED = OFF_MOEGU + (size_t)NE * D * D * 2;
constexpr size_t OFF_END = al256(OFF_MOED + (size_t)NE * D * DEXP * 2);
constexpr size_t OFF_UPRAW = OFF_MOEGU;
constexpr size_t OFF_OPART = OFF_MOEGU;
constexpr size_t OFF_MLPART = OFF_OPART + (size_t)4 * ML * 256 * 2;
static_assert(OFF_MLPART + (size_t)4 * ML * 4 * 2 * 4 <= OFF_END, "partials must fit in the MoE weight region");
constexpr size_t OFF_HID = OFF_RB + (size_t)64 * 1024 * 1024;
constexpr size_t OFF_Y = OFF_P;
constexpr size_t OFF_YO = OFF_P;
constexpr size_t OFF_XS = OFF_P;


struct Params {
  const float* x; const float* c; const float* ctx; const float* c_ctx; const float* ada_w; const float* ada_b;
  const float* norm1_g; const float* norm2_g; const float* w_in; const float* q_a_norm; const float* w_uq; const float* kv_a_norm;
  const float* w_ukv; const float* q_norm; const float* k_norm; const float* conv_w; const float* a_log; const float* dt_bias;
  const float* gdn_norm_g; const float* pool_w; const float* pool_scale; const float* w_out; const float* router;
  const float* w_gate; const float* w_up; const float* w_down;
  float* out; char* ws;
};

__device__ __forceinline__ const float* xrow_src(const Params& p, int r, int l) { return l == 0 ? (r < ML ? p.x + (size_t)r * D : p.ctx + (size_t)(r - ML) * D) : (r < ML ? p.out + (size_t)r * D : (const float*)(p.ws + OFF_XC) + (size_t)(r - ML) * D); }
__device__ __forceinline__ float* xrow(const Params& p, int r) { return r < ML ? p.out + (size_t)r * D : (float*)(p.ws + OFF_XC) + (size_t)(r - ML) * D; }
__device__ __forceinline__ void rowinfo(int r, int& mj, int& t, int& tlen, int& r0) {
  if (r < ML) { mj = r >> 13; t = r & (T - 1); tlen = T; r0 = r - t; } else { int rc = r - ML; mj = 2; t = rc & (TC - 1); tlen = TC; r0 = r - t; }
}
__device__ __forceinline__ const float* modvec(const Params& p, int l, int mj, int chunk) { return (const float*)(p.ws + OFF_MOD) + ((size_t)(l * 3 + mj) * 6 + chunk) * D; }
__device__ __forceinline__ int pair_base(int s, int e) { return s < 2 ? (s * NE + e) * CAPL : NB * NE * CAPL + ((s - 2) * NE + e) * CAPC; }
__device__ __forceinline__ float wave_sum(float v) { for (int o = 32; o > 0; o >>= 1) v += __shfl_xor(v, o); return v; }

__device__ __forceinline__ int ltid() { int t = threadIdx.x; asm volatile("" : "+v"(t)); return t; }
__device__ __forceinline__ int lbid() { int t = blockIdx.x; asm volatile("" : "+s"(t)); return t; }
#define XB_TMO      128
#define XB_XCNT(j)  (256  + 64 * (j))
#define XB_XSUB(j)  (1280 + 64 * (j))
#define XB_XGEN(j)  (2304 + 64 * (j))
#define XB_TOP      3328
#define XB_TOPGEN   3392
#define XCD_BAR_WORDS 3456
#define XB_SPIN_CAP (1u << 22)
#define LAS __attribute__((address_space(3)))
__device__ __forceinline__ unsigned xb_ld(unsigned* p)              { return __hip_atomic_load(p, __ATOMIC_RELAXED, __HIP_MEMORY_SCOPE_AGENT); }
__device__ __forceinline__ unsigned xb_add(unsigned* p, unsigned v) { return __hip_atomic_fetch_add(p, v, __ATOMIC_RELAXED, __HIP_MEMORY_SCOPE_AGENT); }
__device__ __forceinline__ unsigned xb_xcc_id() { return (unsigned)__builtin_amdgcn_s_getreg((3 << 11) | 20) & 0xFu; }
#define XB_SPIN(cond, bar) do { unsigned _sp = 0; while (cond) { __builtin_amdgcn_s_sleep(1); \
    if ((++_sp & 255u) == 0u) { if (xb_ld(&(bar)[XB_TMO])) break; if (_sp > XB_SPIN_CAP) { atomicAdd(&(bar)[XB_TMO], 1u); break; } } } } while (0)
struct XcdBarrier { unsigned* bar; unsigned x; volatile LAS unsigned* st; };
__device__ __forceinline__ XcdBarrier xcd_barrier_post(unsigned* bar, volatile LAS unsigned* st) {
  XcdBarrier b; b.bar = bar; b.x = xb_xcc_id(); b.st = st;
  if (threadIdx.x == 0) (void)xb_add(&bar[XB_XCNT(b.x)], 1u);
  return b;
}
__device__ __forceinline__ void xcd_barrier_complete(unsigned* bar, unsigned x, unsigned& nloc, unsigned& nx) {
  const unsigned G = gridDim.x * gridDim.y * gridDim.z;
  unsigned sum, cnt, mine, sp = 0u;
  for (;;) {
    sum = 0u; cnt = 0u; mine = 0u;
#pragma unroll
    for (unsigned j = 0; j < 16; ++j) { const unsigned c = xb_ld(&bar[XB_XCNT(j)]); sum += c; cnt += (c > 0u) ? 1u : 0u; mine = (j == x) ? c : mine; }
    if (sum == G) break;
    __builtin_amdgcn_s_sleep(1);
    if ((++sp & 255u) == 0u) { if (xb_ld(&bar[XB_TMO])) break; if (sp > XB_SPIN_CAP) { atomicAdd(&bar[XB_TMO], 1u); break; } }
  }
  nloc = mine > 0u ? mine : 1u; nx = cnt > 0u ? cnt : 1u;
}
__device__ __forceinline__ void xcd_barrier(const XcdBarrier& b) {
  asm volatile("s_waitcnt vmcnt(0)" ::: "memory");
  __syncthreads();
  if (threadIdx.x == 0) {
    unsigned* bar = b.bar;
    __builtin_amdgcn_s_waitcnt(0);
    unsigned nloc = b.st[0], nx = b.st[1];
    if (nloc == 0u) { xcd_barrier_complete(bar, b.x, nloc, nx); b.st[0] = nloc; b.st[1] = nx; }
    const unsigned old = xb_add(&bar[XB_XSUB(b.x)], 1u);
    const unsigned gen = old / nloc;
    if (old + 1u == (gen + 1u) * nloc) {
      __builtin_amdgcn_fence(__ATOMIC_RELEASE, "agent");
      asm volatile("s_waitcnt vmcnt(0)" ::: "memory");
      const unsigned og = xb_add(&bar[XB_TOP], 1u);
      const unsigned tg = og / nx;
      if (og + 1u == (tg + 1u) * nx) xb_add(&bar[XB_TOPGEN], 1u);
      else XB_SPIN(xb_ld(&bar[XB_TOPGEN]) == tg, bar);
      __builtin_amdgcn_fence(__ATOMIC_ACQUIRE, "agent");
      xb_add(&bar[XB_XGEN(b.x)], 1u);
      asm volatile("s_waitcnt vmcnt(0)" ::: "memory");
    } else {
      XB_SPIN(xb_ld(&bar[XB_XGEN(b.x)]) == gen, bar);
      __builtin_amdgcn_fence(__ATOMIC_ACQUIRE, "agent");
      asm volatile("s_waitcnt vmcnt(0)" ::: "memory");
    }
  }
  __syncthreads();
}


namespace pg8 {
#define PG8_LAS __attribute__((address_space(3)))
typedef short bf16x8 __attribute__((ext_vector_type(8)));
typedef float f32x4 __attribute__((ext_vector_type(4)));
typedef unsigned u32x4 __attribute__((ext_vector_type(4)));
constexpr int BM = 256, BK = 64, HALF = 128, HTB = HALF * BK * 2, STAGE_BYTES = 8 * HTB, NXCD = 8, WGM = 8;
__host__ __device__ __forceinline__ int lds_byte(int r, int c) { const int st = (r >> 4) * 2 + (c >> 5), rr = r & 15, cc = c & 31, ob = rr * 64 + cc * 2; return st * 1024 + (ob ^ (((ob >> 9) & 1) << 5)); }
__host__ __device__ __forceinline__ void stage_rc(int b, int& R, int& C) { const int st = b / 1024, sb = b % 1024, swz = sb ^ (((sb >> 9) & 1) << 5); R = (st >> 1) * 16 + swz / 64; C = (st & 1) * 32 + (swz % 64) / 2; }
__host__ __device__ __forceinline__ int perm32(int rho) { const int n = rho >> 4, i = rho & 15; return 8 * (i >> 2) + 4 * n + (i & 3); }
struct Unit { int pm, pn; };
__device__ __forceinline__ unsigned cvt_pk_bf16(float lo, float hi) { unsigned r; asm volatile("v_cvt_pk_bf16_f32 %0, %1, %2" : "=v"(r) : "v"(lo), "v"(hi)); return r; }
struct GridOrder {
  int nM, nN, nwg, G, c;
  __device__ __forceinline__ void init(int nM_, int nN_, int G_, int c_) { nM = nM_; nN = nN_; nwg = nM * nN; G = G_; c = c_; }
  __device__ __forceinline__ bool next(int i, Unit& u) const {
    const long L = (long)i * G + c; if (L >= nwg) return false;
    int wgid = (int)L; { const int q = nwg / NXCD, r = nwg % NXCD, xcd = wgid % NXCD, off = wgid / NXCD; wgid = (xcd < r ? xcd * (q + 1) : r * (q + 1) + (xcd - r) * q) + off; }
    const int nig = WGM * nN, gid = wgid / nig, fm = gid * WGM, gsz = (nM - fm) < WGM ? (nM - fm) : WGM;
    u.pm = fm + ((wgid % nig) % gsz); u.pn = (wgid % nig) / gsz; return true;
  }
};
template <class Epi, class Sched, bool GATHER = false>
__device__ __forceinline__ void gemm_phase(PG8_LAS unsigned char* lds, const Sched& S, const Epi& E) {
  const int tid = ltid(), wid = __builtin_amdgcn_readfirstlane(tid >> 6), lane = tid & 63, wr = wid >> 2, wc = wid & 3, fr = lane & 15, fq = lane >> 4;
  const int K = S.K, nt = K / BK;
  unsigned voffA[2], voffB[2]; int RA[2], CA[2];
#pragma unroll
  for (int i = 0; i < 2; ++i) { int R, C; stage_rc(tid * 16 + i * 8192, R, C); const int Rb = Epi::PERM ? ((R & ~31) + perm32(R & 31)) : R;
    voffA[i] = (unsigned)(R * S.lda + C) * 2u; voffB[i] = (unsigned)(Rb * S.ldb + C) * 2u; RA[i] = R; CA[i] = C; }
  const size_t kstep = (size_t)(BK * 2);
  const size_t hstepA = GATHER ? 0 : (size_t)HALF * S.lda * 2, hstepB = (size_t)HALF * S.ldb * 2;
  unsigned vc[2][2], vn[2][2];
#define PG8_GOFF(dst, unit) do { if (GATHER) { _Pragma("unroll") for (int _h = 0; _h < 2; ++_h) _Pragma("unroll") for (int _i = 0; _i < 2; ++_i) \
    dst[_h][_i] = (unsigned)(S.gidx[(unit).pm * 256 + _h * HALF + RA[_i]] * S.lda + CA[_i]) * 2u; } } while (0)
#define PG8_STAGE_A(bufoff, gbase, half, usenext) do { if (GATHER) { unsigned _v[2] = {(usenext) ? vn[half][0] : vc[half][0], (usenext) ? vn[half][1] : vc[half][1]}; PG8_STAGE(bufoff, gbase, _v); } \
    else PG8_STAGE(bufoff, gbase, voffA); } while (0)
  const unsigned ldsw = (unsigned)wid * 1024u;
  const int aoff = lds_byte(wr * 64 + fr, fq * 8), boff = lds_byte(wc * 32 + fr, fq * 8);
#define PG8_SA(b, h) (((b) * 2 + (h)) * HTB)
#define PG8_SB(b, h) ((4 + (b) * 2 + (h)) * HTB)
#define PG8_STAGE(bufoff, gbase, voff) do { _Pragma("unroll") for (int _i = 0; _i < 2; ++_i) \
    __builtin_amdgcn_global_load_lds((const unsigned*)((const char*)(gbase) + (voff)[_i]), (PG8_LAS unsigned*)(lds + (bufoff) + ldsw + _i * 8192), 16, 0, 0); } while (0)
#define PG8_LDA(dst, b, h) do { _Pragma("unroll") for (int m = 0; m < 4; ++m) _Pragma("unroll") for (int k = 0; k < 2; ++k) dst[m][k] = *(const PG8_LAS bf16x8*)(lds + PG8_SA(b, h) + aoff + m * 2048 + k * 1024); } while (0)
#define PG8_LDB(dst, b, h) do { _Pragma("unroll") for (int n = 0; n < 2; ++n) _Pragma("unroll") for (int k = 0; k < 2; ++k) dst[n][k] = *(const PG8_LAS bf16x8*)(lds + PG8_SB(b, h) + boff + n * 2048 + k * 1024); } while (0)
#define PG8_MMA(ai, bj, At, Bt) do { __builtin_amdgcn_s_setprio(1); _Pragma("unroll") for (int m = 0; m < 4; ++m) _Pragma("unroll") for (int n = 0; n < 2; ++n) _Pragma("unroll") for (int k = 0; k < 2; ++k) \
    acc[ai][bj][m][n] = __builtin_amdgcn_mfma_f32_16x16x32_bf16(Bt[n][k], At[m][k], acc[ai][bj][m][n], 0, 0, 0); __builtin_amdgcn_s_setprio(0); } while (0)
#define PG8_WAIT_V(n) asm volatile("s_waitcnt vmcnt(" #n ")" ::: "memory")
#define PG8_WAIT_L(n) asm volatile("s_waitcnt lgkmcnt(" #n ")" ::: "memory")
#define PG8_BAR __builtin_amdgcn_s_barrier()
#define PG8_SCHED __builtin_amdgcn_sched_barrier(0)
  Unit cur, nxt; int ui = 0;
  if (!S.next(0, cur)) return;
  f32x4 acc[2][2][4][2];
#pragma unroll
  for (int a = 0; a < 2; ++a)
#pragma unroll
    for (int b = 0; b < 2; ++b)
#pragma unroll
      for (int m = 0; m < 4; ++m)
#pragma unroll
        for (int n = 0; n < 2; ++n) acc[a][b][m][n] = (f32x4){0.f, 0.f, 0.f, 0.f};
  bf16x8 At[4][2], B0[2][2], B1[2][2];
  const char* cA = S.a_ptr(cur); const char* cB = S.b_ptr(cur);
  PG8_GOFF(vc, cur);
  PG8_STAGE(PG8_SB(0, 0), cB, voffB); PG8_STAGE_A(PG8_SA(0, 0), cA, 0, false); PG8_STAGE(PG8_SB(0, 1), cB + hstepB, voffB); PG8_STAGE_A(PG8_SA(0, 1), cA + hstepA, 1, false);
  if (wr == 1) PG8_BAR;
  PG8_WAIT_V(4); PG8_BAR;
  PG8_STAGE(PG8_SB(1, 0), cB + kstep, voffB); PG8_STAGE_A(PG8_SA(1, 0), cA + kstep, 0, false); PG8_STAGE(PG8_SB(1, 1), cB + hstepB + kstep, voffB);
  PG8_WAIT_V(6); PG8_BAR;
  for (;;) {
    const bool has_next = S.next(ui + 1, nxt);
    const char* nA = has_next ? S.a_ptr(nxt) : cA; const char* nB = has_next ? S.b_ptr(nxt) : cB;
    if (has_next) PG8_GOFF(vn, nxt); else { _Pragma("unroll") for (int _h = 0; _h < 2; ++_h) _Pragma("unroll") for (int _i = 0; _i < 2; ++_i) vn[_h][_i] = vc[_h][_i]; }
    for (int t = 0; t < nt; t += 2) {
      const bool last = (t == nt - 2);
      const char* a1 = cA + (size_t)(t + 1) * kstep;
      const char* a2 = last ? nA : cA + (size_t)(t + 2) * kstep; const char* b2 = last ? nB : cB + (size_t)(t + 2) * kstep;
      const char* a3 = a2 + kstep; const char* b3 = b2 + kstep;
      PG8_LDB(B0, 0, 0); PG8_SCHED; PG8_LDA(At, 0, 0); PG8_STAGE_A(PG8_SA(1, 1), a1 + hstepA, 1, false);
      PG8_WAIT_L(8); PG8_BAR; PG8_WAIT_L(0); PG8_MMA(0, 0, At, B0); PG8_BAR; PG8_SCHED;
      PG8_LDB(B1, 0, 1); PG8_STAGE(PG8_SB(0, 0), b2, voffB);
      PG8_BAR; PG8_WAIT_L(0); PG8_MMA(0, 1, At, B1); PG8_BAR;
      PG8_LDA(At, 0, 1); PG8_STAGE_A(PG8_SA(0, 0), a2, 0, last);
      PG8_BAR; PG8_WAIT_L(0); PG8_MMA(1, 0, At, B0); PG8_BAR; PG8_SCHED;
      PG8_STAGE(PG8_SB(0, 1), b2 + hstepB, voffB);
      PG8_WAIT_V(6); PG8_BAR; PG8_MMA(1, 1, At, B1); PG8_BAR;
      PG8_LDB(B0, 1, 0); PG8_SCHED; PG8_LDA(At, 1, 0); PG8_STAGE_A(PG8_SA(0, 1), a2 + hstepA, 1, last);
      PG8_WAIT_L(8); PG8_BAR; PG8_WAIT_L(0); PG8_MMA(0, 0, At, B0); PG8_BAR; PG8_SCHED;
      PG8_LDB(B1, 1, 1); PG8_STAGE(PG8_SB(1, 0), b3, voffB);
      PG8_BAR; PG8_WAIT_L(0); PG8_MMA(0, 1, At, B1); PG8_BAR;
      PG8_LDA(At, 1, 1); PG8_STAGE_A(PG8_SA(1, 0), a3, 0, last);
      PG8_BAR; PG8_WAIT_L(0); PG8_MMA(1, 0, At, B0); PG8_BAR; PG8_SCHED;
      PG8_STAGE(PG8_SB(1, 1), b3 + hstepB, voffB);
      PG8_WAIT_V(6); PG8_BAR; PG8_MMA(1, 1, At, B1); PG8_BAR;
    }
    E(acc, cur, wr, wc, fr, fq);
    if (!has_next) break;
#pragma unroll
    for (int a = 0; a < 2; ++a)
#pragma unroll
      for (int b = 0; b < 2; ++b)
#pragma unroll
        for (int m = 0; m < 4; ++m)
#pragma unroll
          for (int n = 0; n < 2; ++n) acc[a][b][m][n] = (f32x4){0.f, 0.f, 0.f, 0.f};
    cur = nxt; cA = nA; cB = nB; ++ui;
    _Pragma("unroll") for (int _h = 0; _h < 2; ++_h) _Pragma("unroll") for (int _i = 0; _i < 2; ++_i) vc[_h][_i] = vn[_h][_i];
  }
  PG8_WAIT_V(0);
  if (wr == 0) PG8_BAR;
  PG8_BAR;
#undef PG8_SA
#undef PG8_SB
#undef PG8_STAGE
#undef PG8_STAGE_A
#undef PG8_GOFF
#undef PG8_LDA
#undef PG8_LDB
#undef PG8_MMA
#undef PG8_WAIT_V
#undef PG8_WAIT_L
#undef PG8_BAR
#undef PG8_SCHED
}
}

struct DenseSched : pg8::GridOrder {
  const char* A; const char* Bt; int lda, ldb, K; const int* gidx;
  __device__ __forceinline__ const char* a_ptr(const pg8::Unit& u) const { return A + (size_t)u.pm * 256 * lda * 2; }
  __device__ __forceinline__ const char* b_ptr(const pg8::Unit& u) const { return Bt + (size_t)u.pn * 256 * ldb * 2; }
};
struct EpiStoreBf16 {
  static constexpr bool PERM = true, AFTER_DRAIN = false;
  bf16_t* O; int ldc;
  __device__ __forceinline__ void operator()(const pg8::f32x4 (&acc)[2][2][4][2], const pg8::Unit& u, int wr, int wc, int fr, int fq) const {
    const int row0 = u.pm * 256 + wr * 64 + fr, col0 = u.pn * 256 + wc * 32 + 8 * fq;
#pragma unroll
    for (int ai = 0; ai < 2; ++ai)
#pragma unroll
      for (int m = 0; m < 4; ++m) { bf16_t* rowp = O + (size_t)(row0 + ai * 128 + m * 16) * ldc + col0;
#pragma unroll
        for (int bj = 0; bj < 2; ++bj) { const pg8::f32x4 v0 = acc[ai][bj][m][0], v1 = acc[ai][bj][m][1];
          pg8::u32x4 w; w.x = pg8::cvt_pk_bf16(v0[0], v0[1]); w.y = pg8::cvt_pk_bf16(v0[2], v0[3]); w.z = pg8::cvt_pk_bf16(v1[0], v1[1]); w.w = pg8::cvt_pk_bf16(v1[2], v1[3]);
          *(pg8::u32x4*)(rowp + bj * 128) = w; } }
  }
};
struct EpiResidual {
  static constexpr bool PERM = false, AFTER_DRAIN = false;
  float* xl; float* xc; const float* mod;
  int chunk;
  __device__ __forceinline__ void operator()(const pg8::f32x4 (&acc)[2][2][4][2], const pg8::Unit& u, int wr, int wc, int fr, int fq) const {
    const int mj = u.pm < 32 ? 0 : (u.pm < 64 ? 1 : 2);
    float* base = u.pm < 64 ? xl + (size_t)u.pm * 256 * D : xc + (size_t)(u.pm - 64) * 256 * D;
    const float* gv = mod + ((size_t)mj * 6 + chunk) * D;
    const int row0 = wr * 64 + fr, col0 = u.pn * 256 + wc * 32 + 4 * fq;
#pragma unroll
    for (int bj = 0; bj < 2; ++bj)
#pragma unroll
      for (int n = 0; n < 2; ++n) {
        const pg8::f32x4 g = *(const pg8::f32x4*)(gv + col0 + bj * 128 + n * 16);
#pragma unroll
        for (int ai = 0; ai < 2; ++ai)
#pragma unroll
          for (int m = 0; m < 4; ++m) { pg8::f32x4* q = (pg8::f32x4*)(base + (size_t)(row0 + ai * 128 + m * 16) * D + col0 + bj * 128 + n * 16); *q = *q + g * acc[ai][bj][m][n]; }
      }
  }
};
struct MoeSched : pg8::GridOrder {
  const char* A; const char* Bt; int lda, ldb, K; size_t bstride;
  const int* gidx; bool gather;
  __device__ __forceinline__ const char* a_ptr(const pg8::Unit& u) const { return gather ? A : A + (size_t)u.pm * 256 * lda * 2; }
  __device__ __forceinline__ const char* b_ptr(const pg8::Unit& u) const { return Bt + (size_t)((u.pm >> 2) & 15) * bstride + (size_t)u.pn * 256 * ldb * 2; }
};
struct EpiSwiGLU {
  static constexpr bool PERM = true, AFTER_DRAIN = false;
  bf16_t* O;
  __device__ __forceinline__ void operator()(const pg8::f32x4 (&acc)[2][2][4][2], const pg8::Unit& u, int wr, int wc, int fr, int fq) const {
    const int row0 = u.pm * 256 + wr * 64 + fr, col0 = u.pn * 128 + wc * 16 + 4 * fq;
#pragma unroll
    for (int ai = 0; ai < 2; ++ai)
#pragma unroll
      for (int m = 0; m < 4; ++m) { bf16_t* rowp = O + (size_t)(row0 + ai * 128 + m * 16) * DEXP + col0;
#pragma unroll
        for (int bj = 0; bj < 2; ++bj) { const pg8::f32x4 v0 = acc[ai][bj][m][0], v1 = acc[ai][bj][m][1];
          const float h0 = silu_f(v0[0]) * v0[1], h1 = silu_f(v0[2]) * v0[3], h2 = silu_f(v1[0]) * v1[1], h3 = silu_f(v1[2]) * v1[3];
          uint2 w; w.x = pg8::cvt_pk_bf16(h0, h1); w.y = pg8::cvt_pk_bf16(h2, h3);
          *(uint2*)(rowp + bj * 64) = w; } }
  }
};
struct EpiGateBf16 {
  static constexpr bool PERM = true, AFTER_DRAIN = false;
  bf16_t* O; const float* gate;
  __device__ __forceinline__ void operator()(const pg8::f32x4 (&acc)[2][2][4][2], const pg8::Unit& u, int wr, int wc, int fr, int fq) const {
    const int row0 = u.pm * 256 + wr * 64 + fr, col0 = u.pn * 256 + wc * 32 + 8 * fq;
#pragma unroll
    for (int ai = 0; ai < 2; ++ai)
#pragma unroll
      for (int m = 0; m < 4; ++m) { const int row = row0 + ai * 128 + m * 16; const float g = gate[row]; bf16_t* rowp = O + (size_t)row * D + col0;
#pragma unroll
        for (int bj = 0; bj < 2; ++bj) { const pg8::f32x4 v0 = acc[ai][bj][m][0] * g, v1 = acc[ai][bj][m][1] * g;
          pg8::u32x4 w; w.x = pg8::cvt_pk_bf16(v0[0], v0[1]); w.y = pg8::cvt_pk_bf16(v0[2], v0[3]); w.z = pg8::cvt_pk_bf16(v1[0], v1[1]); w.w = pg8::cvt_pk_bf16(v1[2], v1[3]);
          *(pg8::u32x4*)(rowp + bj * 128) = w; } }
  }
};

namespace fa {
using bf16x8 = __attribute__((ext_vector_type(8))) short;
using s16x4  = __attribute__((ext_vector_type(4))) short;
using f32x16 = __attribute__((ext_vector_type(16))) float;
using u32x4  = __attribute__((ext_vector_type(4))) unsigned;
constexpr int NW = 8, QBLK = 32, KVBLK = 64, LDQK = 128, LDV = 64;
constexpr float SCALE = 0.10206207261596575f;
constexpr float THR = 8.f;
constexpr size_t SHM_V = KVBLK * 64 * 2, SHM_K = KVBLK * 128 * 2, SHM_ATTN = 2 * SHM_V + 2 * SHM_K + NW * 64 * 4;
#define FA_KSWZ(row, colB) ((row) * 256 + ((colB) ^ (((row) & 7) << 4)))
#define FA_SBAR() __builtin_amdgcn_sched_barrier(0)
__device__ __forceinline__ int crow(int r, int hi) { return (r & 3) + 8 * (r >> 2) + 4 * hi; }
__device__ __forceinline__ unsigned cvtpk(float lo, float hi) { unsigned r; asm volatile("v_cvt_pk_bf16_f32 %0, %1, %2" : "=v"(r) : "v"(lo), "v"(hi)); return r; }
__device__ __forceinline__ void partialSM(f32x16& p0, f32x16& p1, float& m_reg, float& mn, float& alpha) {
  constexpr float C = SCALE * 1.4426950408889634f;
  float pmax = p0[0];
#pragma unroll
  for (int r = 1; r < 16; ++r) pmax = fmaxf(pmax, p0[r]);
#pragma unroll
  for (int r = 0; r < 16; ++r) pmax = fmaxf(pmax, p1[r]);
  { auto rr = __builtin_amdgcn_permlane32_swap(__float_as_uint(pmax), __float_as_uint(pmax), false, false);
    pmax = fmaxf(__uint_as_float(rr[0]), __uint_as_float(rr[1])); }
  if (__builtin_expect(__all(pmax - m_reg <= THR / SCALE), 1)) { mn = m_reg; alpha = 1.f; }
  else { mn = fmaxf(m_reg, pmax); alpha = __builtin_amdgcn_exp2f((m_reg - mn) * C); m_reg = mn; }
  float mnC = -mn * C;
  p0 = p0 * C + mnC; p1 = p1 * C + mnC;
#pragma unroll
  for (int r = 0; r < 16; ++r) p0[r] = __builtin_amdgcn_exp2f(p0[r]);
}
__device__ __forceinline__ void finishSM(f32x16& p0, f32x16& p1, float alpha, float& l_reg, bf16x8& pa0, bf16x8& pa1, bf16x8& pa2, bf16x8& pa3) {
#pragma unroll
  for (int r = 0; r < 16; ++r) p1[r] = __builtin_amdgcn_exp2f(p1[r]);
  float ps;
  { const f32x16 t = p0 + p1; const auto t8 = t.lo + t.hi; const auto t4 = t8.lo + t8.hi; const auto t2 = t4.lo + t4.hi; ps = t2.x + t2.y; }
  { auto rr = __builtin_amdgcn_permlane32_swap(__float_as_uint(ps), __float_as_uint(ps), false, false);
    ps = __uint_as_float(rr[0]) + __uint_as_float(rr[1]); }
  l_reg = l_reg * alpha + ps;
#define FA_PK4(P, BASE, OUT) do { unsigned a0 = cvtpk(P[BASE + 0], P[BASE + 1]), a1 = cvtpk(P[BASE + 2], P[BASE + 3]);   \
    unsigned b0 = cvtpk(P[BASE + 4], P[BASE + 5]), b1 = cvtpk(P[BASE + 6], P[BASE + 7]);                              \
    auto r0 = __builtin_amdgcn_permlane32_swap(a0, b0, false, false); auto r1 = __builtin_amdgcn_permlane32_swap(a1, b1, false, false); \
    u32x4 w = {r0[0], r1[0], r0[1], r1[1]}; OUT = *reinterpret_cast<bf16x8*>(&w); } while (0)
  FA_PK4(p0, 0, pa0); FA_PK4(p0, 8, pa1); FA_PK4(p1, 0, pa2); FA_PK4(p1, 8, pa3);
#undef FA_PK4
}
__device__ __forceinline__ void qkt(f32x16& p0, f32x16& p1, const char* Ks, const bf16x8* qr, int r32, int hi) {
  p0 = f32x16{}; p1 = f32x16{};
#pragma unroll
  for (int d0 = 0; d0 < 6; ++d0) { int cb = (d0 * 16 + hi * 8) * 2;
    bf16x8 b0 = *reinterpret_cast<const bf16x8*>(Ks + FA_KSWZ(r32, cb));
    bf16x8 b1 = *reinterpret_cast<const bf16x8*>(Ks + FA_KSWZ(32 + r32, cb));
    p0 = __builtin_amdgcn_mfma_f32_32x32x16_bf16(b0, qr[d0], p0, 0, 0, 0);
    p1 = __builtin_amdgcn_mfma_f32_32x32x16_bf16(b1, qr[d0], p1, 0, 0, 0); }
}
__device__ __forceinline__ int v_st(int k, int c) { const int kk = (k & ~0xC) | ((k & 4) << 1) | ((k & 8) >> 1); return ((kk >> 3) * 2 + (c >> 5)) * 512 + ((kk & 7) * 32 + (c & 31)) * 2; }
__device__ __forceinline__ int v_rd_base(int lane) { return ((lane & 3) << 3) | (((lane >> 2) & 3) << 6) | (((lane >> 4) & 1) << 5) | (((lane >> 5) & 1) << 8); }
constexpr int v_rd_off(int d0, int ks, int half) { return d0 * 512 + ks * 2048 + half * 1024; }
template <int OFF> __device__ __forceinline__ s16x4 tr_read(int vb) {
  s16x4 r; asm volatile("ds_read_b64_tr_b16 %0, %1 offset:%2" : "=&v"(r) : "v"(vb), "i"(OFF) : "memory"); return r;
}
template <int D0> __device__ __forceinline__ void pv_one(f32x16& od, int vb, bf16x8 pa0, bf16x8 pa1, bf16x8 pa2, bf16x8 pa3) {
  const s16x4 l0 = tr_read<v_rd_off(D0, 0, 0)>(vb), h0 = tr_read<v_rd_off(D0, 0, 1)>(vb), l1 = tr_read<v_rd_off(D0, 1, 0)>(vb), h1 = tr_read<v_rd_off(D0, 1, 1)>(vb);
  const s16x4 l2 = tr_read<v_rd_off(D0, 2, 0)>(vb), h2 = tr_read<v_rd_off(D0, 2, 1)>(vb), l3 = tr_read<v_rd_off(D0, 3, 0)>(vb), h3 = tr_read<v_rd_off(D0, 3, 1)>(vb);
  asm volatile("s_waitcnt lgkmcnt(0)" ::: "memory"); FA_SBAR();
#define FA_PK(L, H) (bf16x8){L[0], L[1], L[2], L[3], H[0], H[1], H[2], H[3]}
  od = __builtin_amdgcn_mfma_f32_32x32x16_bf16(pa0, FA_PK(l0, h0), od, 0, 0, 0);
  od = __builtin_amdgcn_mfma_f32_32x32x16_bf16(pa1, FA_PK(l1, h1), od, 0, 0, 0);
  od = __builtin_amdgcn_mfma_f32_32x32x16_bf16(pa2, FA_PK(l2, h2), od, 0, 0, 0);
  od = __builtin_amdgcn_mfma_f32_32x32x16_bf16(pa3, FA_PK(l3, h3), od, 0, 0, 0);
#undef FA_PK
}
__device__ __forceinline__ void attn_body(const bf16_t* __restrict__ Qb, const bf16_t* __restrict__ Kh, const bf16_t* __restrict__ Vh, bf16_t* __restrict__ Ob, int ldo, int seq, char* lds, float* mlp = nullptr, int mlstride = 0) {
  const int tid = ltid(), wid = tid >> 6, lane = tid & 63, r32 = lane & 31, hi = lane >> 5;
  char* V_lds = lds; char* K_lds = lds + 2 * SHM_V;
  float* ws = (float*)(lds + 2 * SHM_V + 2 * SHM_K) + wid * 64; float* li_l = ws; float* al_l = ws + 32;
  float m_reg = -1e30f, l_reg = 0; f32x16 o[2] = {}; bf16x8 qr[6];
  const bf16_t* Qw = Qb + (long)(wid * QBLK + r32) * LDQK + hi * 8;
#pragma unroll
  for (int d0 = 0; d0 < 6; ++d0) qr[d0] = *reinterpret_cast<const bf16x8*>(Qw + d0 * 16);
  const int sr = tid >> 4, sc = (tid & 15) * 8;
  const int vr = tid >> 3, vc = (tid & 7) * 8, vst0 = v_st(vr, vc);
  const int vb0 = (int)(uintptr_t)V_lds + v_rd_base(lane);
  struct { bf16x8 vs0, ks0, ks1; } sr_[2];
#define FA_SLOAD(i, k0) do { sr_[i].vs0 = *reinterpret_cast<const bf16x8*>(&Vh[(long)((k0) + vr) * LDV + vc]); \
    sr_[i].ks0 = *reinterpret_cast<const bf16x8*>(&Kh[(long)((k0) + sr) * LDQK + sc]); sr_[i].ks1 = *reinterpret_cast<const bf16x8*>(&Kh[(long)((k0) + 32 + sr) * LDQK + sc]); } while (0)
#define FA_SWRITE(b, i) do { *(bf16x8*)(V_lds + (b) * SHM_V + vst0) = sr_[i].vs0; int kc = sc * 2;               \
    *(bf16x8*)(K_lds + (b) * SHM_K + FA_KSWZ(sr, kc)) = sr_[i].ks0;                       \
    *(bf16x8*)(K_lds + (b) * SHM_K + FA_KSWZ(32 + sr, kc)) = sr_[i].ks1; } while (0)
#define FA_SWAIT() asm volatile("s_waitcnt vmcnt(3)" ::: "memory")
#define FA_RESC(a) do { if (__any((a) < 1.f)) { if (hi == 0) al_l[r32] = (a); asm volatile("s_waitcnt lgkmcnt(0)" ::: "memory"); \
    _Pragma("unroll") for (int d = 0; d < 2; ++d) _Pragma("unroll") for (int r = 0; r < 16; ++r) o[d][r] *= al_l[crow(r, hi)]; } } while (0)
  f32x16 pA0, pA1, pB0, pB1; float mnA, mnB, alA, alB; bf16x8 pa0, pa1, pa2, pa3; const int NTL = seq / KVBLK;
  constexpr int SE = 0, SO = 1;
  __syncthreads();
  FA_SLOAD(SE, 0); asm volatile("s_waitcnt vmcnt(0)" ::: "memory"); FA_SWRITE(0, SE); __syncthreads();
  qkt(pA0, pA1, K_lds, qr, r32, hi); partialSM(pA0, pA1, m_reg, mnA, alA);
  FA_SLOAD(SO, KVBLK); if (2 < NTL) FA_SLOAD(SE, 2 * KVBLK);
  FA_SWAIT(); FA_SWRITE(1, SO); __syncthreads();
  for (int j = 1; j + 1 < NTL; j += 2) {
    FA_SBAR(); qkt(pB0, pB1, K_lds + SHM_K, qr, r32, hi);
    finishSM(pA0, pA1, alA, l_reg, pa0, pa1, pa2, pa3); FA_SBAR();
    FA_SLOAD(SO, (j + 2) * KVBLK); FA_SBAR();
    pv_one<0>(o[0], vb0, pa0, pa1, pa2, pa3); pv_one<1>(o[1], vb0, pa0, pa1, pa2, pa3); partialSM(pB0, pB1, m_reg, mnB, alB);
    __syncthreads(); FA_SWAIT(); FA_SWRITE(0, SE);
    FA_RESC(alB); __syncthreads();
    FA_SBAR(); qkt(pA0, pA1, K_lds, qr, r32, hi);
    finishSM(pB0, pB1, alB, l_reg, pa0, pa1, pa2, pa3); FA_SBAR();
    if (j + 3 < NTL) FA_SLOAD(SE, (j + 3) * KVBLK); FA_SBAR();
    pv_one<0>(o[0], vb0 + (int)SHM_V, pa0, pa1, pa2, pa3); pv_one<1>(o[1], vb0 + (int)SHM_V, pa0, pa1, pa2, pa3); partialSM(pA0, pA1, m_reg, mnA, alA);
    __syncthreads(); FA_SWAIT(); FA_SWRITE(1, SO);
    FA_RESC(alA); __syncthreads();
  }
  FA_SBAR(); qkt(pB0, pB1, K_lds + SHM_K, qr, r32, hi);
  finishSM(pA0, pA1, alA, l_reg, pa0, pa1, pa2, pa3); FA_SBAR();
  pv_one<0>(o[0], vb0, pa0, pa1, pa2, pa3); pv_one<1>(o[1], vb0, pa0, pa1, pa2, pa3); partialSM(pB0, pB1, m_reg, mnB, alB);
  __syncthreads(); FA_RESC(alB);
  finishSM(pB0, pB1, alB, l_reg, pa0, pa1, pa2, pa3); FA_SBAR();
  pv_one<0>(o[0], vb0 + (int)SHM_V, pa0, pa1, pa2, pa3); pv_one<1>(o[1], vb0 + (int)SHM_V, pa0, pa1, pa2, pa3);
  if (hi == 0) { li_l[r32] = l_reg; if (mlp) { float* q2 = mlp + (size_t)(wid * QBLK + r32) * mlstride; q2[0] = m_reg; q2[1] = l_reg; } }
  asm volatile("s_waitcnt lgkmcnt(0)" ::: "memory");
  float rli[16];
#pragma unroll
  for (int r = 0; r < 16; ++r) rli[r] = __builtin_amdgcn_rcpf(li_l[crow(r, hi)]);
  bf16_t* Ow = Ob + (long)(wid * QBLK) * ldo;
#pragma unroll
  for (int r = 0; r < 16; ++r) { int orow = crow(r, hi);
#pragma unroll
    for (int d0 = 0; d0 < 2; ++d0) Ow[(long)orow * ldo + d0 * 32 + r32] = f2bf(o[d0][r] * rli[r]); }
#undef FA_SLOAD
#undef FA_SWRITE
#undef FA_SWAIT
#undef FA_RESC
}
}

namespace gd {
using bf16x8 = __attribute__((ext_vector_type(8))) short;
using f32x4 = __attribute__((ext_vector_type(4))) float;
constexpr int NCH = 132;
constexpr size_t R_QF = 0, R_KF = 16384, R_KTF = 32768, R_VC = 49152, R_DIR = 65536, DIR_BYTES = 17408, D_TINV = 0, D_QKM = 8192, D_VEC = 16384;
constexpr size_t CHREC = R_DIR + 2 * DIR_BYTES;
__device__ __forceinline__ unsigned pk(float lo, float hi) { unsigned r; asm volatile("v_cvt_pk_bf16_f32 %0, %1, %2" : "=v"(r) : "v"(lo), "v"(hi)); return r; }
__device__ __forceinline__ bf16x8 pack8(const f32x4 a, const f32x4 b) { typedef unsigned u4 __attribute__((ext_vector_type(4))); u4 w = {pk(a[0], a[1]), pk(a[2], a[3]), pk(b[0], b[1]), pk(b[2], b[3])}; return *reinterpret_cast<bf16x8*>(&w); }
__device__ __forceinline__ int chunk_row0(int b, int c) { return c < 4 ? ML + b * TC + 64 * c : b * T + 64 * (c - 4); }
constexpr int L_Q = 0, L_K = 16384, L_V = 32768, L_KK = 49152  , L_QK = 65792, L_G = 82432  ,
              L_A = 0  , L_X0 = 32768  , L_X1 = 83968, L_AT = 100352;
__device__ __forceinline__ int swz(int row, int colB) { return row * 256 + (colB ^ ((row & 7) << 4)); }
__device__ __forceinline__ void tr_pair(int a0, int a1, uint2& lo, uint2& hi) {
  asm volatile("ds_read_b64_tr_b16 %0, %2\n\tds_read_b64_tr_b16 %1, %3\n\ts_waitcnt lgkmcnt(0)" : "=&v"(lo), "=&v"(hi) : "v"(a0), "v"(a1) : "memory");
}
__device__ __forceinline__ uint2 tr_one(int a0) {
  uint2 r; asm volatile("ds_read_b64_tr_b16 %0, %1\n\ts_waitcnt lgkmcnt(0)" : "=&v"(r) : "v"(a0) : "memory"); return r;
}

__device__ __forceinline__ void inv_offdiag(const float* A, float* X, int bi, int bj, int lane) {
  const int rc = lane & 15, g = lane >> 4;
  f32x4 t = {0.f, 0.f, 0.f, 0.f};
  for (int k = bj; k < bi; ++k) {
#pragma unroll
    for (int s4 = 0; s4 < 4; ++s4)
      t = __builtin_amdgcn_mfma_f32_16x16x4f32(A[(bi * 16 + rc) * 64 + k * 16 + s4 * 4 + g], X[(k * 16 + s4 * 4 + g) * 64 + bj * 16 + rc], t, 0, 0, 0);
  }
  f32x4 o = {0.f, 0.f, 0.f, 0.f};
#pragma unroll
  for (int r = 0; r < 4; ++r)
    o = __builtin_amdgcn_mfma_f32_16x16x4f32(X[(bi * 16 + rc) * 64 + bi * 16 + g * 4 + r], t[r], o, 0, 0, 0);
#pragma unroll
  for (int r = 0; r < 4; ++r) X[(bi * 16 + g * 4 + r) * 64 + bj * 16 + rc] = -o[r];
}
__device__ __forceinline__ void lds_barrier() { asm volatile("s_waitcnt lgkmcnt(0)" ::: "memory"); __builtin_amdgcn_s_barrier(); asm volatile("" ::: "memory"); }
constexpr int L_CW = 133120;
__device__ __forceinline__ void precompute_load(const Params& p, int b, int h, int c, int tid, uint4 (&xin)[3][4]) {
  const bf16_t* P = (const bf16_t*)(p.ws + OFF_P);
  const int row0 = chunk_row0(b, c), tlen = c < 4 ? TC : T, t0 = c < 4 ? 64 * c : 64 * (c - 4);
  const int ch8 = tid & 15, tokA = 2 * (tid >> 4);
#pragma unroll
  for (int which = 0; which < 3; ++which) {
    const int ch0 = which * 512 + h * 128 + ch8 * 8;
#pragma unroll
    for (int jj = 0; jj < 4; ++jj) { const int tt = t0 + tokA - 1 + jj;
      xin[which][jj] = (tt >= 0 && tt < tlen) ? *(const uint4*)(P + (size_t)(row0 + tokA - 1 + jj) * NINP + PC_GQ + ch0) : make_uint4(0u, 0u, 0u, 0u); }
  }
}
__device__ __forceinline__ void precompute_item(const Params& p, int l, int b, int h, int c, char* lds, int tid, const uint4 (&xin)[3][4]) {
  const int lane = tid & 63, wv = tid >> 6;
  const bf16_t* P = (const bf16_t*)(p.ws + OFF_P);
  char* rec = p.ws + OFF_RB + (size_t)((b * 4 + h) * NCH + c) * CHREC;
  const int row0 = chunk_row0(b, c);
  const int ldsb = (int)(uintptr_t)lds;
  lds_barrier();
  {
    const int ch8 = tid & 15, tg = tid >> 4, tokA = 2 * tg;
    const float* cwl = (const float*)(lds + L_CW);
#pragma unroll
    for (int which = 0; which < 3; ++which) {
      float xf[4][8];
#pragma unroll
      for (int jj = 0; jj < 4; ++jj) { const unsigned w4[4] = {xin[which][jj].x, xin[which][jj].y, xin[which][jj].z, xin[which][jj].w};
#pragma unroll
        for (int i = 0; i < 4; ++i) { xf[jj][2 * i] = __uint_as_float(w4[i] << 16); xf[jj][2 * i + 1] = __uint_as_float(w4[i] & 0xffff0000u); } }
      float wf[3][8];
#pragma unroll
      for (int j = 0; j < 3; ++j) { const float4 w0 = *(const float4*)(cwl + j * 1536 + which * 512 + h * 128 + ch8 * 8), w1 = *(const float4*)(cwl + j * 1536 + which * 512 + h * 128 + ch8 * 8 + 4);
        wf[j][0] = w0.x; wf[j][1] = w0.y; wf[j][2] = w0.z; wf[j][3] = w0.w; wf[j][4] = w1.x; wf[j][5] = w1.y; wf[j][6] = w1.z; wf[j][7] = w1.w; }
#pragma unroll
      for (int a = 0; a < 2; ++a) {
        float o[8], ss = 0.f;
#pragma unroll
        for (int i = 0; i < 8; ++i) { o[i] = silu_f(wf[0][i] * xf[a][i] + wf[1][i] * xf[a + 1][i] + wf[2][i] * xf[a + 2][i]); ss += o[i] * o[i]; }
        if (which < 2) {
          ss += __shfl_xor(ss, 1); ss += __shfl_xor(ss, 2); ss += __shfl_xor(ss, 4); ss += __shfl_xor(ss, 8);
          const float sc = rsqrtf(ss + EPS) * (which == 0 ? 0.08838834764831845f : 1.f);
#pragma unroll
          for (int i = 0; i < 8; ++i) o[i] *= sc;
        }
        uint4 w; w.x = pk(o[0], o[1]); w.y = pk(o[2], o[3]); w.z = pk(o[4], o[5]); w.w = pk(o[6], o[7]);
        *(uint4*)(lds + (which == 0 ? L_Q : (which == 1 ? L_K : L_V)) + swz(tokA + a, ch8 * 16)) = w;
      }
    }
    if (tid < 128) {
      const int d = tid >> 6, tk = tid & 63;
      const float pa = bf2f(P[(size_t)(row0 + tk) * NINP + PC_A + d * 4 + h]), pb = bf2f(P[(size_t)(row0 + tk) * NINP + PC_B + d * 4 + h]);
      float* gs = (float*)(lds + L_G);
      gs[d * 64 + tk] = -expf(p.a_log[l * 8 + d * 4 + h]) * softplus_f(pa + p.dt_bias[l * 8 + d * 4 + h]);
      gs[128 + d * 64 + tk] = sigmoid_f(pb);
    }
  }
  lds_barrier();
  if (wv == 0) {
    float* gs = (float*)(lds + L_G);
    float a0 = gs[lane], a1 = gs[64 + 63 - lane];
#pragma unroll
    for (int o = 1; o < 64; o <<= 1) { const float n0 = __shfl_up(a0, o), n1 = __shfl_up(a1, o); if (lane >= o) { a0 += n0; a1 += n1; } }
    gs[256 + lane] = a0; gs[256 + 64 + 63 - lane] = a1;
  }
  {
    const int cc = lane & 15, g = lane >> 4;
#pragma unroll
    for (int tt = 0; tt < 2; ++tt) {
      const int tile = wv * 2 + tt, mi = tile >> 2, nj = tile & 3;
      f32x4 akk = {0.f, 0.f, 0.f, 0.f}, aqk = {0.f, 0.f, 0.f, 0.f};
#pragma unroll
      for (int s4 = 0; s4 < 4; ++s4) {
        const bf16x8 ak = *(const bf16x8*)(lds + L_K + swz(mi * 16 + cc, s4 * 64 + g * 16));
        const bf16x8 aq = *(const bf16x8*)(lds + L_Q + swz(mi * 16 + cc, s4 * 64 + g * 16));
        const bf16x8 bk = *(const bf16x8*)(lds + L_K + swz(nj * 16 + cc, s4 * 64 + g * 16));
        akk = __builtin_amdgcn_mfma_f32_16x16x32_bf16(ak, bk, akk, 0, 0, 0);
        aqk = __builtin_amdgcn_mfma_f32_16x16x32_bf16(aq, bk, aqk, 0, 0, 0);
      }
      float* KK = (float*)(lds + L_KK); float* QK = (float*)(lds + L_QK);
#pragma unroll
      for (int r = 0; r < 4; ++r) { KK[(mi * 16 + g * 4 + r) * 65 + nj * 16 + cc] = akk[r]; QK[(mi * 16 + g * 4 + r) * 65 + nj * 16 + cc] = aqk[r]; }
    }
#pragma unroll
    for (int it = 0; it < 2; ++it) {
      const int item = tid + it * NT, fl = item & 63, frag = item >> 6, mt = frag >> 3, kbj = frag & 7, r = fl & 31, hl = fl >> 5;
      const int row = mt * 32 + r, cb = (kbj * 16 + hl * 4) * 2;
      uint4 wq, wk;
      { const uint2 lo = *(const uint2*)(lds + L_Q + swz(row, cb)), hi = *(const uint2*)(lds + L_Q + swz(row, cb + 16)); wq = make_uint4(lo.x, lo.y, hi.x, hi.y); }
      { const uint2 lo = *(const uint2*)(lds + L_K + swz(row, cb)), hi = *(const uint2*)(lds + L_K + swz(row, cb + 16)); wk = make_uint4(lo.x, lo.y, hi.x, hi.y); }
      *(uint4*)(rec + R_QF + (size_t)item * 16) = wq; *(uint4*)(rec + R_KF + (size_t)item * 16) = wk;
    }
#pragma unroll
    for (int it = 0; it < 2; ++it) {
      const int item = tid + it * NT, fl = item & 63, frag = item >> 6, mt = frag >> 2, kbj = frag & 3, i16 = fl & 15, gq = fl >> 4;
      const int tok0 = kbj * 16 + (gq >> 1) * 4 + (i16 >> 2), cb = (mt * 32 + (gq & 1) * 16 + (i16 & 3) * 4) * 2;
      uint2 lo, hi; tr_pair(ldsb + L_K + swz(tok0, cb), ldsb + L_K + swz(tok0 + 8, cb), lo, hi);
      *(uint4*)(rec + R_KTF + (size_t)item * 16) = make_uint4(lo.x, lo.y, hi.x, hi.y);
    }
#pragma unroll
    for (int it = 0; it < 4; ++it) {
      const int item = tid + it * NT, fl = item & 63, q = (item >> 6) & 3, mt = (item >> 8) & 1, sl = item >> 9, i16 = fl & 15, gq = fl >> 4;
      const int tok0 = mt * 32 + q * 8 + (gq >> 1) * 4 + (i16 >> 2), cb = (sl * 32 + (gq & 1) * 16 + (i16 & 3) * 4) * 2;
      const uint2 v = tr_one(ldsb + L_V + swz(tok0, cb));
      *(uint2*)(rec + R_VC + (size_t)item * 8) = v;
    }
  }
  lds_barrier();
  {
    const float* gs = (const float*)(lds + L_G); const float* KK = (const float*)(lds + L_KK);
    float* A = (float*)(lds + L_A);
#pragma unroll 4
    for (int it = 0; it < 16; ++it) {
      const int e = tid + it * NT, d = e >> 12, ip = (e >> 6) & 63, jp = e & 63, ti = d ? 63 - ip : ip, tj = d ? 63 - jp : jp;
      A[e] = ip > jp ? gs[128 + d * 64 + ti] * KK[ti * 65 + tj] * __expf(gs[256 + d * 64 + ti] - gs[256 + d * 64 + tj]) : 0.f;
    }
  }
  lds_barrier();
  if (wv < 2) {
    const float* A = (const float*)(lds + L_A) + wv * 4096; float* X = (float*)(lds + (wv ? L_X1 : L_X0));
    const int qb = lane >> 4, c16 = lane & 15;
    float x[16];
    f32x4 an[4];
#pragma unroll
    for (int q4 = 0; q4 < 4; ++q4) an[q4] = *(const f32x4*)(A + (qb * 16) * 64 + qb * 16 + q4 * 4);
#pragma unroll
    for (int r = 0; r < 16; ++r) {
      f32x4 ac[4];
#pragma unroll
      for (int q4 = 0; q4 < 4; ++q4) ac[q4] = an[q4];
      if (r < 15) {
#pragma unroll
        for (int q4 = 0; q4 < 4; ++q4) an[q4] = *(const f32x4*)(A + (qb * 16 + r + 1) * 64 + qb * 16 + q4 * 4); }
      asm volatile("" ::: "memory");
      float sacc = (r == c16) ? 1.f : 0.f;
#pragma unroll
      for (int q = 0; q < 16; ++q) if (q < r) sacc -= ac[q >> 2][q & 3] * x[q];
      x[r] = sacc;
      X[(qb * 16 + r) * 64 + qb * 16 + c16] = sacc;
    }
  } else {
    const float* gs = (const float*)(lds + L_G); const float* QK = (const float*)(lds + L_QK);
    const int t2 = tid - 128;
    for (int e = t2; e < 2 * 6 * 256; e += 384) {
      const int d = e / 1536, r6 = (e % 1536) >> 8, w = e & 255; const int bi = r6 < 3 ? 0 : (r6 < 5 ? 1 : 2), bj = r6 < 3 ? r6 + 1 : (r6 < 5 ? r6 - 1 : 3);
      ((float*)(lds + (d ? L_X1 : L_X0)))[(bi * 16 + (w >> 4)) * 64 + bj * 16 + (w & 15)] = 0.f; }
    for (int item = t2; item < 1024; item += 384) {
      const int d = item >> 9, fl = item & 63, frag = (item >> 6) & 7, mt = frag >> 2, kbj = frag & 3, r = fl & 31, hl = fl >> 5;
      const int i = mt * 32 + r; const float gci = gs[256 + d * 64 + i];
      float v[8];
#pragma unroll
      for (int j = 0; j < 8; ++j) { const int jj = kbj * 16 + 8 * (j >> 2) + 4 * hl + (j & 3); const bool ok = d ? (i <= jj) : (i >= jj);
        v[j] = ok ? QK[i * 65 + jj] * __expf(gci - gs[256 + d * 64 + jj]) : 0.f; }
      *(uint4*)(rec + R_DIR + d * DIR_BYTES + D_QKM + (size_t)(item & 511) * 16) = make_uint4(pk(v[0], v[1]), pk(v[2], v[3]), pk(v[4], v[5]), pk(v[6], v[7]));
    }
    if (t2 < 128) {
      const int d = t2 >> 6, tk = t2 & 63; float* vec = (float*)(rec + R_DIR + d * DIR_BYTES + D_VEC);
      const float gc = gs[256 + d * 64 + tk], gl = gs[256 + d * 64 + (d ? 0 : 63)];
      vec[tk] = gs[128 + d * 64 + tk]; vec[64 + tk] = __expf(gc); vec[128 + tk] = __expf(gl - gc);
      if (tk == 0) vec[192] = __expf(gl);
    }
  }
  lds_barrier();
  if (wv < 6) inv_offdiag((const float*)(lds + L_A) + (wv & 1) * 4096, (float*)(lds + ((wv & 1) ? L_X1 : L_X0)), (wv >> 1) + 1, wv >> 1, lane);
  lds_barrier();
  if (wv < 4) inv_offdiag((const float*)(lds + L_A) + (wv & 1) * 4096, (float*)(lds + ((wv & 1) ? L_X1 : L_X0)), (wv >> 1) + 2, wv >> 1, lane);
  lds_barrier();
  if (wv < 2) inv_offdiag((const float*)(lds + L_A) + wv * 4096, (float*)(lds + (wv ? L_X1 : L_X0)), 3, 0, lane);
  lds_barrier();
  {
#pragma unroll
    for (int it = 0; it < 2; ++it) {
      const int item = tid + it * NT, d = item >> 9, fl = item & 63, frag = (item >> 6) & 7, mt = frag >> 2, kbj = frag & 3, r = fl & 31, hl = fl >> 5;
      const int i = mt * 32 + r, ri = d ? 63 - i : i; const float* X = (const float*)(lds + (d ? L_X1 : L_X0)) + ri * 64; const float* bet = (const float*)(lds + L_G) + 128 + d * 64;
      float v[8];
#pragma unroll
      for (int j = 0; j < 8; ++j) { const int jj = kbj * 16 + 8 * (j >> 2) + 4 * hl + (j & 3); v[j] = X[d ? 63 - jj : jj] * bet[jj]; }
      *(uint4*)(rec + R_DIR + d * DIR_BYTES + D_TINV + (size_t)(item & 511) * 16) = make_uint4(pk(v[0], v[1]), pk(v[2], v[3]), pk(v[4], v[5]), pk(v[6], v[7]));
    }
  }
}

constexpr int SBUF_ = 74752;
template <int LW>
__device__ __forceinline__ void scan_loader(const char* recs, int dir, int half, char* smem, int lane) {
  typedef unsigned v4u __attribute__((ext_vector_type(4))); typedef __attribute__((address_space(1))) const v4u g_u4; typedef __attribute__((address_space(3))) v4u l_u4;
#define GD_CHUNK(step) (dir == 0 ? (step) : ((step) < 4 ? 3 - (step) : NCH + 3 - (step)))
#define GD_SOFF(i_) ((i_) < 48 ? (size_t)(i_) * 1024 : ((i_) < 56 ? R_VC + (size_t)half * 8192 + ((i_) - 48) * 1024 : R_DIR + (size_t)dir * DIR_BYTES + ((i_) - 56) * 1024))
#define GD_LOAD(R, step) do { const char* _b = recs + (size_t)GD_CHUNK(step) * CHREC + lane * 16; \
    _Pragma("unroll") for (int _j = 0; _j < 19; ++_j) { const int _i = LW + 4 * _j; if (_i < 73) R[_j] = *(g_u4*)(_b + GD_SOFF(_i)); } } while (0)
#define GD_WRITE(R, buf) do { char* _d = smem + (buf) * SBUF_ + lane * 16; \
    _Pragma("unroll") for (int _j = 0; _j < 19; ++_j) { const int _i = LW + 4 * _j; if (_i < 73) *(l_u4*)(_d + _i * 1024) = R[_j]; } } while (0)
  v4u RA[19], RB[19];
  GD_LOAD(RA, 0); GD_LOAD(RB, 1); GD_WRITE(RA, 0); GD_LOAD(RA, 2);
  lds_barrier();
  for (int step = 0; step < NCH; step += 2) {
    if (step + 1 < NCH) GD_WRITE(RB, 1);
    if (step + 3 < NCH) GD_LOAD(RB, step + 3);
    lds_barrier();
    if (step + 2 < NCH) GD_WRITE(RA, 0);
    if (step + 4 < NCH) GD_LOAD(RA, step + 4);
    lds_barrier();
  }
#undef GD_CHUNK
#undef GD_SOFF
#undef GD_LOAD
#undef GD_WRITE
}
constexpr int SB_QF = 0, SB_KF = 16384, SB_KTF = 32768, SB_VC = 49152, SB_TINV = 57344, SB_QKM = 65536, SB_VEC = 73728, SBUF = 74752;
using f32x16 = __attribute__((ext_vector_type(16))) float;
__device__ __forceinline__ unsigned pkb(float lo, float hi) {
  typedef __bf16 bf2 __attribute__((ext_vector_type(2))); typedef float f2 __attribute__((ext_vector_type(2)));
  bf2 r = __builtin_convertvector((f2){lo, hi}, bf2); return *reinterpret_cast<unsigned*>(&r);
}
template <int J> __device__ __forceinline__ bf16x8 pack16(const f32x16& v) {
  typedef unsigned u4 __attribute__((ext_vector_type(4)));
  u4 w = {pk(v[8 * J], v[8 * J + 1]), pk(v[8 * J + 2], v[8 * J + 3]), pk(v[8 * J + 4], v[8 * J + 5]), pk(v[8 * J + 6], v[8 * J + 7])};
  return *reinterpret_cast<bf16x8*>(&w);
}
typedef __attribute__((address_space(1))) char gchar; typedef __attribute__((address_space(1))) bf16_t gbf16;
#define GD_STO(o, I, MT) do { const unsigned _w = pk(o[I], o[(I) + 1]); gchar* _rb = Pst + (size_t)((MT) * 32 + 8 * ((I) >> 2) + ((I) & 3)) * (NINP * 2); asm volatile("" : "+s"(_rb)); \
    *(gbf16*)(_rb + voff) = (bf16_t)_w; *(gbf16*)(_rb + voff1) = (bf16_t)(_w >> 16); } while (0)
__device__ __forceinline__ void scan_unit_lds(const Params& p, int unit_, char* smem, int tid) {
  const int wv = __builtin_amdgcn_readfirstlane(tid >> 6), lane = tid & 63, unit = __builtin_amdgcn_readfirstlane(unit_);
  const int chain = unit >> 1, half = unit & 1, dir = chain & 1, h = (chain >> 1) & 3, b = chain >> 3;
  const char* recs = p.ws + OFF_RB + (size_t)((b * 4 + h) * NCH) * CHREC;
#define GD_CHUNK(step) (dir == 0 ? (step) : ((step) < 4 ? 3 - (step) : NCH + 3 - (step)))
  if (wv >= 4) {
    if (wv == 4) scan_loader<0>(recs, dir, half, smem, lane); else if (wv == 5) scan_loader<1>(recs, dir, half, smem, lane);
    else if (wv == 6) scan_loader<2>(recs, dir, half, smem, lane); else scan_loader<3>(recs, dir, half, smem, lane);
    return;
  }
  if (wv >= 2) {
    for (int i = 0; i <= NCH; ++i) lds_barrier();
    return;
  }
  lds_barrier();
  const int c32 = lane & 31, hl = lane >> 5;
  const unsigned voff_ = (unsigned)(c32 * 2 + hl * 4 * NINP * 2);
  gchar* Pc = (gchar*)(p.ws + OFF_P + (size_t)((dir ? PC_OB : PC_OF) + h * 128 + (half * 2 + wv) * 32) * 2);
  gchar* Pprev = (gchar*)(p.ws + OFF_P + (size_t)(PC_GV + h * 128 + (half * 2 + wv) * 32) * 2 + (size_t)chunk_row0(b, GD_CHUNK(0)) * (NINP * 2));
  f32x16 S[4], ks0, ks1, oq0, oq1, vn0, vn1;
  bf16x8 f0[8], f1[8], Sb[8], Rb[4], Vb[4], VFb[4];
  typedef unsigned u4 __attribute__((ext_vector_type(4)));
#pragma unroll
  for (int t = 0; t < 4; ++t)
#pragma unroll
    for (int i = 0; i < 16; ++i) S[t][i] = 0.f;
#pragma unroll
  for (int i = 0; i < 16; ++i) { oq0[i] = 0.f; oq1[i] = 0.f; }
#pragma unroll
  for (int k = 0; k < 8; ++k) { Sb[k] = (bf16x8){0, 0, 0, 0, 0, 0, 0, 0}; f0[k] = ((const bf16x8*)(smem + SB_KF))[k * 64 + lane]; }
#define GD_SB() __builtin_amdgcn_sched_barrier(0)
#define GD_MF(a, b, c) c = __builtin_amdgcn_mfma_f32_32x32x16_bf16(a, b, c, 0, 0, 0)
#define GD_ZERO(a) do { _Pragma("unroll") for (int _i = 0; _i < 16; ++_i) a[_i] = 0.f; } while (0)
#define GD_LO(w) __uint_as_float((w) << 16)
#define GD_HI(w) __uint_as_float((w) & 0xffff0000u)
#define GD_RLOAD(vA, vB, eA, eB, MT, HQ) do { vA = VC[((MT) * 4 + 2 * (HQ)) * 64 + lane]; vB = VC[((MT) * 4 + 2 * (HQ) + 1) * 64 + lane]; \
    eA = *(const f32x4*)(vec + 64 + (MT) * 32 + (HQ) * 16); eB = *(const f32x4*)(vec + 64 + (MT) * 32 + (HQ) * 16 + 8); } while (0)
#define GD_RC2(ks, v, e, I0, wa, wb) do { wa = pk(GD_LO(v.x) - e[0] * ks[(I0)], GD_HI(v.x) - e[1] * ks[(I0) + 1]); wb = pk(GD_LO(v.y) - e[2] * ks[(I0) + 2], GD_HI(v.y) - e[3] * ks[(I0) + 3]); } while (0)
#define GD_VF2(vn, e, I0, wa, wb) do { wa = pk(vn[(I0)] * e[0], vn[(I0) + 1] * e[1]); wb = pk(vn[(I0) + 2] * e[2], vn[(I0) + 3] * e[3]); } while (0)
#define GD_W4(dst) do { const u4 _w = {w0, w1, w2, w3}; dst = *reinterpret_cast<const bf16x8*>(&_w); } while (0)
#define GD_FLOAD(eA, eB, MT, HQ) do { eA = *(const f32x4*)(vec + 128 + (MT) * 32 + (HQ) * 16); eB = *(const f32x4*)(vec + 128 + (MT) * 32 + (HQ) * 16 + 8); } while (0)
#define GD_ELOAD(eA, eB, MT, HQ) do { eA = *(const f32x4*)(vec + 64 + (MT) * 32 + (HQ) * 16); eB = *(const f32x4*)(vec + 64 + (MT) * 32 + (HQ) * 16 + 8); } while (0)
#define GD_OINIT(oq, eA, eB, HQ) do { _Pragma("unroll") for (int _r = 0; _r < 4; ++_r) { oq[8 * (HQ) + _r] *= eA[_r]; oq[8 * (HQ) + 4 + _r] *= eB[_r]; } } while (0)
#define GD_SCALE(St, I0) do { float _e = egl; asm volatile("" : "+v"(_e)); _Pragma("unroll") for (int _r = 0; _r < 4; ++_r) St[(I0) + _r] *= _e; } while (0)
  uint2 vXA, vXB, vYA, vYB; f32x4 eXA, eXB, eYA, eYB, gXA, gXB, gYA, gYB; float egl; unsigned w0, w1, w2, w3;
  for (int step = 0; step < NCH; ++step) {
    const char* buf = smem + (step & 1) * SBUF; const char* nbuf = smem + ((step + 1) & 1) * SBUF;
    const bf16x8* QF = (const bf16x8*)(buf + SB_QF); const bf16x8* KF = (const bf16x8*)(buf + SB_KF); const bf16x8* KTF = (const bf16x8*)(buf + SB_KTF);
    const bf16x8* KFn = (const bf16x8*)(nbuf + SB_KF);
    const uint2* VC = (const uint2*)(buf + SB_VC + wv * 4096);
    const bf16x8* TF = (const bf16x8*)(buf + SB_TINV); const bf16x8* QKF = (const bf16x8*)(buf + SB_QKM); const float* vec = (const float*)(buf + SB_VEC) + 4 * hl;
    gchar* Pst = Pprev;
    unsigned voff = voff_; asm volatile("" : "+v"(voff)); unsigned voff1 = voff_ + NINP * 2; asm volatile("" : "+v"(voff1));
    GD_ZERO(ks0);
    GD_SB();
#pragma unroll
    for (int k = 0; k < 8; ++k) {
      GD_MF(f0[k], Sb[k], ks0);
      f1[k] = KF[(8 + k) * 64 + lane];
      if (k < 4) { GD_STO(oq0, 4 * k, 0); GD_STO(oq0, 4 * k + 2, 0); } else { GD_STO(oq1, 4 * (k - 4), 1); GD_STO(oq1, 4 * (k - 4) + 2, 1); }
      if (k == 6) GD_RLOAD(vXA, vXB, eXA, eXB, 0, 0);
      if (k == 7) { GD_RLOAD(vYA, vYB, eYA, eYB, 0, 1); GD_ZERO(ks1); }
      GD_SB();
    }
#pragma unroll
    for (int k = 0; k < 8; ++k) {
      GD_MF(f1[k], Sb[k], ks1);
      f0[k] = QF[k * 64 + lane];
      if (k == 1) GD_RC2(ks0, vXA, eXA, 0, w0, w1);
      if (k == 2) { GD_RC2(ks0, vXB, eXB, 4, w2, w3); GD_W4(Rb[0]); }
      if (k == 3) GD_RC2(ks0, vYA, eYA, 8, w0, w1);
      if (k == 4) { GD_RC2(ks0, vYB, eYB, 12, w2, w3); GD_W4(Rb[1]); }
      if (k == 5) GD_RLOAD(vXA, vXB, eXA, eXB, 1, 0);
      if (k == 6) GD_RLOAD(vYA, vYB, eYA, eYB, 1, 1);
      if (k == 7) { GD_ZERO(oq0); }
      GD_SB();
    }
#pragma unroll
    for (int k = 0; k < 8; ++k) {
      GD_MF(f0[k], Sb[k], oq0);
      f1[k] = QF[(8 + k) * 64 + lane];
      if (k == 1) GD_RC2(ks1, vXA, eXA, 0, w0, w1);
      if (k == 2) { GD_RC2(ks1, vXB, eXB, 4, w2, w3); GD_W4(Rb[2]); }
      if (k == 3) GD_RC2(ks1, vYA, eYA, 8, w0, w1);
      if (k == 4) { GD_RC2(ks1, vYB, eYB, 12, w2, w3); GD_W4(Rb[3]); }
      if (k == 6) egl = vec[192 - 4 * hl];
      if (k == 7) { GD_ZERO(oq1); }
      GD_SB();
    }
#pragma unroll
    for (int k = 0; k < 8; ++k) {
      GD_MF(f1[k], Sb[k], oq1);
      f0[k] = TF[k * 64 + lane];
      GD_SCALE(S[k >> 2], 4 * (k & 3)); GD_SCALE(S[2 + (k >> 2)], 4 * (k & 3));
      if (k == 6) { GD_FLOAD(gXA, gXB, 0, 0); GD_FLOAD(gYA, gYB, 0, 1); }
      if (k == 7) { GD_ZERO(vn0); GD_ZERO(vn1); }
      GD_SB();
    }
#pragma unroll
    for (int k = 0; k < 8; ++k) {
      if (k < 4) GD_MF(f0[k], Rb[k], vn0); else GD_MF(f0[k], Rb[k - 4], vn1);
      f1[k] = KTF[k * 64 + lane];
      if (k == 5) GD_VF2(vn0, gXA, 0, w0, w1);
      if (k == 6) { GD_VF2(vn0, gXB, 4, w2, w3); GD_W4(VFb[0]); }
      if (k == 7) { GD_VF2(vn0, gYA, 8, w0, w1); GD_FLOAD(gXA, gXB, 1, 0); }
      GD_SB();
    }
#pragma unroll
    for (int k = 0; k < 8; ++k) {
      if (k == 0) GD_MF(f1[0], VFb[0], S[0]); if (k == 1) GD_MF(f1[4], VFb[0], S[1]); if (k == 2) GD_MF(f1[1], VFb[1], S[0]); if (k == 3) GD_MF(f1[5], VFb[1], S[1]);
      if (k == 4) GD_MF(f1[2], VFb[2], S[0]); if (k == 5) GD_MF(f1[6], VFb[2], S[1]); if (k == 6) GD_MF(f1[3], VFb[3], S[0]); if (k == 7) GD_MF(f1[7], VFb[3], S[1]);
      f0[k] = KTF[(8 + k) * 64 + lane];
      if (k == 0) { GD_VF2(vn0, gYB, 12, w2, w3); GD_W4(VFb[1]); }
      if (k == 1) { GD_VF2(vn1, gXA, 0, w0, w1); GD_FLOAD(gYA, gYB, 1, 1); }
      if (k == 2) { GD_VF2(vn1, gXB, 4, w2, w3); GD_W4(VFb[2]); }
      if (k == 3) GD_VF2(vn1, gYA, 8, w0, w1);
      if (k == 4) { GD_VF2(vn1, gYB, 12, w2, w3); GD_W4(VFb[3]); }
      if (k == 5) Vb[0] = pack16<0>(vn0);
      if (k == 6) { Vb[1] = pack16<1>(vn0); GD_ELOAD(eXA, eXB, 0, 0); }
      if (k == 7) { Vb[2] = pack16<0>(vn1); GD_ELOAD(eYA, eYB, 0, 1); }
      GD_SB();
    }
#pragma unroll
    for (int k = 0; k < 8; ++k) {
      if (k < 4) GD_MF(f0[k], VFb[k], S[2]); else GD_MF(f0[k], VFb[k - 4], S[3]);
      if (k < 4) { f1[2 * k] = QKF[(2 * k) * 64 + lane]; f1[2 * k + 1] = QKF[(2 * k + 1) * 64 + lane]; }
      if (k == 0) GD_OINIT(oq0, eXA, eXB, 0);
      if (k == 1) { GD_OINIT(oq0, eYA, eYB, 1); GD_ELOAD(eXA, eXB, 1, 0); }
      if (k == 2) { GD_ELOAD(eYA, eYB, 1, 1); Vb[3] = pack16<1>(vn1); Sb[0] = pack16<0>(S[0]); }
      if (k == 3) GD_OINIT(oq1, eXA, eXB, 0);
      if (k == 4) GD_OINIT(oq1, eYA, eYB, 1);
      if (k == 5) Sb[1] = pack16<1>(S[0]);
      if (k == 6) Sb[2] = pack16<0>(S[1]);
      if (k == 7) Sb[3] = pack16<1>(S[1]);
      GD_SB();
    }
    Pprev = Pc + (size_t)chunk_row0(b, GD_CHUNK(step)) * (NINP * 2);
    lds_barrier();
    GD_SB();
#pragma unroll
    for (int k = 0; k < 8; ++k) {
      if (k < 4) GD_MF(f1[k], Vb[k], oq0); else GD_MF(f1[k], Vb[k - 4], oq1);
      f0[k] = KFn[k * 64 + lane];
      if (k == 0) Sb[4] = pack16<0>(S[2]);
      if (k == 1) Sb[5] = pack16<1>(S[2]);
      if (k == 2) Sb[6] = pack16<0>(S[3]);
      if (k == 3) Sb[7] = pack16<1>(S[3]);
      GD_SB();
    }
  }
  {
    gchar* Pst = Pprev; const unsigned voff = voff_, voff1 = voff_ + NINP * 2;
#pragma unroll
    for (int k = 0; k < 8; ++k) { if (k < 4) { GD_STO(oq0, 4 * k, 0); GD_STO(oq0, 4 * k + 2, 0); } else { GD_STO(oq1, 4 * (k - 4), 1); GD_STO(oq1, 4 * (k - 4) + 2, 1); } }
  }
#undef GD_SB
#undef GD_MF
#undef GD_ZERO
#undef GD_LO
#undef GD_HI
#undef GD_RLOAD
#undef GD_RC2
#undef GD_VF2
#undef GD_W4
#undef GD_FLOAD
#undef GD_ELOAD
#undef GD_OINIT
#undef GD_SCALE
#undef GD_CHUNK
}
#undef GD_STO
}

__device__ __forceinline__ void ph_init_ada(const Params& p) {
  const int TIDX = ltid(); const int BIDX = lbid();
  const size_t n = (size_t)MR * D, gt = (size_t)BIDX * NT + TIDX, gs = (size_t)gridDim.x * NT;
  for (size_t i = gt; i < n; i += gs) {
    int r = (int)(i / D), cc = (int)(i % D);
    xrow(p, r)[cc] = r < ML ? p.x[i] : p.ctx[(size_t)(r - ML) * D + cc];
  }
}
__device__ __forceinline__ void ph_modulate(const Params& p, int l, int which, int nrows) {
  const int TIDX = ltid(); const int BIDX = lbid();
  const int lane = TIDX & 63, wv = TIDX >> 6;
  for (int r = BIDX * 8 + wv; r < nrows; r += gridDim.x * 8) {
    int mj, t, tlen, r0; rowinfo(r, mj, t, tlen, r0);
    const float* xr = xrow_src(p, r, l);
    const float* g = (which ? p.norm2_g : p.norm1_g) + l * D;
    const float* sh = modvec(p, l, mj, which ? 3 : 0); const float* sc = modvec(p, l, mj, which ? 4 : 1);
    float v[16], ss = 0;
#pragma unroll
    for (int i = 0; i < 16; ++i) { v[i] = xr[lane + i * 64]; ss += v[i] * v[i]; }
    ss = wave_sum(ss);
    const float rstd = rsqrtf(ss / D + EPS);
    bf16_t* h = (bf16_t*)(p.ws + OFF_H) + (size_t)r * D;
#pragma unroll
    for (int i = 0; i < 16; ++i) { int cc = lane + i * 64; v[i] = v[i] * rstd * g[cc] * (1.f + sc[cc]) + sh[cc]; h[cc] = f2bf(v[i]); }
    if (which) {
      const float* wr = p.router + (size_t)l * D * NE;
      float lo[16];
#pragma unroll
      for (int e = 0; e < 16; ++e) lo[e] = 0.f;
#pragma unroll
      for (int i = 0; i < 16; ++i) { int cc = lane + i * 64;
#pragma unroll
        for (int e = 0; e < 16; ++e) lo[e] += v[i] * wr[cc * NE + e]; }
      float mx = -1e30f;
#pragma unroll
      for (int e = 0; e < 16; ++e) { lo[e] = wave_sum(lo[e]); mx = fmaxf(mx, lo[e]); }
      float sum = 0;
#pragma unroll
      for (int e = 0; e < 16; ++e) { lo[e] = expf(lo[e] - mx); sum += lo[e]; }
      float* afft = (float*)(p.ws + OFF_AFFT);
      if (lane == 0) {
#pragma unroll
        for (int e = 0; e < 16; ++e) afft[(size_t)e * MR + r] = lo[e] / sum;
      }
    }
  }
}

__device__ __forceinline__ constexpr int ngemm_lds_floats() { return 16 * 65 + 16 * 129; }
template <typename LoadA, typename LoadB, typename Epi>
__device__ __forceinline__ void ngemm_tile(float* lds, int M, int N, int K, int tm, int tn, LoadA lda_, LoadB ldb_, Epi epi) {
  float (*sA)[65] = (float (*)[65])lds; float (*sB)[129] = (float (*)[129])(lds + 16 * 65);
  const int tid = ltid(), tx = tid & 31, ty = tid >> 5;
  float acc[4][4];
#pragma unroll
  for (int i = 0; i < 4; ++i)
#pragma unroll
    for (int j = 0; j < 4; ++j) acc[i][j] = 0.f;
  for (int k0 = 0; k0 < K; k0 += 16) {
#pragma unroll
    for (int i = 0; i < 2; ++i) { int e = tid + i * 512; int rr = e >> 4, kk = e & 15; int gr = tm * 64 + rr; sA[kk][rr] = gr < M ? lda_(gr, k0 + kk) : 0.f; }
#pragma unroll
    for (int i = 0; i < 4; ++i) { int e = tid + i * 512; int kk = e >> 7, cc = e & 127; int gc = tn * 128 + cc; sB[kk][cc] = gc < N ? ldb_(k0 + kk, gc) : 0.f; }
    __syncthreads();
#pragma unroll
    for (int kk = 0; kk < 16; ++kk) {
      float a[4], b[4];
#pragma unroll
      for (int i = 0; i < 4; ++i) { a[i] = sA[kk][ty * 4 + i]; b[i] = sB[kk][tx * 4 + i]; }
#pragma unroll
      for (int i = 0; i < 4; ++i)
#pragma unroll
        for (int j = 0; j < 4; ++j) acc[i][j] += a[i] * b[j];
    }
    __syncthreads();
  }
#pragma unroll
  for (int i = 0; i < 4; ++i)
#pragma unroll
    for (int j = 0; j < 4; ++j) { int rr = tm * 64 + ty * 4 + i, cc = tn * 128 + tx * 4 + j; if (rr < M && cc < N) epi(rr, cc, acc[i][j]); }
}

__device__ __forceinline__ void ph_inproj(const Params& p, int l, float* lds) {
  const int TIDX = ltid(); const int BIDX = lbid();
  const bf16_t* H = (const bf16_t*)(p.ws + OFF_H); const float* W = p.w_in + (size_t)l * D * NIN; bf16_t* P = (bf16_t*)(p.ws + OFF_P);
  const int ntn = (NIN + 127) / 128, ntm = MR / 64;
  for (int vb = BIDX; vb < ntn * ntm; vb += gridDim.x)
    ngemm_tile(lds, MR, NIN, D, vb / ntn, vb % ntn,
               [&](int r, int k) { return bf2f(H[(size_t)r * D + k]); },
               [&](int k, int n) { return W[(size_t)k * NIN + n]; },
               [&](int r, int n, float v) { P[(size_t)r * NINP + n] = f2bf(v); });
}

__device__ __forceinline__ void ph_mla(const Params& p, int l, float* lds) {
  const int TIDX = ltid(); const int BIDX = lbid();
  float* pq = lds; float* pkv = pq + 192; float* pkr = pkv + 128; float* qraw = pkr + 32; float* kvraw = qraw + 384; float* qn = kvraw + 512; float* kn = qn + 384; float* red = kn + 384;
  const int tid = TIDX;
  for (int r = BIDX; r < MR; r += gridDim.x) {
    int mj, t, tlen, r0; rowinfo(r, mj, t, tlen, r0);
    const bf16_t* P = (const bf16_t*)(p.ws + OFF_P) + (size_t)r * NINP;
    __syncthreads();
    if (tid < 192) pq[tid] = bf2f(P[PC_Q + tid]);
    if (tid < 128) pkv[tid] = bf2f(P[PC_KV + tid]);
    if (tid < 32) pkr[tid] = bf2f(P[PC_KR + tid]);
    __syncthreads();
    if (tid < 64) { float s = 0; for (int k = tid; k < 192; k += 64) s += pq[k] * pq[k]; s = wave_sum(s); if (tid == 0) red[0] = rsqrtf(s / 192.f + EPS); }
    else if (tid < 128) { float s = 0; for (int k = tid - 64; k < 128; k += 64) s += pkv[k] * pkv[k]; s = wave_sum(s); if (tid == 64) red[1] = rsqrtf(s / 128.f + EPS); }
    __syncthreads();
    const float rq = red[0], rkv = red[1];
    const float* wuq = p.w_uq + (size_t)l * 192 * 384; const float* qan = p.q_a_norm + l * 192;
    const float* wukv = p.w_ukv + (size_t)l * 128 * 512; const float* kvan = p.kv_a_norm + l * 128;
    if (tid < 384) { float a = 0; for (int k = 0; k < 192; ++k) a += pq[k] * rq * qan[k] * wuq[k * 384 + tid]; qraw[tid] = a; }
    { float a = 0; for (int k = 0; k < 128; ++k) a += pkv[k] * rkv * kvan[k] * wukv[k * 512 + tid]; kvraw[tid] = a; }
    __syncthreads();
    const float* qnw = p.q_norm + l * 96; const float* knw = p.k_norm + l * 96;
    if (tid < 384) {
      int h = tid / 96, d = tid % 96;
      float sq = 0, sk = 0;
      for (int dd = 0; dd < 96; ++dd) { float a = qraw[h * 96 + dd]; sq += a * a; float b = dd < 64 ? kvraw[h * 128 + dd] : pkr[dd - 64]; sk += b * b; }
      float kval = d < 64 ? kvraw[h * 128 + d] : pkr[d - 64];
      qn[tid] = qraw[tid] * rsqrtf(sq / 96.f + EPS) * qnw[d];
      kn[tid] = kval * rsqrtf(sk / 96.f + EPS) * knw[d];
    }
    __syncthreads();
    const bool lat = r < ML; const int b = lat ? (r >> 13) : ((r - ML) >> 8); const int pos = lat ? TC + t : t;
    bf16_t* Q = (bf16_t*)(p.ws + OFF_QKV); bf16_t* Kb = Q + QK_ELEMS; bf16_t* Vb = Kb + QK_ELEMS;
    {
      int h = tid >> 7, d = tid & 127;
      float qv = 0, kv = 0;
      if (d < 96) {
        qv = qn[h * 96 + d]; kv = kn[h * 96 + d];
        if (lat && d >= 64) {
          int part = (d - 64) >> 4, w = (d - 64) & 15, i = w & 7; bool first = w < 8;
          float posv = part == 0 ? (float)(t >> 6) : (float)(t & 63);
          float invf = powf(10000.f, -(float)i / 8.f);
          float ang = posv * invf, cs = cosf(ang), sn = sinf(ang);
          int i1 = h * 96 + 64 + part * 16 + i, i2 = i1 + 8;
          qv = first ? qn[i1] * cs - qn[i2] * sn : qn[i2] * cs + qn[i1] * sn;
          kv = first ? kn[i1] * cs - kn[i2] * sn : kn[i2] * cs + kn[i1] * sn;
        }
      }
      size_t o = ((size_t)(b * 4 + h) * TK + pos) * 128 + d;
      Q[o] = f2bf(qv); Kb[o] = f2bf(kv);
      if (d < 64) Vb[((size_t)(b * 4 + h) * TK + pos) * 64 + d] = f2bf(kvraw[h * 128 + 64 + d]);
    }
  }
}

__device__ __forceinline__ void ph_gdnprep(const Params& p, int l, float* lds) {
  const int TIDX = ltid(); const int BIDX = lbid();
  float* cv = lds; float* rs = lds + 1536;
  const int tid = TIDX;
  const bf16_t* P = (const bf16_t*)(p.ws + OFF_P);
  const float* cw = p.conv_w + (size_t)l * 3 * 1536;
  for (int r = BIDX; r < MR; r += gridDim.x) {
    int mj, t, tlen, r0; rowinfo(r, mj, t, tlen, r0);
    __syncthreads();
    for (int c = tid; c < 1536; c += NT) {
      float a = 0;
      for (int j = 0; j < 3; ++j) { int tt = t + j - 1; if (tt >= 0 && tt < tlen) a += cw[j * 1536 + c] * bf2f(P[(size_t)(r0 + tt) * NINP + PC_GQ + c]); }
      cv[c] = silu_f(a);
    }
    __syncthreads();
    if (tid < 8) { float s = 0; for (int d = 0; d < 128; ++d) { float v = cv[tid * 128 + d]; s += v * v; } rs[tid] = rsqrtf(s + EPS) * (tid < 4 ? 0.08838834764831845f : 1.f); }
    __syncthreads();
    float* G = (float*)(p.ws + OFF_RB) + (size_t)r * 1536;
    for (int c = tid; c < 1536; c += NT) G[c] = c < 1024 ? cv[c] * rs[c >> 7] : cv[c];
    if (tid < 8) {
      float* gb = (float*)(p.ws + OFF_GB) + (size_t)r * 16;
      float pa = bf2f(P[(size_t)r * NINP + PC_A + tid]), pb = bf2f(P[(size_t)r * NINP + PC_B + tid]);
      gb[tid] = -expf(p.a_log[l * 8 + tid]) * softplus_f(pa + p.dt_bias[l * 8 + tid]);
      gb[8 + tid] = sigmoid_f(pb);
    }
  }
}
__device__ __forceinline__ void ph_scan(const Params& p, float* lds) {
  const int TIDX = ltid(); const int BIDX = lbid();
  if (BIDX >= 16) return;
  float* sk = lds; float* sq = lds + 128; float* red = lds + 256; float* red2 = lds + 256 + 512;
  const int tid = TIDX, e = tid & 127, part = tid >> 7;
  const int chain = BIDX, dir = chain & 1, h = (chain >> 1) & 3, b = chain >> 3;
  const float* G = (const float*)(p.ws + OFF_RB); const float* GB = (const float*)(p.ws + OFF_GB);
  bf16_t* P = (bf16_t*)(p.ws + OFF_P);
  float S[32];
#pragma unroll
  for (int d = 0; d < 32; ++d) S[d] = 0.f;
  __syncthreads();
  for (int step = 0; step < TC + T; ++step) {
    int row;
    if (step < TC) row = ML + b * TC + (dir ? TC - 1 - step : step);
    else { int i = step - TC; row = b * T + (dir ? T - 1 - i : i); }
    const float* q = G + (size_t)row * 1536 + h * 128; const float* k = q + 512; const float v = q[1024 + e];
    if (tid < 128) sk[tid] = k[tid]; else if (tid < 256) sq[tid - 128] = q[tid - 128];
    const float g = GB[(size_t)row * 16 + dir * 4 + h], beta = GB[(size_t)row * 16 + 8 + dir * 4 + h];
    const float eg = expf(g);
    __syncthreads();
    float ks = 0;
#pragma unroll
    for (int d = 0; d < 32; ++d) ks += sk[part * 32 + d] * S[d];
    red[part * 128 + e] = ks;
    __syncthreads();
    ks = red[e] + red[128 + e] + red[256 + e] + red[384 + e];
    const float vn = beta * (v - eg * ks);
    float o = 0;
#pragma unroll
    for (int d = 0; d < 32; ++d) { S[d] = eg * S[d] + sk[part * 32 + d] * vn; o += sq[part * 32 + d] * S[d]; }
    red2[part * 128 + e] = o;
    __syncthreads();
    if (part == 0) P[(size_t)row * NINP + (dir ? PC_OB : PC_OF) + h * 128 + e] = f2bf(red2[e] + red2[128 + e] + red2[256 + e] + red2[384 + e]);
  }
  __syncthreads();
}
__device__ __forceinline__ void ph_attn(const Params& p, bool need_ctx, float* lds) {
  const int TIDX = ltid(); const int BIDX = lbid();
  float (*sK)[96] = (float (*)[96])lds; float (*sV)[64] = (float (*)[64])(lds + 32 * 96);
  const int tid = TIDX;
  const int nlat = NB * 4 * (T / NT), nitem = nlat + (need_ctx ? NB * 4 : 0);
  const bf16_t* Q = (const bf16_t*)(p.ws + OFF_QKV); const bf16_t* Kb = Q + QK_ELEMS; const bf16_t* Vb = Kb + QK_ELEMS;
  for (int it = gridDim.x - 1 - BIDX; it < nitem; it += gridDim.x) {
    const bool ctxq = it >= nlat;
    int b, h, qt;
    if (!ctxq) { qt = it % (T / NT); h = (it / (T / NT)) & 3; b = it / (4 * (T / NT)); } else { int j = it - nlat; qt = 0; h = j & 3; b = j >> 2; }
    const bool active = !ctxq || tid < TC;
    const int qpos = ctxq ? (active ? tid : 0) : TC + qt * NT + tid;
    const int nk = ctxq ? TC : TK;
    const size_t bh = (size_t)(b * 4 + h) * TK;
    float q[96], o[64];
#pragma unroll
    for (int d = 0; d < 96; ++d) q[d] = bf2f(Q[(bh + qpos) * 128 + d]);
#pragma unroll
    for (int d = 0; d < 64; ++d) o[d] = 0.f;
    float m = -1e30f, lsum = 0.f;
    const float scale = 0.10206207261596575f;
    for (int k0 = 0; k0 < nk; k0 += 32) {
      __syncthreads();
      for (int e = tid; e < 32 * 96; e += NT) { int j = e / 96, d = e % 96; sK[j][d] = bf2f(Kb[(bh + k0 + j) * 128 + d]); }
      for (int e = tid; e < 32 * 64; e += NT) { int j = e >> 6, d = e & 63; sV[j][d] = bf2f(Vb[(bh + k0 + j) * 64 + d]); }
      __syncthreads();
      for (int j = 0; j < 32; ++j) {
        float s = 0;
#pragma unroll
        for (int d = 0; d < 96; ++d) s += q[d] * sK[j][d];
        s *= scale;
        if (s > m) { float a = __expf(m - s); lsum *= a;
#pragma unroll
          for (int d = 0; d < 64; ++d) o[d] *= a;
          m = s; }
        float pe = __expf(s - m); lsum += pe;
#pragma unroll
        for (int d = 0; d < 64; ++d) o[d] += pe * sV[j][d];
      }
    }
    if (active) {
      const int row = ctxq ? ML + b * TC + qpos : b * T + (qpos - TC);
      bf16_t* cat = (bf16_t*)(p.ws + OFF_H) + (size_t)row * D + h * 64;
      float inv = 1.f / lsum;
#pragma unroll
      for (int d = 0; d < 64; ++d) cat[d] = f2bf(o[d] * inv);
    }
  }
}
__device__ __forceinline__ void ph_gdnfin_pool(const Params& p, int l, int nrows, float* lds) {
  const int TIDX = ltid(); const int BIDX = lbid();
  float* ov = lds; float* rs = lds + 512; float* dv = lds + 520;
  const int tid = TIDX;
  const bf16_t* P = (const bf16_t*)(p.ws + OFF_P);
  for (int r = BIDX; r < nrows; r += gridDim.x) {
    int mj, t, tlen, r0; rowinfo(r, mj, t, tlen, r0);
    bf16_t* cat = (bf16_t*)(p.ws + OFF_H) + (size_t)r * D;
    __syncthreads();
    ov[tid] = bf2f(P[(size_t)r * NINP + PC_OF + tid]) + bf2f(P[(size_t)r * NINP + PC_OB + tid]);
    if (tid < 256) {
      int c = tid, gi = c >> 6, win = 2 << gi;
      int lo = t - win / 2, hi = lo + win; lo = lo < 0 ? 0 : lo; hi = hi > tlen ? tlen : hi;
      float s = 0; for (int tt = lo; tt < hi; ++tt) s += bf2f(P[(size_t)(r0 + tt) * NINP + PC_POOL + c]);
      dv[c] = s / (float)(hi - lo) - bf2f(P[(size_t)r * NINP + PC_POOL + c]);
    }
    __syncthreads();
    if (tid < 4) { float s = 0; for (int d = 0; d < 128; ++d) { float v = ov[tid * 128 + d]; s += v * v; } rs[tid] = rsqrtf(s / 128.f + EPS); }
    __syncthreads();
    const float* gn = p.gdn_norm_g + l * 128;
    { int c = tid; float z = bf2f(P[(size_t)r * NINP + PC_Z + c]); cat[256 + c] = f2bf(ov[c] * rs[c >> 7] * gn[c & 127] * silu_f(z)); }
    if (tid < 256) {
      int j = tid, gi = j >> 6, dd = j & 63;
      const float* pw = p.pool_w + ((size_t)l * 4 + gi) * 64 * 64;
      float a = 0; for (int c = 0; c < 64; ++c) a += dv[gi * 64 + c] * pw[c * 64 + dd];
      cat[768 + j] = f2bf(a * p.pool_scale[l * 256 + j]);
    }
  }
}
__device__ __forceinline__ void ph_outproj(const Params& p, int l, int nrows, float* lds) {
  const int TIDX = ltid(); const int BIDX = lbid();
  const bf16_t* A = (const bf16_t*)(p.ws + OFF_H); const float* W = p.w_out + (size_t)l * D * D;
  const int ntn = D / 128, ntm = nrows / 64;
  for (int vb = BIDX; vb < ntn * ntm; vb += gridDim.x)
    ngemm_tile(lds, nrows, D, D, vb / ntn, vb % ntn,
               [&](int r, int k) { return bf2f(A[(size_t)r * D + k]); },
               [&](int k, int n) { return W[(size_t)k * D + n]; },
               [&](int r, int n, float v) { int mj = r < ML ? (r >> 13) : 2; xrow(p, r)[n] += modvec(p, l, mj, 2)[n] * v; });
}
__device__ __forceinline__ void ph_topk(const Params& p, int nseq) {
  const int TIDX = ltid(); const int BIDX = lbid();
  const size_t total = (size_t)nseq * NE * T;
  for (size_t i = (size_t)BIDX * NT + TIDX; i < total; i += (size_t)gridDim.x * NT) {
    const int t = (int)(i % T), e = (int)((i / T) % NE), s = (int)(i / ((size_t)T * NE));
    const int tlen = s < 2 ? T : TC, cap = s < 2 ? CAPL : CAPC, r0 = s < 2 ? s * T : ML + (s - 2) * TC;
    if (t >= tlen) continue;
    const float* a = (const float*)(p.ws + OFF_AFFT) + (size_t)e * MR + r0;
    const float me = a[t];
    int rank = 0;
    for (int u = 0; u < tlen; ++u) { float o = a[u]; rank += (o > me || (o == me && u < t)) ? 1 : 0; }
    int* slot = (int*)(p.ws + OFF_SLOT);
    if (rank < cap) { int pi = pair_base(s, e) + rank; ((int*)(p.ws + OFF_IDX))[pi] = r0 + t; ((float*)(p.ws + OFF_GATE))[pi] = me; slot[(size_t)(r0 + t) * 16 + e] = rank; }
    else slot[(size_t)(r0 + t) * 16 + e] = -1;
  }
}
__device__ __forceinline__ void ph_moe_gu(const Params& p, int l, int grp0, int grp1, float* lds) {
  const int TIDX = ltid(); const int BIDX = lbid();
  const bf16_t* H = (const bf16_t*)(p.ws + OFF_H);
  float* tmp = (float*)(p.ws + OFF_P);
  const int ntn = DEXP / 128, ntm = CAPL / 64, per = ntn * ntm;
  for (int vb = BIDX; vb < (grp1 - grp0) * per; vb += gridDim.x) {
    const int grp = grp0 + vb / per, tt = vb % per, tm = tt / ntn, tn = tt % ntn;
    const int s = grp >> 4, e = grp & 15; const int cap = s < 2 ? CAPL : CAPC;
    if (tm * 64 >= cap) continue;
    const int pb = pair_base(s, e);
    const int* idx = (const int*)(p.ws + OFF_IDX) + pb;
    const float* Wg = p.w_gate + ((size_t)l * NE + e) * D * DEXP; const float* Wu = p.w_up + ((size_t)l * NE + e) * D * DEXP;
    bf16_t* hid = (bf16_t*)(p.ws + OFF_HID) + (size_t)pb * DEXP;
    ngemm_tile(lds, cap, DEXP, D, tm, tn,
               [&](int r, int k) { return bf2f(H[(size_t)idx[r] * D + k]); },
               [&](int k, int n) { return Wg[(size_t)k * DEXP + n]; },
               [&](int r, int n, float v) { tmp[(size_t)(pb + r) * DEXP + n] = v; });
    ngemm_tile(lds, cap, DEXP, D, tm, tn,
               [&](int r, int k) { return bf2f(H[(size_t)idx[r] * D + k]); },
               [&](int k, int n) { return Wu[(size_t)k * DEXP + n]; },
               [&](int r, int n, float v) { float g = tmp[(size_t)(pb + r) * DEXP + n]; hid[(size_t)r * DEXP + n] = f2bf(silu_f(g) * v); });
  }
}
__device__ __forceinline__ void ph_moe_down(const Params& p, int l, int grp0, int grp1, float* lds) {
  const int TIDX = ltid(); const int BIDX = lbid();
  const int ntn = D / 128, ntm = CAPL / 64, per = ntn * ntm;
  for (int vb = BIDX; vb < (grp1 - grp0) * per; vb += gridDim.x) {
    const int grp = grp0 + vb / per, tt = vb % per, tm = tt / ntn, tn = tt % ntn;
    const int s = grp >> 4, e = grp & 15; const int cap = s < 2 ? CAPL : CAPC;
    if (tm * 64 >= cap) continue;
    const int pb = pair_base(s, e);
    const bf16_t* hid = (const bf16_t*)(p.ws + OFF_HID) + (size_t)pb * DEXP;
    const float* Wd = p.w_down + ((size_t)l * NE + e) * DEXP * D;
    const float* gate = (const float*)(p.ws + OFF_GATE) + pb;
    bf16_t* Y = (bf16_t*)(p.ws + OFF_Y) + (size_t)pb * D;
    ngemm_tile(lds, cap, D, DEXP, tm, tn,
               [&](int r, int k) { return bf2f(hid[(size_t)r * DEXP + k]); },
               [&](int k, int n) { return Wd[(size_t)k * D + n]; },
               [&](int r, int n, float v) { Y[(size_t)r * D + n] = f2bf(v * gate[r]); });
  }
}
__device__ __forceinline__ void ph_combine(const Params& p, int l, int nrows) {
  const int TIDX = ltid(); const int BIDX = lbid();
  const bf16_t* Y = (const bf16_t*)(p.ws + OFF_Y);
  for (int r = BIDX; r < nrows; r += gridDim.x) {
    int mj, t, tlen, r0; rowinfo(r, mj, t, tlen, r0);
    const int s = r < ML ? (r >> 13) : 2 + ((r - ML) >> 8);
    const int* slot = (const int*)(p.ws + OFF_SLOT) + (size_t)r * 16;
    const float* g2 = modvec(p, l, mj, 5);
    float* xr = xrow(p, r);
    for (int c = TIDX; c < D; c += NT) {
      float a = 0;
      for (int e = 0; e < 16; ++e) { int sl = slot[e]; if (sl >= 0) a += bf2f(Y[(size_t)(pair_base(s, e) + sl) * D + c]); }
      xr[c] += g2[c] * a;
    }
  }
}


__device__ __forceinline__ void transpose_cvt_tile(float* lds, const float* W, int ldw, int N, bf16_t* Wt, int K, int rmul, int roff, int tk, int tn, int tid, const float* kscale = nullptr) {
  __syncthreads();
#pragma unroll
  for (int i = 0; i < 8; ++i) { int e = tid + i * NT; int kk = e >> 6, nn = e & 63; int n = tn * 64 + nn; lds[kk * 65 + nn] = n < N ? W[(size_t)(tk * 64 + kk) * ldw + n] * (kscale ? kscale[tk * 64 + kk] : 1.f) : 0.f; }
  __syncthreads();
#pragma unroll
  for (int i = 0; i < 8; ++i) { int e = tid + i * NT; int nn = e >> 6, kk = e & 63; int n = tn * 64 + nn; if (n < N) Wt[(size_t)(n * rmul + roff) * K + tk * 64 + kk] = f2bf(lds[kk * 65 + nn]); }
}
__device__ __forceinline__ void transpose_cvt_4tiles(float* lds, const float* W, int ldw, int N, bf16_t* Wt, int K, int rmul, int roff, int t4, int ntiles, int tid, const float* kscale) {
  const int ntn = (N + 63) / 64;
  float v[4][8];
#pragma unroll
  for (int q = 0; q < 4; ++q) { const int t = t4 + q, tk = t / ntn, tn = t % ntn;
#pragma unroll
    for (int i = 0; i < 8; ++i) { const int el = tid + i * NT, kk = el >> 6, nn = el & 63, n = tn * 64 + nn;
      v[q][i] = (t < ntiles && n < N) ? W[(size_t)(tk * 64 + kk) * ldw + n] * (kscale ? kscale[tk * 64 + kk] : 1.f) : 0.f; } }
  __syncthreads();
#pragma unroll
  for (int q = 0; q < 4; ++q)
#pragma unroll
    for (int i = 0; i < 8; ++i) { const int el = tid + i * NT, kk = el >> 6, nn = el & 63; lds[q * 4160 + kk * 65 + nn] = v[q][i]; }
  __syncthreads();
#pragma unroll
  for (int q = 0; q < 4; ++q) { const int t = t4 + q, tk = t / ntn, tn = t % ntn;
#pragma unroll
    for (int i = 0; i < 4; ++i) { const int el = tid + i * NT, nn = el >> 5, k2 = (el & 31) * 2, n = tn * 64 + nn;
      if (t < ntiles && n < N) *(unsigned*)(Wt + (size_t)(n * rmul + roff) * K + tk * 64 + k2) = gd::pk(lds[q * 4160 + k2 * 65 + nn], lds[q * 4160 + (k2 + 1) * 65 + nn]); } }
}
__device__ __forceinline__ void ph_prep_weights(const Params& p, float* lds) {
  const int TIDX = ltid(); const int BIDX = lbid();
  bf16_t* winT = (bf16_t*)(p.ws + OFF_WINT); bf16_t* woutT = (bf16_t*)(p.ws + OFF_WOUTT);
  const int g_in = 2 * 168, g_out = 2 * 64, g_q = 2 * 5, g_kv = 2 * 4;
  for (int vb = BIDX; vb < g_in + g_out + g_q + g_kv; vb += gridDim.x) {
    if (vb < g_in) { const int l = vb / 168, r = vb % 168; transpose_cvt_4tiles(lds, p.w_in + (size_t)l * D * NIN, NIN, NIN, winT + (size_t)l * NINP * D, D, 1, 0, r * 4, 16 * 42, TIDX, nullptr); }
    else if (vb < g_in + g_out) { const int v = vb - g_in, l = v / 64, r = v % 64; transpose_cvt_4tiles(lds, p.w_out + (size_t)l * D * D, D, D, woutT + (size_t)l * D * D, D, 1, 0, r * 4, 256, TIDX, nullptr); }
    else if (vb < g_in + g_out + g_q) { const int v = vb - g_in - g_out, l = v / 5, r = v % 5;
      transpose_cvt_4tiles(lds, p.w_uq + (size_t)l * 192 * 384, 384, 384, (bf16_t*)(p.ws + OFF_WUP) + (size_t)l * 1024 * 256, 256, 1, 0, r * 4, 18, TIDX, p.q_a_norm + l * 192); }
    else { const int v = vb - g_in - g_out - g_q, l = v / 4, r = v % 4;
      transpose_cvt_4tiles(lds, p.w_ukv + (size_t)l * 128 * 512, 512, 512, (bf16_t*)(p.ws + OFF_WUP) + (size_t)l * 1024 * 256 + 512 * 256, 256, 1, 0, r * 4, 16, TIDX, p.kv_a_norm + l * 128); }
  }
  for (int q = 0; q < 16; ++q) {
    const int i = (q * (int)gridDim.x + BIDX) * NT + TIDX; if (i >= 2 * 1024 * 256) break;
    const int k = i & 255, n = (i >> 8) & 1023;
    if ((n < 384 && k >= 192) || (n >= 384 && n < 512) || (n >= 512 && k >= 128)) ((bf16_t*)(p.ws + OFF_WUP))[i] = 0;
  }
  for (size_t i = (size_t)BIDX * NT + TIDX; i < (size_t)2 * (NINP - NIN) * D; i += (size_t)gridDim.x * NT) {
    const int l = (int)(i / ((size_t)(NINP - NIN) * D)); const size_t r = i % ((size_t)(NINP - NIN) * D);
    winT[(size_t)l * NINP * D + (size_t)NIN * D + r] = 0;
  }
}
__device__ __forceinline__ void ph_inproj_fast(const Params& p, int l, char* smem) {
  DenseSched S; S.init(MR / 256, NINP / 256, (int)gridDim.x, lbid());
  S.A = p.ws + OFF_H; S.Bt = p.ws + OFF_WINT + (size_t)l * NINP * D * 2; S.lda = D; S.ldb = D; S.K = D;
  EpiStoreBf16 E; E.O = (bf16_t*)(p.ws + OFF_P); E.ldc = NINP;
  pg8::gemm_phase(( PG8_LAS unsigned char*)smem, S, E);
}

__device__ __forceinline__ void ph_outproj_fast(const Params& p, int l, char* smem) {
  DenseSched S; S.init(ML / 256, D / 256, (int)gridDim.x, lbid());
  S.A = p.ws + OFF_H; S.Bt = p.ws + OFF_WOUTT + (size_t)l * D * D * 2; S.lda = D; S.ldb = D; S.K = D;
  EpiStoreBf16 E; E.O = (bf16_t*)(p.ws + OFF_YO); E.ldc = D;
  pg8::gemm_phase((PG8_LAS unsigned char*)smem, S, E);
}

__device__ __forceinline__ void ph_prep_moe_weights(const Params& p, int l, float* lds, int b0, int nb) {
  const int TIDX = ltid(); const int BIDX = lbid() - b0;
  if (BIDX < 0) return;
  bf16_t* gu = (bf16_t*)(p.ws + OFF_MOEGU); bf16_t* dn = (bf16_t*)(p.ws + OFF_MOED);
  unsigned* ctr = (unsigned*)(p.ws + OFF_BAR) + 16 + l; volatile int* bc = (volatile int*)(lds + 4 * 4160);
  __syncthreads();
  if (TIDX == 0) bc[0] = (int)__hip_atomic_fetch_add(ctr, 1u, __ATOMIC_RELAXED, __HIP_MEMORY_SCOPE_AGENT);
  __syncthreads();
  int vb = __builtin_amdgcn_readfirstlane(bc[0]);
  for (int it = 1; ; ++it) {
    if (vb >= NE * 3 * 32) break;
    const int e = vb / 96, r = vb % 96, which = r >> 5, t4 = (r & 31) * 4;
    const float* W; int ldw, K, rmul, roff; bf16_t* Wt;
    if (which < 2) { W = (which ? p.w_up : p.w_gate) + ((size_t)l * NE + e) * D * DEXP; ldw = DEXP; K = D; rmul = 2; roff = which; Wt = gu + (size_t)e * D * D; }
    else { W = p.w_down + ((size_t)l * NE + e) * DEXP * D; ldw = D; K = DEXP; rmul = 1; roff = 0; Wt = dn + (size_t)e * D * DEXP; }
    const int ntn = ldw / 64;
    float v[4][8];
#pragma unroll
    for (int q = 0; q < 4; ++q) { const int t = t4 + q, tk = t / ntn, tn = t % ntn;
#pragma unroll
      for (int i = 0; i < 8; ++i) { const int el = TIDX + i * NT, kk = el >> 6, nn = el & 63; v[q][i] = __builtin_nontemporal_load(&W[(size_t)(tk * 64 + kk) * ldw + tn * 64 + nn]); } }
    if (TIDX == 0) bc[it & 1] = (int)__hip_atomic_fetch_add(ctr, 1u, __ATOMIC_RELAXED, __HIP_MEMORY_SCOPE_AGENT);
    __syncthreads();
#pragma unroll
    for (int q = 0; q < 4; ++q)
#pragma unroll
      for (int i = 0; i < 8; ++i) { const int el = TIDX + i * NT, kk = el >> 6, nn = el & 63; lds[q * 4160 + kk * 65 + nn] = v[q][i]; }
    __syncthreads();
#pragma unroll
    for (int q = 0; q < 4; ++q) { const int t = t4 + q, tk = t / ntn, tn = t % ntn;
#pragma unroll
      for (int i = 0; i < 4; ++i) { const int el = TIDX + i * NT, nn = el >> 5, k2 = (el & 31) * 2;
        const unsigned w = gd::pk(lds[q * 4160 + k2 * 65 + nn], lds[q * 4160 + (k2 + 1) * 65 + nn]);
        *(unsigned*)(Wt + (size_t)((tn * 64 + nn) * rmul + roff) * K + tk * 64 + k2) = w; } }
    vb = __builtin_amdgcn_readfirstlane(bc[it & 1]);
  }
}
__device__ __forceinline__ void ph_gather(const Params& p) {
  const int TIDX = ltid(); const int BIDX = lbid();
  const int lane = TIDX & 63, wv = TIDX >> 6;
  const int* idx = (const int*)(p.ws + OFF_IDX);
  const uint4* H = (const uint4*)(p.ws + OFF_H); uint4* xs = (uint4*)(p.ws + OFF_XS);
  for (int r = BIDX * 8 + wv; r < NB * NE * CAPL; r += gridDim.x * 8) {
    const int src = idx[r];
    const uint4 a = H[(size_t)src * 128 + lane], b = H[(size_t)src * 128 + 64 + lane];
    xs[(size_t)r * 128 + lane] = a; xs[(size_t)r * 128 + 64 + lane] = b;
  }
}
__device__ __forceinline__ void ph_moe_gu_fast(const Params& p, char* smem) {
  MoeSched S; S.init(NB * NE * CAPL / 256, 2 * DEXP / 256, (int)gridDim.x, lbid());
  S.A = p.ws + OFF_H; S.Bt = p.ws + OFF_MOEGU; S.lda = D; S.ldb = D; S.K = D; S.bstride = (size_t)D * D * 2; S.gidx = (const int*)(p.ws + OFF_IDX); S.gather = true;
  EpiSwiGLU E; E.O = (bf16_t*)(p.ws + OFF_HID);
  pg8::gemm_phase<EpiSwiGLU, MoeSched, true>((PG8_LAS unsigned char*)smem, S, E);
}
__device__ __forceinline__ void ph_moe_down_fast(const Params& p, char* smem) {
  MoeSched S; S.init(NB * NE * CAPL / 256, D / 256, (int)gridDim.x, lbid());
  S.A = p.ws + OFF_HID; S.Bt = p.ws + OFF_MOED; S.lda = DEXP; S.ldb = DEXP; S.K = DEXP; S.bstride = (size_t)D * DEXP * 2; S.gidx = nullptr; S.gather = false;
  EpiGateBf16 E; E.O = (bf16_t*)(p.ws + OFF_Y); E.gate = (const float*)(p.ws + OFF_GATE);
  pg8::gemm_phase((PG8_LAS unsigned char*)smem, S, E);
}

__device__ __forceinline__ void attn_ctx_item(const Params& p, int j, char* smem) {
  const bf16_t* Q = (const bf16_t*)(p.ws + OFF_QKV); const bf16_t* Kb = Q + QK_ELEMS; const bf16_t* Vb = Kb + QK_ELEMS;
  const int h = j & 3, b = j >> 2; const size_t bh = (size_t)(b * 4 + h) * TK;
  fa::attn_body(Q + bh * 128, Kb + bh * 128, Vb + bh * 64, (bf16_t*)(p.ws + OFF_H) + (size_t)(ML + b * TC) * D + h * 64, D, TC, smem);
}
__device__ __forceinline__ void attn_seg(const Params& p, int x, int qt, int off, int len, char* smem) {
  const bf16_t* Q = (const bf16_t*)(p.ws + OFF_QKV); const bf16_t* Kb = Q + QK_ELEMS; const bf16_t* Vb = Kb + QK_ELEMS;
  const int h = x & 3, b = x >> 2, part = off == 0 ? 0 : 1, kv0 = off * 128;
  const size_t bh = (size_t)(b * 4 + h) * TK; const int row0 = b * T + qt * 256;
  bf16_t* op = (bf16_t*)(p.ws + OFF_OPART) + ((size_t)part * ML + row0) * 256 + h * 64;
  float* ml = (float*)(p.ws + OFF_MLPART) + (((size_t)part * ML + row0) * 4 + h) * 2;
  fa::attn_body(Q + (bh + TC + qt * 256) * 128, Kb + (bh + kv0) * 128, Vb + (bh + kv0) * 64, op, 256, len * 128, smem, ml, 8);
  if (off == 0 && len == TK / 128) {
    const int t = ltid();
    if (t < 256) *(float2*)((float*)(p.ws + OFF_MLPART) + (((size_t)ML + row0 + t) * 4 + h) * 2) = make_float2(-1e30f, 0.f);
  }
}
__device__ __forceinline__ void ph_attn_fast(const Params& p, bool need_ctx, char* smem) {
  const int BIDX = lbid();
  const int nns = (int)gridDim.x - 32;
  if (BIDX >= 32) {
    const int x = BIDX & 7, j = (BIDX - 32) >> 3, nj = nns >> 3;
    constexpr int PPQ = TK / 128, NPAIRS = 32 * PPQ;
    const int hi = (NPAIRS * (j + 1)) / nj;
    for (int cur = (NPAIRS * j) / nj; cur < hi; ) {
      const int qt = cur / PPQ, off = cur - qt * PPQ, len = min(PPQ - off, hi - cur);
      attn_seg(p, x, qt, off, len, smem);
      cur += len;
    }
    if (need_ctx && j == nj - 1) attn_ctx_item(p, x, smem);
  }
}

__device__ __forceinline__ void ph_gdn_precompute(const Params& p, int l, char* smem) {
  const int TIDX = ltid(); const int BIDX = lbid();
  __syncthreads();
  { const float* cw = p.conv_w + (size_t)l * 3 * 1536; float* cwl = (float*)(smem + gd::L_CW);
    for (int i = TIDX; i < 3 * 1536 / 4; i += NT) ((float4*)cwl)[i] = ((const float4*)cw)[i]; }
  const int nit = NB * 4 * gd::NCH;
  for (int it = BIDX; it < nit; it += gridDim.x) {
    const int c = it % gd::NCH, bh = it / gd::NCH;
    uint4 cur[3][4];
    gd::precompute_load(p, bh >> 2, bh & 3, c, TIDX, cur);
    gd::precompute_item(p, l, bh >> 2, bh & 3, c, smem, TIDX, cur);
  }
  __syncthreads();
}
__device__ __forceinline__ void ph_scan_fast(const Params& p, char* smem) {
  const int TIDX = ltid(); const int BIDX = lbid();
  if (BIDX < 32) gd::scan_unit_lds(p, (((BIDX & 7) + 8 * (BIDX >> 4)) << 1) | ((BIDX >> 3) & 1), smem, TIDX);
}

struct MlaSched : pg8::GridOrder {
  const char* P; const char* W; int lda, ldb, K; const int* gidx;
  __device__ __forceinline__ const char* a_ptr(const pg8::Unit& u) const { return P + (size_t)u.pm * 256 * NINP * 2 + (u.pn < 2 ? PC_Q : PC_KV) * 2; }
  __device__ __forceinline__ const char* b_ptr(const pg8::Unit& u) const { return W + (size_t)u.pn * 256 * 256 * 2; }
};
__device__ __forceinline__ void ph_mla_gemm(const Params& p, int l, char* smem) {
  if (lbid() < 32) return;
  MlaSched S; S.init(MR / 256, 4, (int)gridDim.x - 32, lbid() - 32);
  S.P = p.ws + OFF_P; S.W = p.ws + OFF_WUP + (size_t)l * 1024 * 256 * 2; S.lda = NINP; S.ldb = 256; S.K = 256; S.gidx = nullptr;
  EpiStoreBf16 E; E.O = (bf16_t*)(p.ws + OFF_UPRAW); E.ldc = 1024;
  pg8::gemm_phase((PG8_LAS unsigned char*)smem, S, E);
}
__device__ __forceinline__ void ph_mla_finish(const Params& p, int l, float* lds) {
  const int TIDX = ltid(); const int BIDX = lbid();
  const int lane = TIDX & 63, wv = TIDX >> 6, h = lane >> 4, j = lane & 15;
  const bf16_t* P = (const bf16_t*)(p.ws + OFF_P); const bf16_t* RAW = (const bf16_t*)(p.ws + OFF_UPRAW);
  bf16_t* Qo = (bf16_t*)(p.ws + OFF_QKV); bf16_t* Ko = Qo + QK_ELEMS; bf16_t* Vo = Ko + QK_ELEMS;
  __syncthreads();
  for (int i = TIDX; i < 128 * 8; i += NT) { const int a = i >> 3, e = i & 7; const float ang = (float)a * __builtin_amdgcn_exp2f(-(float)e * 1.6609640474436813f);
    lds[a * 16 + e] = __cosf(ang); lds[a * 16 + 8 + e] = __sinf(ang); }
  __syncthreads();
  float qw8[8], kw8[8], kwr8[8];
#pragma unroll
  for (int e = 0; e < 8; ++e) { qw8[e] = j < 12 ? p.q_norm[l * 96 + j * 8 + e] : 0.f; kw8[e] = j < 8 ? p.k_norm[l * 96 + j * 8 + e] : 0.f; kwr8[e] = p.k_norm[l * 96 + 64 + (lane & 3) * 8 + e]; }
  const bool ropel = j >= 8 && j < 12, first = (j & 1) == 0;
#define MF_UNPACK(dst, U4) do { dst[0] = __uint_as_float((U4).x << 16); dst[1] = __uint_as_float((U4).x & 0xffff0000u); dst[2] = __uint_as_float((U4).y << 16); dst[3] = __uint_as_float((U4).y & 0xffff0000u); \
    dst[4] = __uint_as_float((U4).z << 16); dst[5] = __uint_as_float((U4).z & 0xffff0000u); dst[6] = __uint_as_float((U4).w << 16); dst[7] = __uint_as_float((U4).w & 0xffff0000u); } while (0)
#define MF_PACK(src) make_uint4(gd::pk(src[0], src[1]), gd::pk(src[2], src[3]), gd::pk(src[4], src[5]), gd::pk(src[6], src[7]))
  for (int r2 = (BIDX + gridDim.x * wv) * 2; r2 < MR; r2 += gridDim.x * 8 * 2)
#pragma unroll
  for (int rr = 0; rr < 2; ++rr) { const int r = r2 + rr;
    const bool lat = r < ML; const int b = lat ? (r >> 13) : ((r - ML) >> 8), t = lat ? (r & (T - 1)) : ((r - ML) & (TC - 1)), pos = lat ? TC + t : t;
    const bf16_t* Pr = P + (size_t)r * NINP; const bf16_t* Rr = RAW + (size_t)r * 1024;
    const uint4 zero4 = make_uint4(0u, 0u, 0u, 0u);
    const uint4 q4 = j < 12 ? *(const uint4*)(Rr + h * 96 + j * 8) : zero4;
    const uint4 k4 = *(const uint4*)(Rr + 512 + h * 128 + j * 8);
    const bf16_t* pp = lane < 24 ? Pr + PC_Q + lane * 8 : (lane < 40 ? Pr + PC_KV + (lane - 24) * 8 : Pr + PC_KR + (lane - 40) * 8);
    const uint4 p4 = lane < 44 ? *(const uint4*)pp : zero4;
    float xq[8], xk[8], xp[8];
    MF_UNPACK(xq, q4); MF_UNPACK(xk, k4); MF_UNPACK(xp, p4);
    float sp = 0.f, sq = 0.f, sk = 0.f;
#pragma unroll
    for (int e = 0; e < 8; ++e) { sp += xp[e] * xp[e]; sq += xq[e] * xq[e]; sk += xk[e] * xk[e]; }
    if (j >= 8) sk = 0.f;
    sp += __shfl_xor(sp, 1); sp += __shfl_xor(sp, 2); sp += __shfl_xor(sp, 4);
    const float g0 = __builtin_amdgcn_readlane(sp, 0), g1 = __builtin_amdgcn_readlane(sp, 8), g2 = __builtin_amdgcn_readlane(sp, 16), g3 = __builtin_amdgcn_readlane(sp, 24), g4 = __builtin_amdgcn_readlane(sp, 32), skr = __builtin_amdgcn_readlane(sp, 40);
    const float rq = rsqrtf((g0 + g1 + g2) / 192.f + EPS), rkv = rsqrtf((g3 + g4) / 128.f + EPS);
    sq += __shfl_xor(sq, 1); sq += __shfl_xor(sq, 2); sq += __shfl_xor(sq, 4); sq += __shfl_xor(sq, 8);
    sk += __shfl_xor(sk, 1); sk += __shfl_xor(sk, 2); sk += __shfl_xor(sk, 4); sk += __shfl_xor(sk, 8);
    const float sc = rq * rsqrtf(rq * rq * sq / 96.f + EPS);
    const float sck = rsqrtf((rkv * rkv * sk + skr) / 96.f + EPS);
    const int aq = j < 10 ? (t >> 6) : (t & 63);
    float cs[8], sn[8];
    { const float4 c0 = *(const float4*)(lds + aq * 16), c1 = *(const float4*)(lds + aq * 16 + 4), s0 = *(const float4*)(lds + aq * 16 + 8), s1 = *(const float4*)(lds + aq * 16 + 12);
      cs[0] = c0.x; cs[1] = c0.y; cs[2] = c0.z; cs[3] = c0.w; cs[4] = c1.x; cs[5] = c1.y; cs[6] = c1.z; cs[7] = c1.w;
      sn[0] = s0.x; sn[1] = s0.y; sn[2] = s0.z; sn[3] = s0.w; sn[4] = s1.x; sn[5] = s1.y; sn[6] = s1.z; sn[7] = s1.w; }
    const size_t ob = (size_t)(b * 4 + h) * TK + pos;
    { float y[8];
#pragma unroll
      for (int e = 0; e < 8; ++e) { y[e] = xq[e] * sc * qw8[e]; const float o = __shfl_xor(y[e], 1);
        if (lat && ropel) y[e] = first ? y[e] * cs[e] - o * sn[e] : y[e] * cs[e] + o * sn[e]; }
      if (j < 12) *(uint4*)(Qo + ob * 128 + j * 8) = MF_PACK(y); }
    { float z[8], kk[8];
#pragma unroll
      for (int e = 0; e < 8; ++e) { z[e] = xp[e] * kwr8[e]; const float o = __shfl_xor(z[e], 1);
        if (lat) z[e] = first ? z[e] * cs[e] - o * sn[e] : z[e] * cs[e] + o * sn[e];
        const float zr = __shfl(z[e], 40 + (lane & 3));
        kk[e] = j < 8 ? xk[e] * rkv * sck * kw8[e] : zr * sck; }
      if (j < 12) *(uint4*)(Ko + ob * 128 + j * 8) = MF_PACK(kk); }
    { float vv[8];
#pragma unroll
      for (int e = 0; e < 8; ++e) vv[e] = xk[e] * rkv;
      if (j >= 8) *(uint4*)(Vo + ob * 64 + (j - 8) * 8) = MF_PACK(vv); }
  }
#undef MF_UNPACK
#undef MF_PACK
}
constexpr int POOL_ROWB = 144, POOL_TILEB = 64 * POOL_ROWB;
template <int H>
__device__ __forceinline__ void pool_unit(const Params& p, int l, int tile, int gi, char* Dw, const char* WTl, int lane) {
  typedef unsigned u2 __attribute__((ext_vector_type(2)));
  using bf16x8 = fa::bf16x8; using f32x16 = fa::f32x16;
  const int r_first = tile * 64;
  int r0, tlen;
  if (r_first < ML) { r0 = r_first & ~(T - 1); tlen = T; } else { r0 = ML + ((r_first - ML) & ~(TC - 1)); tlen = TC; }
  const int cq = lane & 15, tb = lane >> 4, tbase = r_first - r0 + tb * 16;
  const bf16_t* Pg = (const bf16_t*)(p.ws + OFF_P) + (size_t)r0 * NINP + PC_POOL + gi * 64 + cq * 4;
  constexpr int NR = 15 + 2 * H;
  u2 xs[NR];
#pragma unroll
  for (int j = 0; j < NR; ++j) { const int tt = tbase - H + j; xs[j] = (tt >= 0 && tt < tlen) ? *(const u2*)(Pg + (size_t)tt * NINP) : (u2){0u, 0u}; }
#define PL_LO(w) __uint_as_float((w) << 16)
#define PL_HI(w) __uint_as_float((w) & 0xffff0000u)
  float s0 = 0.f, s1 = 0.f, s2 = 0.f, s3 = 0.f;
#pragma unroll
  for (int j = 0; j < 2 * H; ++j) { s0 += PL_LO(xs[j].x); s1 += PL_HI(xs[j].x); s2 += PL_LO(xs[j].y); s3 += PL_HI(xs[j].y); }
  char* drow = Dw + (tb * 16) * POOL_ROWB + cq * 8;
#pragma unroll
  for (int i = 0; i < 16; ++i) {
    const int t = tbase + i; const int lo = t - H < 0 ? 0 : t - H, hi = t + H > tlen ? tlen : t + H;
    const float inv = 1.f / (float)(hi - lo);
    const u2 c = xs[i + H];
    u2 w; w.x = gd::pk(s0 * inv - PL_LO(c.x), s1 * inv - PL_HI(c.x)); w.y = gd::pk(s2 * inv - PL_LO(c.y), s3 * inv - PL_HI(c.y));
    *(u2*)(drow + i * POOL_ROWB) = w;
    if (i < 15) { const u2 a = xs[i + 2 * H], b = xs[i];
      s0 += PL_LO(a.x) - PL_LO(b.x); s1 += PL_HI(a.x) - PL_HI(b.x); s2 += PL_LO(a.y) - PL_LO(b.y); s3 += PL_HI(a.y) - PL_HI(b.y); }
  }
#undef PL_LO
#undef PL_HI
  asm volatile("s_waitcnt lgkmcnt(0)" ::: "memory");
  const int r32 = lane & 31, hl = lane >> 5;
  f32x16 acc[2][2];
#pragma unroll
  for (int a = 0; a < 2; ++a)
#pragma unroll
    for (int b = 0; b < 2; ++b)
#pragma unroll
      for (int i = 0; i < 16; ++i) acc[a][b][i] = 0.f;
#pragma unroll
  for (int ks = 0; ks < 4; ++ks) {
    const bf16x8 a0 = *(const bf16x8*)(WTl + r32 * POOL_ROWB + ks * 32 + hl * 16), a1 = *(const bf16x8*)(WTl + (32 + r32) * POOL_ROWB + ks * 32 + hl * 16);
    const bf16x8 b0 = *(const bf16x8*)(Dw + r32 * POOL_ROWB + ks * 32 + hl * 16), b1 = *(const bf16x8*)(Dw + (32 + r32) * POOL_ROWB + ks * 32 + hl * 16);
    acc[0][0] = __builtin_amdgcn_mfma_f32_32x32x16_bf16(a0, b0, acc[0][0], 0, 0, 0); acc[0][1] = __builtin_amdgcn_mfma_f32_32x32x16_bf16(a0, b1, acc[0][1], 0, 0, 0);
    acc[1][0] = __builtin_amdgcn_mfma_f32_32x32x16_bf16(a1, b0, acc[1][0], 0, 0, 0); acc[1][1] = __builtin_amdgcn_mfma_f32_32x32x16_bf16(a1, b1, acc[1][1], 0, 0, 0);
  }
  const float* psc = p.pool_scale + l * 256 + gi * 64 + 4 * hl;
  bf16_t* cat = (bf16_t*)(p.ws + OFF_H) + (size_t)(r_first + r32) * D + 768 + gi * 64 + 4 * hl;
#pragma unroll
  for (int mt = 0; mt < 2; ++mt)
#pragma unroll
    for (int q = 0; q < 4; ++q) {
      const float4 s4 = *(const float4*)(psc + mt * 32 + q * 8);
#pragma unroll
      for (int nt = 0; nt < 2; ++nt) {
        u2 w; w.x = gd::pk(acc[mt][nt][4 * q] * s4.x, acc[mt][nt][4 * q + 1] * s4.y); w.y = gd::pk(acc[mt][nt][4 * q + 2] * s4.z, acc[mt][nt][4 * q + 3] * s4.w);
        *(u2*)(cat + (size_t)(nt * 32) * D + mt * 32 + q * 8) = w;
      }
    }
  asm volatile("s_waitcnt lgkmcnt(0)" ::: "memory");
}
__device__ __forceinline__ void ph_pool_mfma(const Params& p, int l, int nrows, char* smem) {
  const int TIDX = ltid(); const int BIDX = lbid();
  const int lane = TIDX & 63, wv = TIDX >> 6;
  const int gi = BIDX & 3;
  __syncthreads();
  {
    const float4* W = (const float4*)(p.pool_w + ((size_t)l * 4 + gi) * 4096);
    for (int i = TIDX; i < 1024; i += NT) { const float4 w = W[i]; const int c = i >> 4, o4 = (i & 15) * 4;
      bf16_t* dst = (bf16_t*)(smem + o4 * POOL_ROWB) + c;
      dst[0] = f2bf(w.x); dst[POOL_ROWB / 2] = f2bf(w.y); dst[POOL_ROWB] = f2bf(w.z); dst[3 * POOL_ROWB / 2] = f2bf(w.w); }
  }
  __syncthreads();
  char* Dw = smem + POOL_TILEB + wv * POOL_TILEB;
  const int ntiles = nrows >> 6;
  for (int tile = wv * ((int)gridDim.x >> 2) + (BIDX >> 2); tile < ntiles; tile += 8 * ((int)gridDim.x >> 2)) {
    if (gi == 0) pool_unit<1>(p, l, tile, 0, Dw, smem, lane); else if (gi == 1) pool_unit<2>(p, l, tile, 1, Dw, smem, lane);
    else if (gi == 2) pool_unit<4>(p, l, tile, 2, Dw, smem, lane); else pool_unit<8>(p, l, tile, 3, Dw, smem, lane);
  }
}
template <int MODE>
__device__ __forceinline__ void ph_gdnfin_pool_fast(const Params& p, int l, int nrows, float* lds, int b0, int nb) {
  const int TIDX = ltid(); const int BIDX = lbid() - b0;
  if (BIDX < 0) return;
  const int lane = TIDX & 63, wv = TIDX >> 6;
  float* Wl = lds; float* dsc = lds + 16384 + wv * 256;
  if (MODE == 1) {
    __syncthreads();
    for (int i = TIDX; i < 4096; i += NT) ((float4*)Wl)[i] = ((const float4*)(p.pool_w + (size_t)l * 16384))[i];
    __syncthreads();
  }
  const bf16_t* P = (const bf16_t*)(p.ws + OFF_P);
  const float* gn = p.gdn_norm_g + l * 128; const float* psc = p.pool_scale + l * 256;
  for (int r = BIDX + nb * wv; r < nrows; r += nb * 8) {
    int mj, t, tlen, r0; rowinfo(r, mj, t, tlen, r0);
    bf16_t* cat = (bf16_t*)(p.ws + OFF_H) + (size_t)r * D;
    const bf16_t* Pr = P + (size_t)r * NINP;
    if (MODE == 2 && r < ML) {
      const int hh = lane >> 4;
      float mp[2], lp[2], mx = -1e30f;
#pragma unroll
      for (int q = 0; q < 2; ++q) { const float2 ml = *(const float2*)((const float*)(p.ws + OFF_MLPART) + (((size_t)q * ML + r) * 4 + hh) * 2); mp[q] = ml.x; lp[q] = ml.y; mx = fmaxf(mx, ml.x); }
      float acc4[4] = {0.f, 0.f, 0.f, 0.f}, wsum = 0.f;
#pragma unroll
      for (int q = 0; q < 2; ++q) { const float w = lp[q] * __expf((mp[q] - mx) * fa::SCALE); wsum += w;
        const uint2 o = *(const uint2*)((const bf16_t*)(p.ws + OFF_OPART) + ((size_t)q * ML + r) * 256 + lane * 4);
        acc4[0] += w * __uint_as_float(o.x << 16); acc4[1] += w * __uint_as_float(o.x & 0xffff0000u); acc4[2] += w * __uint_as_float(o.y << 16); acc4[3] += w * __uint_as_float(o.y & 0xffff0000u); }
      const float inv = 1.f / wsum;
      uint2 w2; w2.x = gd::pk(acc4[0] * inv, acc4[1] * inv); w2.y = gd::pk(acc4[2] * inv, acc4[3] * inv);
      *(uint2*)(cat + lane * 4) = w2;
    }
    if (MODE == 2) {
      const uint4 a = *(const uint4*)(Pr + PC_OF + lane * 8), bq = *(const uint4*)(Pr + PC_OB + lane * 8), z = *(const uint4*)(Pr + PC_Z + lane * 8);
      const unsigned aw[4] = {a.x, a.y, a.z, a.w}, bw[4] = {bq.x, bq.y, bq.z, bq.w}, zw[4] = {z.x, z.y, z.z, z.w};
      float o[8], ss = 0.f;
#pragma unroll
      for (int i = 0; i < 4; ++i) { o[2 * i] = __uint_as_float(aw[i] << 16) + __uint_as_float(bw[i] << 16); o[2 * i + 1] = __uint_as_float(aw[i] & 0xffff0000u) + __uint_as_float(bw[i] & 0xffff0000u); }
#pragma unroll
      for (int i = 0; i < 8; ++i) ss += o[i] * o[i];
      ss += __shfl_xor(ss, 1); ss += __shfl_xor(ss, 2); ss += __shfl_xor(ss, 4); ss += __shfl_xor(ss, 8);
      const float rs = rsqrtf(ss / 128.f + EPS);
      float y[8];
#pragma unroll
      for (int i = 0; i < 4; ++i) { const float z0 = __uint_as_float(zw[i] << 16), z1 = __uint_as_float(zw[i] & 0xffff0000u);
        y[2 * i] = o[2 * i] * rs * gn[(lane & 15) * 8 + 2 * i] * silu_f(z0); y[2 * i + 1] = o[2 * i + 1] * rs * gn[(lane & 15) * 8 + 2 * i + 1] * silu_f(z1); }
      uint4 w; w.x = gd::pk(y[0], y[1]); w.y = gd::pk(y[2], y[3]); w.z = gd::pk(y[4], y[5]); w.w = gd::pk(y[6], y[7]);
      *(uint4*)(cat + 256 + lane * 8) = w;
    }
    if (MODE == 1) {
      const int gi = lane >> 4, win = 2 << gi;
      int lo = t - win / 2, hi = lo + win; lo = lo < 0 ? 0 : lo; hi = hi > tlen ? tlen : hi;
      float sm[4] = {0.f, 0.f, 0.f, 0.f};
      uint2 uw[16];
#pragma unroll
      for (int q = 0; q < 16; ++q) { const int tt = t - 8 + q; const bool ok = tt >= lo && tt < hi; uw[q] = ok ? *(const uint2*)(P + (size_t)(r0 + tt) * NINP + PC_POOL + lane * 4) : make_uint2(0u, 0u); }
#pragma unroll
      for (int q = 0; q < 16; ++q) { sm[0] += __uint_as_float(uw[q].x << 16); sm[1] += __uint_as_float(uw[q].x & 0xffff0000u); sm[2] += __uint_as_float(uw[q].y << 16); sm[3] += __uint_as_float(uw[q].y & 0xffff0000u); }
      const uint2 u = *(const uint2*)(Pr + PC_POOL + lane * 4); const float inv = 1.f / (float)(hi - lo);
      dsc[lane * 4 + 0] = sm[0] * inv - __uint_as_float(u.x << 16); dsc[lane * 4 + 1] = sm[1] * inv - __uint_as_float(u.x & 0xffff0000u);
      dsc[lane * 4 + 2] = sm[2] * inv - __uint_as_float(u.y << 16); dsc[lane * 4 + 3] = sm[3] * inv - __uint_as_float(u.y & 0xffff0000u);
      float4 acc = {0.f, 0.f, 0.f, 0.f};
      const float* wg = Wl + gi * 4096 + (lane & 15) * 4; const float* dg = dsc + gi * 64;
#pragma unroll 8
      for (int c = 0; c < 64; ++c) { const float dv = dg[c]; const float4 w4 = *(const float4*)(wg + c * 64); acc.x += dv * w4.x; acc.y += dv * w4.y; acc.z += dv * w4.z; acc.w += dv * w4.w; }
      const float4 s4 = *(const float4*)(psc + lane * 4);
      uint2 w; w.x = gd::pk(acc.x * s4.x, acc.y * s4.y); w.y = gd::pk(acc.z * s4.z, acc.w * s4.w);
      *(uint2*)(cat + 768 + lane * 4) = w;
    }
  }
}
__device__ __forceinline__ void ph_ada_fast(const Params& p, float* lds) {
  const int TIDX = ltid(); const int BIDX = lbid();
  const int cg = TIDX & 15, ksl = TIDX >> 4;
  for (int u = BIDX; u < 2 * 96; u += gridDim.x) {
    const int l = u / 96, n0 = (u % 96) * 64 + cg * 4;
    const float* w = p.ada_w + (size_t)l * D * 6144 + n0;
    float4 a0 = {0.f, 0.f, 0.f, 0.f}, a1 = a0, a2 = a0;
#pragma unroll 16
    for (int kk = 0; kk < 32; ++kk) { const int k = ksl * 32 + kk; typedef float f4v __attribute__((ext_vector_type(4))); const f4v w4 = __builtin_nontemporal_load((const f4v*)(w + (size_t)k * 6144));
      const float s0 = silu_f(p.c[k]), s1 = silu_f(p.c[D + k]), s2 = silu_f(p.c_ctx[k]);
      a0.x += s0 * w4.x; a0.y += s0 * w4.y; a0.z += s0 * w4.z; a0.w += s0 * w4.w;
      a1.x += s1 * w4.x; a1.y += s1 * w4.y; a1.z += s1 * w4.z; a1.w += s1 * w4.w;
      a2.x += s2 * w4.x; a2.y += s2 * w4.y; a2.z += s2 * w4.z; a2.w += s2 * w4.w; }
    __syncthreads();
    float4* red = (float4*)lds;
    red[(ksl * 3 + 0) * 16 + cg] = a0; red[(ksl * 3 + 1) * 16 + cg] = a1; red[(ksl * 3 + 2) * 16 + cg] = a2;
    __syncthreads();
    if (TIDX < 192) { const int j = TIDX / 64, c = TIDX % 64; const float* rf = lds;
      float a = p.ada_b[l * 6144 + (u % 96) * 64 + c];
      for (int q = 0; q < 32; ++q) a += rf[((q * 3 + j) * 16 + (c >> 2)) * 4 + (c & 3)];
      ((float*)(p.ws + OFF_MOD))[(size_t)(l * 3 + j) * 6144 + (u % 96) * 64 + c] = a; }
  }
}

__device__ __forceinline__ void ph_topk_fast(const Params& p, int nseq, char* smem) {
  const int TIDX = ltid(); const int BIDX = lbid();
  unsigned* keys = (unsigned*)smem;
  unsigned* hist = keys + 8192;
  unsigned* ctl = hist + 256;
  unsigned* scn = ctl + 8;
  for (int prob = BIDX; prob < nseq * NE; prob += gridDim.x) {
    const int s = prob >> 4, e = prob & 15;
    const int tlen = s < 2 ? T : TC, cap = s < 2 ? CAPL : CAPC, r0 = s < 2 ? s * T : ML + (s - 2) * TC;
    const float* a = (const float*)(p.ws + OFF_AFFT) + (size_t)e * MR + r0;
    __syncthreads();
    for (int i = TIDX; i < tlen; i += NT) keys[i] = __float_as_uint(a[i]);
    if (TIDX == 0) { ctl[0] = 0u; ctl[1] = (unsigned)cap; }
    __syncthreads();
    for (int pass = 0; pass < 4; ++pass) {
      const int shift = 24 - 8 * pass;
      if (TIDX < 256) hist[TIDX] = 0u;
      __syncthreads();
      const unsigned prefix = ctl[0], want = ctl[1];
      const unsigned himask = pass == 0 ? 0u : (0xffffffffu << (shift + 8));
      { unsigned cur = 0u, cnt = 0u;
        for (int i = TIDX; i < tlen; i += NT) { const unsigned k = keys[i];
          if ((k & himask) == prefix) { const unsigned dgt = (k >> shift) & 255u; if (dgt == cur) ++cnt; else { if (cnt) atomicAdd(&hist[cur], cnt); cur = dgt; cnt = 1u; } } }
        if (cnt) atomicAdd(&hist[cur], cnt); }
      __syncthreads();
      if (TIDX < 256) {
        const unsigned mine = hist[TIDX];
        unsigned inc = mine;
#pragma unroll
        for (int o = 1; o < 64; o <<= 1) { const unsigned n = __shfl_down(inc, o); if ((TIDX & 63) + o < 64) inc += n; }
        if ((TIDX & 63) == 0) scn[TIDX >> 6] = inc;
        __builtin_amdgcn_s_waitcnt(0);
      }
      __syncthreads();
      if (TIDX < 256) {
        const unsigned mine = hist[TIDX];
        unsigned inc = mine;
#pragma unroll
        for (int o = 1; o < 64; o <<= 1) { const unsigned n = __shfl_down(inc, o); if ((TIDX & 63) + o < 64) inc += n; }
        unsigned above = inc - mine;
        for (int w = (TIDX >> 6) + 1; w < 4; ++w) above += scn[w];
        if (above < want && above + mine >= want) { ctl[2] = prefix | ((unsigned)TIDX << shift); ctl[3] = want - above; }
      }
      __syncthreads();
      if (TIDX == 0) { ctl[0] = ctl[2]; ctl[1] = ctl[3]; }
      __syncthreads();
    }
    const unsigned thr = ctl[0], weq = ctl[1];
    const int per = tlen / NT > 0 ? tlen / NT : 1, nthr = tlen / per, t0 = TIDX * per;
    unsigned cnt = 0u;
    if (TIDX < nthr) for (int i = 0; i < per; ++i) { const unsigned k = keys[t0 + i]; cnt += (k > thr ? 0x10000u : 0u) + (k == thr ? 1u : 0u); }
    unsigned inc = cnt;
#pragma unroll
    for (int o = 1; o < 64; o <<= 1) { const unsigned n = __shfl_up(inc, o); if ((TIDX & 63) >= o) inc += n; }
    if ((TIDX & 63) == 63) scn[TIDX >> 6] = inc;
    __syncthreads();
    unsigned base = 0u;
    for (int w = 0; w < (TIDX >> 6); ++w) base += scn[w];
    unsigned run = base + inc - cnt;
    int* idx = (int*)(p.ws + OFF_IDX); float* gate = (float*)(p.ws + OFF_GATE); int* slot = (int*)(p.ws + OFF_SLOT);
    const int pb = pair_base(s, e);
    if (TIDX < nthr) for (int i = 0; i < per; ++i) {
      const unsigned k = keys[t0 + i]; const unsigned ngt = run >> 16, neq = run & 0xffffu;
      const unsigned eqtaken = neq < weq ? neq : weq;
      int sl = -1;
      if (k > thr) sl = (int)(ngt + eqtaken);
      else if (k == thr && neq < weq) sl = (int)(ngt + neq);
      if (sl >= 0) { idx[pb + sl] = r0 + t0 + i; gate[pb + sl] = __uint_as_float(k); }
      slot[(size_t)(r0 + t0 + i) * 16 + e] = sl;
      run += (k > thr ? 0x10000u : 0u) + (k == thr ? 1u : 0u);
    }
  }
}
__device__ __forceinline__ void ph_combine_fast(const Params& p, int l, int nrows, int next_l) {
  const int TIDX = ltid(); const int BIDX = lbid();
  const int lane = TIDX & 63, wv = TIDX >> 6;
  const bf16_t* Y = (const bf16_t*)(p.ws + OFF_Y);
  for (int r4 = (BIDX + gridDim.x * wv) * 4; r4 < nrows; r4 += gridDim.x * 8 * 4) {
    int mj, t, tlen, r0; rowinfo(r4, mj, t, tlen, r0);
    const int s = r4 < ML ? (r4 >> 13) : 2 + ((r4 - ML) >> 8);
    const int slot4 = ((const int*)(p.ws + OFF_SLOT))[(size_t)r4 * 16 + lane];
    const unsigned long long vm = __ballot(slot4 >= 0);
    const int pairl = pair_base(s, lane & 15) + slot4;
    float4 xv[4][4]; uint4 ya[4][2][2]; int nsel[4];
    float* xr[4];
#pragma unroll
    for (int rr = 0; rr < 4; ++rr) { xr[rr] = xrow(p, r4 + rr);
#pragma unroll
      for (int hf = 0; hf < 2; ++hf) { const uint4 xb4 = ld_nt_u4((const bf16_t*)xr[rr] + hf * 512 + lane * 8);
        xv[rr][hf * 2 + 0] = make_float4(__uint_as_float(xb4.x << 16), __uint_as_float(xb4.x & 0xffff0000u), __uint_as_float(xb4.y << 16), __uint_as_float(xb4.y & 0xffff0000u));
        xv[rr][hf * 2 + 1] = make_float4(__uint_as_float(xb4.z << 16), __uint_as_float(xb4.z & 0xffff0000u), __uint_as_float(xb4.w << 16), __uint_as_float(xb4.w & 0xffff0000u)); } }
#pragma unroll
    for (int rr = 0; rr < 4; ++rr) {
      unsigned m16 = (unsigned)(vm >> (rr * 16)) & 0xffffu; nsel[rr] = __builtin_popcount(m16);
#pragma unroll
      for (int k = 0; k < 2; ++k) {
        if (m16) { const int e = __builtin_ctz(m16); m16 &= m16 - 1; const int pr = __builtin_amdgcn_readlane(pairl, rr * 16 + e);
          const bf16_t* yr = Y + (size_t)pr * D; ya[rr][k][0] = ld_nt_u4(yr + lane * 8); ya[rr][k][1] = ld_nt_u4(yr + 512 + lane * 8); }
        else { ya[rr][k][0] = make_uint4(0u, 0u, 0u, 0u); ya[rr][k][1] = make_uint4(0u, 0u, 0u, 0u); }
      }
    }
    const float* g2 = modvec(p, l, mj, 5);
    float4 gq[4];
#pragma unroll
    for (int hf = 0; hf < 2; ++hf)
#pragma unroll
      for (int q = 0; q < 2; ++q) gq[hf * 2 + q] = *(const float4*)(g2 + hf * 512 + lane * 8 + q * 4);
    asm volatile("s_waitcnt vmcnt(0)" ::: "memory");
#pragma unroll
    for (int rr = 0; rr < 4; ++rr) {
      float acc[16];
#pragma unroll
      for (int i = 0; i < 16; ++i) acc[i] = 0.f;
#pragma unroll
      for (int k = 0; k < 2; ++k)
#pragma unroll
        for (int hf = 0; hf < 2; ++hf) { const unsigned w[4] = {ya[rr][k][hf].x, ya[rr][k][hf].y, ya[rr][k][hf].z, ya[rr][k][hf].w};
#pragma unroll
          for (int i = 0; i < 4; ++i) { acc[hf * 8 + 2 * i] += __uint_as_float(w[i] << 16); acc[hf * 8 + 2 * i + 1] += __uint_as_float(w[i] & 0xffff0000u); } }
      if (nsel[rr] > 2) {
        unsigned m16 = (unsigned)(vm >> (rr * 16)) & 0xffffu; m16 &= m16 - 1; m16 &= m16 - 1;
        while (m16) { const int e = __builtin_ctz(m16); m16 &= m16 - 1; const int pr = __builtin_amdgcn_readlane(pairl, rr * 16 + e);
          const bf16_t* yr = Y + (size_t)pr * D; const uint4 a = *(const uint4*)(yr + lane * 8), bq = *(const uint4*)(yr + 512 + lane * 8);
          const unsigned w[8] = {a.x, a.y, a.z, a.w, bq.x, bq.y, bq.z, bq.w};
#pragma unroll
          for (int i = 0; i < 8; ++i) { acc[2 * i] += __uint_as_float(w[i] << 16); acc[2 * i + 1] += __uint_as_float(w[i] & 0xffff0000u); } }
      }
      float x[16], ss = 0.f;
#pragma unroll
      for (int hf = 0; hf < 2; ++hf)
#pragma unroll
        for (int q = 0; q < 2; ++q) { const int c = hf * 512 + lane * 8 + q * 4; float4 xq = xv[rr][hf * 2 + q]; const float4 gv = gq[hf * 2 + q];
          xq.x += gv.x * acc[hf * 8 + q * 4 + 0]; xq.y += gv.y * acc[hf * 8 + q * 4 + 1]; xq.z += gv.z * acc[hf * 8 + q * 4 + 2]; xq.w += gv.w * acc[hf * 8 + q * 4 + 3];
          if (next_l >= 0) { uint2 xb2; xb2.x = gd::pk(xq.x, xq.y); xb2.y = gd::pk(xq.z, xq.w); *(uint2*)((bf16_t*)xr[rr] + c) = xb2; }
          else st_nt_f4(xr[rr] + c, xq);
          x[hf * 8 + q * 4 + 0] = xq.x; x[hf * 8 + q * 4 + 1] = xq.y; x[hf * 8 + q * 4 + 2] = xq.z; x[hf * 8 + q * 4 + 3] = xq.w;
          ss += xq.x * xq.x + xq.y * xq.y + xq.z * xq.z + xq.w * xq.w; }
      if (next_l >= 0) {
        ss = wave_sum(ss);
        const float rstd = rsqrtf(ss / D + EPS);
        const float* g = p.norm1_g + next_l * D; const float* sh = modvec(p, next_l, mj, 0); const float* sc = modvec(p, next_l, mj, 1);
        bf16_t* h = (bf16_t*)(p.ws + OFF_H) + (size_t)(r4 + rr) * D;
#pragma unroll
        for (int hf = 0; hf < 2; ++hf) { const int c = hf * 512 + lane * 8; float y[8];
#pragma unroll
          for (int i = 0; i < 8; ++i) y[i] = x[hf * 8 + i] * rstd * g[c + i] * (1.f + sc[c + i]) + sh[c + i];
          uint4 w; w.x = gd::pk(y[0], y[1]); w.y = gd::pk(y[2], y[3]); w.z = gd::pk(y[4], y[5]); w.w = gd::pk(y[6], y[7]);
          *(uint4*)(h + c) = w; }
      }
    }
  }
}
template <class RowPtr>
__device__ __forceinline__ gd::f32x4 coop_tile_32x64(RowPtr arow, const bf16_t* Bt, int ldb, int K, float* lds, int wv, int lane) {
  using gd::bf16x8; using gd::f32x4;
  const int cc = lane & 15, g = lane >> 4;
  const bf16_t* a0 = arow(cc) + g * 8; const bf16_t* a1 = arow(16 + cc) + g * 8;
  f32x4 acc[2][4];
#pragma unroll
  for (int m = 0; m < 2; ++m)
#pragma unroll
    for (int n = 0; n < 4; ++n) acc[m][n] = (f32x4){0.f, 0.f, 0.f, 0.f};
  for (int ks = wv; ks < K / 32; ks += 8) {
    const bf16x8 A0 = *(const bf16x8*)(a0 + ks * 32), A1 = *(const bf16x8*)(a1 + ks * 32);
#pragma unroll
    for (int n = 0; n < 4; ++n) { const bf16x8 B = *(const bf16x8*)(Bt + (size_t)(n * 16 + cc) * ldb + ks * 32 + g * 8);
      acc[0][n] = __builtin_amdgcn_mfma_f32_16x16x32_bf16(A0, B, acc[0][n], 0, 0, 0); acc[1][n] = __builtin_amdgcn_mfma_f32_16x16x32_bf16(A1, B, acc[1][n], 0, 0, 0); }
  }
  gd::lds_barrier();
#pragma unroll
  for (int m = 0; m < 2; ++m)
#pragma unroll
    for (int n = 0; n < 4; ++n) *(f32x4*)(lds + ((wv * 8 + m * 4 + n) * 64 + lane) * 4) = acc[m][n];
  gd::lds_barrier();
  f32x4 r = {0.f, 0.f, 0.f, 0.f};
#pragma unroll
  for (int w = 0; w < 8; ++w) r += *(const f32x4*)(lds + ((w * 8 + wv) * 64 + lane) * 4);
  return r;
}
__device__ __forceinline__ void ph_ctx_moe_gu(const Params& p, float* lds) {
  const int TIDX = ltid(); const int BIDX = lbid();
  const int lane = TIDX & 63, wv = TIDX >> 6, cc = lane & 15, g = lane >> 4;
  const bf16_t* H = (const bf16_t*)(p.ws + OFF_H); const bf16_t* GU = (const bf16_t*)(p.ws + OFF_MOEGU); bf16_t* hid = (bf16_t*)(p.ws + OFF_HID);
  const int* idx = (const int*)(p.ws + OFF_IDX);
  for (int it = BIDX; it < 32 * 16; it += gridDim.x) {
    const int grp = 32 + (it >> 4), ns = it & 15, s = grp >> 4, e = grp & 15, pb = pair_base(s, e);
    const gd::f32x4 v4 = coop_tile_32x64([&](int r) { return H + (size_t)idx[pb + r] * D; }, GU + (size_t)e * D * D + (size_t)(ns * 64) * D, D, D, lds, wv, lane);
    const int m = wv >> 2, n = wv & 3;
#pragma unroll
    for (int r = 0; r < 4; ++r) { const float v = v4[r], o = __shfl_xor(v, 1);
      if ((cc & 1) == 0) hid[(size_t)(pb + m * 16 + g * 4 + r) * DEXP + ((ns * 64 + n * 16 + cc) >> 1)] = f2bf(silu_f(v) * o); }
  }
}
__device__ __forceinline__ void ph_ctx_moe_down(const Params& p, float* lds) {
  const int TIDX = ltid(); const int BIDX = lbid();
  const int lane = TIDX & 63, wv = TIDX >> 6, cc = lane & 15, g = lane >> 4;
  const bf16_t* hid = (const bf16_t*)(p.ws + OFF_HID); const bf16_t* DN = (const bf16_t*)(p.ws + OFF_MOED); bf16_t* Y = (bf16_t*)(p.ws + OFF_Y);
  const float* gate = (const float*)(p.ws + OFF_GATE);
  for (int it = BIDX; it < 32 * 16; it += gridDim.x) {
    const int grp = 32 + (it >> 4), ns = it & 15, s = grp >> 4, e = grp & 15, pb = pair_base(s, e);
    const gd::f32x4 v4 = coop_tile_32x64([&](int r) { return hid + (size_t)(pb + r) * DEXP; }, DN + (size_t)e * D * DEXP + (size_t)(ns * 64) * DEXP, DEXP, DEXP, lds, wv, lane);
    const int m = wv >> 2, n = wv & 3;
#pragma unroll
    for (int r = 0; r < 4; ++r) { const int row = pb + m * 16 + g * 4 + r; Y[(size_t)row * D + ns * 64 + n * 16 + cc] = f2bf(v4[r] * gate[row]); }
  }
}
__device__ __forceinline__ void ph_ctx_outproj(const Params& p, int l, float* lds) {
  const int TIDX = ltid(); const int BIDX = lbid();
  const int lane = TIDX & 63, wv = TIDX >> 6, cc = lane & 15, g = lane >> 4;
  const bf16_t* A = (const bf16_t*)(p.ws + OFF_H) + (size_t)ML * D; const bf16_t* W = (const bf16_t*)(p.ws + OFF_WOUTT) + (size_t)l * D * D;
  bf16_t* yo = (bf16_t*)(p.ws + OFF_YO) + (size_t)ML * D;
  for (int it = BIDX; it < 16 * 16; it += gridDim.x) {
    const int mt = it >> 4, ns = it & 15;
    const gd::f32x4 v4 = coop_tile_32x64([&](int r) { return A + (size_t)(mt * 32 + r) * D; }, W + (size_t)(ns * 64) * D, D, D, lds, wv, lane);
    const int m = wv >> 2, n = wv & 3;
#pragma unroll
    for (int r = 0; r < 4; ++r) yo[(size_t)(mt * 32 + m * 16 + g * 4 + r) * D + ns * 64 + n * 16 + cc] = f2bf(v4[r]);
  }
}
__device__ __forceinline__ void ph_modulate2_fast(const Params& p, int l, int nrows, float* lds) {
  const int TIDX = ltid(); const int BIDX = lbid();
  const int lane = TIDX & 63, wv = TIDX >> 6;
  __syncthreads();
  { const float* wr = p.router + (size_t)l * D * NE;
    for (int i = TIDX; i < D * 4; i += NT) { const int c = i >> 2, q = i & 3, pr = (c & ~255) + (c & 3) * 64 + ((c >> 2) & 63);
      *(float4*)(lds + pr * 20 + q * 4) = *(const float4*)(wr + c * 16 + q * 4); } }
  __syncthreads();
  const float* g = p.norm2_g + l * D;
  for (int r4 = (BIDX + gridDim.x * wv) * 4; r4 < nrows; r4 += gridDim.x * 8 * 4) {
    int mj, t, tlen, r0; rowinfo(r4, mj, t, tlen, r0);
    const float* sh = modvec(p, l, mj, 3); const float* sc = modvec(p, l, mj, 4);
    float4 xv[4][4], gv[4], sv[4], hv[4];
#pragma unroll
    for (int rr = 0; rr < 4; ++rr) xv[rr][0] = xv[rr][1] = xv[rr][2] = xv[rr][3] = make_float4(0.f, 0.f, 0.f, 0.f);
    if (l == 0) {
#pragma unroll
      for (int rr = 0; rr < 4; ++rr) { const float* xr = xrow_src(p, r4 + rr, 0);
#pragma unroll
        for (int i = 0; i < 4; ++i) xv[rr][i] = ld_nt_f4(xr + i * 256 + lane * 4); }
    } else {
#pragma unroll
      for (int rr = 0; rr < 4; ++rr) { const bf16_t* xr = (const bf16_t*)xrow_src(p, r4 + rr, 1);
#pragma unroll
        for (int i = 0; i < 4; ++i) { const uint2 v = ld_nt_u2(xr + i * 256 + lane * 4);
          xv[rr][i] = make_float4(__uint_as_float(v.x << 16), __uint_as_float(v.x & 0xffff0000u), __uint_as_float(v.y << 16), __uint_as_float(v.y & 0xffff0000u)); } }
    }
    {
      const float* g1 = modvec(p, l, mj, 2); const bf16_t* yo = (const bf16_t*)(p.ws + OFF_YO);
#pragma unroll
      for (int i = 0; i < 4; ++i) { const int c = i * 256 + lane * 4; const float4 gg = *(const float4*)(g1 + c);
#pragma unroll
        for (int rr = 0; rr < 4; ++rr) { const uint2 yv = ld_nt_u2(yo + (size_t)(r4 + rr) * D + c);
          xv[rr][i].x += gg.x * __uint_as_float(yv.x << 16); xv[rr][i].y += gg.y * __uint_as_float(yv.x & 0xffff0000u);
          xv[rr][i].z += gg.z * __uint_as_float(yv.y << 16); xv[rr][i].w += gg.w * __uint_as_float(yv.y & 0xffff0000u);
          uint2 xb2; xb2.x = gd::pk(xv[rr][i].x, xv[rr][i].y); xb2.y = gd::pk(xv[rr][i].z, xv[rr][i].w);
          *(uint2*)((bf16_t*)xrow(p, r4 + rr) + c) = xb2; } }
    }
#pragma unroll
    for (int i = 0; i < 4; ++i) { const int c = i * 256 + lane * 4; gv[i] = *(const float4*)(g + c); sv[i] = *(const float4*)(sc + c); hv[i] = *(const float4*)(sh + c); }
#pragma unroll
    for (int rr = 0; rr < 4; ++rr) {
      const int r = r4 + rr;
      float ss = 0.f;
#pragma unroll
      for (int i = 0; i < 4; ++i) ss += xv[rr][i].x * xv[rr][i].x + xv[rr][i].y * xv[rr][i].y + xv[rr][i].z * xv[rr][i].z + xv[rr][i].w * xv[rr][i].w;
      ss = wave_sum(ss);
      const float rstd = rsqrtf(ss / D + EPS);
      bf16_t* h = (bf16_t*)(p.ws + OFF_H) + (size_t)r * D;
      float lo[16];
#pragma unroll
      for (int e = 0; e < 16; ++e) lo[e] = 0.f;
#pragma unroll
      for (int i = 0; i < 4; ++i) {
        const int c = i * 256 + lane * 4;
        float y[4];
        y[0] = xv[rr][i].x * rstd * gv[i].x * (1.f + sv[i].x) + hv[i].x; y[1] = xv[rr][i].y * rstd * gv[i].y * (1.f + sv[i].y) + hv[i].y;
        y[2] = xv[rr][i].z * rstd * gv[i].z * (1.f + sv[i].z) + hv[i].z; y[3] = xv[rr][i].w * rstd * gv[i].w * (1.f + sv[i].w) + hv[i].w;
        uint2 w; w.x = gd::pk(y[0], y[1]); w.y = gd::pk(y[2], y[3]);
        *(uint2*)(h + c) = w;
#pragma unroll
        for (int q = 0; q < 4; ++q) {
          const float* wrow = lds + (i * 256 + q * 64 + lane) * 20;
#pragma unroll
          for (int e4 = 0; e4 < 4; ++e4) { const float4 w4 = *(const float4*)(wrow + e4 * 4);
            lo[e4 * 4 + 0] += y[q] * w4.x; lo[e4 * 4 + 1] += y[q] * w4.y; lo[e4 * 4 + 2] += y[q] * w4.z; lo[e4 * 4 + 3] += y[q] * w4.w; }
        }
      }
#pragma unroll
      for (int k = 0; k < 4; ++k) {
        const int half = 8 >> k, mask = 32 >> k; const bool upper = (lane & mask) != 0;
#pragma unroll
        for (int i = 0; i < half; ++i) { const float send = upper ? lo[i] : lo[i + half]; const float recv = __shfl_xor(send, mask); lo[i] = (upper ? lo[i + half] : lo[i]) + recv; }
      }
      float v = lo[0]; v += __shfl_xor(v, 1); v += __shfl_xor(v, 2);
      float mx = v;
      mx = fmaxf(mx, __shfl_xor(mx, 4)); mx = fmaxf(mx, __shfl_xor(mx, 8)); mx = fmaxf(mx, __shfl_xor(mx, 16)); mx = fmaxf(mx, __shfl_xor(mx, 32));
      const float ex = expf(v - mx);
      float sm = ex; sm += __shfl_xor(sm, 4); sm += __shfl_xor(sm, 8); sm += __shfl_xor(sm, 16); sm += __shfl_xor(sm, 32);
      if ((lane & 3) == 0) { const int e = ((lane >> 5) & 1) * 8 + ((lane >> 4) & 1) * 4 + ((lane >> 3) & 1) * 2 + ((lane >> 2) & 1);
        ((float*)(p.ws + OFF_AFFT))[(size_t)e * MR + r] = ex / sm; }
    }
  }
}

__device__ __forceinline__ void ph_modulate1_fast(const Params& p) {
  const int TIDX = ltid(); const int BIDX = lbid();
  const int lane = TIDX & 63, wv = TIDX >> 6;
  const float* g = p.norm1_g;
  for (int r2 = (BIDX + gridDim.x * wv) * 2; r2 < MR; r2 += gridDim.x * 8 * 2) {
    int mj, t, tlen, r0; rowinfo(r2, mj, t, tlen, r0);
    const float* sh = modvec(p, 0, mj, 0); const float* sc = modvec(p, 0, mj, 1);
    float4 xv[2][4];
#pragma unroll
    for (int rr = 0; rr < 2; ++rr) { const float* xr = xrow_src(p, r2 + rr, 0);
#pragma unroll
      for (int i = 0; i < 4; ++i) xv[rr][i] = ld_nt_f4(xr + i * 256 + lane * 4); }
    float4 gv[4], sv[4], hv[4];
#pragma unroll
    for (int i = 0; i < 4; ++i) { const int c = i * 256 + lane * 4; gv[i] = *(const float4*)(g + c); sv[i] = *(const float4*)(sc + c); hv[i] = *(const float4*)(sh + c); }
#pragma unroll
    for (int rr = 0; rr < 2; ++rr) {
      float ss = 0.f;
#pragma unroll
      for (int i = 0; i < 4; ++i) ss += xv[rr][i].x * xv[rr][i].x + xv[rr][i].y * xv[rr][i].y + xv[rr][i].z * xv[rr][i].z + xv[rr][i].w * xv[rr][i].w;
      ss = wave_sum(ss);
      const float rstd = rsqrtf(ss / D + EPS);
      bf16_t* h = (bf16_t*)(p.ws + OFF_H) + (size_t)(r2 + rr) * D;
#pragma unroll
      for (int i = 0; i < 4; ++i) { const int c = i * 256 + lane * 4;
        uint2 w; w.x = gd::pk(xv[rr][i].x * rstd * gv[i].x * (1.f + sv[i].x) + hv[i].x, xv[rr][i].y * rstd * gv[i].y * (1.f + sv[i].y) + hv[i].y);
        w.y = gd::pk(xv[rr][i].z * rstd * gv[i].z * (1.f + sv[i].z) + hv[i].z, xv[rr][i].w * rstd * gv[i].w * (1.f + sv[i].w) + hv[i].w);
        *(uint2*)(h + c) = w; }
    }
  }
}

constexpr size_t LDS_BYTES = 163840;
__global__ void __launch_bounds__(NT, 2) mega(Params p) {
  extern __shared__ __attribute__((aligned(16))) char smem[];
  float* lds = (float*)smem;
  volatile LAS unsigned* xbst = (volatile LAS unsigned*)(smem + LDS_BYTES - 16);
  if (threadIdx.x == 0) { xbst[0] = 0u; xbst[1] = 0u; xbst[2] = 0u; xbst[3] = 0u; }
  __syncthreads();
  XcdBarrier xb = xcd_barrier_post((unsigned*)(p.ws + OFF_BAR), xbst);
  cg::grid_group grid = cg::this_grid();

  if (p.ws == nullptr) grid.sync();
  for (int l = 0; l < 2; ++l) {
    const bool need_ctx = l == 0;
    const int nrows = need_ctx ? MR : ML, nseq = need_ctx ? 4 : 2;
    if (l == 0) { ph_ada_fast(p, lds); ph_prep_weights(p, lds); xcd_barrier(xb); ph_modulate1_fast(p); xcd_barrier(xb); }
    for (int _r = 0; _r < REP_INPROJ; ++_r) ph_inproj_fast(p, l, smem);
    xcd_barrier(xb);
    for (int _r = 0; _r < REP_PRE; ++_r) ph_gdn_precompute(p, l, smem);
    ph_mla_gemm(p, l, smem);
    xcd_barrier(xb);
    for (int _r = 0; _r < REP_MLA; ++_r) ph_mla_finish(p, l, lds);
    xcd_barrier(xb);
    for (int _r = 0; _r < REP_SCAN; ++_r) ph_scan_fast(p, smem);
    for (int _r = 0; _r < REP_ATTN; ++_r) ph_attn_fast(p, need_ctx, smem);
    ph_pool_mfma(p, l, nrows, smem);
    xcd_barrier(xb);
    ph_gdnfin_pool_fast<2>(p, l, nrows, lds, 0, (int)gridDim.x);
    xcd_barrier(xb);
    ph_outproj_fast(p, l, smem);
    if (need_ctx) ph_ctx_outproj(p, l, lds);
    xcd_barrier(xb);
    for (int _r = 0; _r < REP_MOD; ++_r) ph_modulate2_fast(p, l, nrows, lds);
    xcd_barrier(xb);
    for (int _r = 0; _r < REP_TOPK; ++_r) ph_topk_fast(p, nseq, smem);
    ph_prep_moe_weights(p, l, lds, 0, (int)gridDim.x);
    xcd_barrier(xb);
    for (int _r = 0; _r < REP_MOEGU; ++_r) ph_moe_gu_fast(p, smem);
    if (need_ctx) ph_ctx_moe_gu(p, lds);
    xcd_barrier(xb);
    ph_moe_down_fast(p, smem);
    if (need_ctx) ph_ctx_moe_down(p, lds);
    xcd_barrier(xb);
    ph_combine_fast(p, l, nrows, l == 0 ? 1 : -1);
    if (l == 0) xcd_barrier(xb);
  }
}

extern "C" void kernel_launch(void* const* d_in, const int* in_sizes, int n_in, void* d_out, int out_size, void* d_ws, size_t ws_size, hipStream_t stream) {
  static int grid_blocks = 0;
  if (ws_size < OFF_END) { fprintf(stderr, "kernel_launch: workspace too small: %zu < %zu\n", ws_size, (size_t)OFF_END); return; }
  if (!grid_blocks) {
    if (hipFuncSetAttribute((const void*)mega, hipFuncAttributeMaxDynamicSharedMemorySize, (int)LDS_BYTES) != hipSuccess) { fprintf(stderr, "kernel_launch: hipFuncSetAttribute failed\n"); return; }
    int dev = 0, cus = 0, per_cu = 0;
    hipGetDevice(&dev);
    hipDeviceGetAttribute(&cus, hipDeviceAttributeMultiprocessorCount, dev);
    hipOccupancyMaxActiveBlocksPerMultiprocessor(&per_cu, mega, NT, LDS_BYTES);
    if (per_cu < 1) { fprintf(stderr, "kernel_launch: occupancy query returned %d\n", per_cu); return; }
    grid_blocks = cus;
  }
  Params p{};
  const float** f = (const float**)&p;
  for (int i = 0; i < 26; ++i) f[i] = (const float*)d_in[i];
  p.out = (float*)d_out; p.ws = (char*)d_ws;
  hipMemsetAsync((char*)d_ws + OFF_BAR, 0, 16384, stream);
  void* args[] = {&p};
  hipError_t e = hipLaunchCooperativeKernel((const void*)mega, dim3(grid_blocks), dim3(NT), args, LDS_BYTES, stream);
  if (e != hipSuccess) fprintf(stderr, "cooperative launch failed: %s (grid %d)\n", hipGetErrorString(e), grid_blocks);
}
```

```cpp
#include <hip/hip_runtime.h>
#include <hip/hip_bf16.h>
#include <hip/hip_cooperative_groups.h>
#include <cstdint>
#include <cstdio>
namespace cg = cooperative_groups;
#define REP_SCAN 1
#define REP_ATTN 1
#define REP_PRE 1
#define REP_MLA 1
#define REP_PMW 1
#define REP_TOPK 1
#define REP_GATHER 1
#define REP_INPROJ 1
#define REP_MOEGU 1
#define REP_MOD 1
#define REP_FIN 1
#define REP_INIT 1

constexpr int D = 1024, NB = 2, T = 8192, TC = 256;
constexpr int ML = NB * T;
constexpr int MC = NB * TC;
constexpr int MR = ML + MC;
constexpr int NIN = 2672, NINP = 2816;
constexpr int NE = 16, DEXP = 512, CAPL = 1024, CAPC = 32;
constexpr int NPAIR = NB * NE * CAPL + NB * NE * CAPC;
constexpr int TK = TC + T;
constexpr float EPS = 1e-6f;
constexpr int NT = 512;
constexpr int PC_Q = 0, PC_KV = 192, PC_KR = 320, PC_GQ = 352, PC_GK = 864, PC_GV = 1376, PC_Z = 1888, PC_A = 2400, PC_B = 2408, PC_POOL = 2416;
constexpr int PC_OF = 352, PC_OB = 864;

typedef unsigned short bf16_t;
__device__ __forceinline__ float bf2f(bf16_t b) { return __uint_as_float(((unsigned)b) << 16); }
__device__ __forceinline__ bf16_t f2bf(float f) { unsigned u = __float_as_uint(f); u += 0x7FFFu + ((u >> 16) & 1u); return (bf16_t)(u >> 16); }
__device__ __forceinline__ float silu_f(float x) { return x * __builtin_amdgcn_rcpf(1.0f + __expf(-x)); }
__device__ __forceinline__ float sigmoid_f(float x) { return 1.0f / (1.0f + expf(-x)); }
__device__ __forceinline__ float softplus_f(float x) {
  if (x > 20.f) return x;
  const float y = __expf(x);
  return y < 0.0625f ? y * (1.f - y * (0.5f - y * (0.333333343f - 0.25f * y))) : __logf(1.f + y);
}

typedef float f4v_t __attribute__((ext_vector_type(4))); typedef unsigned u2v_t __attribute__((ext_vector_type(2))); typedef unsigned u4v_t __attribute__((ext_vector_type(4)));
__device__ __forceinline__ float4 ld_nt_f4(const float* q) { const f4v_t v = __builtin_nontemporal_load((const f4v_t*)q); return make_float4(v[0], v[1], v[2], v[3]); }
__device__ __forceinline__ uint2 ld_nt_u2(const void* q) { const u2v_t v = __builtin_nontemporal_load((const u2v_t*)q); return make_uint2(v[0], v[1]); }
__device__ __forceinline__ uint4 ld_nt_u4(const void* q) { const u4v_t v = __builtin_nontemporal_load((const u4v_t*)q); return make_uint4(v[0], v[1], v[2], v[3]); }
__device__ __forceinline__ void st_nt_f4(float* q, const float4 v) { const f4v_t w = {v.x, v.y, v.z, v.w}; __builtin_nontemporal_store(w, (f4v_t*)q); }
constexpr size_t al256(size_t x) { return (x + 255) / 256 * 256; }
constexpr size_t OFF_BAR = 0;
constexpr size_t OFF_MOD = 16384;
constexpr size_t OFF_XC = al256(OFF_MOD + 2 * 3 * 6144 * 4);
constexpr size_t OFF_AFFT = al256(OFF_XC + (size_t)MC * D * 4);
constexpr size_t OFF_IDX = al256(OFF_AFFT + (size_t)NE * MR * 4);
constexpr size_t OFF_GATE = al256(OFF_IDX + (size_t)NPAIR * 4);
constexpr size_t OFF_SLOT = al256(OFF_GATE + (size_t)NPAIR * 4);
constexpr size_t OFF_GB = al256(OFF_SLOT + (size_t)MR * 16 * 4);
constexpr size_t OFF_H = al256(OFF_GB + (size_t)MR * 16 * 4);
constexpr size_t OFF_P = al256(OFF_H + (size_t)MR * D * 2);
constexpr size_t OFF_RB = al256(OFF_P + (size_t)MR * NINP * 2);
constexpr size_t RB_BYTES = (size_t)1056 * 100352;
constexpr size_t OFF_QKV = al256(OFF_RB + RB_BYTES);
constexpr size_t QK_ELEMS = (size_t)NB * 4 * TK * 128, V_ELEMS = (size_t)NB * 4 * TK * 64;
constexpr size_t OFF_WINT = al256(OFF_QKV + (2 * QK_ELEMS + V_ELEMS) * 2);
constexpr size_t OFF_WOUTT = al256(OFF_WINT + (size_t)2 * NINP * D * 2);
constexpr size_t OFF_WUP = al256(OFF_WOUTT + (size_t)2 * D * D * 2);
constexpr size_t OFF_MOEGU = al256(OFF_WUP + (size_t)2 * 1024 * 256 * 2);
constexpr size_t OFF_MOED = OFF_MOEGU + (size_t)NE * D * D * 2;
constexpr size_t OFF_END = al256(OFF_MOED + (size_t)NE * D * DEXP * 2);
constexpr size_t OFF_UPRAW = OFF_MOEGU;
constexpr size_t OFF_OPART = OFF_MOEGU;
constexpr size_t OFF_MLPART = OFF_OPART + (size_t)4 * ML * 256 * 2;
static_assert(OFF_MLPART + (size_t)4 * ML * 4 * 2 * 4 <= OFF_END, "partials must fit in the MoE weight region");
constexpr size_t OFF_HID = OFF_RB + (size_t)64 * 1024 * 1024;
constexpr size_t OFF_Y = OFF_P;
constexpr size_t OFF_YO = OFF_P;
constexpr size_t OFF_XS = OFF_P;


struct Params {
  const float* x; const float* c; const float* ctx; const float* c_ctx; const float* ada_w; const float* ada_b;
  const float* norm1_g; const float* norm2_g; const float* w_in; const float* q_a_norm; const float* w_uq; const float* kv_a_norm;
  const float* w_ukv; const float* q_norm; const float* k_norm; const float* conv_w; const float* a_log; const float* dt_bias;
  const float* gdn_norm_g; const float* pool_w; const float* pool_scale; const float* w_out; const float* router;
  const float* w_gate; const float* w_up; const float* w_down;
  float* out; char* ws;
};

__device__ __forceinline__ const float* xrow_src(const Params& p, int r, int l) { return l == 0 ? (r < ML ? p.x + (size_t)r * D : p.ctx + (size_t)(r - ML) * D) : (r < ML ? p.out + (size_t)r * D : (const float*)(p.ws + OFF_XC) + (size_t)(r - ML) * D); }
__device__ __forceinline__ float* xrow(const Params& p, int r) { return r < ML ? p.out + (size_t)r * D : (float*)(p.ws + OFF_XC) + (size_t)(r - ML) * D; }
__device__ __forceinline__ void rowinfo(int r, int& mj, int& t, int& tlen, int& r0) {
  if (r < ML) { mj = r >> 13; t = r & (T - 1); tlen = T; r0 = r - t; } else { int rc = r - ML; mj = 2; t = rc & (TC - 1); tlen = TC; r0 = r - t; }
}
__device__ __forceinline__ const float* modvec(const Params& p, int l, int mj, int chunk) { return (const float*)(p.ws + OFF_MOD) + ((size_t)(l * 3 + mj) * 6 + chunk) * D; }
__device__ __forceinline__ int pair_base(int s, int e) { return s < 2 ? (s * NE + e) * CAPL : NB * NE * CAPL + ((s - 2) * NE + e) * CAPC; }
__device__ __forceinline__ float wave_sum(float v) { for (int o = 32; o > 0; o >>= 1) v += __shfl_xor(v, o); return v; }

__device__ __forceinline__ int ltid() { int t = threadIdx.x; asm volatile("" : "+v"(t)); return t; }
__device__ __forceinline__ int lbid() { int t = blockIdx.x; asm volatile("" : "+s"(t)); return t; }
#define XB_TMO      128
#define XB_XCNT(j)  (256  + 64 * (j))
#define XB_XSUB(j)  (1280 + 64 * (j))
#define XB_XGEN(j)  (2304 + 64 * (j))
#define XB_TOP      3328
#define XB_TOPGEN   3392
#define XCD_BAR_WORDS 3456
#define XB_SPIN_CAP (1u << 22)
#define LAS __attribute__((address_space(3)))
__device__ __forceinline__ unsigned xb_ld(unsigned* p)              { return __hip_atomic_load(p, __ATOMIC_RELAXED, __HIP_MEMORY_SCOPE_AGENT); }
__device__ __forceinline__ unsigned xb_add(unsigned* p, unsigned v) { return __hip_atomic_fetch_add(p, v, __ATOMIC_RELAXED, __HIP_MEMORY_SCOPE_AGENT); }
__device__ __forceinline__ unsigned xb_xcc_id() { return (unsigned)__builtin_amdgcn_s_getreg((3 << 11) | 20) & 0xFu; }
#define XB_SPIN(cond, bar) do { unsigned _sp = 0; while (cond) { __builtin_amdgcn_s_sleep(1); \
    if ((++_sp & 255u) == 0u) { if (xb_ld(&(bar)[XB_TMO])) break; if (_sp > XB_SPIN_CAP) { atomicAdd(&(bar)[XB_TMO], 1u); break; } } } } while (0)
struct XcdBarrier { unsigned* bar; unsigned x; volatile LAS unsigned* st; };
__device__ __forceinline__ XcdBarrier xcd_barrier_post(unsigned* bar, volatile LAS unsigned* st) {
  XcdBarrier b; b.bar = bar; b.x = xb_xcc_id(); b.st = st;
  if (threadIdx.x == 0) (void)xb_add(&bar[XB_XCNT(b.x)], 1u);
  return b;
}
__device__ __forceinline__ void xcd_barrier_complete(unsigned* bar, unsigned x, unsigned& nloc, unsigned& nx) {
  const unsigned G = gridDim.x * gridDim.y * gridDim.z;
  unsigned sum, cnt, mine, sp = 0u;
  for (;;) {
    sum = 0u; cnt = 0u; mine = 0u;
#pragma unroll
    for (unsigned j = 0; j < 16; ++j) { const unsigned c = xb_ld(&bar[XB_XCNT(j)]); sum += c; cnt += (c > 0u) ? 1u : 0u; mine = (j == x) ? c : mine; }
    if (sum == G) break;
    __builtin_amdgcn_s_sleep(1);
    if ((++sp & 255u) == 0u) { if (xb_ld(&bar[XB_TMO])) break; if (sp > XB_SPIN_CAP) { atomicAdd(&bar[XB_TMO], 1u); break; } }
  }
  nloc = mine > 0u ? mine : 1u; nx = cnt > 0u ? cnt : 1u;
}
__device__ __forceinline__ void xcd_barrier(const XcdBarrier& b) {
  asm volatile("s_waitcnt vmcnt(0)" ::: "memory");
  __syncthreads();
  if (threadIdx.x == 0) {
    unsigned* bar = b.bar;
    __builtin_amdgcn_s_waitcnt(0);
    unsigned nloc = b.st[0], nx = b.st[1];
    if (nloc == 0u) { xcd_barrier_complete(bar, b.x, nloc, nx); b.st[0] = nloc; b.st[1] = nx; }
    const unsigned old = xb_add(&bar[XB_XSUB(b.x)], 1u);
    const unsigned gen = old / nloc;
    if (old + 1u == (gen + 1u) * nloc) {
      __builtin_amdgcn_fence(__ATOMIC_RELEASE, "agent");
      asm volatile("s_waitcnt vmcnt(0)" ::: "memory");
      const unsigned og = xb_add(&bar[XB_TOP], 1u);
      const unsigned tg = og / nx;
      if (og + 1u == (tg + 1u) * nx) xb_add(&bar[XB_TOPGEN], 1u);
      else XB_SPIN(xb_ld(&bar[XB_TOPGEN]) == tg, bar);
      __builtin_amdgcn_fence(__ATOMIC_ACQUIRE, "agent");
      xb_add(&bar[XB_XGEN(b.x)], 1u);
      asm volatile("s_waitcnt vmcnt(0)" ::: "memory");
    } else {
      XB_SPIN(xb_ld(&bar[XB_XGEN(b.x)]) == gen, bar);
      __builtin_amdgcn_fence(__ATOMIC_ACQUIRE, "agent");
      asm volatile("s_waitcnt vmcnt(0)" ::: "memory");
    }
  }
  __syncthreads();
}


namespace pg8 {
#define PG8_LAS __attribute__((address_space(3)))
typedef short bf16x8 __attribute__((ext_vector_type(8)));
typedef float f32x4 __attribute__((ext_vector_type(4)));
typedef unsigned u32x4 __attribute__((ext_vector_type(4)));
constexpr int BM = 256, BK = 64, HALF = 128, HTB = HALF * BK * 2, STAGE_BYTES = 8 * HTB, NXCD = 8, WGM = 8;
__host__ __device__ __forceinline__ int lds_byte(int r, int c) { const int st = (r >> 4) * 2 + (c >> 5), rr = r & 15, cc = c & 31, ob = rr * 64 + cc * 2; return st * 1024 + (ob ^ (((ob >> 9) & 1) << 5)); }
__host__ __device__ __forceinline__ void stage_rc(int b, int& R, int& C) { const int st = b / 1024, sb = b % 1024, swz = sb ^ (((sb >> 9) & 1) << 5); R = (st >> 1) * 16 + swz / 64; C = (st & 1) * 32 + (swz % 64) / 2; }
__host__ __device__ __forceinline__ int perm32(int rho) { const int n = rho >> 4, i = rho & 15; return 8 * (i >> 2) + 4 * n + (i & 3); }
struct Unit { int pm, pn; };
__device__ __forceinline__ unsigned cvt_pk_bf16(float lo, float hi) { unsigned r; asm volatile("v_cvt_pk_bf16_f32 %0, %1, %2" : "=v"(r) : "v"(lo), "v"(hi)); return r; }
struct GridOrder {
  int nM, nN, nwg, G, c;
  __device__ __forceinline__ void init(int nM_, int nN_, int G_, int c_) { nM = nM_; nN = nN_; nwg = nM * nN; G = G_; c = c_; }
  __device__ __forceinline__ bool next(int i, Unit& u) const {
    const long L = (long)i * G + c; if (L >= nwg) return false;
    int wgid = (int)L; { const int q = nwg / NXCD, r = nwg % NXCD, xcd = wgid % NXCD, off = wgid / NXCD; wgid = (xcd < r ? xcd * (q + 1) : r * (q + 1) + (xcd - r) * q) + off; }
    const int nig = WGM * nN, gid = wgid / nig, fm = gid * WGM, gsz = (nM - fm) < WGM ? (nM - fm) : WGM;
    u.pm = fm + ((wgid % nig) % gsz); u.pn = (wgid % nig) / gsz; return true;
  }
};
template <class Epi, class Sched, bool GATHER = false>
__device__ __forceinline__ void gemm_phase(PG8_LAS unsigned char* lds, const Sched& S, const Epi& E) {
  const int tid = ltid(), wid = __builtin_amdgcn_readfirstlane(tid >> 6), lane = tid & 63, wr = wid >> 2, wc = wid & 3, fr = lane & 15, fq = lane >> 4;
  const int K = S.K, nt = K / BK;
  unsigned voffA[2], voffB[2]; int RA[2], CA[2];
#pragma unroll
  for (int i = 0; i < 2; ++i) { int R, C; stage_rc(tid * 16 + i * 8192, R, C); const int Rb = Epi::PERM ? ((R & ~31) + perm32(R & 31)) : R;
    voffA[i] = (unsigned)(R * S.lda + C) * 2u; voffB[i] = (unsigned)(Rb * S.ldb + C) * 2u; RA[i] = R; CA[i] = C; }
  const size_t kstep = (size_t)(BK * 2);
  const size_t hstepA = GATHER ? 0 : (size_t)HALF * S.lda * 2, hstepB = (size_t)HALF * S.ldb * 2;
  unsigned vc[2][2], vn[2][2];
#define PG8_GOFF(dst, unit) do { if (GATHER) { _Pragma("unroll") for (int _h = 0; _h < 2; ++_h) _Pragma("unroll") for (int _i = 0; _i < 2; ++_i) \
    dst[_h][_i] = (unsigned)(S.gidx[(unit).pm * 256 + _h * HALF + RA[_i]] * S.lda + CA[_i]) * 2u; } } while (0)
#define PG8_STAGE_A(bufoff, gbase, half, usenext) do { if (GATHER) { unsigned _v[2] = {(usenext) ? vn[half][0] : vc[half][0], (usenext) ? vn[half][1] : vc[half][1]}; PG8_STAGE(bufoff, gbase, _v); } \
    else PG8_STAGE(bufoff, gbase, voffA); } while (0)
  const unsigned ldsw = (unsigned)wid * 1024u;
  const int aoff = lds_byte(wr * 64 + fr, fq * 8), boff = lds_byte(wc * 32 + fr, fq * 8);
#define PG8_SA(b, h) (((b) * 2 + (h)) * HTB)
#define PG8_SB(b, h) ((4 + (b) * 2 + (h)) * HTB)
#define PG8_STAGE(bufoff, gbase, voff) do { _Pragma("unroll") for (int _i = 0; _i < 2; ++_i) \
    __builtin_amdgcn_global_load_lds((const unsigned*)((const char*)(gbase) + (voff)[_i]), (PG8_LAS unsigned*)(lds + (bufoff) + ldsw + _i * 8192), 16, 0, 0); } while (0)
#define PG8_LDA(dst, b, h) do { _Pragma("unroll") for (int m = 0; m < 4; ++m) _Pragma("unroll") for (int k = 0; k < 2; ++k) dst[m][k] = *(const PG8_LAS bf16x8*)(lds + PG8_SA(b, h) + aoff + m * 2048 + k * 1024); } while (0)
#define PG8_LDB(dst, b, h) do { _Pragma("unroll") for (int n = 0; n < 2; ++n) _Pragma("unroll") for (int k = 0; k < 2; ++k) dst[n][k] = *(const PG8_LAS bf16x8*)(lds + PG8_SB(b, h) + boff + n * 2048 + k * 1024); } while (0)
#define PG8_MMA(ai, bj, At, Bt) do { __builtin_amdgcn_s_setprio(1); _Pragma("unroll") for (int m = 0; m < 4; ++m) _Pragma("unroll") for (int n = 0; n < 2; ++n) _Pragma("unroll") for (int k = 0; k < 2; ++k) \
    acc[ai][bj][m][n] = __builtin_amdgcn_mfma_f32_16x16x32_bf16(Bt[n][k], At[m][k], acc[ai][bj][m][n], 0, 0, 0); __builtin_amdgcn_s_setprio(0); } while (0)
#define PG8_WAIT_V(n) asm volatile("s_waitcnt vmcnt(" #n ")" ::: "memory")
#define PG8_WAIT_L(n) asm volatile("s_waitcnt lgkmcnt(" #n ")" ::: "memory")
#define PG8_BAR __builtin_amdgcn_s_barrier()
#define PG8_SCHED __builtin_amdgcn_sched_barrier(0)
  Unit cur, nxt; int ui = 0;
  if (!S.next(0, cur)) return;
  f32x4 acc[2][2][4][2];
#pragma unroll
  for (int a = 0; a < 2; ++a)
#pragma unroll
    for (int b = 0; b < 2; ++b)
#pragma unroll
      for (int m = 0; m < 4; ++m)
#pragma unroll
        for (int n = 0; n < 2; ++n) acc[a][b][m][n] = (f32x4){0.f, 0.f, 0.f, 0.f};
  bf16x8 At[4][2], B0[2][2], B1[2][2];
  const char* cA = S.a_ptr(cur); const char* cB = S.b_ptr(cur);
  PG8_GOFF(vc, cur);
  PG8_STAGE(PG8_SB(0, 0), cB, voffB); PG8_STAGE_A(PG8_SA(0, 0), cA, 0, false); PG8_STAGE(PG8_SB(0, 1), cB + hstepB, voffB); PG8_STAGE_A(PG8_SA(0, 1), cA + hstepA, 1, false);
  if (wr == 1) PG8_BAR;
  PG8_WAIT_V(4); PG8_BAR;
  PG8_STAGE(PG8_SB(1, 0), cB + kstep, voffB); PG8_STAGE_A(PG8_SA(1, 0), cA + kstep, 0, false); PG8_STAGE(PG8_SB(1, 1), cB + hstepB + kstep, voffB);
  PG8_WAIT_V(6); PG8_BAR;
  for (;;) {
    const bool has_next = S.next(ui + 1, nxt);
    const char* nA = has_next ? S.a_ptr(nxt) : cA; const char* nB = has_next ? S.b_ptr(nxt) : cB;
    if (has_next) PG8_GOFF(vn, nxt); else { _Pragma("unroll") for (int _h = 0; _h < 2; ++_h) _Pragma("unroll") for (int _i = 0; _i < 2; ++_i) vn[_h][_i] = vc[_h][_i]; }
    for (int t = 0; t < nt; t += 2) {
      const bool last = (t == nt - 2);
      const char* a1 = cA + (size_t)(t + 1) * kstep;
      const char* a2 = last ? nA : cA + (size_t)(t + 2) * kstep; const char* b2 = last ? nB : cB + (size_t)(t + 2) * kstep;
      const char* a3 = a2 + kstep; const char* b3 = b2 + kstep;
      PG8_LDB(B0, 0, 0); PG8_SCHED; PG8_LDA(At, 0, 0); PG8_STAGE_A(PG8_SA(1, 1), a1 + hstepA, 1, false);
      PG8_WAIT_L(8); PG8_BAR; PG8_WAIT_L(0); PG8_MMA(0, 0, At, B0); PG8_BAR; PG8_SCHED;
      PG8_LDB(B1, 0, 1); PG8_STAGE(PG8_SB(0, 0), b2, voffB);
      PG8_BAR; PG8_WAIT_L(0); PG8_MMA(0, 1, At, B1); PG8_BAR;
      PG8_LDA(At, 0, 1); PG8_STAGE_A(PG8_SA(0, 0), a2, 0, last);
      PG8_BAR; PG8_WAIT_L(0); PG8_MMA(1, 0, At, B0); PG8_BAR; PG8_SCHED;
      PG8_STAGE(PG8_SB(0, 1), b2 + hstepB, voffB);
      PG8_WAIT_V(6); PG8_BAR; PG8_MMA(1, 1, At, B1); PG8_BAR;
      PG8_LDB(B0, 1, 0); PG8_SCHED; PG8_LDA(At, 1, 0); PG8_STAGE_A(PG8_SA(0, 1), a2 + hstepA, 1, last);
      PG8_WAIT_L(8); PG8_BAR; PG8_WAIT_L(0); PG8_MMA(0, 0, At, B0); PG8_BAR; PG8_SCHED;
      PG8_LDB(B1, 1, 1); PG8_STAGE(PG8_SB(1, 0), b3, voffB);
      PG8_BAR; PG8_WAIT_L(0); PG8_MMA(0, 1, At, B1); PG8_BAR;
      PG8_LDA(At, 1, 1); PG8_STAGE_A(PG8_SA(1, 0), a3, 0, last);
      PG8_BAR; PG8_WAIT_L(0); PG8_MMA(1, 0, At, B0); PG8_BAR; PG8_SCHED;
      PG8_STAGE(PG8_SB(1, 1), b3 + hstepB, voffB);
      PG8_WAIT_V(6); PG8_BAR; PG8_MMA(1, 1, At, B1); PG8_BAR;
    }
    E(acc, cur, wr, wc, fr, fq);
    if (!has_next) break;
#pragma unroll
    for (int a = 0; a < 2; ++a)
#pragma unroll
      for (int b = 0; b < 2; ++b)
#pragma unroll
        for (int m = 0; m < 4; ++m)
#pragma unroll
          for (int n = 0; n < 2; ++n) acc[a][b][m][n] = (f32x4){0.f, 0.f, 0.f, 0.f};
    cur = nxt; cA = nA; cB = nB; ++ui;
    _Pragma("unroll") for (int _h = 0; _h < 2; ++_h) _Pragma("unroll") for (int _i = 0; _i < 2; ++_i) vc[_h][_i] = vn[_h][_i];
  }
  PG8_WAIT_V(0);
  if (wr == 0) PG8_BAR;
  PG8_BAR;
#undef PG8_SA
#undef PG8_SB
#undef PG8_STAGE
#undef PG8_STAGE_A
#undef PG8_GOFF
#undef PG8_LDA
#undef PG8_LDB
#undef PG8_MMA
#undef PG8_WAIT_V
#undef PG8_WAIT_L
#undef PG8_BAR
#undef PG8_SCHED
}
}

struct DenseSched : pg8::GridOrder {
  const char* A; const char* Bt; int lda, ldb, K; const int* gidx;
  __device__ __forceinline__ const char* a_ptr(const pg8::Unit& u) const { return A + (size_t)u.pm * 256 * lda * 2; }
  __device__ __forceinline__ const char* b_ptr(const pg8::Unit& u) const { return Bt + (size_t)u.pn * 256 * ldb * 2; }
};
struct EpiStoreBf16 {
  static constexpr bool PERM = true, AFTER_DRAIN = false;
  bf16_t* O; int ldc;
  __device__ __forceinline__ void operator()(const pg8::f32x4 (&acc)[2][2][4][2], const pg8::Unit& u, int wr, int wc, int fr, int fq) const {
    const int row0 = u.pm * 256 + wr * 64 + fr, col0 = u.pn * 256 + wc * 32 + 8 * fq;
#pragma unroll
    for (int ai = 0; ai < 2; ++ai)
#pragma unroll
      for (int m = 0; m < 4; ++m) { bf16_t* rowp = O + (size_t)(row0 + ai * 128 + m * 16) * ldc + col0;
#pragma unroll
        for (int bj = 0; bj < 2; ++bj) { const pg8::f32x4 v0 = acc[ai][bj][m][0], v1 = acc[ai][bj][m][1];
          pg8::u32x4 w; w.x = pg8::cvt_pk_bf16(v0[0], v0[1]); w.y = pg8::cvt_pk_bf16(v0[2], v0[3]); w.z = pg8::cvt_pk_bf16(v1[0], v1[1]); w.w = pg8::cvt_pk_bf16(v1[2], v1[3]);
          *(pg8::u32x4*)(rowp + bj * 128) = w; } }
  }
};
struct EpiResidual {
  static constexpr bool PERM = false, AFTER_DRAIN = false;
  float* xl; float* xc; const float* mod;
  int chunk;
  __device__ __forceinline__ void operator()(const pg8::f32x4 (&acc)[2][2][4][2], const pg8::Unit& u, int wr, int wc, int fr, int fq) const {
    const int mj = u.pm < 32 ? 0 : (u.pm < 64 ? 1 : 2);
    float* base = u.pm < 64 ? xl + (size_t)u.pm * 256 * D : xc + (size_t)(u.pm - 64) * 256 * D;
    const float* gv = mod + ((size_t)mj * 6 + chunk) * D;
    const int row0 = wr * 64 + fr, col0 = u.pn * 256 + wc * 32 + 4 * fq;
#pragma unroll
    for (int bj = 0; bj < 2; ++bj)
#pragma unroll
      for (int n = 0; n < 2; ++n) {
        const pg8::f32x4 g = *(const pg8::f32x4*)(gv + col0 + bj * 128 + n * 16);
#pragma unroll
        for (int ai = 0; ai < 2; ++ai)
#pragma unroll
          for (int m = 0; m < 4; ++m) { pg8::f32x4* q = (pg8::f32x4*)(base + (size_t)(row0 + ai * 128 + m * 16) * D + col0 + bj * 128 + n * 16); *q = *q + g * acc[ai][bj][m][n]; }
      }
  }
};
struct MoeSched : pg8::GridOrder {
  const char* A; const char* Bt; int lda, ldb, K; size_t bstride;
  const int* gidx; bool gather;
  __device__ __forceinline__ const char* a_ptr(const pg8::Unit& u) const { return gather ? A : A + (size_t)u.pm * 256 * lda * 2; }
  __device__ __forceinline__ const char* b_ptr(const pg8::Unit& u) const { return Bt + (size_t)((u.pm >> 2) & 15) * bstride + (size_t)u.pn * 256 * ldb * 2; }
};
struct EpiSwiGLU {
  static constexpr bool PERM = true, AFTER_DRAIN = false;
  bf16_t* O;
  __device__ __forceinline__ void operator()(const pg8::f32x4 (&acc)[2][2][4][2], const pg8::Unit& u, int wr, int wc, int fr, int fq) const {
    const int row0 = u.pm * 256 + wr * 64 + fr, col0 = u.pn * 128 + wc * 16 + 4 * fq;
#pragma unroll
    for (int ai = 0; ai < 2; ++ai)
#pragma unroll
      for (int m = 0; m < 4; ++m) { bf16_t* rowp = O + (size_t)(row0 + ai * 128 + m * 16) * DEXP + col0;
#pragma unroll
        for (int bj = 0; bj < 2; ++bj) { const pg8::f32x4 v0 = acc[ai][bj][m][0], v1 = acc[ai][bj][m][1];
          const float h0 = silu_f(v0[0]) * v0[1], h1 = silu_f(v0[2]) * v0[3], h2 = silu_f(v1[0]) * v1[1], h3 = silu_f(v1[2]) * v1[3];
          uint2 w; w.x = pg8::cvt_pk_bf16(h0, h1); w.y = pg8::cvt_pk_bf16(h2, h3);
          *(uint2*)(rowp + bj * 64) = w; } }
  }
};
struct EpiGateBf16 {
  static constexpr bool PERM = true, AFTER_DRAIN = false;
  bf16_t* O; const float* gate;
  __device__ __forceinline__ void operator()(const pg8::f32x4 (&acc)[2][2][4][2], const pg8::Unit& u, int wr, int wc, int fr, int fq) const {
    const int row0 = u.pm * 256 + wr * 64 + fr, col0 = u.pn * 256 + wc * 32 + 8 * fq;
#pragma unroll
    for (int ai = 0; ai < 2; ++ai)
#pragma unroll
      for (int m = 0; m < 4; ++m) { const int row = row0 + ai * 128 + m * 16; const float g = gate[row]; bf16_t* rowp = O + (size_t)row * D + col0;
#pragma unroll
        for (int bj = 0; bj < 2; ++bj) { const pg8::f32x4 v0 = acc[ai][bj][m][0] * g, v1 = acc[ai][bj][m][1] * g;
          pg8::u32x4 w; w.x = pg8::cvt_pk_bf16(v0[0], v0[1]); w.y = pg8::cvt_pk_bf16(v0[2], v0[3]); w.z = pg8::cvt_pk_bf16(v1[0], v1[1]); w.w = pg8::cvt_pk_bf16(v1[2], v1[3]);
          *(pg8::u32x4*)(rowp + bj * 128) = w; } }
  }
};

namespace fa {
using bf16x8 = __attribute__((ext_vector_type(8))) short;
using s16x4  = __attribute__((ext_vector_type(4))) short;
using f32x16 = __attribute__((ext_vector_type(16))) float;
using u32x4  = __attribute__((ext_vector_type(4))) unsigned;
constexpr int NW = 8, QBLK = 32, KVBLK = 64, LDQK = 128, LDV = 64;
constexpr float SCALE = 0.10206207261596575f;
constexpr float THR = 8.f;
constexpr size_t SHM_V = KVBLK * 64 * 2, SHM_K = KVBLK * 128 * 2, SHM_ATTN = 2 * SHM_V + 2 * SHM_K + NW * 64 * 4;
#define FA_KSWZ(row, colB) ((row) * 256 + ((colB) ^ (((row) & 7) << 4)))
#define FA_SBAR() __builtin_amdgcn_sched_barrier(0)
__device__ __forceinline__ int crow(int r, int hi) { return (r & 3) + 8 * (r >> 2) + 4 * hi; }
__device__ __forceinline__ unsigned cvtpk(float lo, float hi) { unsigned r; asm volatile("v_cvt_pk_bf16_f32 %0, %1, %2" : "=v"(r) : "v"(lo), "v"(hi)); return r; }
__device__ __forceinline__ void partialSM(f32x16& p0, f32x16& p1, float& m_reg, float& mn, float& alpha) {
  constexpr float C = SCALE * 1.4426950408889634f;
  float pmax = p0[0];
#pragma unroll
  for (int r = 1; r < 16; ++r) pmax = fmaxf(pmax, p0[r]);
#pragma unroll
  for (int r = 0; r < 16; ++r) pmax = fmaxf(pmax, p1[r]);
  { auto rr = __builtin_amdgcn_permlane32_swap(__float_as_uint(pmax), __float_as_uint(pmax), false, false);
    pmax = fmaxf(__uint_as_float(rr[0]), __uint_as_float(rr[1])); }
  if (__builtin_expect(__all(pmax - m_reg <= THR / SCALE), 1)) { mn = m_reg; alpha = 1.f; }
  else { mn = fmaxf(m_reg, pmax); alpha = __builtin_amdgcn_exp2f((m_reg - mn) * C); m_reg = mn; }
  float mnC = -mn * C;
  p0 = p0 * C + mnC; p1 = p1 * C + mnC;
#pragma unroll
  for (int r = 0; r < 16; ++r) p0[r] = __builtin_amdgcn_exp2f(p0[r]);
}
__device__ __forceinline__ void finishSM(f32x16& p0, f32x16& p1, float alpha, float& l_reg, bf16x8& pa0, bf16x8& pa1, bf16x8& pa2, bf16x8& pa3) {
#pragma unroll
  for (int r = 0; r < 16; ++r) p1[r] = __builtin_amdgcn_exp2f(p1[r]);
  float ps;
  { const f32x16 t = p0 + p1; const auto t8 = t.lo + t.hi; const auto t4 = t8.lo + t8.hi; const auto t2 = t4.lo + t4.hi; ps = t2.x + t2.y; }
  { auto rr = __builtin_amdgcn_permlane32_swap(__float_as_uint(ps), __float_as_uint(ps), false, false);
    ps = __uint_as_float(rr[0]) + __uint_as_float(rr[1]); }
  l_reg = l_reg * alpha + ps;
#define FA_PK4(P, BASE, OUT) do { unsigned a0 = cvtpk(P[BASE + 0], P[BASE + 1]), a1 = cvtpk(P[BASE + 2], P[BASE + 3]);   \
    unsigned b0 = cvtpk(P[BASE + 4], P[BASE + 5]), b1 = cvtpk(P[BASE + 6], P[BASE + 7]);                              \
    auto r0 = __builtin_amdgcn_permlane32_swap(a0, b0, false, false); auto r1 = __builtin_amdgcn_permlane32_swap(a1, b1, false, false); \
    u32x4 w = {r0[0], r1[0], r0[1], r1[1]}; OUT = *reinterpret_cast<bf16x8*>(&w); } while (0)
  FA_PK4(p0, 0, pa0); FA_PK4(p0, 8, pa1); FA_PK4(p1, 0, pa2); FA_PK4(p1, 8, pa3);
#undef FA_PK4
}
__device__ __forceinline__ void qkt(f32x16& p0, f32x16& p1, const char* Ks, const bf16x8* qr, int r32, int hi) {
  p0 = f32x16{}; p1 = f32x16{};
#pragma unroll
  for (int d0 = 0; d0 < 6; ++d0) { int cb = (d0 * 16 + hi * 8) * 2;
    bf16x8 b0 = *reinterpret_cast<const bf16x8*>(Ks + FA_KSWZ(r32, cb));
    bf16x8 b1 = *reinterpret_cast<const bf16x8*>(Ks + FA_KSWZ(32 + r32, cb));
    p0 = __builtin_amdgcn_mfma_f32_32x32x16_bf16(b0, qr[d0], p0, 0, 0, 0);
    p1 = __builtin_amdgcn_mfma_f32_32x32x16_bf16(b1, qr[d0], p1, 0, 0, 0); }
}
__device__ __forceinline__ int v_st(int k, int c) { const int kk = (k & ~0xC) | ((k & 4) << 1) | ((k & 8) >> 1); return ((kk >> 3) * 2 + (c >> 5)) * 512 + ((kk & 7) * 32 + (c & 31)) * 2; }
__device__ __forceinline__ int v_rd_base(int lane) { return ((lane & 3) << 3) | (((lane >> 2) & 3) << 6) | (((lane >> 4) & 1) << 5) | (((lane >> 5) & 1) << 8); }
constexpr int v_rd_off(int d0, int ks, int half) { return d0 * 512 + ks * 2048 + half * 1024; }
template <int OFF> __device__ __forceinline__ s16x4 tr_read(int vb) {
  s16x4 r; asm volatile("ds_read_b64_tr_b16 %0, %1 offset:%2" : "=&v"(r) : "v"(vb), "i"(OFF) : "memory"); return r;
}
template <int D0> __device__ __forceinline__ void pv_one(f32x16& od, int vb, bf16x8 pa0, bf16x8 pa1, bf16x8 pa2, bf16x8 pa3) {
  const s16x4 l0 = tr_read<v_rd_off(D0, 0, 0)>(vb), h0 = tr_read<v_rd_off(D0, 0, 1)>(vb), l1 = tr_read<v_rd_off(D0, 1, 0)>(vb), h1 = tr_read<v_rd_off(D0, 1, 1)>(vb);
  const s16x4 l2 = tr_read<v_rd_off(D0, 2, 0)>(vb), h2 = tr_read<v_rd_off(D0, 2, 1)>(vb), l3 = tr_read<v_rd_off(D0, 3, 0)>(vb), h3 = tr_read<v_rd_off(D0, 3, 1)>(vb);
  asm volatile("s_waitcnt lgkmcnt(0)" ::: "memory"); FA_SBAR();
#define FA_PK(L, H) (bf16x8){L[0], L[1], L[2], L[3], H[0], H[1], H[2], H[3]}
  od = __builtin_amdgcn_mfma_f32_32x32x16_bf16(pa0, FA_PK(l0, h0), od, 0, 0, 0);
  od = __builtin_amdgcn_mfma_f32_32x32x16_bf16(pa1, FA_PK(l1, h1), od, 0, 0, 0);
  od = __builtin_amdgcn_mfma_f32_32x32x16_bf16(pa2, FA_PK(l2, h2), od, 0, 0, 0);
  od = __builtin_amdgcn_mfma_f32_32x32x16_bf16(pa3, FA_PK(l3, h3), od, 0, 0, 0);
#undef FA_PK
}
__device__ __forceinline__ void attn_body(const bf16_t* __restrict__ Qb, const bf16_t* __restrict__ Kh, const bf16_t* __restrict__ Vh, bf16_t* __restrict__ Ob, int ldo, int seq, char* lds, float* mlp = nullptr, int mlstride = 0) {
  const int tid = ltid(), wid = tid >> 6, lane = tid & 63, r32 = lane & 31, hi = lane >> 5;
  char* V_lds = lds; char* K_lds = lds + 2 * SHM_V;
  float* ws = (float*)(lds + 2 * SHM_V + 2 * SHM_K) + wid * 64; float* li_l = ws; float* al_l = ws + 32;
  float m_reg = -1e30f, l_reg = 0; f32x16 o[2] = {}; bf16x8 qr[6];
  const bf16_t* Qw = Qb + (long)(wid * QBLK + r32) * LDQK + hi * 8;
#pragma unroll
  for (int d0 = 0; d0 < 6; ++d0) qr[d0] = *reinterpret_cast<const bf16x8*>(Qw + d0 * 16);
  const int sr = tid >> 4, sc = (tid & 15) * 8;
  const int vr = tid >> 3, vc = (tid & 7) * 8, vst0 = v_st(vr, vc);
  const int vb0 = (int)(uintptr_t)V_lds + v_rd_base(lane);
  struct { bf16x8 vs0, ks0, ks1; } sr_[2];
#define FA_SLOAD(i, k0) do { sr_[i].vs0 = *reinterpret_cast<const bf16x8*>(&Vh[(long)((k0) + vr) * LDV + vc]); \
    sr_[i].ks0 = *reinterpret_cast<const bf16x8*>(&Kh[(long)((k0) + sr) * LDQK + sc]); sr_[i].ks1 = *reinterpret_cast<const bf16x8*>(&Kh[(long)((k0) + 32 + sr) * LDQK + sc]); } while (0)
#define FA_SWRITE(b, i) do { *(bf16x8*)(V_lds + (b) * SHM_V + vst0) = sr_[i].vs0; int kc = sc * 2;               \
    *(bf16x8*)(K_lds + (b) * SHM_K + FA_KSWZ(sr, kc)) = sr_[i].ks0;                       \
    *(bf16x8*)(K_lds + (b) * SHM_K + FA_KSWZ(32 + sr, kc)) = sr_[i].ks1; } while (0)
#define FA_SWAIT() asm volatile("s_waitcnt vmcnt(3)" ::: "memory")
#define FA_RESC(a) do { if (__any((a) < 1.f)) { if (hi == 0) al_l[r32] = (a); asm volatile("s_waitcnt lgkmcnt(0)" ::: "memory"); \
    _Pragma("unroll") for (int d = 0; d < 2; ++d) _Pragma("unroll") for (int r = 0; r < 16; ++r) o[d][r] *= al_l[crow(r, hi)]; } } while (0)
  f32x16 pA0, pA1, pB0, pB1; float mnA, mnB, alA, alB; bf16x8 pa0, pa1, pa2, pa3; const int NTL = seq / KVBLK;
  constexpr int SE = 0, SO = 1;
  __syncthreads();
  FA_SLOAD(SE, 0); asm volatile("s_waitcnt vmcnt(0)" ::: "memory"); FA_SWRITE(0, SE); __syncthreads();
  qkt(pA0, pA1, K_lds, qr, r32, hi); partialSM(pA0, pA1, m_reg, mnA, alA);
  FA_SLOAD(SO, KVBLK); if (2 < NTL) FA_SLOAD(SE, 2 * KVBLK);
  FA_SWAIT(); FA_SWRITE(1, SO); __syncthreads();
  for (int j = 1; j + 1 < NTL; j += 2) {
    FA_SBAR(); qkt(pB0, pB1, K_lds + SHM_K, qr, r32, hi);
    finishSM(pA0, pA1, alA, l_reg, pa0, pa1, pa2, pa3); FA_SBAR();
    FA_SLOAD(SO, (j + 2) * KVBLK); FA_SBAR();
    pv_one<0>(o[0], vb0, pa0, pa1, pa2, pa3); pv_one<1>(o[1], vb0, pa0, pa1, pa2, pa3); partialSM(pB0, pB1, m_reg, mnB, alB);
    __syncthreads(); FA_SWAIT(); FA_SWRITE(0, SE);
    FA_RESC(alB); __syncthreads();
    FA_SBAR(); qkt(pA0, pA1, K_lds, qr, r32, hi);
    finishSM(pB0, pB1, alB, l_reg, pa0, pa1, pa2, pa3); FA_SBAR();
    if (j + 3 < NTL) FA_SLOAD(SE, (j + 3) * KVBLK); FA_SBAR();
    pv_one<0>(o[0], vb0 + (int)SHM_V, pa0, pa1, pa2, pa3); pv_one<1>(o[1], vb0 + (int)SHM_V, pa0, pa1, pa2, pa3); partialSM(pA0, pA1, m_reg, mnA, alA);
    __syncthreads(); FA_SWAIT(); FA_SWRITE(1, SO);
    FA_RESC(alA); __syncthreads();
  }
  FA_SBAR(); qkt(pB0, pB1, K_lds + SHM_K, qr, r32, hi);
  finishSM(pA0, pA1, alA, l_reg, pa0, pa1, pa2, pa3); FA_SBAR();
  pv_one<0>(o[0], vb0, pa0, pa1, pa2, pa3); pv_one<1>(o[1], vb0, pa0, pa1, pa2, pa3); partialSM(pB0, pB1, m_reg, mnB, alB);
  __syncthreads(); FA_RESC(alB);
  finishSM(pB0, pB1, alB, l_reg, pa0, pa1, pa2, pa3); FA_SBAR();
  pv_one<0>(o[0], vb0 + (int)SHM_V, pa0, pa1, pa2, pa3); pv_one<1>(o[1], vb0 + (int)SHM_V, pa0, pa1, pa2, pa3);
  if (hi == 0) { li_l[r32] = l_reg; if (mlp) { float* q2 = mlp + (size_t)(wid * QBLK + r32) * mlstride; q2[0] = m_reg; q2[1] = l_reg; } }
  asm volatile("s_waitcnt lgkmcnt(0)" ::: "memory");
  float rli[16];
#pragma unroll
  for (int r = 0; r < 16; ++r) rli[r] = __builtin_amdgcn_rcpf(li_l[crow(r, hi)]);
  bf16_t* Ow = Ob + (long)(wid * QBLK) * ldo;
#pragma unroll
  for (int r = 0; r < 16; ++r) { int orow = crow(r, hi);
#pragma unroll
    for (int d0 = 0; d0 < 2; ++d0) Ow[(long)orow * ldo + d0 * 32 + r32] = f2bf(o[d0][r] * rli[r]); }
#undef FA_SLOAD
#undef FA_SWRITE
#undef FA_SWAIT
#undef FA_RESC
}
}

namespace gd {
using bf16x8 = __attribute__((ext_vector_type(8))) short;
using f32x4 = __attribute__((ext_vector_type(4))) float;
constexpr int NCH = 132;
constexpr size_t R_QF = 0, R_KF = 16384, R_KTF = 32768, R_VC = 49152, R_DIR = 65536, DIR_BYTES = 17408, D_TINV = 0, D_QKM = 8192, D_VEC = 16384;
constexpr size_t CHREC = R_DIR + 2 * DIR_BYTES;
__device__ __forceinline__ unsigned pk(float lo, float hi) { unsigned r; asm volatile("v_cvt_pk_bf16_f32 %0, %1, %2" : "=v"(r) : "v"(lo), "v"(hi)); return r; }
__device__ __forceinline__ bf16x8 pack8(const f32x4 a, const f32x4 b) { typedef unsigned u4 __attribute__((ext_vector_type(4))); u4 w = {pk(a[0], a[1]), pk(a[2], a[3]), pk(b[0], b[1]), pk(b[2], b[3])}; return *reinterpret_cast<bf16x8*>(&w); }
__device__ __forceinline__ int chunk_row0(int b, int c) { return c < 4 ? ML + b * TC + 64 * c : b * T + 64 * (c - 4); }
constexpr int L_Q = 0, L_K = 16384, L_V = 32768, L_KK = 49152  , L_QK = 65792, L_G = 82432  ,
              L_A = 0  , L_X0 = 32768  , L_X1 = 83968, L_AT = 100352;
__device__ __forceinline__ int swz(int row, int colB) { return row * 256 + (colB ^ ((row & 7) << 4)); }
__device__ __forceinline__ void tr_pair(int a0, int a1, uint2& lo, uint2& hi) {
  asm volatile("ds_read_b64_tr_b16 %0, %2\n\tds_read_b64_tr_b16 %1, %3\n\ts_waitcnt lgkmcnt(0)" : "=&v"(lo), "=&v"(hi) : "v"(a0), "v"(a1) : "memory");
}
__device__ __forceinline__ uint2 tr_one(int a0) {
  uint2 r; asm volatile("ds_read_b64_tr_b16 %0, %1\n\ts_waitcnt lgkmcnt(0)" : "=&v"(r) : "v"(a0) : "memory"); return r;
}

__device__ __forceinline__ void inv_offdiag(const float* A, float* X, int bi, int bj, int lane) {
  const int rc = lane & 15, g = lane >> 4;
  f32x4 t = {0.f, 0.f, 0.f, 0.f};
  for (int k = bj; k < bi; ++k) {
#pragma unroll
    for (int s4 = 0; s4 < 4; ++s4)
      t = __builtin_amdgcn_mfma_f32_16x16x4f32(A[(bi * 16 + rc) * 64 + k * 16 + s4 * 4 + g], X[(k * 16 + s4 * 4 + g) * 64 + bj * 16 + rc], t, 0, 0, 0);
  }
  f32x4 o = {0.f, 0.f, 0.f, 0.f};
#pragma unroll
  for (int r = 0; r < 4; ++r)
    o = __builtin_amdgcn_mfma_f32_16x16x4f32(X[(bi * 16 + rc) * 64 + bi * 16 + g * 4 + r], t[r], o, 0, 0, 0);
#pragma unroll
  for (int r = 0; r < 4; ++r) X[(bi * 16 + g * 4 + r) * 64 + bj * 16 + rc] = -o[r];
}
__device__ __forceinline__ void lds_barrier() { asm volatile("s_waitcnt lgkmcnt(0)" ::: "memory"); __builtin_amdgcn_s_barrier(); asm volatile("" ::: "memory"); }
constexpr int L_CW = 133120;
__device__ __forceinline__ void precompute_load(const Params& p, int b, int h, int c, int tid, uint4 (&xin)[3][4]) {
  const bf16_t* P = (const bf16_t*)(p.ws + OFF_P);
  const int row0 = chunk_row0(b, c), tlen = c < 4 ? TC : T, t0 = c < 4 ? 64 * c : 64 * (c - 4);
  const int ch8 = tid & 15, tokA = 2 * (tid >> 4);
#pragma unroll
  for (int which = 0; which < 3; ++which) {
    const int ch0 = which * 512 + h * 128 + ch8 * 8;
#pragma unroll
    for (int jj = 0; jj < 4; ++jj) { const int tt = t0 + tokA - 1 + jj;
      xin[which][jj] = (tt >= 0 && tt < tlen) ? *(const uint4*)(P + (size_t)(row0 + tokA - 1 + jj) * NINP + PC_GQ + ch0) : make_uint4(0u, 0u, 0u, 0u); }
  }
}
__device__ __forceinline__ void precompute_item(const Params& p, int l, int b, int h, int c, char* lds, int tid, const uint4 (&xin)[3][4]) {
  const int lane = tid & 63, wv = tid >> 6;
  const bf16_t* P = (const bf16_t*)(p.ws + OFF_P);
  char* rec = p.ws + OFF_RB + (size_t)((b * 4 + h) * NCH + c) * CHREC;
  const int row0 = chunk_row0(b, c);
  const int ldsb = (int)(uintptr_t)lds;
  lds_barrier();
  {
    const int ch8 = tid & 15, tg = tid >> 4, tokA = 2 * tg;
    const float* cwl = (const float*)(lds + L_CW);
#pragma unroll
    for (int which = 0; which < 3; ++which) {
      float xf[4][8];
#pragma unroll
      for (int jj = 0; jj < 4; ++jj) { const unsigned w4[4] = {xin[which][jj].x, xin[which][jj].y, xin[which][jj].z, xin[which][jj].w};
#pragma unroll
        for (int i = 0; i < 4; ++i) { xf[jj][2 * i] = __uint_as_float(w4[i] << 16); xf[jj][2 * i + 1] = __uint_as_float(w4[i] & 0xffff0000u); } }
      float wf[3][8];
#pragma unroll
      for (int j = 0; j < 3; ++j) { const float4 w0 = *(const float4*)(cwl + j * 1536 + which * 512 + h * 128 + ch8 * 8), w1 = *(const float4*)(cwl + j * 1536 + which * 512 + h * 128 + ch8 * 8 + 4);
        wf[j][0] = w0.x; wf[j][1] = w0.y; wf[j][2] = w0.z; wf[j][3] = w0.w; wf[j][4] = w1.x; wf[j][5] = w1.y; wf[j][6] = w1.z; wf[j][7] = w1.w; }
#pragma unroll
      for (int a = 0; a < 2; ++a) {
        float o[8], ss = 0.f;
#pragma unroll
        for (int i = 0; i < 8; ++i) { o[i] = silu_f(wf[0][i] * xf[a][i] + wf[1][i] * xf[a + 1][i] + wf[2][i] * xf[a + 2][i]); ss += o[i] * o[i]; }
        if (which < 2) {
          ss += __shfl_xor(ss, 1); ss += __shfl_xor(ss, 2); ss += __shfl_xor(ss, 4); ss += __shfl_xor(ss, 8);
          const float sc = rsqrtf(ss + EPS) * (which == 0 ? 0.08838834764831845f : 1.f);
#pragma unroll
          for (int i = 0; i < 8; ++i) o[i] *= sc;
        }
        uint4 w; w.x = pk(o[0], o[1]); w.y = pk(o[2], o[3]); w.z = pk(o[4], o[5]); w.w = pk(o[6], o[7]);
        *(uint4*)(lds + (which == 0 ? L_Q : (which == 1 ? L_K : L_V)) + swz(tokA + a, ch8 * 16)) = w;
      }
    }
    if (tid < 128) {
      const int d = tid >> 6, tk = tid & 63;
      const float pa = bf2f(P[(size_t)(row0 + tk) * NINP + PC_A + d * 4 + h]), pb = bf2f(P[(size_t)(row0 + tk) * NINP + PC_B + d * 4 + h]);
      float* gs = (float*)(lds + L_G);
      gs[d * 64 + tk] = -expf(p.a_log[l * 8 + d * 4 + h]) * softplus_f(pa + p.dt_bias[l * 8 + d * 4 + h]);
      gs[128 + d * 64 + tk] = sigmoid_f(pb);
    }
  }
  lds_barrier();
  if (wv == 0) {
    float* gs = (float*)(lds + L_G);
    float a0 = gs[lane], a1 = gs[64 + 63 - lane];
#pragma unroll
    for (int o = 1; o < 64; o <<= 1) { const float n0 = __shfl_up(a0, o), n1 = __shfl_up(a1, o); if (lane >= o) { a0 += n0; a1 += n1; } }
    gs[256 + lane] = a0; gs[256 + 64 + 63 - lane] = a1;
  }
  {
    const int cc = lane & 15, g = lane >> 4;
#pragma unroll
    for (int tt = 0; tt < 2; ++tt) {
      const int tile = wv * 2 + tt, mi = tile >> 2, nj = tile & 3;
      f32x4 akk = {0.f, 0.f, 0.f, 0.f}, aqk = {0.f, 0.f, 0.f, 0.f};
#pragma unroll
      for (int s4 = 0; s4 < 4; ++s4) {
        const bf16x8 ak = *(const bf16x8*)(lds + L_K + swz(mi * 16 + cc, s4 * 64 + g * 16));
        const bf16x8 aq = *(const bf16x8*)(lds + L_Q + swz(mi * 16 + cc, s4 * 64 + g * 16));
        const bf16x8 bk = *(const bf16x8*)(lds + L_K + swz(nj * 16 + cc, s4 * 64 + g * 16));
        akk = __builtin_amdgcn_mfma_f32_16x16x32_bf16(ak, bk, akk, 0, 0, 0);
        aqk = __builtin_amdgcn_mfma_f32_16x16x32_bf16(aq, bk, aqk, 0, 0, 0);
      }
      float* KK = (float*)(lds + L_KK); float* QK = (float*)(lds + L_QK);
#pragma unroll
      for (int r = 0; r < 4; ++r) { KK[(mi * 16 + g * 4 + r) * 65 + nj * 16 + cc] = akk[r]; QK[(mi * 16 + g * 4 + r) * 65 + nj * 16 + cc] = aqk[r]; }
    }
#pragma unroll
    for (int it = 0; it < 2; ++it) {
      const int item = tid + it * NT, fl = item & 63, frag = item >> 6, mt = frag >> 3, kbj = frag & 7, r = fl & 31, hl = fl >> 5;
      const int row = mt * 32 + r, cb = (kbj * 16 + hl * 4) * 2;
      uint4 wq, wk;
      { const uint2 lo = *(const uint2*)(lds + L_Q + swz(row, cb)), hi = *(const uint2*)(lds + L_Q + swz(row, cb + 16)); wq = make_uint4(lo.x, lo.y, hi.x, hi.y); }
      { const uint2 lo = *(const uint2*)(lds + L_K + swz(row, cb)), hi = *(const uint2*)(lds + L_K + swz(row, cb + 16)); wk = make_uint4(lo.x, lo.y, hi.x, hi.y); }
      *(uint4*)(rec + R_QF + (size_t)item * 16) = wq; *(uint4*)(rec + R_KF + (size_t)item * 16) = wk;
    }
#pragma unroll
    for (int it = 0; it < 2; ++it) {
      const int item = tid + it * NT, fl = item & 63, frag = item >> 6, mt = frag >> 2, kbj = frag & 3, i16 = fl & 15, gq = fl >> 4;
      const int tok0 = kbj * 16 + (gq >> 1) * 4 + (i16 >> 2), cb = (mt * 32 + (gq & 1) * 16 + (i16 & 3) * 4) * 2;
      uint2 lo, hi; tr_pair(ldsb + L_K + swz(tok0, cb), ldsb + L_K + swz(tok0 + 8, cb), lo, hi);
      *(uint4*)(rec + R_KTF + (size_t)item * 16) = make_uint4(lo.x, lo.y, hi.x, hi.y);
    }
#pragma unroll
    for (int it = 0; it < 4; ++it) {
      const int item = tid + it * NT, fl = item & 63, q = (item >> 6) & 3, mt = (item >> 8) & 1, sl = item >> 9, i16 = fl & 15, gq = fl >> 4;
      const int tok0 = mt * 32 + q * 8 + (gq >> 1) * 4 + (i16 >> 2), cb = (sl * 32 + (gq & 1) * 16 + (i16 & 3) * 4) * 2;
      const uint2 v = tr_one(ldsb + L_V + swz(tok0, cb));
      *(uint2*)(rec + R_VC + (size_t)item * 8) = v;
    }
  }
  lds_barrier();
  {
    const float* gs = (const float*)(lds + L_G); const float* KK = (const float*)(lds + L_KK);
    float* A = (float*)(lds + L_A);
#pragma unroll 4
    for (int it = 0; it < 16; ++it) {
      const int e = tid + it * NT, d = e >> 12, ip = (e >> 6) & 63, jp = e & 63, ti = d ? 63 - ip : ip, tj = d ? 63 - jp : jp;
      A[e] = ip > jp ? gs[128 + d * 64 + ti] * KK[ti * 65 + tj] * __expf(gs[256 + d * 64 + ti] - gs[256 + d * 64 + tj]) : 0.f;
    }
  }
  lds_barrier();
  if (wv < 2) {
    const float* A = (const float*)(lds + L_A) + wv * 4096; float* X = (float*)(lds + (wv ? L_X1 : L_X0));
    const int qb = lane >> 4, c16 = lane & 15;
    float x[16];
    f32x4 an[4];
#pragma unroll
    for (int q4 = 0; q4 < 4; ++q4) an[q4] = *(const f32x4*)(A + (qb * 16) * 64 + qb * 16 + q4 * 4);
#pragma unroll
    for (int r = 0; r < 16; ++r) {
      f32x4 ac[4];
#pragma unroll
      for (int q4 = 0; q4 < 4; ++q4) ac[q4] = an[q4];
      if (r < 15) {
#pragma unroll
        for (int q4 = 0; q4 < 4; ++q4) an[q4] = *(const f32x4*)(A + (qb * 16 + r + 1) * 64 + qb * 16 + q4 * 4); }
      asm volatile("" ::: "memory");
      float sacc = (r == c16) ? 1.f : 0.f;
#pragma unroll
      for (int q = 0; q < 16; ++q) if (q < r) sacc -= ac[q >> 2][q & 3] * x[q];
      x[r] = sacc;
      X[(qb * 16 + r) * 64 + qb * 16 + c16] = sacc;
    }
  } else {
    const float* gs = (const float*)(lds + L_G); const float* QK = (const float*)(lds + L_QK);
    const int t2 = tid - 128;
    for (int e = t2; e < 2 * 6 * 256; e += 384) {
      const int d = e / 1536, r6 = (e % 1536) >> 8, w = e & 255; const int bi = r6 < 3 ? 0 : (r6 < 5 ? 1 : 2), bj = r6 < 3 ? r6 + 1 : (r6 < 5 ? r6 - 1 : 3);
      ((float*)(lds + (d ? L_X1 : L_X0)))[(bi * 16 + (w >> 4)) * 64 + bj * 16 + (w & 15)] = 0.f; }
    for (int item = t2; item < 1024; item += 384) {
      const int d = item >> 9, fl = item & 63, frag = (item >> 6) & 7, mt = frag >> 2, kbj = frag & 3, r = fl & 31, hl = fl >> 5;
      const int i = mt * 32 + r; const float gci = gs[256 + d * 64 + i];
      float v[8];
#pragma unroll
      for (int j = 0; j < 8; ++j) { const int jj = kbj * 16 + 8 * (j >> 2) + 4 * hl + (j & 3); const bool ok = d ? (i <= jj) : (i >= jj);
        v[j] = ok ? QK[i * 65 + jj] * __expf(gci - gs[256 + d * 64 + jj]) : 0.f; }
      *(uint4*)(rec + R_DIR + d * DIR_BYTES + D_QKM + (size_t)(item & 511) * 16) = make_uint4(pk(v[0], v[1]), pk(v[2], v[3]), pk(v[4], v[5]), pk(v[6], v[7]));
    }
    if (t2 < 128) {
      const int d = t2 >> 6, tk = t2 & 63; float* vec = (float*)(rec + R_DIR + d * DIR_BYTES + D_VEC);
      const float gc = gs[256 + d * 64 + tk], gl = gs[256 + d * 64 + (d ? 0 : 63)];
      vec[tk] = gs[128 + d * 64 + tk]; vec[64 + tk] = __expf(gc); vec[128 + tk] = __expf(gl - gc);
      if (tk == 0) vec[192] = __expf(gl);
    }
  }
  lds_barrier();
  if (wv < 6) inv_offdiag((const float*)(lds + L_A) + (wv & 1) * 4096, (float*)(lds + ((wv & 1) ? L_X1 : L_X0)), (wv >> 1) + 1, wv >> 1, lane);
  lds_barrier();
  if (wv < 4) inv_offdiag((const float*)(lds + L_A) + (wv & 1) * 4096, (float*)(lds + ((wv & 1) ? L_X1 : L_X0)), (wv >> 1) + 2, wv >> 1, lane);
  lds_barrier();
  if (wv < 2) inv_offdiag((const float*)(lds + L_A) + wv * 4096, (float*)(lds + (wv ? L_X1 : L_X0)), 3, 0, lane);
  lds_barrier();
  {
#pragma unroll
    for (int it = 0; it < 2; ++it) {
      const int item = tid + it * NT, d = item >> 9, fl = item & 63, frag = (item >> 6) & 7, mt = frag >> 2, kbj = frag & 3, r = fl & 31, hl = fl >> 5;
      const int i = mt * 32 + r, ri = d ? 63 - i : i; const float* X = (const float*)(lds + (d ? L_X1 : L_X0)) + ri * 64; const float* bet = (const float*)(lds + L_G) + 128 + d * 64;
      float v[8];
#pragma unroll
      for (int j = 0; j < 8; ++j) { const int jj = kbj * 16 + 8 * (j >> 2) + 4 * hl + (j & 3); v[j] = X[d ? 63 - jj : jj] * bet[jj]; }
      *(uint4*)(rec + R_DIR + d * DIR_BYTES + D_TINV + (size_t)(item & 511) * 16) = make_uint4(pk(v[0], v[1]), pk(v[2], v[3]), pk(v[4], v[5]), pk(v[6], v[7]));
    }
  }
}

constexpr int SBUF_ = 74752;
template <int LW>
__device__ __forceinline__ void scan_loader(const char* recs, int dir, int half, char* smem, int lane) {
  typedef unsigned v4u __attribute__((ext_vector_type(4))); typedef __attribute__((address_space(1))) const v4u g_u4; typedef __attribute__((address_space(3))) v4u l_u4;
#define GD_CHUNK(step) (dir == 0 ? (step) : ((step) < 4 ? 3 - (step) : NCH + 3 - (step)))
#define GD_SOFF(i_) ((i_) < 48 ? (size_t)(i_) * 1024 : ((i_) < 56 ? R_VC + (size_t)half * 8192 + ((i_) - 48) * 1024 : R_DIR + (size_t)dir * DIR_BYTES + ((i_) - 56) * 1024))
#define GD_LOAD(R, step) do { const char* _b = recs + (size_t)GD_CHUNK(step) * CHREC + lane * 16; \
    _Pragma("unroll") for (int _j = 0; _j < 19; ++_j) { const int _i = LW + 4 * _j; if (_i < 73) R[_j] = *(g_u4*)(_b + GD_SOFF(_i)); } } while (0)
#define GD_WRITE(R, buf) do { char* _d = smem + (buf) * SBUF_ + lane * 16; \
    _Pragma("unroll") for (int _j = 0; _j < 19; ++_j) { const int _i = LW + 4 * _j; if (_i < 73) *(l_u4*)(_d + _i * 1024) = R[_j]; } } while (0)
  v4u RA[19], RB[19];
  GD_LOAD(RA, 0); GD_LOAD(RB, 1); GD_WRITE(RA, 0); GD_LOAD(RA, 2);
  lds_barrier();
  for (int step = 0; step < NCH; step += 2) {
    if (step + 1 < NCH) GD_WRITE(RB, 1);
    if (step + 3 < NCH) GD_LOAD(RB, step + 3);
    lds_barrier();
    if (step + 2 < NCH) GD_WRITE(RA, 0);
    if (step + 4 < NCH) GD_LOAD(RA, step + 4);
    lds_barrier();
  }
#undef GD_CHUNK
#undef GD_SOFF
#undef GD_LOAD
#undef GD_WRITE
}
constexpr int SB_QF = 0, SB_KF = 16384, SB_KTF = 32768, SB_VC = 49152, SB_TINV = 57344, SB_QKM = 65536, SB_VEC = 73728, SBUF = 74752;
using f32x16 = __attribute__((ext_vector_type(16))) float;
__device__ __forceinline__ unsigned pkb(float lo, float hi) {
  typedef __bf16 bf2 __attribute__((ext_vector_type(2))); typedef float f2 __attribute__((ext_vector_type(2)));
  bf2 r = __builtin_convertvector((f2){lo, hi}, bf2); return *reinterpret_cast<unsigned*>(&r);
}
template <int J> __device__ __forceinline__ bf16x8 pack16(const f32x16& v) {
  typedef unsigned u4 __attribute__((ext_vector_type(4)));
  u4 w = {pk(v[8 * J], v[8 * J + 1]), pk(v[8 * J + 2], v[8 * J + 3]), pk(v[8 * J + 4], v[8 * J + 5]), pk(v[8 * J + 6], v[8 * J + 7])};
  return *reinterpret_cast<bf16x8*>(&w);
}
typedef __attribute__((address_space(1))) char gchar; typedef __attribute__((address_space(1))) bf16_t gbf16;
#define GD_STO(o, I, MT) do { const unsigned _w = pk(o[I], o[(I) + 1]); gchar* _rb = Pst + (size_t)((MT) * 32 + 8 * ((I) >> 2) + ((I) & 3)) * (NINP * 2); asm volatile("" : "+s"(_rb)); \
    *(gbf16*)(_rb + voff) = (bf16_t)_w; *(gbf16*)(_rb + voff1) = (bf16_t)(_w >> 16); } while (0)
__device__ __forceinline__ void scan_unit_lds(const Params& p, int unit_, char* smem, int tid) {
  const int wv = __builtin_amdgcn_readfirstlane(tid >> 6), lane = tid & 63, unit = __builtin_amdgcn_readfirstlane(unit_);
  const int chain = unit >> 1, half = unit & 1, dir = chain & 1, h = (chain >> 1) & 3, b = chain >> 3;
  const char* recs = p.ws + OFF_RB + (size_t)((b * 4 + h) * NCH) * CHREC;
#define GD_CHUNK(step) (dir == 0 ? (step) : ((step) < 4 ? 3 - (step) : NCH + 3 - (step)))
  if (wv >= 4) {
    if (wv == 4) scan_loader<0>(recs, dir, half, smem, lane); else if (wv == 5) scan_loader<1>(recs, dir, half, smem, lane);
    else if (wv == 6) scan_loader<2>(recs, dir, half, smem, lane); else scan_loader<3>(recs, dir, half, smem, lane);
    return;
  }
  if (wv >= 2) {
    for (int i = 0; i <= NCH; ++i) lds_barrier();
    return;
  }
  lds_barrier();
  const int c32 = lane & 31, hl = lane >> 5;
  const unsigned voff_ = (unsigned)(c32 * 2 + hl * 4 * NINP * 2);
  gchar* Pc = (gchar*)(p.ws + OFF_P + (size_t)((dir ? PC_OB : PC_OF) + h * 128 + (half * 2 + wv) * 32) * 2);
  gchar* Pprev = (gchar*)(p.ws + OFF_P + (size_t)(PC_GV + h * 128 + (half * 2 + wv) * 32) * 2 + (size_t)chunk_row0(b, GD_CHUNK(0)) * (NINP * 2));
  f32x16 S[4], ks0, ks1, oq0, oq1, vn0, vn1;
  bf16x8 f0[8], f1[8], Sb[8], Rb[4], Vb[4], VFb[4];
  typedef unsigned u4 __attribute__((ext_vector_type(4)));
#pragma unroll
  for (int t = 0; t < 4; ++t)
#pragma unroll
    for (int i = 0; i < 16; ++i) S[t][i] = 0.f;
#pragma unroll
  for (int i = 0; i < 16; ++i) { oq0[i] = 0.f; oq1[i] = 0.f; }
#pragma unroll
  for (int k = 0; k < 8; ++k) { Sb[k] = (bf16x8){0, 0, 0, 0, 0, 0, 0, 0}; f0[k] = ((const bf16x8*)(smem + SB_KF))[k * 64 + lane]; }
#define GD_SB() __builtin_amdgcn_sched_barrier(0)
#define GD_MF(a, b, c) c = __builtin_amdgcn_mfma_f32_32x32x16_bf16(a, b, c, 0, 0, 0)
#define GD_ZERO(a) do { _Pragma("unroll") for (int _i = 0; _i < 16; ++_i) a[_i] = 0.f; } while (0)
#define GD_LO(w) __uint_as_float((w) << 16)
#define GD_HI(w) __uint_as_float((w) & 0xffff0000u)
#define GD_RLOAD(vA, vB, eA, eB, MT, HQ) do { vA = VC[((MT) * 4 + 2 * (HQ)) * 64 + lane]; vB = VC[((MT) * 4 + 2 * (HQ) + 1) * 64 + lane]; \
    eA = *(const f32x4*)(vec + 64 + (MT) * 32 + (HQ) * 16); eB = *(const f32x4*)(vec + 64 + (MT) * 32 + (HQ) * 16 + 8); } while (0)
#define GD_RC2(ks, v, e, I0, wa, wb) do { wa = pk(GD_LO(v.x) - e[0] * ks[(I0)], GD_HI(v.x) - e[1] * ks[(I0) + 1]); wb = pk(GD_LO(v.y) - e[2] * ks[(I0) + 2], GD_HI(v.y) - e[3] * ks[(I0) + 3]); } while (0)
#define GD_VF2(vn, e, I0, wa, wb) do { wa = pk(vn[(I0)] * e[0], vn[(I0) + 1] * e[1]); wb = pk(vn[(I0) + 2] * e[2], vn[(I0) + 3] * e[3]); } while (0)
#define GD_W4(dst) do { const u4 _w = {w0, w1, w2, w3}; dst = *reinterpret_cast<const bf16x8*>(&_w); } while (0)
#define GD_FLOAD(eA, eB, MT, HQ) do { eA = *(const f32x4*)(vec + 128 + (MT) * 32 + (HQ) * 16); eB = *(const f32x4*)(vec + 128 + (MT) * 32 + (HQ) * 16 + 8); } while (0)
#define GD_ELOAD(eA, eB, MT, HQ) do { eA = *(const f32x4*)(vec + 64 + (MT) * 32 + (HQ) * 16); eB = *(const f32x4*)(vec + 64 + (MT) * 32 + (HQ) * 16 + 8); } while (0)
#define GD_OINIT(oq, eA, eB, HQ) do { _Pragma("unroll") for (int _r = 0; _r < 4; ++_r) { oq[8 * (HQ) + _r] *= eA[_r]; oq[8 * (HQ) + 4 + _r] *= eB[_r]; } } while (0)
#define GD_SCALE(St, I0) do { float _e = egl; asm volatile("" : "+v"(_e)); _Pragma("unroll") for (int _r = 0; _r < 4; ++_r) St[(I0) + _r] *= _e; } while (0)
  uint2 vXA, vXB, vYA, vYB; f32x4 eXA, eXB, eYA, eYB, gXA, gXB, gYA, gYB; float egl; unsigned w0, w1, w2, w3;
  for (int step = 0; step < NCH; ++step) {
    const char* buf = smem + (step & 1) * SBUF; const char* nbuf = smem + ((step + 1) & 1) * SBUF;
    const bf16x8* QF = (const bf16x8*)(buf + SB_QF); const bf16x8* KF = (const bf16x8*)(buf + SB_KF); const bf16x8* KTF = (const bf16x8*)(buf + SB_KTF);
    const bf16x8* KFn = (const bf16x8*)(nbuf + SB_KF);
    const uint2* VC = (const uint2*)(buf + SB_VC + wv * 4096);
    const bf16x8* TF = (const bf16x8*)(buf + SB_TINV); const bf16x8* QKF = (const bf16x8*)(buf + SB_QKM); const float* vec = (const float*)(buf + SB_VEC) + 4 * hl;
    gchar* Pst = Pprev;
    unsigned voff = voff_; asm volatile("" : "+v"(voff)); unsigned voff1 = voff_ + NINP * 2; asm volatile("" : "+v"(voff1));
    GD_ZERO(ks0);
    GD_SB();
#pragma unroll
    for (int k = 0; k < 8; ++k) {
      GD_MF(f0[k], Sb[k], ks0);
      f1[k] = KF[(8 + k) * 64 + lane];
      if (k < 4) { GD_STO(oq0, 4 * k, 0); GD_STO(oq0, 4 * k + 2, 0); } else { GD_STO(oq1, 4 * (k - 4), 1); GD_STO(oq1, 4 * (k - 4) + 2, 1); }
      if (k == 6) GD_RLOAD(vXA, vXB, eXA, eXB, 0, 0);
      if (k == 7) { GD_RLOAD(vYA, vYB, eYA, eYB, 0, 1); GD_ZERO(ks1); }
      GD_SB();
    }
#pragma unroll
    for (int k = 0; k < 8; ++k) {
      GD_MF(f1[k], Sb[k], ks1);
      f0[k] = QF[k * 64 + lane];
      if (k == 1) GD_RC2(ks0, vXA, eXA, 0, w0, w1);
      if (k == 2) { GD_RC2(ks0, vXB, eXB, 4, w2, w3); GD_W4(Rb[0]); }
      if (k == 3) GD_RC2(ks0, vYA, eYA, 8, w0, w1);
      if (k == 4) { GD_RC2(ks0, vYB, eYB, 12, w2, w3); GD_W4(Rb[1]); }
      if (k == 5) GD_RLOAD(vXA, vXB, eXA, eXB, 1, 0);
      if (k == 6) GD_RLOAD(vYA, vYB, eYA, eYB, 1, 1);
      if (k == 7) { GD_ZERO(oq0); }
      GD_SB();
    }
#pragma unroll
    for (int k = 0; k < 8; ++k) {
      GD_MF(f0[k], Sb[k], oq0);
      f1[k] = QF[(8 + k) * 64 + lane];
      if (k == 1) GD_RC2(ks1, vXA, eXA, 0, w0, w1);
      if (k == 2) { GD_RC2(ks1, vXB, eXB, 4, w2, w3); GD_W4(Rb[2]); }
      if (k == 3) GD_RC2(ks1, vYA, eYA, 8, w0, w1);
      if (k == 4) { GD_RC2(ks1, vYB, eYB, 12, w2, w3); GD_W4(Rb[3]); }
      if (k == 6) egl = vec[192 - 4 * hl];
      if (k == 7) { GD_ZERO(oq1); }
      GD_SB();
    }
#pragma unroll
    for (int k = 0; k < 8; ++k) {
      GD_MF(f1[k], Sb[k], oq1);
      f0[k] = TF[k * 64 + lane];
      GD_SCALE(S[k >> 2], 4 * (k & 3)); GD_SCALE(S[2 + (k >> 2)], 4 * (k & 3));
      if (k == 6) { GD_FLOAD(gXA, gXB, 0, 0); GD_FLOAD(gYA, gYB, 0, 1); }
      if (k == 7) { GD_ZERO(vn0); GD_ZERO(vn1); }
      GD_SB();
    }
#pragma unroll
    for (int k = 0; k < 8; ++k) {
      if (k < 4) GD_MF(f0[k], Rb[k], vn0); else GD_MF(f0[k], Rb[k - 4], vn1);
      f1[k] = KTF[k * 64 + lane];
      if (k == 5) GD_VF2(vn0, gXA, 0, w0, w1);
      if (k == 6) { GD_VF2(vn0, gXB, 4, w2, w3); GD_W4(VFb[0]); }
      if (k == 7) { GD_VF2(vn0, gYA, 8, w0, w1); GD_FLOAD(gXA, gXB, 1, 0); }
      GD_SB();
    }
#pragma unroll
    for (int k = 0; k < 8; ++k) {
      if (k == 0) GD_MF(f1[0], VFb[0], S[0]); if (k == 1) GD_MF(f1[4], VFb[0], S[1]); if (k == 2) GD_MF(f1[1], VFb[1], S[0]); if (k == 3) GD_MF(f1[5], VFb[1], S[1]);
      if (k == 4) GD_MF(f1[2], VFb[2], S[0]); if (k == 5) GD_MF(f1[6], VFb[2], S[1]); if (k == 6) GD_MF(f1[3], VFb[3], S[0]); if (k == 7) GD_MF(f1[7], VFb[3], S[1]);
      f0[k] = KTF[(8 + k) * 64 + lane];
      if (k == 0) { GD_VF2(vn0, gYB, 12, w2, w3); GD_W4(VFb[1]); }
      if (k == 1) { GD_VF2(vn1, gXA, 0, w0, w1); GD_FLOAD(gYA, gYB, 1, 1); }
      if (k == 2) { GD_VF2(vn1, gXB, 4, w2, w3); GD_W4(VFb[2]); }
      if (k == 3) GD_VF2(vn1, gYA, 8, w0, w1);
      if (k == 4) { GD_VF2(vn1, gYB, 12, w2, w3); GD_W4(VFb[3]); }
      if (k == 5) Vb[0] = pack16<0>(vn0);
      if (k == 6) { Vb[1] = pack16<1>(vn0); GD_ELOAD(eXA, eXB, 0, 0); }
      if (k == 7) { Vb[2] = pack16<0>(vn1); GD_ELOAD(eYA, eYB, 0, 1); }
      GD_SB();
    }
#pragma unroll
    for (int k = 0; k < 8; ++k) {
      if (k < 4) GD_MF(f0[k], VFb[k], S[2]); else GD_MF(f0[k], VFb[k - 4], S[3]);
      if (k < 4) { f1[2 * k] = QKF[(2 * k) * 64 + lane]; f1[2 * k + 1] = QKF[(2 * k + 1) * 64 + lane]; }
      if (k == 0) GD_OINIT(oq0, eXA, eXB, 0);
      if (k == 1) { GD_OINIT(oq0, eYA, eYB, 1); GD_ELOAD(eXA, eXB, 1, 0); }
      if (k == 2) { GD_ELOAD(eYA, eYB, 1, 1); Vb[3] = pack16<1>(vn1); Sb[0] = pack16<0>(S[0]); }
      if (k == 3) GD_OINIT(oq1, eXA, eXB, 0);
      if (k == 4) GD_OINIT(oq1, eYA, eYB, 1);
      if (k == 5) Sb[1] = pack16<1>(S[0]);
      if (k == 6) Sb[2] = pack16<0>(S[1]);
      if (k == 7) Sb[3] = pack16<1>(S[1]);
      GD_SB();
    }
    Pprev = Pc + (size_t)chunk_row0(b, GD_CHUNK(step)) * (NINP * 2);
    lds_barrier();
    GD_SB();
#pragma unroll
    for (int k = 0; k < 8; ++k) {
      if (k < 4) GD_MF(f1[k], Vb[k], oq0); else GD_MF(f1[k], Vb[k - 4], oq1);
      f0[k] = KFn[k * 64 + lane];
      if (k == 0) Sb[4] = pack16<0>(S[2]);
      if (k == 1) Sb[5] = pack16<1>(S[2]);
      if (k == 2) Sb[6] = pack16<0>(S[3]);
      if (k == 3) Sb[7] = pack16<1>(S[3]);
      GD_SB();
    }
  }
  {
    gchar* Pst = Pprev; const unsigned voff = voff_, voff1 = voff_ + NINP * 2;
#pragma unroll
    for (int k = 0; k < 8; ++k) { if (k < 4) { GD_STO(oq0, 4 * k, 0); GD_STO(oq0, 4 * k + 2, 0); } else { GD_STO(oq1, 4 * (k - 4), 1); GD_STO(oq1, 4 * (k - 4) + 2, 1); } }
  }
#undef GD_SB
#undef GD_MF
#undef GD_ZERO
#undef GD_LO
#undef GD_HI
#undef GD_RLOAD
#undef GD_RC2
#undef GD_VF2
#undef GD_W4
#undef GD_FLOAD
#undef GD_ELOAD
#undef GD_OINIT
#undef GD_SCALE
#undef GD_CHUNK
}
#undef GD_STO
}

__device__ __forceinline__ void ph_init_ada(const Params& p) {
  const int TIDX = ltid(); const int BIDX = lbid();
  const size_t n = (size_t)MR * D, gt = (size_t)BIDX * NT + TIDX, gs = (size_t)gridDim.x * NT;
  for (size_t i = gt; i < n; i += gs) {
    int r = (int)(i / D), cc = (int)(i % D);
    xrow(p, r)[cc] = r < ML ? p.x[i] : p.ctx[(size_t)(r - ML) * D + cc];
  }
}
__device__ __forceinline__ void ph_modulate(const Params& p, int l, int which, int nrows) {
  const int TIDX = ltid(); const int BIDX = lbid();
  const int lane = TIDX & 63, wv = TIDX >> 6;
  for (int r = BIDX * 8 + wv; r < nrows; r += gridDim.x * 8) {
    int mj, t, tlen, r0; rowinfo(r, mj, t, tlen, r0);
    const float* xr = xrow_src(p, r, l);
    const float* g = (which ? p.norm2_g : p.norm1_g) + l * D;
    const float* sh = modvec(p, l, mj, which ? 3 : 0); const float* sc = modvec(p, l, mj, which ? 4 : 1);
    float v[16], ss = 0;
#pragma unroll
    for (int i = 0; i < 16; ++i) { v[i] = xr[lane + i * 64]; ss += v[i] * v[i]; }
    ss = wave_sum(ss);
    const float rstd = rsqrtf(ss / D + EPS);
    bf16_t* h = (bf16_t*)(p.ws + OFF_H) + (size_t)r * D;
#pragma unroll
    for (int i = 0; i < 16; ++i) { int cc = lane + i * 64; v[i] = v[i] * rstd * g[cc] * (1.f + sc[cc]) + sh[cc]; h[cc] = f2bf(v[i]); }
    if (which) {
      const float* wr = p.router + (size_t)l * D * NE;
      float lo[16];
#pragma unroll
      for (int e = 0; e < 16; ++e) lo[e] = 0.f;
#pragma unroll
      for (int i = 0; i < 16; ++i) { int cc = lane + i * 64;
#pragma unroll
        for (int e = 0; e < 16; ++e) lo[e] += v[i] * wr[cc * NE + e]; }
      float mx = -1e30f;
#pragma unroll
      for (int e = 0; e < 16; ++e) { lo[e] = wave_sum(lo[e]); mx = fmaxf(mx, lo[e]); }
      float sum = 0;
#pragma unroll
      for (int e = 0; e < 16; ++e) { lo[e] = expf(lo[e] - mx); sum += lo[e]; }
      float* afft = (float*)(p.ws + OFF_AFFT);
      if (lane == 0) {
#pragma unroll
        for (int e = 0; e < 16; ++e) afft[(size_t)e * MR + r] = lo[e] / sum;
      }
    }
  }
}

__device__ __forceinline__ constexpr int ngemm_lds_floats() { return 16 * 65 + 16 * 129; }
template <typename LoadA, typename LoadB, typename Epi>
__device__ __forceinline__ void ngemm_tile(float* lds, int M, int N, int K, int tm, int tn, LoadA lda_, LoadB ldb_, Epi epi) {
  float (*sA)[65] = (float (*)[65])lds; float (*sB)[129] = (float (*)[129])(lds + 16 * 65);
  const int tid = ltid(), tx = tid & 31, ty = tid >> 5;
  float acc[4][4];
#pragma unroll
  for (int i = 0; i < 4; ++i)
#pragma unroll
    for (int j = 0; j < 4; ++j) acc[i][j] = 0.f;
  for (int k0 = 0; k0 < K; k0 += 16) {
#pragma unroll
    for (int i = 0; i < 2; ++i) { int e = tid + i * 512; int rr = e >> 4, kk = e & 15; int gr = tm * 64 + rr; sA[kk][rr] = gr < M ? lda_(gr, k0 + kk) : 0.f; }
#pragma unroll
    for (int i = 0; i < 4; ++i) { int e = tid + i * 512; int kk = e >> 7, cc = e & 127; int gc = tn * 128 + cc; sB[kk][cc] = gc < N ? ldb_(k0 + kk, gc) : 0.f; }
    __syncthreads();
#pragma unroll
    for (int kk = 0; kk < 16; ++kk) {
      float a[4], b[4];
#pragma unroll
      for (int i = 0; i < 4; ++i) { a[i] = sA[kk][ty * 4 + i]; b[i] = sB[kk][tx * 4 + i]; }
#pragma unroll
      for (int i = 0; i < 4; ++i)
#pragma unroll
        for (int j = 0; j < 4; ++j) acc[i][j] += a[i] * b[j];
    }
    __syncthreads();
  }
#pragma unroll
  for (int i = 0; i < 4; ++i)
#pragma unroll
    for (int j = 0; j < 4; ++j) { int rr = tm * 64 + ty * 4 + i, cc = tn * 128 + tx * 4 + j; if (rr < M && cc < N) epi(rr, cc, acc[i][j]); }
}

__device__ __forceinline__ void ph_inproj(const Params& p, int l, float* lds) {
  const int TIDX = ltid(); const int BIDX = lbid();
  const bf16_t* H = (const bf16_t*)(p.ws + OFF_H); const float* W = p.w_in + (size_t)l * D * NIN; bf16_t* P = (bf16_t*)(p.ws + OFF_P);
  const int ntn = (NIN + 127) / 128, ntm = MR / 64;
  for (int vb = BIDX; vb < ntn * ntm; vb += gridDim.x)
    ngemm_tile(lds, MR, NIN, D, vb / ntn, vb % ntn,
               [&](int r, int k) { return bf2f(H[(size_t)r * D + k]); },
               [&](int k, int n) { return W[(size_t)k * NIN + n]; },
               [&](int r, int n, float v) { P[(size_t)r * NINP + n] = f2bf(v); });
}

__device__ __forceinline__ void ph_mla(const Params& p, int l, float* lds) {
  const int TIDX = ltid(); const int BIDX = lbid();
  float* pq = lds; float* pkv = pq + 192; float* pkr = pkv + 128; float* qraw = pkr + 32; float* kvraw = qraw + 384; float* qn = kvraw + 512; float* kn = qn + 384; float* red = kn + 384;
  const int tid = TIDX;
  for (int r = BIDX; r < MR; r += gridDim.x) {
    int mj, t, tlen, r0; rowinfo(r, mj, t, tlen, r0);
    const bf16_t* P = (const bf16_t*)(p.ws + OFF_P) + (size_t)r * NINP;
    __syncthreads();
    if (tid < 192) pq[tid] = bf2f(P[PC_Q + tid]);
    if (tid < 128) pkv[tid] = bf2f(P[PC_KV + tid]);
    if (tid < 32) pkr[tid] = bf2f(P[PC_KR + tid]);
    __syncthreads();
    if (tid < 64) { float s = 0; for (int k = tid; k < 192; k += 64) s += pq[k] * pq[k]; s = wave_sum(s); if (tid == 0) red[0] = rsqrtf(s / 192.f + EPS); }
    else if (tid < 128) { float s = 0; for (int k = tid - 64; k < 128; k += 64) s += pkv[k] * pkv[k]; s = wave_sum(s); if (tid == 64) red[1] = rsqrtf(s / 128.f + EPS); }
    __syncthreads();
    const float rq = red[0], rkv = red[1];
    const float* wuq = p.w_uq + (size_t)l * 192 * 384; const float* qan = p.q_a_norm + l * 192;
    const float* wukv = p.w_ukv + (size_t)l * 128 * 512; const float* kvan = p.kv_a_norm + l * 128;
    if (tid < 384) { float a = 0; for (int k = 0; k < 192; ++k) a += pq[k] * rq * qan[k] * wuq[k * 384 + tid]; qraw[tid] = a; }
    { float a = 0; for (int k = 0; k < 128; ++k) a += pkv[k] * rkv * kvan[k] * wukv[k * 512 + tid]; kvraw[tid] = a; }
    __syncthreads();
    const float* qnw = p.q_norm + l * 96; const float* knw = p.k_norm + l * 96;
    if (tid < 384) {
      int h = tid / 96, d = tid % 96;
      float sq = 0, sk = 0;
      for (int dd = 0; dd < 96; ++dd) { float a = qraw[h * 96 + dd]; sq += a * a; float b = dd < 64 ? kvraw[h * 128 + dd] : pkr[dd - 64]; sk += b * b; }
      float kval = d < 64 ? kvraw[h * 128 + d] : pkr[d - 64];
      qn[tid] = qraw[tid] * rsqrtf(sq / 96.f + EPS) * qnw[d];
      kn[tid] = kval * rsqrtf(sk / 96.f + EPS) * knw[d];
    }
    __syncthreads();
    const bool lat = r < ML; const int b = lat ? (r >> 13) : ((r - ML) >> 8); const int pos = lat ? TC + t : t;
    bf16_t* Q = (bf16_t*)(p.ws + OFF_QKV); bf16_t* Kb = Q + QK_ELEMS; bf16_t* Vb = Kb + QK_ELEMS;
    {
      int h = tid >> 7, d = tid & 127;
      float qv = 0, kv = 0;
      if (d < 96) {
        qv = qn[h * 96 + d]; kv = kn[h * 96 + d];
        if (lat && d >= 64) {
          int part = (d - 64) >> 4, w = (d - 64) & 15, i = w & 7; bool first = w < 8;
          float posv = part == 0 ? (float)(t >> 6) : (float)(t & 63);
          float invf = powf(10000.f, -(float)i / 8.f);
          float ang = posv * invf, cs = cosf(ang), sn = sinf(ang);
          int i1 = h * 96 + 64 + part * 16 + i, i2 = i1 + 8;
          qv = first ? qn[i1] * cs - qn[i2] * sn : qn[i2] * cs + qn[i1] * sn;
          kv = first ? kn[i1] * cs - kn[i2] * sn : kn[i2] * cs + kn[i1] * sn;
        }
      }
      size_t o = ((size_t)(b * 4 + h) * TK + pos) * 128 + d;
      Q[o] = f2bf(qv); Kb[o] = f2bf(kv);
      if (d < 64) Vb[((size_t)(b * 4 + h) * TK + pos) * 64 + d] = f2bf(kvraw[h * 128 + 64 + d]);
    }
  }
}

__device__ __forceinline__ void ph_gdnprep(const Params& p, int l, float* lds) {
  const int TIDX = ltid(); const int BIDX = lbid();
  float* cv = lds; float* rs = lds + 1536;
  const int tid = TIDX;
  const bf16_t* P = (const bf16_t*)(p.ws + OFF_P);
  const float* cw = p.conv_w + (size_t)l * 3 * 1536;
  for (int r = BIDX; r < MR; r += gridDim.x) {
    int mj, t, tlen, r0; rowinfo(r, mj, t, tlen, r0);
    __syncthreads();
    for (int c = tid; c < 1536; c += NT) {
      float a = 0;
      for (int j = 0; j < 3; ++j) { int tt = t + j - 1; if (tt >= 0 && tt < tlen) a += cw[j * 1536 + c] * bf2f(P[(size_t)(r0 + tt) * NINP + PC_GQ + c]); }
      cv[c] = silu_f(a);
    }
    __syncthreads();
    if (tid < 8) { float s = 0; for (int d = 0; d < 128; ++d) { float v = cv[tid * 128 + d]; s += v * v; } rs[tid] = rsqrtf(s + EPS) * (tid < 4 ? 0.08838834764831845f : 1.f); }
    __syncthreads();
    float* G = (float*)(p.ws + OFF_RB) + (size_t)r * 1536;
    for (int c = tid; c < 1536; c += NT) G[c] = c < 1024 ? cv[c] * rs[c >> 7] : cv[c];
    if (tid < 8) {
      float* gb = (float*)(p.ws + OFF_GB) + (size_t)r * 16;
      float pa = bf2f(P[(size_t)r * NINP + PC_A + tid]), pb = bf2f(P[(size_t)r * NINP + PC_B + tid]);
      gb[tid] = -expf(p.a_log[l * 8 + tid]) * softplus_f(pa + p.dt_bias[l * 8 + tid]);
      gb[8 + tid] = sigmoid_f(pb);
    }
  }
}
__device__ __forceinline__ void ph_scan(const Params& p, float* lds) {
  const int TIDX = ltid(); const int BIDX = lbid();
  if (BIDX >= 16) return;
  float* sk = lds; float* sq = lds + 128; float* red = lds + 256; float* red2 = lds + 256 + 512;
  const int tid = TIDX, e = tid & 127, part = tid >> 7;
  const int chain = BIDX, dir = chain & 1, h = (chain >> 1) & 3, b = chain >> 3;
  const float* G = (const float*)(p.ws + OFF_RB); const float* GB = (const float*)(p.ws + OFF_GB);
  bf16_t* P = (bf16_t*)(p.ws + OFF_P);
  float S[32];
#pragma unroll
  for (int d = 0; d < 32; ++d) S[d] = 0.f;
  __syncthreads();
  for (int step = 0; step < TC + T; ++step) {
    int row;
    if (step < TC) row = ML + b * TC + (dir ? TC - 1 - step : step);
    else { int i = step - TC; row = b * T + (dir ? T - 1 - i : i); }
    const float* q = G + (size_t)row * 1536 + h * 128; const float* k = q + 512; const float v = q[1024 + e];
    if (tid < 128) sk[tid] = k[tid]; else if (tid < 256) sq[tid - 128] = q[tid - 128];
    const float g = GB[(size_t)row * 16 + dir * 4 + h], beta = GB[(size_t)row * 16 + 8 + dir * 4 + h];
    const float eg = expf(g);
    __syncthreads();
    float ks = 0;
#pragma unroll
    for (int d = 0; d < 32; ++d) ks += sk[part * 32 + d] * S[d];
    red[part * 128 + e] = ks;
    __syncthreads();
    ks = red[e] + red[128 + e] + red[256 + e] + red[384 + e];
    const float vn = beta * (v - eg * ks);
    float o = 0;
#pragma unroll
    for (int d = 0; d < 32; ++d) { S[d] = eg * S[d] + sk[part * 32 + d] * vn; o += sq[part * 32 + d] * S[d]; }
    red2[part * 128 + e] = o;
    __syncthreads();
    if (part == 0) P[(size_t)row * NINP + (dir ? PC_OB : PC_OF) + h * 128 + e] = f2bf(red2[e] + red2[128 + e] + red2[256 + e] + red2[384 + e]);
  }
  __syncthreads();
}
__device__ __forceinline__ void ph_attn(const Params& p, bool need_ctx, float* lds) {
  const int TIDX = ltid(); const int BIDX = lbid();
  float (*sK)[96] = (float (*)[96])lds; float (*sV)[64] = (float (*)[64])(lds + 32 * 96);
  const int tid = TIDX;
  const int nlat = NB * 4 * (T / NT), nitem = nlat + (need_ctx ? NB * 4 : 0);
  const bf16_t* Q = (const bf16_t*)(p.ws + OFF_QKV); const bf16_t* Kb = Q + QK_ELEMS; const bf16_t* Vb = Kb + QK_ELEMS;
  for (int it = gridDim.x - 1 - BIDX; it < nitem; it += gridDim.x) {
    const bool ctxq = it >= nlat;
    int b, h, qt;
    if (!ctxq) { qt = it % (T / NT); h = (it / (T / NT)) & 3; b = it / (4 * (T / NT)); } else { int j = it - nlat; qt = 0; h = j & 3; b = j >> 2; }
    const bool active = !ctxq || tid < TC;
    const int qpos = ctxq ? (active ? tid : 0) : TC + qt * NT + tid;
    const int nk = ctxq ? TC : TK;
    const size_t bh = (size_t)(b * 4 + h) * TK;
    float q[96], o[64];
#pragma unroll
    for (int d = 0; d < 96; ++d) q[d] = bf2f(Q[(bh + qpos) * 128 + d]);
#pragma unroll
    for (int d = 0; d < 64; ++d) o[d] = 0.f;
    float m = -1e30f, lsum = 0.f;
    const float scale = 0.10206207261596575f;
    for (int k0 = 0; k0 < nk; k0 += 32) {
      __syncthreads();
      for (int e = tid; e < 32 * 96; e += NT) { int j = e / 96, d = e % 96; sK[j][d] = bf2f(Kb[(bh + k0 + j) * 128 + d]); }
      for (int e = tid; e < 32 * 64; e += NT) { int j = e >> 6, d = e & 63; sV[j][d] = bf2f(Vb[(bh + k0 + j) * 64 + d]); }
      __syncthreads();
      for (int j = 0; j < 32; ++j) {
        float s = 0;
#pragma unroll
        for (int d = 0; d < 96; ++d) s += q[d] * sK[j][d];
        s *= scale;
        if (s > m) { float a = __expf(m - s); lsum *= a;
#pragma unroll
          for (int d = 0; d < 64; ++d) o[d] *= a;
          m = s; }
        float pe = __expf(s - m); lsum += pe;
#pragma unroll
        for (int d = 0; d < 64; ++d) o[d] += pe * sV[j][d];
      }
    }
    if (active) {
      const int row = ctxq ? ML + b * TC + qpos : b * T + (qpos - TC);
      bf16_t* cat = (bf16_t*)(p.ws + OFF_H) + (size_t)row * D + h * 64;
      float inv = 1.f / lsum;
#pragma unroll
      for (int d = 0; d < 64; ++d) cat[d] = f2bf(o[d] * inv);
    }
  }
}
__device__ __forceinline__ void ph_gdnfin_pool(const Params& p, int l, int nrows, float* lds) {
  const int TIDX = ltid(); const int BIDX = lbid();
  float* ov = lds; float* rs = lds + 512; float* dv = lds + 520;
  const int tid = TIDX;
  const bf16_t* P = (const bf16_t*)(p.ws + OFF_P);
  for (int r = BIDX; r < nrows; r += gridDim.x) {
    int mj, t, tlen, r0; rowinfo(r, mj, t, tlen, r0);
    bf16_t* cat = (bf16_t*)(p.ws + OFF_H) + (size_t)r * D;
    __syncthreads();
    ov[tid] = bf2f(P[(size_t)r * NINP + PC_OF + tid]) + bf2f(P[(size_t)r * NINP + PC_OB + tid]);
    if (tid < 256) {
      int c = tid, gi = c >> 6, win = 2 << gi;
      int lo = t - win / 2, hi = lo + win; lo = lo < 0 ? 0 : lo; hi = hi > tlen ? tlen : hi;
      float s = 0; for (int tt = lo; tt < hi; ++tt) s += bf2f(P[(size_t)(r0 + tt) * NINP + PC_POOL + c]);
      dv[c] = s / (float)(hi - lo) - bf2f(P[(size_t)r * NINP + PC_POOL + c]);
    }
    __syncthreads();
    if (tid < 4) { float s = 0; for (int d = 0; d < 128; ++d) { float v = ov[tid * 128 + d]; s += v * v; } rs[tid] = rsqrtf(s / 128.f + EPS); }
    __syncthreads();
    const float* gn = p.gdn_norm_g + l * 128;
    { int c = tid; float z = bf2f(P[(size_t)r * NINP + PC_Z + c]); cat[256 + c] = f2bf(ov[c] * rs[c >> 7] * gn[c & 127] * silu_f(z)); }
    if (tid < 256) {
      int j = tid, gi = j >> 6, dd = j & 63;
      const float* pw = p.pool_w + ((size_t)l * 4 + gi) * 64 * 64;
      float a = 0; for (int c = 0; c < 64; ++c) a += dv[gi * 64 + c] * pw[c * 64 + dd];
      cat[768 + j] = f2bf(a * p.pool_scale[l * 256 + j]);
    }
  }
}
__device__ __forceinline__ void ph_outproj(const Params& p, int l, int nrows, float* lds) {
  const int TIDX = ltid(); const int BIDX = lbid();
  const bf16_t* A = (const bf16_t*)(p.ws + OFF_H); const float* W = p.w_out + (size_t)l * D * D;
  const int ntn = D / 128, ntm = nrows / 64;
  for (int vb = BIDX; vb < ntn * ntm; vb += gridDim.x)
    ngemm_tile(lds, nrows, D, D, vb / ntn, vb % ntn,
               [&](int r, int k) { return bf2f(A[(size_t)r * D + k]); },
               [&](int k, int n) { return W[(size_t)k * D + n]; },
               [&](int r, int n, float v) { int mj = r < ML ? (r >> 13) : 2; xrow(p, r)[n] += modvec(p, l, mj, 2)[n] * v; });
}
__device__ __forceinline__ void ph_topk(const Params& p, int nseq) {
  const int TIDX = ltid(); const int BIDX = lbid();
  const size_t total = (size_t)nseq * NE * T;
  for (size_t i = (size_t)BIDX * NT + TIDX; i < total; i += (size_t)gridDim.x * NT) {
    const int t = (int)(i % T), e = (int)((i / T) % NE), s = (int)(i / ((size_t)T * NE));
    const int tlen = s < 2 ? T : TC, cap = s < 2 ? CAPL : CAPC, r0 = s < 2 ? s * T : ML + (s - 2) * TC;
    if (t >= tlen) continue;
    const float* a = (const float*)(p.ws + OFF_AFFT) + (size_t)e * MR + r0;
    const float me = a[t];
    int rank = 0;
    for (int u = 0; u < tlen; ++u) { float o = a[u]; rank += (o > me || (o == me && u < t)) ? 1 : 0; }
    int* slot = (int*)(p.ws + OFF_SLOT);
    if (rank < cap) { int pi = pair_base(s, e) + rank; ((int*)(p.ws + OFF_IDX))[pi] = r0 + t; ((float*)(p.ws + OFF_GATE))[pi] = me; slot[(size_t)(r0 + t) * 16 + e] = rank; }
    else slot[(size_t)(r0 + t) * 16 + e] = -1;
  }
}
__device__ __forceinline__ void ph_moe_gu(const Params& p, int l, int grp0, int grp1, float* lds) {
  const int TIDX = ltid(); const int BIDX = lbid();
  const bf16_t* H = (const bf16_t*)(p.ws + OFF_H);
  float* tmp = (float*)(p.ws + OFF_P);
  const int ntn = DEXP / 128, ntm = CAPL / 64, per = ntn * ntm;
  for (int vb = BIDX; vb < (grp1 - grp0) * per; vb += gridDim.x) {
    const int grp = grp0 + vb / per, tt = vb % per, tm = tt / ntn, tn = tt % ntn;
    const int s = grp >> 4, e = grp & 15; const int cap = s < 2 ? CAPL : CAPC;
    if (tm * 64 >= cap) continue;
    const int pb = pair_base(s, e);
    const int* idx = (const int*)(p.ws + OFF_IDX) + pb;
    const float* Wg = p.w_gate + ((size_t)l * NE + e) * D * DEXP; const float* Wu = p.w_up + ((size_t)l * NE + e) * D * DEXP;
    bf16_t* hid = (bf16_t*)(p.ws + OFF_HID) + (size_t)pb * DEXP;
    ngemm_tile(lds, cap, DEXP, D, tm, tn,
               [&](int r, int k) { return bf2f(H[(size_t)idx[r] * D + k]); },
               [&](int k, int n) { return Wg[(size_t)k * DEXP + n]; },
               [&](int r, int n, float v) { tmp[(size_t)(pb + r) * DEXP + n] = v; });
    ngemm_tile(lds, cap, DEXP, D, tm, tn,
               [&](int r, int k) { return bf2f(H[(size_t)idx[r] * D + k]); },
               [&](int k, int n) { return Wu[(size_t)k * DEXP + n]; },
               [&](int r, int n, float v) { float g = tmp[(size_t)(pb + r) * DEXP + n]; hid[(size_t)r * DEXP + n] = f2bf(silu_f(g) * v); });
  }
}
__device__ __forceinline__ void ph_moe_down(const Params& p, int l, int grp0, int grp1, float* lds) {
  const int TIDX = ltid(); const int BIDX = lbid();
  const int ntn = D / 128, ntm = CAPL / 64, per = ntn * ntm;
  for (int vb = BIDX; vb < (grp1 - grp0) * per; vb += gridDim.x) {
    const int grp = grp0 + vb / per, tt = vb % per, tm = tt / ntn, tn = tt % ntn;
    const int s = grp >> 4, e = grp & 15; const int cap = s < 2 ? CAPL : CAPC;
    if (tm * 64 >= cap) continue;
    const int pb = pair_base(s, e);
    const bf16_t* hid = (const bf16_t*)(p.ws + OFF_HID) + (size_t)pb * DEXP;
    const float* Wd = p.w_down + ((size_t)l * NE + e) * DEXP * D;
    const float* gate = (const float*)(p.ws + OFF_GATE) + pb;
    bf16_t* Y = (bf16_t*)(p.ws + OFF_Y) + (size_t)pb * D;
    ngemm_tile(lds, cap, D, DEXP, tm, tn,
               [&](int r, int k) { return bf2f(hid[(size_t)r * DEXP + k]); },
               [&](int k, int n) { return Wd[(size_t)k * D + n]; },
               [&](int r, int n, float v) { Y[(size_t)r * D + n] = f2bf(v * gate[r]); });
  }
}
__device__ __forceinline__ void ph_combine(const Params& p, int l, int nrows) {
  const int TIDX = ltid(); const int BIDX = lbid();
  const bf16_t* Y = (const bf16_t*)(p.ws + OFF_Y);
  for (int r = BIDX; r < nrows; r += gridDim.x) {
    int mj, t, tlen, r0; rowinfo(r, mj, t, tlen, r0);
    const int s = r < ML ? (r >> 13) : 2 + ((r - ML) >> 8);
    const int* slot = (const int*)(p.ws + OFF_SLOT) + (size_t)r * 16;
    const float* g2 = modvec(p, l, mj, 5);
    float* xr = xrow(p, r);
    for (int c = TIDX; c < D; c += NT) {
      float a = 0;
      for (int e = 0; e < 16; ++e) { int sl = slot[e]; if (sl >= 0) a += bf2f(Y[(size_t)(pair_base(s, e) + sl) * D + c]); }
      xr[c] += g2[c] * a;
    }
  }
}


__device__ __forceinline__ void transpose_cvt_tile(float* lds, const float* W, int ldw, int N, bf16_t* Wt, int K, int rmul, int roff, int tk, int tn, int tid, const float* kscale = nullptr) {
  __syncthreads();
#pragma unroll
  for (int i = 0; i < 8; ++i) { int e = tid + i * NT; int kk = e >> 6, nn = e & 63; int n = tn * 64 + nn; lds[kk * 65 + nn] = n < N ? W[(size_t)(tk * 64 + kk) * ldw + n] * (kscale ? kscale[tk * 64 + kk] : 1.f) : 0.f; }
  __syncthreads();
#pragma unroll
  for (int i = 0; i < 8; ++i) { int e = tid + i * NT; int nn = e >> 6, kk = e & 63; int n = tn * 64 + nn; if (n < N) Wt[(size_t)(n * rmul + roff) * K + tk * 64 + kk] = f2bf(lds[kk * 65 + nn]); }
}
__device__ __forceinline__ void transpose_cvt_4tiles(float* lds, const float* W, int ldw, int N, bf16_t* Wt, int K, int rmul, int roff, int t4, int ntiles, int tid, const float* kscale) {
  const int ntn = (N + 63) / 64;
  float v[4][8];
#pragma unroll
  for (int q = 0; q < 4; ++q) { const int t = t4 + q, tk = t / ntn, tn = t % ntn;
#pragma unroll
    for (int i = 0; i < 8; ++i) { const int el = tid + i * NT, kk = el >> 6, nn = el & 63, n = tn * 64 + nn;
      v[q][i] = (t < ntiles && n < N) ? W[(size_t)(tk * 64 + kk) * ldw + n] * (kscale ? kscale[tk * 64 + kk] : 1.f) : 0.f; } }
  __syncthreads();
#pragma unroll
  for (int q = 0; q < 4; ++q)
#pragma unroll
    for (int i = 0; i < 8; ++i) { const int el = tid + i * NT, kk = el >> 6, nn = el & 63; lds[q * 4160 + kk * 65 + nn] = v[q][i]; }
  __syncthreads();
#pragma unroll
  for (int q = 0; q < 4; ++q) { const int t = t4 + q, tk = t / ntn, tn = t % ntn;
#pragma unroll
    for (int i = 0; i < 4; ++i) { const int el = tid + i * NT, nn = el >> 5, k2 = (el & 31) * 2, n = tn * 64 + nn;
      if (t < ntiles && n < N) *(unsigned*)(Wt + (size_t)(n * rmul + roff) * K + tk * 64 + k2) = gd::pk(lds[q * 4160 + k2 * 65 + nn], lds[q * 4160 + (k2 + 1) * 65 + nn]); } }
}
__device__ __forceinline__ void ph_prep_weights(const Params& p, float* lds) {
  const int TIDX = ltid(); const int BIDX = lbid();
  bf16_t* winT = (bf16_t*)(p.ws + OFF_WINT); bf16_t* woutT = (bf16_t*)(p.ws + OFF_WOUTT);
  const int g_in = 2 * 168, g_out = 2 * 64, g_q = 2 * 5, g_kv = 2 * 4;
  for (int vb = BIDX; vb < g_in + g_out + g_q + g_kv; vb += gridDim.x) {
    if (vb < g_in) { const int l = vb / 168, r = vb % 168; transpose_cvt_4tiles(lds, p.w_in + (size_t)l * D * NIN, NIN, NIN, winT + (size_t)l * NINP * D, D, 1, 0, r * 4, 16 * 42, TIDX, nullptr); }
    else if (vb < g_in + g_out) { const int v = vb - g_in, l = v / 64, r = v % 64; transpose_cvt_4tiles(lds, p.w_out + (size_t)l * D * D, D, D, woutT + (size_t)l * D * D, D, 1, 0, r * 4, 256, TIDX, nullptr); }
    else if (vb < g_in + g_out + g_q) { const int v = vb - g_in - g_out, l = v / 5, r = v % 5;
      transpose_cvt_4tiles(lds, p.w_uq + (size_t)l * 192 * 384, 384, 384, (bf16_t*)(p.ws + OFF_WUP) + (size_t)l * 1024 * 256, 256, 1, 0, r * 4, 18, TIDX, p.q_a_norm + l * 192); }
    else { const int v = vb - g_in - g_out - g_q, l = v / 4, r = v % 4;
      transpose_cvt_4tiles(lds, p.w_ukv + (size_t)l * 128 * 512, 512, 512, (bf16_t*)(p.ws + OFF_WUP) + (size_t)l * 1024 * 256 + 512 * 256, 256, 1, 0, r * 4, 16, TIDX, p.kv_a_norm + l * 128); }
  }
  for (int q = 0; q < 16; ++q) {
    const int i = (q * (int)gridDim.x + BIDX) * NT + TIDX; if (i >= 2 * 1024 * 256) break;
    const int k = i & 255, n = (i >> 8) & 1023;
    if ((n < 384 && k >= 192) || (n >= 384 && n < 512) || (n >= 512 && k >= 128)) ((bf16_t*)(p.ws + OFF_WUP))[i] = 0;
  }
  for (size_t i = (size_t)BIDX * NT + TIDX; i < (size_t)2 * (NINP - NIN) * D; i += (size_t)gridDim.x * NT) {
    const int l = (int)(i / ((size_t)(NINP - NIN) * D)); const size_t r = i % ((size_t)(NINP - NIN) * D);
    winT[(size_t)l * NINP * D + (size_t)NIN * D + r] = 0;
  }
}
__device__ __forceinline__ void ph_inproj_fast(const Params& p, int l, char* smem) {
  DenseSched S; S.init(MR / 256, NINP / 256, (int)gridDim.x, lbid());
  S.A = p.ws + OFF_H; S.Bt = p.ws + OFF_WINT + (size_t)l * NINP * D * 2; S.lda = D; S.ldb = D; S.K = D;
  EpiStoreBf16 E; E.O = (bf16_t*)(p.ws + OFF_P); E.ldc = NINP;
  pg8::gemm_phase(( PG8_LAS unsigned char*)smem, S, E);
}

__device__ __forceinline__ void ph_outproj_fast(const Params& p, int l, char* smem) {
  DenseSched S; S.init(ML / 256, D / 256, (int)gridDim.x, lbid());
  S.A = p.ws + OFF_H; S.Bt = p.ws + OFF_WOUTT + (size_t)l * D * D * 2; S.lda = D; S.ldb = D; S.K = D;
  EpiStoreBf16 E; E.O = (bf16_t*)(p.ws + OFF_YO); E.ldc = D;
  pg8::gemm_phase((PG8_LAS unsigned char*)smem, S, E);
}

__device__ __forceinline__ void ph_prep_moe_weights(const Params& p, int l, float* lds, int b0, int nb) {
  const int TIDX = ltid(); const int BIDX = lbid() - b0;
  if (BIDX < 0) return;
  bf16_t* gu = (bf16_t*)(p.ws + OFF_MOEGU); bf16_t* dn = (bf16_t*)(p.ws + OFF_MOED);
  unsigned* ctr = (unsigned*)(p.ws + OFF_BAR) + 16 + l; volatile int* bc = (volatile int*)(lds + 4 * 4160);
  __syncthreads();
  if (TIDX == 0) bc[0] = (int)__hip_atomic_fetch_add(ctr, 1u, __ATOMIC_RELAXED, __HIP_MEMORY_SCOPE_AGENT);
  __syncthreads();
  int vb = __builtin_amdgcn_readfirstlane(bc[0]);
  for (int it = 1; ; ++it) {
    if (vb >= NE * 3 * 32) break;
    const int e = vb / 96, r = vb % 96, which = r >> 5, t4 = (r & 31) * 4;
    const float* W; int ldw, K, rmul, roff; bf16_t* Wt;
    if (which < 2) { W = (which ? p.w_up : p.w_gate) + ((size_t)l * NE + e) * D * DEXP; ldw = DEXP; K = D; rmul = 2; roff = which; Wt = gu + (size_t)e * D * D; }
    else { W = p.w_down + ((size_t)l * NE + e) * DEXP * D; ldw = D; K = DEXP; rmul = 1; roff = 0; Wt = dn + (size_t)e * D * DEXP; }
    const int ntn = ldw / 64;
    float v[4][8];
#pragma unroll
    for (int q = 0; q < 4; ++q) { const int t = t4 + q, tk = t / ntn, tn = t % ntn;
#pragma unroll
      for (int i = 0; i < 8; ++i) { const int el = TIDX + i * NT, kk = el >> 6, nn = el & 63; v[q][i] = __builtin_nontemporal_load(&W[(size_t)(tk * 64 + kk) * ldw + tn * 64 + nn]); } }
    if (TIDX == 0) bc[it & 1] = (int)__hip_atomic_fetch_add(ctr, 1u, __ATOMIC_RELAXED, __HIP_MEMORY_SCOPE_AGENT);
    __syncthreads();
#pragma unroll
    for (int q = 0; q < 4; ++q)
#pragma unroll
      for (int i = 0; i < 8; ++i) { const int el = TIDX + i * NT, kk = el >> 6, nn = el & 63; lds[q * 4160 + kk * 65 + nn] = v[q][i]; }
    __syncthreads();
#pragma unroll
    for (int q = 0; q < 4; ++q) { const int t = t4 + q, tk = t / ntn, tn = t % ntn;
#pragma unroll
      for (int i = 0; i < 4; ++i) { const int el = TIDX + i * NT, nn = el >> 5, k2 = (el & 31) * 2;
        const unsigned w = gd::pk(lds[q * 4160 + k2 * 65 + nn], lds[q * 4160 + (k2 + 1) * 65 + nn]);
        *(unsigned*)(Wt + (size_t)((tn * 64 + nn) * rmul + roff) * K + tk * 64 + k2) = w; } }
    vb = __builtin_amdgcn_readfirstlane(bc[it & 1]);
  }
}
__device__ __forceinline__ void ph_gather(const Params& p) {
  const int TIDX = ltid(); const int BIDX = lbid();
  const int lane = TIDX & 63, wv = TIDX >> 6;
  const int* idx = (const int*)(p.ws + OFF_IDX);
  const uint4* H = (const uint4*)(p.ws + OFF_H); uint4* xs = (uint4*)(p.ws + OFF_XS);
  for (int r = BIDX * 8 + wv; r < NB * NE * CAPL; r += gridDim.x * 8) {
    const int src = idx[r];
    const uint4 a = H[(size_t)src * 128 + lane], b = H[(size_t)src * 128 + 64 + lane];
    xs[(size_t)r * 128 + lane] = a; xs[(size_t)r * 128 + 64 + lane] = b;
  }
}
__device__ __forceinline__ void ph_moe_gu_fast(const Params& p, char* smem) {
  MoeSched S; S.init(NB * NE * CAPL / 256, 2 * DEXP / 256, (int)gridDim.x, lbid());
  S.A = p.ws + OFF_H; S.Bt = p.ws + OFF_MOEGU; S.lda = D; S.ldb = D; S.K = D; S.bstride = (size_t)D * D * 2; S.gidx = (const int*)(p.ws + OFF_IDX); S.gather = true;
  EpiSwiGLU E; E.O = (bf16_t*)(p.ws + OFF_HID);
  pg8::gemm_phase<EpiSwiGLU, MoeSched, true>((PG8_LAS unsigned char*)smem, S, E);
}
__device__ __forceinline__ void ph_moe_down_fast(const Params& p, char* smem) {
  MoeSched S; S.init(NB * NE * CAPL / 256, D / 256, (int)gridDim.x, lbid());
  S.A = p.ws + OFF_HID; S.Bt = p.ws + OFF_MOED; S.lda = DEXP; S.ldb = DEXP; S.K = DEXP; S.bstride = (size_t)D * DEXP * 2; S.gidx = nullptr; S.gather = false;
  EpiGateBf16 E; E.O = (bf16_t*)(p.ws + OFF_Y); E.gate = (const float*)(p.ws + OFF_GATE);
  pg8::gemm_phase((PG8_LAS unsigned char*)smem, S, E);
}

__device__ __forceinline__ void attn_ctx_item(const Params& p, int j, char* smem) {
  const bf16_t* Q = (const bf16_t*)(p.ws + OFF_QKV); const bf16_t* Kb = Q + QK_ELEMS; const bf16_t* Vb = Kb + QK_ELEMS;
  const int h = j & 3, b = j >> 2; const size_t bh = (size_t)(b * 4 + h) * TK;
  fa::attn_body(Q + bh * 128, Kb + bh * 128, Vb + bh * 64, (bf16_t*)(p.ws + OFF_H) + (size_t)(ML + b * TC) * D + h * 64, D, TC, smem);
}
__device__ __forceinline__ void attn_seg(const Params& p, int x, int qt, int off, int len, char* smem) {
  const bf16_t* Q = (const bf16_t*)(p.ws + OFF_QKV); const bf16_t* Kb = Q + QK_ELEMS; const bf16_t* Vb = Kb + QK_ELEMS;
  const int h = x & 3, b = x >> 2, part = off == 0 ? 0 : 1, kv0 = off * 128;
  const size_t bh = (size_t)(b * 4 + h) * TK; const int row0 = b * T + qt * 256;
  bf16_t* op = (bf16_t*)(p.ws + OFF_OPART) + ((size_t)part * ML + row0) * 256 + h * 64;
  float* ml = (float*)(p.ws + OFF_MLPART) + (((size_t)part * ML + row0) * 4 + h) * 2;
  fa::attn_body(Q + (bh + TC + qt * 256) * 128, Kb + (bh + kv0) * 128, Vb + (bh + kv0) * 64, op, 256, len * 128, smem, ml, 8);
  if (off == 0 && len == TK / 128) {
    const int t = ltid();
    if (t < 256) *(float2*)((float*)(p.ws + OFF_MLPART) + (((size_t)ML + row0 + t) * 4 + h) * 2) = make_float2(-1e30f, 0.f);
  }
}
__device__ __forceinline__ void ph_attn_fast(const Params& p, bool need_ctx, char* smem) {
  const int BIDX = lbid();
  const int nns = (int)gridDim.x - 32;
  if (BIDX >= 32) {
    const int x = BIDX & 7, j = (BIDX - 32) >> 3, nj = nns >> 3;
    constexpr int PPQ = TK / 128, NPAIRS = 32 * PPQ;
    const int hi = (NPAIRS * (j + 1)) / nj;
    for (int cur = (NPAIRS * j) / nj; cur < hi; ) {
      const int qt = cur / PPQ, off = cur - qt * PPQ, len = min(PPQ - off, hi - cur);
      attn_seg(p, x, qt, off, len, smem);
      cur += len;
    }
    if (need_ctx && j == nj - 1) attn_ctx_item(p, x, smem);
  }
}

__device__ __forceinline__ void ph_gdn_precompute(const Params& p, int l, char* smem) {
  const int TIDX = ltid(); const int BIDX = lbid();
  __syncthreads();
  { const float* cw = p.conv_w + (size_t)l * 3 * 1536; float* cwl = (float*)(smem + gd::L_CW);
    for (int i = TIDX; i < 3 * 1536 / 4; i += NT) ((float4*)cwl)[i] = ((const float4*)cw)[i]; }
  const int nit = NB * 4 * gd::NCH;
  for (int it = BIDX; it < nit; it += gridDim.x) {
    const int c = it % gd::NCH, bh = it / gd::NCH;
    uint4 cur[3][4];
    gd::precompute_load(p, bh >> 2, bh & 3, c, TIDX, cur);
    gd::precompute_item(p, l, bh >> 2, bh & 3, c, smem, TIDX, cur);
  }
  __syncthreads();
}
__device__ __forceinline__ void ph_scan_fast(const Params& p, char* smem) {
  const int TIDX = ltid(); const int BIDX = lbid();
  if (BIDX < 32) gd::scan_unit_lds(p, (((BIDX & 7) + 8 * (BIDX >> 4)) << 1) | ((BIDX >> 3) & 1), smem, TIDX);
}

struct MlaSched : pg8::GridOrder {
  const char* P; const char* W; int lda, ldb, K; const int* gidx;
  __device__ __forceinline__ const char* a_ptr(const pg8::Unit& u) const { return P + (size_t)u.pm * 256 * NINP * 2 + (u.pn < 2 ? PC_Q : PC_KV) * 2; }
  __device__ __forceinline__ const char* b_ptr(const pg8::Unit& u) const { return W + (size_t)u.pn * 256 * 256 * 2; }
};
__device__ __forceinline__ void ph_mla_gemm(const Params& p, int l, char* smem) {
  if (lbid() < 32) return;
  MlaSched S; S.init(MR / 256, 4, (int)gridDim.x - 32, lbid() - 32);
  S.P = p.ws + OFF_P; S.W = p.ws + OFF_WUP + (size_t)l * 1024 * 256 * 2; S.lda = NINP; S.ldb = 256; S.K = 256; S.gidx = nullptr;
  EpiStoreBf16 E; E.O = (bf16_t*)(p.ws + OFF_UPRAW); E.ldc = 1024;
  pg8::gemm_phase((PG8_LAS unsigned char*)smem, S, E);
}
__device__ __forceinline__ void handoff_publish(unsigned* ctr) {
  asm volatile("s_waitcnt vmcnt(0)" ::: "memory");
  __syncthreads();
  if (threadIdx.x == 0) { __builtin_amdgcn_fence(__ATOMIC_RELEASE, "agent"); asm volatile("s_waitcnt vmcnt(0)" ::: "memory"); xb_add(ctr, 1u); }
}
__device__ __forceinline__ void handoff_wait(unsigned* ctr, unsigned need, unsigned* bar) {
  if (threadIdx.x == 0) { XB_SPIN(xb_ld(ctr) < need, bar); __builtin_amdgcn_fence(__ATOMIC_ACQUIRE, "agent"); asm volatile("s_waitcnt vmcnt(0)" ::: "memory"); }
  __syncthreads();
}
__device__ __forceinline__ void ph_mla_finish(const Params& p, int l, float* lds) {
  const int TIDX = ltid(); const int BIDX = lbid() - 32; const int nb = (int)gridDim.x - 32;
  if (BIDX < 0) return;
  const int lane = TIDX & 63, wv = TIDX >> 6, h = lane >> 4, j = lane & 15;
  const bf16_t* P = (const bf16_t*)(p.ws + OFF_P); const bf16_t* RAW = (const bf16_t*)(p.ws + OFF_UPRAW);
  bf16_t* Qo = (bf16_t*)(p.ws + OFF_QKV); bf16_t* Ko = Qo + QK_ELEMS; bf16_t* Vo = Ko + QK_ELEMS;
  __syncthreads();
  for (int i = TIDX; i < 128 * 8; i += NT) { const int a = i >> 3, e = i & 7; const float ang = (float)a * __builtin_amdgcn_exp2f(-(float)e * 1.6609640474436813f);
    lds[a * 16 + e] = __cosf(ang); lds[a * 16 + 8 + e] = __sinf(ang); }
  __syncthreads();
  float qw8[8], kw8[8], kwr8[8];
#pragma unroll
  for (int e = 0; e < 8; ++e) { qw8[e] = j < 12 ? p.q_norm[l * 96 + j * 8 + e] : 0.f; kw8[e] = j < 8 ? p.k_norm[l * 96 + j * 8 + e] : 0.f; kwr8[e] = p.k_norm[l * 96 + 64 + (lane & 3) * 8 + e]; }
  const bool ropel = j >= 8 && j < 12, first = (j & 1) == 0;
#define MF_UNPACK(dst, U4) do { dst[0] = __uint_as_float((U4).x << 16); dst[1] = __uint_as_float((U4).x & 0xffff0000u); dst[2] = __uint_as_float((U4).y << 16); dst[3] = __uint_as_float((U4).y & 0xffff0000u); \
    dst[4] = __uint_as_float((U4).z << 16); dst[5] = __uint_as_float((U4).z & 0xffff0000u); dst[6] = __uint_as_float((U4).w << 16); dst[7] = __uint_as_float((U4).w & 0xffff0000u); } while (0)
#define MF_PACK(src) make_uint4(gd::pk(src[0], src[1]), gd::pk(src[2], src[3]), gd::pk(src[4], src[5]), gd::pk(src[6], src[7]))
  for (int r2 = (BIDX + nb * wv) * 2; r2 < MR; r2 += nb * 8 * 2)
#pragma unroll
  for (int rr = 0; rr < 2; ++rr) { const int r = r2 + rr;
    const bool lat = r < ML; const int b = lat ? (r >> 13) : ((r - ML) >> 8), t = lat ? (r & (T - 1)) : ((r - ML) & (TC - 1)), pos = lat ? TC + t : t;
    const bf16_t* Pr = P + (size_t)r * NINP; const bf16_t* Rr = RAW + (size_t)r * 1024;
    const uint4 zero4 = make_uint4(0u, 0u, 0u, 0u);
    const uint4 q4 = j < 12 ? *(const uint4*)(Rr + h * 96 + j * 8) : zero4;
    const uint4 k4 = *(const uint4*)(Rr + 512 + h * 128 + j * 8);
    const bf16_t* pp = lane < 24 ? Pr + PC_Q + lane * 8 : (lane < 40 ? Pr + PC_KV + (lane - 24) * 8 : Pr + PC_KR + (lane - 40) * 8);
    const uint4 p4 = lane < 44 ? *(const uint4*)pp : zero4;
    float xq[8], xk[8], xp[8];
    MF_UNPACK(xq, q4); MF_UNPACK(xk, k4); MF_UNPACK(xp, p4);
    float sp = 0.f, sq = 0.f, sk = 0.f;
#pragma unroll
    for (int e = 0; e < 8; ++e) { sp += xp[e] * xp[e]; sq += xq[e] * xq[e]; sk += xk[e] * xk[e]; }
    if (j >= 8) sk = 0.f;
    sp += __shfl_xor(sp, 1); sp += __shfl_xor(sp, 2); sp += __shfl_xor(sp, 4);
    const float g0 = __builtin_amdgcn_readlane(sp, 0), g1 = __builtin_amdgcn_readlane(sp, 8), g2 = __builtin_amdgcn_readlane(sp, 16), g3 = __builtin_amdgcn_readlane(sp, 24), g4 = __builtin_amdgcn_readlane(sp, 32), skr = __builtin_amdgcn_readlane(sp, 40);
    const float rq = rsqrtf((g0 + g1 + g2) / 192.f + EPS), rkv = rsqrtf((g3 + g4) / 128.f + EPS);
    sq += __shfl_xor(sq, 1); sq += __shfl_xor(sq, 2); sq += __shfl_xor(sq, 4); sq += __shfl_xor(sq, 8);
    sk += __shfl_xor(sk, 1); sk += __shfl_xor(sk, 2); sk += __shfl_xor(sk, 4); sk += __shfl_xor(sk, 8);
    const float sc = rq * rsqrtf(rq * rq * sq / 96.f + EPS);
    const float sck = rsqrtf((rkv * rkv * sk + skr) / 96.f + EPS);
    const int aq = j < 10 ? (t >> 6) : (t & 63);
    float cs[8], sn[8];
    { const float4 c0 = *(const float4*)(lds + aq * 16), c1 = *(const float4*)(lds + aq * 16 + 4), s0 = *(const float4*)(lds + aq * 16 + 8), s1 = *(const float4*)(lds + aq * 16 + 12);
      cs[0] = c0.x; cs[1] = c0.y; cs[2] = c0.z; cs[3] = c0.w; cs[4] = c1.x; cs[5] = c1.y; cs[6] = c1.z; cs[7] = c1.w;
      sn[0] = s0.x; sn[1] = s0.y; sn[2] = s0.z; sn[3] = s0.w; sn[4] = s1.x; sn[5] = s1.y; sn[6] = s1.z; sn[7] = s1.w; }
    const size_t ob = (size_t)(b * 4 + h) * TK + pos;
    { float y[8];
#pragma unroll
      for (int e = 0; e < 8; ++e) { y[e] = xq[e] * sc * qw8[e]; const float o = __shfl_xor(y[e], 1);
        if (lat && ropel) y[e] = first ? y[e] * cs[e] - o * sn[e] : y[e] * cs[e] + o * sn[e]; }
      if (j < 12) *(uint4*)(Qo + ob * 128 + j * 8) = MF_PACK(y); }
    { float z[8], kk[8];
#pragma unroll
      for (int e = 0; e < 8; ++e) { z[e] = xp[e] * kwr8[e]; const float o = __shfl_xor(z[e], 1);
        if (lat) z[e] = first ? z[e] * cs[e] - o * sn[e] : z[e] * cs[e] + o * sn[e];
        const float zr = __shfl(z[e], 40 + (lane & 3));
        kk[e] = j < 8 ? xk[e] * rkv * sck * kw8[e] : zr * sck; }
      if (j < 12) *(uint4*)(Ko + ob * 128 + j * 8) = MF_PACK(kk); }
    { float vv[8];
#pragma unroll
      for (int e = 0; e < 8; ++e) vv[e] = xk[e] * rkv;
      if (j >= 8) *(uint4*)(Vo + ob * 64 + (j - 8) * 8) = MF_PACK(vv); }
  }
#undef MF_UNPACK
#undef MF_PACK
}
constexpr int POOL_ROWB = 144, POOL_TILEB = 64 * POOL_ROWB;
template <int H>
__device__ __forceinline__ void pool_unit(const Params& p, int l, int tile, int gi, char* Dw, const char* WTl, int lane) {
  typedef unsigned u2 __attribute__((ext_vector_type(2)));
  using bf16x8 = fa::bf16x8; using f32x16 = fa::f32x16;
  const int r_first = tile * 64;
  int r0, tlen;
  if (r_first < ML) { r0 = r_first & ~(T - 1); tlen = T; } else { r0 = ML + ((r_first - ML) & ~(TC - 1)); tlen = TC; }
  const int cq = lane & 15, tb = lane >> 4, tbase = r_first - r0 + tb * 16;
  const bf16_t* Pg = (const bf16_t*)(p.ws + OFF_P) + (size_t)r0 * NINP + PC_POOL + gi * 64 + cq * 4;
  constexpr int NR = 15 + 2 * H;
  u2 xs[NR];
#pragma unroll
  for (int j = 0; j < NR; ++j) { const int tt = tbase - H + j; xs[j] = (tt >= 0 && tt < tlen) ? *(const u2*)(Pg + (size_t)tt * NINP) : (u2){0u, 0u}; }
#define PL_LO(w) __uint_as_float((w) << 16)
#define PL_HI(w) __uint_as_float((w) & 0xffff0000u)
  float s0 = 0.f, s1 = 0.f, s2 = 0.f, s3 = 0.f;
#pragma unroll
  for (int j = 0; j < 2 * H; ++j) { s0 += PL_LO(xs[j].x); s1 += PL_HI(xs[j].x); s2 += PL_LO(xs[j].y); s3 += PL_HI(xs[j].y); }
  char* drow = Dw + (tb * 16) * POOL_ROWB + cq * 8;
#pragma unroll
  for (int i = 0; i < 16; ++i) {
    const int t = tbase + i; const int lo = t - H < 0 ? 0 : t - H, hi = t + H > tlen ? tlen : t + H;
    const float inv = 1.f / (float)(hi - lo);
    const u2 c = xs[i + H];
    u2 w; w.x = gd::pk(s0 * inv - PL_LO(c.x), s1 * inv - PL_HI(c.x)); w.y = gd::pk(s2 * inv - PL_LO(c.y), s3 * inv - PL_HI(c.y));
    *(u2*)(drow + i * POOL_ROWB) = w;
    if (i < 15) { const u2 a = xs[i + 2 * H], b = xs[i];
      s0 += PL_LO(a.x) - PL_LO(b.x); s1 += PL_HI(a.x) - PL_HI(b.x); s2 += PL_LO(a.y) - PL_LO(b.y); s3 += PL_HI(a.y) - PL_HI(b.y); }
  }
#undef PL_LO
#undef PL_HI
  asm volatile("s_waitcnt lgkmcnt(0)" ::: "memory");
  const int r32 = lane & 31, hl = lane >> 5;
  f32x16 acc[2][2];
#pragma unroll
  for (int a = 0; a < 2; ++a)
#pragma unroll
    for (int b = 0; b < 2; ++b)
#pragma unroll
      for (int i = 0; i < 16; ++i) acc[a][b][i] = 0.f;
#pragma unroll
  for (int ks = 0; ks < 4; ++ks) {
    const bf16x8 a0 = *(const bf16x8*)(WTl + r32 * POOL_ROWB + ks * 32 + hl * 16), a1 = *(const bf16x8*)(WTl + (32 + r32) * POOL_ROWB + ks * 32 + hl * 16);
    const bf16x8 b0 = *(const bf16x8*)(Dw + r32 * POOL_ROWB + ks * 32 + hl * 16), b1 = *(const bf16x8*)(Dw + (32 + r32) * POOL_ROWB + ks * 32 + hl * 16);
    acc[0][0] = __builtin_amdgcn_mfma_f32_32x32x16_bf16(a0, b0, acc[0][0], 0, 0, 0); acc[0][1] = __builtin_amdgcn_mfma_f32_32x32x16_bf16(a0, b1, acc[0][1], 0, 0, 0);
    acc[1][0] = __builtin_amdgcn_mfma_f32_32x32x16_bf16(a1, b0, acc[1][0], 0, 0, 0); acc[1][1] = __builtin_amdgcn_mfma_f32_32x32x16_bf16(a1, b1, acc[1][1], 0, 0, 0);
  }
  const float* psc = p.pool_scale + l * 256 + gi * 64 + 4 * hl;
  bf16_t* cat = (bf16_t*)(p.ws + OFF_H) + (size_t)(r_first + r32) * D + 768 + gi * 64 + 4 * hl;
#pragma unroll
  for (int mt = 0; mt < 2; ++mt)
#pragma unroll
    for (int q = 0; q < 4; ++q) {
      const float4 s4 = *(const float4*)(psc + mt * 32 + q * 8);
#pragma unroll
      for (int nt = 0; nt < 2; ++nt) {
        u2 w; w.x = gd::pk(acc[mt][nt][4 * q] * s4.x, acc[mt][nt][4 * q + 1] * s4.y); w.y = gd::pk(acc[mt][nt][4 * q + 2] * s4.z, acc[mt][nt][4 * q + 3] * s4.w);
        *(u2*)(cat + (size_t)(nt * 32) * D + mt * 32 + q * 8) = w;
      }
    }
  asm volatile("s_waitcnt lgkmcnt(0)" ::: "memory");
}
__device__ __forceinline__ void ph_pool_mfma(const Params& p, int l, int nrows, char* smem) {
  const int TIDX = ltid(); const int BIDX = lbid();
  const int lane = TIDX & 63, wv = TIDX >> 6;
  const int gi = BIDX & 3;
  __syncthreads();
  {
    const float4* W = (const float4*)(p.pool_w + ((size_t)l * 4 + gi) * 4096);
    for (int i = TIDX; i < 1024; i += NT) { const float4 w = W[i]; const int c = i >> 4, o4 = (i & 15) * 4;
      bf16_t* dst = (bf16_t*)(smem + o4 * POOL_ROWB) + c;
      dst[0] = f2bf(w.x); dst[POOL_ROWB / 2] = f2bf(w.y); dst[POOL_ROWB] = f2bf(w.z); dst[3 * POOL_ROWB / 2] = f2bf(w.w); }
  }
  __syncthreads();
  char* Dw = smem + POOL_TILEB + wv * POOL_TILEB;
  const int ntiles = nrows >> 6;
  for (int tile = wv * ((int)gridDim.x >> 2) + (BIDX >> 2); tile < ntiles; tile += 8 * ((int)gridDim.x >> 2)) {
    if (gi == 0) pool_unit<1>(p, l, tile, 0, Dw, smem, lane); else if (gi == 1) pool_unit<2>(p, l, tile, 1, Dw, smem, lane);
    else if (gi == 2) pool_unit<4>(p, l, tile, 2, Dw, smem, lane); else pool_unit<8>(p, l, tile, 3, Dw, smem, lane);
  }
}
template <int MODE>
__device__ __forceinline__ void ph_gdnfin_pool_fast(const Params& p, int l, int nrows, float* lds, int b0, int nb) {
  const int TIDX = ltid(); const int BIDX = lbid() - b0;
  if (BIDX < 0) return;
  const int lane = TIDX & 63, wv = TIDX >> 6;
  float* Wl = lds; float* dsc = lds + 16384 + wv * 256;
  if (MODE == 1) {
    __syncthreads();
    for (int i = TIDX; i < 4096; i += NT) ((float4*)Wl)[i] = ((const float4*)(p.pool_w + (size_t)l * 16384))[i];
    __syncthreads();
  }
  const bf16_t* P = (const bf16_t*)(p.ws + OFF_P);
  const float* gn = p.gdn_norm_g + l * 128; const float* psc = p.pool_scale + l * 256;
  for (int r = BIDX + nb * wv; r < nrows; r += nb * 8) {
    int mj, t, tlen, r0; rowinfo(r, mj, t, tlen, r0);
    bf16_t* cat = (bf16_t*)(p.ws + OFF_H) + (size_t)r * D;
    const bf16_t* Pr = P + (size_t)r * NINP;
    if (MODE == 2 && r < ML) {
      const int hh = lane >> 4;
      float mp[2], lp[2], mx = -1e30f;
#pragma unroll
      for (int q = 0; q < 2; ++q) { const float2 ml = *(const float2*)((const float*)(p.ws + OFF_MLPART) + (((size_t)q * ML + r) * 4 + hh) * 2); mp[q] = ml.x; lp[q] = ml.y; mx = fmaxf(mx, ml.x); }
      float acc4[4] = {0.f, 0.f, 0.f, 0.f}, wsum = 0.f;
#pragma unroll
      for (int q = 0; q < 2; ++q) { const float w = lp[q] * __expf((mp[q] - mx) * fa::SCALE); wsum += w;
        const uint2 o = *(const uint2*)((const bf16_t*)(p.ws + OFF_OPART) + ((size_t)q * ML + r) * 256 + lane * 4);
        acc4[0] += w * __uint_as_float(o.x << 16); acc4[1] += w * __uint_as_float(o.x & 0xffff0000u); acc4[2] += w * __uint_as_float(o.y << 16); acc4[3] += w * __uint_as_float(o.y & 0xffff0000u); }
      const float inv = 1.f / wsum;
      uint2 w2; w2.x = gd::pk(acc4[0] * inv, acc4[1] * inv); w2.y = gd::pk(acc4[2] * inv, acc4[3] * inv);
      *(uint2*)(cat + lane * 4) = w2;
    }
    if (MODE == 2) {
      const uint4 a = *(const uint4*)(Pr + PC_OF + lane * 8), bq = *(const uint4*)(Pr + PC_OB + lane * 8), z = *(const uint4*)(Pr + PC_Z + lane * 8);
      const unsigned aw[4] = {a.x, a.y, a.z, a.w}, bw[4] = {bq.x, bq.y, bq.z, bq.w}, zw[4] = {z.x, z.y, z.z, z.w};
      float o[8], ss = 0.f;
#pragma unroll
      for (int i = 0; i < 4; ++i) { o[2 * i] = __uint_as_float(aw[i] << 16) + __uint_as_float(bw[i] << 16); o[2 * i + 1] = __uint_as_float(aw[i] & 0xffff0000u) + __uint_as_float(bw[i] & 0xffff0000u); }
#pragma unroll
      for (int i = 0; i < 8; ++i) ss += o[i] * o[i];
      ss += __shfl_xor(ss, 1); ss += __shfl_xor(ss, 2); ss += __shfl_xor(ss, 4); ss += __shfl_xor(ss, 8);
      const float rs = rsqrtf(ss / 128.f + EPS);
      float y[8];
#pragma unroll
      for (int i = 0; i < 4; ++i) { const float z0 = __uint_as_float(zw[i] << 16), z1 = __uint_as_float(zw[i] & 0xffff0000u);
        y[2 * i] = o[2 * i] * rs * gn[(lane & 15) * 8 + 2 * i] * silu_f(z0); y[2 * i + 1] = o[2 * i + 1] * rs * gn[(lane & 15) * 8 + 2 * i + 1] * silu_f(z1); }
      uint4 w; w.x = gd::pk(y[0], y[1]); w.y = gd::pk(y[2], y[3]); w.z = gd::pk(y[4], y[5]); w.w = gd::pk(y[6], y[7]);
      *(uint4*)(cat + 256 + lane * 8) = w;
    }
    if (MODE == 1) {
      const int gi = lane >> 4, win = 2 << gi;
      int lo = t - win / 2, hi = lo + win; lo = lo < 0 ? 0 : lo; hi = hi > tlen ? tlen : hi;
      float sm[4] = {0.f, 0.f, 0.f, 0.f};
      uint2 uw[16];
#pragma unroll
      for (int q = 0; q < 16; ++q) { const int tt = t - 8 + q; const bool ok = tt >= lo && tt < hi; uw[q] = ok ? *(const uint2*)(P + (size_t)(r0 + tt) * NINP + PC_POOL + lane * 4) : make_uint2(0u, 0u); }
#pragma unroll
      for (int q = 0; q < 16; ++q) { sm[0] += __uint_as_float(uw[q].x << 16); sm[1] += __uint_as_float(uw[q].x & 0xffff0000u); sm[2] += __uint_as_float(uw[q].y << 16); sm[3] += __uint_as_float(uw[q].y & 0xffff0000u); }
      const uint2 u = *(const uint2*)(Pr + PC_POOL + lane * 4); const float inv = 1.f / (float)(hi - lo);
      dsc[lane * 4 + 0] = sm[0] * inv - __uint_as_float(u.x << 16); dsc[lane * 4 + 1] = sm[1] * inv - __uint_as_float(u.x & 0xffff0000u);
      dsc[lane * 4 + 2] = sm[2] * inv - __uint_as_float(u.y << 16); dsc[lane * 4 + 3] = sm[3] * inv - __uint_as_float(u.y & 0xffff0000u);
      float4 acc = {0.f, 0.f, 0.f, 0.f};
      const float* wg = Wl + gi * 4096 + (lane & 15) * 4; const float* dg = dsc + gi * 64;
#pragma unroll 8
      for (int c = 0; c < 64; ++c) { const float dv = dg[c]; const float4 w4 = *(const float4*)(wg + c * 64); acc.x += dv * w4.x; acc.y += dv * w4.y; acc.z += dv * w4.z; acc.w += dv * w4.w; }
      const float4 s4 = *(const float4*)(psc + lane * 4);
      uint2 w; w.x = gd::pk(acc.x * s4.x, acc.y * s4.y); w.y = gd::pk(acc.z * s4.z, acc.w * s4.w);
      *(uint2*)(cat + 768 + lane * 4) = w;
    }
  }
}
__device__ __forceinline__ void ph_ada_fast(const Params& p, float* lds) {
  const int TIDX = ltid(); const int BIDX = lbid();
  const int cg = TIDX & 15, ksl = TIDX >> 4;
  for (int u = BIDX; u < 2 * 96; u += gridDim.x) {
    const int l = u / 96, n0 = (u % 96) * 64 + cg * 4;
    const float* w = p.ada_w + (size_t)l * D * 6144 + n0;
    float4 a0 = {0.f, 0.f, 0.f, 0.f}, a1 = a0, a2 = a0;
#pragma unroll 16
    for (int kk = 0; kk < 32; ++kk) { const int k = ksl * 32 + kk; typedef float f4v __attribute__((ext_vector_type(4))); const f4v w4 = __builtin_nontemporal_load((const f4v*)(w + (size_t)k * 6144));
      const float s0 = silu_f(p.c[k]), s1 = silu_f(p.c[D + k]), s2 = silu_f(p.c_ctx[k]);
      a0.x += s0 * w4.x; a0.y += s0 * w4.y; a0.z += s0 * w4.z; a0.w += s0 * w4.w;
      a1.x += s1 * w4.x; a1.y += s1 * w4.y; a1.z += s1 * w4.z; a1.w += s1 * w4.w;
      a2.x += s2 * w4.x; a2.y += s2 * w4.y; a2.z += s2 * w4.z; a2.w += s2 * w4.w; }
    __syncthreads();
    float4* red = (float4*)lds;
    red[(ksl * 3 + 0) * 16 + cg] = a0; red[(ksl * 3 + 1) * 16 + cg] = a1; red[(ksl * 3 + 2) * 16 + cg] = a2;
    __syncthreads();
    if (TIDX < 192) { const int j = TIDX / 64, c = TIDX % 64; const float* rf = lds;
      float a = p.ada_b[l * 6144 + (u % 96) * 64 + c];
      for (int q = 0; q < 32; ++q) a += rf[((q * 3 + j) * 16 + (c >> 2)) * 4 + (c & 3)];
      ((float*)(p.ws + OFF_MOD))[(size_t)(l * 3 + j) * 6144 + (u % 96) * 64 + c] = a; }
  }
}

__device__ __forceinline__ void ph_topk_fast(const Params& p, int nseq, char* smem) {
  const int TIDX = ltid(); const int BIDX = lbid();
  unsigned* keys = (unsigned*)smem;
  unsigned* hist = keys + 8192;
  unsigned* ctl = hist + 256;
  unsigned* scn = ctl + 8;
  for (int prob = BIDX; prob < nseq * NE; prob += gridDim.x) {
    const int s = prob >> 4, e = prob & 15;
    const int tlen = s < 2 ? T : TC, cap = s < 2 ? CAPL : CAPC, r0 = s < 2 ? s * T : ML + (s - 2) * TC;
    const float* a = (const float*)(p.ws + OFF_AFFT) + (size_t)e * MR + r0;
    __syncthreads();
    for (int i = TIDX; i < tlen; i += NT) keys[i] = __float_as_uint(a[i]);
    if (TIDX == 0) { ctl[0] = 0u; ctl[1] = (unsigned)cap; }
    __syncthreads();
    for (int pass = 0; pass < 4; ++pass) {
      const int shift = 24 - 8 * pass;
      if (TIDX < 256) hist[TIDX] = 0u;
      __syncthreads();
      const unsigned prefix = ctl[0], want = ctl[1];
      const unsigned himask = pass == 0 ? 0u : (0xffffffffu << (shift + 8));
      { unsigned cur = 0u, cnt = 0u;
        for (int i = TIDX; i < tlen; i += NT) { const unsigned k = keys[i];
          if ((k & himask) == prefix) { const unsigned dgt = (k >> shift) & 255u; if (dgt == cur) ++cnt; else { if (cnt) atomicAdd(&hist[cur], cnt); cur = dgt; cnt = 1u; } } }
        if (cnt) atomicAdd(&hist[cur], cnt); }
      __syncthreads();
      if (TIDX < 256) {
        const unsigned mine = hist[TIDX];
        unsigned inc = mine;
#pragma unroll
        for (int o = 1; o < 64; o <<= 1) { const unsigned n = __shfl_down(inc, o); if ((TIDX & 63) + o < 64) inc += n; }
        if ((TIDX & 63) == 0) scn[TIDX >> 6] = inc;
        __builtin_amdgcn_s_waitcnt(0);
      }
      __syncthreads();
      if (TIDX < 256) {
        const unsigned mine = hist[TIDX];
        unsigned inc = mine;
#pragma unroll
        for (int o = 1; o < 64; o <<= 1) { const unsigned n = __shfl_down(inc, o); if ((TIDX & 63) + o < 64) inc += n; }
        unsigned above = inc - mine;
        for (int w = (TIDX >> 6) + 1; w < 4; ++w) above += scn[w];
        if (above < want && above + mine >= want) { ctl[2] = prefix | ((unsigned)TIDX << shift); ctl[3] = want - above; }
      }
      __syncthreads();
      if (TIDX == 0) { ctl[0] = ctl[2]; ctl[1] = ctl[3]; }
      __syncthreads();
    }
    const unsigned thr = ctl[0], weq = ctl[1];
    const int per = tlen / NT > 0 ? tlen / NT : 1, nthr = tlen / per, t0 = TIDX * per;
    unsigned cnt = 0u;
    if (TIDX < nthr) for (int i = 0; i < per; ++i) { const unsigned k = keys[t0 + i]; cnt += (k > thr ? 0x10000u : 0u) + (k == thr ? 1u : 0u); }
    unsigned inc = cnt;
#pragma unroll
    for (int o = 1; o < 64; o <<= 1) { const unsigned n = __shfl_up(inc, o); if ((TIDX & 63) >= o) inc += n; }
    if ((TIDX & 63) == 63) scn[TIDX >> 6] = inc;
    __syncthreads();
    unsigned base = 0u;
    for (int w = 0; w < (TIDX >> 6); ++w) base += scn[w];
    unsigned run = base + inc - cnt;
    int* idx = (int*)(p.ws + OFF_IDX); float* gate = (float*)(p.ws + OFF_GATE); int* slot = (int*)(p.ws + OFF_SLOT);
    const int pb = pair_base(s, e);
    if (TIDX < nthr) for (int i = 0; i < per; ++i) {
      const unsigned k = keys[t0 + i]; const unsigned ngt = run >> 16, neq = run & 0xffffu;
      const unsigned eqtaken = neq < weq ? neq : weq;
      int sl = -1;
      if (k > thr) sl = (int)(ngt + eqtaken);
      else if (k == thr && neq < weq) sl = (int)(ngt + neq);
      if (sl >= 0) { idx[pb + sl] = r0 + t0 + i; gate[pb + sl] = __uint_as_float(k); }
      slot[(size_t)(r0 + t0 + i) * 16 + e] = sl;
      run += (k > thr ? 0x10000u : 0u) + (k == thr ? 1u : 0u);
    }
  }
}
__device__ __forceinline__ void ph_combine_fast(const Params& p, int l, int nrows, int next_l) {
  const int TIDX = ltid(); const int BIDX = lbid();
  const int lane = TIDX & 63, wv = TIDX >> 6;
  const bf16_t* Y = (const bf16_t*)(p.ws + OFF_Y);
  for (int r4 = (BIDX + gridDim.x * wv) * 4; r4 < nrows; r4 += gridDim.x * 8 * 4) {
    int mj, t, tlen, r0; rowinfo(r4, mj, t, tlen, r0);
    const int s = r4 < ML ? (r4 >> 13) : 2 + ((r4 - ML) >> 8);
    const int slot4 = ((const int*)(p.ws + OFF_SLOT))[(size_t)r4 * 16 + lane];
    const unsigned long long vm = __ballot(slot4 >= 0);
    const int pairl = pair_base(s, lane & 15) + slot4;
    float4 xv[4][4]; uint4 ya[4][2][2]; int nsel[4];
    float* xr[4];
#pragma unroll
    for (int rr = 0; rr < 4; ++rr) { xr[rr] = xrow(p, r4 + rr);
#pragma unroll
      for (int hf = 0; hf < 2; ++hf) { const uint4 xb4 = ld_nt_u4((const bf16_t*)xr[rr] + hf * 512 + lane * 8);
        xv[rr][hf * 2 + 0] = make_float4(__uint_as_float(xb4.x << 16), __uint_as_float(xb4.x & 0xffff0000u), __uint_as_float(xb4.y << 16), __uint_as_float(xb4.y & 0xffff0000u));
        xv[rr][hf * 2 + 1] = make_float4(__uint_as_float(xb4.z << 16), __uint_as_float(xb4.z & 0xffff0000u), __uint_as_float(xb4.w << 16), __uint_as_float(xb4.w & 0xffff0000u)); } }
#pragma unroll
    for (int rr = 0; rr < 4; ++rr) {
      unsigned m16 = (unsigned)(vm >> (rr * 16)) & 0xffffu; nsel[rr] = __builtin_popcount(m16);
#pragma unroll
      for (int k = 0; k < 2; ++k) {
        if (m16) { const int e = __builtin_ctz(m16); m16 &= m16 - 1; const int pr = __builtin_amdgcn_readlane(pairl, rr * 16 + e);
          const bf16_t* yr = Y + (size_t)pr * D; ya[rr][k][0] = ld_nt_u4(yr + lane * 8); ya[rr][k][1] = ld_nt_u4(yr + 512 + lane * 8); }
        else { ya[rr][k][0] = make_uint4(0u, 0u, 0u, 0u); ya[rr][k][1] = make_uint4(0u, 0u, 0u, 0u); }
      }
    }
    const float* g2 = modvec(p, l, mj, 5);
    float4 gq[4];
#pragma unroll
    for (int hf = 0; hf < 2; ++hf)
#pragma unroll
      for (int q = 0; q < 2; ++q) gq[hf * 2 + q] = *(const float4*)(g2 + hf * 512 + lane * 8 + q * 4);
    asm volatile("s_waitcnt vmcnt(0)" ::: "memory");
#pragma unroll
    for (int rr = 0; rr < 4; ++rr) {
      float acc[16];
#pragma unroll
      for (int i = 0; i < 16; ++i) acc[i] = 0.f;
#pragma unroll
      for (int k = 0; k < 2; ++k)
#pragma unroll
        for (int hf = 0; hf < 2; ++hf) { const unsigned w[4] = {ya[rr][k][hf].x, ya[rr][k][hf].y, ya[rr][k][hf].z, ya[rr][k][hf].w};
#pragma unroll
          for (int i = 0; i < 4; ++i) { acc[hf * 8 + 2 * i] += __uint_as_float(w[i] << 16); acc[hf * 8 + 2 * i + 1] += __uint_as_float(w[i] & 0xffff0000u); } }
      if (nsel[rr] > 2) {
        unsigned m16 = (unsigned)(vm >> (rr * 16)) & 0xffffu; m16 &= m16 - 1; m16 &= m16 - 1;
        while (m16) { const int e = __builtin_ctz(m16); m16 &= m16 - 1; const int pr = __builtin_amdgcn_readlane(pairl, rr * 16 + e);
          const bf16_t* yr = Y + (size_t)pr * D; const uint4 a = *(const uint4*)(yr + lane * 8), bq = *(const uint4*)(yr + 512 + lane * 8);
          const unsigned w[8] = {a.x, a.y, a.z, a.w, bq.x, bq.y, bq.z, bq.w};
#pragma unroll
          for (int i = 0; i < 8; ++i) { acc[2 * i] += __uint_as_float(w[i] << 16); acc[2 * i + 1] += __uint_as_float(w[i] & 0xffff0000u); } }
      }
      float x[16], ss = 0.f;
#pragma unroll
      for (int hf = 0; hf < 2; ++hf)
#pragma unroll
        for (int q = 0; q < 2; ++q) { const int c = hf * 512 + lane * 8 + q * 4; float4 xq = xv[rr][hf * 2 + q]; const float4 gv = gq[hf * 2 + q];
          xq.x += gv.x * acc[hf * 8 + q * 4 + 0]; xq.y += gv.y * acc[hf * 8 + q * 4 + 1]; xq.z += gv.z * acc[hf * 8 + q * 4 + 2]; xq.w += gv.w * acc[hf * 8 + q * 4 + 3];
          if (next_l >= 0) { uint2 xb2; xb2.x = gd::pk(xq.x, xq.y); xb2.y = gd::pk(xq.z, xq.w); *(uint2*)((bf16_t*)xr[rr] + c) = xb2; }
          else st_nt_f4(xr[rr] + c, xq);
          x[hf * 8 + q * 4 + 0] = xq.x; x[hf * 8 + q * 4 + 1] = xq.y; x[hf * 8 + q * 4 + 2] = xq.z; x[hf * 8 + q * 4 + 3] = xq.w;
          ss += xq.x * xq.x + xq.y * xq.y + xq.z * xq.z + xq.w * xq.w; }
      if (next_l >= 0) {
        ss = wave_sum(ss);
        const float rstd = rsqrtf(ss / D + EPS);
        const float* g = p.norm1_g + next_l * D; const float* sh = modvec(p, next_l, mj, 0); const float* sc = modvec(p, next_l, mj, 1);
        bf16_t* h = (bf16_t*)(p.ws + OFF_H) + (size_t)(r4 + rr) * D;
#pragma unroll
        for (int hf = 0; hf < 2; ++hf) { const int c = hf * 512 + lane * 8; float y[8];
#pragma unroll
          for (int i = 0; i < 8; ++i) y[i] = x[hf * 8 + i] * rstd * g[c + i] * (1.f + sc[c + i]) + sh[c + i];
          uint4 w; w.x = gd::pk(y[0], y[1]); w.y = gd::pk(y[2], y[3]); w.z = gd::pk(y[4], y[5]); w.w = gd::pk(y[6], y[7]);
          *(uint4*)(h + c) = w; }
      }
    }
  }
}
template <class RowPtr>
__device__ __forceinline__ gd::f32x4 coop_tile_32x64(RowPtr arow, const bf16_t* Bt, int ldb, int K, float* lds, int wv, int lane) {
  using gd::bf16x8; using gd::f32x4;
  const int cc = lane & 15, g = lane >> 4;
  const bf16_t* a0 = arow(cc) + g * 8; const bf16_t* a1 = arow(16 + cc) + g * 8;
  f32x4 acc[2][4];
#pragma unroll
  for (int m = 0; m < 2; ++m)
#pragma unroll
    for (int n = 0; n < 4; ++n) acc[m][n] = (f32x4){0.f, 0.f, 0.f, 0.f};
  for (int ks = wv; ks < K / 32; ks += 8) {
    const bf16x8 A0 = *(const bf16x8*)(a0 + ks * 32), A1 = *(const bf16x8*)(a1 + ks * 32);
#pragma unroll
    for (int n = 0; n < 4; ++n) { const bf16x8 B = *(const bf16x8*)(Bt + (size_t)(n * 16 + cc) * ldb + ks * 32 + g * 8);
      acc[0][n] = __builtin_amdgcn_mfma_f32_16x16x32_bf16(A0, B, acc[0][n], 0, 0, 0); acc[1][n] = __builtin_amdgcn_mfma_f32_16x16x32_bf16(A1, B, acc[1][n], 0, 0, 0); }
  }
  gd::lds_barrier();
#pragma unroll
  for (int m = 0; m < 2; ++m)
#pragma unroll
    for (int n = 0; n < 4; ++n) *(f32x4*)(lds + ((wv * 8 + m * 4 + n) * 64 + lane) * 4) = acc[m][n];
  gd::lds_barrier();
  f32x4 r = {0.f, 0.f, 0.f, 0.f};
#pragma unroll
  for (int w = 0; w < 8; ++w) r += *(const f32x4*)(lds + ((w * 8 + wv) * 64 + lane) * 4);
  return r;
}
__device__ __forceinline__ void ph_ctx_moe_gu(const Params& p, float* lds) {
  const int TIDX = ltid(); const int BIDX = lbid();
  const int lane = TIDX & 63, wv = TIDX >> 6, cc = lane & 15, g = lane >> 4;
  const bf16_t* H = (const bf16_t*)(p.ws + OFF_H); const bf16_t* GU = (const bf16_t*)(p.ws + OFF_MOEGU); bf16_t* hid = (bf16_t*)(p.ws + OFF_HID);
  const int* idx = (const int*)(p.ws + OFF_IDX);
  for (int it = BIDX; it < 32 * 16; it += gridDim.x) {
    const int grp = 32 + (it >> 4), ns = it & 15, s = grp >> 4, e = grp & 15, pb = pair_base(s, e);
    const gd::f32x4 v4 = coop_tile_32x64([&](int r) { return H + (size_t)idx[pb + r] * D; }, GU + (size_t)e * D * D + (size_t)(ns * 64) * D, D, D, lds, wv, lane);
    const int m = wv >> 2, n = wv & 3;
#pragma unroll
    for (int r = 0; r < 4; ++r) { const float v = v4[r], o = __shfl_xor(v, 1);
      if ((cc & 1) == 0) hid[(size_t)(pb + m * 16 + g * 4 + r) * DEXP + ((ns * 64 + n * 16 + cc) >> 1)] = f2bf(silu_f(v) * o); }
  }
}
__device__ __forceinline__ void ph_ctx_moe_down(const Params& p, float* lds) {
  const int TIDX = ltid(); const int BIDX = lbid();
  const int lane = TIDX & 63, wv = TIDX >> 6, cc = lane & 15, g = lane >> 4;
  const bf16_t* hid = (const bf16_t*)(p.ws + OFF_HID); const bf16_t* DN = (const bf16_t*)(p.ws + OFF_MOED); bf16_t* Y = (bf16_t*)(p.ws + OFF_Y);
  const float* gate = (const float*)(p.ws + OFF_GATE);
  for (int it = BIDX; it < 32 * 16; it += gridDim.x) {
    const int grp = 32 + (it >> 4), ns = it & 15, s = grp >> 4, e = grp & 15, pb = pair_base(s, e);
    const gd::f32x4 v4 = coop_tile_32x64([&](int r) { return hid + (size_t)(pb + r) * DEXP; }, DN + (size_t)e * D * DEXP + (size_t)(ns * 64) * DEXP, DEXP, DEXP, lds, wv, lane);
    const int m = wv >> 2, n = wv & 3;
#pragma unroll
    for (int r = 0; r < 4; ++r) { const int row = pb + m * 16 + g * 4 + r; Y[(size_t)row * D + ns * 64 + n * 16 + cc] = f2bf(v4[r] * gate[row]); }
  }
}
__device__ __forceinline__ void ph_ctx_outproj(const Params& p, int l, float* lds) {
  const int TIDX = ltid(); const int BIDX = lbid();
  const int lane = TIDX & 63, wv = TIDX >> 6, cc = lane & 15, g = lane >> 4;
  const bf16_t* A = (const bf16_t*)(p.ws + OFF_H) + (size_t)ML * D; const bf16_t* W = (const bf16_t*)(p.ws + OFF_WOUTT) + (size_t)l * D * D;
  bf16_t* yo = (bf16_t*)(p.ws + OFF_YO) + (size_t)ML * D;
  for (int it = BIDX; it < 16 * 16; it += gridDim.x) {
    const int mt = it >> 4, ns = it & 15;
    const gd::f32x4 v4 = coop_tile_32x64([&](int r) { return A + (size_t)(mt * 32 + r) * D; }, W + (size_t)(ns * 64) * D, D, D, lds, wv, lane);
    const int m = wv >> 2, n = wv & 3;
#pragma unroll
    for (int r = 0; r < 4; ++r) yo[(size_t)(mt * 32 + m * 16 + g * 4 + r) * D + ns * 64 + n * 16 + cc] = f2bf(v4[r]);
  }
}
__device__ __forceinline__ void ph_modulate2_fast(const Params& p, int l, int nrows, float* lds) {
  const int TIDX = ltid(); const int BIDX = lbid();
  const int lane = TIDX & 63, wv = TIDX >> 6;
  __syncthreads();
  { const float* wr = p.router + (size_t)l * D * NE;
    for (int i = TIDX; i < D * 4; i += NT) { const int c = i >> 2, q = i & 3, pr = (c & ~255) + (c & 3) * 64 + ((c >> 2) & 63);
      *(float4*)(lds + pr * 20 + q * 4) = *(const float4*)(wr + c * 16 + q * 4); } }
  __syncthreads();
  const float* g = p.norm2_g + l * D;
  for (int r4 = (BIDX + gridDim.x * wv) * 4; r4 < nrows; r4 += gridDim.x * 8 * 4) {
    int mj, t, tlen, r0; rowinfo(r4, mj, t, tlen, r0);
    const float* sh = modvec(p, l, mj, 3); const float* sc = modvec(p, l, mj, 4);
    float4 xv[4][4], gv[4], sv[4], hv[4];
#pragma unroll
    for (int rr = 0; rr < 4; ++rr) xv[rr][0] = xv[rr][1] = xv[rr][2] = xv[rr][3] = make_float4(0.f, 0.f, 0.f, 0.f);
    if (l == 0) {
#pragma unroll
      for (int rr = 0; rr < 4; ++rr) { const float* xr = xrow_src(p, r4 + rr, 0);
#pragma unroll
        for (int i = 0; i < 4; ++i) xv[rr][i] = ld_nt_f4(xr + i * 256 + lane * 4); }
    } else {
#pragma unroll
      for (int rr = 0; rr < 4; ++rr) { const bf16_t* xr = (const bf16_t*)xrow_src(p, r4 + rr, 1);
#pragma unroll
        for (int i = 0; i < 4; ++i) { const uint2 v = ld_nt_u2(xr + i * 256 + lane * 4);
          xv[rr][i] = make_float4(__uint_as_float(v.x << 16), __uint_as_float(v.x & 0xffff0000u), __uint_as_float(v.y << 16), __uint_as_float(v.y & 0xffff0000u)); } }
    }
    {
      const float* g1 = modvec(p, l, mj, 2); const bf16_t* yo = (const bf16_t*)(p.ws + OFF_YO);
#pragma unroll
      for (int i = 0; i < 4; ++i) { const int c = i * 256 + lane * 4; const float4 gg = *(const float4*)(g1 + c);
#pragma unroll
        for (int rr = 0; rr < 4; ++rr) { const uint2 yv = ld_nt_u2(yo + (size_t)(r4 + rr) * D + c);
          xv[rr][i].x += gg.x * __uint_as_float(yv.x << 16); xv[rr][i].y += gg.y * __uint_as_float(yv.x & 0xffff0000u);
          xv[rr][i].z += gg.z * __uint_as_float(yv.y << 16); xv[rr][i].w += gg.w * __uint_as_float(yv.y & 0xffff0000u);
          uint2 xb2; xb2.x = gd::pk(xv[rr][i].x, xv[rr][i].y); xb2.y = gd::pk(xv[rr][i].z, xv[rr][i].w);
          *(uint2*)((bf16_t*)xrow(p, r4 + rr) + c) = xb2; } }
    }
#pragma unroll
    for (int i = 0; i < 4; ++i) { const int c = i * 256 + lane * 4; gv[i] = *(const float4*)(g + c); sv[i] = *(const float4*)(sc + c); hv[i] = *(const float4*)(sh + c); }
#pragma unroll
    for (int rr = 0; rr < 4; ++rr) {
      const int r = r4 + rr;
      float ss = 0.f;
#pragma unroll
      for (int i = 0; i < 4; ++i) ss += xv[rr][i].x * xv[rr][i].x + xv[rr][i].y * xv[rr][i].y + xv[rr][i].z * xv[rr][i].z + xv[rr][i].w * xv[rr][i].w;
      ss = wave_sum(ss);
      const float rstd = rsqrtf(ss / D + EPS);
      bf16_t* h = (bf16_t*)(p.ws + OFF_H) + (size_t)r * D;
      float lo[16];
#pragma unroll
      for (int e = 0; e < 16; ++e) lo[e] = 0.f;
#pragma unroll
      for (int i = 0; i < 4; ++i) {
        const int c = i * 256 + lane * 4;
        float y[4];
        y[0] = xv[rr][i].x * rstd * gv[i].x * (1.f + sv[i].x) + hv[i].x; y[1] = xv[rr][i].y * rstd * gv[i].y * (1.f + sv[i].y) + hv[i].y;
        y[2] = xv[rr][i].z * rstd * gv[i].z * (1.f + sv[i].z) + hv[i].z; y[3] = xv[rr][i].w * rstd * gv[i].w * (1.f + sv[i].w) + hv[i].w;
        uint2 w; w.x = gd::pk(y[0], y[1]); w.y = gd::pk(y[2], y[3]);
        *(uint2*)(h + c) = w;
#pragma unroll
        for (int q = 0; q < 4; ++q) {
          const float* wrow = lds + (i * 256 + q * 64 + lane) * 20;
#pragma unroll
          for (int e4 = 0; e4 < 4; ++e4) { const float4 w4 = *(const float4*)(wrow + e4 * 4);
            lo[e4 * 4 + 0] += y[q] * w4.x; lo[e4 * 4 + 1] += y[q] * w4.y; lo[e4 * 4 + 2] += y[q] * w4.z; lo[e4 * 4 + 3] += y[q] * w4.w; }
        }
      }
#pragma unroll
      for (int k = 0; k < 4; ++k) {
        const int half = 8 >> k, mask = 32 >> k; const bool upper = (lane & mask) != 0;
#pragma unroll
        for (int i = 0; i < half; ++i) { const float send = upper ? lo[i] : lo[i + half]; const float recv = __shfl_xor(send, mask); lo[i] = (upper ? lo[i + half] : lo[i]) + recv; }
      }
      float v = lo[0]; v += __shfl_xor(v, 1); v += __shfl_xor(v, 2);
      float mx = v;
      mx = fmaxf(mx, __shfl_xor(mx, 4)); mx = fmaxf(mx, __shfl_xor(mx, 8)); mx = fmaxf(mx, __shfl_xor(mx, 16)); mx = fmaxf(mx, __shfl_xor(mx, 32));
      const float ex = expf(v - mx);
      float sm = ex; sm += __shfl_xor(sm, 4); sm += __shfl_xor(sm, 8); sm += __shfl_xor(sm, 16); sm += __shfl_xor(sm, 32);
      if ((lane & 3) == 0) { const int e = ((lane >> 5) & 1) * 8 + ((lane >> 4) & 1) * 4 + ((lane >> 3) & 1) * 2 + ((lane >> 2) & 1);
        ((float*)(p.ws + OFF_AFFT))[(size_t)e * MR + r] = ex / sm; }
    }
  }
}

__device__ __forceinline__ void ph_modulate1_fast(const Params& p) {
  const int TIDX = ltid(); const int BIDX = lbid();
  const int lane = TIDX & 63, wv = TIDX >> 6;
  const float* g = p.norm1_g;
  for (int r2 = (BIDX + gridDim.x * wv) * 2; r2 < MR; r2 += gridDim.x * 8 * 2) {
    int mj, t, tlen, r0; rowinfo(r2, mj, t, tlen, r0);
    const float* sh = modvec(p, 0, mj, 0); const float* sc = modvec(p, 0, mj, 1);
    float4 xv[2][4];
#pragma unroll
    for (int rr = 0; rr < 2; ++rr) { const float* xr = xrow_src(p, r2 + rr, 0);
#pragma unroll
      for (int i = 0; i < 4; ++i) xv[rr][i] = ld_nt_f4(xr + i * 256 + lane * 4); }
    float4 gv[4], sv[4], hv[4];
#pragma unroll
    for (int i = 0; i < 4; ++i) { const int c = i * 256 + lane * 4; gv[i] = *(const float4*)(g + c); sv[i] = *(const float4*)(sc + c); hv[i] = *(const float4*)(sh + c); }
#pragma unroll
    for (int rr = 0; rr < 2; ++rr) {
      float ss = 0.f;
#pragma unroll
      for (int i = 0; i < 4; ++i) ss += xv[rr][i].x * xv[rr][i].x + xv[rr][i].y * xv[rr][i].y + xv[rr][i].z * xv[rr][i].z + xv[rr][i].w * xv[rr][i].w;
      ss = wave_sum(ss);
      const float rstd = rsqrtf(ss / D + EPS);
      bf16_t* h = (bf16_t*)(p.ws + OFF_H) + (size_t)(r2 + rr) * D;
#pragma unroll
      for (int i = 0; i < 4; ++i) { const int c = i * 256 + lane * 4;
        uint2 w; w.x = gd::pk(xv[rr][i].x * rstd * gv[i].x * (1.f + sv[i].x) + hv[i].x, xv[rr][i].y * rstd * gv[i].y * (1.f + sv[i].y) + hv[i].y);
        w.y = gd::pk(xv[rr][i].z * rstd * gv[i].z * (1.f + sv[i].z) + hv[i].z, xv[rr][i].w * rstd * gv[i].w * (1.f + sv[i].w) + hv[i].w);
        *(uint2*)(h + c) = w; }
    }
  }
}

constexpr size_t LDS_BYTES = 163840;
__global__ void __launch_bounds__(NT, 2) mega(Params p) {
  extern __shared__ __attribute__((aligned(16))) char smem[];
  float* lds = (float*)smem;
  volatile LAS unsigned* xbst = (volatile LAS unsigned*)(smem + LDS_BYTES - 16);
  if (threadIdx.x == 0) { xbst[0] = 0u; xbst[1] = 0u; xbst[2] = 0u; xbst[3] = 0u; }
  __syncthreads();
  XcdBarrier xb = xcd_barrier_post((unsigned*)(p.ws + OFF_BAR), xbst);
  cg::grid_group grid = cg::this_grid();

  if (p.ws == nullptr) grid.sync();
  for (int l = 0; l < 2; ++l) {
    const bool need_ctx = l == 0;
    const int nrows = need_ctx ? MR : ML, nseq = need_ctx ? 4 : 2;
    if (l == 0) { ph_ada_fast(p, lds); ph_prep_weights(p, lds); xcd_barrier(xb); ph_modulate1_fast(p); xcd_barrier(xb); }
    for (int _r = 0; _r < REP_INPROJ; ++_r) ph_inproj_fast(p, l, smem);
    xcd_barrier(xb);
    { unsigned* bar = (unsigned*)(p.ws + OFF_BAR); unsigned* ctr = bar + 64 + 32 * l;
      ph_mla_gemm(p, l, smem);
      if (lbid() >= 32) handoff_publish(ctr);
      ph_gdn_precompute(p, l, smem);
      if (lbid() >= 32) { handoff_wait(ctr, gridDim.x - 32, bar); ph_mla_finish(p, l, lds); } }
    xcd_barrier(xb);
    for (int _r = 0; _r < REP_SCAN; ++_r) ph_scan_fast(p, smem);
    for (int _r = 0; _r < REP_ATTN; ++_r) ph_attn_fast(p, need_ctx, smem);
    ph_pool_mfma(p, l, nrows, smem);
    xcd_barrier(xb);
    ph_gdnfin_pool_fast<2>(p, l, nrows, lds, 0, (int)gridDim.x);
    xcd_barrier(xb);
    ph_outproj_fast(p, l, smem);
    if (need_ctx) ph_ctx_outproj(p, l, lds);
    xcd_barrier(xb);
    for (int _r = 0; _r < REP_MOD; ++_r) ph_modulate2_fast(p, l, nrows, lds);
    xcd_barrier(xb);
    for (int _r = 0; _r < REP_TOPK; ++_r) ph_topk_fast(p, nseq, smem);
    ph_prep_moe_weights(p, l, lds, 0, (int)gridDim.x);
    xcd_barrier(xb);
    for (int _r = 0; _r < REP_MOEGU; ++_r) ph_moe_gu_fast(p, smem);
    if (need_ctx) ph_ctx_moe_gu(p, lds);
    xcd_barrier(xb);
    ph_moe_down_fast(p, smem);
    if (need_ctx) ph_ctx_moe_down(p, lds);
    xcd_barrier(xb);
    ph_combine_fast(p, l, nrows, l == 0 ? 1 : -1);
    if (l == 0) xcd_barrier(xb);
  }
}

extern "C" void kernel_launch(void* const* d_in, const int* in_sizes, int n_in, void* d_out, int out_size, void* d_ws, size_t ws_size, hipStream_t stream) {
  static int grid_blocks = 0;
  if (ws_size < OFF_END) { fprintf(stderr, "kernel_launch: workspace too small: %zu < %zu\n", ws_size, (size_t)OFF_END); return; }
  if (!grid_blocks) {
    if (hipFuncSetAttribute((const void*)mega, hipFuncAttributeMaxDynamicSharedMemorySize, (int)LDS_BYTES) != hipSuccess) { fprintf(stderr, "kernel_launch: hipFuncSetAttribute failed\n"); return; }
    int dev = 0, cus = 0, per_cu = 0;
    hipGetDevice(&dev);
    hipDeviceGetAttribute(&cus, hipDeviceAttributeMultiprocessorCount, dev);
    hipOccupancyMaxActiveBlocksPerMultiprocessor(&per_cu, mega, NT, LDS_BYTES);
    if (per_cu < 1) { fprintf(stderr, "kernel_launch: occupancy query returned %d\n", per_cu); return; }
    grid_blocks = cus;
  }
  Params p{};
  const float** f = (const float**)&p;
  for (int i = 0; i < 26; ++i) f[i] = (const float*)d_in[i];
  p.out = (float*)d_out; p.ws = (char*)d_ws;
  hipMemsetAsync((char*)d_ws + OFF_BAR, 0, 16384, stream);
  void* args[] = {&p};
  hipError_t e = hipLaunchCooperativeKernel((const void*)mega, dim3(grid_blocks), dim3(NT), args, LDS_BYTES, stream);
  if (e != hipSuccess) fprintf(stderr, "cooperative launch failed: %s (grid %d)\n", hipGetErrorString(e), grid_blocks);
}
```

```cpp
#include <hip/hip_runtime.h>
#include <hip/hip_bf16.h>
#include <hip/hip_cooperative_groups.h>
#include <cstdint>
#include <cstdio>
namespace cg = cooperative_groups;
#define REP_SCAN 1
#define REP_ATTN 1
#define REP_PRE 1
#define REP_MLA 1
#define REP_PMW 1
#define REP_TOPK 1
#define REP_GATHER 1
#define REP_INPROJ 1
#define REP_MOEGU 1
#define REP_MOD 1
#define REP_FIN 1
#define REP_INIT 1

constexpr int D = 1024, NB = 2, T = 8192, TC = 256;
constexpr int ML = NB * T;
constexpr int MC = NB * TC;
constexpr int MR = ML + MC;
constexpr int NIN = 2672, NINP = 2816;
constexpr int NE = 16, DEXP = 512, CAPL = 1024, CAPC = 32;
constexpr int NPAIR = NB * NE * CAPL + NB * NE * CAPC;
constexpr int TK = TC + T;
constexpr float EPS = 1e-6f;
constexpr int NT = 512;
constexpr int PC_Q = 0, PC_KV = 192, PC_KR = 320, PC_GQ = 352, PC_GK = 864, PC_GV = 1376, PC_Z = 1888, PC_A = 2400, PC_B = 2408, PC_POOL = 2416;
constexpr int PC_OF = 352, PC_OB = 864;

typedef unsigned short bf16_t;
__device__ __forceinline__ float bf2f(bf16_t b) { return __uint_as_float(((unsigned)b) << 16); }
__device__ __forceinline__ bf16_t f2bf(float f) { unsigned u = __float_as_uint(f); u += 0x7FFFu + ((u >> 16) & 1u); return (bf16_t)(u >> 16); }
__device__ __forceinline__ float silu_f(float x) { return x * __builtin_amdgcn_rcpf(1.0f + __expf(-x)); }
__device__ __forceinline__ float sigmoid_f(float x) { return 1.0f / (1.0f + expf(-x)); }
__device__ __forceinline__ float softplus_f(float x) {
  if (x > 20.f) return x;
  const float y = __expf(x);
  return y < 0.0625f ? y * (1.f - y * (0.5f - y * (0.333333343f - 0.25f * y))) : __logf(1.f + y);
}

typedef float f4v_t __attribute__((ext_vector_type(4))); typedef unsigned u2v_t __attribute__((ext_vector_type(2))); typedef unsigned u4v_t __attribute__((ext_vector_type(4)));
__device__ __forceinline__ float4 ld_nt_f4(const float* q) { const f4v_t v = __builtin_nontemporal_load((const f4v_t*)q); return make_float4(v[0], v[1], v[2], v[3]); }
__device__ __forceinline__ uint2 ld_nt_u2(const void* q) { const u2v_t v = __builtin_nontemporal_load((const u2v_t*)q); return make_uint2(v[0], v[1]); }
__device__ __forceinline__ uint4 ld_nt_u4(const void* q) { const u4v_t v = __builtin_nontemporal_load((const u4v_t*)q); return make_uint4(v[0], v[1], v[2], v[3]); }
__device__ __forceinline__ void st_nt_f4(float* q, const float4 v) { const f4v_t w = {v.x, v.y, v.z, v.w}; __builtin_nontemporal_store(w, (f4v_t*)q); }
constexpr size_t al256(size_t x) { return (x + 255) / 256 * 256; }
constexpr size_t OFF_BAR = 0;
constexpr size_t OFF_MOD = 16384;
constexpr size_t OFF_XC = al256(OFF_MOD + 2 * 3 * 6144 * 4);
constexpr size_t OFF_AFFT = al256(OFF_XC + (size_t)MC * D * 4);
constexpr size_t OFF_IDX = al256(OFF_AFFT + (size_t)NE * MR * 4);
constexpr size_t OFF_GATE = al256(OFF_IDX + (size_t)NPAIR * 4);
constexpr size_t OFF_SLOT = al256(OFF_GATE + (size_t)NPAIR * 4);
constexpr size_t OFF_GB = al256(OFF_SLOT + (size_t)MR * 16 * 4);
constexpr size_t OFF_H = al256(OFF_GB + (size_t)MR * 16 * 4);
constexpr size_t OFF_P = al256(OFF_H + (size_t)MR * D * 2);
constexpr size_t OFF_RB = al256(OFF_P + (size_t)MR * NINP * 2);
constexpr size_t RB_BYTES = (size_t)1056 * 100352;
constexpr size_t OFF_QKV = al256(OFF_RB + RB_BYTES);
constexpr size_t QK_ELEMS = (size_t)NB * 4 * TK * 128, V_ELEMS = (size_t)NB * 4 * TK * 64;
constexpr size_t OFF_WINT = al256(OFF_QKV + (2 * QK_ELEMS + V_ELEMS) * 2);
constexpr size_t OFF_WOUTT = al256(OFF_WINT + (size_t)2 * NINP * D * 2);
constexpr size_t OFF_WUP = al256(OFF_WOUTT + (size_t)2 * D * D * 2);
constexpr size_t OFF_MOEGU = al256(OFF_WUP + (size_t)2 * 1024 * 256 * 2);
constexpr size_t OFF_MOED = OFF_MOEGU + (size_t)NE * D * D * 2;
constexpr size_t OFF_END = al256(OFF_MOED + (size_t)NE * D * DEXP * 2);
constexpr size_t OFF_UPRAW = OFF_MOEGU;
constexpr size_t OFF_OPART = OFF_MOEGU;
constexpr size_t OFF_MLPART = OFF_OPART + (size_t)4 * ML * 256 * 2;
static_assert(OFF_MLPART + (size_t)4 * ML * 4 * 2 * 4 <= OFF_END, "partials must fit in the MoE weight region");
constexpr size_t OFF_HID = OFF_RB + (size_t)64 * 1024 * 1024;
constexpr size_t OFF_Y = OFF_P;
constexpr size_t OFF_YO = OFF_P;
constexpr size_t OFF_XS = OFF_P;


struct Params {
  const float* x; const float* c; const float* ctx; const float* c_ctx; const float* ada_w; const float* ada_b;
  const float* norm1_g; const float* norm2_g; const float* w_in; const float* q_a_norm; const float* w_uq; const float* kv_a_norm;
  const float* w_ukv; const float* q_norm; const float* k_norm; const float* conv_w; const float* a_log; const float* dt_bias;
  const float* gdn_norm_g; const float* pool_w; const float* pool_scale; const float* w_out; const float* router;
  const float* w_gate; const float* w_up; const float* w_down;
  float* out; char* ws;
};

__device__ __forceinline__ const float* xrow_src(const Params& p, int r, int l) { return l == 0 ? (r < ML ? p.x + (size_t)r * D : p.ctx + (size_t)(r - ML) * D) : (r < ML ? p.out + (size_t)r * D : (const float*)(p.ws + OFF_XC) + (size_t)(r - ML) * D); }
__device__ __forceinline__ float* xrow(const Params& p, int r) { return r < ML ? p.out + (size_t)r * D : (float*)(p.ws + OFF_XC) + (size_t)(r - ML) * D; }
__device__ __forceinline__ void rowinfo(int r, int& mj, int& t, int& tlen, int& r0) {
  if (r < ML) { mj = r >> 13; t = r & (T - 1); tlen = T; r0 = r - t; } else { int rc = r - ML; mj = 2; t = rc & (TC - 1); tlen = TC; r0 = r - t; }
}
__device__ __forceinline__ const float* modvec(const Params& p, int l, int mj, int chunk) { return (const float*)(p.ws + OFF_MOD) + ((size_t)(l * 3 + mj) * 6 + chunk) * D; }
__device__ __forceinline__ int pair_base(int s, int e) { return s < 2 ? (s * NE + e) * CAPL : NB * NE * CAPL + ((s - 2) * NE + e) * CAPC; }
__device__ __forceinline__ float wave_sum(float v) { for (int o = 32; o > 0; o >>= 1) v += __shfl_xor(v, o); return v; }

__device__ __forceinline__ int ltid() { int t = threadIdx.x; asm volatile("" : "+v"(t)); return t; }
__device__ __forceinline__ int lbid() { int t = blockIdx.x; asm volatile("" : "+s"(t)); return t; }
#define XB_TMO      128
#define XB_XCNT(j)  (256  + 64 * (j))
#define XB_XSUB(j)  (1280 + 64 * (j))
#define XB_XGEN(j)  (2304 + 64 * (j))
#define XB_TOP      3328
#define XB_TOPGEN   3392
#define XCD_BAR_WORDS 3456
#define XB_SPIN_CAP (1u << 22)
#define LAS __attribute__((address_space(3)))
__device__ __forceinline__ unsigned xb_ld(unsigned* p)              { return __hip_atomic_load(p, __ATOMIC_RELAXED, __HIP_MEMORY_SCOPE_AGENT); }
__device__ __forceinline__ unsigned xb_add(unsigned* p, unsigned v) { return __hip_atomic_fetch_add(p, v, __ATOMIC_RELAXED, __HIP_MEMORY_SCOPE_AGENT); }
__device__ __forceinline__ unsigned xb_xcc_id() { return (unsigned)__builtin_amdgcn_s_getreg((3 << 11) | 20) & 0xFu; }
#define XB_SPIN(cond, bar) do { unsigned _sp = 0; while (cond) { __builtin_amdgcn_s_sleep(1); \
    if ((++_sp & 255u) == 0u) { if (xb_ld(&(bar)[XB_TMO])) break; if (_sp > XB_SPIN_CAP) { atomicAdd(&(bar)[XB_TMO], 1u); break; } } } } while (0)
struct XcdBarrier { unsigned* bar; unsigned x; volatile LAS unsigned* st; };
__device__ __forceinline__ XcdBarrier xcd_barrier_post(unsigned* bar, volatile LAS unsigned* st) {
  XcdBarrier b; b.bar = bar; b.x = xb_xcc_id(); b.st = st;
  if (threadIdx.x == 0) (void)xb_add(&bar[XB_XCNT(b.x)], 1u);
  return b;
}
__device__ __forceinline__ void xcd_barrier_complete(unsigned* bar, unsigned x, unsigned& nloc, unsigned& nx) {
  const unsigned G = gridDim.x * gridDim.y * gridDim.z;
  unsigned sum, cnt, mine, sp = 0u;
  for (;;) {
    sum = 0u; cnt = 0u; mine = 0u;
#pragma unroll
    for (unsigned j = 0; j < 16; ++j) { const unsigned c = xb_ld(&bar[XB_XCNT(j)]); sum += c; cnt += (c > 0u) ? 1u : 0u; mine = (j == x) ? c : mine; }
    if (sum == G) break;
    __builtin_amdgcn_s_sleep(1);
    if ((++sp & 255u) == 0u) { if (xb_ld(&bar[XB_TMO])) break; if (sp > XB_SPIN_CAP) { atomicAdd(&bar[XB_TMO], 1u); break; } }
  }
  nloc = mine > 0u ? mine : 1u; nx = cnt > 0u ? cnt : 1u;
}
__device__ __forceinline__ void xcd_barrier(const XcdBarrier& b) {
  asm volatile("s_waitcnt vmcnt(0)" ::: "memory");
  __syncthreads();
  if (threadIdx.x == 0) {
    unsigned* bar = b.bar;
    __builtin_amdgcn_s_waitcnt(0);
    unsigned nloc = b.st[0], nx = b.st[1];
    if (nloc == 0u) { xcd_barrier_complete(bar, b.x, nloc, nx); b.st[0] = nloc; b.st[1] = nx; }
    const unsigned old = xb_add(&bar[XB_XSUB(b.x)], 1u);
    const unsigned gen = old / nloc;
    if (old + 1u == (gen + 1u) * nloc) {
      __builtin_amdgcn_fence(__ATOMIC_RELEASE, "agent");
      asm volatile("s_waitcnt vmcnt(0)" ::: "memory");
      const unsigned og = xb_add(&bar[XB_TOP], 1u);
      const unsigned tg = og / nx;
      if (og + 1u == (tg + 1u) * nx) xb_add(&bar[XB_TOPGEN], 1u);
      else XB_SPIN(xb_ld(&bar[XB_TOPGEN]) == tg, bar);
      xb_add(&bar[XB_XGEN(b.x)], 1u);
      __builtin_amdgcn_fence(__ATOMIC_ACQUIRE, "agent");
      asm volatile("s_waitcnt vmcnt(0)" ::: "memory");
    } else {
      XB_SPIN(xb_ld(&bar[XB_XGEN(b.x)]) == gen, bar);
      __builtin_amdgcn_fence(__ATOMIC_ACQUIRE, "agent");
      asm volatile("s_waitcnt vmcnt(0)" ::: "memory");
    }
  }
  __syncthreads();
}


namespace pg8 {
#define PG8_LAS __attribute__((address_space(3)))
typedef short bf16x8 __attribute__((ext_vector_type(8)));
typedef float f32x4 __attribute__((ext_vector_type(4)));
typedef unsigned u32x4 __attribute__((ext_vector_type(4)));
constexpr int BM = 256, BK = 64, HALF = 128, HTB = HALF * BK * 2, STAGE_BYTES = 8 * HTB, NXCD = 8, WGM = 8;
__host__ __device__ __forceinline__ int lds_byte(int r, int c) { const int st = (r >> 4) * 2 + (c >> 5), rr = r & 15, cc = c & 31, ob = rr * 64 + cc * 2; return st * 1024 + (ob ^ (((ob >> 9) & 1) << 5)); }
__host__ __device__ __forceinline__ void stage_rc(int b, int& R, int& C) { const int st = b / 1024, sb = b % 1024, swz = sb ^ (((sb >> 9) & 1) << 5); R = (st >> 1) * 16 + swz / 64; C = (st & 1) * 32 + (swz % 64) / 2; }
__host__ __device__ __forceinline__ int perm32(int rho) { const int n = rho >> 4, i = rho & 15; return 8 * (i >> 2) + 4 * n + (i & 3); }
struct Unit { int pm, pn; };
__device__ __forceinline__ unsigned cvt_pk_bf16(float lo, float hi) { unsigned r; asm volatile("v_cvt_pk_bf16_f32 %0, %1, %2" : "=v"(r) : "v"(lo), "v"(hi)); return r; }
struct GridOrder {
  int nM, nN, nwg, G, c;
  __device__ __forceinline__ void init(int nM_, int nN_, int G_, int c_) { nM = nM_; nN = nN_; nwg = nM * nN; G = G_; c = c_; }
  __device__ __forceinline__ bool next(int i, Unit& u) const {
    const long L = (long)i * G + c; if (L >= nwg) return false;
    int wgid = (int)L; { const int q = nwg / NXCD, r = nwg % NXCD, xcd = wgid % NXCD, off = wgid / NXCD; wgid = (xcd < r ? xcd * (q + 1) : r * (q + 1) + (xcd - r) * q) + off; }
    const int nig = WGM * nN, gid = wgid / nig, fm = gid * WGM, gsz = (nM - fm) < WGM ? (nM - fm) : WGM;
    u.pm = fm + ((wgid % nig) % gsz); u.pn = (wgid % nig) / gsz; return true;
  }
};
template <class Epi, class Sched, bool GATHER = false>
__device__ __forceinline__ void gemm_phase(PG8_LAS unsigned char* lds, const Sched& S, const Epi& E) {
  const int tid = ltid(), wid = __builtin_amdgcn_readfirstlane(tid >> 6), lane = tid & 63, wr = wid >> 2, wc = wid & 3, fr = lane & 15, fq = lane >> 4;
  const int K = S.K, nt = K / BK;
  unsigned voffA[2], voffB[2]; int RA[2], CA[2];
#pragma unroll
  for (int i = 0; i < 2; ++i) { int R, C; stage_rc(tid * 16 + i * 8192, R, C); const int Rb = Epi::PERM ? ((R & ~31) + perm32(R & 31)) : R;
    voffA[i] = (unsigned)(R * S.lda + C) * 2u; voffB[i] = (unsigned)(Rb * S.ldb + C) * 2u; RA[i] = R; CA[i] = C; }
  const size_t kstep = (size_t)(BK * 2);
  const size_t hstepA = GATHER ? 0 : (size_t)HALF * S.lda * 2, hstepB = (size_t)HALF * S.ldb * 2;
  unsigned vc[2][2], vn[2][2];
#define PG8_GOFF(dst, unit) do { if (GATHER) { _Pragma("unroll") for (int _h = 0; _h < 2; ++_h) _Pragma("unroll") for (int _i = 0; _i < 2; ++_i) \
    dst[_h][_i] = (unsigned)(S.gidx[(unit).pm * 256 + _h * HALF + RA[_i]] * S.lda + CA[_i]) * 2u; } } while (0)
#define PG8_STAGE_A(bufoff, gbase, half, usenext) do { if (GATHER) { unsigned _v[2] = {(usenext) ? vn[half][0] : vc[half][0], (usenext) ? vn[half][1] : vc[half][1]}; PG8_STAGE(bufoff, gbase, _v); } \
    else PG8_STAGE(bufoff, gbase, voffA); } while (0)
  const unsigned ldsw = (unsigned)wid * 1024u;
  const int aoff = lds_byte(wr * 64 + fr, fq * 8), boff = lds_byte(wc * 32 + fr, fq * 8);
#define PG8_SA(b, h) (((b) * 2 + (h)) * HTB)
#define PG8_SB(b, h) ((4 + (b) * 2 + (h)) * HTB)
#define PG8_STAGE(bufoff, gbase, voff) do { _Pragma("unroll") for (int _i = 0; _i < 2; ++_i) \
    __builtin_amdgcn_global_load_lds((const unsigned*)((const char*)(gbase) + (voff)[_i]), (PG8_LAS unsigned*)(lds + (bufoff) + ldsw + _i * 8192), 16, 0, 0); } while (0)
#define PG8_LDA(dst, b, h) do { _Pragma("unroll") for (int m = 0; m < 4; ++m) _Pragma("unroll") for (int k = 0; k < 2; ++k) dst[m][k] = *(const PG8_LAS bf16x8*)(lds + PG8_SA(b, h) + aoff + m * 2048 + k * 1024); } while (0)
#define PG8_LDB(dst, b, h) do { _Pragma("unroll") for (int n = 0; n < 2; ++n) _Pragma("unroll") for (int k = 0; k < 2; ++k) dst[n][k] = *(const PG8_LAS bf16x8*)(lds + PG8_SB(b, h) + boff + n * 2048 + k * 1024); } while (0)
#define PG8_MMA(ai, bj, At, Bt) do { __builtin_amdgcn_s_setprio(1); _Pragma("unroll") for (int m = 0; m < 4; ++m) _Pragma("unroll") for (int n = 0; n < 2; ++n) _Pragma("unroll") for (int k = 0; k < 2; ++k) \
    acc[ai][bj][m][n] = __builtin_amdgcn_mfma_f32_16x16x32_bf16(Bt[n][k], At[m][k], acc[ai][bj][m][n], 0, 0, 0); __builtin_amdgcn_s_setprio(0); } while (0)
#define PG8_WAIT_V(n) asm volatile("s_waitcnt vmcnt(" #n ")" ::: "memory")
#define PG8_WAIT_L(n) asm volatile("s_waitcnt lgkmcnt(" #n ")" ::: "memory")
#define PG8_BAR __builtin_amdgcn_s_barrier()
#define PG8_SCHED __builtin_amdgcn_sched_barrier(0)
  Unit cur, nxt; int ui = 0;
  if (!S.next(0, cur)) return;
  f32x4 acc[2][2][4][2];
#pragma unroll
  for (int a = 0; a < 2; ++a)
#pragma unroll
    for (int b = 0; b < 2; ++b)
#pragma unroll
      for (int m = 0; m < 4; ++m)
#pragma unroll
        for (int n = 0; n < 2; ++n) acc[a][b][m][n] = (f32x4){0.f, 0.f, 0.f, 0.f};
  bf16x8 At[4][2], B0[2][2], B1[2][2];
  const char* cA = S.a_ptr(cur); const char* cB = S.b_ptr(cur);
  PG8_GOFF(vc, cur);
  PG8_STAGE(PG8_SB(0, 0), cB, voffB); PG8_STAGE_A(PG8_SA(0, 0), cA, 0, false); PG8_STAGE(PG8_SB(0, 1), cB + hstepB, voffB); PG8_STAGE_A(PG8_SA(0, 1), cA + hstepA, 1, false);
  if (wr == 1) PG8_BAR;
  PG8_WAIT_V(4); PG8_BAR;
  PG8_STAGE(PG8_SB(1, 0), cB + kstep, voffB); PG8_STAGE_A(PG8_SA(1, 0), cA + kstep, 0, false); PG8_STAGE(PG8_SB(1, 1), cB + hstepB + kstep, voffB);
  PG8_WAIT_V(6); PG8_BAR;
  for (;;) {
    const bool has_next = S.next(ui + 1, nxt);
    const char* nA = has_next ? S.a_ptr(nxt) : cA; const char* nB = has_next ? S.b_ptr(nxt) : cB;
    if (has_next) PG8_GOFF(vn, nxt); else { _Pragma("unroll") for (int _h = 0; _h < 2; ++_h) _Pragma("unroll") for (int _i = 0; _i < 2; ++_i) vn[_h][_i] = vc[_h][_i]; }
    for (int t = 0; t < nt; t += 2) {
      const bool last = (t == nt - 2);
      const char* a1 = cA + (size_t)(t + 1) * kstep;
      const char* a2 = last ? nA : cA + (size_t)(t + 2) * kstep; const char* b2 = last ? nB : cB + (size_t)(t + 2) * kstep;
      const char* a3 = a2 + kstep; const char* b3 = b2 + kstep;
      PG8_LDB(B0, 0, 0); PG8_SCHED; PG8_LDA(At, 0, 0); PG8_STAGE_A(PG8_SA(1, 1), a1 + hstepA, 1, false);
      PG8_WAIT_L(8); PG8_BAR; PG8_WAIT_L(0); PG8_MMA(0, 0, At, B0); PG8_BAR; PG8_SCHED;
      PG8_LDB(B1, 0, 1); PG8_STAGE(PG8_SB(0, 0), b2, voffB);
      PG8_BAR; PG8_WAIT_L(0); PG8_MMA(0, 1, At, B1); PG8_BAR;
      PG8_LDA(At, 0, 1); PG8_STAGE_A(PG8_SA(0, 0), a2, 0, last);
      PG8_BAR; PG8_WAIT_L(0); PG8_MMA(1, 0, At, B0); PG8_BAR; PG8_SCHED;
      PG8_STAGE(PG8_SB(0, 1), b2 + hstepB, voffB);
      PG8_WAIT_V(6); PG8_BAR; PG8_MMA(1, 1, At, B1); PG8_BAR;
      PG8_LDB(B0, 1, 0); PG8_SCHED; PG8_LDA(At, 1, 0); PG8_STAGE_A(PG8_SA(0, 1), a2 + hstepA, 1, last);
      PG8_WAIT_L(8); PG8_BAR; PG8_WAIT_L(0); PG8_MMA(0, 0, At, B0); PG8_BAR; PG8_SCHED;
      PG8_LDB(B1, 1, 1); PG8_STAGE(PG8_SB(1, 0), b3, voffB);
      PG8_BAR; PG8_WAIT_L(0); PG8_MMA(0, 1, At, B1); PG8_BAR;
      PG8_LDA(At, 1, 1); PG8_STAGE_A(PG8_SA(1, 0), a3, 0, last);
      PG8_BAR; PG8_WAIT_L(0); PG8_MMA(1, 0, At, B0); PG8_BAR; PG8_SCHED;
      PG8_STAGE(PG8_SB(1, 1), b3 + hstepB, voffB);
      PG8_WAIT_V(6); PG8_BAR; PG8_MMA(1, 1, At, B1); PG8_BAR;
    }
    E(acc, cur, wr, wc, fr, fq);
    if (!has_next) break;
#pragma unroll
    for (int a = 0; a < 2; ++a)
#pragma unroll
      for (int b = 0; b < 2; ++b)
#pragma unroll
        for (int m = 0; m < 4; ++m)
#pragma unroll
          for (int n = 0; n < 2; ++n) acc[a][b][m][n] = (f32x4){0.f, 0.f, 0.f, 0.f};
    cur = nxt; cA = nA; cB = nB; ++ui;
    _Pragma("unroll") for (int _h = 0; _h < 2; ++_h) _Pragma("unroll") for (int _i = 0; _i < 2; ++_i) vc[_h][_i] = vn[_h][_i];
  }
  PG8_WAIT_V(0);
  if (wr == 0) PG8_BAR;
  PG8_BAR;
#undef PG8_SA
#undef PG8_SB
#undef PG8_STAGE
#undef PG8_STAGE_A
#undef PG8_GOFF
#undef PG8_LDA
#undef PG8_LDB
#undef PG8_MMA
#undef PG8_WAIT_V
#undef PG8_WAIT_L
#undef PG8_BAR
#undef PG8_SCHED
}
}

struct DenseSched : pg8::GridOrder {
  const char* A; const char* Bt; int lda, ldb, K; const int* gidx;
  __device__ __forceinline__ const char* a_ptr(const pg8::Unit& u) const { return A + (size_t)u.pm * 256 * lda * 2; }
  __device__ __forceinline__ const char* b_ptr(const pg8::Unit& u) const { return Bt + (size_t)u.pn * 256 * ldb * 2; }
};
struct EpiStoreBf16 {
  static constexpr bool PERM = true, AFTER_DRAIN = false;
  bf16_t* O; int ldc;
  __device__ __forceinline__ void operator()(const pg8::f32x4 (&acc)[2][2][4][2], const pg8::Unit& u, int wr, int wc, int fr, int fq) const {
    const int row0 = u.pm * 256 + wr * 64 + fr, col0 = u.pn * 256 + wc * 32 + 8 * fq;
#pragma unroll
    for (int ai = 0; ai < 2; ++ai)
#pragma unroll
      for (int m = 0; m < 4; ++m) { bf16_t* rowp = O + (size_t)(row0 + ai * 128 + m * 16) * ldc + col0;
#pragma unroll
        for (int bj = 0; bj < 2; ++bj) { const pg8::f32x4 v0 = acc[ai][bj][m][0], v1 = acc[ai][bj][m][1];
          pg8::u32x4 w; w.x = pg8::cvt_pk_bf16(v0[0], v0[1]); w.y = pg8::cvt_pk_bf16(v0[2], v0[3]); w.z = pg8::cvt_pk_bf16(v1[0], v1[1]); w.w = pg8::cvt_pk_bf16(v1[2], v1[3]);
          *(pg8::u32x4*)(rowp + bj * 128) = w; } }
  }
};
struct EpiResidual {
  static constexpr bool PERM = false, AFTER_DRAIN = false;
  float* xl; float* xc; const float* mod;
  int chunk;
  __device__ __forceinline__ void operator()(const pg8::f32x4 (&acc)[2][2][4][2], const pg8::Unit& u, int wr, int wc, int fr, int fq) const {
    const int mj = u.pm < 32 ? 0 : (u.pm < 64 ? 1 : 2);
    float* base = u.pm < 64 ? xl + (size_t)u.pm * 256 * D : xc + (size_t)(u.pm - 64) * 256 * D;
    const float* gv = mod + ((size_t)mj * 6 + chunk) * D;
    const int row0 = wr * 64 + fr, col0 = u.pn * 256 + wc * 32 + 4 * fq;
#pragma unroll
    for (int bj = 0; bj < 2; ++bj)
#pragma unroll
      for (int n = 0; n < 2; ++n) {
        const pg8::f32x4 g = *(const pg8::f32x4*)(gv + col0 + bj * 128 + n * 16);
#pragma unroll
        for (int ai = 0; ai < 2; ++ai)
#pragma unroll
          for (int m = 0; m < 4; ++m) { pg8::f32x4* q = (pg8::f32x4*)(base + (size_t)(row0 + ai * 128 + m * 16) * D + col0 + bj * 128 + n * 16); *q = *q + g * acc[ai][bj][m][n]; }
      }
  }
};
struct MoeSched : pg8::GridOrder {
  const char* A; const char* Bt; int lda, ldb, K; size_t bstride;
  const int* gidx; bool gather;
  __device__ __forceinline__ const char* a_ptr(const pg8::Unit& u) const { return gather ? A : A + (size_t)u.pm * 256 * lda * 2; }
  __device__ __forceinline__ const char* b_ptr(const pg8::Unit& u) const { return Bt + (size_t)((u.pm >> 2) & 15) * bstride + (size_t)u.pn * 256 * ldb * 2; }
};
struct EpiSwiGLU {
  static constexpr bool PERM = true, AFTER_DRAIN = false;
  bf16_t* O;
  __device__ __forceinline__ void operator()(const pg8::f32x4 (&acc)[2][2][4][2], const pg8::Unit& u, int wr, int wc, int fr, int fq) const {
    const int row0 = u.pm * 256 + wr * 64 + fr, col0 = u.pn * 128 + wc * 16 + 4 * fq;
#pragma unroll
    for (int ai = 0; ai < 2; ++ai)
#pragma unroll
      for (int m = 0; m < 4; ++m) { bf16_t* rowp = O + (size_t)(row0 + ai * 128 + m * 16) * DEXP + col0;
#pragma unroll
        for (int bj = 0; bj < 2; ++bj) { const pg8::f32x4 v0 = acc[ai][bj][m][0], v1 = acc[ai][bj][m][1];
          const float h0 = silu_f(v0[0]) * v0[1], h1 = silu_f(v0[2]) * v0[3], h2 = silu_f(v1[0]) * v1[1], h3 = silu_f(v1[2]) * v1[3];
          uint2 w; w.x = pg8::cvt_pk_bf16(h0, h1); w.y = pg8::cvt_pk_bf16(h2, h3);
          *(uint2*)(rowp + bj * 64) = w; } }
  }
};
struct EpiGateBf16 {
  static constexpr bool PERM = true, AFTER_DRAIN = false;
  bf16_t* O; const float* gate;
  __device__ __forceinline__ void operator()(const pg8::f32x4 (&acc)[2][2][4][2], const pg8::Unit& u, int wr, int wc, int fr, int fq) const {
    const int row0 = u.pm * 256 + wr * 64 + fr, col0 = u.pn * 256 + wc * 32 + 8 * fq;
#pragma unroll
    for (int ai = 0; ai < 2; ++ai)
#pragma unroll
      for (int m = 0; m < 4; ++m) { const int row = row0 + ai * 128 + m * 16; const float g = gate[row]; bf16_t* rowp = O + (size_t)row * D + col0;
#pragma unroll
        for (int bj = 0; bj < 2; ++bj) { const pg8::f32x4 v0 = acc[ai][bj][m][0] * g, v1 = acc[ai][bj][m][1] * g;
          pg8::u32x4 w; w.x = pg8::cvt_pk_bf16(v0[0], v0[1]); w.y = pg8::cvt_pk_bf16(v0[2], v0[3]); w.z = pg8::cvt_pk_bf16(v1[0], v1[1]); w.w = pg8::cvt_pk_bf16(v1[2], v1[3]);
          *(pg8::u32x4*)(rowp + bj * 128) = w; } }
  }
};

namespace fa {
using bf16x8 = __attribute__((ext_vector_type(8))) short;
using s16x4  = __attribute__((ext_vector_type(4))) short;
using f32x16 = __attribute__((ext_vector_type(16))) float;
using u32x4  = __attribute__((ext_vector_type(4))) unsigned;
constexpr int NW = 8, QBLK = 32, KVBLK = 64, LDQK = 128, LDV = 64;
constexpr float SCALE = 0.10206207261596575f;
constexpr float THR = 8.f;
constexpr size_t SHM_V = KVBLK * 64 * 2, SHM_K = KVBLK * 128 * 2, SHM_ATTN = 2 * SHM_V + 2 * SHM_K + NW * 64 * 4;
#define FA_KSWZ(row, colB) ((row) * 256 + ((colB) ^ (((row) & 7) << 4)))
#define FA_SBAR() __builtin_amdgcn_sched_barrier(0)
__device__ __forceinline__ int crow(int r, int hi) { return (r & 3) + 8 * (r >> 2) + 4 * hi; }
__device__ __forceinline__ unsigned cvtpk(float lo, float hi) { unsigned r; asm volatile("v_cvt_pk_bf16_f32 %0, %1, %2" : "=v"(r) : "v"(lo), "v"(hi)); return r; }
__device__ __forceinline__ void partialSM(f32x16& p0, f32x16& p1, float& m_reg, float& mn, float& alpha) {
  constexpr float C = SCALE * 1.4426950408889634f;
  float pmax = p0[0];
#pragma unroll
  for (int r = 1; r < 16; ++r) pmax = fmaxf(pmax, p0[r]);
#pragma unroll
  for (int r = 0; r < 16; ++r) pmax = fmaxf(pmax, p1[r]);
  { auto rr = __builtin_amdgcn_permlane32_swap(__float_as_uint(pmax), __float_as_uint(pmax), false, false);
    pmax = fmaxf(__uint_as_float(rr[0]), __uint_as_float(rr[1])); }
  if (__builtin_expect(__all(pmax - m_reg <= THR / SCALE), 1)) { mn = m_reg; alpha = 1.f; }
  else { mn = fmaxf(m_reg, pmax); alpha = __builtin_amdgcn_exp2f((m_reg - mn) * C); m_reg = mn; }
  float mnC = -mn * C;
  p0 = p0 * C + mnC; p1 = p1 * C + mnC;
#pragma unroll
  for (int r = 0; r < 16; ++r) p0[r] = __builtin_amdgcn_exp2f(p0[r]);
}
__device__ __forceinline__ void finishSM(f32x16& p0, f32x16& p1, float alpha, float& l_reg, bf16x8& pa0, bf16x8& pa1, bf16x8& pa2, bf16x8& pa3) {
#pragma unroll
  for (int r = 0; r < 16; ++r) p1[r] = __builtin_amdgcn_exp2f(p1[r]);
  float ps;
  { const f32x16 t = p0 + p1; const auto t8 = t.lo + t.hi; const auto t4 = t8.lo + t8.hi; const auto t2 = t4.lo + t4.hi; ps = t2.x + t2.y; }
  { auto rr = __builtin_amdgcn_permlane32_swap(__float_as_uint(ps), __float_as_uint(ps), false, false);
    ps = __uint_as_float(rr[0]) + __uint_as_float(rr[1]); }
  l_reg = l_reg * alpha + ps;
#define FA_PK4(P, BASE, OUT) do { unsigned a0 = cvtpk(P[BASE + 0], P[BASE + 1]), a1 = cvtpk(P[BASE + 2], P[BASE + 3]);   \
    unsigned b0 = cvtpk(P[BASE + 4], P[BASE + 5]), b1 = cvtpk(P[BASE + 6], P[BASE + 7]);                              \
    auto r0 = __builtin_amdgcn_permlane32_swap(a0, b0, false, false); auto r1 = __builtin_amdgcn_permlane32_swap(a1, b1, false, false); \
    u32x4 w = {r0[0], r1[0], r0[1], r1[1]}; OUT = *reinterpret_cast<bf16x8*>(&w); } while (0)
  FA_PK4(p0, 0, pa0); FA_PK4(p0, 8, pa1); FA_PK4(p1, 0, pa2); FA_PK4(p1, 8, pa3);
#undef FA_PK4
}
__device__ __forceinline__ void qkt(f32x16& p0, f32x16& p1, const char* Ks, const bf16x8* qr, int r32, int hi) {
  p0 = f32x16{}; p1 = f32x16{};
#pragma unroll
  for (int d0 = 0; d0 < 6; ++d0) { int cb = (d0 * 16 + hi * 8) * 2;
    bf16x8 b0 = *reinterpret_cast<const bf16x8*>(Ks + FA_KSWZ(r32, cb));
    bf16x8 b1 = *reinterpret_cast<const bf16x8*>(Ks + FA_KSWZ(32 + r32, cb));
    p0 = __builtin_amdgcn_mfma_f32_32x32x16_bf16(b0, qr[d0], p0, 0, 0, 0);
    p1 = __builtin_amdgcn_mfma_f32_32x32x16_bf16(b1, qr[d0], p1, 0, 0, 0); }
}
__device__ __forceinline__ int v_st(int k, int c) { const int kk = (k & ~0xC) | ((k & 4) << 1) | ((k & 8) >> 1); return ((kk >> 3) * 2 + (c >> 5)) * 512 + ((kk & 7) * 32 + (c & 31)) * 2; }
__device__ __forceinline__ int v_rd_base(int lane) { return ((lane & 3) << 3) | (((lane >> 2) & 3) << 6) | (((lane >> 4) & 1) << 5) | (((lane >> 5) & 1) << 8); }
constexpr int v_rd_off(int d0, int ks, int half) { return d0 * 512 + ks * 2048 + half * 1024; }
template <int OFF> __device__ __forceinline__ s16x4 tr_read(int vb) {
  s16x4 r; asm volatile("ds_read_b64_tr_b16 %0, %1 offset:%2" : "=&v"(r) : "v"(vb), "i"(OFF) : "memory"); return r;
}
template <int D0> __device__ __forceinline__ void pv_one(f32x16& od, int vb, bf16x8 pa0, bf16x8 pa1, bf16x8 pa2, bf16x8 pa3) {
  const s16x4 l0 = tr_read<v_rd_off(D0, 0, 0)>(vb), h0 = tr_read<v_rd_off(D0, 0, 1)>(vb), l1 = tr_read<v_rd_off(D0, 1, 0)>(vb), h1 = tr_read<v_rd_off(D0, 1, 1)>(vb);
  const s16x4 l2 = tr_read<v_rd_off(D0, 2, 0)>(vb), h2 = tr_read<v_rd_off(D0, 2, 1)>(vb), l3 = tr_read<v_rd_off(D0, 3, 0)>(vb), h3 = tr_read<v_rd_off(D0, 3, 1)>(vb);
  asm volatile("s_waitcnt lgkmcnt(0)" ::: "memory"); FA_SBAR();
#define FA_PK(L, H) (bf16x8){L[0], L[1], L[2], L[3], H[0], H[1], H[2], H[3]}
  od = __builtin_amdgcn_mfma_f32_32x32x16_bf16(pa0, FA_PK(l0, h0), od, 0, 0, 0);
  od = __builtin_amdgcn_mfma_f32_32x32x16_bf16(pa1, FA_PK(l1, h1), od, 0, 0, 0);
  od = __builtin_amdgcn_mfma_f32_32x32x16_bf16(pa2, FA_PK(l2, h2), od, 0, 0, 0);
  od = __builtin_amdgcn_mfma_f32_32x32x16_bf16(pa3, FA_PK(l3, h3), od, 0, 0, 0);
#undef FA_PK
}
__device__ __forceinline__ void attn_body(const bf16_t* __restrict__ Qb, const bf16_t* __restrict__ Kh, const bf16_t* __restrict__ Vh, bf16_t* __restrict__ Ob, int ldo, int seq, char* lds, float* mlp = nullptr, int mlstride = 0) {
  const int tid = ltid(), wid = tid >> 6, lane = tid & 63, r32 = lane & 31, hi = lane >> 5;
  char* V_lds = lds; char* K_lds = lds + 2 * SHM_V;
  float* ws = (float*)(lds + 2 * SHM_V + 2 * SHM_K) + wid * 64; float* li_l = ws; float* al_l = ws + 32;
  float m_reg = -1e30f, l_reg = 0; f32x16 o[2] = {}; bf16x8 qr[6];
  const bf16_t* Qw = Qb + (long)(wid * QBLK + r32) * LDQK + hi * 8;
#pragma unroll
  for (int d0 = 0; d0 < 6; ++d0) qr[d0] = *reinterpret_cast<const bf16x8*>(Qw + d0 * 16);
  const int sr = tid >> 4, sc = (tid & 15) * 8;
  const int vr = tid >> 3, vc = (tid & 7) * 8, vst0 = v_st(vr, vc);
  const int vb0 = (int)(uintptr_t)V_lds + v_rd_base(lane);
  struct { bf16x8 vs0, ks0, ks1; } sr_[2];
#define FA_SLOAD(i, k0) do { sr_[i].vs0 = *reinterpret_cast<const bf16x8*>(&Vh[(long)((k0) + vr) * LDV + vc]); \
    sr_[i].ks0 = *reinterpret_cast<const bf16x8*>(&Kh[(long)((k0) + sr) * LDQK + sc]); sr_[i].ks1 = *reinterpret_cast<const bf16x8*>(&Kh[(long)((k0) + 32 + sr) * LDQK + sc]); } while (0)
#define FA_SWRITE(b, i) do { *(bf16x8*)(V_lds + (b) * SHM_V + vst0) = sr_[i].vs0; int kc = sc * 2;               \
    *(bf16x8*)(K_lds + (b) * SHM_K + FA_KSWZ(sr, kc)) = sr_[i].ks0;                       \
    *(bf16x8*)(K_lds + (b) * SHM_K + FA_KSWZ(32 + sr, kc)) = sr_[i].ks1; } while (0)
#define FA_SWAIT() asm volatile("s_waitcnt vmcnt(3)" ::: "memory")
#define FA_RESC(a) do { if (__any((a) < 1.f)) { if (hi == 0) al_l[r32] = (a); asm volatile("s_waitcnt lgkmcnt(0)" ::: "memory"); \
    _Pragma("unroll") for (int d = 0; d < 2; ++d) _Pragma("unroll") for (int r = 0; r < 16; ++r) o[d][r] *= al_l[crow(r, hi)]; } } while (0)
  f32x16 pA0, pA1, pB0, pB1; float mnA, mnB, alA, alB; bf16x8 pa0, pa1, pa2, pa3; const int NTL = seq / KVBLK;
  constexpr int SE = 0, SO = 1;
  __syncthreads();
  FA_SLOAD(SE, 0); asm volatile("s_waitcnt vmcnt(0)" ::: "memory"); FA_SWRITE(0, SE); __syncthreads();
  qkt(pA0, pA1, K_lds, qr, r32, hi); partialSM(pA0, pA1, m_reg, mnA, alA);
  FA_SLOAD(SO, KVBLK); if (2 < NTL) FA_SLOAD(SE, 2 * KVBLK);
  FA_SWAIT(); FA_SWRITE(1, SO); __syncthreads();
  for (int j = 1; j + 1 < NTL; j += 2) {
    FA_SBAR(); qkt(pB0, pB1, K_lds + SHM_K, qr, r32, hi);
    finishSM(pA0, pA1, alA, l_reg, pa0, pa1, pa2, pa3); FA_SBAR();
    FA_SLOAD(SO, (j + 2) * KVBLK); FA_SBAR();
    pv_one<0>(o[0], vb0, pa0, pa1, pa2, pa3); pv_one<1>(o[1], vb0, pa0, pa1, pa2, pa3); partialSM(pB0, pB1, m_reg, mnB, alB);
    __syncthreads(); FA_SWAIT(); FA_SWRITE(0, SE);
    FA_RESC(alB); __syncthreads();
    FA_SBAR(); qkt(pA0, pA1, K_lds, qr, r32, hi);
    finishSM(pB0, pB1, alB, l_reg, pa0, pa1, pa2, pa3); FA_SBAR();
    if (j + 3 < NTL) FA_SLOAD(SE, (j + 3) * KVBLK); FA_SBAR();
    pv_one<0>(o[0], vb0 + (int)SHM_V, pa0, pa1, pa2, pa3); pv_one<1>(o[1], vb0 + (int)SHM_V, pa0, pa1, pa2, pa3); partialSM(pA0, pA1, m_reg, mnA, alA);
    __syncthreads(); FA_SWAIT(); FA_SWRITE(1, SO);
    FA_RESC(alA); __syncthreads();
  }
  FA_SBAR(); qkt(pB0, pB1, K_lds + SHM_K, qr, r32, hi);
  finishSM(pA0, pA1, alA, l_reg, pa0, pa1, pa2, pa3); FA_SBAR();
  pv_one<0>(o[0], vb0, pa0, pa1, pa2, pa3); pv_one<1>(o[1], vb0, pa0, pa1, pa2, pa3); partialSM(pB0, pB1, m_reg, mnB, alB);
  __syncthreads(); FA_RESC(alB);
  finishSM(pB0, pB1, alB, l_reg, pa0, pa1, pa2, pa3); FA_SBAR();
  pv_one<0>(o[0], vb0 + (int)SHM_V, pa0, pa1, pa2, pa3); pv_one<1>(o[1], vb0 + (int)SHM_V, pa0, pa1, pa2, pa3);
  if (hi == 0) { li_l[r32] = l_reg; if (mlp) { float* q2 = mlp + (size_t)(wid * QBLK + r32) * mlstride; q2[0] = m_reg; q2[1] = l_reg; } }
  asm volatile("s_waitcnt lgkmcnt(0)" ::: "memory");
  float rli[16];
#pragma unroll
  for (int r = 0; r < 16; ++r) rli[r] = __builtin_amdgcn_rcpf(li_l[crow(r, hi)]);
  bf16_t* Ow = Ob + (long)(wid * QBLK) * ldo;
#pragma unroll
  for (int r = 0; r < 16; ++r) { int orow = crow(r, hi);
#pragma unroll
    for (int d0 = 0; d0 < 2; ++d0) Ow[(long)orow * ldo + d0 * 32 + r32] = f2bf(o[d0][r] * rli[r]); }
#undef FA_SLOAD
#undef FA_SWRITE
#undef FA_SWAIT
#undef FA_RESC
}
}

namespace gd {
using bf16x8 = __attribute__((ext_vector_type(8))) short;
using f32x4 = __attribute__((ext_vector_type(4))) float;
constexpr int NCH = 132;
constexpr size_t R_QF = 0, R_KF = 16384, R_KTF = 32768, R_VC = 49152, R_DIR = 65536, DIR_BYTES = 17408, D_TINV = 0, D_QKM = 8192, D_VEC = 16384;
constexpr size_t CHREC = R_DIR + 2 * DIR_BYTES;
__device__ __forceinline__ unsigned pk(float lo, float hi) { unsigned r; asm volatile("v_cvt_pk_bf16_f32 %0, %1, %2" : "=v"(r) : "v"(lo), "v"(hi)); return r; }
__device__ __forceinline__ bf16x8 pack8(const f32x4 a, const f32x4 b) { typedef unsigned u4 __attribute__((ext_vector_type(4))); u4 w = {pk(a[0], a[1]), pk(a[2], a[3]), pk(b[0], b[1]), pk(b[2], b[3])}; return *reinterpret_cast<bf16x8*>(&w); }
__device__ __forceinline__ int chunk_row0(int b, int c) { return c < 4 ? ML + b * TC + 64 * c : b * T + 64 * (c - 4); }
constexpr int L_Q = 0, L_K = 16384, L_V = 32768, L_KK = 49152  , L_QK = 65792, L_G = 82432  ,
              L_A = 0  , L_X0 = 32768  , L_X1 = 83968, L_AT = 100352;
__device__ __forceinline__ int swz(int row, int colB) { return row * 256 + (colB ^ ((row & 7) << 4)); }
__device__ __forceinline__ void tr_pair(int a0, int a1, uint2& lo, uint2& hi) {
  asm volatile("ds_read_b64_tr_b16 %0, %2\n\tds_read_b64_tr_b16 %1, %3\n\ts_waitcnt lgkmcnt(0)" : "=&v"(lo), "=&v"(hi) : "v"(a0), "v"(a1) : "memory");
}
__device__ __forceinline__ uint2 tr_one(int a0) {
  uint2 r; asm volatile("ds_read_b64_tr_b16 %0, %1\n\ts_waitcnt lgkmcnt(0)" : "=&v"(r) : "v"(a0) : "memory"); return r;
}

__device__ __forceinline__ void inv_offdiag(const float* A, float* X, int bi, int bj, int lane) {
  const int rc = lane & 15, g = lane >> 4;
  f32x4 t = {0.f, 0.f, 0.f, 0.f};
  for (int k = bj; k < bi; ++k) {
#pragma unroll
    for (int s4 = 0; s4 < 4; ++s4)
      t = __builtin_amdgcn_mfma_f32_16x16x4f32(A[(bi * 16 + rc) * 64 + k * 16 + s4 * 4 + g], X[(k * 16 + s4 * 4 + g) * 64 + bj * 16 + rc], t, 0, 0, 0);
  }
  f32x4 o = {0.f, 0.f, 0.f, 0.f};
#pragma unroll
  for (int r = 0; r < 4; ++r)
    o = __builtin_amdgcn_mfma_f32_16x16x4f32(X[(bi * 16 + rc) * 64 + bi * 16 + g * 4 + r], t[r], o, 0, 0, 0);
#pragma unroll
  for (int r = 0; r < 4; ++r) X[(bi * 16 + g * 4 + r) * 64 + bj * 16 + rc] = -o[r];
}
__device__ __forceinline__ void lds_barrier() { asm volatile("s_waitcnt lgkmcnt(0)" ::: "memory"); __builtin_amdgcn_s_barrier(); asm volatile("" ::: "memory"); }
constexpr int L_CW = 133120;
__device__ __forceinline__ void precompute_load(const Params& p, int b, int h, int c, int tid, uint4 (&xin)[3][4]) {
  const bf16_t* P = (const bf16_t*)(p.ws + OFF_P);
  const int row0 = chunk_row0(b, c), tlen = c < 4 ? TC : T, t0 = c < 4 ? 64 * c : 64 * (c - 4);
  const int ch8 = tid & 15, tokA = 2 * (tid >> 4);
#pragma unroll
  for (int which = 0; which < 3; ++which) {
    const int ch0 = which * 512 + h * 128 + ch8 * 8;
#pragma unroll
    for (int jj = 0; jj < 4; ++jj) { const int tt = t0 + tokA - 1 + jj;
      xin[which][jj] = (tt >= 0 && tt < tlen) ? *(const uint4*)(P + (size_t)(row0 + tokA - 1 + jj) * NINP + PC_GQ + ch0) : make_uint4(0u, 0u, 0u, 0u); }
  }
}
__device__ __forceinline__ void precompute_item(const Params& p, int l, int b, int h, int c, char* lds, int tid, const uint4 (&xin)[3][4]) {
  const int lane = tid & 63, wv = tid >> 6;
  const bf16_t* P = (const bf16_t*)(p.ws + OFF_P);
  char* rec = p.ws + OFF_RB + (size_t)((b * 4 + h) * NCH + c) * CHREC;
  const int row0 = chunk_row0(b, c);
  const int ldsb = (int)(uintptr_t)lds;
  lds_barrier();
  {
    const int ch8 = tid & 15, tg = tid >> 4, tokA = 2 * tg;
    const float* cwl = (const float*)(lds + L_CW);
#pragma unroll
    for (int which = 0; which < 3; ++which) {
      float xf[4][8];
#pragma unroll
      for (int jj = 0; jj < 4; ++jj) { const unsigned w4[4] = {xin[which][jj].x, xin[which][jj].y, xin[which][jj].z, xin[which][jj].w};
#pragma unroll
        for (int i = 0; i < 4; ++i) { xf[jj][2 * i] = __uint_as_float(w4[i] << 16); xf[jj][2 * i + 1] = __uint_as_float(w4[i] & 0xffff0000u); } }
      float wf[3][8];
#pragma unroll
      for (int j = 0; j < 3; ++j) { const float4 w0 = *(const float4*)(cwl + j * 1536 + which * 512 + h * 128 + ch8 * 8), w1 = *(const float4*)(cwl + j * 1536 + which * 512 + h * 128 + ch8 * 8 + 4);
        wf[j][0] = w0.x; wf[j][1] = w0.y; wf[j][2] = w0.z; wf[j][3] = w0.w; wf[j][4] = w1.x; wf[j][5] = w1.y; wf[j][6] = w1.z; wf[j][7] = w1.w; }
#pragma unroll
      for (int a = 0; a < 2; ++a) {
        float o[8], ss = 0.f;
#pragma unroll
        for (int i = 0; i < 8; ++i) { o[i] = silu_f(wf[0][i] * xf[a][i] + wf[1][i] * xf[a + 1][i] + wf[2][i] * xf[a + 2][i]); ss += o[i] * o[i]; }
        if (which < 2) {
          ss += __shfl_xor(ss, 1); ss += __shfl_xor(ss, 2); ss += __shfl_xor(ss, 4); ss += __shfl_xor(ss, 8);
          const float sc = rsqrtf(ss + EPS) * (which == 0 ? 0.08838834764831845f : 1.f);
#pragma unroll
          for (int i = 0; i < 8; ++i) o[i] *= sc;
        }
        uint4 w; w.x = pk(o[0], o[1]); w.y = pk(o[2], o[3]); w.z = pk(o[4], o[5]); w.w = pk(o[6], o[7]);
        *(uint4*)(lds + (which == 0 ? L_Q : (which == 1 ? L_K : L_V)) + swz(tokA + a, ch8 * 16)) = w;
      }
    }
    if (tid < 128) {
      const int d = tid >> 6, tk = tid & 63;
      const float pa = bf2f(P[(size_t)(row0 + tk) * NINP + PC_A + d * 4 + h]), pb = bf2f(P[(size_t)(row0 + tk) * NINP + PC_B + d * 4 + h]);
      float* gs = (float*)(lds + L_G);
      gs[d * 64 + tk] = -expf(p.a_log[l * 8 + d * 4 + h]) * softplus_f(pa + p.dt_bias[l * 8 + d * 4 + h]);
      gs[128 + d * 64 + tk] = sigmoid_f(pb);
    }
  }
  lds_barrier();
  if (wv == 0) {
    float* gs = (float*)(lds + L_G);
    float a0 = gs[lane], a1 = gs[64 + 63 - lane];
#pragma unroll
    for (int o = 1; o < 64; o <<= 1) { const float n0 = __shfl_up(a0, o), n1 = __shfl_up(a1, o); if (lane >= o) { a0 += n0; a1 += n1; } }
    gs[256 + lane] = a0; gs[256 + 64 + 63 - lane] = a1;
  }
  {
    const int cc = lane & 15, g = lane >> 4;
#pragma unroll
    for (int tt = 0; tt < 2; ++tt) {
      const int tile = wv * 2 + tt, mi = tile >> 2, nj = tile & 3;
      f32x4 akk = {0.f, 0.f, 0.f, 0.f}, aqk = {0.f, 0.f, 0.f, 0.f};
#pragma unroll
      for (int s4 = 0; s4 < 4; ++s4) {
        const bf16x8 ak = *(const bf16x8*)(lds + L_K + swz(mi * 16 + cc, s4 * 64 + g * 16));
        const bf16x8 aq = *(const bf16x8*)(lds + L_Q + swz(mi * 16 + cc, s4 * 64 + g * 16));
        const bf16x8 bk = *(const bf16x8*)(lds + L_K + swz(nj * 16 + cc, s4 * 64 + g * 16));
        akk = __builtin_amdgcn_mfma_f32_16x16x32_bf16(ak, bk, akk, 0, 0, 0);
        aqk = __builtin_amdgcn_mfma_f32_16x16x32_bf16(aq, bk, aqk, 0, 0, 0);
      }
      float* KK = (float*)(lds + L_KK); float* QK = (float*)(lds + L_QK);
#pragma unroll
      for (int r = 0; r < 4; ++r) { KK[(mi * 16 + g * 4 + r) * 65 + nj * 16 + cc] = akk[r]; QK[(mi * 16 + g * 4 + r) * 65 + nj * 16 + cc] = aqk[r]; }
    }
#pragma unroll
    for (int it = 0; it < 2; ++it) {
      const int item = tid + it * NT, fl = item & 63, frag = item >> 6, mt = frag >> 3, kbj = frag & 7, r = fl & 31, hl = fl >> 5;
      const int row = mt * 32 + r, cb = (kbj * 16 + hl * 4) * 2;
      uint4 wq, wk;
      { const uint2 lo = *(const uint2*)(lds + L_Q + swz(row, cb)), hi = *(const uint2*)(lds + L_Q + swz(row, cb + 16)); wq = make_uint4(lo.x, lo.y, hi.x, hi.y); }
      { const uint2 lo = *(const uint2*)(lds + L_K + swz(row, cb)), hi = *(const uint2*)(lds + L_K + swz(row, cb + 16)); wk = make_uint4(lo.x, lo.y, hi.x, hi.y); }
      *(uint4*)(rec + R_QF + (size_t)item * 16) = wq; *(uint4*)(rec + R_KF + (size_t)item * 16) = wk;
    }
#pragma unroll
    for (int it = 0; it < 2; ++it) {
      const int item = tid + it * NT, fl = item & 63, frag = item >> 6, mt = frag >> 2, kbj = frag & 3, i16 = fl & 15, gq = fl >> 4;
      const int tok0 = kbj * 16 + (gq >> 1) * 4 + (i16 >> 2), cb = (mt * 32 + (gq & 1) * 16 + (i16 & 3) * 4) * 2;
      uint2 lo, hi; tr_pair(ldsb + L_K + swz(tok0, cb), ldsb + L_K + swz(tok0 + 8, cb), lo, hi);
      *(uint4*)(rec + R_KTF + (size_t)item * 16) = make_uint4(lo.x, lo.y, hi.x, hi.y);
    }
#pragma unroll
    for (int it = 0; it < 4; ++it) {
      const int item = tid + it * NT, fl = item & 63, q = (item >> 6) & 3, mt = (item >> 8) & 1, sl = item >> 9, i16 = fl & 15, gq = fl >> 4;
      const int tok0 = mt * 32 + q * 8 + (gq >> 1) * 4 + (i16 >> 2), cb = (sl * 32 + (gq & 1) * 16 + (i16 & 3) * 4) * 2;
      const uint2 v = tr_one(ldsb + L_V + swz(tok0, cb));
      *(uint2*)(rec + R_VC + (size_t)item * 8) = v;
    }
  }
  lds_barrier();
  {
    const float* gs = (const float*)(lds + L_G); const float* KK = (const float*)(lds + L_KK);
    float* A = (float*)(lds + L_A);
#pragma unroll 4
    for (int it = 0; it < 16; ++it) {
      const int e = tid + it * NT, d = e >> 12, ip = (e >> 6) & 63, jp = e & 63, ti = d ? 63 - ip : ip, tj = d ? 63 - jp : jp;
      A[e] = ip > jp ? gs[128 + d * 64 + ti] * KK[ti * 65 + tj] * __expf(gs[256 + d * 64 + ti] - gs[256 + d * 64 + tj]) : 0.f;
    }
  }
  lds_barrier();
  if (wv < 2) {
    const float* A = (const float*)(lds + L_A) + wv * 4096; float* X = (float*)(lds + (wv ? L_X1 : L_X0));
    const int qb = lane >> 4, c16 = lane & 15;
    float x[16];
    f32x4 an[4];
#pragma unroll
    for (int q4 = 0; q4 < 4; ++q4) an[q4] = *(const f32x4*)(A + (qb * 16) * 64 + qb * 16 + q4 * 4);
#pragma unroll
    for (int r = 0; r < 16; ++r) {
      f32x4 ac[4];
#pragma unroll
      for (int q4 = 0; q4 < 4; ++q4) ac[q4] = an[q4];
      if (r < 15) {
#pragma unroll
        for (int q4 = 0; q4 < 4; ++q4) an[q4] = *(const f32x4*)(A + (qb * 16 + r + 1) * 64 + qb * 16 + q4 * 4); }
      asm volatile("" ::: "memory");
      float sacc = (r == c16) ? 1.f : 0.f;
#pragma unroll
      for (int q = 0; q < 16; ++q) if (q < r) sacc -= ac[q >> 2][q & 3] * x[q];
      x[r] = sacc;
      X[(qb * 16 + r) * 64 + qb * 16 + c16] = sacc;
    }
  } else {
    const float* gs = (const float*)(lds + L_G); const float* QK = (const float*)(lds + L_QK);
    const int t2 = tid - 128;
    for (int e = t2; e < 2 * 6 * 256; e += 384) {
      const int d = e / 1536, r6 = (e % 1536) >> 8, w = e & 255; const int bi = r6 < 3 ? 0 : (r6 < 5 ? 1 : 2), bj = r6 < 3 ? r6 + 1 : (r6 < 5 ? r6 - 1 : 3);
      ((float*)(lds + (d ? L_X1 : L_X0)))[(bi * 16 + (w >> 4)) * 64 + bj * 16 + (w & 15)] = 0.f; }
    for (int item = t2; item < 1024; item += 384) {
      const int d = item >> 9, fl = item & 63, frag = (item >> 6) & 7, mt = frag >> 2, kbj = frag & 3, r = fl & 31, hl = fl >> 5;
      const int i = mt * 32 + r; const float gci = gs[256 + d * 64 + i];
      float v[8];
#pragma unroll
      for (int j = 0; j < 8; ++j) { const int jj = kbj * 16 + 8 * (j >> 2) + 4 * hl + (j & 3); const bool ok = d ? (i <= jj) : (i >= jj);
        v[j] = ok ? QK[i * 65 + jj] * __expf(gci - gs[256 + d * 64 + jj]) : 0.f; }
      *(uint4*)(rec + R_DIR + d * DIR_BYTES + D_QKM + (size_t)(item & 511) * 16) = make_uint4(pk(v[0], v[1]), pk(v[2], v[3]), pk(v[4], v[5]), pk(v[6], v[7]));
    }
    if (t2 < 128) {
      const int d = t2 >> 6, tk = t2 & 63; float* vec = (float*)(rec + R_DIR + d * DIR_BYTES + D_VEC);
      const float gc = gs[256 + d * 64 + tk], gl = gs[256 + d * 64 + (d ? 0 : 63)];
      vec[tk] = gs[128 + d * 64 + tk]; vec[64 + tk] = __expf(gc); vec[128 + tk] = __expf(gl - gc);
      if (tk == 0) vec[192] = __expf(gl);
    }
  }
  lds_barrier();
  if (wv < 6) inv_offdiag((const float*)(lds + L_A) + (wv & 1) * 4096, (float*)(lds + ((wv & 1) ? L_X1 : L_X0)), (wv >> 1) + 1, wv >> 1, lane);
  lds_barrier();
  if (wv < 4) inv_offdiag((const float*)(lds + L_A) + (wv & 1) * 4096, (float*)(lds + ((wv & 1) ? L_X1 : L_X0)), (wv >> 1) + 2, wv >> 1, lane);
  lds_barrier();
  if (wv < 2) inv_offdiag((const float*)(lds + L_A) + wv * 4096, (float*)(lds + (wv ? L_X1 : L_X0)), 3, 0, lane);
  lds_barrier();
  {
#pragma unroll
    for (int it = 0; it < 2; ++it) {
      const int item = tid + it * NT, d = item >> 9, fl = item & 63, frag = (item >> 6) & 7, mt = frag >> 2, kbj = frag & 3, r = fl & 31, hl = fl >> 5;
      const int i = mt * 32 + r, ri = d ? 63 - i : i; const float* X = (const float*)(lds + (d ? L_X1 : L_X0)) + ri * 64; const float* bet = (const float*)(lds + L_G) + 128 + d * 64;
      float v[8];
#pragma unroll
      for (int j = 0; j < 8; ++j) { const int jj = kbj * 16 + 8 * (j >> 2) + 4 * hl + (j & 3); v[j] = X[d ? 63 - jj : jj] * bet[jj]; }
      *(uint4*)(rec + R_DIR + d * DIR_BYTES + D_TINV + (size_t)(item & 511) * 16) = make_uint4(pk(v[0], v[1]), pk(v[2], v[3]), pk(v[4], v[5]), pk(v[6], v[7]));
    }
  }
}

constexpr int SBUF_ = 74752;
template <int LW>
__device__ __forceinline__ void scan_loader(const char* recs, int dir, int half, char* smem, int lane) {
  typedef unsigned v4u __attribute__((ext_vector_type(4))); typedef __attribute__((address_space(1))) const v4u g_u4; typedef __attribute__((address_space(3))) v4u l_u4;
#define GD_CHUNK(step) (dir == 0 ? (step) : ((step) < 4 ? 3 - (step) : NCH + 3 - (step)))
#define GD_SOFF(i_) ((i_) < 48 ? (size_t)(i_) * 1024 : ((i_) < 56 ? R_VC + (size_t)half * 8192 + ((i_) - 48) * 1024 : R_DIR + (size_t)dir * DIR_BYTES + ((i_) - 56) * 1024))
#define GD_LOAD(R, step) do { const char* _b = recs + (size_t)GD_CHUNK(step) * CHREC + lane * 16; \
    _Pragma("unroll") for (int _j = 0; _j < 19; ++_j) { const int _i = LW + 4 * _j; if (_i < 73) R[_j] = *(g_u4*)(_b + GD_SOFF(_i)); } } while (0)
#define GD_WRITE(R, buf) do { char* _d = smem + (buf) * SBUF_ + lane * 16; \
    _Pragma("unroll") for (int _j = 0; _j < 19; ++_j) { const int _i = LW + 4 * _j; if (_i < 73) *(l_u4*)(_d + _i * 1024) = R[_j]; } } while (0)
  v4u RA[19], RB[19];
  GD_LOAD(RA, 0); GD_LOAD(RB, 1); GD_WRITE(RA, 0); GD_LOAD(RA, 2);
  lds_barrier();
  for (int step = 0; step < NCH; step += 2) {
    if (step + 1 < NCH) GD_WRITE(RB, 1);
    if (step + 3 < NCH) GD_LOAD(RB, step + 3);
    lds_barrier();
    if (step + 2 < NCH) GD_WRITE(RA, 0);
    if (step + 4 < NCH) GD_LOAD(RA, step + 4);
    lds_barrier();
  }
#undef GD_CHUNK
#undef GD_SOFF
#undef GD_LOAD
#undef GD_WRITE
}
constexpr int SB_QF = 0, SB_KF = 16384, SB_KTF = 32768, SB_VC = 49152, SB_TINV = 57344, SB_QKM = 65536, SB_VEC = 73728, SBUF = 74752;
using f32x16 = __attribute__((ext_vector_type(16))) float;
__device__ __forceinline__ unsigned pkb(float lo, float hi) {
  typedef __bf16 bf2 __attribute__((ext_vector_type(2))); typedef float f2 __attribute__((ext_vector_type(2)));
  bf2 r = __builtin_convertvector((f2){lo, hi}, bf2); return *reinterpret_cast<unsigned*>(&r);
}
template <int J> __device__ __forceinline__ bf16x8 pack16(const f32x16& v) {
  typedef unsigned u4 __attribute__((ext_vector_type(4)));
  u4 w = {pk(v[8 * J], v[8 * J + 1]), pk(v[8 * J + 2], v[8 * J + 3]), pk(v[8 * J + 4], v[8 * J + 5]), pk(v[8 * J + 6], v[8 * J + 7])};
  return *reinterpret_cast<bf16x8*>(&w);
}
typedef __attribute__((address_space(1))) char gchar; typedef __attribute__((address_space(1))) bf16_t gbf16;
#define GD_STO(o, I, MT) do { const unsigned _w = pk(o[I], o[(I) + 1]); gchar* _rb = Pst + (size_t)((MT) * 32 + 8 * ((I) >> 2) + ((I) & 3)) * (NINP * 2); asm volatile("" : "+s"(_rb)); \
    *(gbf16*)(_rb + voff) = (bf16_t)_w; *(gbf16*)(_rb + voff1) = (bf16_t)(_w >> 16); } while (0)
__device__ __forceinline__ void scan_unit_lds(const Params& p, int unit_, char* smem, int tid) {
  const int wv = __builtin_amdgcn_readfirstlane(tid >> 6), lane = tid & 63, unit = __builtin_amdgcn_readfirstlane(unit_);
  const int chain = unit >> 1, half = unit & 1, dir = chain & 1, h = (chain >> 1) & 3, b = chain >> 3;
  const char* recs = p.ws + OFF_RB + (size_t)((b * 4 + h) * NCH) * CHREC;
#define GD_CHUNK(step) (dir == 0 ? (step) : ((step) < 4 ? 3 - (step) : NCH + 3 - (step)))
  if (wv >= 4) {
    if (wv == 4) scan_loader<0>(recs, dir, half, smem, lane); else if (wv == 5) scan_loader<1>(recs, dir, half, smem, lane);
    else if (wv == 6) scan_loader<2>(recs, dir, half, smem, lane); else scan_loader<3>(recs, dir, half, smem, lane);
    return;
  }
  if (wv >= 2) {
    for (int i = 0; i <= NCH; ++i) lds_barrier();
    return;
  }
  lds_barrier();
  const int c32 = lane & 31, hl = lane >> 5;
  const unsigned voff_ = (unsigned)(c32 * 2 + hl * 4 * NINP * 2);
  gchar* Pc = (gchar*)(p.ws + OFF_P + (size_t)((dir ? PC_OB : PC_OF) + h * 128 + (half * 2 + wv) * 32) * 2);
  gchar* Pprev = (gchar*)(p.ws + OFF_P + (size_t)(PC_GV + h * 128 + (half * 2 + wv) * 32) * 2 + (size_t)chunk_row0(b, GD_CHUNK(0)) * (NINP * 2));
  f32x16 S[4], ks0, ks1, oq0, oq1, vn0, vn1;
  bf16x8 f0[8], f1[8], Sb[8], Rb[4], Vb[4], VFb[4];
  typedef unsigned u4 __attribute__((ext_vector_type(4)));
#pragma unroll
  for (int t = 0; t < 4; ++t)
#pragma unroll
    for (int i = 0; i < 16; ++i) S[t][i] = 0.f;
#pragma unroll
  for (int i = 0; i < 16; ++i) { oq0[i] = 0.f; oq1[i] = 0.f; }
#pragma unroll
  for (int k = 0; k < 8; ++k) { Sb[k] = (bf16x8){0, 0, 0, 0, 0, 0, 0, 0}; f0[k] = ((const bf16x8*)(smem + SB_KF))[k * 64 + lane]; }
#define GD_SB() __builtin_amdgcn_sched_barrier(0)
#define GD_MF(a, b, c) c = __builtin_amdgcn_mfma_f32_32x32x16_bf16(a, b, c, 0, 0, 0)
#define GD_ZERO(a) do { _Pragma("unroll") for (int _i = 0; _i < 16; ++_i) a[_i] = 0.f; } while (0)
#define GD_LO(w) __uint_as_float((w) << 16)
#define GD_HI(w) __uint_as_float((w) & 0xffff0000u)
#define GD_RLOAD(vA, vB, eA, eB, MT, HQ) do { vA = VC[((MT) * 4 + 2 * (HQ)) * 64 + lane]; vB = VC[((MT) * 4 + 2 * (HQ) + 1) * 64 + lane]; \
    eA = *(const f32x4*)(vec + 64 + (MT) * 32 + (HQ) * 16); eB = *(const f32x4*)(vec + 64 + (MT) * 32 + (HQ) * 16 + 8); } while (0)
#define GD_RC2(ks, v, e, I0, wa, wb) do { wa = pk(GD_LO(v.x) - e[0] * ks[(I0)], GD_HI(v.x) - e[1] * ks[(I0) + 1]); wb = pk(GD_LO(v.y) - e[2] * ks[(I0) + 2], GD_HI(v.y) - e[3] * ks[(I0) + 3]); } while (0)
#define GD_VF2(vn, e, I0, wa, wb) do { wa = pk(vn[(I0)] * e[0], vn[(I0) + 1] * e[1]); wb = pk(vn[(I0) + 2] * e[2], vn[(I0) + 3] * e[3]); } while (0)
#define GD_W4(dst) do { const u4 _w = {w0, w1, w2, w3}; dst = *reinterpret_cast<const bf16x8*>(&_w); } while (0)
#define GD_FLOAD(eA, eB, MT, HQ) do { eA = *(const f32x4*)(vec + 128 + (MT) * 32 + (HQ) * 16); eB = *(const f32x4*)(vec + 128 + (MT) * 32 + (HQ) * 16 + 8); } while (0)
#define GD_ELOAD(eA, eB, MT, HQ) do { eA = *(const f32x4*)(vec + 64 + (MT) * 32 + (HQ) * 16); eB = *(const f32x4*)(vec + 64 + (MT) * 32 + (HQ) * 16 + 8); } while (0)
#define GD_OINIT(oq, eA, eB, HQ) do { _Pragma("unroll") for (int _r = 0; _r < 4; ++_r) { oq[8 * (HQ) + _r] *= eA[_r]; oq[8 * (HQ) + 4 + _r] *= eB[_r]; } } while (0)
#define GD_SCALE(St, I0) do { float _e = egl; asm volatile("" : "+v"(_e)); _Pragma("unroll") for (int _r = 0; _r < 4; ++_r) St[(I0) + _r] *= _e; } while (0)
  uint2 vXA, vXB, vYA, vYB; f32x4 eXA, eXB, eYA, eYB, gXA, gXB, gYA, gYB; float egl; unsigned w0, w1, w2, w3;
  for (int step = 0; step < NCH; ++step) {
    const char* buf = smem + (step & 1) * SBUF; const char* nbuf = smem + ((step + 1) & 1) * SBUF;
    const bf16x8* QF = (const bf16x8*)(buf + SB_QF); const bf16x8* KF = (const bf16x8*)(buf + SB_KF); const bf16x8* KTF = (const bf16x8*)(buf + SB_KTF);
    const bf16x8* KFn = (const bf16x8*)(nbuf + SB_KF);
    const uint2* VC = (const uint2*)(buf + SB_VC + wv * 4096);
    const bf16x8* TF = (const bf16x8*)(buf + SB_TINV); const bf16x8* QKF = (const bf16x8*)(buf + SB_QKM); const float* vec = (const float*)(buf + SB_VEC) + 4 * hl;
    gchar* Pst = Pprev;
    unsigned voff = voff_; asm volatile("" : "+v"(voff)); unsigned voff1 = voff_ + NINP * 2; asm volatile("" : "+v"(voff1));
    GD_ZERO(ks0);
    GD_SB();
#pragma unroll
    for (int k = 0; k < 8; ++k) {
      GD_MF(f0[k], Sb[k], ks0);
      f1[k] = KF[(8 + k) * 64 + lane];
      if (k < 4) { GD_STO(oq0, 4 * k, 0); GD_STO(oq0, 4 * k + 2, 0); } else { GD_STO(oq1, 4 * (k - 4), 1); GD_STO(oq1, 4 * (k - 4) + 2, 1); }
      if (k == 6) GD_RLOAD(vXA, vXB, eXA, eXB, 0, 0);
      if (k == 7) { GD_RLOAD(vYA, vYB, eYA, eYB, 0, 1); GD_ZERO(ks1); }
      GD_SB();
    }
#pragma unroll
    for (int k = 0; k < 8; ++k) {
      GD_MF(f1[k], Sb[k], ks1);
      f0[k] = QF[k * 64 + lane];
      if (k == 1) GD_RC2(ks0, vXA, eXA, 0, w0, w1);
      if (k == 2) { GD_RC2(ks0, vXB, eXB, 4, w2, w3); GD_W4(Rb[0]); }
      if (k == 3) GD_RC2(ks0, vYA, eYA, 8, w0, w1);
      if (k == 4) { GD_RC2(ks0, vYB, eYB, 12, w2, w3); GD_W4(Rb[1]); }
      if (k == 5) GD_RLOAD(vXA, vXB, eXA, eXB, 1, 0);
      if (k == 6) GD_RLOAD(vYA, vYB, eYA, eYB, 1, 1);
      if (k == 7) { GD_ZERO(oq0); }
      GD_SB();
    }
#pragma unroll
    for (int k = 0; k < 8; ++k) {
      GD_MF(f0[k], Sb[k], oq0);
      f1[k] = QF[(8 + k) * 64 + lane];
      if (k == 1) GD_RC2(ks1, vXA, eXA, 0, w0, w1);
      if (k == 2) { GD_RC2(ks1, vXB, eXB, 4, w2, w3); GD_W4(Rb[2]); }
      if (k == 3) GD_RC2(ks1, vYA, eYA, 8, w0, w1);
      if (k == 4) { GD_RC2(ks1, vYB, eYB, 12, w2, w3); GD_W4(Rb[3]); }
      if (k == 6) egl = vec[192 - 4 * hl];
      if (k == 7) { GD_ZERO(oq1); }
      GD_SB();
    }
#pragma unroll
    for (int k = 0; k < 8; ++k) {
      GD_MF(f1[k], Sb[k], oq1);
      f0[k] = TF[k * 64 + lane];
      GD_SCALE(S[k >> 2], 4 * (k & 3)); GD_SCALE(S[2 + (k >> 2)], 4 * (k & 3));
      if (k == 6) { GD_FLOAD(gXA, gXB, 0, 0); GD_FLOAD(gYA, gYB, 0, 1); }
      if (k == 7) { GD_ZERO(vn0); GD_ZERO(vn1); }
      GD_SB();
    }
#pragma unroll
    for (int k = 0; k < 8; ++k) {
      if (k < 4) GD_MF(f0[k], Rb[k], vn0); else GD_MF(f0[k], Rb[k - 4], vn1);
      f1[k] = KTF[k * 64 + lane];
      if (k == 5) GD_VF2(vn0, gXA, 0, w0, w1);
      if (k == 6) { GD_VF2(vn0, gXB, 4, w2, w3); GD_W4(VFb[0]); }
      if (k == 7) { GD_VF2(vn0, gYA, 8, w0, w1); GD_FLOAD(gXA, gXB, 1, 0); }
      GD_SB();
    }
#pragma unroll
    for (int k = 0; k < 8; ++k) {
      if (k == 0) GD_MF(f1[0], VFb[0], S[0]); if (k == 1) GD_MF(f1[4], VFb[0], S[1]); if (k == 2) GD_MF(f1[1], VFb[1], S[0]); if (k == 3) GD_MF(f1[5], VFb[1], S[1]);
      if (k == 4) GD_MF(f1[2], VFb[2], S[0]); if (k == 5) GD_MF(f1[6], VFb[2], S[1]); if (k == 6) GD_MF(f1[3], VFb[3], S[0]); if (k == 7) GD_MF(f1[7], VFb[3], S[1]);
      f0[k] = KTF[(8 + k) * 64 + lane];
      if (k == 0) { GD_VF2(vn0, gYB, 12, w2, w3); GD_W4(VFb[1]); }
      if (k == 1) { GD_VF2(vn1, gXA, 0, w0, w1); GD_FLOAD(gYA, gYB, 1, 1); }
      if (k == 2) { GD_VF2(vn1, gXB, 4, w2, w3); GD_W4(VFb[2]); }
      if (k == 3) GD_VF2(vn1, gYA, 8, w0, w1);
      if (k == 4) { GD_VF2(vn1, gYB, 12, w2, w3); GD_W4(VFb[3]); }
      if (k == 5) Vb[0] = pack16<0>(vn0);
      if (k == 6) { Vb[1] = pack16<1>(vn0); GD_ELOAD(eXA, eXB, 0, 0); }
      if (k == 7) { Vb[2] = pack16<0>(vn1); GD_ELOAD(eYA, eYB, 0, 1); }
      GD_SB();
    }
#pragma unroll
    for (int k = 0; k < 8; ++k) {
      if (k < 4) GD_MF(f0[k], VFb[k], S[2]); else GD_MF(f0[k], VFb[k - 4], S[3]);
      if (k < 4) { f1[2 * k] = QKF[(2 * k) * 64 + lane]; f1[2 * k + 1] = QKF[(2 * k + 1) * 64 + lane]; }
      if (k == 0) GD_OINIT(oq0, eXA, eXB, 0);
      if (k == 1) { GD_OINIT(oq0, eYA, eYB, 1); GD_ELOAD(eXA, eXB, 1, 0); }
      if (k == 2) { GD_ELOAD(eYA, eYB, 1, 1); Vb[3] = pack16<1>(vn1); Sb[0] = pack16<0>(S[0]); }
      if (k == 3) GD_OINIT(oq1, eXA, eXB, 0);
      if (k == 4) GD_OINIT(oq1, eYA, eYB, 1);
      if (k == 5) Sb[1] = pack16<1>(S[0]);
      if (k == 6) Sb[2] = pack16<0>(S[1]);
      if (k == 7) Sb[3] = pack16<1>(S[1]);
      GD_SB();
    }
    Pprev = Pc + (size_t)chunk_row0(b, GD_CHUNK(step)) * (NINP * 2);
    lds_barrier();
    GD_SB();
#pragma unroll
    for (int k = 0; k < 8; ++k) {
      if (k < 4) GD_MF(f1[k], Vb[k], oq0); else GD_MF(f1[k], Vb[k - 4], oq1);
      f0[k] = KFn[k * 64 + lane];
      if (k == 0) Sb[4] = pack16<0>(S[2]);
      if (k == 1) Sb[5] = pack16<1>(S[2]);
      if (k == 2) Sb[6] = pack16<0>(S[3]);
      if (k == 3) Sb[7] = pack16<1>(S[3]);
      GD_SB();
    }
  }
  {
    gchar* Pst = Pprev; const unsigned voff = voff_, voff1 = voff_ + NINP * 2;
#pragma unroll
    for (int k = 0; k < 8; ++k) { if (k < 4) { GD_STO(oq0, 4 * k, 0); GD_STO(oq0, 4 * k + 2, 0); } else { GD_STO(oq1, 4 * (k - 4), 1); GD_STO(oq1, 4 * (k - 4) + 2, 1); } }
  }
#undef GD_SB
#undef GD_MF
#undef GD_ZERO
#undef GD_LO
#undef GD_HI
#undef GD_RLOAD
#undef GD_RC2
#undef GD_VF2
#undef GD_W4
#undef GD_FLOAD
#undef GD_ELOAD
#undef GD_OINIT
#undef GD_SCALE
#undef GD_CHUNK
}
#undef GD_STO
}

__device__ __forceinline__ void ph_init_ada(const Params& p) {
  const int TIDX = ltid(); const int BIDX = lbid();
  const size_t n = (size_t)MR * D, gt = (size_t)BIDX * NT + TIDX, gs = (size_t)gridDim.x * NT;
  for (size_t i = gt; i < n; i += gs) {
    int r = (int)(i / D), cc = (int)(i % D);
    xrow(p, r)[cc] = r < ML ? p.x[i] : p.ctx[(size_t)(r - ML) * D + cc];
  }
}
__device__ __forceinline__ void ph_modulate(const Params& p, int l, int which, int nrows) {
  const int TIDX = ltid(); const int BIDX = lbid();
  const int lane = TIDX & 63, wv = TIDX >> 6;
  for (int r = BIDX * 8 + wv; r < nrows; r += gridDim.x * 8) {
    int mj, t, tlen, r0; rowinfo(r, mj, t, tlen, r0);
    const float* xr = xrow_src(p, r, l);
    const float* g = (which ? p.norm2_g : p.norm1_g) + l * D;
    const float* sh = modvec(p, l, mj, which ? 3 : 0); const float* sc = modvec(p, l, mj, which ? 4 : 1);
    float v[16], ss = 0;
#pragma unroll
    for (int i = 0; i < 16; ++i) { v[i] = xr[lane + i * 64]; ss += v[i] * v[i]; }
    ss = wave_sum(ss);
    const float rstd = rsqrtf(ss / D + EPS);
    bf16_t* h = (bf16_t*)(p.ws + OFF_H) + (size_t)r * D;
#pragma unroll
    for (int i = 0; i < 16; ++i) { int cc = lane + i * 64; v[i] = v[i] * rstd * g[cc] * (1.f + sc[cc]) + sh[cc]; h[cc] = f2bf(v[i]); }
    if (which) {
      const float* wr = p.router + (size_t)l * D * NE;
      float lo[16];
#pragma unroll
      for (int e = 0; e < 16; ++e) lo[e] = 0.f;
#pragma unroll
      for (int i = 0; i < 16; ++i) { int cc = lane + i * 64;
#pragma unroll
        for (int e = 0; e < 16; ++e) lo[e] += v[i] * wr[cc * NE + e]; }
      float mx = -1e30f;
#pragma unroll
      for (int e = 0; e < 16; ++e) { lo[e] = wave_sum(lo[e]); mx = fmaxf(mx, lo[e]); }
      float sum = 0;
#pragma unroll
      for (int e = 0; e < 16; ++e) { lo[e] = expf(lo[e] - mx); sum += lo[e]; }
      float* afft = (float*)(p.ws + OFF_AFFT);
      if (lane == 0) {
#pragma unroll
        for (int e = 0; e < 16; ++e) afft[(size_t)e * MR + r] = lo[e] / sum;
      }
    }
  }
}

__device__ __forceinline__ constexpr int ngemm_lds_floats() { return 16 * 65 + 16 * 129; }
template <typename LoadA, typename LoadB, typename Epi>
__device__ __forceinline__ void ngemm_tile(float* lds, int M, int N, int K, int tm, int tn, LoadA lda_, LoadB ldb_, Epi epi) {
  float (*sA)[65] = (float (*)[65])lds; float (*sB)[129] = (float (*)[129])(lds + 16 * 65);
  const int tid = ltid(), tx = tid & 31, ty = tid >> 5;
  float acc[4][4];
#pragma unroll
  for (int i = 0; i < 4; ++i)
#pragma unroll
    for (int j = 0; j < 4; ++j) acc[i][j] = 0.f;
  for (int k0 = 0; k0 < K; k0 += 16) {
#pragma unroll
    for (int i = 0; i < 2; ++i) { int e = tid + i * 512; int rr = e >> 4, kk = e & 15; int gr = tm * 64 + rr; sA[kk][rr] = gr < M ? lda_(gr, k0 + kk) : 0.f; }
#pragma unroll
    for (int i = 0; i < 4; ++i) { int e = tid + i * 512; int kk = e >> 7, cc = e & 127; int gc = tn * 128 + cc; sB[kk][cc] = gc < N ? ldb_(k0 + kk, gc) : 0.f; }
    __syncthreads();
#pragma unroll
    for (int kk = 0; kk < 16; ++kk) {
      float a[4], b[4];
#pragma unroll
      for (int i = 0; i < 4; ++i) { a[i] = sA[kk][ty * 4 + i]; b[i] = sB[kk][tx * 4 + i]; }
#pragma unroll
      for (int i = 0; i < 4; ++i)
#pragma unroll
        for (int j = 0; j < 4; ++j) acc[i][j] += a[i] * b[j];
    }
    __syncthreads();
  }
#pragma unroll
  for (int i = 0; i < 4; ++i)
#pragma unroll
    for (int j = 0; j < 4; ++j) { int rr = tm * 64 + ty * 4 + i, cc = tn * 128 + tx * 4 + j; if (rr < M && cc < N) epi(rr, cc, acc[i][j]); }
}

__device__ __forceinline__ void ph_inproj(const Params& p, int l, float* lds) {
  const int TIDX = ltid(); const int BIDX = lbid();
  const bf16_t* H = (const bf16_t*)(p.ws + OFF_H); const float* W = p.w_in + (size_t)l * D * NIN; bf16_t* P = (bf16_t*)(p.ws + OFF_P);
  const int ntn = (NIN + 127) / 128, ntm = MR / 64;
  for (int vb = BIDX; vb < ntn * ntm; vb += gridDim.x)
    ngemm_tile(lds, MR, NIN, D, vb / ntn, vb % ntn,
               [&](int r, int k) { return bf2f(H[(size_t)r * D + k]); },
               [&](int k, int n) { return W[(size_t)k * NIN + n]; },
               [&](int r, int n, float v) { P[(size_t)r * NINP + n] = f2bf(v); });
}

__device__ __forceinline__ void ph_mla(const Params& p, int l, float* lds) {
  const int TIDX = ltid(); const int BIDX = lbid();
  float* pq = lds; float* pkv = pq + 192; float* pkr = pkv + 128; float* qraw = pkr + 32; float* kvraw = qraw + 384; float* qn = kvraw + 512; float* kn = qn + 384; float* red = kn + 384;
  const int tid = TIDX;
  for (int r = BIDX; r < MR; r += gridDim.x) {
    int mj, t, tlen, r0; rowinfo(r, mj, t, tlen, r0);
    const bf16_t* P = (const bf16_t*)(p.ws + OFF_P) + (size_t)r * NINP;
    __syncthreads();
    if (tid < 192) pq[tid] = bf2f(P[PC_Q + tid]);
    if (tid < 128) pkv[tid] = bf2f(P[PC_KV + tid]);
    if (tid < 32) pkr[tid] = bf2f(P[PC_KR + tid]);
    __syncthreads();
    if (tid < 64) { float s = 0; for (int k = tid; k < 192; k += 64) s += pq[k] * pq[k]; s = wave_sum(s); if (tid == 0) red[0] = rsqrtf(s / 192.f + EPS); }
    else if (tid < 128) { float s = 0; for (int k = tid - 64; k < 128; k += 64) s += pkv[k] * pkv[k]; s = wave_sum(s); if (tid == 64) red[1] = rsqrtf(s / 128.f + EPS); }
    __syncthreads();
    const float rq = red[0], rkv = red[1];
    const float* wuq = p.w_uq + (size_t)l * 192 * 384; const float* qan = p.q_a_norm + l * 192;
    const float* wukv = p.w_ukv + (size_t)l * 128 * 512; const float* kvan = p.kv_a_norm + l * 128;
    if (tid < 384) { float a = 0; for (int k = 0; k < 192; ++k) a += pq[k] * rq * qan[k] * wuq[k * 384 + tid]; qraw[tid] = a; }
    { float a = 0; for (int k = 0; k < 128; ++k) a += pkv[k] * rkv * kvan[k] * wukv[k * 512 + tid]; kvraw[tid] = a; }
    __syncthreads();
    const float* qnw = p.q_norm + l * 96; const float* knw = p.k_norm + l * 96;
    if (tid < 384) {
      int h = tid / 96, d = tid % 96;
      float sq = 0, sk = 0;
      for (int dd = 0; dd < 96; ++dd) { float a = qraw[h * 96 + dd]; sq += a * a; float b = dd < 64 ? kvraw[h * 128 + dd] : pkr[dd - 64]; sk += b * b; }
      float kval = d < 64 ? kvraw[h * 128 + d] : pkr[d - 64];
      qn[tid] = qraw[tid] * rsqrtf(sq / 96.f + EPS) * qnw[d];
      kn[tid] = kval * rsqrtf(sk / 96.f + EPS) * knw[d];
    }
    __syncthreads();
    const bool lat = r < ML; const int b = lat ? (r >> 13) : ((r - ML) >> 8); const int pos = lat ? TC + t : t;
    bf16_t* Q = (bf16_t*)(p.ws + OFF_QKV); bf16_t* Kb = Q + QK_ELEMS; bf16_t* Vb = Kb + QK_ELEMS;
    {
      int h = tid >> 7, d = tid & 127;
      float qv = 0, kv = 0;
      if (d < 96) {
        qv = qn[h * 96 + d]; kv = kn[h * 96 + d];
        if (lat && d >= 64) {
          int part = (d - 64) >> 4, w = (d - 64) & 15, i = w & 7; bool first = w < 8;
          float posv = part == 0 ? (float)(t >> 6) : (float)(t & 63);
          float invf = powf(10000.f, -(float)i / 8.f);
          float ang = posv * invf, cs = cosf(ang), sn = sinf(ang);
          int i1 = h * 96 + 64 + part * 16 + i, i2 = i1 + 8;
          qv = first ? qn[i1] * cs - qn[i2] * sn : qn[i2] * cs + qn[i1] * sn;
          kv = first ? kn[i1] * cs - kn[i2] * sn : kn[i2] * cs + kn[i1] * sn;
        }
      }
      size_t o = ((size_t)(b * 4 + h) * TK + pos) * 128 + d;
      Q[o] = f2bf(qv); Kb[o] = f2bf(kv);
      if (d < 64) Vb[((size_t)(b * 4 + h) * TK + pos) * 64 + d] = f2bf(kvraw[h * 128 + 64 + d]);
    }
  }
}

__device__ __forceinline__ void ph_gdnprep(const Params& p, int l, float* lds) {
  const int TIDX = ltid(); const int BIDX = lbid();
  float* cv = lds; float* rs = lds + 1536;
  const int tid = TIDX;
  const bf16_t* P = (const bf16_t*)(p.ws + OFF_P);
  const float* cw = p.conv_w + (size_t)l * 3 * 1536;
  for (int r = BIDX; r < MR; r += gridDim.x) {
    int mj, t, tlen, r0; rowinfo(r, mj, t, tlen, r0);
    __syncthreads();
    for (int c = tid; c < 1536; c += NT) {
      float a = 0;
      for (int j = 0; j < 3; ++j) { int tt = t + j - 1; if (tt >= 0 && tt < tlen) a += cw[j * 1536 + c] * bf2f(P[(size_t)(r0 + tt) * NINP + PC_GQ + c]); }
      cv[c] = silu_f(a);
    }
    __syncthreads();
    if (tid < 8) { float s = 0; for (int d = 0; d < 128; ++d) { float v = cv[tid * 128 + d]; s += v * v; } rs[tid] = rsqrtf(s + EPS) * (tid < 4 ? 0.08838834764831845f : 1.f); }
    __syncthreads();
    float* G = (float*)(p.ws + OFF_RB) + (size_t)r * 1536;
    for (int c = tid; c < 1536; c += NT) G[c] = c < 1024 ? cv[c] * rs[c >> 7] : cv[c];
    if (tid < 8) {
      float* gb = (float*)(p.ws + OFF_GB) + (size_t)r * 16;
      float pa = bf2f(P[(size_t)r * NINP + PC_A + tid]), pb = bf2f(P[(size_t)r * NINP + PC_B + tid]);
      gb[tid] = -expf(p.a_log[l * 8 + tid]) * softplus_f(pa + p.dt_bias[l * 8 + tid]);
      gb[8 + tid] = sigmoid_f(pb);
    }
  }
}
__device__ __forceinline__ void ph_scan(const Params& p, float* lds) {
  const int TIDX = ltid(); const int BIDX = lbid();
  if (BIDX >= 16) return;
  float* sk = lds; float* sq = lds + 128; float* red = lds + 256; float* red2 = lds + 256 + 512;
  const int tid = TIDX, e = tid & 127, part = tid >> 7;
  const int chain = BIDX, dir = chain & 1, h = (chain >> 1) & 3, b = chain >> 3;
  const float* G = (const float*)(p.ws + OFF_RB); const float* GB = (const float*)(p.ws + OFF_GB);
  bf16_t* P = (bf16_t*)(p.ws + OFF_P);
  float S[32];
#pragma unroll
  for (int d = 0; d < 32; ++d) S[d] = 0.f;
  __syncthreads();
  for (int step = 0; step < TC + T; ++step) {
    int row;
    if (step < TC) row = ML + b * TC + (dir ? TC - 1 - step : step);
    else { int i = step - TC; row = b * T + (dir ? T - 1 - i : i); }
    const float* q = G + (size_t)row * 1536 + h * 128; const float* k = q + 512; const float v = q[1024 + e];
    if (tid < 128) sk[tid] = k[tid]; else if (tid < 256) sq[tid - 128] = q[tid - 128];
    const float g = GB[(size_t)row * 16 + dir * 4 + h], beta = GB[(size_t)row * 16 + 8 + dir * 4 + h];
    const float eg = expf(g);
    __syncthreads();
    float ks = 0;
#pragma unroll
    for (int d = 0; d < 32; ++d) ks += sk[part * 32 + d] * S[d];
    red[part * 128 + e] = ks;
    __syncthreads();
    ks = red[e] + red[128 + e] + red[256 + e] + red[384 + e];
    const float vn = beta * (v - eg * ks);
    float o = 0;
#pragma unroll
    for (int d = 0; d < 32; ++d) { S[d] = eg * S[d] + sk[part * 32 + d] * vn; o += sq[part * 32 + d] * S[d]; }
    red2[part * 128 + e] = o;
    __syncthreads();
    if (part == 0) P[(size_t)row * NINP + (dir ? PC_OB : PC_OF) + h * 128 + e] = f2bf(red2[e] + red2[128 + e] + red2[256 + e] + red2[384 + e]);
  }
  __syncthreads();
}
__device__ __forceinline__ void ph_attn(const Params& p, bool need_ctx, float* lds) {
  const int TIDX = ltid(); const int BIDX = lbid();
  float (*sK)[96] = (float (*)[96])lds; float (*sV)[64] = (float (*)[64])(lds + 32 * 96);
  const int tid = TIDX;
  const int nlat = NB * 4 * (T / NT), nitem = nlat + (need_ctx ? NB * 4 : 0);
  const bf16_t* Q = (const bf16_t*)(p.ws + OFF_QKV); const bf16_t* Kb = Q + QK_ELEMS; const bf16_t* Vb = Kb + QK_ELEMS;
  for (int it = gridDim.x - 1 - BIDX; it < nitem; it += gridDim.x) {
    const bool ctxq = it >= nlat;
    int b, h, qt;
    if (!ctxq) { qt = it % (T / NT); h = (it / (T / NT)) & 3; b = it / (4 * (T / NT)); } else { int j = it - nlat; qt = 0; h = j & 3; b = j >> 2; }
    const bool active = !ctxq || tid < TC;
    const int qpos = ctxq ? (active ? tid : 0) : TC + qt * NT + tid;
    const int nk = ctxq ? TC : TK;
    const size_t bh = (size_t)(b * 4 + h) * TK;
    float q[96], o[64];
#pragma unroll
    for (int d = 0; d < 96; ++d) q[d] = bf2f(Q[(bh + qpos) * 128 + d]);
#pragma unroll
    for (int d = 0; d < 64; ++d) o[d] = 0.f;
    float m = -1e30f, lsum = 0.f;
    const float scale = 0.10206207261596575f;
    for (int k0 = 0; k0 < nk; k0 += 32) {
      __syncthreads();
      for (int e = tid; e < 32 * 96; e += NT) { int j = e / 96, d = e % 96; sK[j][d] = bf2f(Kb[(bh + k0 + j) * 128 + d]); }
      for (int e = tid; e < 32 * 64; e += NT) { int j = e >> 6, d = e & 63; sV[j][d] = bf2f(Vb[(bh + k0 + j) * 64 + d]); }
      __syncthreads();
      for (int j = 0; j < 32; ++j) {
        float s = 0;
#pragma unroll
        for (int d = 0; d < 96; ++d) s += q[d] * sK[j][d];
        s *= scale;
        if (s > m) { float a = __expf(m - s); lsum *= a;
#pragma unroll
          for (int d = 0; d < 64; ++d) o[d] *= a;
          m = s; }
        float pe = __expf(s - m); lsum += pe;
#pragma unroll
        for (int d = 0; d < 64; ++d) o[d] += pe * sV[j][d];
      }
    }
    if (active) {
      const int row = ctxq ? ML + b * TC + qpos : b * T + (qpos - TC);
      bf16_t* cat = (bf16_t*)(p.ws + OFF_H) + (size_t)row * D + h * 64;
      float inv = 1.f / lsum;
#pragma unroll
      for (int d = 0; d < 64; ++d) cat[d] = f2bf(o[d] * inv);
    }
  }
}
__device__ __forceinline__ void ph_gdnfin_pool(const Params& p, int l, int nrows, float* lds) {
  const int TIDX = ltid(); const int BIDX = lbid();
  float* ov = lds; float* rs = lds + 512; float* dv = lds + 520;
  const int tid = TIDX;
  const bf16_t* P = (const bf16_t*)(p.ws + OFF_P);
  for (int r = BIDX; r < nrows; r += gridDim.x) {
    int mj, t, tlen, r0; rowinfo(r, mj, t, tlen, r0);
    bf16_t* cat = (bf16_t*)(p.ws + OFF_H) + (size_t)r * D;
    __syncthreads();
    ov[tid] = bf2f(P[(size_t)r * NINP + PC_OF + tid]) + bf2f(P[(size_t)r * NINP + PC_OB + tid]);
    if (tid < 256) {
      int c = tid, gi = c >> 6, win = 2 << gi;
      int lo = t - win / 2, hi = lo + win; lo = lo < 0 ? 0 : lo; hi = hi > tlen ? tlen : hi;
      float s = 0; for (int tt = lo; tt < hi; ++tt) s += bf2f(P[(size_t)(r0 + tt) * NINP + PC_POOL + c]);
      dv[c] = s / (float)(hi - lo) - bf2f(P[(size_t)r * NINP + PC_POOL + c]);
    }
    __syncthreads();
    if (tid < 4) { float s = 0; for (int d = 0; d < 128; ++d) { float v = ov[tid * 128 + d]; s += v * v; } rs[tid] = rsqrtf(s / 128.f + EPS); }
    __syncthreads();
    const float* gn = p.gdn_norm_g + l * 128;
    { int c = tid; float z = bf2f(P[(size_t)r * NINP + PC_Z + c]); cat[256 + c] = f2bf(ov[c] * rs[c >> 7] * gn[c & 127] * silu_f(z)); }
    if (tid < 256) {
      int j = tid, gi = j >> 6, dd = j & 63;
      const float* pw = p.pool_w + ((size_t)l * 4 + gi) * 64 * 64;
      float a = 0; for (int c = 0; c < 64; ++c) a += dv[gi * 64 + c] * pw[c * 64 + dd];
      cat[768 + j] = f2bf(a * p.pool_scale[l * 256 + j]);
    }
  }
}
__device__ __forceinline__ void ph_outproj(const Params& p, int l, int nrows, float* lds) {
  const int TIDX = ltid(); const int BIDX = lbid();
  const bf16_t* A = (const bf16_t*)(p.ws + OFF_H); const float* W = p.w_out + (size_t)l * D * D;
  const int ntn = D / 128, ntm = nrows / 64;
  for (int vb = BIDX; vb < ntn * ntm; vb += gridDim.x)
    ngemm_tile(lds, nrows, D, D, vb / ntn, vb % ntn,
               [&](int r, int k) { return bf2f(A[(size_t)r * D + k]); },
               [&](int k, int n) { return W[(size_t)k * D + n]; },
               [&](int r, int n, float v) { int mj = r < ML ? (r >> 13) : 2; xrow(p, r)[n] += modvec(p, l, mj, 2)[n] * v; });
}
__device__ __forceinline__ void ph_topk(const Params& p, int nseq) {
  const int TIDX = ltid(); const int BIDX = lbid();
  const size_t total = (size_t)nseq * NE * T;
  for (size_t i = (size_t)BIDX * NT + TIDX; i < total; i += (size_t)gridDim.x * NT) {
    const int t = (int)(i % T), e = (int)((i / T) % NE), s = (int)(i / ((size_t)T * NE));
    const int tlen = s < 2 ? T : TC, cap = s < 2 ? CAPL : CAPC, r0 = s < 2 ? s * T : ML + (s - 2) * TC;
    if (t >= tlen) continue;
    const float* a = (const float*)(p.ws + OFF_AFFT) + (size_t)e * MR + r0;
    const float me = a[t];
    int rank = 0;
    for (int u = 0; u < tlen; ++u) { float o = a[u]; rank += (o > me || (o == me && u < t)) ? 1 : 0; }
    int* slot = (int*)(p.ws + OFF_SLOT);
    if (rank < cap) { int pi = pair_base(s, e) + rank; ((int*)(p.ws + OFF_IDX))[pi] = r0 + t; ((float*)(p.ws + OFF_GATE))[pi] = me; slot[(size_t)(r0 + t) * 16 + e] = rank; }
    else slot[(size_t)(r0 + t) * 16 + e] = -1;
  }
}
__device__ __forceinline__ void ph_moe_gu(const Params& p, int l, int grp0, int grp1, float* lds) {
  const int TIDX = ltid(); const int BIDX = lbid();
  const bf16_t* H = (const bf16_t*)(p.ws + OFF_H);
  float* tmp = (float*)(p.ws + OFF_P);
  const int ntn = DEXP / 128, ntm = CAPL / 64, per = ntn * ntm;
  for (int vb = BIDX; vb < (grp1 - grp0) * per; vb += gridDim.x) {
    const int grp = grp0 + vb / per, tt = vb % per, tm = tt / ntn, tn = tt % ntn;
    const int s = grp >> 4, e = grp & 15; const int cap = s < 2 ? CAPL : CAPC;
    if (tm * 64 >= cap) continue;
    const int pb = pair_base(s, e);
    const int* idx = (const int*)(p.ws + OFF_IDX) + pb;
    const float* Wg = p.w_gate + ((size_t)l * NE + e) * D * DEXP; const float* Wu = p.w_up + ((size_t)l * NE + e) * D * DEXP;
    bf16_t* hid = (bf16_t*)(p.ws + OFF_HID) + (size_t)pb * DEXP;
    ngemm_tile(lds, cap, DEXP, D, tm, tn,
               [&](int r, int k) { return bf2f(H[(size_t)idx[r] * D + k]); },
               [&](int k, int n) { return Wg[(size_t)k * DEXP + n]; },
               [&](int r, int n, float v) { tmp[(size_t)(pb + r) * DEXP + n] = v; });
    ngemm_tile(lds, cap, DEXP, D, tm, tn,
               [&](int r, int k) { return bf2f(H[(size_t)idx[r] * D + k]); },
               [&](int k, int n) { return Wu[(size_t)k * DEXP + n]; },
               [&](int r, int n, float v) { float g = tmp[(size_t)(pb + r) * DEXP + n]; hid[(size_t)r * DEXP + n] = f2bf(silu_f(g) * v); });
  }
}
__device__ __forceinline__ void ph_moe_down(const Params& p, int l, int grp0, int grp1, float* lds) {
  const int TIDX = ltid(); const int BIDX = lbid();
  const int ntn = D / 128, ntm = CAPL / 64, per = ntn * ntm;
  for (int vb = BIDX; vb < (grp1 - grp0) * per; vb += gridDim.x) {
    const int grp = grp0 + vb / per, tt = vb % per, tm = tt / ntn, tn = tt % ntn;
    const int s = grp >> 4, e = grp & 15; const int cap = s < 2 ? CAPL : CAPC;
    if (tm * 64 >= cap) continue;
    const int pb = pair_base(s, e);
    const bf16_t* hid = (const bf16_t*)(p.ws + OFF_HID) + (size_t)pb * DEXP;
    const float* Wd = p.w_down + ((size_t)l * NE + e) * DEXP * D;
    const float* gate = (const float*)(p.ws + OFF_GATE) + pb;
    bf16_t* Y = (bf16_t*)(p.ws + OFF_Y) + (size_t)pb * D;
    ngemm_tile(lds, cap, D, DEXP, tm, tn,
               [&](int r, int k) { return bf2f(hid[(size_t)r * DEXP + k]); },
               [&](int k, int n) { return Wd[(size_t)k * D + n]; },
               [&](int r, int n, float v) { Y[(size_t)r * D + n] = f2bf(v * gate[r]); });
  }
}
__device__ __forceinline__ void ph_combine(const Params& p, int l, int nrows) {
  const int TIDX = ltid(); const int BIDX = lbid();
  const bf16_t* Y = (const bf16_t*)(p.ws + OFF_Y);
  for (int r = BIDX; r < nrows; r += gridDim.x) {
    int mj, t, tlen, r0; rowinfo(r, mj, t, tlen, r0);
    const int s = r < ML ? (r >> 13) : 2 + ((r - ML) >> 8);
    const int* slot = (const int*)(p.ws + OFF_SLOT) + (size_t)r * 16;
    const float* g2 = modvec(p, l, mj, 5);
    float* xr = xrow(p, r);
    for (int c = TIDX; c < D; c += NT) {
      float a = 0;
      for (int e = 0; e < 16; ++e) { int sl = slot[e]; if (sl >= 0) a += bf2f(Y[(size_t)(pair_base(s, e) + sl) * D + c]); }
      xr[c] += g2[c] * a;
    }
  }
}


__device__ __forceinline__ void transpose_cvt_tile(float* lds, const float* W, int ldw, int N, bf16_t* Wt, int K, int rmul, int roff, int tk, int tn, int tid, const float* kscale = nullptr) {
  __syncthreads();
#pragma unroll
  for (int i = 0; i < 8; ++i) { int e = tid + i * NT; int kk = e >> 6, nn = e & 63; int n = tn * 64 + nn; lds[kk * 65 + nn] = n < N ? W[(size_t)(tk * 64 + kk) * ldw + n] * (kscale ? kscale[tk * 64 + kk] : 1.f) : 0.f; }
  __syncthreads();
#pragma unroll
  for (int i = 0; i < 8; ++i) { int e = tid + i * NT; int nn = e >> 6, kk = e & 63; int n = tn * 64 + nn; if (n < N) Wt[(size_t)(n * rmul + roff) * K + tk * 64 + kk] = f2bf(lds[kk * 65 + nn]); }
}
__device__ __forceinline__ void transpose_cvt_4tiles(float* lds, const float* W, int ldw, int N, bf16_t* Wt, int K, int rmul, int roff, int t4, int ntiles, int tid, const float* kscale) {
  const int ntn = (N + 63) / 64;
  float v[4][8];
#pragma unroll
  for (int q = 0; q < 4; ++q) { const int t = t4 + q, tk = t / ntn, tn = t % ntn;
#pragma unroll
    for (int i = 0; i < 8; ++i) { const int el = tid + i * NT, kk = el >> 6, nn = el & 63, n = tn * 64 + nn;
      v[q][i] = (t < ntiles && n < N) ? W[(size_t)(tk * 64 + kk) * ldw + n] * (kscale ? kscale[tk * 64 + kk] : 1.f) : 0.f; } }
  __syncthreads();
#pragma unroll
  for (int q = 0; q < 4; ++q)
#pragma unroll
    for (int i = 0; i < 8; ++i) { const int el = tid + i * NT, kk = el >> 6, nn = el & 63; lds[q * 4160 + kk * 65 + nn] = v[q][i]; }
  __syncthreads();
#pragma unroll
  for (int q = 0; q < 4; ++q) { const int t = t4 + q, tk = t / ntn, tn = t % ntn;
#pragma unroll
    for (int i = 0; i < 4; ++i) { const int el = tid + i * NT, nn = el >> 5, k2 = (el & 31) * 2, n = tn * 64 + nn;
      if (t < ntiles && n < N) *(unsigned*)(Wt + (size_t)(n * rmul + roff) * K + tk * 64 + k2) = gd::pk(lds[q * 4160 + k2 * 65 + nn], lds[q * 4160 + (k2 + 1) * 65 + nn]); } }
}
__device__ __forceinline__ void ph_prep_weights(const Params& p, float* lds) {
  const int TIDX = ltid(); const int BIDX = lbid();
  bf16_t* winT = (bf16_t*)(p.ws + OFF_WINT); bf16_t* woutT = (bf16_t*)(p.ws + OFF_WOUTT);
  const int g_in = 2 * 168, g_out = 2 * 64, g_q = 2 * 5, g_kv = 2 * 4;
  for (int vb = BIDX; vb < g_in + g_out + g_q + g_kv; vb += gridDim.x) {
    if (vb < g_in) { const int l = vb / 168, r = vb % 168; transpose_cvt_4tiles(lds, p.w_in + (size_t)l * D * NIN, NIN, NIN, winT + (size_t)l * NINP * D, D, 1, 0, r * 4, 16 * 42, TIDX, nullptr); }
    else if (vb < g_in + g_out) { const int v = vb - g_in, l = v / 64, r = v % 64; transpose_cvt_4tiles(lds, p.w_out + (size_t)l * D * D, D, D, woutT + (size_t)l * D * D, D, 1, 0, r * 4, 256, TIDX, nullptr); }
    else if (vb < g_in + g_out + g_q) { const int v = vb - g_in - g_out, l = v / 5, r = v % 5;
      transpose_cvt_4tiles(lds, p.w_uq + (size_t)l * 192 * 384, 384, 384, (bf16_t*)(p.ws + OFF_WUP) + (size_t)l * 1024 * 256, 256, 1, 0, r * 4, 18, TIDX, p.q_a_norm + l * 192); }
    else { const int v = vb - g_in - g_out - g_q, l = v / 4, r = v % 4;
      transpose_cvt_4tiles(lds, p.w_ukv + (size_t)l * 128 * 512, 512, 512, (bf16_t*)(p.ws + OFF_WUP) + (size_t)l * 1024 * 256 + 512 * 256, 256, 1, 0, r * 4, 16, TIDX, p.kv_a_norm + l * 128); }
  }
  for (int q = 0; q < 16; ++q) {
    const int i = (q * (int)gridDim.x + BIDX) * NT + TIDX; if (i >= 2 * 1024 * 256) break;
    const int k = i & 255, n = (i >> 8) & 1023;
    if ((n < 384 && k >= 192) || (n >= 384 && n < 512) || (n >= 512 && k >= 128)) ((bf16_t*)(p.ws + OFF_WUP))[i] = 0;
  }
  for (size_t i = (size_t)BIDX * NT + TIDX; i < (size_t)2 * (NINP - NIN) * D; i += (size_t)gridDim.x * NT) {
    const int l = (int)(i / ((size_t)(NINP - NIN) * D)); const size_t r = i % ((size_t)(NINP - NIN) * D);
    winT[(size_t)l * NINP * D + (size_t)NIN * D + r] = 0;
  }
}
__device__ __forceinline__ void ph_inproj_fast(const Params& p, int l, char* smem) {
  DenseSched S; S.init(MR / 256, NINP / 256, (int)gridDim.x, lbid());
  S.A = p.ws + OFF_H; S.Bt = p.ws + OFF_WINT + (size_t)l * NINP * D * 2; S.lda = D; S.ldb = D; S.K = D;
  EpiStoreBf16 E; E.O = (bf16_t*)(p.ws + OFF_P); E.ldc = NINP;
  pg8::gemm_phase(( PG8_LAS unsigned char*)smem, S, E);
}

__device__ __forceinline__ void ph_outproj_fast(const Params& p, int l, char* smem) {
  DenseSched S; S.init(ML / 256, D / 256, (int)gridDim.x, lbid());
  S.A = p.ws + OFF_H; S.Bt = p.ws + OFF_WOUTT + (size_t)l * D * D * 2; S.lda = D; S.ldb = D; S.K = D;
  EpiStoreBf16 E; E.O = (bf16_t*)(p.ws + OFF_YO); E.ldc = D;
  pg8::gemm_phase((PG8_LAS unsigned char*)smem, S, E);
}

__device__ __forceinline__ void ph_prep_moe_weights(const Params& p, int l, float* lds, int b0, int nb) {
  const int TIDX = ltid(); const int BIDX = lbid() - b0;
  if (BIDX < 0) return;
  bf16_t* gu = (bf16_t*)(p.ws + OFF_MOEGU); bf16_t* dn = (bf16_t*)(p.ws + OFF_MOED);
  unsigned* ctr = (unsigned*)(p.ws + OFF_BAR) + 16 + l; volatile int* bc = (volatile int*)(lds + 4 * 4160);
  __syncthreads();
  if (TIDX == 0) bc[0] = (int)__hip_atomic_fetch_add(ctr, 1u, __ATOMIC_RELAXED, __HIP_MEMORY_SCOPE_AGENT);
  __syncthreads();
  int vb = __builtin_amdgcn_readfirstlane(bc[0]);
  for (int it = 1; ; ++it) {
    if (vb >= NE * 3 * 32) break;
    const int e = vb / 96, r = vb % 96, which = r >> 5, t4 = (r & 31) * 4;
    const float* W; int ldw, K, rmul, roff; bf16_t* Wt;
    if (which < 2) { W = (which ? p.w_up : p.w_gate) + ((size_t)l * NE + e) * D * DEXP; ldw = DEXP; K = D; rmul = 2; roff = which; Wt = gu + (size_t)e * D * D; }
    else { W = p.w_down + ((size_t)l * NE + e) * DEXP * D; ldw = D; K = DEXP; rmul = 1; roff = 0; Wt = dn + (size_t)e * D * DEXP; }
    const int ntn = ldw / 64;
    float v[4][8];
#pragma unroll
    for (int q = 0; q < 4; ++q) { const int t = t4 + q, tk = t / ntn, tn = t % ntn;
#pragma unroll
      for (int i = 0; i < 8; ++i) { const int el = TIDX + i * NT, kk = el >> 6, nn = el & 63; v[q][i] = __builtin_nontemporal_load(&W[(size_t)(tk * 64 + kk) * ldw + tn * 64 + nn]); } }
    if (TIDX == 0) bc[it & 1] = (int)__hip_atomic_fetch_add(ctr, 1u, __ATOMIC_RELAXED, __HIP_MEMORY_SCOPE_AGENT);
    __syncthreads();
#pragma unroll
    for (int q = 0; q < 4; ++q)
#pragma unroll
      for (int i = 0; i < 8; ++i) { const int el = TIDX + i * NT, kk = el >> 6, nn = el & 63; lds[q * 4160 + kk * 65 + nn] = v[q][i]; }
    __syncthreads();
#pragma unroll
    for (int q = 0; q < 4; ++q) { const int t = t4 + q, tk = t / ntn, tn = t % ntn;
#pragma unroll
      for (int i = 0; i < 4; ++i) { const int el = TIDX + i * NT, nn = el >> 5, k2 = (el & 31) * 2;
        const unsigned w = gd::pk(lds[q * 4160 + k2 * 65 + nn], lds[q * 4160 + (k2 + 1) * 65 + nn]);
        *(unsigned*)(Wt + (size_t)((tn * 64 + nn) * rmul + roff) * K + tk * 64 + k2) = w; } }
    vb = __builtin_amdgcn_readfirstlane(bc[it & 1]);
  }
}
__device__ __forceinline__ void ph_gather(const Params& p) {
  const int TIDX = ltid(); const int BIDX = lbid();
  const int lane = TIDX & 63, wv = TIDX >> 6;
  const int* idx = (const int*)(p.ws + OFF_IDX);
  const uint4* H = (const uint4*)(p.ws + OFF_H); uint4* xs = (uint4*)(p.ws + OFF_XS);
  for (int r = BIDX * 8 + wv; r < NB * NE * CAPL; r += gridDim.x * 8) {
    const int src = idx[r];
    const uint4 a = H[(size_t)src * 128 + lane], b = H[(size_t)src * 128 + 64 + lane];
    xs[(size_t)r * 128 + lane] = a; xs[(size_t)r * 128 + 64 + lane] = b;
  }
}
__device__ __forceinline__ void ph_moe_gu_fast(const Params& p, char* smem) {
  MoeSched S; S.init(NB * NE * CAPL / 256, 2 * DEXP / 256, (int)gridDim.x, lbid());
  S.A = p.ws + OFF_H; S.Bt = p.ws + OFF_MOEGU; S.lda = D; S.ldb = D; S.K = D; S.bstride = (size_t)D * D * 2; S.gidx = (const int*)(p.ws + OFF_IDX); S.gather = true;
  EpiSwiGLU E; E.O = (bf16_t*)(p.ws + OFF_HID);
  pg8::gemm_phase<EpiSwiGLU, MoeSched, true>((PG8_LAS unsigned char*)smem, S, E);
}
__device__ __forceinline__ void ph_moe_down_fast(const Params& p, char* smem) {
  MoeSched S; S.init(NB * NE * CAPL / 256, D / 256, (int)gridDim.x, lbid());
  S.A = p.ws + OFF_HID; S.Bt = p.ws + OFF_MOED; S.lda = DEXP; S.ldb = DEXP; S.K = DEXP; S.bstride = (size_t)D * DEXP * 2; S.gidx = nullptr; S.gather = false;
  EpiGateBf16 E; E.O = (bf16_t*)(p.ws + OFF_Y); E.gate = (const float*)(p.ws + OFF_GATE);
  pg8::gemm_phase((PG8_LAS unsigned char*)smem, S, E);
}

__device__ __forceinline__ void attn_ctx_item(const Params& p, int j, char* smem) {
  const bf16_t* Q = (const bf16_t*)(p.ws + OFF_QKV); const bf16_t* Kb = Q + QK_ELEMS; const bf16_t* Vb = Kb + QK_ELEMS;
  const int h = j & 3, b = j >> 2; const size_t bh = (size_t)(b * 4 + h) * TK;
  fa::attn_body(Q + bh * 128, Kb + bh * 128, Vb + bh * 64, (bf16_t*)(p.ws + OFF_H) + (size_t)(ML + b * TC) * D + h * 64, D, TC, smem);
}
__device__ __forceinline__ void attn_seg(const Params& p, int x, int qt, int off, int len, char* smem) {
  const bf16_t* Q = (const bf16_t*)(p.ws + OFF_QKV); const bf16_t* Kb = Q + QK_ELEMS; const bf16_t* Vb = Kb + QK_ELEMS;
  const int h = x & 3, b = x >> 2, part = off == 0 ? 0 : 1, kv0 = off * 128;
  const size_t bh = (size_t)(b * 4 + h) * TK; const int row0 = b * T + qt * 256;
  bf16_t* op = (bf16_t*)(p.ws + OFF_OPART) + ((size_t)part * ML + row0) * 256 + h * 64;
  float* ml = (float*)(p.ws + OFF_MLPART) + (((size_t)part * ML + row0) * 4 + h) * 2;
  fa::attn_body(Q + (bh + TC + qt * 256) * 128, Kb + (bh + kv0) * 128, Vb + (bh + kv0) * 64, op, 256, len * 128, smem, ml, 8);
  if (off == 0 && len == TK / 128) {
    const int t = ltid();
    if (t < 256) *(float2*)((float*)(p.ws + OFF_MLPART) + (((size_t)ML + row0 + t) * 4 + h) * 2) = make_float2(-1e30f, 0.f);
  }
}
__device__ __forceinline__ void ph_attn_fast(const Params& p, bool need_ctx, char* smem) {
  const int BIDX = lbid();
  const int nns = (int)gridDim.x - 32;
  if (BIDX >= 32) {
    const int x = BIDX & 7, j = (BIDX - 32) >> 3, nj = nns >> 3;
    constexpr int PPQ = TK / 128, NPAIRS = 32 * PPQ;
    const int hi = (NPAIRS * (j + 1)) / nj;
    for (int cur = (NPAIRS * j) / nj; cur < hi; ) {
      const int qt = cur / PPQ, off = cur - qt * PPQ, len = min(PPQ - off, hi - cur);
      attn_seg(p, x, qt, off, len, smem);
      cur += len;
    }
    if (need_ctx && j == nj - 1) attn_ctx_item(p, x, smem);
  }
}

__device__ __forceinline__ void ph_gdn_precompute(const Params& p, int l, char* smem) {
  const int TIDX = ltid(); const int BIDX = lbid();
  __syncthreads();
  { const float* cw = p.conv_w + (size_t)l * 3 * 1536; float* cwl = (float*)(smem + gd::L_CW);
    for (int i = TIDX; i < 3 * 1536 / 4; i += NT) ((float4*)cwl)[i] = ((const float4*)cw)[i]; }
  const int nit = NB * 4 * gd::NCH;
  for (int it = BIDX; it < nit; it += gridDim.x) {
    const int c = it % gd::NCH, bh = it / gd::NCH;
    uint4 cur[3][4];
    gd::precompute_load(p, bh >> 2, bh & 3, c, TIDX, cur);
    gd::precompute_item(p, l, bh >> 2, bh & 3, c, smem, TIDX, cur);
  }
  __syncthreads();
}
__device__ __forceinline__ void ph_scan_fast(const Params& p, char* smem) {
  const int TIDX = ltid(); const int BIDX = lbid();
  if (BIDX < 32) gd::scan_unit_lds(p, (((BIDX & 7) + 8 * (BIDX >> 4)) << 1) | ((BIDX >> 3) & 1), smem, TIDX);
}

struct MlaSched : pg8::GridOrder {
  const char* P; const char* W; int lda, ldb, K; const int* gidx;
  __device__ __forceinline__ const char* a_ptr(const pg8::Unit& u) const { return P + (size_t)u.pm * 256 * NINP * 2 + (u.pn < 2 ? PC_Q : PC_KV) * 2; }
  __device__ __forceinline__ const char* b_ptr(const pg8::Unit& u) const { return W + (size_t)u.pn * 256 * 256 * 2; }
};
__device__ __forceinline__ void ph_mla_gemm(const Params& p, int l, char* smem) {
  if (lbid() < 32) return;
  MlaSched S; S.init(MR / 256, 4, (int)gridDim.x - 32, lbid() - 32);
  S.P = p.ws + OFF_P; S.W = p.ws + OFF_WUP + (size_t)l * 1024 * 256 * 2; S.lda = NINP; S.ldb = 256; S.K = 256; S.gidx = nullptr;
  EpiStoreBf16 E; E.O = (bf16_t*)(p.ws + OFF_UPRAW); E.ldc = 1024;
  pg8::gemm_phase((PG8_LAS unsigned char*)smem, S, E);
}
__device__ __forceinline__ void handoff_publish(unsigned* ctr) {
  asm volatile("s_waitcnt vmcnt(0)" ::: "memory");
  __syncthreads();
  if (threadIdx.x == 0) { __builtin_amdgcn_fence(__ATOMIC_RELEASE, "agent"); asm volatile("s_waitcnt vmcnt(0)" ::: "memory"); xb_add(ctr, 1u); }
}
__device__ __forceinline__ void handoff_wait(unsigned* ctr, unsigned need, unsigned* bar) {
  if (threadIdx.x == 0) { XB_SPIN(xb_ld(ctr) < need, bar); __builtin_amdgcn_fence(__ATOMIC_ACQUIRE, "agent"); asm volatile("s_waitcnt vmcnt(0)" ::: "memory"); }
  __syncthreads();
}
__device__ __forceinline__ void ph_mla_finish(const Params& p, int l, float* lds) {
  const int TIDX = ltid(); const int BIDX = lbid() - 32; const int nb = (int)gridDim.x - 32;
  if (BIDX < 0) return;
  const int lane = TIDX & 63, wv = TIDX >> 6, h = lane >> 4, j = lane & 15;
  const bf16_t* P = (const bf16_t*)(p.ws + OFF_P); const bf16_t* RAW = (const bf16_t*)(p.ws + OFF_UPRAW);
  bf16_t* Qo = (bf16_t*)(p.ws + OFF_QKV); bf16_t* Ko = Qo + QK_ELEMS; bf16_t* Vo = Ko + QK_ELEMS;
  __syncthreads();
  for (int i = TIDX; i < 128 * 8; i += NT) { const int a = i >> 3, e = i & 7; const float ang = (float)a * __builtin_amdgcn_exp2f(-(float)e * 1.6609640474436813f);
    lds[a * 16 + e] = __cosf(ang); lds[a * 16 + 8 + e] = __sinf(ang); }
  __syncthreads();
  float qw8[8], kw8[8], kwr8[8];
#pragma unroll
  for (int e = 0; e < 8; ++e) { qw8[e] = j < 12 ? p.q_norm[l * 96 + j * 8 + e] : 0.f; kw8[e] = j < 8 ? p.k_norm[l * 96 + j * 8 + e] : 0.f; kwr8[e] = p.k_norm[l * 96 + 64 + (lane & 3) * 8 + e]; }
  const bool ropel = j >= 8 && j < 12, first = (j & 1) == 0;
#define MF_UNPACK(dst, U4) do { dst[0] = __uint_as_float((U4).x << 16); dst[1] = __uint_as_float((U4).x & 0xffff0000u); dst[2] = __uint_as_float((U4).y << 16); dst[3] = __uint_as_float((U4).y & 0xffff0000u); \
    dst[4] = __uint_as_float((U4).z << 16); dst[5] = __uint_as_float((U4).z & 0xffff0000u); dst[6] = __uint_as_float((U4).w << 16); dst[7] = __uint_as_float((U4).w & 0xffff0000u); } while (0)
#define MF_PACK(src) make_uint4(gd::pk(src[0], src[1]), gd::pk(src[2], src[3]), gd::pk(src[4], src[5]), gd::pk(src[6], src[7]))
  for (int r2 = (BIDX + nb * wv) * 2; r2 < MR; r2 += nb * 8 * 2)
#pragma unroll
  for (int rr = 0; rr < 2; ++rr) { const int r = r2 + rr;
    const bool lat = r < ML; const int b = lat ? (r >> 13) : ((r - ML) >> 8), t = lat ? (r & (T - 1)) : ((r - ML) & (TC - 1)), pos = lat ? TC + t : t;
    const bf16_t* Pr = P + (size_t)r * NINP; const bf16_t* Rr = RAW + (size_t)r * 1024;
    const uint4 zero4 = make_uint4(0u, 0u, 0u, 0u);
    const uint4 q4 = j < 12 ? *(const uint4*)(Rr + h * 96 + j * 8) : zero4;
    const uint4 k4 = *(const uint4*)(Rr + 512 + h * 128 + j * 8);
    const bf16_t* pp = lane < 24 ? Pr + PC_Q + lane * 8 : (lane < 40 ? Pr + PC_KV + (lane - 24) * 8 : Pr + PC_KR + (lane - 40) * 8);
    const uint4 p4 = lane < 44 ? *(const uint4*)pp : zero4;
    float xq[8], xk[8], xp[8];
    MF_UNPACK(xq, q4); MF_UNPACK(xk, k4); MF_UNPACK(xp, p4);
    float sp = 0.f, sq = 0.f, sk = 0.f;
#pragma unroll
    for (int e = 0; e < 8; ++e) { sp += xp[e] * xp[e]; sq += xq[e] * xq[e]; sk += xk[e] * xk[e]; }
    if (j >= 8) sk = 0.f;
    sp += __shfl_xor(sp, 1); sp += __shfl_xor(sp, 2); sp += __shfl_xor(sp, 4);
    const float g0 = __builtin_amdgcn_readlane(sp, 0), g1 = __builtin_amdgcn_readlane(sp, 8), g2 = __builtin_amdgcn_readlane(sp, 16), g3 = __builtin_amdgcn_readlane(sp, 24), g4 = __builtin_amdgcn_readlane(sp, 32), skr = __builtin_amdgcn_readlane(sp, 40);
    const float rq = rsqrtf((g0 + g1 + g2) / 192.f + EPS), rkv = rsqrtf((g3 + g4) / 128.f + EPS);
    sq += __shfl_xor(sq, 1); sq += __shfl_xor(sq, 2); sq += __shfl_xor(sq, 4); sq += __shfl_xor(sq, 8);
    sk += __shfl_xor(sk, 1); sk += __shfl_xor(sk, 2); sk += __shfl_xor(sk, 4); sk += __shfl_xor(sk, 8);
    const float sc = rq * rsqrtf(rq * rq * sq / 96.f + EPS);
    const float sck = rsqrtf((rkv * rkv * sk + skr) / 96.f + EPS);
    const int aq = j < 10 ? (t >> 6) : (t & 63);
    float cs[8], sn[8];
    { const float4 c0 = *(const float4*)(lds + aq * 16), c1 = *(const float4*)(lds + aq * 16 + 4), s0 = *(const float4*)(lds + aq * 16 + 8), s1 = *(const float4*)(lds + aq * 16 + 12);
      cs[0] = c0.x; cs[1] = c0.y; cs[2] = c0.z; cs[3] = c0.w; cs[4] = c1.x; cs[5] = c1.y; cs[6] = c1.z; cs[7] = c1.w;
      sn[0] = s0.x; sn[1] = s0.y; sn[2] = s0.z; sn[3] = s0.w; sn[4] = s1.x; sn[5] = s1.y; sn[6] = s1.z; sn[7] = s1.w; }
    const size_t ob = (size_t)(b * 4 + h) * TK + pos;
    { float y[8];
#pragma unroll
      for (int e = 0; e < 8; ++e) { y[e] = xq[e] * sc * qw8[e]; const float o = __shfl_xor(y[e], 1);
        if (lat && ropel) y[e] = first ? y[e] * cs[e] - o * sn[e] : y[e] * cs[e] + o * sn[e]; }
      if (j < 12) *(uint4*)(Qo + ob * 128 + j * 8) = MF_PACK(y); }
    { float z[8], kk[8];
#pragma unroll
      for (int e = 0; e < 8; ++e) { z[e] = xp[e] * kwr8[e]; const float o = __shfl_xor(z[e], 1);
        if (lat) z[e] = first ? z[e] * cs[e] - o * sn[e] : z[e] * cs[e] + o * sn[e];
        const float zr = __shfl(z[e], 40 + (lane & 3));
        kk[e] = j < 8 ? xk[e] * rkv * sck * kw8[e] : zr * sck; }
      if (j < 12) *(uint4*)(Ko + ob * 128 + j * 8) = MF_PACK(kk); }
    { float vv[8];
#pragma unroll
      for (int e = 0; e < 8; ++e) vv[e] = xk[e] * rkv;
      if (j >= 8) *(uint4*)(Vo + ob * 64 + (j - 8) * 8) = MF_PACK(vv); }
  }
#undef MF_UNPACK
#undef MF_PACK
}
constexpr int POOL_ROWB = 144, POOL_TILEB = 64 * POOL_ROWB;
template <int H>
__device__ __forceinline__ void pool_unit(const Params& p, int l, int tile, int gi, char* Dw, const char* WTl, int lane) {
  typedef unsigned u2 __attribute__((ext_vector_type(2)));
  using bf16x8 = fa::bf16x8; using f32x16 = fa::f32x16;
  const int r_first = tile * 64;
  int r0, tlen;
  if (r_first < ML) { r0 = r_first & ~(T - 1); tlen = T; } else { r0 = ML + ((r_first - ML) & ~(TC - 1)); tlen = TC; }
  const int cq = lane & 15, tb = lane >> 4, tbase = r_first - r0 + tb * 16;
  const bf16_t* Pg = (const bf16_t*)(p.ws + OFF_P) + (size_t)r0 * NINP + PC_POOL + gi * 64 + cq * 4;
  constexpr int NR = 15 + 2 * H;
  u2 xs[NR];
#pragma unroll
  for (int j = 0; j < NR; ++j) { const int tt = tbase - H + j; xs[j] = (tt >= 0 && tt < tlen) ? *(const u2*)(Pg + (size_t)tt * NINP) : (u2){0u, 0u}; }
#define PL_LO(w) __uint_as_float((w) << 16)
#define PL_HI(w) __uint_as_float((w) & 0xffff0000u)
  float s0 = 0.f, s1 = 0.f, s2 = 0.f, s3 = 0.f;
#pragma unroll
  for (int j = 0; j < 2 * H; ++j) { s0 += PL_LO(xs[j].x); s1 += PL_HI(xs[j].x); s2 += PL_LO(xs[j].y); s3 += PL_HI(xs[j].y); }
  char* drow = Dw + (tb * 16) * POOL_ROWB + cq * 8;
#pragma unroll
  for (int i = 0; i < 16; ++i) {
    const int t = tbase + i; const int lo = t - H < 0 ? 0 : t - H, hi = t + H > tlen ? tlen : t + H;
    const float inv = 1.f / (float)(hi - lo);
    const u2 c = xs[i + H];
    u2 w; w.x = gd::pk(s0 * inv - PL_LO(c.x), s1 * inv - PL_HI(c.x)); w.y = gd::pk(s2 * inv - PL_LO(c.y), s3 * inv - PL_HI(c.y));
    *(u2*)(drow + i * POOL_ROWB) = w;
    if (i < 15) { const u2 a = xs[i + 2 * H], b = xs[i];
      s0 += PL_LO(a.x) - PL_LO(b.x); s1 += PL_HI(a.x) - PL_HI(b.x); s2 += PL_LO(a.y) - PL_LO(b.y); s3 += PL_HI(a.y) - PL_HI(b.y); }
  }
#undef PL_LO
#undef PL_HI
  asm volatile("s_waitcnt lgkmcnt(0)" ::: "memory");
  const int r32 = lane & 31, hl = lane >> 5;
  f32x16 acc[2][2];
#pragma unroll
  for (int a = 0; a < 2; ++a)
#pragma unroll
    for (int b = 0; b < 2; ++b)
#pragma unroll
      for (int i = 0; i < 16; ++i) acc[a][b][i] = 0.f;
#pragma unroll
  for (int ks = 0; ks < 4; ++ks) {
    const bf16x8 a0 = *(const bf16x8*)(WTl + r32 * POOL_ROWB + ks * 32 + hl * 16), a1 = *(const bf16x8*)(WTl + (32 + r32) * POOL_ROWB + ks * 32 + hl * 16);
    const bf16x8 b0 = *(const bf16x8*)(Dw + r32 * POOL_ROWB + ks * 32 + hl * 16), b1 = *(const bf16x8*)(Dw + (32 + r32) * POOL_ROWB + ks * 32 + hl * 16);
    acc[0][0] = __builtin_amdgcn_mfma_f32_32x32x16_bf16(a0, b0, acc[0][0], 0, 0, 0); acc[0][1] = __builtin_amdgcn_mfma_f32_32x32x16_bf16(a0, b1, acc[0][1], 0, 0, 0);
    acc[1][0] = __builtin_amdgcn_mfma_f32_32x32x16_bf16(a1, b0, acc[1][0], 0, 0, 0); acc[1][1] = __builtin_amdgcn_mfma_f32_32x32x16_bf16(a1, b1, acc[1][1], 0, 0, 0);
  }
  const float* psc = p.pool_scale + l * 256 + gi * 64 + 4 * hl;
  bf16_t* cat = (bf16_t*)(p.ws + OFF_H) + (size_t)(r_first + r32) * D + 768 + gi * 64 + 4 * hl;
#pragma unroll
  for (int mt = 0; mt < 2; ++mt)
#pragma unroll
    for (int q = 0; q < 4; ++q) {
      const float4 s4 = *(const float4*)(psc + mt * 32 + q * 8);
#pragma unroll
      for (int nt = 0; nt < 2; ++nt) {
        u2 w; w.x = gd::pk(acc[mt][nt][4 * q] * s4.x, acc[mt][nt][4 * q + 1] * s4.y); w.y = gd::pk(acc[mt][nt][4 * q + 2] * s4.z, acc[mt][nt][4 * q + 3] * s4.w);
        *(u2*)(cat + (size_t)(nt * 32) * D + mt * 32 + q * 8) = w;
      }
    }
  asm volatile("s_waitcnt lgkmcnt(0)" ::: "memory");
}
__device__ __forceinline__ void ph_pool_mfma(const Params& p, int l, int nrows, char* smem) {
  const int TIDX = ltid(); const int BIDX = lbid();
  const int lane = TIDX & 63, wv = TIDX >> 6;
  const int gi = BIDX & 3;
  __syncthreads();
  {
    const float4* W = (const float4*)(p.pool_w + ((size_t)l * 4 + gi) * 4096);
    for (int i = TIDX; i < 1024; i += NT) { const float4 w = W[i]; const int c = i >> 4, o4 = (i & 15) * 4;
      bf16_t* dst = (bf16_t*)(smem + o4 * POOL_ROWB) + c;
      dst[0] = f2bf(w.x); dst[POOL_ROWB / 2] = f2bf(w.y); dst[POOL_ROWB] = f2bf(w.z); dst[3 * POOL_ROWB / 2] = f2bf(w.w); }
  }
  __syncthreads();
  char* Dw = smem + POOL_TILEB + wv * POOL_TILEB;
  const int ntiles = nrows >> 6;
  for (int tile = wv * ((int)gridDim.x >> 2) + (BIDX >> 2); tile < ntiles; tile += 8 * ((int)gridDim.x >> 2)) {
    if (gi == 0) pool_unit<1>(p, l, tile, 0, Dw, smem, lane); else if (gi == 1) pool_unit<2>(p, l, tile, 1, Dw, smem, lane);
    else if (gi == 2) pool_unit<4>(p, l, tile, 2, Dw, smem, lane); else pool_unit<8>(p, l, tile, 3, Dw, smem, lane);
  }
}
template <int MODE>
__device__ __forceinline__ void ph_gdnfin_pool_fast(const Params& p, int l, int nrows, float* lds, int b0, int nb) {
  const int TIDX = ltid(); const int BIDX = lbid() - b0;
  if (BIDX < 0) return;
  const int lane = TIDX & 63, wv = TIDX >> 6;
  float* Wl = lds; float* dsc = lds + 16384 + wv * 256;
  if (MODE == 1) {
    __syncthreads();
    for (int i = TIDX; i < 4096; i += NT) ((float4*)Wl)[i] = ((const float4*)(p.pool_w + (size_t)l * 16384))[i];
    __syncthreads();
  }
  const bf16_t* P = (const bf16_t*)(p.ws + OFF_P);
  const float* gn = p.gdn_norm_g + l * 128; const float* psc = p.pool_scale + l * 256;
  for (int r = BIDX + nb * wv; r < nrows; r += nb * 8) {
    int mj, t, tlen, r0; rowinfo(r, mj, t, tlen, r0);
    bf16_t* cat = (bf16_t*)(p.ws + OFF_H) + (size_t)r * D;
    const bf16_t* Pr = P + (size_t)r * NINP;
    if (MODE == 2 && r < ML) {
      const int hh = lane >> 4;
      float mp[2], lp[2], mx = -1e30f;
#pragma unroll
      for (int q = 0; q < 2; ++q) { const float2 ml = *(const float2*)((const float*)(p.ws + OFF_MLPART) + (((size_t)q * ML + r) * 4 + hh) * 2); mp[q] = ml.x; lp[q] = ml.y; mx = fmaxf(mx, ml.x); }
      float acc4[4] = {0.f, 0.f, 0.f, 0.f}, wsum = 0.f;
#pragma unroll
      for (int q = 0; q < 2; ++q) { const float w = lp[q] * __expf((mp[q] - mx) * fa::SCALE); wsum += w;
        const uint2 o = *(const uint2*)((const bf16_t*)(p.ws + OFF_OPART) + ((size_t)q * ML + r) * 256 + lane * 4);
        acc4[0] += w * __uint_as_float(o.x << 16); acc4[1] += w * __uint_as_float(o.x & 0xffff0000u); acc4[2] += w * __uint_as_float(o.y << 16); acc4[3] += w * __uint_as_float(o.y & 0xffff0000u); }
      const float inv = 1.f / wsum;
      uint2 w2; w2.x = gd::pk(acc4[0] * inv, acc4[1] * inv); w2.y = gd::pk(acc4[2] * inv, acc4[3] * inv);
      *(uint2*)(cat + lane * 4) = w2;
    }
    if (MODE == 2) {
      const uint4 a = *(const uint4*)(Pr + PC_OF + lane * 8), bq = *(const uint4*)(Pr + PC_OB + lane * 8), z = *(const uint4*)(Pr + PC_Z + lane * 8);
      const unsigned aw[4] = {a.x, a.y, a.z, a.w}, bw[4] = {bq.x, bq.y, bq.z, bq.w}, zw[4] = {z.x, z.y, z.z, z.w};
      float o[8], ss = 0.f;
#pragma unroll
      for (int i = 0; i < 4; ++i) { o[2 * i] = __uint_as_float(aw[i] << 16) + __uint_as_float(bw[i] << 16); o[2 * i + 1] = __uint_as_float(aw[i] & 0xffff0000u) + __uint_as_float(bw[i] & 0xffff0000u); }
#pragma unroll
      for (int i = 0; i < 8; ++i) ss += o[i] * o[i];
      ss += __shfl_xor(ss, 1); ss += __shfl_xor(ss, 2); ss += __shfl_xor(ss, 4); ss += __shfl_xor(ss, 8);
      const float rs = rsqrtf(ss / 128.f + EPS);
      float y[8];
#pragma unroll
      for (int i = 0; i < 4; ++i) { const float z0 = __uint_as_float(zw[i] << 16), z1 = __uint_as_float(zw[i] & 0xffff0000u);
        y[2 * i] = o[2 * i] * rs * gn[(lane & 15) * 8 + 2 * i] * silu_f(z0); y[2 * i + 1] = o[2 * i + 1] * rs * gn[(lane & 15) * 8 + 2 * i + 1] * silu_f(z1); }
      uint4 w; w.x = gd::pk(y[0], y[1]); w.y = gd::pk(y[2], y[3]); w.z = gd::pk(y[4], y[5]); w.w = gd::pk(y[6], y[7]);
      *(uint4*)(cat + 256 + lane * 8) = w;
    }
    if (MODE == 1) {
      const int gi = lane >> 4, win = 2 << gi;
      int lo = t - win / 2, hi = lo + win; lo = lo < 0 ? 0 : lo; hi = hi > tlen ? tlen : hi;
      float sm[4] = {0.f, 0.f, 0.f, 0.f};
      uint2 uw[16];
#pragma unroll
      for (int q = 0; q < 16; ++q) { const int tt = t - 8 + q; const bool ok = tt >= lo && tt < hi; uw[q] = ok ? *(const uint2*)(P + (size_t)(r0 + tt) * NINP + PC_POOL + lane * 4) : make_uint2(0u, 0u); }
#pragma unroll
      for (int q = 0; q < 16; ++q) { sm[0] += __uint_as_float(uw[q].x << 16); sm[1] += __uint_as_float(uw[q].x & 0xffff0000u); sm[2] += __uint_as_float(uw[q].y << 16); sm[3] += __uint_as_float(uw[q].y & 0xffff0000u); }
      const uint2 u = *(const uint2*)(Pr + PC_POOL + lane * 4); const float inv = 1.f / (float)(hi - lo);
      dsc[lane * 4 + 0] = sm[0] * inv - __uint_as_float(u.x << 16); dsc[lane * 4 + 1] = sm[1] * inv - __uint_as_float(u.x & 0xffff0000u);
      dsc[lane * 4 + 2] = sm[2] * inv - __uint_as_float(u.y << 16); dsc[lane * 4 + 3] = sm[3] * inv - __uint_as_float(u.y & 0xffff0000u);
      float4 acc = {0.f, 0.f, 0.f, 0.f};
      const float* wg = Wl + gi * 4096 + (lane & 15) * 4; const float* dg = dsc + gi * 64;
#pragma unroll 8
      for (int c = 0; c < 64; ++c) { const float dv = dg[c]; const float4 w4 = *(const float4*)(wg + c * 64); acc.x += dv * w4.x; acc.y += dv * w4.y; acc.z += dv * w4.z; acc.w += dv * w4.w; }
      const float4 s4 = *(const float4*)(psc + lane * 4);
      uint2 w; w.x = gd::pk(acc.x * s4.x, acc.y * s4.y); w.y = gd::pk(acc.z * s4.z, acc.w * s4.w);
      *(uint2*)(cat + 768 + lane * 4) = w;
    }
  }
}
__device__ __forceinline__ void ph_ada_fast(const Params& p, float* lds) {
  const int TIDX = ltid(); const int BIDX = lbid();
  const int cg = TIDX & 15, ksl = TIDX >> 4;
  for (int u = BIDX; u < 2 * 96; u += gridDim.x) {
    const int l = u / 96, n0 = (u % 96) * 64 + cg * 4;
    const float* w = p.ada_w + (size_t)l * D * 6144 + n0;
    float4 a0 = {0.f, 0.f, 0.f, 0.f}, a1 = a0, a2 = a0;
#pragma unroll 16
    for (int kk = 0; kk < 32; ++kk) { const int k = ksl * 32 + kk; typedef float f4v __attribute__((ext_vector_type(4))); const f4v w4 = __builtin_nontemporal_load((const f4v*)(w + (size_t)k * 6144));
      const float s0 = silu_f(p.c[k]), s1 = silu_f(p.c[D + k]), s2 = silu_f(p.c_ctx[k]);
      a0.x += s0 * w4.x; a0.y += s0 * w4.y; a0.z += s0 * w4.z; a0.w += s0 * w4.w;
      a1.x += s1 * w4.x; a1.y += s1 * w4.y; a1.z += s1 * w4.z; a1.w += s1 * w4.w;
      a2.x += s2 * w4.x; a2.y += s2 * w4.y; a2.z += s2 * w4.z; a2.w += s2 * w4.w; }
    __syncthreads();
    float4* red = (float4*)lds;
    red[(ksl * 3 + 0) * 16 + cg] = a0; red[(ksl * 3 + 1) * 16 + cg] = a1; red[(ksl * 3 + 2) * 16 + cg] = a2;
    __syncthreads();
    if (TIDX < 192) { const int j = TIDX / 64, c = TIDX % 64; const float* rf = lds;
      float a = p.ada_b[l * 6144 + (u % 96) * 64 + c];
      for (int q = 0; q < 32; ++q) a += rf[((q * 3 + j) * 16 + (c >> 2)) * 4 + (c & 3)];
      ((float*)(p.ws + OFF_MOD))[(size_t)(l * 3 + j) * 6144 + (u % 96) * 64 + c] = a; }
  }
}

__device__ __forceinline__ void ph_topk_fast(const Params& p, int nseq, char* smem) {
  const int TIDX = ltid(); const int BIDX = lbid();
  unsigned* keys = (unsigned*)smem;
  unsigned* hist = keys + 8192;
  unsigned* ctl = hist + 256;
  unsigned* scn = ctl + 8;
  for (int prob = BIDX; prob < nseq * NE; prob += gridDim.x) {
    const int s = prob >> 4, e = prob & 15;
    const int tlen = s < 2 ? T : TC, cap = s < 2 ? CAPL : CAPC, r0 = s < 2 ? s * T : ML + (s - 2) * TC;
    const float* a = (const float*)(p.ws + OFF_AFFT) + (size_t)e * MR + r0;
    __syncthreads();
    for (int i = TIDX; i < tlen; i += NT) keys[i] = __float_as_uint(a[i]);
    if (TIDX == 0) { ctl[0] = 0u; ctl[1] = (unsigned)cap; }
    __syncthreads();
    for (int pass = 0; pass < 4; ++pass) {
      const int shift = 24 - 8 * pass;
      if (TIDX < 256) hist[TIDX] = 0u;
      __syncthreads();
      const unsigned prefix = ctl[0], want = ctl[1];
      const unsigned himask = pass == 0 ? 0u : (0xffffffffu << (shift + 8));
      { unsigned cur = 0u, cnt = 0u;
        for (int i = TIDX; i < tlen; i += NT) { const unsigned k = keys[i];
          if ((k & himask) == prefix) { const unsigned dgt = (k >> shift) & 255u; if (dgt == cur) ++cnt; else { if (cnt) atomicAdd(&hist[cur], cnt); cur = dgt; cnt = 1u; } } }
        if (cnt) atomicAdd(&hist[cur], cnt); }
      __syncthreads();
      if (TIDX < 256) {
        const unsigned mine = hist[TIDX];
        unsigned inc = mine;
#pragma unroll
        for (int o = 1; o < 64; o <<= 1) { const unsigned n = __shfl_down(inc, o); if ((TIDX & 63) + o < 64) inc += n; }
        if ((TIDX & 63) == 0) scn[TIDX >> 6] = inc;
        __builtin_amdgcn_s_waitcnt(0);
      }
      __syncthreads();
      if (TIDX < 256) {
        const unsigned mine = hist[TIDX];
        unsigned inc = mine;
#pragma unroll
        for (int o = 1; o < 64; o <<= 1) { const unsigned n = __shfl_down(inc, o); if ((TIDX & 63) + o < 64) inc += n; }
        unsigned above = inc - mine;
        for (int w = (TIDX >> 6) + 1; w < 4; ++w) above += scn[w];
        if (above < want && above + mine >= want) { ctl[2] = prefix | ((unsigned)TIDX << shift); ctl[3] = want - above; }
      }
      __syncthreads();
      if (TIDX == 0) { ctl[0] = ctl[2]; ctl[1] = ctl[3]; }
      __syncthreads();
    }
    const unsigned thr = ctl[0], weq = ctl[1];
    const int per = tlen / NT > 0 ? tlen / NT : 1, nthr = tlen / per, t0 = TIDX * per;
    unsigned cnt = 0u;
    if (TIDX < nthr) for (int i = 0; i < per; ++i) { const unsigned k = keys[t0 + i]; cnt += (k > thr ? 0x10000u : 0u) + (k == thr ? 1u : 0u); }
    unsigned inc = cnt;
#pragma unroll
    for (int o = 1; o < 64; o <<= 1) { const unsigned n = __shfl_up(inc, o); if ((TIDX & 63) >= o) inc += n; }
    if ((TIDX & 63) == 63) scn[TIDX >> 6] = inc;
    __syncthreads();
    unsigned base = 0u;
    for (int w = 0; w < (TIDX >> 6); ++w) base += scn[w];
    unsigned run = base + inc - cnt;
    int* idx = (int*)(p.ws + OFF_IDX); float* gate = (float*)(p.ws + OFF_GATE); int* slot = (int*)(p.ws + OFF_SLOT);
    const int pb = pair_base(s, e);
    if (TIDX < nthr) for (int i = 0; i < per; ++i) {
      const unsigned k = keys[t0 + i]; const unsigned ngt = run >> 16, neq = run & 0xffffu;
      const unsigned eqtaken = neq < weq ? neq : weq;
      int sl = -1;
      if (k > thr) sl = (int)(ngt + eqtaken);
      else if (k == thr && neq < weq) sl = (int)(ngt + neq);
      if (sl >= 0) { idx[pb + sl] = r0 + t0 + i; gate[pb + sl] = __uint_as_float(k); }
      slot[(size_t)(r0 + t0 + i) * 16 + e] = sl;
      run += (k > thr ? 0x10000u : 0u) + (k == thr ? 1u : 0u);
    }
  }
}
__device__ __forceinline__ void ph_combine_fast(const Params& p, int l, int nrows, int next_l) {
  const int TIDX = ltid(); const int BIDX = lbid();
  const int lane = TIDX & 63, wv = TIDX >> 6;
  const bf16_t* Y = (const bf16_t*)(p.ws + OFF_Y);
  for (int r4 = (BIDX + gridDim.x * wv) * 4; r4 < nrows; r4 += gridDim.x * 8 * 4) {
    int mj, t, tlen, r0; rowinfo(r4, mj, t, tlen, r0);
    const int s = r4 < ML ? (r4 >> 13) : 2 + ((r4 - ML) >> 8);
    const int slot4 = ((const int*)(p.ws + OFF_SLOT))[(size_t)r4 * 16 + lane];
    const unsigned long long vm = __ballot(slot4 >= 0);
    const int pairl = pair_base(s, lane & 15) + slot4;
    float4 xv[4][4]; uint4 ya[4][2][2]; int nsel[4];
    float* xr[4];
#pragma unroll
    for (int rr = 0; rr < 4; ++rr) { xr[rr] = xrow(p, r4 + rr);
#pragma unroll
      for (int hf = 0; hf < 2; ++hf) { const uint4 xb4 = ld_nt_u4((const bf16_t*)xr[rr] + hf * 512 + lane * 8);
        xv[rr][hf * 2 + 0] = make_float4(__uint_as_float(xb4.x << 16), __uint_as_float(xb4.x & 0xffff0000u), __uint_as_float(xb4.y << 16), __uint_as_float(xb4.y & 0xffff0000u));
        xv[rr][hf * 2 + 1] = make_float4(__uint_as_float(xb4.z << 16), __uint_as_float(xb4.z & 0xffff0000u), __uint_as_float(xb4.w << 16), __uint_as_float(xb4.w & 0xffff0000u)); } }
#pragma unroll
    for (int rr = 0; rr < 4; ++rr) {
      unsigned m16 = (unsigned)(vm >> (rr * 16)) & 0xffffu; nsel[rr] = __builtin_popcount(m16);
#pragma unroll
      for (int k = 0; k < 2; ++k) {
        if (m16) { const int e = __builtin_ctz(m16); m16 &= m16 - 1; const int pr = __builtin_amdgcn_readlane(pairl, rr * 16 + e);
          const bf16_t* yr = Y + (size_t)pr * D; ya[rr][k][0] = ld_nt_u4(yr + lane * 8); ya[rr][k][1] = ld_nt_u4(yr + 512 + lane * 8); }
        else { ya[rr][k][0] = make_uint4(0u, 0u, 0u, 0u); ya[rr][k][1] = make_uint4(0u, 0u, 0u, 0u); }
      }
    }
    const float* g2 = modvec(p, l, mj, 5);
    float4 gq[4];
#pragma unroll
    for (int hf = 0; hf < 2; ++hf)
#pragma unroll
      for (int q = 0; q < 2; ++q) gq[hf * 2 + q] = *(const float4*)(g2 + hf * 512 + lane * 8 + q * 4);
    asm volatile("s_waitcnt vmcnt(0)" ::: "memory");
#pragma unroll
    for (int rr = 0; rr < 4; ++rr) {
      float acc[16];
#pragma unroll
      for (int i = 0; i < 16; ++i) acc[i] = 0.f;
#pragma unroll
      for (int k = 0; k < 2; ++k)
#pragma unroll
        for (int hf = 0; hf < 2; ++hf) { const unsigned w[4] = {ya[rr][k][hf].x, ya[rr][k][hf].y, ya[rr][k][hf].z, ya[rr][k][hf].w};
#pragma unroll
          for (int i = 0; i < 4; ++i) { acc[hf * 8 + 2 * i] += __uint_as_float(w[i] << 16); acc[hf * 8 + 2 * i + 1] += __uint_as_float(w[i] & 0xffff0000u); } }
      if (nsel[rr] > 2) {
        unsigned m16 = (unsigned)(vm >> (rr * 16)) & 0xffffu; m16 &= m16 - 1; m16 &= m16 - 1;
        while (m16) { const int e = __builtin_ctz(m16); m16 &= m16 - 1; const int pr = __builtin_amdgcn_readlane(pairl, rr * 16 + e);
          const bf16_t* yr = Y + (size_t)pr * D; const uint4 a = *(const uint4*)(yr + lane * 8), bq = *(const uint4*)(yr + 512 + lane * 8);
          const unsigned w[8] = {a.x, a.y, a.z, a.w, bq.x, bq.y, bq.z, bq.w};
#pragma unroll
          for (int i = 0; i < 8; ++i) { acc[2 * i] += __uint_as_float(w[i] << 16); acc[2 * i + 1] += __uint_as_float(w[i] & 0xffff0000u); } }
      }
      float x[16], ss = 0.f;
#pragma unroll
      for (int hf = 0; hf < 2; ++hf)
#pragma unroll
        for (int q = 0; q < 2; ++q) { const int c = hf * 512 + lane * 8 + q * 4; float4 xq = xv[rr][hf * 2 + q]; const float4 gv = gq[hf * 2 + q];
          xq.x += gv.x * acc[hf * 8 + q * 4 + 0]; xq.y += gv.y * acc[hf * 8 + q * 4 + 1]; xq.z += gv.z * acc[hf * 8 + q * 4 + 2]; xq.w += gv.w * acc[hf * 8 + q * 4 + 3];
          if (next_l >= 0) { uint2 xb2; xb2.x = gd::pk(xq.x, xq.y); xb2.y = gd::pk(xq.z, xq.w); *(uint2*)((bf16_t*)xr[rr] + c) = xb2; }
          else st_nt_f4(xr[rr] + c, xq);
          x[hf * 8 + q * 4 + 0] = xq.x; x[hf * 8 + q * 4 + 1] = xq.y; x[hf * 8 + q * 4 + 2] = xq.z; x[hf * 8 + q * 4 + 3] = xq.w;
          ss += xq.x * xq.x + xq.y * xq.y + xq.z * xq.z + xq.w * xq.w; }
      if (next_l >= 0) {
        ss = wave_sum(ss);
        const float rstd = rsqrtf(ss / D + EPS);
        const float* g = p.norm1_g + next_l * D; const float* sh = modvec(p, next_l, mj, 0); const float* sc = modvec(p, next_l, mj, 1);
        bf16_t* h = (bf16_t*)(p.ws + OFF_H) + (size_t)(r4 + rr) * D;
#pragma unroll
        for (int hf = 0; hf < 2; ++hf) { const int c = hf * 512 + lane * 8; float y[8];
#pragma unroll
          for (int i = 0; i < 8; ++i) y[i] = x[hf * 8 + i] * rstd * g[c + i] * (1.f + sc[c + i]) + sh[c + i];
          uint4 w; w.x = gd::pk(y[0], y[1]); w.y = gd::pk(y[2], y[3]); w.z = gd::pk(y[4], y[5]); w.w = gd::pk(y[6], y[7]);
          *(uint4*)(h + c) = w; }
      }
    }
  }
}
template <class RowPtr>
__device__ __forceinline__ gd::f32x4 coop_tile_32x64(RowPtr arow, const bf16_t* Bt, int ldb, int K, float* lds, int wv, int lane) {
  using gd::bf16x8; using gd::f32x4;
  const int cc = lane & 15, g = lane >> 4;
  const bf16_t* a0 = arow(cc) + g * 8; const bf16_t* a1 = arow(16 + cc) + g * 8;
  f32x4 acc[2][4];
#pragma unroll
  for (int m = 0; m < 2; ++m)
#pragma unroll
    for (int n = 0; n < 4; ++n) acc[m][n] = (f32x4){0.f, 0.f, 0.f, 0.f};
  for (int ks = wv; ks < K / 32; ks += 8) {
    const bf16x8 A0 = *(const bf16x8*)(a0 + ks * 32), A1 = *(const bf16x8*)(a1 + ks * 32);
#pragma unroll
    for (int n = 0; n < 4; ++n) { const bf16x8 B = *(const bf16x8*)(Bt + (size_t)(n * 16 + cc) * ldb + ks * 32 + g * 8);
      acc[0][n] = __builtin_amdgcn_mfma_f32_16x16x32_bf16(A0, B, acc[0][n], 0, 0, 0); acc[1][n] = __builtin_amdgcn_mfma_f32_16x16x32_bf16(A1, B, acc[1][n], 0, 0, 0); }
  }
  gd::lds_barrier();
#pragma unroll
  for (int m = 0; m < 2; ++m)
#pragma unroll
    for (int n = 0; n < 4; ++n) *(f32x4*)(lds + ((wv * 8 + m * 4 + n) * 64 + lane) * 4) = acc[m][n];
  gd::lds_barrier();
  f32x4 r = {0.f, 0.f, 0.f, 0.f};
#pragma unroll
  for (int w = 0; w < 8; ++w) r += *(const f32x4*)(lds + ((w * 8 + wv) * 64 + lane) * 4);
  return r;
}
__device__ __forceinline__ void ph_ctx_moe_gu(const Params& p, float* lds) {
  const int TIDX = ltid(); const int BIDX = lbid();
  const int lane = TIDX & 63, wv = TIDX >> 6, cc = lane & 15, g = lane >> 4;
  const bf16_t* H = (const bf16_t*)(p.ws + OFF_H); const bf16_t* GU = (const bf16_t*)(p.ws + OFF_MOEGU); bf16_t* hid = (bf16_t*)(p.ws + OFF_HID);
  const int* idx = (const int*)(p.ws + OFF_IDX);
  for (int it = BIDX; it < 32 * 16; it += gridDim.x) {
    const int grp = 32 + (it >> 4), ns = it & 15, s = grp >> 4, e = grp & 15, pb = pair_base(s, e);
    const gd::f32x4 v4 = coop_tile_32x64([&](int r) { return H + (size_t)idx[pb + r] * D; }, GU + (size_t)e * D * D + (size_t)(ns * 64) * D, D, D, lds, wv, lane);
    const int m = wv >> 2, n = wv & 3;
#pragma unroll
    for (int r = 0; r < 4; ++r) { const float v = v4[r], o = __shfl_xor(v, 1);
      if ((cc & 1) == 0) hid[(size_t)(pb + m * 16 + g * 4 + r) * DEXP + ((ns * 64 + n * 16 + cc) >> 1)] = f2bf(silu_f(v) * o); }
  }
}
__device__ __forceinline__ void ph_ctx_moe_down(const Params& p, float* lds) {
  const int TIDX = ltid(); const int BIDX = lbid();
  const int lane = TIDX & 63, wv = TIDX >> 6, cc = lane & 15, g = lane >> 4;
  const bf16_t* hid = (const bf16_t*)(p.ws + OFF_HID); const bf16_t* DN = (const bf16_t*)(p.ws + OFF_MOED); bf16_t* Y = (bf16_t*)(p.ws + OFF_Y);
  const float* gate = (const float*)(p.ws + OFF_GATE);
  for (int it = BIDX; it < 32 * 16; it += gridDim.x) {
    const int grp = 32 + (it >> 4), ns = it & 15, s = grp >> 4, e = grp & 15, pb = pair_base(s, e);
    const gd::f32x4 v4 = coop_tile_32x64([&](int r) { return hid + (size_t)(pb + r) * DEXP; }, DN + (size_t)e * D * DEXP + (size_t)(ns * 64) * DEXP, DEXP, DEXP, lds, wv, lane);
    const int m = wv >> 2, n = wv & 3;
#pragma unroll
    for (int r = 0; r < 4; ++r) { const int row = pb + m * 16 + g * 4 + r; Y[(size_t)row * D + ns * 64 + n * 16 + cc] = f2bf(v4[r] * gate[row]); }
  }
}
__device__ __forceinline__ void ph_ctx_outproj(const Params& p, int l, float* lds) {
  const int TIDX = ltid(); const int BIDX = lbid();
  const int lane = TIDX & 63, wv = TIDX >> 6, cc = lane & 15, g = lane >> 4;
  const bf16_t* A = (const bf16_t*)(p.ws + OFF_H) + (size_t)ML * D; const bf16_t* W = (const bf16_t*)(p.ws + OFF_WOUTT) + (size_t)l * D * D;
  bf16_t* yo = (bf16_t*)(p.ws + OFF_YO) + (size_t)ML * D;
  for (int it = BIDX; it < 16 * 16; it += gridDim.x) {
    const int mt = it >> 4, ns = it & 15;
    const gd::f32x4 v4 = coop_tile_32x64([&](int r) { return A + (size_t)(mt * 32 + r) * D; }, W + (size_t)(ns * 64) * D, D, D, lds, wv, lane);
    const int m = wv >> 2, n = wv & 3;
#pragma unroll
    for (int r = 0; r < 4; ++r) yo[(size_t)(mt * 32 + m * 16 + g * 4 + r) * D + ns * 64 + n * 16 + cc] = f2bf(v4[r]);
  }
}
__device__ __forceinline__ void ph_modulate2_fast(const Params& p, int l, int nrows, float* lds) {
  const int TIDX = ltid(); const int BIDX = lbid();
  const int lane = TIDX & 63, wv = TIDX >> 6;
  __syncthreads();
  { const float* wr = p.router + (size_t)l * D * NE;
    for (int i = TIDX; i < D * 4; i += NT) { const int c = i >> 2, q = i & 3, pr = (c & ~255) + (c & 3) * 64 + ((c >> 2) & 63);
      *(float4*)(lds + pr * 20 + q * 4) = *(const float4*)(wr + c * 16 + q * 4); } }
  __syncthreads();
  const float* g = p.norm2_g + l * D;
  for (int r4 = (BIDX + gridDim.x * wv) * 4; r4 < nrows; r4 += gridDim.x * 8 * 4) {
    int mj, t, tlen, r0; rowinfo(r4, mj, t, tlen, r0);
    const float* sh = modvec(p, l, mj, 3); const float* sc = modvec(p, l, mj, 4);
    float4 xv[4][4], gv[4], sv[4], hv[4];
#pragma unroll
    for (int rr = 0; rr < 4; ++rr) xv[rr][0] = xv[rr][1] = xv[rr][2] = xv[rr][3] = make_float4(0.f, 0.f, 0.f, 0.f);
    if (l == 0) {
#pragma unroll
      for (int rr = 0; rr < 4; ++rr) { const float* xr = xrow_src(p, r4 + rr, 0);
#pragma unroll
        for (int i = 0; i < 4; ++i) xv[rr][i] = ld_nt_f4(xr + i * 256 + lane * 4); }
    } else {
#pragma unroll
      for (int rr = 0; rr < 4; ++rr) { const bf16_t* xr = (const bf16_t*)xrow_src(p, r4 + rr, 1);
#pragma unroll
        for (int i = 0; i < 4; ++i) { const uint2 v = ld_nt_u2(xr + i * 256 + lane * 4);
          xv[rr][i] = make_float4(__uint_as_float(v.x << 16), __uint_as_float(v.x & 0xffff0000u), __uint_as_float(v.y << 16), __uint_as_float(v.y & 0xffff0000u)); } }
    }
    {
      const float* g1 = modvec(p, l, mj, 2); const bf16_t* yo = (const bf16_t*)(p.ws + OFF_YO);
#pragma unroll
      for (int i = 0; i < 4; ++i) { const int c = i * 256 + lane * 4; const float4 gg = *(const float4*)(g1 + c);
#pragma unroll
        for (int rr = 0; rr < 4; ++rr) { const uint2 yv = ld_nt_u2(yo + (size_t)(r4 + rr) * D + c);
          xv[rr][i].x += gg.x * __uint_as_float(yv.x << 16); xv[rr][i].y += gg.y * __uint_as_float(yv.x & 0xffff0000u);
          xv[rr][i].z += gg.z * __uint_as_float(yv.y << 16); xv[rr][i].w += gg.w * __uint_as_float(yv.y & 0xffff0000u);
          uint2 xb2; xb2.x = gd::pk(xv[rr][i].x, xv[rr][i].y); xb2.y = gd::pk(xv[rr][i].z, xv[rr][i].w);
          *(uint2*)((bf16_t*)xrow(p, r4 + rr) + c) = xb2; } }
    }
#pragma unroll
    for (int i = 0; i < 4; ++i) { const int c = i * 256 + lane * 4; gv[i] = *(const float4*)(g + c); sv[i] = *(const float4*)(sc + c); hv[i] = *(const float4*)(sh + c); }
#pragma unroll
    for (int rr = 0; rr < 4; ++rr) {
      const int r = r4 + rr;
      float ss = 0.f;
#pragma unroll
      for (int i = 0; i < 4; ++i) ss += xv[rr][i].x * xv[rr][i].x + xv[rr][i].y * xv[rr][i].y + xv[rr][i].z * xv[rr][i].z + xv[rr][i].w * xv[rr][i].w;
      ss = wave_sum(ss);
      const float rstd = rsqrtf(ss / D + EPS);
      bf16_t* h = (bf16_t*)(p.ws + OFF_H) + (size_t)r * D;
      float lo[16];
#pragma unroll
      for (int e = 0; e < 16; ++e) lo[e] = 0.f;
#pragma unroll
      for (int i = 0; i < 4; ++i) {
        const int c = i * 256 + lane * 4;
        float y[4];
        y[0] = xv[rr][i].x * rstd * gv[i].x * (1.f + sv[i].x) + hv[i].x; y[1] = xv[rr][i].y * rstd * gv[i].y * (1.f + sv[i].y) + hv[i].y;
        y[2] = xv[rr][i].z * rstd * gv[i].z * (1.f + sv[i].z) + hv[i].z; y[3] = xv[rr][i].w * rstd * gv[i].w * (1.f + sv[i].w) + hv[i].w;
        uint2 w; w.x = gd::pk(y[0], y[1]); w.y = gd::pk(y[2], y[3]);
        *(uint2*)(h + c) = w;
#pragma unroll
        for (int q = 0; q < 4; ++q) {
          const float* wrow = lds + (i * 256 + q * 64 + lane) * 20;
#pragma unroll
          for (int e4 = 0; e4 < 4; ++e4) { const float4 w4 = *(const float4*)(wrow + e4 * 4);
            lo[e4 * 4 + 0] += y[q] * w4.x; lo[e4 * 4 + 1] += y[q] * w4.y; lo[e4 * 4 + 2] += y[q] * w4.z; lo[e4 * 4 + 3] += y[q] * w4.w; }
        }
      }
#pragma unroll
      for (int k = 0; k < 4; ++k) {
        const int half = 8 >> k, mask = 32 >> k; const bool upper = (lane & mask) != 0;
#pragma unroll
        for (int i = 0; i < half; ++i) { const float send = upper ? lo[i] : lo[i + half]; const float recv = __shfl_xor(send, mask); lo[i] = (upper ? lo[i + half] : lo[i]) + recv; }
      }
      float v = lo[0]; v += __shfl_xor(v, 1); v += __shfl_xor(v, 2);
      float mx = v;
      mx = fmaxf(mx, __shfl_xor(mx, 4)); mx = fmaxf(mx, __shfl_xor(mx, 8)); mx = fmaxf(mx, __shfl_xor(mx, 16)); mx = fmaxf(mx, __shfl_xor(mx, 32));
      const float ex = expf(v - mx);
      float sm = ex; sm += __shfl_xor(sm, 4); sm += __shfl_xor(sm, 8); sm += __shfl_xor(sm, 16); sm += __shfl_xor(sm, 32);
      if ((lane & 3) == 0) { const int e = ((lane >> 5) & 1) * 8 + ((lane >> 4) & 1) * 4 + ((lane >> 3) & 1) * 2 + ((lane >> 2) & 1);
        ((float*)(p.ws + OFF_AFFT))[(size_t)e * MR + r] = ex / sm; }
    }
  }
}

__device__ __forceinline__ void ph_modulate1_fast(const Params& p) {
  const int TIDX = ltid(); const int BIDX = lbid();
  const int lane = TIDX & 63, wv = TIDX >> 6;
  const float* g = p.norm1_g;
  for (int r2 = (BIDX + gridDim.x * wv) * 2; r2 < MR; r2 += gridDim.x * 8 * 2) {
    int mj, t, tlen, r0; rowinfo(r2, mj, t, tlen, r0);
    const float* sh = modvec(p, 0, mj, 0); const float* sc = modvec(p, 0, mj, 1);
    float4 xv[2][4];
#pragma unroll
    for (int rr = 0; rr < 2; ++rr) { const float* xr = xrow_src(p, r2 + rr, 0);
#pragma unroll
      for (int i = 0; i < 4; ++i) xv[rr][i] = ld_nt_f4(xr + i * 256 + lane * 4); }
    float4 gv[4], sv[4], hv[4];
#pragma unroll
    for (int i = 0; i < 4; ++i) { const int c = i * 256 + lane * 4; gv[i] = *(const float4*)(g + c); sv[i] = *(const float4*)(sc + c); hv[i] = *(const float4*)(sh + c); }
#pragma unroll
    for (int rr = 0; rr < 2; ++rr) {
      float ss = 0.f;
#pragma unroll
      for (int i = 0; i < 4; ++i) ss += xv[rr][i].x * xv[rr][i].x + xv[rr][i].y * xv[rr][i].y + xv[rr][i].z * xv[rr][i].z + xv[rr][i].w * xv[rr][i].w;
      ss = wave_sum(ss);
      const float rstd = rsqrtf(ss / D + EPS);
      bf16_t* h = (bf16_t*)(p.ws + OFF_H) + (size_t)(r2 + rr) * D;
#pragma unroll
      for (int i = 0; i < 4; ++i) { const int c = i * 256 + lane * 4;
        uint2 w; w.x = gd::pk(xv[rr][i].x * rstd * gv[i].x * (1.f + sv[i].x) + hv[i].x, xv[rr][i].y * rstd * gv[i].y * (1.f + sv[i].y) + hv[i].y);
        w.y = gd::pk(xv[rr][i].z * rstd * gv[i].z * (1.f + sv[i].z) + hv[i].z, xv[rr][i].w * rstd * gv[i].w * (1.f + sv[i].w) + hv[i].w);
        *(uint2*)(h + c) = w; }
    }
  }
}

constexpr size_t LDS_BYTES = 163840;
__global__ void __launch_bounds__(NT, 2) mega(Params p) {
  extern __shared__ __attribute__((aligned(16))) char smem[];
  float* lds = (float*)smem;
  volatile LAS unsigned* xbst = (volatile LAS unsigned*)(smem + LDS_BYTES - 16);
  if (threadIdx.x == 0) { xbst[0] = 0u; xbst[1] = 0u; xbst[2] = 0u; xbst[3] = 0u; }
  __syncthreads();
  XcdBarrier xb = xcd_barrier_post((unsigned*)(p.ws + OFF_BAR), xbst);
  cg::grid_group grid = cg::this_grid();

  if (p.ws == nullptr) grid.sync();
  for (int l = 0; l < 2; ++l) {
    const bool need_ctx = l == 0;
    const int nrows = need_ctx ? MR : ML, nseq = need_ctx ? 4 : 2;
    if (l == 0) { ph_ada_fast(p, lds); ph_prep_weights(p, lds); xcd_barrier(xb); ph_modulate1_fast(p); xcd_barrier(xb); }
    for (int _r = 0; _r < REP_INPROJ; ++_r) ph_inproj_fast(p, l, smem);
    xcd_barrier(xb);
    { unsigned* bar = (unsigned*)(p.ws + OFF_BAR); unsigned* ctr = bar + 64 + 32 * l;
      ph_mla_gemm(p, l, smem);
      if (lbid() >= 32) handoff_publish(ctr);
      ph_gdn_precompute(p, l, smem);
      if (lbid() >= 32) { handoff_wait(ctr, gridDim.x - 32, bar); ph_mla_finish(p, l, lds); } }
    xcd_barrier(xb);
    for (int _r = 0; _r < REP_SCAN; ++_r) ph_scan_fast(p, smem);
    for (int _r = 0; _r < REP_ATTN; ++_r) ph_attn_fast(p, need_ctx, smem);
    ph_pool_mfma(p, l, nrows, smem);
    xcd_barrier(xb);
    ph_gdnfin_pool_fast<2>(p, l, nrows, lds, 0, (int)gridDim.x);
    xcd_barrier(xb);
    ph_outproj_fast(p, l, smem);
    if (need_ctx) ph_ctx_outproj(p, l, lds);
    xcd_barrier(xb);
    for (int _r = 0; _r < REP_MOD; ++_r) ph_modulate2_fast(p, l, nrows, lds);
    xcd_barrier(xb);
    for (int _r = 0; _r < REP_TOPK; ++_r) ph_topk_fast(p, nseq, smem);
    ph_prep_moe_weights(p, l, lds, 0, (int)gridDim.x);
    xcd_barrier(xb);
    for (int _r = 0; _r < REP_MOEGU; ++_r) ph_moe_gu_fast(p, smem);
    if (need_ctx) ph_ctx_moe_gu(p, lds);
    xcd_barrier(xb);
    ph_moe_down_fast(p, smem);
    if (need_ctx) ph_ctx_moe_down(p, lds);
    xcd_barrier(xb);
    ph_combine_fast(p, l, nrows, l == 0 ? 1 : -1);
    if (l == 0) xcd_barrier(xb);
  }
}

extern "C" void kernel_launch(void* const* d_in, const int* in_sizes, int n_in, void* d_out, int out_size, void* d_ws, size_t ws_size, hipStream_t stream) {
  static int grid_blocks = 0;
  if (ws_size < OFF_END) { fprintf(stderr, "kernel_launch: workspace too small: %zu < %zu\n", ws_size, (size_t)OFF_END); return; }
  if (!grid_blocks) {
    if (hipFuncSetAttribute((const void*)mega, hipFuncAttributeMaxDynamicSharedMemorySize, (int)LDS_BYTES) != hipSuccess) { fprintf(stderr, "kernel_launch: hipFuncSetAttribute failed\n"); return; }
    int dev = 0, cus = 0, per_cu = 0;
    hipGetDevice(&dev);
    hipDeviceGetAttribute(&cus, hipDeviceAttributeMultiprocessorCount, dev);
    hipOccupancyMaxActiveBlocksPerMultiprocessor(&per_cu, mega, NT, LDS_BYTES);
    if (per_cu < 1) { fprintf(stderr, "kernel_launch: occupancy query returned %d\n", per_cu); return; }
    grid_blocks = cus;
  }
  Params p{};
  const float** f = (const float**)&p;
  for (int i = 0; i < 26; ++i) f[i] = (const float*)d_in[i];
  p.out = (float*)d_out; p.ws = (char*)d_ws;
  hipMemsetAsync((char*)d_ws + OFF_BAR, 0, 16384, stream);
  void* args[] = {&p};
  hipError_t e = hipLaunchCooperativeKernel((const void*)mega, dim3(grid_blocks), dim3(NT), args, LDS_BYTES, stream);
  if (e != hipSuccess) fprintf(stderr, "cooperative launch failed: %s (grid %d)\n", hipGetErrorString(e), grid_blocks);
}
```

```cpp
#include <hip/hip_runtime.h>
#include <hip/hip_bf16.h>
#include <hip/hip_cooperative_groups.h>
#include <cstdint>
#include <cstdio>
namespace cg = cooperative_groups;
#define REP_SCAN 1
#define REP_ATTN 1
#define REP_PRE 1
#define REP_MLA 1
#define REP_PMW 1
#define REP_TOPK 1
#define REP_GATHER 1
#define REP_INPROJ 1
#define REP_MOEGU 1
#define REP_MOD 1
#define REP_FIN 1
#define REP_INIT 1

constexpr int D = 1024, NB = 2, T = 8192, TC = 256;
constexpr int ML = NB * T;
constexpr int MC = NB * TC;
constexpr int MR = ML + MC;
constexpr int NIN = 2672, NINP = 2816;
constexpr int NE = 16, DEXP = 512, CAPL = 1024, CAPC = 32;
constexpr int NPAIR = NB * NE * CAPL + NB * NE * CAPC;
constexpr int TK = TC + T;
constexpr float EPS = 1e-6f;
constexpr int NT = 512;
constexpr int PC_Q = 0, PC_KV = 192, PC_KR = 320, PC_GQ = 352, PC_GK = 864, PC_GV = 1376, PC_Z = 1888, PC_A = 2400, PC_B = 2408, PC_POOL = 2416;
constexpr int PC_OF = 352, PC_OB = 864;

typedef unsigned short bf16_t;
__device__ __forceinline__ float bf2f(bf16_t b) { return __uint_as_float(((unsigned)b) << 16); }
__device__ __forceinline__ bf16_t f2bf(float f) { unsigned u = __float_as_uint(f); u += 0x7FFFu + ((u >> 16) & 1u); return (bf16_t)(u >> 16); }
__device__ __forceinline__ float silu_f(float x) { return x * __builtin_amdgcn_rcpf(1.0f + __expf(-x)); }
__device__ __forceinline__ float sigmoid_f(float x) { return 1.0f / (1.0f + expf(-x)); }
__device__ __forceinline__ float softplus_f(float x) {
  if (x > 20.f) return x;
  const float y = __expf(x);
  return y < 0.0625f ? y * (1.f - y * (0.5f - y * (0.333333343f - 0.25f * y))) : __logf(1.f + y);
}

typedef float f4v_t __attribute__((ext_vector_type(4))); typedef unsigned u2v_t __attribute__((ext_vector_type(2))); typedef unsigned u4v_t __attribute__((ext_vector_type(4)));
__device__ __forceinline__ float4 ld_nt_f4(const float* q) { const f4v_t v = __builtin_nontemporal_load((const f4v_t*)q); return make_float4(v[0], v[1], v[2], v[3]); }
__device__ __forceinline__ uint2 ld_nt_u2(const void* q) { const u2v_t v = __builtin_nontemporal_load((const u2v_t*)q); return make_uint2(v[0], v[1]); }
__device__ __forceinline__ uint4 ld_nt_u4(const void* q) { const u4v_t v = __builtin_nontemporal_load((const u4v_t*)q); return make_uint4(v[0], v[1], v[2], v[3]); }
__device__ __forceinline__ void st_nt_f4(float* q, const float4 v) { const f4v_t w = {v.x, v.y, v.z, v.w}; __builtin_nontemporal_store(w, (f4v_t*)q); }
constexpr size_t al256(size_t x) { return (x + 255) / 256 * 256; }
constexpr size_t OFF_BAR = 0;
constexpr size_t OFF_MOD = 16384;
constexpr size_t OFF_XC = al256(OFF_MOD + 2 * 3 * 6144 * 4);
constexpr size_t OFF_AFFT = al256(OFF_XC + (size_t)MC * D * 4);
constexpr size_t OFF_IDX = al256(OFF_AFFT + (size_t)NE * MR * 4);
constexpr size_t OFF_GATE = al256(OFF_IDX + (size_t)NPAIR * 4);
constexpr size_t OFF_SLOT = al256(OFF_GATE + (size_t)NPAIR * 4);
constexpr size_t OFF_GB = al256(OFF_SLOT + (size_t)MR * 16 * 4);
constexpr size_t OFF_H = al256(OFF_GB + (size_t)MR * 16 * 4);
constexpr size_t OFF_P = al256(OFF_H + (size_t)MR * D * 2);
constexpr size_t OFF_RB = al256(OFF_P + (size_t)MR * NINP * 2);
constexpr size_t RB_BYTES = (size_t)1056 * 100352;
constexpr size_t OFF_QKV = al256(OFF_RB + RB_BYTES);
constexpr size_t QK_ELEMS = (size_t)NB * 4 * TK * 128, V_ELEMS = (size_t)NB * 4 * TK * 64;
constexpr size_t OFF_WINT = al256(OFF_QKV + (2 * QK_ELEMS + V_ELEMS) * 2);
constexpr size_t OFF_WOUTT = al256(OFF_WINT + (size_t)2 * NINP * D * 2);
constexpr size_t OFF_WUP = al256(OFF_WOUTT + (size_t)2 * D * D * 2);
constexpr size_t OFF_MOEGU = al256(OFF_WUP + (size_t)2 * 1024 * 256 * 2);
constexpr size_t OFF_MOED = OFF_MOEGU + (size_t)NE * D * D * 2;
constexpr size_t OFF_POOLWT = al256(OFF_MOED + (size_t)NE * D * DEXP * 2);
constexpr size_t OFF_END = OFF_POOLWT + (size_t)2 * 4 * 64 * 64 * 2;
constexpr size_t OFF_UPRAW = OFF_MOEGU;
constexpr size_t OFF_OPART = OFF_MOEGU;
constexpr size_t OFF_MLPART = OFF_OPART + (size_t)4 * ML * 256 * 2;
static_assert(OFF_MLPART + (size_t)4 * ML * 4 * 2 * 4 <= OFF_END, "partials must fit in the MoE weight region");
constexpr size_t OFF_HID = OFF_RB + (size_t)64 * 1024 * 1024;
constexpr size_t OFF_Y = OFF_P;
constexpr size_t OFF_YO = OFF_P;
constexpr size_t OFF_XS = OFF_P;


struct Params {
  const float* x; const float* c; const float* ctx; const float* c_ctx; const float* ada_w; const float* ada_b;
  const float* norm1_g; const float* norm2_g; const float* w_in; const float* q_a_norm; const float* w_uq; const float* kv_a_norm;
  const float* w_ukv; const float* q_norm; const float* k_norm; const float* conv_w; const float* a_log; const float* dt_bias;
  const float* gdn_norm_g; const float* pool_w; const float* pool_scale; const float* w_out; const float* router;
  const float* w_gate; const float* w_up; const float* w_down;
  float* out; char* ws;
};

__device__ __forceinline__ const float* xrow_src(const Params& p, int r, int l) { return l == 0 ? (r < ML ? p.x + (size_t)r * D : p.ctx + (size_t)(r - ML) * D) : (r < ML ? p.out + (size_t)r * D : (const float*)(p.ws + OFF_XC) + (size_t)(r - ML) * D); }
__device__ __forceinline__ float* xrow(const Params& p, int r) { return r < ML ? p.out + (size_t)r * D : (float*)(p.ws + OFF_XC) + (size_t)(r - ML) * D; }
__device__ __forceinline__ void rowinfo(int r, int& mj, int& t, int& tlen, int& r0) {
  if (r < ML) { mj = r >> 13; t = r & (T - 1); tlen = T; r0 = r - t; } else { int rc = r - ML; mj = 2; t = rc & (TC - 1); tlen = TC; r0 = r - t; }
}
__device__ __forceinline__ const float* modvec(const Params& p, int l, int mj, int chunk) { return (const float*)(p.ws + OFF_MOD) + ((size_t)(l * 3 + mj) * 6 + chunk) * D; }
__device__ __forceinline__ int pair_base(int s, int e) { return s < 2 ? (s * NE + e) * CAPL : NB * NE * CAPL + ((s - 2) * NE + e) * CAPC; }
__device__ __forceinline__ float wave_sum(float v) { for (int o = 32; o > 0; o >>= 1) v += __shfl_xor(v, o); return v; }

__device__ __forceinline__ int ltid() { int t = threadIdx.x; asm volatile("" : "+v"(t)); return t; }
__device__ __forceinline__ int lbid() { int t = blockIdx.x; asm volatile("" : "+s"(t)); return t; }
#define XB_TMO      128
#define XB_XCNT(j)  (256  + 64 * (j))
#define XB_XSUB(j)  (1280 + 64 * (j))
#define XB_XGEN(j)  (2304 + 64 * (j))
#define XB_TOP      3328
#define XB_TOPGEN   3392
#define XCD_BAR_WORDS 3456
#define XB_SPIN_CAP (1u << 22)
#define LAS __attribute__((address_space(3)))
__device__ __forceinline__ unsigned xb_ld(unsigned* p)              { return __hip_atomic_load(p, __ATOMIC_RELAXED, __HIP_MEMORY_SCOPE_AGENT); }
__device__ __forceinline__ unsigned xb_add(unsigned* p, unsigned v) { return __hip_atomic_fetch_add(p, v, __ATOMIC_RELAXED, __HIP_MEMORY_SCOPE_AGENT); }
__device__ __forceinline__ unsigned xb_xcc_id() { return (unsigned)__builtin_amdgcn_s_getreg((3 << 11) | 20) & 0xFu; }
#define XB_SPIN(cond, bar) do { unsigned _sp = 0; while (cond) { __builtin_amdgcn_s_sleep(1); \
    if ((++_sp & 255u) == 0u) { if (xb_ld(&(bar)[XB_TMO])) break; if (_sp > XB_SPIN_CAP) { atomicAdd(&(bar)[XB_TMO], 1u); break; } } } } while (0)
struct XcdBarrier { unsigned* bar; unsigned x; volatile LAS unsigned* st; };
__device__ __forceinline__ XcdBarrier xcd_barrier_post(unsigned* bar, volatile LAS unsigned* st) {
  XcdBarrier b; b.bar = bar; b.x = xb_xcc_id(); b.st = st;
  if (threadIdx.x == 0) (void)xb_add(&bar[XB_XCNT(b.x)], 1u);
  return b;
}
__device__ __forceinline__ void xcd_barrier_complete(unsigned* bar, unsigned x, unsigned& nloc, unsigned& nx) {
  const unsigned G = gridDim.x * gridDim.y * gridDim.z;
  unsigned sum, cnt, mine, sp = 0u;
  for (;;) {
    sum = 0u; cnt = 0u; mine = 0u;
#pragma unroll
    for (unsigned j = 0; j < 16; ++j) { const unsigned c = xb_ld(&bar[XB_XCNT(j)]); sum += c; cnt += (c > 0u) ? 1u : 0u; mine = (j == x) ? c : mine; }
    if (sum == G) break;
    __builtin_amdgcn_s_sleep(1);
    if ((++sp & 255u) == 0u) { if (xb_ld(&bar[XB_TMO])) break; if (sp > XB_SPIN_CAP) { atomicAdd(&bar[XB_TMO], 1u); break; } }
  }
  nloc = mine > 0u ? mine : 1u; nx = cnt > 0u ? cnt : 1u;
}
__device__ __forceinline__ void xcd_barrier_lane0(const XcdBarrier& b) {
  {
    unsigned* bar = b.bar;
    __builtin_amdgcn_s_waitcnt(0);
    asm volatile("buffer_inv sc1" ::: "memory");
    unsigned nloc = b.st[0], nx = b.st[1];
    if (nloc == 0u) { xcd_barrier_complete(bar, b.x, nloc, nx); b.st[0] = nloc; b.st[1] = nx; }
    const unsigned old = xb_add(&bar[XB_XSUB(b.x)], 1u);
    const unsigned gen = old / nloc;
    if (old + 1u == (gen + 1u) * nloc) {
      __builtin_amdgcn_fence(__ATOMIC_RELEASE, "agent");
      asm volatile("s_waitcnt vmcnt(0)" ::: "memory");
      const unsigned og = xb_add(&bar[XB_TOP], 1u);
      const unsigned tg = og / nx;
      if (og + 1u == (tg + 1u) * nx) xb_add(&bar[XB_TOPGEN], 1u);
      else XB_SPIN(xb_ld(&bar[XB_TOPGEN]) == tg, bar);
      xb_add(&bar[XB_XGEN(b.x)], 1u);
      asm volatile("s_waitcnt vmcnt(0)" ::: "memory");
    } else {
      XB_SPIN(xb_ld(&bar[XB_XGEN(b.x)]) == gen, bar);
      asm volatile("s_waitcnt vmcnt(0)" ::: "memory");
    }
  }
}
__device__ __forceinline__ void xcd_barrier(const XcdBarrier& b) {
  asm volatile("s_waitcnt vmcnt(0)" ::: "memory");
  __syncthreads();
  if (threadIdx.x == 0) xcd_barrier_lane0(b);
  __syncthreads();
}
template <class F>
__device__ __forceinline__ void xcd_barrier_overlap(const XcdBarrier& b, F side) {
  asm volatile("s_waitcnt vmcnt(0)" ::: "memory");
  __syncthreads();
  const int tl = ltid();
  if (tl < 64) { if (tl == 0) xcd_barrier_lane0(b); }
  else side(tl - 64, NT - 64);
  __syncthreads();
}


namespace pg8 {
#define PG8_LAS __attribute__((address_space(3)))
typedef short bf16x8 __attribute__((ext_vector_type(8)));
typedef float f32x4 __attribute__((ext_vector_type(4)));
typedef unsigned u32x4 __attribute__((ext_vector_type(4)));
constexpr int BM = 256, BK = 64, HALF = 128, HTB = HALF * BK * 2, STAGE_BYTES = 8 * HTB, NXCD = 8, WGM = 8;
__host__ __device__ __forceinline__ int lds_byte(int r, int c) { const int st = (r >> 4) * 2 + (c >> 5), rr = r & 15, cc = c & 31, ob = rr * 64 + cc * 2; return st * 1024 + (ob ^ (((ob >> 9) & 1) << 5)); }
__host__ __device__ __forceinline__ void stage_rc(int b, int& R, int& C) { const int st = b / 1024, sb = b % 1024, swz = sb ^ (((sb >> 9) & 1) << 5); R = (st >> 1) * 16 + swz / 64; C = (st & 1) * 32 + (swz % 64) / 2; }
__host__ __device__ __forceinline__ int perm32(int rho) { const int n = rho >> 4, i = rho & 15; return 8 * (i >> 2) + 4 * n + (i & 3); }
struct Unit { int pm, pn; };
__device__ __forceinline__ unsigned cvt_pk_bf16(float lo, float hi) { unsigned r; asm volatile("v_cvt_pk_bf16_f32 %0, %1, %2" : "=v"(r) : "v"(lo), "v"(hi)); return r; }
struct GridOrder {
  int nM, nN, nwg, G, c;
  __device__ __forceinline__ void init(int nM_, int nN_, int G_, int c_) { nM = nM_; nN = nN_; nwg = nM * nN; G = G_; c = c_; }
  __device__ __forceinline__ bool next(int i, Unit& u) const {
    const long L = (long)i * G + c; if (L >= nwg) return false;
    int wgid = (int)L; { const int q = nwg / NXCD, r = nwg % NXCD, xcd = wgid % NXCD, off = wgid / NXCD; wgid = (xcd < r ? xcd * (q + 1) : r * (q + 1) + (xcd - r) * q) + off; }
    const int nig = WGM * nN, gid = wgid / nig, fm = gid * WGM, gsz = (nM - fm) < WGM ? (nM - fm) : WGM;
    u.pm = fm + ((wgid % nig) % gsz); u.pn = (wgid % nig) / gsz; return true;
  }
};
template <class Epi, class Sched, bool GATHER = false>
__device__ __forceinline__ void gemm_phase(PG8_LAS unsigned char* lds, const Sched& S, const Epi& E) {
  const int tid = ltid(), wid = __builtin_amdgcn_readfirstlane(tid >> 6), lane = tid & 63, wr = wid >> 2, wc = wid & 3, fr = lane & 15, fq = lane >> 4;
  const int K = S.K, nt = K / BK;
  unsigned voffA[2], voffB[2]; int RA[2], CA[2];
#pragma unroll
  for (int i = 0; i < 2; ++i) { int R, C; stage_rc(tid * 16 + i * 8192, R, C); const int Rb = Epi::PERM ? ((R & ~31) + perm32(R & 31)) : R;
    voffA[i] = (unsigned)(R * S.lda + C) * 2u; voffB[i] = (unsigned)(Rb * S.ldb + C) * 2u; RA[i] = R; CA[i] = C; }
  const size_t kstep = (size_t)(BK * 2);
  const size_t hstepA = GATHER ? 0 : (size_t)HALF * S.lda * 2, hstepB = (size_t)HALF * S.ldb * 2;
  unsigned vc[2][2], vn[2][2];
#define PG8_GOFF(dst, unit) do { if (GATHER) { _Pragma("unroll") for (int _h = 0; _h < 2; ++_h) _Pragma("unroll") for (int _i = 0; _i < 2; ++_i) \
    dst[_h][_i] = (unsigned)(S.gidx[(unit).pm * 256 + _h * HALF + RA[_i]] * S.lda + CA[_i]) * 2u; } } while (0)
#define PG8_STAGE_A(bufoff, gbase, half, usenext) do { if (GATHER) { unsigned _v[2] = {(usenext) ? vn[half][0] : vc[half][0], (usenext) ? vn[half][1] : vc[half][1]}; PG8_STAGE(bufoff, gbase, _v); } \
    else PG8_STAGE(bufoff, gbase, voffA); } while (0)
  const unsigned ldsw = (unsigned)wid * 1024u;
  const int aoff = lds_byte(wr * 64 + fr, fq * 8), boff = lds_byte(wc * 32 + fr, fq * 8);
#define PG8_SA(b, h) (((b) * 2 + (h)) * HTB)
#define PG8_SB(b, h) ((4 + (b) * 2 + (h)) * HTB)
#define PG8_STAGE(bufoff, gbase, voff) do { _Pragma("unroll") for (int _i = 0; _i < 2; ++_i) \
    __builtin_amdgcn_global_load_lds((const unsigned*)((const char*)(gbase) + (voff)[_i]), (PG8_LAS unsigned*)(lds + (bufoff) + ldsw + _i * 8192), 16, 0, 0); } while (0)
#define PG8_LDA(dst, b, h) do { _Pragma("unroll") for (int m = 0; m < 4; ++m) _Pragma("unroll") for (int k = 0; k < 2; ++k) dst[m][k] = *(const PG8_LAS bf16x8*)(lds + PG8_SA(b, h) + aoff + m * 2048 + k * 1024); } while (0)
#define PG8_LDB(dst, b, h) do { _Pragma("unroll") for (int n = 0; n < 2; ++n) _Pragma("unroll") for (int k = 0; k < 2; ++k) dst[n][k] = *(const PG8_LAS bf16x8*)(lds + PG8_SB(b, h) + boff + n * 2048 + k * 1024); } while (0)
#define PG8_MMA(ai, bj, At, Bt) do { __builtin_amdgcn_s_setprio(1); _Pragma("unroll") for (int m = 0; m < 4; ++m) _Pragma("unroll") for (int n = 0; n < 2; ++n) _Pragma("unroll") for (int k = 0; k < 2; ++k) \
    acc[ai][bj][m][n] = __builtin_amdgcn_mfma_f32_16x16x32_bf16(Bt[n][k], At[m][k], acc[ai][bj][m][n], 0, 0, 0); __builtin_amdgcn_s_setprio(0); } while (0)
#define PG8_WAIT_V(n) asm volatile("s_waitcnt vmcnt(" #n ")" ::: "memory")
#define PG8_WAIT_L(n) asm volatile("s_waitcnt lgkmcnt(" #n ")" ::: "memory")
#define PG8_BAR __builtin_amdgcn_s_barrier()
#define PG8_SCHED __builtin_amdgcn_sched_barrier(0)
  Unit cur, nxt; int ui = 0;
  if (!S.next(0, cur)) return;
  f32x4 acc[2][2][4][2];
#pragma unroll
  for (int a = 0; a < 2; ++a)
#pragma unroll
    for (int b = 0; b < 2; ++b)
#pragma unroll
      for (int m = 0; m < 4; ++m)
#pragma unroll
        for (int n = 0; n < 2; ++n) acc[a][b][m][n] = (f32x4){0.f, 0.f, 0.f, 0.f};
  bf16x8 At[4][2], B0[2][2], B1[2][2];
  const char* cA = S.a_ptr(cur); const char* cB = S.b_ptr(cur);
  PG8_GOFF(vc, cur);
  PG8_STAGE(PG8_SB(0, 0), cB, voffB); PG8_STAGE_A(PG8_SA(0, 0), cA, 0, false); PG8_STAGE(PG8_SB(0, 1), cB + hstepB, voffB); PG8_STAGE_A(PG8_SA(0, 1), cA + hstepA, 1, false);
  if (wr == 1) PG8_BAR;
  PG8_WAIT_V(4); PG8_BAR;
  PG8_STAGE(PG8_SB(1, 0), cB + kstep, voffB); PG8_STAGE_A(PG8_SA(1, 0), cA + kstep, 0, false); PG8_STAGE(PG8_SB(1, 1), cB + hstepB + kstep, voffB);
  PG8_WAIT_V(6); PG8_BAR;
  for (;;) {
    const bool has_next = S.next(ui + 1, nxt);
    const char* nA = has_next ? S.a_ptr(nxt) : cA; const char* nB = has_next ? S.b_ptr(nxt) : cB;
    if (has_next) PG8_GOFF(vn, nxt); else { _Pragma("unroll") for (int _h = 0; _h < 2; ++_h) _Pragma("unroll") for (int _i = 0; _i < 2; ++_i) vn[_h][_i] = vc[_h][_i]; }
    for (int t = 0; t < nt; t += 2) {
      const bool last = (t == nt - 2);
      const char* a1 = cA + (size_t)(t + 1) * kstep;
      const char* a2 = last ? nA : cA + (size_t)(t + 2) * kstep; const char* b2 = last ? nB : cB + (size_t)(t + 2) * kstep;
      const char* a3 = a2 + kstep; const char* b3 = b2 + kstep;
      PG8_LDB(B0, 0, 0); PG8_SCHED; PG8_LDA(At, 0, 0); PG8_STAGE_A(PG8_SA(1, 1), a1 + hstepA, 1, false);
      PG8_WAIT_L(8); PG8_BAR; PG8_WAIT_L(0); PG8_MMA(0, 0, At, B0); PG8_BAR; PG8_SCHED;
      PG8_LDB(B1, 0, 1); PG8_STAGE(PG8_SB(0, 0), b2, voffB);
      PG8_BAR; PG8_WAIT_L(0); PG8_MMA(0, 1, At, B1); PG8_BAR;
      PG8_LDA(At, 0, 1); PG8_STAGE_A(PG8_SA(0, 0), a2, 0, last);
      PG8_BAR; PG8_WAIT_L(0); PG8_MMA(1, 0, At, B0); PG8_BAR; PG8_SCHED;
      PG8_STAGE(PG8_SB(0, 1), b2 + hstepB, voffB);
      PG8_WAIT_V(6); PG8_BAR; PG8_MMA(1, 1, At, B1); PG8_BAR;
      PG8_LDB(B0, 1, 0); PG8_SCHED; PG8_LDA(At, 1, 0); PG8_STAGE_A(PG8_SA(0, 1), a2 + hstepA, 1, last);
      PG8_WAIT_L(8); PG8_BAR; PG8_WAIT_L(0); PG8_MMA(0, 0, At, B0); PG8_BAR; PG8_SCHED;
      PG8_LDB(B1, 1, 1); PG8_STAGE(PG8_SB(1, 0), b3, voffB);
      PG8_BAR; PG8_WAIT_L(0); PG8_MMA(0, 1, At, B1); PG8_BAR;
      PG8_LDA(At, 1, 1); PG8_STAGE_A(PG8_SA(1, 0), a3, 0, last);
      PG8_BAR; PG8_WAIT_L(0); PG8_MMA(1, 0, At, B0); PG8_BAR; PG8_SCHED;
      PG8_STAGE(PG8_SB(1, 1), b3 + hstepB, voffB);
      PG8_WAIT_V(6); PG8_BAR; PG8_MMA(1, 1, At, B1); PG8_BAR;
    }
    E(acc, cur, wr, wc, fr, fq);
    if (!has_next) break;
#pragma unroll
    for (int a = 0; a < 2; ++a)
#pragma unroll
      for (int b = 0; b < 2; ++b)
#pragma unroll
        for (int m = 0; m < 4; ++m)
#pragma unroll
          for (int n = 0; n < 2; ++n) acc[a][b][m][n] = (f32x4){0.f, 0.f, 0.f, 0.f};
    cur = nxt; cA = nA; cB = nB; ++ui;
    _Pragma("unroll") for (int _h = 0; _h < 2; ++_h) _Pragma("unroll") for (int _i = 0; _i < 2; ++_i) vc[_h][_i] = vn[_h][_i];
  }
  PG8_WAIT_V(0);
  if (wr == 0) PG8_BAR;
  PG8_BAR;
#undef PG8_SA
#undef PG8_SB
#undef PG8_STAGE
#undef PG8_STAGE_A
#undef PG8_GOFF
#undef PG8_LDA
#undef PG8_LDB
#undef PG8_MMA
#undef PG8_WAIT_V
#undef PG8_WAIT_L
#undef PG8_BAR
#undef PG8_SCHED
}
}

struct DenseSched : pg8::GridOrder {
  const char* A; const char* Bt; int lda, ldb, K; const int* gidx;
  __device__ __forceinline__ const char* a_ptr(const pg8::Unit& u) const { return A + (size_t)u.pm * 256 * lda * 2; }
  __device__ __forceinline__ const char* b_ptr(const pg8::Unit& u) const { return Bt + (size_t)u.pn * 256 * ldb * 2; }
};
struct EpiStoreBf16 {
  static constexpr bool PERM = true, AFTER_DRAIN = false;
  bf16_t* O; int ldc;
  __device__ __forceinline__ void operator()(const pg8::f32x4 (&acc)[2][2][4][2], const pg8::Unit& u, int wr, int wc, int fr, int fq) const {
    const int row0 = u.pm * 256 + wr * 64 + fr, col0 = u.pn * 256 + wc * 32 + 8 * fq;
#pragma unroll
    for (int ai = 0; ai < 2; ++ai)
#pragma unroll
      for (int m = 0; m < 4; ++m) { bf16_t* rowp = O + (size_t)(row0 + ai * 128 + m * 16) * ldc + col0;
#pragma unroll
        for (int bj = 0; bj < 2; ++bj) { const pg8::f32x4 v0 = acc[ai][bj][m][0], v1 = acc[ai][bj][m][1];
          pg8::u32x4 w; w.x = pg8::cvt_pk_bf16(v0[0], v0[1]); w.y = pg8::cvt_pk_bf16(v0[2], v0[3]); w.z = pg8::cvt_pk_bf16(v1[0], v1[1]); w.w = pg8::cvt_pk_bf16(v1[2], v1[3]);
          *(pg8::u32x4*)(rowp + bj * 128) = w; } }
  }
};
struct EpiStoreBf16WT {
  static constexpr bool PERM = true, AFTER_DRAIN = false;
  bf16_t* O; int ldc;
  __device__ __forceinline__ void operator()(const pg8::f32x4 (&acc)[2][2][4][2], const pg8::Unit& u, int wr, int wc, int fr, int fq) const {
    const int row0 = u.pm * 256 + wr * 64 + fr, col0 = u.pn * 256 + wc * 32 + 8 * fq;
    const __amdgpu_buffer_rsrc_t rs = __builtin_amdgcn_make_buffer_rsrc(O, 0, 0x7fffffff, 0x00020000);
#pragma unroll
    for (int ai = 0; ai < 2; ++ai)
#pragma unroll
      for (int m = 0; m < 4; ++m) { const unsigned ro = (unsigned)((row0 + ai * 128 + m * 16) * ldc + col0) * 2u;
#pragma unroll
        for (int bj = 0; bj < 2; ++bj) { const pg8::f32x4 v0 = acc[ai][bj][m][0], v1 = acc[ai][bj][m][1];
          pg8::u32x4 w; w.x = pg8::cvt_pk_bf16(v0[0], v0[1]); w.y = pg8::cvt_pk_bf16(v0[2], v0[3]); w.z = pg8::cvt_pk_bf16(v1[0], v1[1]); w.w = pg8::cvt_pk_bf16(v1[2], v1[3]);
          __builtin_amdgcn_raw_buffer_store_b128(w, rs, (int)(ro + bj * 256), 0, 16); } }
  }
};
struct EpiResidual {
  static constexpr bool PERM = false, AFTER_DRAIN = false;
  float* xl; float* xc; const float* mod;
  int chunk;
  __device__ __forceinline__ void operator()(const pg8::f32x4 (&acc)[2][2][4][2], const pg8::Unit& u, int wr, int wc, int fr, int fq) const {
    const int mj = u.pm < 32 ? 0 : (u.pm < 64 ? 1 : 2);
    float* base = u.pm < 64 ? xl + (size_t)u.pm * 256 * D : xc + (size_t)(u.pm - 64) * 256 * D;
    const float* gv = mod + ((size_t)mj * 6 + chunk) * D;
    const int row0 = wr * 64 + fr, col0 = u.pn * 256 + wc * 32 + 4 * fq;
#pragma unroll
    for (int bj = 0; bj < 2; ++bj)
#pragma unroll
      for (int n = 0; n < 2; ++n) {
        const pg8::f32x4 g = *(const pg8::f32x4*)(gv + col0 + bj * 128 + n * 16);
#pragma unroll
        for (int ai = 0; ai < 2; ++ai)
#pragma unroll
          for (int m = 0; m < 4; ++m) { pg8::f32x4* q = (pg8::f32x4*)(base + (size_t)(row0 + ai * 128 + m * 16) * D + col0 + bj * 128 + n * 16); *q = *q + g * acc[ai][bj][m][n]; }
      }
  }
};
struct MoeSched : pg8::GridOrder {
  const char* A; const char* Bt; int lda, ldb, K; size_t bstride;
  const int* gidx; bool gather;
  __device__ __forceinline__ const char* a_ptr(const pg8::Unit& u) const { return gather ? A : A + (size_t)u.pm * 256 * lda * 2; }
  __device__ __forceinline__ const char* b_ptr(const pg8::Unit& u) const { return Bt + (size_t)((u.pm >> 2) & 15) * bstride + (size_t)u.pn * 256 * ldb * 2; }
};
struct EpiSwiGLU {
  static constexpr bool PERM = true, AFTER_DRAIN = false;
  bf16_t* O;
  __device__ __forceinline__ void operator()(const pg8::f32x4 (&acc)[2][2][4][2], const pg8::Unit& u, int wr, int wc, int fr, int fq) const {
    const int row0 = u.pm * 256 + wr * 64 + fr, col0 = u.pn * 128 + wc * 16 + 4 * fq;
#pragma unroll
    for (int ai = 0; ai < 2; ++ai)
#pragma unroll
      for (int m = 0; m < 4; ++m) { bf16_t* rowp = O + (size_t)(row0 + ai * 128 + m * 16) * DEXP + col0;
#pragma unroll
        for (int bj = 0; bj < 2; ++bj) { const pg8::f32x4 v0 = acc[ai][bj][m][0], v1 = acc[ai][bj][m][1];
          const float h0 = silu_f(v0[0]) * v0[1], h1 = silu_f(v0[2]) * v0[3], h2 = silu_f(v1[0]) * v1[1], h3 = silu_f(v1[2]) * v1[3];
          uint2 w; w.x = pg8::cvt_pk_bf16(h0, h1); w.y = pg8::cvt_pk_bf16(h2, h3);
          *(uint2*)(rowp + bj * 64) = w; } }
  }
};
struct EpiGateBf16 {
  static constexpr bool PERM = true, AFTER_DRAIN = false;
  bf16_t* O; const float* gate;
  __device__ __forceinline__ void operator()(const pg8::f32x4 (&acc)[2][2][4][2], const pg8::Unit& u, int wr, int wc, int fr, int fq) const {
    const int row0 = u.pm * 256 + wr * 64 + fr, col0 = u.pn * 256 + wc * 32 + 8 * fq;
#pragma unroll
    for (int ai = 0; ai < 2; ++ai)
#pragma unroll
      for (int m = 0; m < 4; ++m) { const int row = row0 + ai * 128 + m * 16; const float g = gate[row]; bf16_t* rowp = O + (size_t)row * D + col0;
#pragma unroll
        for (int bj = 0; bj < 2; ++bj) { const pg8::f32x4 v0 = acc[ai][bj][m][0] * g, v1 = acc[ai][bj][m][1] * g;
          pg8::u32x4 w; w.x = pg8::cvt_pk_bf16(v0[0], v0[1]); w.y = pg8::cvt_pk_bf16(v0[2], v0[3]); w.z = pg8::cvt_pk_bf16(v1[0], v1[1]); w.w = pg8::cvt_pk_bf16(v1[2], v1[3]);
          *(pg8::u32x4*)(rowp + bj * 128) = w; } }
  }
};

namespace fa {
using bf16x8 = __attribute__((ext_vector_type(8))) short;
using s16x4  = __attribute__((ext_vector_type(4))) short;
using f32x16 = __attribute__((ext_vector_type(16))) float;
using u32x4  = __attribute__((ext_vector_type(4))) unsigned;
constexpr int NW = 8, QBLK = 32, KVBLK = 64, LDQK = 128, LDV = 64;
constexpr float SCALE = 0.10206207261596575f;
constexpr float THR = 8.f;
constexpr size_t SHM_V = KVBLK * 64 * 2, SHM_K = KVBLK * 128 * 2, SHM_ATTN = 2 * SHM_V + 2 * SHM_K + NW * 64 * 4;
#define FA_KSWZ(row, colB) ((row) * 256 + ((colB) ^ (((row) & 7) << 4)))
#define FA_SBAR() __builtin_amdgcn_sched_barrier(0)
__device__ __forceinline__ int crow(int r, int hi) { return (r & 3) + 8 * (r >> 2) + 4 * hi; }
__device__ __forceinline__ unsigned cvtpk(float lo, float hi) { unsigned r; asm volatile("v_cvt_pk_bf16_f32 %0, %1, %2" : "=v"(r) : "v"(lo), "v"(hi)); return r; }
template <bool FIRST>
__device__ __forceinline__ void partialSM(f32x16& p0, f32x16& p1, float& m_reg, float& mn, float& alpha) {
  constexpr float THR2 = THR * 1.4426950408889634f;
  float pmax = p0[0];
#pragma unroll
  for (int r = 1; r < 16; ++r) pmax = fmaxf(pmax, p0[r]);
#pragma unroll
  for (int r = 0; r < 16; ++r) pmax = fmaxf(pmax, p1[r]);
  { auto rr = __builtin_amdgcn_permlane32_swap(__float_as_uint(pmax), __float_as_uint(pmax), false, false);
    pmax = fmaxf(__uint_as_float(rr[0]), __uint_as_float(rr[1])); }
  const float rel = pmax - m_reg;
  const bool keep = FIRST ? (rel <= THR2 && rel >= -64.f) : (rel <= THR2);
  if (__builtin_expect(__all(keep), 1)) { mn = m_reg; alpha = 1.f; }
  else { mn = FIRST ? pmax : fmaxf(m_reg, pmax); alpha = FIRST ? 1.f : __builtin_amdgcn_exp2f(m_reg - mn); m_reg = mn; }
  if (__builtin_expect(!__all(mn == 0.f), 0)) { p0 = p0 - mn; p1 = p1 - mn; }
#pragma unroll
  for (int r = 0; r < 16; ++r) p0[r] = __builtin_amdgcn_exp2f(p0[r]);
}
__device__ __forceinline__ void finishSM(f32x16& p0, f32x16& p1, float alpha, float& l_reg, bf16x8& pa0, bf16x8& pa1, bf16x8& pa2, bf16x8& pa3) {
#pragma unroll
  for (int r = 0; r < 16; ++r) p1[r] = __builtin_amdgcn_exp2f(p1[r]);
  float ps;
  { const f32x16 t = p0 + p1; const auto t8 = t.lo + t.hi; const auto t4 = t8.lo + t8.hi; const auto t2 = t4.lo + t4.hi; ps = t2.x + t2.y; }
  { auto rr = __builtin_amdgcn_permlane32_swap(__float_as_uint(ps), __float_as_uint(ps), false, false);
    ps = __uint_as_float(rr[0]) + __uint_as_float(rr[1]); }
  l_reg = l_reg * alpha + ps;
#define FA_PK4(P, BASE, OUT) do { unsigned a0 = cvtpk(P[BASE + 0], P[BASE + 1]), a1 = cvtpk(P[BASE + 2], P[BASE + 3]);   \
    unsigned b0 = cvtpk(P[BASE + 4], P[BASE + 5]), b1 = cvtpk(P[BASE + 6], P[BASE + 7]);                              \
    auto r0 = __builtin_amdgcn_permlane32_swap(a0, b0, false, false); auto r1 = __builtin_amdgcn_permlane32_swap(a1, b1, false, false); \
    u32x4 w = {r0[0], r1[0], r0[1], r1[1]}; OUT = *reinterpret_cast<bf16x8*>(&w); } while (0)
  FA_PK4(p0, 0, pa0); FA_PK4(p0, 8, pa1); FA_PK4(p1, 0, pa2); FA_PK4(p1, 8, pa3);
#undef FA_PK4
}
__device__ __forceinline__ void qkt(f32x16& p0, f32x16& p1, const char* Ks, const bf16x8* qr, int r32, int hi) {
  p0 = f32x16{}; p1 = f32x16{};
#pragma unroll
  for (int d0 = 0; d0 < 6; ++d0) { int cb = (d0 * 16 + hi * 8) * 2;
    bf16x8 b0 = *reinterpret_cast<const bf16x8*>(Ks + FA_KSWZ(r32, cb));
    bf16x8 b1 = *reinterpret_cast<const bf16x8*>(Ks + FA_KSWZ(32 + r32, cb));
    p0 = __builtin_amdgcn_mfma_f32_32x32x16_bf16(b0, qr[d0], p0, 0, 0, 0);
    p1 = __builtin_amdgcn_mfma_f32_32x32x16_bf16(b1, qr[d0], p1, 0, 0, 0); }
}
__device__ __forceinline__ int v_st(int k, int c) { const int kk = (k & ~0xC) | ((k & 4) << 1) | ((k & 8) >> 1); return ((kk >> 3) * 2 + (c >> 5)) * 512 + ((kk & 7) * 32 + (c & 31)) * 2; }
__device__ __forceinline__ int v_rd_base(int lane) { return ((lane & 3) << 3) | (((lane >> 2) & 3) << 6) | (((lane >> 4) & 1) << 5) | (((lane >> 5) & 1) << 8); }
constexpr int v_rd_off(int d0, int ks, int half) { return d0 * 512 + ks * 2048 + half * 1024; }
template <int OFF> __device__ __forceinline__ s16x4 tr_read(int vb) {
  s16x4 r; asm volatile("ds_read_b64_tr_b16 %0, %1 offset:%2" : "=&v"(r) : "v"(vb), "i"(OFF) : "memory"); return r;
}
template <int D0> __device__ __forceinline__ void pv_one(f32x16& od, int vb, bf16x8 pa0, bf16x8 pa1, bf16x8 pa2, bf16x8 pa3) {
  const s16x4 l0 = tr_read<v_rd_off(D0, 0, 0)>(vb), h0 = tr_read<v_rd_off(D0, 0, 1)>(vb), l1 = tr_read<v_rd_off(D0, 1, 0)>(vb), h1 = tr_read<v_rd_off(D0, 1, 1)>(vb);
  const s16x4 l2 = tr_read<v_rd_off(D0, 2, 0)>(vb), h2 = tr_read<v_rd_off(D0, 2, 1)>(vb), l3 = tr_read<v_rd_off(D0, 3, 0)>(vb), h3 = tr_read<v_rd_off(D0, 3, 1)>(vb);
  asm volatile("s_waitcnt lgkmcnt(0)" ::: "memory"); FA_SBAR();
#define FA_PK(L, H) (bf16x8){L[0], L[1], L[2], L[3], H[0], H[1], H[2], H[3]}
  od = __builtin_amdgcn_mfma_f32_32x32x16_bf16(pa0, FA_PK(l0, h0), od, 0, 0, 0);
  od = __builtin_amdgcn_mfma_f32_32x32x16_bf16(pa1, FA_PK(l1, h1), od, 0, 0, 0);
  od = __builtin_amdgcn_mfma_f32_32x32x16_bf16(pa2, FA_PK(l2, h2), od, 0, 0, 0);
  od = __builtin_amdgcn_mfma_f32_32x32x16_bf16(pa3, FA_PK(l3, h3), od, 0, 0, 0);
#undef FA_PK
}
__device__ __forceinline__ void attn_body(const bf16_t* __restrict__ Qb, const bf16_t* __restrict__ Kh, const bf16_t* __restrict__ Vh, bf16_t* __restrict__ Ob, int ldo, int seq, char* lds, float* mlp = nullptr, int mlstride = 0) {
  const int tid = ltid(), wid = tid >> 6, lane = tid & 63, r32 = lane & 31, hi = lane >> 5;
  char* V_lds = lds; char* K_lds = lds + 2 * SHM_V;
  float* ws = (float*)(lds + 2 * SHM_V + 2 * SHM_K) + wid * 64; float* li_l = ws; float* al_l = ws + 32;
  float m_reg = 0.f, l_reg = 0; f32x16 o[2] = {}; bf16x8 qr[6];
  const bf16_t* Qw = Qb + (long)(wid * QBLK + r32) * LDQK + hi * 8;
  u32x4 qw[6];
#pragma unroll
  for (int d0 = 0; d0 < 6; ++d0) qw[d0] = *reinterpret_cast<const u32x4*>(Qw + d0 * 16);
  const int sr = tid >> 4, sc = (tid & 15) * 8;
  const int vr = tid >> 3, vc = (tid & 7) * 8, vst0 = v_st(vr, vc);
  const int vb0 = (int)(uintptr_t)V_lds + v_rd_base(lane);
  struct { bf16x8 vs0, ks0, ks1; } sr_[2];
#define FA_SLOAD(i, k0) do { sr_[i].vs0 = *reinterpret_cast<const bf16x8*>(&Vh[(long)((k0) + vr) * LDV + vc]); \
    sr_[i].ks0 = *reinterpret_cast<const bf16x8*>(&Kh[(long)((k0) + sr) * LDQK + sc]); sr_[i].ks1 = *reinterpret_cast<const bf16x8*>(&Kh[(long)((k0) + 32 + sr) * LDQK + sc]); } while (0)
#define FA_SWRITE(b, i) do { *(bf16x8*)(V_lds + (b) * SHM_V + vst0) = sr_[i].vs0; int kc = sc * 2;               \
    *(bf16x8*)(K_lds + (b) * SHM_K + FA_KSWZ(sr, kc)) = sr_[i].ks0;                       \
    *(bf16x8*)(K_lds + (b) * SHM_K + FA_KSWZ(32 + sr, kc)) = sr_[i].ks1; } while (0)
#define FA_SWAIT() asm volatile("s_waitcnt vmcnt(3)" ::: "memory")
#define FA_RESC(a) do { if (__any((a) < 1.f)) { if (hi == 0) al_l[r32] = (a); asm volatile("s_waitcnt lgkmcnt(0)" ::: "memory"); \
    _Pragma("unroll") for (int d = 0; d < 2; ++d) _Pragma("unroll") for (int r = 0; r < 16; ++r) o[d][r] *= al_l[crow(r, hi)]; } } while (0)
  f32x16 pA0, pA1, pB0, pB1; float mnA, mnB, alA, alB; bf16x8 pa0, pa1, pa2, pa3; const int NTL = seq / KVBLK;
  constexpr int SE = 0, SO = 1;
  FA_SLOAD(SE, 0); FA_SLOAD(SO, KVBLK);
  __syncthreads();
#pragma unroll
  for (int d0 = 0; d0 < 6; ++d0) { u32x4 w = qw[d0];
    constexpr float C = SCALE * 1.4426950408889634f;
#pragma unroll
    for (int q = 0; q < 4; ++q) w[q] = cvtpk(__uint_as_float(w[q] << 16) * C, __uint_as_float(w[q] & 0xffff0000u) * C);
    qr[d0] = *reinterpret_cast<bf16x8*>(&w); }
  FA_SWAIT(); FA_SWRITE(0, SE); __syncthreads();
  qkt(pA0, pA1, K_lds, qr, r32, hi); partialSM<true>(pA0, pA1, m_reg, mnA, alA);
  if (2 < NTL) FA_SLOAD(SE, 2 * KVBLK);
  FA_SWAIT(); FA_SWRITE(1, SO); __syncthreads();
  for (int j = 1; j + 1 < NTL; j += 2) {
    FA_SBAR(); qkt(pB0, pB1, K_lds + SHM_K, qr, r32, hi);
    finishSM(pA0, pA1, alA, l_reg, pa0, pa1, pa2, pa3); FA_SBAR();
    FA_SLOAD(SO, (j + 2) * KVBLK); FA_SBAR();
    pv_one<0>(o[0], vb0, pa0, pa1, pa2, pa3); pv_one<1>(o[1], vb0, pa0, pa1, pa2, pa3); partialSM<false>(pB0, pB1, m_reg, mnB, alB);
    __syncthreads(); FA_SWAIT(); FA_SWRITE(0, SE);
    FA_RESC(alB); __syncthreads();
    FA_SBAR(); qkt(pA0, pA1, K_lds, qr, r32, hi);
    finishSM(pB0, pB1, alB, l_reg, pa0, pa1, pa2, pa3); FA_SBAR();
    if (j + 3 < NTL) FA_SLOAD(SE, (j + 3) * KVBLK); FA_SBAR();
    pv_one<0>(o[0], vb0 + (int)SHM_V, pa0, pa1, pa2, pa3); pv_one<1>(o[1], vb0 + (int)SHM_V, pa0, pa1, pa2, pa3); partialSM<false>(pA0, pA1, m_reg, mnA, alA);
    __syncthreads(); FA_SWAIT(); FA_SWRITE(1, SO);
    FA_RESC(alA); __syncthreads();
  }
  FA_SBAR(); qkt(pB0, pB1, K_lds + SHM_K, qr, r32, hi);
  finishSM(pA0, pA1, alA, l_reg, pa0, pa1, pa2, pa3); FA_SBAR();
  pv_one<0>(o[0], vb0, pa0, pa1, pa2, pa3); pv_one<1>(o[1], vb0, pa0, pa1, pa2, pa3); partialSM<false>(pB0, pB1, m_reg, mnB, alB);
  __syncthreads(); FA_RESC(alB);
  finishSM(pB0, pB1, alB, l_reg, pa0, pa1, pa2, pa3); FA_SBAR();
  pv_one<0>(o[0], vb0 + (int)SHM_V, pa0, pa1, pa2, pa3); pv_one<1>(o[1], vb0 + (int)SHM_V, pa0, pa1, pa2, pa3);
  if (hi == 0) { li_l[r32] = l_reg; if (mlp) { float* q2 = mlp + (size_t)(wid * QBLK + r32) * mlstride; q2[0] = m_reg * (1.f / (SCALE * 1.4426950408889634f)); q2[1] = l_reg;     } }
  asm volatile("s_waitcnt lgkmcnt(0)" ::: "memory");
  float rli[16];
#pragma unroll
  for (int r = 0; r < 16; ++r) rli[r] = __builtin_amdgcn_rcpf(li_l[crow(r, hi)]);
  bf16_t* Ow = Ob + (long)(wid * QBLK) * ldo;
  char* ot = lds + SHM_ATTN + wid * 4096;
#pragma unroll
  for (int r = 0; r < 16; ++r) { int orow = crow(r, hi);
#pragma unroll
    for (int d0 = 0; d0 < 2; ++d0) *(bf16_t*)(ot + orow * 128 + (d0 * 32 + r32) * 2) = f2bf(o[d0][r] * rli[r]); }
#pragma unroll
  for (int k = 0; k < 4; ++k) { const int row = k * 8 + (lane >> 3);
    const u32x4 v = *(const u32x4*)(ot + row * 128 + (lane & 7) * 16);
    *(u32x4*)(Ow + (long)row * ldo + (lane & 7) * 8) = v; }
#undef FA_SLOAD
#undef FA_SWRITE
#undef FA_SWAIT
#undef FA_RESC
}
}

namespace gd {
using bf16x8 = __attribute__((ext_vector_type(8))) short;
using f32x4 = __attribute__((ext_vector_type(4))) float;
constexpr int NCH = 132;
constexpr size_t R_QF = 0, R_KF = 16384, R_KTF = 32768, R_VC = 49152, R_DIR = 65536, DIR_BYTES = 17408, D_TINV = 0, D_QKM = 8192, D_VEC = 16384;
constexpr size_t CHREC = R_DIR + 2 * DIR_BYTES;
__device__ __forceinline__ unsigned pk(float lo, float hi) { unsigned r; asm volatile("v_cvt_pk_bf16_f32 %0, %1, %2" : "=v"(r) : "v"(lo), "v"(hi)); return r; }
__device__ __forceinline__ bf16x8 pack8(const f32x4 a, const f32x4 b) { typedef unsigned u4 __attribute__((ext_vector_type(4))); u4 w = {pk(a[0], a[1]), pk(a[2], a[3]), pk(b[0], b[1]), pk(b[2], b[3])}; return *reinterpret_cast<bf16x8*>(&w); }
__device__ __forceinline__ int chunk_row0(int b, int c) { return c < 4 ? ML + b * TC + 64 * c : b * T + 64 * (c - 4); }
constexpr int L_Q = 0, L_K = 16384, L_V = 32768, L_KK = 49152  , L_QK = 65792, L_G = 82432  ,
              L_A = 0  , L_X0 = 32768  , L_X1 = 83968, L_AT = 100352;
__device__ __forceinline__ int swz(int row, int colB) { return row * 256 + (colB ^ ((row & 7) << 4)); }
__device__ __forceinline__ void tr_pair(int a0, int a1, uint2& lo, uint2& hi) {
  asm volatile("ds_read_b64_tr_b16 %0, %2\n\tds_read_b64_tr_b16 %1, %3\n\ts_waitcnt lgkmcnt(0)" : "=&v"(lo), "=&v"(hi) : "v"(a0), "v"(a1) : "memory");
}
__device__ __forceinline__ uint2 tr_one(int a0) {
  uint2 r; asm volatile("ds_read_b64_tr_b16 %0, %1\n\ts_waitcnt lgkmcnt(0)" : "=&v"(r) : "v"(a0) : "memory"); return r;
}

__device__ __forceinline__ void inv_offdiag(const float* A, float* X, int bi, int bj, int lane) {
  const int rc = lane & 15, g = lane >> 4;
  f32x4 t = {0.f, 0.f, 0.f, 0.f};
  for (int k = bj; k < bi; ++k) {
#pragma unroll
    for (int s4 = 0; s4 < 4; ++s4)
      t = __builtin_amdgcn_mfma_f32_16x16x4f32(A[(bi * 16 + rc) * 64 + k * 16 + s4 * 4 + g], X[(k * 16 + s4 * 4 + g) * 64 + bj * 16 + rc], t, 0, 0, 0);
  }
  f32x4 o = {0.f, 0.f, 0.f, 0.f};
#pragma unroll
  for (int r = 0; r < 4; ++r)
    o = __builtin_amdgcn_mfma_f32_16x16x4f32(X[(bi * 16 + rc) * 64 + bi * 16 + g * 4 + r], t[r], o, 0, 0, 0);
#pragma unroll
  for (int r = 0; r < 4; ++r) X[(bi * 16 + g * 4 + r) * 64 + bj * 16 + rc] = -o[r];
}
__device__ __forceinline__ void lds_barrier() { asm volatile("s_waitcnt lgkmcnt(0)" ::: "memory"); __builtin_amdgcn_s_barrier(); asm volatile("" ::: "memory"); }
constexpr int L_CW = 133120;
typedef unsigned pc_u4 __attribute__((ext_vector_type(4)));
__device__ __forceinline__ void precompute_load(const Params& p, int b, int h, int c, int tid, pc_u4 (&xin)[3][4]) {
  const bf16_t* P = (const bf16_t*)(p.ws + OFF_P);
  const int row0 = chunk_row0(b, c), tlen = c < 4 ? TC : T, t0 = c < 4 ? 64 * c : 64 * (c - 4);
  const int ch8 = tid & 15, tokA = 2 * (tid >> 4);
#pragma unroll
  for (int which = 0; which < 3; ++which) {
    const int ch0 = which * 512 + h * 128 + ch8 * 8;
#pragma unroll
    for (int jj = 0; jj < 4; ++jj) { const int tt = t0 + tokA - 1 + jj;
      xin[which][jj] = (tt >= 0 && tt < tlen) ? *(const pc_u4*)(P + (size_t)(row0 + tokA - 1 + jj) * NINP + PC_GQ + ch0) : (pc_u4){0u, 0u, 0u, 0u}; }
  }
}
__device__ __forceinline__ void precompute_item(const Params& p, int l, int b, int h, int c, char* lds, int tid, const pc_u4 (&xin)[3][4], pc_u4 (&xnx)[3][4], int itn) {
  const int lane = tid & 63, wv = tid >> 6;
  const bf16_t* P = (const bf16_t*)(p.ws + OFF_P);
  char* rec = p.ws + OFF_RB + (size_t)((b * 4 + h) * NCH + c) * CHREC;
  const int row0 = chunk_row0(b, c);
  const int ldsb = (int)(uintptr_t)lds;
  lds_barrier();
  {
    const int ch8 = tid & 15, tg = tid >> 4, tokA = 2 * tg;
    const float* cwl = (const float*)(lds + L_CW);
#pragma unroll
    for (int which = 0; which < 3; ++which) {
      float xf[4][8];
#pragma unroll
      for (int jj = 0; jj < 4; ++jj) { const unsigned w4[4] = {xin[which][jj].x, xin[which][jj].y, xin[which][jj].z, xin[which][jj].w};
#pragma unroll
        for (int i = 0; i < 4; ++i) { xf[jj][2 * i] = __uint_as_float(w4[i] << 16); xf[jj][2 * i + 1] = __uint_as_float(w4[i] & 0xffff0000u); } }
      float wf[3][8];
#pragma unroll
      for (int j = 0; j < 3; ++j) { const float4 w0 = *(const float4*)(cwl + j * 1536 + which * 512 + h * 128 + ch8 * 8), w1 = *(const float4*)(cwl + j * 1536 + which * 512 + h * 128 + ch8 * 8 + 4);
        wf[j][0] = w0.x; wf[j][1] = w0.y; wf[j][2] = w0.z; wf[j][3] = w0.w; wf[j][4] = w1.x; wf[j][5] = w1.y; wf[j][6] = w1.z; wf[j][7] = w1.w; }
#pragma unroll
      for (int a = 0; a < 2; ++a) {
        float o[8], ss = 0.f;
#pragma unroll
        for (int i = 0; i < 8; ++i) { o[i] = silu_f(wf[0][i] * xf[a][i] + wf[1][i] * xf[a + 1][i] + wf[2][i] * xf[a + 2][i]); ss += o[i] * o[i]; }
        if (which < 2) {
          ss += __shfl_xor(ss, 1); ss += __shfl_xor(ss, 2); ss += __shfl_xor(ss, 4); ss += __shfl_xor(ss, 8);
          const float sc = rsqrtf(ss + EPS) * (which == 0 ? 0.08838834764831845f : 1.f);
#pragma unroll
          for (int i = 0; i < 8; ++i) o[i] *= sc;
        }
        uint4 w; w.x = pk(o[0], o[1]); w.y = pk(o[2], o[3]); w.z = pk(o[4], o[5]); w.w = pk(o[6], o[7]);
        *(uint4*)(lds + (which == 0 ? L_Q : (which == 1 ? L_K : L_V)) + swz(tokA + a, ch8 * 16)) = w;
      }
    }
    if (tid < 128) {
      const int d = tid >> 6, tk = tid & 63;
      const float pa = bf2f(P[(size_t)(row0 + tk) * NINP + PC_A + d * 4 + h]), pb = bf2f(P[(size_t)(row0 + tk) * NINP + PC_B + d * 4 + h]);
      float* gs = (float*)(lds + L_G);
      gs[d * 64 + tk] = -expf(p.a_log[l * 8 + d * 4 + h]) * softplus_f(pa + p.dt_bias[l * 8 + d * 4 + h]);
      gs[128 + d * 64 + tk] = sigmoid_f(pb);
    }
  }
  lds_barrier();
  if (wv == 0) {
    float* gs = (float*)(lds + L_G);
    float a0 = gs[lane], a1 = gs[64 + 63 - lane];
#pragma unroll
    for (int o = 1; o < 64; o <<= 1) { const float n0 = __shfl_up(a0, o), n1 = __shfl_up(a1, o); if (lane >= o) { a0 += n0; a1 += n1; } }
    gs[256 + lane] = a0; gs[256 + 64 + 63 - lane] = a1;
  }
  {
    const int cc = lane & 15, g = lane >> 4;
#pragma unroll
    for (int tt = 0; tt < 2; ++tt) {
      const int tile = wv * 2 + tt, mi = tile >> 2, nj = tile & 3;
      f32x4 akk = {0.f, 0.f, 0.f, 0.f}, aqk = {0.f, 0.f, 0.f, 0.f};
#pragma unroll
      for (int s4 = 0; s4 < 4; ++s4) {
        const bf16x8 ak = *(const bf16x8*)(lds + L_K + swz(mi * 16 + cc, s4 * 64 + g * 16));
        const bf16x8 aq = *(const bf16x8*)(lds + L_Q + swz(mi * 16 + cc, s4 * 64 + g * 16));
        const bf16x8 bk = *(const bf16x8*)(lds + L_K + swz(nj * 16 + cc, s4 * 64 + g * 16));
        akk = __builtin_amdgcn_mfma_f32_16x16x32_bf16(ak, bk, akk, 0, 0, 0);
        aqk = __builtin_amdgcn_mfma_f32_16x16x32_bf16(aq, bk, aqk, 0, 0, 0);
      }
      float* KK = (float*)(lds + L_KK); float* QK = (float*)(lds + L_QK);
#pragma unroll
      for (int r = 0; r < 4; ++r) { KK[(mi * 16 + g * 4 + r) * 65 + nj * 16 + cc] = akk[r]; QK[(mi * 16 + g * 4 + r) * 65 + nj * 16 + cc] = aqk[r]; }
    }
#pragma unroll
    for (int it = 0; it < 2; ++it) {
      const int item = tid + it * NT, fl = item & 63, frag = item >> 6, mt = frag >> 3, kbj = frag & 7, r = fl & 31, hl = fl >> 5;
      const int row = mt * 32 + r, cb = (kbj * 16 + hl * 4) * 2;
      uint4 wq, wk;
      { const uint2 lo = *(const uint2*)(lds + L_Q + swz(row, cb)), hi = *(const uint2*)(lds + L_Q + swz(row, cb + 16)); wq = make_uint4(lo.x, lo.y, hi.x, hi.y); }
      { const uint2 lo = *(const uint2*)(lds + L_K + swz(row, cb)), hi = *(const uint2*)(lds + L_K + swz(row, cb + 16)); wk = make_uint4(lo.x, lo.y, hi.x, hi.y); }
      *(uint4*)(rec + R_QF + (size_t)item * 16) = wq; *(uint4*)(rec + R_KF + (size_t)item * 16) = wk;
    }
#pragma unroll
    for (int it = 0; it < 2; ++it) {
      const int item = tid + it * NT, fl = item & 63, frag = item >> 6, mt = frag >> 2, kbj = frag & 3, i16 = fl & 15, gq = fl >> 4;
      const int tok0 = kbj * 16 + (gq >> 1) * 4 + (i16 >> 2), cb = (mt * 32 + (gq & 1) * 16 + (i16 & 3) * 4) * 2;
      uint2 lo, hi; tr_pair(ldsb + L_K + swz(tok0, cb), ldsb + L_K + swz(tok0 + 8, cb), lo, hi);
      *(uint4*)(rec + R_KTF + (size_t)item * 16) = make_uint4(lo.x, lo.y, hi.x, hi.y);
    }
#pragma unroll
    for (int it = 0; it < 4; ++it) {
      const int item = tid + it * NT, fl = item & 63, q = (item >> 6) & 3, mt = (item >> 8) & 1, sl = item >> 9, i16 = fl & 15, gq = fl >> 4;
      const int tok0 = mt * 32 + q * 8 + (gq >> 1) * 4 + (i16 >> 2), cb = (sl * 32 + (gq & 1) * 16 + (i16 & 3) * 4) * 2;
      const uint2 v = tr_one(ldsb + L_V + swz(tok0, cb));
      *(uint2*)(rec + R_VC + (size_t)item * 8) = v;
    }
  }
  lds_barrier();
  {
    const float* gs = (const float*)(lds + L_G); const float* KK = (const float*)(lds + L_KK);
    float* A = (float*)(lds + L_A);
#pragma unroll 4
    for (int it = 0; it < 16; ++it) {
      const int e = tid + it * NT, d = e >> 12, ip = (e >> 6) & 63, jp = e & 63, ti = d ? 63 - ip : ip, tj = d ? 63 - jp : jp;
      A[e] = ip > jp ? gs[128 + d * 64 + ti] * KK[ti * 65 + tj] * __expf(gs[256 + d * 64 + ti] - gs[256 + d * 64 + tj]) : 0.f;
    }
  }
  lds_barrier();
  if (wv < 2) {
    const float* A = (const float*)(lds + L_A) + wv * 4096; float* X = (float*)(lds + (wv ? L_X1 : L_X0));
    const int qb = lane >> 4, c16 = lane & 15;
    float x[16];
    f32x4 an[4];
#pragma unroll
    for (int q4 = 0; q4 < 4; ++q4) an[q4] = *(const f32x4*)(A + (qb * 16) * 64 + qb * 16 + q4 * 4);
#pragma unroll
    for (int r = 0; r < 16; ++r) {
      f32x4 ac[4];
#pragma unroll
      for (int q4 = 0; q4 < 4; ++q4) ac[q4] = an[q4];
      if (r < 15) {
#pragma unroll
        for (int q4 = 0; q4 < 4; ++q4) an[q4] = *(const f32x4*)(A + (qb * 16 + r + 1) * 64 + qb * 16 + q4 * 4); }
      asm volatile("" ::: "memory");
      float sacc = (r == c16) ? 1.f : 0.f;
#pragma unroll
      for (int q = 0; q < 16; ++q) if (q < r) sacc -= ac[q >> 2][q & 3] * x[q];
      x[r] = sacc;
      X[(qb * 16 + r) * 64 + qb * 16 + c16] = sacc;
    }
  } else {
    const float* gs = (const float*)(lds + L_G); const float* QK = (const float*)(lds + L_QK);
    const int t2 = tid - 128;
    for (int e = t2; e < 2 * 6 * 256; e += 384) {
      const int d = e / 1536, r6 = (e % 1536) >> 8, w = e & 255; const int bi = r6 < 3 ? 0 : (r6 < 5 ? 1 : 2), bj = r6 < 3 ? r6 + 1 : (r6 < 5 ? r6 - 1 : 3);
      ((float*)(lds + (d ? L_X1 : L_X0)))[(bi * 16 + (w >> 4)) * 64 + bj * 16 + (w & 15)] = 0.f; }
    for (int item = t2; item < 1024; item += 384) {
      const int d = item >> 9, fl = item & 63, frag = (item >> 6) & 7, mt = frag >> 2, kbj = frag & 3, r = fl & 31, hl = fl >> 5;
      const int i = mt * 32 + r; const float gci = gs[256 + d * 64 + i];
      float v[8];
#pragma unroll
      for (int j = 0; j < 8; ++j) { const int jj = kbj * 16 + 8 * (j >> 2) + 4 * hl + (j & 3); const bool ok = d ? (i <= jj) : (i >= jj);
        v[j] = ok ? QK[i * 65 + jj] * __expf(gci - gs[256 + d * 64 + jj]) : 0.f; }
      *(uint4*)(rec + R_DIR + d * DIR_BYTES + D_QKM + (size_t)(item & 511) * 16) = make_uint4(pk(v[0], v[1]), pk(v[2], v[3]), pk(v[4], v[5]), pk(v[6], v[7]));
    }
    if (t2 < 128) {
      const int d = t2 >> 6, tk = t2 & 63; float* vec = (float*)(rec + R_DIR + d * DIR_BYTES + D_VEC);
      const float gc = gs[256 + d * 64 + tk], gl = gs[256 + d * 64 + (d ? 0 : 63)];
      vec[tk] = gs[128 + d * 64 + tk]; vec[64 + tk] = __expf(gc); vec[128 + tk] = __expf(gl - gc);
      if (tk == 0) vec[192] = __expf(gl);
    }
  }
  lds_barrier();
  if (wv < 6) inv_offdiag((const float*)(lds + L_A) + (wv & 1) * 4096, (float*)(lds + ((wv & 1) ? L_X1 : L_X0)), (wv >> 1) + 1, wv >> 1, lane);
  lds_barrier();
  if (wv < 4) inv_offdiag((const float*)(lds + L_A) + (wv & 1) * 4096, (float*)(lds + ((wv & 1) ? L_X1 : L_X0)), (wv >> 1) + 2, wv >> 1, lane);
  lds_barrier();
  if (wv < 2) inv_offdiag((const float*)(lds + L_A) + wv * 4096, (float*)(lds + (wv ? L_X1 : L_X0)), 3, 0, lane);
  lds_barrier();
  if (itn >= 0) precompute_load(p, (itn / NCH) >> 2, (itn / NCH) & 3, itn % NCH, tid, xnx);
  {
#pragma unroll
    for (int it = 0; it < 2; ++it) {
      const int item = tid + it * NT, d = item >> 9, fl = item & 63, frag = (item >> 6) & 7, mt = frag >> 2, kbj = frag & 3, r = fl & 31, hl = fl >> 5;
      const int i = mt * 32 + r, ri = d ? 63 - i : i; const float* X = (const float*)(lds + (d ? L_X1 : L_X0)) + ri * 64; const float* bet = (const float*)(lds + L_G) + 128 + d * 64;
      float v[8];
#pragma unroll
      for (int j = 0; j < 8; ++j) { const int jj = kbj * 16 + 8 * (j >> 2) + 4 * hl + (j & 3); v[j] = X[d ? 63 - jj : jj] * bet[jj]; }
      *(uint4*)(rec + R_DIR + d * DIR_BYTES + D_TINV + (size_t)(item & 511) * 16) = make_uint4(pk(v[0], v[1]), pk(v[2], v[3]), pk(v[4], v[5]), pk(v[6], v[7]));
    }
  }
}

constexpr int SBUF_ = 74752;
template <int LW>
__device__ __forceinline__ void scan_loader(const char* recs, int dir, int half, char* smem, int lane) {
  typedef unsigned v4u __attribute__((ext_vector_type(4))); typedef __attribute__((address_space(1))) const v4u g_u4; typedef __attribute__((address_space(3))) v4u l_u4;
#define GD_CHUNK(step) (dir == 0 ? (step) : ((step) < 4 ? 3 - (step) : NCH + 3 - (step)))
#define GD_SOFF(i_) ((i_) < 48 ? (size_t)(i_) * 1024 : ((i_) < 56 ? R_VC + (size_t)half * 8192 + ((i_) - 48) * 1024 : R_DIR + (size_t)dir * DIR_BYTES + ((i_) - 56) * 1024))
#define GD_LOAD(R, step) do { const char* _b = recs + (size_t)GD_CHUNK(step) * CHREC + lane * 16; \
    _Pragma("unroll") for (int _j = 0; _j < 19; ++_j) { const int _i = LW + 4 * _j; if (_i < 73) R[_j] = *(g_u4*)(_b + GD_SOFF(_i)); } } while (0)
#define GD_WRITE(R, buf) do { char* _d = smem + (buf) * SBUF_ + lane * 16; \
    _Pragma("unroll") for (int _j = 0; _j < 19; ++_j) { const int _i = LW + 4 * _j; if (_i < 73) *(l_u4*)(_d + _i * 1024) = R[_j]; } } while (0)
  v4u RA[19], RB[19];
  GD_LOAD(RA, 0); GD_LOAD(RB, 1); GD_WRITE(RA, 0); GD_LOAD(RA, 2);
  lds_barrier();
  for (int step = 0; step < NCH; step += 2) {
    if (step + 1 < NCH) GD_WRITE(RB, 1);
    if (step + 3 < NCH) GD_LOAD(RB, step + 3);
    lds_barrier();
    if (step + 2 < NCH) GD_WRITE(RA, 0);
    if (step + 4 < NCH) GD_LOAD(RA, step + 4);
    lds_barrier();
  }
#undef GD_CHUNK
#undef GD_SOFF
#undef GD_LOAD
#undef GD_WRITE
}
constexpr int SB_QF = 0, SB_KF = 16384, SB_KTF = 32768, SB_VC = 49152, SB_TINV = 57344, SB_QKM = 65536, SB_VEC = 73728, SBUF = 74752;
using f32x16 = __attribute__((ext_vector_type(16))) float;
__device__ __forceinline__ unsigned pkb(float lo, float hi) {
  typedef __bf16 bf2 __attribute__((ext_vector_type(2))); typedef float f2 __attribute__((ext_vector_type(2)));
  bf2 r = __builtin_convertvector((f2){lo, hi}, bf2); return *reinterpret_cast<unsigned*>(&r);
}
template <int J> __device__ __forceinline__ bf16x8 pack16(const f32x16& v) {
  typedef unsigned u4 __attribute__((ext_vector_type(4)));
  u4 w = {pk(v[8 * J], v[8 * J + 1]), pk(v[8 * J + 2], v[8 * J + 3]), pk(v[8 * J + 4], v[8 * J + 5]), pk(v[8 * J + 6], v[8 * J + 7])};
  return *reinterpret_cast<bf16x8*>(&w);
}
typedef __attribute__((address_space(1))) char gchar; typedef __attribute__((address_space(1))) bf16_t gbf16;
#define GD_STO(o, I, MT) do { const unsigned _w = pk(o[I], o[(I) + 1]); gchar* _rb = Pst + (size_t)((MT) * 32 + 8 * ((I) >> 2) + ((I) & 3)) * (NINP * 2); asm volatile("" : "+s"(_rb)); \
    *(gbf16*)(_rb + voff) = (bf16_t)_w; *(gbf16*)(_rb + voff1) = (bf16_t)(_w >> 16); } while (0)
__device__ __forceinline__ void scan_unit_lds(const Params& p, int unit_, char* smem, int tid) {
  const int wv = __builtin_amdgcn_readfirstlane(tid >> 6), lane = tid & 63, unit = __builtin_amdgcn_readfirstlane(unit_);
  const int chain = unit >> 1, half = unit & 1, dir = chain & 1, h = (chain >> 1) & 3, b = chain >> 3;
  const char* recs = p.ws + OFF_RB + (size_t)((b * 4 + h) * NCH) * CHREC;
#define GD_CHUNK(step) (dir == 0 ? (step) : ((step) < 4 ? 3 - (step) : NCH + 3 - (step)))
  if (wv >= 4) {
    if (wv == 4) scan_loader<0>(recs, dir, half, smem, lane); else if (wv == 5) scan_loader<1>(recs, dir, half, smem, lane);
    else if (wv == 6) scan_loader<2>(recs, dir, half, smem, lane); else scan_loader<3>(recs, dir, half, smem, lane);
    return;
  }
  if (wv >= 2) {
    for (int i = 0; i <= NCH; ++i) lds_barrier();
    return;
  }
  lds_barrier();
  const int c32 = lane & 31, hl = lane >> 5;
  const unsigned voff_ = (unsigned)(c32 * 2 + hl * 4 * NINP * 2);
  gchar* Pc = (gchar*)(p.ws + OFF_P + (size_t)((dir ? PC_OB : PC_OF) + h * 128 + (half * 2 + wv) * 32) * 2);
  gchar* Pprev = (gchar*)(p.ws + OFF_P + (size_t)(PC_GV + h * 128 + (half * 2 + wv) * 32) * 2 + (size_t)chunk_row0(b, GD_CHUNK(0)) * (NINP * 2));
  f32x16 S[4], ks0, ks1, oq0, oq1, vn0, vn1;
  bf16x8 f0[8], f1[8], Sb[8], Rb[4], Vb[4], VFb[4];
  typedef unsigned u4 __attribute__((ext_vector_type(4)));
#pragma unroll
  for (int t = 0; t < 4; ++t)
#pragma unroll
    for (int i = 0; i < 16; ++i) S[t][i] = 0.f;
#pragma unroll
  for (int i = 0; i < 16; ++i) { oq0[i] = 0.f; oq1[i] = 0.f; }
#pragma unroll
  for (int k = 0; k < 8; ++k) { Sb[k] = (bf16x8){0, 0, 0, 0, 0, 0, 0, 0}; f0[k] = ((const bf16x8*)(smem + SB_KF))[k * 64 + lane]; }
#define GD_SB() __builtin_amdgcn_sched_barrier(0)
#define GD_MF(a, b, c) c = __builtin_amdgcn_mfma_f32_32x32x16_bf16(a, b, c, 0, 0, 0)
#define GD_ZERO(a) do { _Pragma("unroll") for (int _i = 0; _i < 16; ++_i) a[_i] = 0.f; } while (0)
#define GD_LO(w) __uint_as_float((w) << 16)
#define GD_HI(w) __uint_as_float((w) & 0xffff0000u)
#define GD_RLOAD(vA, vB, eA, eB, MT, HQ) do { vA = VC[((MT) * 4 + 2 * (HQ)) * 64 + lane]; vB = VC[((MT) * 4 + 2 * (HQ) + 1) * 64 + lane]; \
    eA = *(const f32x4*)(vec + 64 + (MT) * 32 + (HQ) * 16); eB = *(const f32x4*)(vec + 64 + (MT) * 32 + (HQ) * 16 + 8); } while (0)
#define GD_RC2(ks, v, e, I0, wa, wb) do { wa = pk(GD_LO(v.x) - e[0] * ks[(I0)], GD_HI(v.x) - e[1] * ks[(I0) + 1]); wb = pk(GD_LO(v.y) - e[2] * ks[(I0) + 2], GD_HI(v.y) - e[3] * ks[(I0) + 3]); } while (0)
#define GD_VF2(vn, e, I0, wa, wb) do { wa = pk(vn[(I0)] * e[0], vn[(I0) + 1] * e[1]); wb = pk(vn[(I0) + 2] * e[2], vn[(I0) + 3] * e[3]); } while (0)
#define GD_W4(dst) do { const u4 _w = {w0, w1, w2, w3}; dst = *reinterpret_cast<const bf16x8*>(&_w); } while (0)
#define GD_FLOAD(eA, eB, MT, HQ) do { eA = *(const f32x4*)(vec + 128 + (MT) * 32 + (HQ) * 16); eB = *(const f32x4*)(vec + 128 + (MT) * 32 + (HQ) * 16 + 8); } while (0)
#define GD_ELOAD(eA, eB, MT, HQ) do { eA = *(const f32x4*)(vec + 64 + (MT) * 32 + (HQ) * 16); eB = *(const f32x4*)(vec + 64 + (MT) * 32 + (HQ) * 16 + 8); } while (0)
#define GD_OINIT(oq, eA, eB, HQ) do { _Pragma("unroll") for (int _r = 0; _r < 4; ++_r) { oq[8 * (HQ) + _r] *= eA[_r]; oq[8 * (HQ) + 4 + _r] *= eB[_r]; } } while (0)
#define GD_SCALE(St, I0) do { float _e = egl; asm volatile("" : "+v"(_e)); _Pragma("unroll") for (int _r = 0; _r < 4; ++_r) St[(I0) + _r] *= _e; } while (0)
  uint2 vXA, vXB, vYA, vYB; f32x4 eXA, eXB, eYA, eYB, gXA, gXB, gYA, gYB; float egl; unsigned w0, w1, w2, w3;
  for (int step = 0; step < NCH; ++step) {
    const char* buf = smem + (step & 1) * SBUF; const char* nbuf = smem + ((step + 1) & 1) * SBUF;
    const bf16x8* QF = (const bf16x8*)(buf + SB_QF); const bf16x8* KF = (const bf16x8*)(buf + SB_KF); const bf16x8* KTF = (const bf16x8*)(buf + SB_KTF);
    const bf16x8* KFn = (const bf16x8*)(nbuf + SB_KF);
    const uint2* VC = (const uint2*)(buf + SB_VC + wv * 4096);
    const bf16x8* TF = (const bf16x8*)(buf + SB_TINV); const bf16x8* QKF = (const bf16x8*)(buf + SB_QKM); const float* vec = (const float*)(buf + SB_VEC) + 4 * hl;
    gchar* Pst = Pprev;
    unsigned voff = voff_; asm volatile("" : "+v"(voff)); unsigned voff1 = voff_ + NINP * 2; asm volatile("" : "+v"(voff1));
    GD_ZERO(ks0);
    GD_SB();
#pragma unroll
    for (int k = 0; k < 8; ++k) {
      GD_MF(f0[k], Sb[k], ks0);
      f1[k] = KF[(8 + k) * 64 + lane];
      if (k < 4) { GD_STO(oq0, 4 * k, 0); GD_STO(oq0, 4 * k + 2, 0); } else { GD_STO(oq1, 4 * (k - 4), 1); GD_STO(oq1, 4 * (k - 4) + 2, 1); }
      if (k == 6) GD_RLOAD(vXA, vXB, eXA, eXB, 0, 0);
      if (k == 7) { GD_RLOAD(vYA, vYB, eYA, eYB, 0, 1); GD_ZERO(ks1); }
      GD_SB();
    }
#pragma unroll
    for (int k = 0; k < 8; ++k) {
      GD_MF(f1[k], Sb[k], ks1);
      f0[k] = QF[k * 64 + lane];
      if (k == 1) GD_RC2(ks0, vXA, eXA, 0, w0, w1);
      if (k == 2) { GD_RC2(ks0, vXB, eXB, 4, w2, w3); GD_W4(Rb[0]); }
      if (k == 3) GD_RC2(ks0, vYA, eYA, 8, w0, w1);
      if (k == 4) { GD_RC2(ks0, vYB, eYB, 12, w2, w3); GD_W4(Rb[1]); }
      if (k == 5) GD_RLOAD(vXA, vXB, eXA, eXB, 1, 0);
      if (k == 6) GD_RLOAD(vYA, vYB, eYA, eYB, 1, 1);
      if (k == 7) { GD_ZERO(oq0); }
      GD_SB();
    }
#pragma unroll
    for (int k = 0; k < 8; ++k) {
      GD_MF(f0[k], Sb[k], oq0);
      f1[k] = QF[(8 + k) * 64 + lane];
      if (k == 1) GD_RC2(ks1, vXA, eXA, 0, w0, w1);
      if (k == 2) { GD_RC2(ks1, vXB, eXB, 4, w2, w3); GD_W4(Rb[2]); }
      if (k == 3) GD_RC2(ks1, vYA, eYA, 8, w0, w1);
      if (k == 4) { GD_RC2(ks1, vYB, eYB, 12, w2, w3); GD_W4(Rb[3]); }
      if (k == 6) egl = vec[192 - 4 * hl];
      if (k == 7) { GD_ZERO(oq1); }
      GD_SB();
    }
#pragma unroll
    for (int k = 0; k < 8; ++k) {
      GD_MF(f1[k], Sb[k], oq1);
      f0[k] = TF[k * 64 + lane];
      GD_SCALE(S[k >> 2], 4 * (k & 3)); GD_SCALE(S[2 + (k >> 2)], 4 * (k & 3));
      if (k == 6) { GD_FLOAD(gXA, gXB, 0, 0); GD_FLOAD(gYA, gYB, 0, 1); }
      if (k == 7) { GD_ZERO(vn0); GD_ZERO(vn1); }
      GD_SB();
    }
#pragma unroll
    for (int k = 0; k < 8; ++k) {
      if (k < 4) GD_MF(f0[k], Rb[k], vn0); else GD_MF(f0[k], Rb[k - 4], vn1);
      f1[k] = KTF[k * 64 + lane];
      if (k == 5) GD_VF2(vn0, gXA, 0, w0, w1);
      if (k == 6) { GD_VF2(vn0, gXB, 4, w2, w3); GD_W4(VFb[0]); }
      if (k == 7) { GD_VF2(vn0, gYA, 8, w0, w1); GD_FLOAD(gXA, gXB, 1, 0); }
      GD_SB();
    }
#pragma unroll
    for (int k = 0; k < 8; ++k) {
      if (k == 0) GD_MF(f1[0], VFb[0], S[0]); if (k == 1) GD_MF(f1[4], VFb[0], S[1]); if (k == 2) GD_MF(f1[1], VFb[1], S[0]); if (k == 3) GD_MF(f1[5], VFb[1], S[1]);
      if (k == 4) GD_MF(f1[2], VFb[2], S[0]); if (k == 5) GD_MF(f1[6], VFb[2], S[1]); if (k == 6) GD_MF(f1[3], VFb[3], S[0]); if (k == 7) GD_MF(f1[7], VFb[3], S[1]);
      f0[k] = KTF[(8 + k) * 64 + lane];
      if (k == 0) { GD_VF2(vn0, gYB, 12, w2, w3); GD_W4(VFb[1]); }
      if (k == 1) { GD_VF2(vn1, gXA, 0, w0, w1); GD_FLOAD(gYA, gYB, 1, 1); }
      if (k == 2) { GD_VF2(vn1, gXB, 4, w2, w3); GD_W4(VFb[2]); }
      if (k == 3) GD_VF2(vn1, gYA, 8, w0, w1);
      if (k == 4) { GD_VF2(vn1, gYB, 12, w2, w3); GD_W4(VFb[3]); }
      if (k == 5) Vb[0] = pack16<0>(vn0);
      if (k == 6) { Vb[1] = pack16<1>(vn0); GD_ELOAD(eXA, eXB, 0, 0); }
      if (k == 7) { Vb[2] = pack16<0>(vn1); GD_ELOAD(eYA, eYB, 0, 1); }
      GD_SB();
    }
#pragma unroll
    for (int k = 0; k < 8; ++k) {
      if (k < 4) GD_MF(f0[k], VFb[k], S[2]); else GD_MF(f0[k], VFb[k - 4], S[3]);
      if (k < 4) { f1[2 * k] = QKF[(2 * k) * 64 + lane]; f1[2 * k + 1] = QKF[(2 * k + 1) * 64 + lane]; }
      if (k == 0) GD_OINIT(oq0, eXA, eXB, 0);
      if (k == 1) { GD_OINIT(oq0, eYA, eYB, 1); GD_ELOAD(eXA, eXB, 1, 0); }
      if (k == 2) { GD_ELOAD(eYA, eYB, 1, 1); Vb[3] = pack16<1>(vn1); Sb[0] = pack16<0>(S[0]); }
      if (k == 3) GD_OINIT(oq1, eXA, eXB, 0);
      if (k == 4) GD_OINIT(oq1, eYA, eYB, 1);
      if (k == 5) Sb[1] = pack16<1>(S[0]);
      if (k == 6) Sb[2] = pack16<0>(S[1]);
      if (k == 7) Sb[3] = pack16<1>(S[1]);
      GD_SB();
    }
    Pprev = Pc + (size_t)chunk_row0(b, GD_CHUNK(step)) * (NINP * 2);
    lds_barrier();
    GD_SB();
#pragma unroll
    for (int k = 0; k < 8; ++k) {
      if (k < 4) GD_MF(f1[k], Vb[k], oq0); else GD_MF(f1[k], Vb[k - 4], oq1);
      f0[k] = KFn[k * 64 + lane];
      if (k == 0) Sb[4] = pack16<0>(S[2]);
      if (k == 1) Sb[5] = pack16<1>(S[2]);
      if (k == 2) Sb[6] = pack16<0>(S[3]);
      if (k == 3) Sb[7] = pack16<1>(S[3]);
      GD_SB();
    }
  }
  {
    gchar* Pst = Pprev; const unsigned voff = voff_, voff1 = voff_ + NINP * 2;
#pragma unroll
    for (int k = 0; k < 8; ++k) { if (k < 4) { GD_STO(oq0, 4 * k, 0); GD_STO(oq0, 4 * k + 2, 0); } else { GD_STO(oq1, 4 * (k - 4), 1); GD_STO(oq1, 4 * (k - 4) + 2, 1); } }
  }
#undef GD_SB
#undef GD_MF
#undef GD_ZERO
#undef GD_LO
#undef GD_HI
#undef GD_RLOAD
#undef GD_RC2
#undef GD_VF2
#undef GD_W4
#undef GD_FLOAD
#undef GD_ELOAD
#undef GD_OINIT
#undef GD_SCALE
#undef GD_CHUNK
}
#undef GD_STO
}

__device__ __forceinline__ void ph_init_ada(const Params& p) {
  const int TIDX = ltid(); const int BIDX = lbid();
  const size_t n = (size_t)MR * D, gt = (size_t)BIDX * NT + TIDX, gs = (size_t)gridDim.x * NT;
  for (size_t i = gt; i < n; i += gs) {
    int r = (int)(i / D), cc = (int)(i % D);
    xrow(p, r)[cc] = r < ML ? p.x[i] : p.ctx[(size_t)(r - ML) * D + cc];
  }
}
__device__ __forceinline__ void ph_modulate(const Params& p, int l, int which, int nrows) {
  const int TIDX = ltid(); const int BIDX = lbid();
  const int lane = TIDX & 63, wv = TIDX >> 6;
  for (int r = BIDX * 8 + wv; r < nrows; r += gridDim.x * 8) {
    int mj, t, tlen, r0; rowinfo(r, mj, t, tlen, r0);
    const float* xr = xrow_src(p, r, l);
    const float* g = (which ? p.norm2_g : p.norm1_g) + l * D;
    const float* sh = modvec(p, l, mj, which ? 3 : 0); const float* sc = modvec(p, l, mj, which ? 4 : 1);
    float v[16], ss = 0;
#pragma unroll
    for (int i = 0; i < 16; ++i) { v[i] = xr[lane + i * 64]; ss += v[i] * v[i]; }
    ss = wave_sum(ss);
    const float rstd = rsqrtf(ss / D + EPS);
    bf16_t* h = (bf16_t*)(p.ws + OFF_H) + (size_t)r * D;
#pragma unroll
    for (int i = 0; i < 16; ++i) { int cc = lane + i * 64; v[i] = v[i] * rstd * g[cc] * (1.f + sc[cc]) + sh[cc]; h[cc] = f2bf(v[i]); }
    if (which) {
      const float* wr = p.router + (size_t)l * D * NE;
      float lo[16];
#pragma unroll
      for (int e = 0; e < 16; ++e) lo[e] = 0.f;
#pragma unroll
      for (int i = 0; i < 16; ++i) { int cc = lane + i * 64;
#pragma unroll
        for (int e = 0; e < 16; ++e) lo[e] += v[i] * wr[cc * NE + e]; }
      float mx = -1e30f;
#pragma unroll
      for (int e = 0; e < 16; ++e) { lo[e] = wave_sum(lo[e]); mx = fmaxf(mx, lo[e]); }
      float sum = 0;
#pragma unroll
      for (int e = 0; e < 16; ++e) { lo[e] = expf(lo[e] - mx); sum += lo[e]; }
      float* afft = (float*)(p.ws + OFF_AFFT);
      if (lane == 0) {
#pragma unroll
        for (int e = 0; e < 16; ++e) afft[(size_t)e * MR + r] = lo[e] / sum;
      }
    }
  }
}

__device__ __forceinline__ constexpr int ngemm_lds_floats() { return 16 * 65 + 16 * 129; }
template <typename LoadA, typename LoadB, typename Epi>
__device__ __forceinline__ void ngemm_tile(float* lds, int M, int N, int K, int tm, int tn, LoadA lda_, LoadB ldb_, Epi epi) {
  float (*sA)[65] = (float (*)[65])lds; float (*sB)[129] = (float (*)[129])(lds + 16 * 65);
  const int tid = ltid(), tx = tid & 31, ty = tid >> 5;
  float acc[4][4];
#pragma unroll
  for (int i = 0; i < 4; ++i)
#pragma unroll
    for (int j = 0; j < 4; ++j) acc[i][j] = 0.f;
  for (int k0 = 0; k0 < K; k0 += 16) {
#pragma unroll
    for (int i = 0; i < 2; ++i) { int e = tid + i * 512; int rr = e >> 4, kk = e & 15; int gr = tm * 64 + rr; sA[kk][rr] = gr < M ? lda_(gr, k0 + kk) : 0.f; }
#pragma unroll
    for (int i = 0; i < 4; ++i) { int e = tid + i * 512; int kk = e >> 7, cc = e & 127; int gc = tn * 128 + cc; sB[kk][cc] = gc < N ? ldb_(k0 + kk, gc) : 0.f; }
    __syncthreads();
#pragma unroll
    for (int kk = 0; kk < 16; ++kk) {
      float a[4], b[4];
#pragma unroll
      for (int i = 0; i < 4; ++i) { a[i] = sA[kk][ty * 4 + i]; b[i] = sB[kk][tx * 4 + i]; }
#pragma unroll
      for (int i = 0; i < 4; ++i)
#pragma unroll
        for (int j = 0; j < 4; ++j) acc[i][j] += a[i] * b[j];
    }
    __syncthreads();
  }
#pragma unroll
  for (int i = 0; i < 4; ++i)
#pragma unroll
    for (int j = 0; j < 4; ++j) { int rr = tm * 64 + ty * 4 + i, cc = tn * 128 + tx * 4 + j; if (rr < M && cc < N) epi(rr, cc, acc[i][j]); }
}

__device__ __forceinline__ void ph_inproj(const Params& p, int l, float* lds) {
  const int TIDX = ltid(); const int BIDX = lbid();
  const bf16_t* H = (const bf16_t*)(p.ws + OFF_H); const float* W = p.w_in + (size_t)l * D * NIN; bf16_t* P = (bf16_t*)(p.ws + OFF_P);
  const int ntn = (NIN + 127) / 128, ntm = MR / 64;
  for (int vb = BIDX; vb < ntn * ntm; vb += gridDim.x)
    ngemm_tile(lds, MR, NIN, D, vb / ntn, vb % ntn,
               [&](int r, int k) { return bf2f(H[(size_t)r * D + k]); },
               [&](int k, int n) { return W[(size_t)k * NIN + n]; },
               [&](int r, int n, float v) { P[(size_t)r * NINP + n] = f2bf(v); });
}

__device__ __forceinline__ void ph_mla(const Params& p, int l, float* lds) {
  const int TIDX = ltid(); const int BIDX = lbid();
  float* pq = lds; float* pkv = pq + 192; float* pkr = pkv + 128; float* qraw = pkr + 32; float* kvraw = qraw + 384; float* qn = kvraw + 512; float* kn = qn + 384; float* red = kn + 384;
  const int tid = TIDX;
  for (int r = BIDX; r < MR; r += gridDim.x) {
    int mj, t, tlen, r0; rowinfo(r, mj, t, tlen, r0);
    const bf16_t* P = (const bf16_t*)(p.ws + OFF_P) + (size_t)r * NINP;
    __syncthreads();
    if (tid < 192) pq[tid] = bf2f(P[PC_Q + tid]);
    if (tid < 128) pkv[tid] = bf2f(P[PC_KV + tid]);
    if (tid < 32) pkr[tid] = bf2f(P[PC_KR + tid]);
    __syncthreads();
    if (tid < 64) { float s = 0; for (int k = tid; k < 192; k += 64) s += pq[k] * pq[k]; s = wave_sum(s); if (tid == 0) red[0] = rsqrtf(s / 192.f + EPS); }
    else if (tid < 128) { float s = 0; for (int k = tid - 64; k < 128; k += 64) s += pkv[k] * pkv[k]; s = wave_sum(s); if (tid == 64) red[1] = rsqrtf(s / 128.f + EPS); }
    __syncthreads();
    const float rq = red[0], rkv = red[1];
    const float* wuq = p.w_uq + (size_t)l * 192 * 384; const float* qan = p.q_a_norm + l * 192;
    const float* wukv = p.w_ukv + (size_t)l * 128 * 512; const float* kvan = p.kv_a_norm + l * 128;
    if (tid < 384) { float a = 0; for (int k = 0; k < 192; ++k) a += pq[k] * rq * qan[k] * wuq[k * 384 + tid]; qraw[tid] = a; }
    { float a = 0; for (int k = 0; k < 128; ++k) a += pkv[k] * rkv * kvan[k] * wukv[k * 512 + tid]; kvraw[tid] = a; }
    __syncthreads();
    const float* qnw = p.q_norm + l * 96; const float* knw = p.k_norm + l * 96;
    if (tid < 384) {
      int h = tid / 96, d = tid % 96;
      float sq = 0, sk = 0;
      for (int dd = 0; dd < 96; ++dd) { float a = qraw[h * 96 + dd]; sq += a * a; float b = dd < 64 ? kvraw[h * 128 + dd] : pkr[dd - 64]; sk += b * b; }
      float kval = d < 64 ? kvraw[h * 128 + d] : pkr[d - 64];
      qn[tid] = qraw[tid] * rsqrtf(sq / 96.f + EPS) * qnw[d];
      kn[tid] = kval * rsqrtf(sk / 96.f + EPS) * knw[d];
    }
    __syncthreads();
    const bool lat = r < ML; const int b = lat ? (r >> 13) : ((r - ML) >> 8); const int pos = lat ? TC + t : t;
    bf16_t* Q = (bf16_t*)(p.ws + OFF_QKV); bf16_t* Kb = Q + QK_ELEMS; bf16_t* Vb = Kb + QK_ELEMS;
    {
      int h = tid >> 7, d = tid & 127;
      float qv = 0, kv = 0;
      if (d < 96) {
        qv = qn[h * 96 + d]; kv = kn[h * 96 + d];
        if (lat && d >= 64) {
          int part = (d - 64) >> 4, w = (d - 64) & 15, i = w & 7; bool first = w < 8;
          float posv = part == 0 ? (float)(t >> 6) : (float)(t & 63);
          float invf = powf(10000.f, -(float)i / 8.f);
          float ang = posv * invf, cs = cosf(ang), sn = sinf(ang);
          int i1 = h * 96 + 64 + part * 16 + i, i2 = i1 + 8;
          qv = first ? qn[i1] * cs - qn[i2] * sn : qn[i2] * cs + qn[i1] * sn;
          kv = first ? kn[i1] * cs - kn[i2] * sn : kn[i2] * cs + kn[i1] * sn;
        }
      }
      size_t o = ((size_t)(b * 4 + h) * TK + pos) * 128 + d;
      Q[o] = f2bf(qv); Kb[o] = f2bf(kv);
      if (d < 64) Vb[((size_t)(b * 4 + h) * TK + pos) * 64 + d] = f2bf(kvraw[h * 128 + 64 + d]);
    }
  }
}

__device__ __forceinline__ void ph_gdnprep(const Params& p, int l, float* lds) {
  const int TIDX = ltid(); const int BIDX = lbid();
  float* cv = lds; float* rs = lds + 1536;
  const int tid = TIDX;
  const bf16_t* P = (const bf16_t*)(p.ws + OFF_P);
  const float* cw = p.conv_w + (size_t)l * 3 * 1536;
  for (int r = BIDX; r < MR; r += gridDim.x) {
    int mj, t, tlen, r0; rowinfo(r, mj, t, tlen, r0);
    __syncthreads();
    for (int c = tid; c < 1536; c += NT) {
      float a = 0;
      for (int j = 0; j < 3; ++j) { int tt = t + j - 1; if (tt >= 0 && tt < tlen) a += cw[j * 1536 + c] * bf2f(P[(size_t)(r0 + tt) * NINP + PC_GQ + c]); }
      cv[c] = silu_f(a);
    }
    __syncthreads();
    if (tid < 8) { float s = 0; for (int d = 0; d < 128; ++d) { float v = cv[tid * 128 + d]; s += v * v; } rs[tid] = rsqrtf(s + EPS) * (tid < 4 ? 0.08838834764831845f : 1.f); }
    __syncthreads();
    float* G = (float*)(p.ws + OFF_RB) + (size_t)r * 1536;
    for (int c = tid; c < 1536; c += NT) G[c] = c < 1024 ? cv[c] * rs[c >> 7] : cv[c];
    if (tid < 8) {
      float* gb = (float*)(p.ws + OFF_GB) + (size_t)r * 16;
      float pa = bf2f(P[(size_t)r * NINP + PC_A + tid]), pb = bf2f(P[(size_t)r * NINP + PC_B + tid]);
      gb[tid] = -expf(p.a_log[l * 8 + tid]) * softplus_f(pa + p.dt_bias[l * 8 + tid]);
      gb[8 + tid] = sigmoid_f(pb);
    }
  }
}
__device__ __forceinline__ void ph_scan(const Params& p, float* lds) {
  const int TIDX = ltid(); const int BIDX = lbid();
  if (BIDX >= 16) return;
  float* sk = lds; float* sq = lds + 128; float* red = lds + 256; float* red2 = lds + 256 + 512;
  const int tid = TIDX, e = tid & 127, part = tid >> 7;
  const int chain = BIDX, dir = chain & 1, h = (chain >> 1) & 3, b = chain >> 3;
  const float* G = (const float*)(p.ws + OFF_RB); const float* GB = (const float*)(p.ws + OFF_GB);
  bf16_t* P = (bf16_t*)(p.ws + OFF_P);
  float S[32];
#pragma unroll
  for (int d = 0; d < 32; ++d) S[d] = 0.f;
  __syncthreads();
  for (int step = 0; step < TC + T; ++step) {
    int row;
    if (step < TC) row = ML + b * TC + (dir ? TC - 1 - step : step);
    else { int i = step - TC; row = b * T + (dir ? T - 1 - i : i); }
    const float* q = G + (size_t)row * 1536 + h * 128; const float* k = q + 512; const float v = q[1024 + e];
    if (tid < 128) sk[tid] = k[tid]; else if (tid < 256) sq[tid - 128] = q[tid - 128];
    const float g = GB[(size_t)row * 16 + dir * 4 + h], beta = GB[(size_t)row * 16 + 8 + dir * 4 + h];
    const float eg = expf(g);
    __syncthreads();
    float ks = 0;
#pragma unroll
    for (int d = 0; d < 32; ++d) ks += sk[part * 32 + d] * S[d];
    red[part * 128 + e] = ks;
    __syncthreads();
    ks = red[e] + red[128 + e] + red[256 + e] + red[384 + e];
    const float vn = beta * (v - eg * ks);
    float o = 0;
#pragma unroll
    for (int d = 0; d < 32; ++d) { S[d] = eg * S[d] + sk[part * 32 + d] * vn; o += sq[part * 32 + d] * S[d]; }
    red2[part * 128 + e] = o;
    __syncthreads();
    if (part == 0) P[(size_t)row * NINP + (dir ? PC_OB : PC_OF) + h * 128 + e] = f2bf(red2[e] + red2[128 + e] + red2[256 + e] + red2[384 + e]);
  }
  __syncthreads();
}
__device__ __forceinline__ void ph_attn(const Params& p, bool need_ctx, float* lds) {
  const int TIDX = ltid(); const int BIDX = lbid();
  float (*sK)[96] = (float (*)[96])lds; float (*sV)[64] = (float (*)[64])(lds + 32 * 96);
  const int tid = TIDX;
  const int nlat = NB * 4 * (T / NT), nitem = nlat + (need_ctx ? NB * 4 : 0);
  const bf16_t* Q = (const bf16_t*)(p.ws + OFF_QKV); const bf16_t* Kb = Q + QK_ELEMS; const bf16_t* Vb = Kb + QK_ELEMS;
  for (int it = gridDim.x - 1 - BIDX; it < nitem; it += gridDim.x) {
    const bool ctxq = it >= nlat;
    int b, h, qt;
    if (!ctxq) { qt = it % (T / NT); h = (it / (T / NT)) & 3; b = it / (4 * (T / NT)); } else { int j = it - nlat; qt = 0; h = j & 3; b = j >> 2; }
    const bool active = !ctxq || tid < TC;
    const int qpos = ctxq ? (active ? tid : 0) : TC + qt * NT + tid;
    const int nk = ctxq ? TC : TK;
    const size_t bh = (size_t)(b * 4 + h) * TK;
    float q[96], o[64];
#pragma unroll
    for (int d = 0; d < 96; ++d) q[d] = bf2f(Q[(bh + qpos) * 128 + d]);
#pragma unroll
    for (int d = 0; d < 64; ++d) o[d] = 0.f;
    float m = -1e30f, lsum = 0.f;
    const float scale = 0.10206207261596575f;
    for (int k0 = 0; k0 < nk; k0 += 32) {
      __syncthreads();
      for (int e = tid; e < 32 * 96; e += NT) { int j = e / 96, d = e % 96; sK[j][d] = bf2f(Kb[(bh + k0 + j) * 128 + d]); }
      for (int e = tid; e < 32 * 64; e += NT) { int j = e >> 6, d = e & 63; sV[j][d] = bf2f(Vb[(bh + k0 + j) * 64 + d]); }
      __syncthreads();
      for (int j = 0; j < 32; ++j) {
        float s = 0;
#pragma unroll
        for (int d = 0; d < 96; ++d) s += q[d] * sK[j][d];
        s *= scale;
        if (s > m) { float a = __expf(m - s); lsum *= a;
#pragma unroll
          for (int d = 0; d < 64; ++d) o[d] *= a;
          m = s; }
        float pe = __expf(s - m); lsum += pe;
#pragma unroll
        for (int d = 0; d < 64; ++d) o[d] += pe * sV[j][d];
      }
    }
    if (active) {
      const int row = ctxq ? ML + b * TC + qpos : b * T + (qpos - TC);
      bf16_t* cat = (bf16_t*)(p.ws + OFF_H) + (size_t)row * D + h * 64;
      float inv = 1.f / lsum;
#pragma unroll
      for (int d = 0; d < 64; ++d) cat[d] = f2bf(o[d] * inv);
    }
  }
}
__device__ __forceinline__ void ph_gdnfin_pool(const Params& p, int l, int nrows, float* lds) {
  const int TIDX = ltid(); const int BIDX = lbid();
  float* ov = lds; float* rs = lds + 512; float* dv = lds + 520;
  const int tid = TIDX;
  const bf16_t* P = (const bf16_t*)(p.ws + OFF_P);
  for (int r = BIDX; r < nrows; r += gridDim.x) {
    int mj, t, tlen, r0; rowinfo(r, mj, t, tlen, r0);
    bf16_t* cat = (bf16_t*)(p.ws + OFF_H) + (size_t)r * D;
    __syncthreads();
    ov[tid] = bf2f(P[(size_t)r * NINP + PC_OF + tid]) + bf2f(P[(size_t)r * NINP + PC_OB + tid]);
    if (tid < 256) {
      int c = tid, gi = c >> 6, win = 2 << gi;
      int lo = t - win / 2, hi = lo + win; lo = lo < 0 ? 0 : lo; hi = hi > tlen ? tlen : hi;
      float s = 0; for (int tt = lo; tt < hi; ++tt) s += bf2f(P[(size_t)(r0 + tt) * NINP + PC_POOL + c]);
      dv[c] = s / (float)(hi - lo) - bf2f(P[(size_t)r * NINP + PC_POOL + c]);
    }
    __syncthreads();
    if (tid < 4) { float s = 0; for (int d = 0; d < 128; ++d) { float v = ov[tid * 128 + d]; s += v * v; } rs[tid] = rsqrtf(s / 128.f + EPS); }
    __syncthreads();
    const float* gn = p.gdn_norm_g + l * 128;
    { int c = tid; float z = bf2f(P[(size_t)r * NINP + PC_Z + c]); cat[256 + c] = f2bf(ov[c] * rs[c >> 7] * gn[c & 127] * silu_f(z)); }
    if (tid < 256) {
      int j = tid, gi = j >> 6, dd = j & 63;
      const float* pw = p.pool_w + ((size_t)l * 4 + gi) * 64 * 64;
      float a = 0; for (int c = 0; c < 64; ++c) a += dv[gi * 64 + c] * pw[c * 64 + dd];
      cat[768 + j] = f2bf(a * p.pool_scale[l * 256 + j]);
    }
  }
}
__device__ __forceinline__ void ph_outproj(const Params& p, int l, int nrows, float* lds) {
  const int TIDX = ltid(); const int BIDX = lbid();
  const bf16_t* A = (const bf16_t*)(p.ws + OFF_H); const float* W = p.w_out + (size_t)l * D * D;
  const int ntn = D / 128, ntm = nrows / 64;
  for (int vb = BIDX; vb < ntn * ntm; vb += gridDim.x)
    ngemm_tile(lds, nrows, D, D, vb / ntn, vb % ntn,
               [&](int r, int k) { return bf2f(A[(size_t)r * D + k]); },
               [&](int k, int n) { return W[(size_t)k * D + n]; },
               [&](int r, int n, float v) { int mj = r < ML ? (r >> 13) : 2; xrow(p, r)[n] += modvec(p, l, mj, 2)[n] * v; });
}
__device__ __forceinline__ void ph_topk(const Params& p, int nseq) {
  const int TIDX = ltid(); const int BIDX = lbid();
  const size_t total = (size_t)nseq * NE * T;
  for (size_t i = (size_t)BIDX * NT + TIDX; i < total; i += (size_t)gridDim.x * NT) {
    const int t = (int)(i % T), e = (int)((i / T) % NE), s = (int)(i / ((size_t)T * NE));
    const int tlen = s < 2 ? T : TC, cap = s < 2 ? CAPL : CAPC, r0 = s < 2 ? s * T : ML + (s - 2) * TC;
    if (t >= tlen) continue;
    const float* a = (const float*)(p.ws + OFF_AFFT) + (size_t)e * MR + r0;
    const float me = a[t];
    int rank = 0;
    for (int u = 0; u < tlen; ++u) { float o = a[u]; rank += (o > me || (o == me && u < t)) ? 1 : 0; }
    int* slot = (int*)(p.ws + OFF_SLOT);
    if (rank < cap) { int pi = pair_base(s, e) + rank; ((int*)(p.ws + OFF_IDX))[pi] = r0 + t; ((float*)(p.ws + OFF_GATE))[pi] = me; slot[(size_t)(r0 + t) * 16 + e] = rank; }
    else slot[(size_t)(r0 + t) * 16 + e] = -1;
  }
}
__device__ __forceinline__ void ph_moe_gu(const Params& p, int l, int grp0, int grp1, float* lds) {
  const int TIDX = ltid(); const int BIDX = lbid();
  const bf16_t* H = (const bf16_t*)(p.ws + OFF_H);
  float* tmp = (float*)(p.ws + OFF_P);
  const int ntn = DEXP / 128, ntm = CAPL / 64, per = ntn * ntm;
  for (int vb = BIDX; vb < (grp1 - grp0) * per; vb += gridDim.x) {
    const int grp = grp0 + vb / per, tt = vb % per, tm = tt / ntn, tn = tt % ntn;
    const int s = grp >> 4, e = grp & 15; const int cap = s < 2 ? CAPL : CAPC;
    if (tm * 64 >= cap) continue;
    const int pb = pair_base(s, e);
    const int* idx = (const int*)(p.ws + OFF_IDX) + pb;
    const float* Wg = p.w_gate + ((size_t)l * NE + e) * D * DEXP; const float* Wu = p.w_up + ((size_t)l * NE + e) * D * DEXP;
    bf16_t* hid = (bf16_t*)(p.ws + OFF_HID) + (size_t)pb * DEXP;
    ngemm_tile(lds, cap, DEXP, D, tm, tn,
               [&](int r, int k) { return bf2f(H[(size_t)idx[r] * D + k]); },
               [&](int k, int n) { return Wg[(size_t)k * DEXP + n]; },
               [&](int r, int n, float v) { tmp[(size_t)(pb + r) * DEXP + n] = v; });
    ngemm_tile(lds, cap, DEXP, D, tm, tn,
               [&](int r, int k) { return bf2f(H[(size_t)idx[r] * D + k]); },
               [&](int k, int n) { return Wu[(size_t)k * DEXP + n]; },
               [&](int r, int n, float v) { float g = tmp[(size_t)(pb + r) * DEXP + n]; hid[(size_t)r * DEXP + n] = f2bf(silu_f(g) * v); });
  }
}
__device__ __forceinline__ void ph_moe_down(const Params& p, int l, int grp0, int grp1, float* lds) {
  const int TIDX = ltid(); const int BIDX = lbid();
  const int ntn = D / 128, ntm = CAPL / 64, per = ntn * ntm;
  for (int vb = BIDX; vb < (grp1 - grp0) * per; vb += gridDim.x) {
    const int grp = grp0 + vb / per, tt = vb % per, tm = tt / ntn, tn = tt % ntn;
    const int s = grp >> 4, e = grp & 15; const int cap = s < 2 ? CAPL : CAPC;
    if (tm * 64 >= cap) continue;
    const int pb = pair_base(s, e);
    const bf16_t* hid = (const bf16_t*)(p.ws + OFF_HID) + (size_t)pb * DEXP;
    const float* Wd = p.w_down + ((size_t)l * NE + e) * DEXP * D;
    const float* gate = (const float*)(p.ws + OFF_GATE) + pb;
    bf16_t* Y = (bf16_t*)(p.ws + OFF_Y) + (size_t)pb * D;
    ngemm_tile(lds, cap, D, DEXP, tm, tn,
               [&](int r, int k) { return bf2f(hid[(size_t)r * DEXP + k]); },
               [&](int k, int n) { return Wd[(size_t)k * D + n]; },
               [&](int r, int n, float v) { Y[(size_t)r * D + n] = f2bf(v * gate[r]); });
  }
}
__device__ __forceinline__ void ph_combine(const Params& p, int l, int nrows) {
  const int TIDX = ltid(); const int BIDX = lbid();
  const bf16_t* Y = (const bf16_t*)(p.ws + OFF_Y);
  for (int r = BIDX; r < nrows; r += gridDim.x) {
    int mj, t, tlen, r0; rowinfo(r, mj, t, tlen, r0);
    const int s = r < ML ? (r >> 13) : 2 + ((r - ML) >> 8);
    const int* slot = (const int*)(p.ws + OFF_SLOT) + (size_t)r * 16;
    const float* g2 = modvec(p, l, mj, 5);
    float* xr = xrow(p, r);
    for (int c = TIDX; c < D; c += NT) {
      float a = 0;
      for (int e = 0; e < 16; ++e) { int sl = slot[e]; if (sl >= 0) a += bf2f(Y[(size_t)(pair_base(s, e) + sl) * D + c]); }
      xr[c] += g2[c] * a;
    }
  }
}


__device__ __forceinline__ void transpose_cvt_tile(float* lds, const float* W, int ldw, int N, bf16_t* Wt, int K, int rmul, int roff, int tk, int tn, int tid, const float* kscale = nullptr) {
  __syncthreads();
#pragma unroll
  for (int i = 0; i < 8; ++i) { int e = tid + i * NT; int kk = e >> 6, nn = e & 63; int n = tn * 64 + nn; lds[kk * 65 + nn] = n < N ? W[(size_t)(tk * 64 + kk) * ldw + n] * (kscale ? kscale[tk * 64 + kk] : 1.f) : 0.f; }
  __syncthreads();
#pragma unroll
  for (int i = 0; i < 8; ++i) { int e = tid + i * NT; int nn = e >> 6, kk = e & 63; int n = tn * 64 + nn; if (n < N) Wt[(size_t)(n * rmul + roff) * K + tk * 64 + kk] = f2bf(lds[kk * 65 + nn]); }
}
__device__ __forceinline__ void transpose_cvt_4tiles(float* lds, const float* W, int ldw, int N, bf16_t* Wt, int K, int rmul, int roff, int t4, int ntiles, int tid, const float* kscale) {
  const int ntn = (N + 63) / 64;
  float v[4][8];
#pragma unroll
  for (int q = 0; q < 4; ++q) { const int t = t4 + q, tk = t / ntn, tn = t % ntn;
#pragma unroll
    for (int i = 0; i < 8; ++i) { const int el = tid + i * NT, kk = el >> 6, nn = el & 63, n = tn * 64 + nn;
      v[q][i] = (t < ntiles && n < N) ? W[(size_t)(tk * 64 + kk) * ldw + n] * (kscale ? kscale[tk * 64 + kk] : 1.f) : 0.f; } }
  __syncthreads();
#pragma unroll
  for (int q = 0; q < 4; ++q)
#pragma unroll
    for (int i = 0; i < 8; ++i) { const int el = tid + i * NT, kk = el >> 6, nn = el & 63; lds[q * 4160 + kk * 65 + nn] = v[q][i]; }
  __syncthreads();
#pragma unroll
  for (int q = 0; q < 4; ++q) { const int t = t4 + q, tk = t / ntn, tn = t % ntn;
#pragma unroll
    for (int i = 0; i < 4; ++i) { const int el = tid + i * NT, nn = el >> 5, k2 = (el & 31) * 2, n = tn * 64 + nn;
      if (t < ntiles && n < N) *(unsigned*)(Wt + (size_t)(n * rmul + roff) * K + tk * 64 + k2) = gd::pk(lds[q * 4160 + k2 * 65 + nn], lds[q * 4160 + (k2 + 1) * 65 + nn]); } }
}
__device__ __forceinline__ void ph_prep_weights(const Params& p, float* lds) {
  const int TIDX = ltid(); const int BIDX = lbid();
  bf16_t* winT = (bf16_t*)(p.ws + OFF_WINT); bf16_t* woutT = (bf16_t*)(p.ws + OFF_WOUTT);
  const int g_in = 2 * 168, g_out = 2 * 64, g_q = 2 * 5, g_kv = 2 * 4;
  for (int vb = BIDX; vb < g_in + g_out + g_q + g_kv; vb += gridDim.x) {
    if (vb < g_in) { const int l = vb / 168, r = vb % 168; transpose_cvt_4tiles(lds, p.w_in + (size_t)l * D * NIN, NIN, NIN, winT + (size_t)l * NINP * D, D, 1, 0, r * 4, 16 * 42, TIDX, nullptr); }
    else if (vb < g_in + g_out) { const int v = vb - g_in, l = v / 64, r = v % 64; transpose_cvt_4tiles(lds, p.w_out + (size_t)l * D * D, D, D, woutT + (size_t)l * D * D, D, 1, 0, r * 4, 256, TIDX, nullptr); }
    else if (vb < g_in + g_out + g_q) { const int v = vb - g_in - g_out, l = v / 5, r = v % 5;
      transpose_cvt_4tiles(lds, p.w_uq + (size_t)l * 192 * 384, 384, 384, (bf16_t*)(p.ws + OFF_WUP) + (size_t)l * 1024 * 256, 256, 1, 0, r * 4, 18, TIDX, p.q_a_norm + l * 192); }
    else { const int v = vb - g_in - g_out - g_q, l = v / 4, r = v % 4;
      transpose_cvt_4tiles(lds, p.w_ukv + (size_t)l * 128 * 512, 512, 512, (bf16_t*)(p.ws + OFF_WUP) + (size_t)l * 1024 * 256 + 512 * 256, 256, 1, 0, r * 4, 16, TIDX, p.kv_a_norm + l * 128); }
  }
  for (int q = 0; q < 16; ++q) {
    const int i = (q * (int)gridDim.x + BIDX) * NT + TIDX; if (i >= 2 * 1024 * 256) break;
    const int k = i & 255, n = (i >> 8) & 1023;
    if ((n < 384 && k >= 192) || (n >= 384 && n < 512) || (n >= 512 && k >= 128)) ((bf16_t*)(p.ws + OFF_WUP))[i] = 0;
  }
  for (size_t i = (size_t)BIDX * NT + TIDX; i < (size_t)2 * (NINP - NIN) * D; i += (size_t)gridDim.x * NT) {
    const int l = (int)(i / ((size_t)(NINP - NIN) * D)); const size_t r = i % ((size_t)(NINP - NIN) * D);
    winT[(size_t)l * NINP * D + (size_t)NIN * D + r] = 0;
  }
  for (int i = BIDX * NT + TIDX; i < 2 * 4 * 64 * 64; i += (int)gridDim.x * NT) { const int c = i & 63, o = (i >> 6) & 63, lg = i >> 12;
    ((bf16_t*)(p.ws + OFF_POOLWT))[i] = f2bf(p.pool_w[(size_t)lg * 4096 + c * 64 + o]); }
}
__device__ __forceinline__ void ph_inproj_fast(const Params& p, int l, char* smem) {
  DenseSched S; S.init(MR / 256, NINP / 256, (int)gridDim.x, lbid());
  S.A = p.ws + OFF_H; S.Bt = p.ws + OFF_WINT + (size_t)l * NINP * D * 2; S.lda = D; S.ldb = D; S.K = D;
  EpiStoreBf16 E; E.O = (bf16_t*)(p.ws + OFF_P); E.ldc = NINP;
  pg8::gemm_phase(( PG8_LAS unsigned char*)smem, S, E);
}

__device__ __forceinline__ void ph_outproj_fast(const Params& p, int l, char* smem) {
  DenseSched S; S.init(ML / 256, D / 256, (int)gridDim.x, lbid());
  S.A = p.ws + OFF_H; S.Bt = p.ws + OFF_WOUTT + (size_t)l * D * D * 2; S.lda = D; S.ldb = D; S.K = D;
  EpiStoreBf16 E; E.O = (bf16_t*)(p.ws + OFF_YO); E.ldc = D;
  pg8::gemm_phase((PG8_LAS unsigned char*)smem, S, E);
}

constexpr int PMW_EARLY = 256;
template <bool EARLY>
__device__ __forceinline__ void ph_prep_moe_weights(const Params& p, int l, float* lds, int b0, int nb) {
  const int TIDX = ltid(); const int BIDX = lbid() - b0;
  if (BIDX < 0) return;
  constexpr int LIMIT = EARLY ? PMW_EARLY : NE * 3 * 32 - PMW_EARLY;
  bf16_t* gu = (bf16_t*)(p.ws + OFF_MOEGU); bf16_t* dn = (bf16_t*)(p.ws + OFF_MOED);
  unsigned* ctr = (unsigned*)(p.ws + OFF_BAR) + (EARLY ? 20 : 16) + l; volatile int* bc = (volatile int*)(lds + 4 * 4160);
  __syncthreads();
  if (TIDX == 0) bc[0] = (int)__hip_atomic_fetch_add(ctr, 1u, __ATOMIC_RELAXED, __HIP_MEMORY_SCOPE_AGENT);
  __syncthreads();
  int vb = __builtin_amdgcn_readfirstlane(bc[0]);
  for (int it = 1; ; ++it) {
    if (vb >= LIMIT) break;
    int e, r;
    if (EARLY) { e = 2 + (vb >> 5); r = 64 + (vb & 31); }
    else if (vb < 1024) { e = vb >> 6; r = vb & 63; }
    else if (vb < 1088) { e = (vb - 1024) >> 5; r = 64 + (vb & 31); }
    else { const int jj = PMW_EARLY + (vb - 1088); e = 2 + (jj >> 5); r = 64 + (jj & 31); }
    const int which = r >> 5, t4 = (r & 31) * 4;
    const float* W; int ldw, K, rmul, roff; bf16_t* Wt;
    if (which < 2) { W = (which ? p.w_up : p.w_gate) + ((size_t)l * NE + e) * D * DEXP; ldw = DEXP; K = D; rmul = 2; roff = which; Wt = gu + (size_t)e * D * D; }
    else { W = p.w_down + ((size_t)l * NE + e) * DEXP * D; ldw = D; K = DEXP; rmul = 1; roff = 0; Wt = dn + (size_t)e * D * DEXP; }
    const int ntn = ldw / 64;
    float v[4][8];
#pragma unroll
    for (int q = 0; q < 4; ++q) { const int t = t4 + q, tk = t / ntn, tn = t % ntn;
#pragma unroll
      for (int i = 0; i < 8; ++i) { const int el = TIDX + i * NT, kk = el >> 6, nn = el & 63; v[q][i] = __builtin_nontemporal_load(&W[(size_t)(tk * 64 + kk) * ldw + tn * 64 + nn]); } }
    if (TIDX == 0) bc[it & 1] = (int)__hip_atomic_fetch_add(ctr, 1u, __ATOMIC_RELAXED, __HIP_MEMORY_SCOPE_AGENT);
    __syncthreads();
#pragma unroll
    for (int q = 0; q < 4; ++q)
#pragma unroll
      for (int i = 0; i < 8; ++i) { const int el = TIDX + i * NT, kk = el >> 6, nn = el & 63; lds[q * 4160 + kk * 65 + nn] = v[q][i]; }
    __syncthreads();
#pragma unroll
    for (int q = 0; q < 4; ++q) { const int t = t4 + q, tk = t / ntn, tn = t % ntn;
#pragma unroll
      for (int i = 0; i < 4; ++i) { const int el = TIDX + i * NT, nn = el >> 5, k2 = (el & 31) * 2;
        const unsigned w = gd::pk(lds[q * 4160 + k2 * 65 + nn], lds[q * 4160 + (k2 + 1) * 65 + nn]);
        *(unsigned*)(Wt + (size_t)((tn * 64 + nn) * rmul + roff) * K + tk * 64 + k2) = w; } }
    vb = __builtin_amdgcn_readfirstlane(bc[it & 1]);
  }
}
__device__ __forceinline__ void ph_gather(const Params& p) {
  const int TIDX = ltid(); const int BIDX = lbid();
  const int lane = TIDX & 63, wv = TIDX >> 6;
  const int* idx = (const int*)(p.ws + OFF_IDX);
  const uint4* H = (const uint4*)(p.ws + OFF_H); uint4* xs = (uint4*)(p.ws + OFF_XS);
  for (int r = BIDX * 8 + wv; r < NB * NE * CAPL; r += gridDim.x * 8) {
    const int src = idx[r];
    const uint4 a = H[(size_t)src * 128 + lane], b = H[(size_t)src * 128 + 64 + lane];
    xs[(size_t)r * 128 + lane] = a; xs[(size_t)r * 128 + 64 + lane] = b;
  }
}
__device__ __forceinline__ void ph_moe_gu_fast(const Params& p, char* smem) {
  MoeSched S; S.init(NB * NE * CAPL / 256, 2 * DEXP / 256, (int)gridDim.x, lbid());
  S.A = p.ws + OFF_H; S.Bt = p.ws + OFF_MOEGU; S.lda = D; S.ldb = D; S.K = D; S.bstride = (size_t)D * D * 2; S.gidx = (const int*)(p.ws + OFF_IDX); S.gather = true;
  EpiSwiGLU E; E.O = (bf16_t*)(p.ws + OFF_HID);
  pg8::gemm_phase<EpiSwiGLU, MoeSched, true>((PG8_LAS unsigned char*)smem, S, E);
}
__device__ __forceinline__ void ph_moe_down_fast(const Params& p, char* smem) {
  MoeSched S; S.init(NB * NE * CAPL / 256, D / 256, (int)gridDim.x, lbid());
  S.A = p.ws + OFF_HID; S.Bt = p.ws + OFF_MOED; S.lda = DEXP; S.ldb = DEXP; S.K = DEXP; S.bstride = (size_t)D * DEXP * 2; S.gidx = nullptr; S.gather = false;
  EpiGateBf16 E; E.O = (bf16_t*)(p.ws + OFF_Y); E.gate = (const float*)(p.ws + OFF_GATE);
  pg8::gemm_phase((PG8_LAS unsigned char*)smem, S, E);
}

__device__ __forceinline__ void attn_ctx_item(const Params& p, int j, char* smem) {
  const bf16_t* Q = (const bf16_t*)(p.ws + OFF_QKV); const bf16_t* Kb = Q + QK_ELEMS; const bf16_t* Vb = Kb + QK_ELEMS;
  const int h = j & 3, b = j >> 2; const size_t bh = (size_t)(b * 4 + h) * TK;
  fa::attn_body(Q + bh * 128, Kb + bh * 128, Vb + bh * 64, (bf16_t*)(p.ws + OFF_H) + (size_t)(ML + b * TC) * D + h * 64, D, TC, smem);
}
__device__ __forceinline__ void attn_seg(const Params& p, int x, int qt, int off, int len, char* smem) {
  const bf16_t* Q = (const bf16_t*)(p.ws + OFF_QKV); const bf16_t* Kb = Q + QK_ELEMS; const bf16_t* Vb = Kb + QK_ELEMS;
  const int h = x & 3, b = x >> 2, part = off == 0 ? 0 : 1, kv0 = off * 128;
  const size_t bh = (size_t)(b * 4 + h) * TK; const int row0 = b * T + qt * 256;
  bf16_t* op = (bf16_t*)(p.ws + OFF_OPART) + ((size_t)part * ML + row0) * 256 + h * 64;
  float* ml = (float*)(p.ws + OFF_MLPART) + (((size_t)part * ML + row0) * 4 + h) * 2;
  fa::attn_body(Q + (bh + TC + qt * 256) * 128, Kb + (bh + kv0) * 128, Vb + (bh + kv0) * 64, op, 256, len * 128, smem, ml, 8);
  if (off == 0 && len == TK / 128) {
    const int t = ltid();
    int mk = (int)0xf149f2ca, mz = 0; asm volatile("" : "+s"(mk), "+s"(mz));
    if (t < 256) *(float2*)((float*)(p.ws + OFF_MLPART) + (((size_t)ML + row0 + t) * 4 + h) * 2) = make_float2(__int_as_float(mk), __int_as_float(mz));
  }
}
__device__ __forceinline__ void ph_attn_fast(const Params& p, bool need_ctx, char* smem) {
  const int BIDX = lbid();
  const int nns = (int)gridDim.x - 32;
  if (BIDX >= 32) {
    const int x = BIDX & 7, j = (BIDX - 32) >> 3, nj = nns >> 3;
    constexpr int PPQ = TK / 128, NPAIRS = 32 * PPQ;
    const int hi = (NPAIRS * (j + 1)) / nj;
    for (int cur = (NPAIRS * j) / nj; cur < hi; ) {
      const int qt = cur / PPQ, off = cur - qt * PPQ, len = min(PPQ - off, hi - cur);
      attn_seg(p, x, qt, off, len, smem);
      cur += len;
    }
    if (need_ctx && j == nj - 1) attn_ctx_item(p, x, smem);
  }
}

__device__ __forceinline__ void gdn_stage_convw(const Params& p, int l, char* smem, int t, int n) {
  const float* cw = p.conv_w + (size_t)l * 3 * 1536; float* cwl = (float*)(smem + gd::L_CW);
  for (int i = t; i < 3 * 1536 / 4; i += n) ((float4*)cwl)[i] = ((const float4*)cw)[i];
}
static_assert(gd::L_CW >= pg8::STAGE_BYTES, "the conv weights must sit above the GEMM body's LDS");
__device__ __forceinline__ void ph_gdn_precompute(const Params& p, int l, char* smem) {
  const int TIDX = ltid(); const int BIDX = lbid();
  __syncthreads();
  const int nit = NB * 4 * gd::NCH;
  gd::pc_u4 cur[3][4], nxt[3][4];
  if (BIDX < nit) gd::precompute_load(p, (BIDX / gd::NCH) >> 2, (BIDX / gd::NCH) & 3, BIDX % gd::NCH, TIDX, cur);
  for (int it = BIDX; it < nit; it += gridDim.x) {
    const int c = it % gd::NCH, bh = it / gd::NCH;
    const int itn = it + (int)gridDim.x;
    gd::precompute_item(p, l, bh >> 2, bh & 3, c, smem, TIDX, cur, nxt, itn < nit ? itn : -1);
#pragma unroll
    for (int a = 0; a < 3; ++a)
#pragma unroll
      for (int q = 0; q < 4; ++q) cur[a][q] = nxt[a][q];
  }
  __syncthreads();
}
__device__ __forceinline__ void ph_scan_fast(const Params& p, char* smem) {
  const int TIDX = ltid(); const int BIDX = lbid();
  if (BIDX < 32) gd::scan_unit_lds(p, (((BIDX & 7) + 8 * (BIDX >> 4)) << 1) | ((BIDX >> 3) & 1), smem, TIDX);
}

struct MlaSched : pg8::GridOrder {
  const char* P; const char* W; int lda, ldb, K; const int* gidx;
  __device__ __forceinline__ const char* a_ptr(const pg8::Unit& u) const { return P + (size_t)u.pm * 256 * NINP * 2 + (u.pn < 2 ? PC_Q : PC_KV) * 2; }
  __device__ __forceinline__ const char* b_ptr(const pg8::Unit& u) const { return W + (size_t)u.pn * 256 * 256 * 2; }
};
__device__ __forceinline__ void ph_mla_gemm(const Params& p, int l, char* smem) {
  if (lbid() < 32) return;
  MlaSched S; S.init(MR / 256, 4, (int)gridDim.x - 32, lbid() - 32);
  S.P = p.ws + OFF_P; S.W = p.ws + OFF_WUP + (size_t)l * 1024 * 256 * 2; S.lda = NINP; S.ldb = 256; S.K = 256; S.gidx = nullptr;
  EpiStoreBf16WT E; E.O = (bf16_t*)(p.ws + OFF_UPRAW); E.ldc = 1024;
  pg8::gemm_phase((PG8_LAS unsigned char*)smem, S, E);
}
__device__ __forceinline__ void handoff_publish(unsigned* ctr) {
  asm volatile("s_waitcnt vmcnt(0)" ::: "memory");
  __syncthreads();
  if (threadIdx.x == 0) xb_add(ctr, 1u);
}
__device__ __forceinline__ void handoff_wait(unsigned* ctr, unsigned need, unsigned* bar) {
  if (threadIdx.x == 0) { XB_SPIN(xb_ld(ctr) < need, bar); __builtin_amdgcn_fence(__ATOMIC_ACQUIRE, "agent"); asm volatile("s_waitcnt vmcnt(0)" ::: "memory"); }
  __syncthreads();
}
constexpr int ROPE_LDS_F = (gd::L_CW + 3 * 1536 * 4) / 4;
static_assert((size_t)ROPE_LDS_F * 4 + 128 * 16 * 4 <= 163840 - 16, "rope table must fit below the barrier words");
__device__ __forceinline__ void mla_stage_rope(float* lds, int t, int n) {
  for (int i = t; i < 128 * 8; i += n) { const int a = i >> 3, e = i & 7; const float ang = (float)a * __builtin_amdgcn_exp2f(-(float)e * 1.6609640474436813f);
    lds[ROPE_LDS_F + a * 16 + e] = __cosf(ang); lds[ROPE_LDS_F + a * 16 + 8 + e] = __sinf(ang); }
}
__device__ __forceinline__ void ph_mla_finish(const Params& p, int l, float* lds) {
  const int TIDX = ltid(); const int BIDX = lbid() - 32; const int nb = (int)gridDim.x - 32;
  if (BIDX < 0) return;
  const int lane = TIDX & 63, wv = TIDX >> 6, h = lane >> 4, j = lane & 15;
  const bf16_t* P = (const bf16_t*)(p.ws + OFF_P); const bf16_t* RAW = (const bf16_t*)(p.ws + OFF_UPRAW);
  bf16_t* Qo = (bf16_t*)(p.ws + OFF_QKV); bf16_t* Ko = Qo + QK_ELEMS; bf16_t* Vo = Ko + QK_ELEMS;
  lds += ROPE_LDS_F;
  float qw8[8], kw8[8], kwr8[8];
#pragma unroll
  for (int e = 0; e < 8; ++e) { qw8[e] = j < 12 ? p.q_norm[l * 96 + j * 8 + e] : 0.f; kw8[e] = j < 8 ? p.k_norm[l * 96 + j * 8 + e] : 0.f; kwr8[e] = p.k_norm[l * 96 + 64 + (lane & 3) * 8 + e]; }
  const bool ropel = j >= 8 && j < 12, first = (j & 1) == 0;
#define MF_UNPACK(dst, U4) do { dst[0] = __uint_as_float((U4).x << 16); dst[1] = __uint_as_float((U4).x & 0xffff0000u); dst[2] = __uint_as_float((U4).y << 16); dst[3] = __uint_as_float((U4).y & 0xffff0000u); \
    dst[4] = __uint_as_float((U4).z << 16); dst[5] = __uint_as_float((U4).z & 0xffff0000u); dst[6] = __uint_as_float((U4).w << 16); dst[7] = __uint_as_float((U4).w & 0xffff0000u); } while (0)
#define MF_PACK(src) make_uint4(gd::pk(src[0], src[1]), gd::pk(src[2], src[3]), gd::pk(src[4], src[5]), gd::pk(src[6], src[7]))
  for (int r2 = (BIDX + nb * wv) * 2; r2 < MR; r2 += nb * 8 * 2) {
  uint4 q4r[2], k4r[2], p4r[2];
#pragma unroll
  for (int rr = 0; rr < 2; ++rr) { const int r = r2 + rr;
    const bf16_t* Pr = P + (size_t)r * NINP; const bf16_t* Rr = RAW + (size_t)r * 1024;
    const uint4 zero4 = make_uint4(0u, 0u, 0u, 0u);
    q4r[rr] = j < 12 ? *(const uint4*)(Rr + h * 96 + j * 8) : zero4;
    k4r[rr] = *(const uint4*)(Rr + 512 + h * 128 + j * 8);
    const bf16_t* pp = lane < 24 ? Pr + PC_Q + lane * 8 : (lane < 40 ? Pr + PC_KV + (lane - 24) * 8 : Pr + PC_KR + (lane - 40) * 8);
    p4r[rr] = lane < 44 ? *(const uint4*)pp : zero4; }
#pragma unroll
  for (int rr = 0; rr < 2; ++rr) { const int r = r2 + rr;
    const bool lat = r < ML; const int b = lat ? (r >> 13) : ((r - ML) >> 8), t = lat ? (r & (T - 1)) : ((r - ML) & (TC - 1)), pos = lat ? TC + t : t;
    const uint4 q4 = q4r[rr], k4 = k4r[rr], p4 = p4r[rr];
    float xq[8], xk[8], xp[8];
    MF_UNPACK(xq, q4); MF_UNPACK(xk, k4); MF_UNPACK(xp, p4);
    float sp = 0.f, sq = 0.f, sk = 0.f;
#pragma unroll
    for (int e = 0; e < 8; ++e) { sp += xp[e] * xp[e]; sq += xq[e] * xq[e]; sk += xk[e] * xk[e]; }
    if (j >= 8) sk = 0.f;
    sp += __shfl_xor(sp, 1); sp += __shfl_xor(sp, 2); sp += __shfl_xor(sp, 4);
    const float g0 = __builtin_amdgcn_readlane(sp, 0), g1 = __builtin_amdgcn_readlane(sp, 8), g2 = __builtin_amdgcn_readlane(sp, 16), g3 = __builtin_amdgcn_readlane(sp, 24), g4 = __builtin_amdgcn_readlane(sp, 32), skr = __builtin_amdgcn_readlane(sp, 40);
    const float rq = rsqrtf((g0 + g1 + g2) / 192.f + EPS), rkv = rsqrtf((g3 + g4) / 128.f + EPS);
    sq += __shfl_xor(sq, 1); sq += __shfl_xor(sq, 2); sq += __shfl_xor(sq, 4); sq += __shfl_xor(sq, 8);
    sk += __shfl_xor(sk, 1); sk += __shfl_xor(sk, 2); sk += __shfl_xor(sk, 4); sk += __shfl_xor(sk, 8);
    const float sc = rq * rsqrtf(rq * rq * sq / 96.f + EPS);
    const float sck = rsqrtf((rkv * rkv * sk + skr) / 96.f + EPS);
    const int aq = j < 10 ? (t >> 6) : (t & 63);
    float cs[8], sn[8];
    { const float4 c0 = *(const float4*)(lds + aq * 16), c1 = *(const float4*)(lds + aq * 16 + 4), s0 = *(const float4*)(lds + aq * 16 + 8), s1 = *(const float4*)(lds + aq * 16 + 12);
      cs[0] = c0.x; cs[1] = c0.y; cs[2] = c0.z; cs[3] = c0.w; cs[4] = c1.x; cs[5] = c1.y; cs[6] = c1.z; cs[7] = c1.w;
      sn[0] = s0.x; sn[1] = s0.y; sn[2] = s0.z; sn[3] = s0.w; sn[4] = s1.x; sn[5] = s1.y; sn[6] = s1.z; sn[7] = s1.w; }
    const size_t ob = (size_t)(b * 4 + h) * TK + pos;
    { float y[8];
#pragma unroll
      for (int e = 0; e < 8; ++e) { y[e] = xq[e] * sc * qw8[e]; const float o = __shfl_xor(y[e], 1);
        if (lat && ropel) y[e] = first ? y[e] * cs[e] - o * sn[e] : y[e] * cs[e] + o * sn[e]; }
      if (j < 12) *(uint4*)(Qo + ob * 128 + j * 8) = MF_PACK(y); }
    { float z[8], kk[8];
#pragma unroll
      for (int e = 0; e < 8; ++e) { z[e] = xp[e] * kwr8[e]; const float o = __shfl_xor(z[e], 1);
        if (lat) z[e] = first ? z[e] * cs[e] - o * sn[e] : z[e] * cs[e] + o * sn[e];
        const float zr = __shfl(z[e], 40 + (lane & 3));
        kk[e] = j < 8 ? xk[e] * rkv * sck * kw8[e] : zr * sck; }
      if (j < 12) *(uint4*)(Ko + ob * 128 + j * 8) = MF_PACK(kk); }
    { float vv[8];
#pragma unroll
      for (int e = 0; e < 8; ++e) vv[e] = xk[e] * rkv;
      if (j >= 8) *(uint4*)(Vo + ob * 64 + (j - 8) * 8) = MF_PACK(vv); }
  }
  }
#undef MF_UNPACK
#undef MF_PACK
}
constexpr int POOL_ROWB = 144, POOL_TILEB = 64 * POOL_ROWB;
template <int H>
__device__ __forceinline__ void pool_unit(const Params& p, int l, int tile, int gi, char* Dw, const bf16_t* WTg, int lane) {
  typedef unsigned u2 __attribute__((ext_vector_type(2)));
  using bf16x8 = fa::bf16x8; using f32x16 = fa::f32x16;
  const int r_first = tile * 64;
  int r0, tlen;
  if (r_first < ML) { r0 = r_first & ~(T - 1); tlen = T; } else { r0 = ML + ((r_first - ML) & ~(TC - 1)); tlen = TC; }
  const int cq = lane & 15, tb = lane >> 4, tbase = r_first - r0 + tb * 16;
  const bf16_t* Pg = (const bf16_t*)(p.ws + OFF_P) + (size_t)r0 * NINP + PC_POOL + gi * 64 + cq * 4;
  constexpr int NR = 15 + 2 * H;
  u2 xs[NR];
#pragma unroll
  for (int j = 0; j < NR; ++j) { const int tt = tbase - H + j; xs[j] = (tt >= 0 && tt < tlen) ? *(const u2*)(Pg + (size_t)tt * NINP) : (u2){0u, 0u}; }
  bf16x8 wa[2][4];
#pragma unroll
  for (int mt = 0; mt < 2; ++mt)
#pragma unroll
    for (int ks = 0; ks < 4; ++ks) wa[mt][ks] = *(const bf16x8*)(WTg + (mt * 32 + (lane & 31)) * 64 + ks * 16 + (lane >> 5) * 8);
  float4 sc4[2][4];
  { const float* psc0 = p.pool_scale + l * 256 + gi * 64 + 4 * (lane >> 5);
#pragma unroll
    for (int mt = 0; mt < 2; ++mt)
#pragma unroll
      for (int q = 0; q < 4; ++q) sc4[mt][q] = *(const float4*)(psc0 + mt * 32 + q * 8); }
#define PL_LO(w) __uint_as_float((w) << 16)
#define PL_HI(w) __uint_as_float((w) & 0xffff0000u)
  float s0 = 0.f, s1 = 0.f, s2 = 0.f, s3 = 0.f;
#pragma unroll
  for (int j = 0; j < 2 * H; ++j) { s0 += PL_LO(xs[j].x); s1 += PL_HI(xs[j].x); s2 += PL_LO(xs[j].y); s3 += PL_HI(xs[j].y); }
  char* drow = Dw + (tb * 16) * POOL_ROWB + cq * 8;
#pragma unroll
  for (int i = 0; i < 16; ++i) {
    const int t = tbase + i; const int lo = t - H < 0 ? 0 : t - H, hi = t + H > tlen ? tlen : t + H;
    const float inv = 1.f / (float)(hi - lo);
    const u2 c = xs[i + H];
    u2 w; w.x = gd::pk(s0 * inv - PL_LO(c.x), s1 * inv - PL_HI(c.x)); w.y = gd::pk(s2 * inv - PL_LO(c.y), s3 * inv - PL_HI(c.y));
    *(u2*)(drow + i * POOL_ROWB) = w;
    if (i < 15) { const u2 a = xs[i + 2 * H], b = xs[i];
      s0 += PL_LO(a.x) - PL_LO(b.x); s1 += PL_HI(a.x) - PL_HI(b.x); s2 += PL_LO(a.y) - PL_LO(b.y); s3 += PL_HI(a.y) - PL_HI(b.y); }
  }
#undef PL_LO
#undef PL_HI
  asm volatile("s_waitcnt lgkmcnt(0)" ::: "memory");
  const int r32 = lane & 31, hl = lane >> 5;
  f32x16 acc[2][2];
#pragma unroll
  for (int a = 0; a < 2; ++a)
#pragma unroll
    for (int b = 0; b < 2; ++b)
#pragma unroll
      for (int i = 0; i < 16; ++i) acc[a][b][i] = 0.f;
#pragma unroll
  for (int ks = 0; ks < 4; ++ks) {
    const bf16x8 a0 = wa[0][ks], a1 = wa[1][ks];
    const bf16x8 b0 = *(const bf16x8*)(Dw + r32 * POOL_ROWB + ks * 32 + hl * 16), b1 = *(const bf16x8*)(Dw + (32 + r32) * POOL_ROWB + ks * 32 + hl * 16);
    acc[0][0] = __builtin_amdgcn_mfma_f32_32x32x16_bf16(a0, b0, acc[0][0], 0, 0, 0); acc[0][1] = __builtin_amdgcn_mfma_f32_32x32x16_bf16(a0, b1, acc[0][1], 0, 0, 0);
    acc[1][0] = __builtin_amdgcn_mfma_f32_32x32x16_bf16(a1, b0, acc[1][0], 0, 0, 0); acc[1][1] = __builtin_amdgcn_mfma_f32_32x32x16_bf16(a1, b1, acc[1][1], 0, 0, 0);
  }
  bf16_t* cat = (bf16_t*)(p.ws + OFF_H) + (size_t)(r_first + r32) * D + 768 + gi * 64 + 4 * hl;
#pragma unroll
  for (int mt = 0; mt < 2; ++mt)
#pragma unroll
    for (int q = 0; q < 4; ++q) {
      const float4 s4 = sc4[mt][q];
#pragma unroll
      for (int nt = 0; nt < 2; ++nt) {
        u2 w; w.x = gd::pk(acc[mt][nt][4 * q] * s4.x, acc[mt][nt][4 * q + 1] * s4.y); w.y = gd::pk(acc[mt][nt][4 * q + 2] * s4.z, acc[mt][nt][4 * q + 3] * s4.w);
        *(u2*)(cat + (size_t)(nt * 32) * D + mt * 32 + q * 8) = w;
      }
    }
  asm volatile("s_waitcnt lgkmcnt(0)" ::: "memory");
}
__device__ __forceinline__ void ph_pool_mfma(const Params& p, int l, int nrows, char* smem) {
  const int TIDX = ltid(); const int BIDX = lbid();
  const int lane = TIDX & 63, wv = TIDX >> 6;
  const int gi = BIDX & 3;
  const bf16_t* WTg = (const bf16_t*)(p.ws + OFF_POOLWT) + (size_t)(l * 4 + gi) * 4096;
  char* Dw = smem + wv * POOL_TILEB;
  __syncthreads();
  const int ntiles = nrows >> 6;
  for (int tile = wv * ((int)gridDim.x >> 2) + (BIDX >> 2); tile < ntiles; tile += 8 * ((int)gridDim.x >> 2)) {
    if (gi == 0) pool_unit<1>(p, l, tile, 0, Dw, WTg, lane); else if (gi == 1) pool_unit<2>(p, l, tile, 1, Dw, WTg, lane);
    else if (gi == 2) pool_unit<4>(p, l, tile, 2, Dw, WTg, lane); else pool_unit<8>(p, l, tile, 3, Dw, WTg, lane);
  }
}
__device__ __forceinline__ void ph_gdnfin2(const Params& p, int l, int nrows) {
  const int TIDX = ltid(); const int BIDX = lbid();
  const int lane = TIDX & 63, wv = TIDX >> 6, hh = lane >> 4;
  const bf16_t* P = (const bf16_t*)(p.ws + OFF_P);
  const float* MLP = (const float*)(p.ws + OFF_MLPART); const bf16_t* OP = (const bf16_t*)(p.ws + OFF_OPART);
  float gn8[8];
#pragma unroll
  for (int i = 0; i < 8; ++i) gn8[i] = p.gdn_norm_g[l * 128 + (lane & 15) * 8 + i];
  for (int r2 = (BIDX + gridDim.x * wv) * 2; r2 < nrows; r2 += gridDim.x * 16) {
    float2 ml[2][2]; uint2 op[2][2]; uint4 a[2], bq[2], z[2];
#pragma unroll
    for (int rr = 0; rr < 2; ++rr) { const int r = r2 + rr; const bool lat = r < ML;
#pragma unroll
      for (int q = 0; q < 2; ++q) {
        ml[rr][q] = lat ? *(const float2*)(MLP + (((size_t)q * ML + r) * 4 + hh) * 2) : make_float2(0.f, 0.f);
        op[rr][q] = lat ? *(const uint2*)(OP + ((size_t)q * ML + r) * 256 + lane * 4) : make_uint2(0u, 0u); }
      const bf16_t* Pr = P + (size_t)r * NINP;
      a[rr] = *(const uint4*)(Pr + PC_OF + lane * 8); bq[rr] = *(const uint4*)(Pr + PC_OB + lane * 8); z[rr] = *(const uint4*)(Pr + PC_Z + lane * 8); }
#pragma unroll
    for (int rr = 0; rr < 2; ++rr) { const int r = r2 + rr;
      bf16_t* cat = (bf16_t*)(p.ws + OFF_H) + (size_t)r * D;
      if (r < ML) {
        const float mx = fmaxf(ml[rr][0].x, ml[rr][1].x);
        float acc4[4] = {0.f, 0.f, 0.f, 0.f}, wsum = 0.f;
#pragma unroll
        for (int q = 0; q < 2; ++q) { const float w = ml[rr][q].y * __expf((ml[rr][q].x - mx) * fa::SCALE); wsum += w; const uint2 o = op[rr][q];
          acc4[0] += w * __uint_as_float(o.x << 16); acc4[1] += w * __uint_as_float(o.x & 0xffff0000u); acc4[2] += w * __uint_as_float(o.y << 16); acc4[3] += w * __uint_as_float(o.y & 0xffff0000u); }
        const float inv = 1.f / wsum;
        uint2 w2; w2.x = gd::pk(acc4[0] * inv, acc4[1] * inv); w2.y = gd::pk(acc4[2] * inv, acc4[3] * inv);
        *(uint2*)(cat + lane * 4) = w2;
      }
      {
        const unsigned aw[4] = {a[rr].x, a[rr].y, a[rr].z, a[rr].w}, bw[4] = {bq[rr].x, bq[rr].y, bq[rr].z, bq[rr].w}, zw[4] = {z[rr].x, z[rr].y, z[rr].z, z[rr].w};
        float o[8], ss = 0.f;
#pragma unroll
        for (int i = 0; i < 4; ++i) { o[2 * i] = __uint_as_float(aw[i] << 16) + __uint_as_float(bw[i] << 16); o[2 * i + 1] = __uint_as_float(aw[i] & 0xffff0000u) + __uint_as_float(bw[i] & 0xffff0000u); }
#pragma unroll
        for (int i = 0; i < 8; ++i) ss += o[i] * o[i];
        ss += __shfl_xor(ss, 1); ss += __shfl_xor(ss, 2); ss += __shfl_xor(ss, 4); ss += __shfl_xor(ss, 8);
        const float rs = rsqrtf(ss / 128.f + EPS);
        float y[8];
#pragma unroll
        for (int i = 0; i < 4; ++i) { const float z0 = __uint_as_float(zw[i] << 16), z1 = __uint_as_float(zw[i] & 0xffff0000u);
          y[2 * i] = o[2 * i] * rs * gn8[2 * i] * silu_f(z0); y[2 * i + 1] = o[2 * i + 1] * rs * gn8[2 * i + 1] * silu_f(z1); }
        uint4 w; w.x = gd::pk(y[0], y[1]); w.y = gd::pk(y[2], y[3]); w.z = gd::pk(y[4], y[5]); w.w = gd::pk(y[6], y[7]);
        *(uint4*)(cat + 256 + lane * 8) = w;
      }
    }
  }
}
template <int MODE>
__device__ __forceinline__ void ph_gdnfin_pool_fast(const Params& p, int l, int nrows, float* lds, int b0, int nb) {
  const int TIDX = ltid(); const int BIDX = lbid() - b0;
  if (BIDX < 0) return;
  const int lane = TIDX & 63, wv = TIDX >> 6;
  float* Wl = lds; float* dsc = lds + 16384 + wv * 256;
  if (MODE == 1) {
    __syncthreads();
    for (int i = TIDX; i < 4096; i += NT) ((float4*)Wl)[i] = ((const float4*)(p.pool_w + (size_t)l * 16384))[i];
    __syncthreads();
  }
  const bf16_t* P = (const bf16_t*)(p.ws + OFF_P);
  const float* gn = p.gdn_norm_g + l * 128; const float* psc = p.pool_scale + l * 256;
  for (int r = BIDX + nb * wv; r < nrows; r += nb * 8) {
    int mj, t, tlen, r0; rowinfo(r, mj, t, tlen, r0);
    bf16_t* cat = (bf16_t*)(p.ws + OFF_H) + (size_t)r * D;
    const bf16_t* Pr = P + (size_t)r * NINP;
    if (MODE == 2 && r < ML) {
      const int hh = lane >> 4;
      float mp[2], lp[2], mx = -1e30f;
#pragma unroll
      for (int q = 0; q < 2; ++q) { const float2 ml = *(const float2*)((const float*)(p.ws + OFF_MLPART) + (((size_t)q * ML + r) * 4 + hh) * 2); mp[q] = ml.x; lp[q] = ml.y; mx = fmaxf(mx, ml.x); }
      float acc4[4] = {0.f, 0.f, 0.f, 0.f}, wsum = 0.f;
#pragma unroll
      for (int q = 0; q < 2; ++q) { const float w = lp[q] * __expf((mp[q] - mx) * fa::SCALE); wsum += w;
        const uint2 o = *(const uint2*)((const bf16_t*)(p.ws + OFF_OPART) + ((size_t)q * ML + r) * 256 + lane * 4);
        acc4[0] += w * __uint_as_float(o.x << 16); acc4[1] += w * __uint_as_float(o.x & 0xffff0000u); acc4[2] += w * __uint_as_float(o.y << 16); acc4[3] += w * __uint_as_float(o.y & 0xffff0000u); }
      const float inv = 1.f / wsum;
      uint2 w2; w2.x = gd::pk(acc4[0] * inv, acc4[1] * inv); w2.y = gd::pk(acc4[2] * inv, acc4[3] * inv);
      *(uint2*)(cat + lane * 4) = w2;
    }
    if (MODE == 2) {
      const uint4 a = *(const uint4*)(Pr + PC_OF + lane * 8), bq = *(const uint4*)(Pr + PC_OB + lane * 8), z = *(const uint4*)(Pr + PC_Z + lane * 8);
      const unsigned aw[4] = {a.x, a.y, a.z, a.w}, bw[4] = {bq.x, bq.y, bq.z, bq.w}, zw[4] = {z.x, z.y, z.z, z.w};
      float o[8], ss = 0.f;
#pragma unroll
      for (int i = 0; i < 4; ++i) { o[2 * i] = __uint_as_float(aw[i] << 16) + __uint_as_float(bw[i] << 16); o[2 * i + 1] = __uint_as_float(aw[i] & 0xffff0000u) + __uint_as_float(bw[i] & 0xffff0000u); }
#pragma unroll
      for (int i = 0; i < 8; ++i) ss += o[i] * o[i];
      ss += __shfl_xor(ss, 1); ss += __shfl_xor(ss, 2); ss += __shfl_xor(ss, 4); ss += __shfl_xor(ss, 8);
      const float rs = rsqrtf(ss / 128.f + EPS);
      float y[8];
#pragma unroll
      for (int i = 0; i < 4; ++i) { const float z0 = __uint_as_float(zw[i] << 16), z1 = __uint_as_float(zw[i] & 0xffff0000u);
        y[2 * i] = o[2 * i] * rs * gn[(lane & 15) * 8 + 2 * i] * silu_f(z0); y[2 * i + 1] = o[2 * i + 1] * rs * gn[(lane & 15) * 8 + 2 * i + 1] * silu_f(z1); }
      uint4 w; w.x = gd::pk(y[0], y[1]); w.y = gd::pk(y[2], y[3]); w.z = gd::pk(y[4], y[5]); w.w = gd::pk(y[6], y[7]);
      *(uint4*)(cat + 256 + lane * 8) = w;
    }
    if (MODE == 1) {
      const int gi = lane >> 4, win = 2 << gi;
      int lo = t - win / 2, hi = lo + win; lo = lo < 0 ? 0 : lo; hi = hi > tlen ? tlen : hi;
      float sm[4] = {0.f, 0.f, 0.f, 0.f};
      uint2 uw[16];
#pragma unroll
      for (int q = 0; q < 16; ++q) { const int tt = t - 8 + q; const bool ok = tt >= lo && tt < hi; uw[q] = ok ? *(const uint2*)(P + (size_t)(r0 + tt) * NINP + PC_POOL + lane * 4) : make_uint2(0u, 0u); }
#pragma unroll
      for (int q = 0; q < 16; ++q) { sm[0] += __uint_as_float(uw[q].x << 16); sm[1] += __uint_as_float(uw[q].x & 0xffff0000u); sm[2] += __uint_as_float(uw[q].y << 16); sm[3] += __uint_as_float(uw[q].y & 0xffff0000u); }
      const uint2 u = *(const uint2*)(Pr + PC_POOL + lane * 4); const float inv = 1.f / (float)(hi - lo);
      dsc[lane * 4 + 0] = sm[0] * inv - __uint_as_float(u.x << 16); dsc[lane * 4 + 1] = sm[1] * inv - __uint_as_float(u.x & 0xffff0000u);
      dsc[lane * 4 + 2] = sm[2] * inv - __uint_as_float(u.y << 16); dsc[lane * 4 + 3] = sm[3] * inv - __uint_as_float(u.y & 0xffff0000u);
      float4 acc = {0.f, 0.f, 0.f, 0.f};
      const float* wg = Wl + gi * 4096 + (lane & 15) * 4; const float* dg = dsc + gi * 64;
#pragma unroll 8
      for (int c = 0; c < 64; ++c) { const float dv = dg[c]; const float4 w4 = *(const float4*)(wg + c * 64); acc.x += dv * w4.x; acc.y += dv * w4.y; acc.z += dv * w4.z; acc.w += dv * w4.w; }
      const float4 s4 = *(const float4*)(psc + lane * 4);
      uint2 w; w.x = gd::pk(acc.x * s4.x, acc.y * s4.y); w.y = gd::pk(acc.z * s4.z, acc.w * s4.w);
      *(uint2*)(cat + 768 + lane * 4) = w;
    }
  }
}
__device__ __forceinline__ void ph_ada_fast(const Params& p, float* lds) {
  const int TIDX = ltid(); const int BIDX = lbid();
  const int cg = TIDX & 15, ksl = TIDX >> 4;
  for (int u = BIDX; u < 2 * 96; u += gridDim.x) {
    const int l = u / 96, n0 = (u % 96) * 64 + cg * 4;
    const float* w = p.ada_w + (size_t)l * D * 6144 + n0;
    float4 a0 = {0.f, 0.f, 0.f, 0.f}, a1 = a0, a2 = a0;
#pragma unroll 16
    for (int kk = 0; kk < 32; ++kk) { const int k = ksl * 32 + kk; typedef float f4v __attribute__((ext_vector_type(4))); const f4v w4 = __builtin_nontemporal_load((const f4v*)(w + (size_t)k * 6144));
      const float s0 = silu_f(p.c[k]), s1 = silu_f(p.c[D + k]), s2 = silu_f(p.c_ctx[k]);
      a0.x += s0 * w4.x; a0.y += s0 * w4.y; a0.z += s0 * w4.z; a0.w += s0 * w4.w;
      a1.x += s1 * w4.x; a1.y += s1 * w4.y; a1.z += s1 * w4.z; a1.w += s1 * w4.w;
      a2.x += s2 * w4.x; a2.y += s2 * w4.y; a2.z += s2 * w4.z; a2.w += s2 * w4.w; }
    __syncthreads();
    float4* red = (float4*)lds;
    red[(ksl * 3 + 0) * 16 + cg] = a0; red[(ksl * 3 + 1) * 16 + cg] = a1; red[(ksl * 3 + 2) * 16 + cg] = a2;
    __syncthreads();
    if (TIDX < 192) { const int j = TIDX / 64, c = TIDX % 64; const float* rf = lds;
      float a = p.ada_b[l * 6144 + (u % 96) * 64 + c];
      for (int q = 0; q < 32; ++q) a += rf[((q * 3 + j) * 16 + (c >> 2)) * 4 + (c & 3)];
      ((float*)(p.ws + OFF_MOD))[(size_t)(l * 3 + j) * 6144 + (u % 96) * 64 + c] = a; }
  }
}

__device__ __forceinline__ void ph_topk_fast(const Params& p, int nseq, char* smem) {
  const int TIDX = ltid(); const int BIDX = lbid();
  const int lane = TIDX & 63, wv = TIDX >> 6;
  unsigned* hist = (unsigned*)smem;
  unsigned* wtot = hist + 1024;
  for (int prob = BIDX; prob < nseq * NE; prob += gridDim.x) {
    const int s = prob >> 4, e = prob & 15;
    const int tlen = s < 2 ? T : TC, cap = s < 2 ? CAPL : CAPC, r0 = s < 2 ? s * T : ML + (s - 2) * TC;
    const float* a = (const float*)(p.ws + OFF_AFFT) + (size_t)e * MR + r0;
    __syncthreads();
    for (int i = TIDX; i < 1024; i += NT) hist[i] = 0u;
    const int nthr = tlen >> 4, t0 = TIDX * 16; const bool act = TIDX < nthr;
    unsigned k[16];
#pragma unroll
    for (int q = 0; q < 4; ++q) { const float4 v = act ? *(const float4*)(a + t0 + q * 4) : make_float4(0.f, 0.f, 0.f, 0.f);
      k[q * 4] = __float_as_uint(v.x); k[q * 4 + 1] = __float_as_uint(v.y); k[q * 4 + 2] = __float_as_uint(v.z); k[q * 4 + 3] = __float_as_uint(v.w); }
    __syncthreads();
    unsigned prefix = 0u, want = (unsigned)cap;
#pragma unroll
    for (int pass = 0; pass < 4; ++pass) {
      const int shift = 24 - 8 * pass;
      const unsigned himask = pass == 0 ? 0u : (0xffffffffu << (shift + 8));
      unsigned* h = hist + pass * 256;
      if (act) { unsigned cur = 0u, cnt = 0u;
#pragma unroll
        for (int i = 0; i < 16; ++i) if ((k[i] & himask) == prefix) { const unsigned dgt = (k[i] >> shift) & 255u; if (dgt == cur) ++cnt; else { if (cnt) atomicAdd(&h[cur], cnt); cur = dgt; cnt = 1u; } }
        if (cnt) atomicAdd(&h[cur], cnt); }
      __syncthreads();
      const uint4 c = *(const uint4*)(h + 4 * lane);
      const unsigned tsum = c.x + c.y + c.z + c.w;
      unsigned inc = tsum;
#pragma unroll
      for (int o = 1; o < 64; o <<= 1) { const unsigned n = __shfl_down(inc, o); if (lane + o < 64) inc += n; }
      const unsigned a3 = inc - tsum, a2 = a3 + c.w, a1 = a2 + c.z, a0 = a1 + c.y;
      unsigned dg = 0u, nw = 0u; bool hit = false;
      if (a3 < want && a3 + c.w >= want) { dg = 4u * lane + 3u; nw = want - a3; hit = true; }
      else if (a2 < want && a2 + c.z >= want) { dg = 4u * lane + 2u; nw = want - a2; hit = true; }
      else if (a1 < want && a1 + c.y >= want) { dg = 4u * lane + 1u; nw = want - a1; hit = true; }
      else if (a0 < want && a0 + c.x >= want) { dg = 4u * lane; nw = want - a0; hit = true; }
      const unsigned long long bal = __ballot(hit);
      const int src = bal ? __builtin_ctzll(bal) : 0;
      dg = (unsigned)__builtin_amdgcn_readlane((int)dg, src); nw = (unsigned)__builtin_amdgcn_readlane((int)nw, src);
      prefix |= dg << shift; want = nw;
    }
    const unsigned thr = prefix, weq = want;
    unsigned cnt = 0u;
#pragma unroll
    for (int i = 0; i < 16; ++i) cnt += (k[i] > thr ? 0x10000u : 0u) + (k[i] == thr ? 1u : 0u);
    if (!act) cnt = 0u;
    unsigned inc = cnt;
#pragma unroll
    for (int o = 1; o < 64; o <<= 1) { const unsigned n = __shfl_up(inc, o); if (lane >= o) inc += n; }
    if (lane == 63) wtot[wv] = inc;
    __syncthreads();
    unsigned base = 0u;
    for (int w = 0; w < wv; ++w) base += wtot[w];
    unsigned run = base + inc - cnt;
    int* idx = (int*)(p.ws + OFF_IDX); float* gate = (float*)(p.ws + OFF_GATE); int* slot = (int*)(p.ws + OFF_SLOT);
    const int pb = pair_base(s, e);
    if (act) {
#pragma unroll
      for (int i = 0; i < 16; ++i) {
        const unsigned kk = k[i]; const unsigned ngt = run >> 16, neq = run & 0xffffu;
        const unsigned eqtaken = neq < weq ? neq : weq;
        int sl = -1;
        if (kk > thr) sl = (int)(ngt + eqtaken);
        else if (kk == thr && neq < weq) sl = (int)(ngt + neq);
        if (sl >= 0) { idx[pb + sl] = r0 + t0 + i; gate[pb + sl] = __uint_as_float(kk); }
        slot[(size_t)(r0 + t0 + i) * 16 + e] = sl;
        run += (kk > thr ? 0x10000u : 0u) + (kk == thr ? 1u : 0u);
      }
    }
  }
}
__device__ __forceinline__ void ph_combine_fast(const Params& p, int l, int nrows, int next_l) {
  const int TIDX = ltid(); const int BIDX = lbid();
  const int lane = TIDX & 63, wv = TIDX >> 6;
  const bf16_t* Y = (const bf16_t*)(p.ws + OFF_Y);
  for (int r4 = (BIDX + gridDim.x * wv) * 4; r4 < nrows; r4 += gridDim.x * 8 * 4) {
    int mj, t, tlen, r0; rowinfo(r4, mj, t, tlen, r0);
    const int s = r4 < ML ? (r4 >> 13) : 2 + ((r4 - ML) >> 8);
    const int slot4 = ((const int*)(p.ws + OFF_SLOT))[(size_t)r4 * 16 + lane];
    const unsigned long long vm = __ballot(slot4 >= 0);
    const int pairl = pair_base(s, lane & 15) + slot4;
    float4 xv[4][4]; uint4 ya[4][2][2]; int nsel[4];
    float* xr[4];
#pragma unroll
    for (int rr = 0; rr < 4; ++rr) { xr[rr] = xrow(p, r4 + rr);
#pragma unroll
      for (int hf = 0; hf < 2; ++hf) { const uint4 xb4 = ld_nt_u4((const bf16_t*)xr[rr] + hf * 512 + lane * 8);
        xv[rr][hf * 2 + 0] = make_float4(__uint_as_float(xb4.x << 16), __uint_as_float(xb4.x & 0xffff0000u), __uint_as_float(xb4.y << 16), __uint_as_float(xb4.y & 0xffff0000u));
        xv[rr][hf * 2 + 1] = make_float4(__uint_as_float(xb4.z << 16), __uint_as_float(xb4.z & 0xffff0000u), __uint_as_float(xb4.w << 16), __uint_as_float(xb4.w & 0xffff0000u)); } }
#pragma unroll
    for (int rr = 0; rr < 4; ++rr) {
      unsigned m16 = (unsigned)(vm >> (rr * 16)) & 0xffffu; nsel[rr] = __builtin_popcount(m16);
#pragma unroll
      for (int k = 0; k < 2; ++k) {
        if (m16) { const int e = __builtin_ctz(m16); m16 &= m16 - 1; const int pr = __builtin_amdgcn_readlane(pairl, rr * 16 + e);
          const bf16_t* yr = Y + (size_t)pr * D; ya[rr][k][0] = ld_nt_u4(yr + lane * 8); ya[rr][k][1] = ld_nt_u4(yr + 512 + lane * 8); }
        else { ya[rr][k][0] = make_uint4(0u, 0u, 0u, 0u); ya[rr][k][1] = make_uint4(0u, 0u, 0u, 0u); }
      }
    }
    const float* g2 = modvec(p, l, mj, 5);
    float4 gq[4];
#pragma unroll
    for (int hf = 0; hf < 2; ++hf)
#pragma unroll
      for (int q = 0; q < 2; ++q) gq[hf * 2 + q] = *(const float4*)(g2 + hf * 512 + lane * 8 + q * 4);
    float4 ng[4], nsc[4], nsh[4];
    if (next_l >= 0) { const float* g = p.norm1_g + next_l * D; const float* sh = modvec(p, next_l, mj, 0); const float* sc = modvec(p, next_l, mj, 1);
#pragma unroll
      for (int hf = 0; hf < 2; ++hf)
#pragma unroll
        for (int q = 0; q < 2; ++q) { const int c = hf * 512 + lane * 8 + q * 4; ng[hf * 2 + q] = *(const float4*)(g + c); nsc[hf * 2 + q] = *(const float4*)(sc + c); nsh[hf * 2 + q] = *(const float4*)(sh + c); } }
    asm volatile("s_waitcnt vmcnt(0)" ::: "memory");
#pragma unroll
    for (int rr = 0; rr < 4; ++rr) {
      float acc[16];
#pragma unroll
      for (int i = 0; i < 16; ++i) acc[i] = 0.f;
#pragma unroll
      for (int k = 0; k < 2; ++k)
#pragma unroll
        for (int hf = 0; hf < 2; ++hf) { const unsigned w[4] = {ya[rr][k][hf].x, ya[rr][k][hf].y, ya[rr][k][hf].z, ya[rr][k][hf].w};
#pragma unroll
          for (int i = 0; i < 4; ++i) { acc[hf * 8 + 2 * i] += __uint_as_float(w[i] << 16); acc[hf * 8 + 2 * i + 1] += __uint_as_float(w[i] & 0xffff0000u); } }
      if (nsel[rr] > 2) {
        unsigned m16 = (unsigned)(vm >> (rr * 16)) & 0xffffu; m16 &= m16 - 1; m16 &= m16 - 1;
        while (m16) { const int e = __builtin_ctz(m16); m16 &= m16 - 1; const int pr = __builtin_amdgcn_readlane(pairl, rr * 16 + e);
          const bf16_t* yr = Y + (size_t)pr * D; const uint4 a = *(const uint4*)(yr + lane * 8), bq = *(const uint4*)(yr + 512 + lane * 8);
          const unsigned w[8] = {a.x, a.y, a.z, a.w, bq.x, bq.y, bq.z, bq.w};
#pragma unroll
          for (int i = 0; i < 8; ++i) { acc[2 * i] += __uint_as_float(w[i] << 16); acc[2 * i + 1] += __uint_as_float(w[i] & 0xffff0000u); } }
      }
      float x[16], ss = 0.f;
#pragma unroll
      for (int hf = 0; hf < 2; ++hf)
#pragma unroll
        for (int q = 0; q < 2; ++q) { const int c = hf * 512 + lane * 8 + q * 4; float4 xq = xv[rr][hf * 2 + q]; const float4 gv = gq[hf * 2 + q];
          xq.x += gv.x * acc[hf * 8 + q * 4 + 0]; xq.y += gv.y * acc[hf * 8 + q * 4 + 1]; xq.z += gv.z * acc[hf * 8 + q * 4 + 2]; xq.w += gv.w * acc[hf * 8 + q * 4 + 3];
          if (next_l >= 0) { uint2 xb2; xb2.x = gd::pk(xq.x, xq.y); xb2.y = gd::pk(xq.z, xq.w); *(uint2*)((bf16_t*)xr[rr] + c) = xb2; }
          else st_nt_f4(xr[rr] + c, xq);
          x[hf * 8 + q * 4 + 0] = xq.x; x[hf * 8 + q * 4 + 1] = xq.y; x[hf * 8 + q * 4 + 2] = xq.z; x[hf * 8 + q * 4 + 3] = xq.w;
          ss += xq.x * xq.x + xq.y * xq.y + xq.z * xq.z + xq.w * xq.w; }
      if (next_l >= 0) {
        ss = wave_sum(ss);
        const float rstd = rsqrtf(ss / D + EPS);
        bf16_t* h = (bf16_t*)(p.ws + OFF_H) + (size_t)(r4 + rr) * D;
#pragma unroll
        for (int hf = 0; hf < 2; ++hf) { const int c = hf * 512 + lane * 8; float y[8];
          const float gg[8] = {ng[hf * 2].x, ng[hf * 2].y, ng[hf * 2].z, ng[hf * 2].w, ng[hf * 2 + 1].x, ng[hf * 2 + 1].y, ng[hf * 2 + 1].z, ng[hf * 2 + 1].w};
          const float cc[8] = {nsc[hf * 2].x, nsc[hf * 2].y, nsc[hf * 2].z, nsc[hf * 2].w, nsc[hf * 2 + 1].x, nsc[hf * 2 + 1].y, nsc[hf * 2 + 1].z, nsc[hf * 2 + 1].w};
          const float hh8[8] = {nsh[hf * 2].x, nsh[hf * 2].y, nsh[hf * 2].z, nsh[hf * 2].w, nsh[hf * 2 + 1].x, nsh[hf * 2 + 1].y, nsh[hf * 2 + 1].z, nsh[hf * 2 + 1].w};
#pragma unroll
          for (int i = 0; i < 8; ++i) y[i] = x[hf * 8 + i] * rstd * gg[i] * (1.f + cc[i]) + hh8[i];
          uint4 w; w.x = gd::pk(y[0], y[1]); w.y = gd::pk(y[2], y[3]); w.z = gd::pk(y[4], y[5]); w.w = gd::pk(y[6], y[7]);
          *(uint4*)(h + c) = w; }
      }
    }
  }
}
template <class RowPtr>
__device__ __forceinline__ gd::f32x4 coop_tile_32x64(RowPtr arow, const bf16_t* Bt, int ldb, int K, float* lds, int wv, int lane) {
  using gd::bf16x8; using gd::f32x4;
  const int cc = lane & 15, g = lane >> 4;
  const bf16_t* a0 = arow(cc) + g * 8; const bf16_t* a1 = arow(16 + cc) + g * 8;
  f32x4 acc[2][4];
#pragma unroll
  for (int m = 0; m < 2; ++m)
#pragma unroll
    for (int n = 0; n < 4; ++n) acc[m][n] = (f32x4){0.f, 0.f, 0.f, 0.f};
  for (int ks = wv; ks < K / 32; ks += 8) {
    const bf16x8 A0 = *(const bf16x8*)(a0 + ks * 32), A1 = *(const bf16x8*)(a1 + ks * 32);
#pragma unroll
    for (int n = 0; n < 4; ++n) { const bf16x8 B = *(const bf16x8*)(Bt + (size_t)(n * 16 + cc) * ldb + ks * 32 + g * 8);
      acc[0][n] = __builtin_amdgcn_mfma_f32_16x16x32_bf16(A0, B, acc[0][n], 0, 0, 0); acc[1][n] = __builtin_amdgcn_mfma_f32_16x16x32_bf16(A1, B, acc[1][n], 0, 0, 0); }
  }
  gd::lds_barrier();
#pragma unroll
  for (int m = 0; m < 2; ++m)
#pragma unroll
    for (int n = 0; n < 4; ++n) *(f32x4*)(lds + ((wv * 8 + m * 4 + n) * 64 + lane) * 4) = acc[m][n];
  gd::lds_barrier();
  f32x4 r = {0.f, 0.f, 0.f, 0.f};
#pragma unroll
  for (int w = 0; w < 8; ++w) r += *(const f32x4*)(lds + ((w * 8 + wv) * 64 + lane) * 4);
  return r;
}
__device__ __forceinline__ void ph_ctx_moe_gu(const Params& p, float* lds) {
  const int TIDX = ltid(); const int BIDX = lbid();
  const int lane = TIDX & 63, wv = TIDX >> 6, cc = lane & 15, g = lane >> 4;
  const bf16_t* H = (const bf16_t*)(p.ws + OFF_H); const bf16_t* GU = (const bf16_t*)(p.ws + OFF_MOEGU); bf16_t* hid = (bf16_t*)(p.ws + OFF_HID);
  const int* idx = (const int*)(p.ws + OFF_IDX);
  for (int it = BIDX; it < 32 * 16; it += gridDim.x) {
    const int grp = 32 + (it >> 4), ns = it & 15, s = grp >> 4, e = grp & 15, pb = pair_base(s, e);
    const gd::f32x4 v4 = coop_tile_32x64([&](int r) { return H + (size_t)idx[pb + r] * D; }, GU + (size_t)e * D * D + (size_t)(ns * 64) * D, D, D, lds, wv, lane);
    const int m = wv >> 2, n = wv & 3;
#pragma unroll
    for (int r = 0; r < 4; ++r) { const float v = v4[r], o = __shfl_xor(v, 1);
      if ((cc & 1) == 0) hid[(size_t)(pb + m * 16 + g * 4 + r) * DEXP + ((ns * 64 + n * 16 + cc) >> 1)] = f2bf(silu_f(v) * o); }
  }
}
__device__ __forceinline__ void ph_ctx_moe_down(const Params& p, float* lds) {
  const int TIDX = ltid(); const int BIDX = lbid();
  const int lane = TIDX & 63, wv = TIDX >> 6, cc = lane & 15, g = lane >> 4;
  const bf16_t* hid = (const bf16_t*)(p.ws + OFF_HID); const bf16_t* DN = (const bf16_t*)(p.ws + OFF_MOED); bf16_t* Y = (bf16_t*)(p.ws + OFF_Y);
  const float* gate = (const float*)(p.ws + OFF_GATE);
  for (int it = BIDX; it < 32 * 16; it += gridDim.x) {
    const int grp = 32 + (it >> 4), ns = it & 15, s = grp >> 4, e = grp & 15, pb = pair_base(s, e);
    const gd::f32x4 v4 = coop_tile_32x64([&](int r) { return hid + (size_t)(pb + r) * DEXP; }, DN + (size_t)e * D * DEXP + (size_t)(ns * 64) * DEXP, DEXP, DEXP, lds, wv, lane);
    const int m = wv >> 2, n = wv & 3;
#pragma unroll
    for (int r = 0; r < 4; ++r) { const int row = pb + m * 16 + g * 4 + r; Y[(size_t)row * D + ns * 64 + n * 16 + cc] = f2bf(v4[r] * gate[row]); }
  }
}
__device__ __forceinline__ void ph_ctx_outproj(const Params& p, int l, float* lds) {
  const int TIDX = ltid(); const int BIDX = lbid();
  const int lane = TIDX & 63, wv = TIDX >> 6, cc = lane & 15, g = lane >> 4;
  const bf16_t* A = (const bf16_t*)(p.ws + OFF_H) + (size_t)ML * D; const bf16_t* W = (const bf16_t*)(p.ws + OFF_WOUTT) + (size_t)l * D * D;
  bf16_t* yo = (bf16_t*)(p.ws + OFF_YO) + (size_t)ML * D;
  for (int it = BIDX; it < 16 * 16; it += gridDim.x) {
    const int mt = it >> 4, ns = it & 15;
    const gd::f32x4 v4 = coop_tile_32x64([&](int r) { return A + (size_t)(mt * 32 + r) * D; }, W + (size_t)(ns * 64) * D, D, D, lds, wv, lane);
    const int m = wv >> 2, n = wv & 3;
#pragma unroll
    for (int r = 0; r < 4; ++r) yo[(size_t)(mt * 32 + m * 16 + g * 4 + r) * D + ns * 64 + n * 16 + cc] = f2bf(v4[r]);
  }
}
__device__ __forceinline__ void mod2_stage_router(const Params& p, int l, float* lds, int t, int n) {
  const float* wr = p.router + (size_t)l * D * NE;
  for (int i = t; i < D * 4; i += n) { const int c = i >> 2, q = i & 3, pr = (c & ~255) + (c & 3) * 64 + ((c >> 2) & 63);
    *(float4*)(lds + pr * 20 + q * 4) = *(const float4*)(wr + c * 16 + q * 4); }
}
__device__ __forceinline__ void ph_modulate2_fast(const Params& p, int l, int nrows, float* lds, bool prestaged) {
  const int TIDX = ltid(); const int BIDX = lbid();
  const int lane = TIDX & 63, wv = TIDX >> 6;
  if (!prestaged) { __syncthreads(); mod2_stage_router(p, l, lds, TIDX, NT); __syncthreads(); }
  const float* g = p.norm2_g + l * D;
  for (int r4 = (BIDX + gridDim.x * wv) * 4; r4 < nrows; r4 += gridDim.x * 8 * 4) {
    int mj, t, tlen, r0; rowinfo(r4, mj, t, tlen, r0);
    const float* sh = modvec(p, l, mj, 3); const float* sc = modvec(p, l, mj, 4);
    float4 xv[4][4], gv[4], sv[4], hv[4];
#pragma unroll
    for (int rr = 0; rr < 4; ++rr) xv[rr][0] = xv[rr][1] = xv[rr][2] = xv[rr][3] = make_float4(0.f, 0.f, 0.f, 0.f);
    if (l == 0) {
#pragma unroll
      for (int rr = 0; rr < 4; ++rr) { const float* xr = xrow_src(p, r4 + rr, 0);
#pragma unroll
        for (int i = 0; i < 4; ++i) xv[rr][i] = ld_nt_f4(xr + i * 256 + lane * 4); }
    } else {
#pragma unroll
      for (int rr = 0; rr < 4; ++rr) { const bf16_t* xr = (const bf16_t*)xrow_src(p, r4 + rr, 1);
#pragma unroll
        for (int i = 0; i < 4; ++i) { const uint2 v = ld_nt_u2(xr + i * 256 + lane * 4);
          xv[rr][i] = make_float4(__uint_as_float(v.x << 16), __uint_as_float(v.x & 0xffff0000u), __uint_as_float(v.y << 16), __uint_as_float(v.y & 0xffff0000u)); } }
    }
    {
      const float* g1 = modvec(p, l, mj, 2); const bf16_t* yo = (const bf16_t*)(p.ws + OFF_YO);
      uint2 yall[4][4]; float4 ggall[4];
#pragma unroll
      for (int i = 0; i < 4; ++i) { const int c = i * 256 + lane * 4; ggall[i] = *(const float4*)(g1 + c); gv[i] = *(const float4*)(g + c); sv[i] = *(const float4*)(sc + c); hv[i] = *(const float4*)(sh + c);
#pragma unroll
        for (int rr = 0; rr < 4; ++rr) yall[rr][i] = ld_nt_u2(yo + (size_t)(r4 + rr) * D + c); }
#pragma unroll
      for (int i = 0; i < 4; ++i) { const int c = i * 256 + lane * 4; const float4 gg = ggall[i];
#pragma unroll
        for (int rr = 0; rr < 4; ++rr) { const uint2 yv = yall[rr][i];
          xv[rr][i].x += gg.x * __uint_as_float(yv.x << 16); xv[rr][i].y += gg.y * __uint_as_float(yv.x & 0xffff0000u);
          xv[rr][i].z += gg.z * __uint_as_float(yv.y << 16); xv[rr][i].w += gg.w * __uint_as_float(yv.y & 0xffff0000u);
          uint2 xb2; xb2.x = gd::pk(xv[rr][i].x, xv[rr][i].y); xb2.y = gd::pk(xv[rr][i].z, xv[rr][i].w);
          *(uint2*)((bf16_t*)xrow(p, r4 + rr) + c) = xb2; } }
    }
#pragma unroll
    for (int rr = 0; rr < 4; ++rr) {
      const int r = r4 + rr;
      float ss = 0.f;
#pragma unroll
      for (int i = 0; i < 4; ++i) ss += xv[rr][i].x * xv[rr][i].x + xv[rr][i].y * xv[rr][i].y + xv[rr][i].z * xv[rr][i].z + xv[rr][i].w * xv[rr][i].w;
      ss = wave_sum(ss);
      const float rstd = rsqrtf(ss / D + EPS);
      bf16_t* h = (bf16_t*)(p.ws + OFF_H) + (size_t)r * D;
      float lo[16];
      float __attribute__((ext_vector_type(4))) lo4[4];
#pragma unroll
      for (int e = 0; e < 4; ++e) lo4[e] = (float __attribute__((ext_vector_type(4)))){0.f, 0.f, 0.f, 0.f};
#pragma unroll
      for (int i = 0; i < 4; ++i) {
        const int c = i * 256 + lane * 4;
        float y[4];
        y[0] = xv[rr][i].x * rstd * gv[i].x * (1.f + sv[i].x) + hv[i].x; y[1] = xv[rr][i].y * rstd * gv[i].y * (1.f + sv[i].y) + hv[i].y;
        y[2] = xv[rr][i].z * rstd * gv[i].z * (1.f + sv[i].z) + hv[i].z; y[3] = xv[rr][i].w * rstd * gv[i].w * (1.f + sv[i].w) + hv[i].w;
        uint2 w; w.x = gd::pk(y[0], y[1]); w.y = gd::pk(y[2], y[3]);
        *(uint2*)(h + c) = w;
#pragma unroll
        for (int q = 0; q < 4; ++q) {
          const float* wrow = lds + (i * 256 + q * 64 + lane) * 20;
#pragma unroll
          for (int e4 = 0; e4 < 4; ++e4) { typedef float rt_f4 __attribute__((ext_vector_type(4))); const rt_f4 w4 = *(const rt_f4*)(wrow + e4 * 4);
            lo4[e4] += w4 * y[q]; }
        }
      }
#pragma unroll
      for (int e4 = 0; e4 < 4; ++e4) { lo[e4 * 4 + 0] = lo4[e4].x; lo[e4 * 4 + 1] = lo4[e4].y; lo[e4 * 4 + 2] = lo4[e4].z; lo[e4 * 4 + 3] = lo4[e4].w; }
#pragma unroll
      for (int k = 0; k < 4; ++k) {
        const int half = 8 >> k, mask = 32 >> k; const bool upper = (lane & mask) != 0;
#pragma unroll
        for (int i = 0; i < half; ++i) { const float send = upper ? lo[i] : lo[i + half]; const float recv = __shfl_xor(send, mask); lo[i] = (upper ? lo[i + half] : lo[i]) + recv; }
      }
      float v = lo[0]; v += __shfl_xor(v, 1); v += __shfl_xor(v, 2);
      float mx = v;
      mx = fmaxf(mx, __shfl_xor(mx, 4)); mx = fmaxf(mx, __shfl_xor(mx, 8)); mx = fmaxf(mx, __shfl_xor(mx, 16)); mx = fmaxf(mx, __shfl_xor(mx, 32));
      const float ex = expf(v - mx);
      float sm = ex; sm += __shfl_xor(sm, 4); sm += __shfl_xor(sm, 8); sm += __shfl_xor(sm, 16); sm += __shfl_xor(sm, 32);
      if ((lane & 3) == 0) { const int e = ((lane >> 5) & 1) * 8 + ((lane >> 4) & 1) * 4 + ((lane >> 3) & 1) * 2 + ((lane >> 2) & 1);
        ((float*)(p.ws + OFF_AFFT))[(size_t)e * MR + r] = ex / sm; }
    }
  }
}

__device__ __forceinline__ void ph_modulate1_fast(const Params& p) {
  const int TIDX = ltid(); const int BIDX = lbid();
  const int lane = TIDX & 63, wv = TIDX >> 6;
  const float* g = p.norm1_g;
  for (int r2 = (BIDX + gridDim.x * wv) * 2; r2 < MR; r2 += gridDim.x * 8 * 2) {
    int mj, t, tlen, r0; rowinfo(r2, mj, t, tlen, r0);
    const float* sh = modvec(p, 0, mj, 0); const float* sc = modvec(p, 0, mj, 1);
    float4 xv[2][4];
#pragma unroll
    for (int rr = 0; rr < 2; ++rr) { const float* xr = xrow_src(p, r2 + rr, 0);
#pragma unroll
      for (int i = 0; i < 4; ++i) xv[rr][i] = ld_nt_f4(xr + i * 256 + lane * 4); }
    float4 gv[4], sv[4], hv[4];
#pragma unroll
    for (int i = 0; i < 4; ++i) { const int c = i * 256 + lane * 4; gv[i] = *(const float4*)(g + c); sv[i] = *(const float4*)(sc + c); hv[i] = *(const float4*)(sh + c); }
#pragma unroll
    for (int rr = 0; rr < 2; ++rr) {
      float ss = 0.f;
#pragma unroll
      for (int i = 0; i < 4; ++i) ss += xv[rr][i].x * xv[rr][i].x + xv[rr][i].y * xv[rr][i].y + xv[rr][i].z * xv[rr][i].z + xv[rr][i].w * xv[rr][i].w;
      ss = wave_sum(ss);
      const float rstd = rsqrtf(ss / D + EPS);
      bf16_t* h = (bf16_t*)(p.ws + OFF_H) + (size_t)(r2 + rr) * D;
#pragma unroll
      for (int i = 0; i < 4; ++i) { const int c = i * 256 + lane * 4;
        uint2 w; w.x = gd::pk(xv[rr][i].x * rstd * gv[i].x * (1.f + sv[i].x) + hv[i].x, xv[rr][i].y * rstd * gv[i].y * (1.f + sv[i].y) + hv[i].y);
        w.y = gd::pk(xv[rr][i].z * rstd * gv[i].z * (1.f + sv[i].z) + hv[i].z, xv[rr][i].w * rstd * gv[i].w * (1.f + sv[i].w) + hv[i].w);
        *(uint2*)(h + c) = w; }
    }
  }
}

constexpr size_t LDS_BYTES = 163840;
__global__ void __launch_bounds__(NT, 2) mega(Params p) {
  extern __shared__ __attribute__((aligned(16))) char smem[];
  float* lds = (float*)smem;
  volatile LAS unsigned* xbst = (volatile LAS unsigned*)(smem + LDS_BYTES - 16);
  if (threadIdx.x == 0) { xbst[0] = 0u; xbst[1] = 0u; xbst[2] = 0u; xbst[3] = 0u; }
  __syncthreads();
  XcdBarrier xb = xcd_barrier_post((unsigned*)(p.ws + OFF_BAR), xbst);
  cg::grid_group grid = cg::this_grid();

  if (p.ws == nullptr) grid.sync();
  for (int l = 0; l < 2; ++l) {
    const bool need_ctx = l == 0;
    const int nrows = need_ctx ? MR : ML, nseq = need_ctx ? 4 : 2;
    if (l == 0) { ph_ada_fast(p, lds); ph_prep_weights(p, lds); xcd_barrier(xb); ph_modulate1_fast(p); xcd_barrier(xb); }
    ph_inproj_fast(p, l, smem);
    ph_prep_moe_weights<true>(p, l, lds, 214, (int)gridDim.x - 214);
    xcd_barrier_overlap(xb, [&](int t, int n) { gdn_stage_convw(p, l, smem, t, n); mla_stage_rope(lds, t, n); });
    { unsigned* bar = (unsigned*)(p.ws + OFF_BAR); unsigned* ctr = bar + 64 + 32 * l;
      ph_mla_gemm(p, l, smem);
      if (lbid() >= 32) handoff_publish(ctr);
      ph_gdn_precompute(p, l, smem);
      if (lbid() >= 32) { handoff_wait(ctr, gridDim.x - 32, bar); ph_mla_finish(p, l, lds); } }
    xcd_barrier(xb);
    for (int _r = 0; _r < REP_SCAN; ++_r) ph_scan_fast(p, smem);
    for (int _r = 0; _r < REP_ATTN; ++_r) ph_attn_fast(p, need_ctx, smem);
    ph_pool_mfma(p, l, nrows, smem);
    xcd_barrier(xb);
    ph_gdnfin2(p, l, nrows);
    xcd_barrier(xb);
    ph_outproj_fast(p, l, smem);
    if (need_ctx) ph_ctx_outproj(p, l, lds);
    xcd_barrier_overlap(xb, [&](int t, int n) { mod2_stage_router(p, l, lds, t, n); });
    for (int _r = 0; _r < REP_MOD; ++_r) ph_modulate2_fast(p, l, nrows, lds, _r == 0);
    xcd_barrier(xb);
    for (int _r = 0; _r < REP_TOPK; ++_r) ph_topk_fast(p, nseq, smem);
    ph_prep_moe_weights<false>(p, l, lds, 0, (int)gridDim.x);
    xcd_barrier(xb);
    for (int _r = 0; _r < REP_MOEGU; ++_r) ph_moe_gu_fast(p, smem);
    if (need_ctx) ph_ctx_moe_gu(p, lds);
    xcd_barrier(xb);
    ph_moe_down_fast(p, smem);
    if (need_ctx) ph_ctx_moe_down(p, lds);
    xcd_barrier(xb);
    ph_combine_fast(p, l, nrows, l == 0 ? 1 : -1);
    if (l == 0) xcd_barrier(xb);
  }
}

extern "C" void kernel_launch(void* const* d_in, const int* in_sizes, int n_in, void* d_out, int out_size, void* d_ws, size_t ws_size, hipStream_t stream) {
  static int grid_blocks = 0;
  if (ws_size < OFF_END) { fprintf(stderr, "kernel_launch: workspace too small: %zu < %zu\n", ws_size, (size_t)OFF_END); return; }
  if (!grid_blocks) {
    if (hipFuncSetAttribute((const void*)mega, hipFuncAttributeMaxDynamicSharedMemorySize, (int)LDS_BYTES) != hipSuccess) { fprintf(stderr, "kernel_launch: hipFuncSetAttribute failed\n"); return; }
    int dev = 0, cus = 0, per_cu = 0;
    hipGetDevice(&dev);
    hipDeviceGetAttribute(&cus, hipDeviceAttributeMultiprocessorCount, dev);
    hipOccupancyMaxActiveBlocksPerMultiprocessor(&per_cu, mega, NT, LDS_BYTES);
    if (per_cu < 1) { fprintf(stderr, "kernel_launch: occupancy query returned %d\n", per_cu); return; }
    grid_blocks = cus;
  }
  Params p{};
  const float** f = (const float**)&p;
  for (int i = 0; i < 26; ++i) f[i] = (const float*)d_in[i];
  p.out = (float*)d_out; p.ws = (char*)d_ws;
  hipMemsetAsync((char*)d_ws + OFF_BAR, 0, 16384, stream);
  void* args[] = {&p};
  hipError_t e = hipLaunchCooperativeKernel((const void*)mega, dim3(grid_blocks), dim3(NT), args, LDS_BYTES, stream);
  if (e != hipSuccess) fprintf(stderr, "cooperative launch failed: %s (grid %d)\n", hipGetErrorString(e), grid_blocks);
}
```
